# Optimizing an MI355X kernel written in HIP

```python
import math
import jax, jax.numpy as jnp
from jax import lax
import numpy as np

D_MODEL = 1024
BATCH = 8
SEQ = 2048
DEPTH = 4

HEAD_DIM = 64
HA = 8
KV_A = 2
G_A = HA // KV_A
HB = 4
WA = HA * HEAD_DIM
WB = HB * 2 * HEAD_DIM
WINDOW = 128
BLK = 128
QBLK = 128
N_BUCKETS = 32
MAX_DIST = 128
D_FF = 2816
CONV_WIDTH = 3
EPS = 1e-6
QA_W, KA_W, VA_W = WA, KV_A * HEAD_DIM, KV_A * HEAD_DIM
QB_W, KB_W, VB_W = HB * 2 * HEAD_DIM, HB * 2 * HEAD_DIM, HB * 2 * HEAD_DIM
IN_W = QA_W + KA_W + VA_W + QB_W + KB_W + VB_W

kernel_name = "hybrid_swa_diffattn_convffn_encoder"


def rms_norm(x, g):
    xf = x.astype(jnp.float32)
    y = xf * lax.rsqrt(jnp.mean(xf * xf, axis=-1, keepdims=True) + EPS)
    return (y * g.astype(jnp.float32)).astype(x.dtype)


def t5_bucket(rel):
    half = N_BUCKETS // 2
    max_exact = half // 2
    ret = jnp.where(rel > 0, half, 0)
    n = jnp.abs(rel)
    nf = jnp.maximum(n, 1).astype(jnp.float32)
    large = max_exact + (jnp.log(nf / max_exact) / math.log(MAX_DIST / max_exact)
                         * (half - max_exact)).astype(jnp.int32)
    large = jnp.minimum(large, half - 1)
    return ret + jnp.where(n < max_exact, n, large)


def windowed_gqa(q, k, v, sink, bias_tab):
    B, S = q.shape[0], q.shape[1]
    nb = S // BLK
    qb = q.reshape(B, nb, BLK, KV_A, G_A, HEAD_DIM)

    def band(t):
        tp = jnp.pad(t, ((0, 0), (BLK, BLK), (0, 0), (0, 0))).reshape(B, nb + 2, BLK, KV_A, HEAD_DIM)
        return jnp.concatenate([tp[:, :-2], tp[:, 1:-1], tp[:, 2:]], axis=2)

    kw, vw = band(k), band(v)
    s = jnp.einsum('bnqkgd,bnskd->bnkgqs', qb, kw).astype(jnp.float32) * (HEAD_DIM ** -0.5)
    rel = jnp.arange(3 * BLK)[None, :] - BLK - jnp.arange(BLK)[:, None]
    kpos = (jnp.arange(nb)[:, None] - 1) * BLK + jnp.arange(3 * BLK)[None, :]
    valid = (jnp.abs(rel) <= WINDOW)[None] & ((kpos >= 0) & (kpos < S))[:, None, :]
    bias = bias_tab[t5_bucket(rel)].astype(jnp.float32).transpose(2, 0, 1)
    s = s + bias.reshape(KV_A, G_A, BLK, 3 * BLK)
    s = jnp.where(valid[None, :, None, None], s, -jnp.inf)
    sink_col = jnp.broadcast_to(sink.astype(jnp.float32).reshape(1, 1, KV_A, G_A, 1, 1),
                                s.shape[:-1] + (1,))
    p = jax.nn.softmax(jnp.concatenate([s, sink_col], axis=-1), axis=-1)[..., :-1]
    o = jnp.einsum('bnkgqs,bnskd->bnqkgd', p.astype(v.dtype), vw)
    return o.reshape(B, S, WA)


def diff_attention(q, k, v, lam, lam_init, subln_g, bias_tab):
    B, S = q.shape[0], q.shape[1]
    nb = S // QBLK
    qblocks = q.reshape(B, nb, QBLK, HB, 2, HEAD_DIM).transpose(1, 0, 2, 3, 4, 5)
    kpos = jnp.arange(S)

    def one_block(args):
        qb, i = args
        qpos = i * QBLK + jnp.arange(QBLK)
        bias = bias_tab[t5_bucket(kpos[None, :] - qpos[:, None])].astype(jnp.float32)
        bias = bias.transpose(2, 0, 1)
        s = jnp.einsum('bqhcd,bkhcd->bhcqk', qb, k).astype(jnp.float32) * (HEAD_DIM ** -0.5)
        p = jax.nn.softmax(s + bias[None, :, None], axis=-1)
        a = p[:, :, 0] - lam * p[:, :, 1]
        return jnp.einsum('bhqk,bkhe->bqhe', a.astype(v.dtype), v)

    o = lax.map(one_block, (qblocks, jnp.arange(nb)))
    o = o.transpose(1, 0, 2, 3, 4).reshape(B, S, HB, 2 * HEAD_DIM)
    o = rms_norm(o, subln_g) * (1.0 - lam_init)
    return o.reshape(B, S, WB)


def dwconv_centred(u, w, b):
    S = u.shape[1]
    pad = CONV_WIDTH // 2
    up = jnp.pad(u, ((0, 0), (pad, pad), (0, 0)))
    out = b
    for j in range(CONV_WIDTH):
        out = out + up[:, j:j + S] * w[j]
    return out


def setup_inputs(seed: int = 0) -> dict:
    key = jax.random.key(seed)
    ks = jax.random.split(key, 24)
    f32 = jnp.float32
    nrm = lambda k, shape, s: jax.random.normal(k, shape, f32) * s
    L, D = DEPTH, D_MODEL
    return {
        "x": nrm(ks[0], (BATCH, SEQ, D), 1.0),
        "ln1_g": 1.0 + nrm(ks[1], (L, D), 0.02),
        "w_in": nrm(ks[2], (L, D, IN_W), D ** -0.5),
        "qn_a": 1.0 + nrm(ks[3], (L, HEAD_DIM), 0.02),
        "kn_a": 1.0 + nrm(ks[4], (L, HEAD_DIM), 0.02),
        "sink": nrm(ks[5], (L, HA), 0.5),
        "qn_b": 1.0 + nrm(ks[6], (L, HEAD_DIM), 0.02),
        "kn_b": 1.0 + nrm(ks[7], (L, HEAD_DIM), 0.02),
        "lam_q1": nrm(ks[8], (L, HEAD_DIM), 0.1),
        "lam_k1": nrm(ks[9], (L, HEAD_DIM), 0.1),
        "lam_q2": nrm(ks[10], (L, HEAD_DIM), 0.1),
        "lam_k2": nrm(ks[11], (L, HEAD_DIM), 0.1),
        "subln_g": 1.0 + nrm(ks[12], (L, 2 * HEAD_DIM), 0.02),
        "rel_bias": nrm(ks[13], (N_BUCKETS, HA + HB), 0.5),
        "w_gate": nrm(ks[14], (L, D, 2 * D), D ** -0.5),
        "b_gate": nrm(ks[15], (L, 2 * D), 0.02),
        "w_a_proj": nrm(ks[16], (L, WA, D), WA ** -0.5),
        "w_b_proj": nrm(ks[17], (L, WB, D), WB ** -0.5),
        "w_o": nrm(ks[18], (L, D, D), D ** -0.5),
        "ln2_g": 1.0 + nrm(ks[19], (L, D), 0.02),
        "w_up": nrm(ks[20], (L, D, 2 * D_FF), D ** -0.5),
        "conv_w": nrm(ks[21], (L, CONV_WIDTH, 2 * D_FF), CONV_WIDTH ** -0.5),
        "conv_b": nrm(ks[22], (L, 2 * D_FF), 0.02),
        "w_down": nrm(ks[23], (L, D_FF, D), D_FF ** -0.5),
    }


def reference(x, ln1_g, w_in, qn_a, kn_a, sink, qn_b, kn_b, lam_q1, lam_k1, lam_q2, lam_k2,
              subln_g, rel_bias, w_gate, b_gate, w_a_proj, w_b_proj, w_o, ln2_g, w_up,
              conv_w, conv_b, w_down):
    B, S, D = x.shape
    bias_a, bias_b = rel_bias[:, :HA], rel_bias[:, HA:]
    cuts = np.cumsum([QA_W, KA_W, VA_W, QB_W, KB_W]).tolist()
    for l in range(DEPTH):
        h = rms_norm(x, ln1_g[l])
        z = h @ w_in[l]
        zqa, zka, zva, zqb, zkb, zvb = jnp.split(z, cuts, axis=-1)
        q_a = rms_norm(zqa.reshape(B, S, HA, HEAD_DIM), qn_a[l])
        k_a = rms_norm(zka.reshape(B, S, KV_A, HEAD_DIM), kn_a[l])
        v_a = zva.reshape(B, S, KV_A, HEAD_DIM)
        o_a = windowed_gqa(q_a, k_a, v_a, sink[l], bias_a)
        q_b = rms_norm(zqb.reshape(B, S, HB, 2, HEAD_DIM), qn_b[l])
        k_b = rms_norm(zkb.reshape(B, S, HB, 2, HEAD_DIM), kn_b[l])
        v_b = zvb.reshape(B, S, HB, 2 * HEAD_DIM)
        lam_init = 0.8 - 0.6 * math.exp(-0.3 * l)
        lam = (jnp.exp(jnp.sum(lam_q1[l].astype(jnp.float32) * lam_k1[l].astype(jnp.float32)))
               - jnp.exp(jnp.sum(lam_q2[l].astype(jnp.float32) * lam_k2[l].astype(jnp.float32)))
               + lam_init)
        o_b = diff_attention(q_b, k_b, v_b, lam, lam_init, subln_g[l], bias_b)
        gates = jax.nn.sigmoid(h @ w_gate[l] + b_gate[l])
        g_a, g_b = gates[..., :D], gates[..., D:]
        mix = g_a * (o_a @ w_a_proj[l]) + g_b * (o_b @ w_b_proj[l])
        x = x + mix @ w_o[l]
        h2 = rms_norm(x, ln2_g[l])
        u = dwconv_centred(h2 @ w_up[l], conv_w[l], conv_b[l])
        val, gate = u[..., :D_FF], u[..., D_FF:]
        x = x + (jax.nn.silu(gate) * val) @ w_down[l]
    return x
```

```cpp
#include <hip/hip_runtime.h>
#include <cstdio>
#include <cstdint>
#include <cmath>

namespace nv {
typedef unsigned short bf16;
constexpr int D = 1024, B = 8, S = 2048, T = B * S, L = 4;
constexpr int HA = 8, KVA = 2, HB = 4, HD = 64;
constexpr int INW = 2304, GW = 2048, ZG = INW + GW;
constexpr int FF = 2816, FF2 = 2 * FF;
constexpr int C_QA = 0, C_KA = 512, C_VA = 640, C_QB = 768, C_KB = 1280, C_VB = 1792, C_G = 2304;
constexpr float EPS = 1e-6f;
constexpr float LOG2E = 1.4426950408889634f;
constexpr float C2 = 0.125f * LOG2E;

__device__ __forceinline__ float bf2f(bf16 v) { return __uint_as_float(((unsigned)v) << 16); }
__device__ __forceinline__ bf16 f2bf(float f) { unsigned u = __float_as_uint(f); return (bf16)((u + 0x7fffu + ((u >> 16) & 1u)) >> 16); }
__device__ __forceinline__ float ldf(const float* p) { return *p; }
__device__ __forceinline__ float ldf(const bf16* p) { return bf2f(*p); }

__device__ __forceinline__ int t5_bucket(int rel) {
    const int n = rel < 0 ? -rel : rel; int v;
    if (n < 8) v = n; else if (n < 12) v = 8; else if (n < 16) v = 9; else if (n < 23) v = 10; else if (n < 32) v = 11;
    else if (n < 46) v = 12; else if (n < 64) v = 13; else if (n < 91) v = 14; else v = 15;
    return (rel > 0 ? 16 : 0) + v;
}
__device__ __forceinline__ float wave_sum(float v) {
#pragma unroll
    for (int o = 1; o < 64; o <<= 1) v += __shfl_xor(v, o);
    return v;
}
__device__ __forceinline__ float wave_max(float v) {
#pragma unroll
    for (int o = 1; o < 64; o <<= 1) v = fmaxf(v, __shfl_xor(v, o));
    return v;
}

template <typename TA>
__global__ void __launch_bounds__(256) n_gemm(const TA* __restrict__ A, int lda, const float* __restrict__ gk, const float* __restrict__ W, int ldw, float* __restrict__ C, int ldc, int K) {
    __shared__ float As[16][68];
    __shared__ float Ws[16][64];
    const int tid = threadIdx.x, tx = tid & 15, ty = tid >> 4;
    const int m0 = blockIdx.y * 64, n0 = blockIdx.x * 64;
    float acc[4][4];
#pragma unroll
    for (int i = 0; i < 4; ++i)
#pragma unroll
        for (int j = 0; j < 4; ++j) acc[i][j] = 0.f;
    for (int k0 = 0; k0 < K; k0 += 16) {
#pragma unroll
        for (int i = 0; i < 4; ++i) { const int e = tid + i * 256, r = e >> 4, c = e & 15; float v = ldf(A + (size_t)(m0 + r) * lda + k0 + c); if (gk) v *= gk[k0 + c]; As[c][r] = v; }
#pragma unroll
        for (int i = 0; i < 4; ++i) { const int e = tid + i * 256, r = e >> 6, c = e & 63; Ws[r][c] = W[(size_t)(k0 + r) * ldw + n0 + c]; }
        __syncthreads();
#pragma unroll
        for (int kk = 0; kk < 16; ++kk) {
            float a[4], b[4];
#pragma unroll
            for (int i = 0; i < 4; ++i) { a[i] = As[kk][ty * 4 + i]; b[i] = Ws[kk][tx * 4 + i]; }
#pragma unroll
            for (int i = 0; i < 4; ++i)
#pragma unroll
                for (int j = 0; j < 4; ++j) acc[i][j] += a[i] * b[j];
        }
        __syncthreads();
    }
#pragma unroll
    for (int i = 0; i < 4; ++i)
#pragma unroll
        for (int j = 0; j < 4; ++j) C[(size_t)(m0 + ty * 4 + i) * ldc + n0 + tx * 4 + j] = acc[i][j];
}

__global__ void __launch_bounds__(256) n_init_x(const float* __restrict__ x, float* __restrict__ xf, bf16* __restrict__ xb, float* __restrict__ ss) {
    const int row = blockIdx.x * 4 + (threadIdx.x >> 6), lane = threadIdx.x & 63;
    float s = 0.f;
    for (int c = lane; c < D; c += 64) { const float v = x[(size_t)row * D + c]; xf[(size_t)row * D + c] = v; xb[(size_t)row * D + c] = f2bf(v); s += v * v; }
    s = wave_sum(s);
    if (lane == 0) ss[row] = s;
}

__global__ void __launch_bounds__(256) n_post_in(const float* __restrict__ Z, const float* __restrict__ ss, const float* __restrict__ qn_a, const float* __restrict__ kn_a,
                                                 const float* __restrict__ qn_b, const float* __restrict__ kn_b, bf16* __restrict__ zg, int row0) {
    const int r = blockIdx.x, t = row0 + r, wave = threadIdx.x >> 6, lane = threadIdx.x & 63;
    const float rs = rsqrtf(ss[t] * (1.0f / D) + EPS);
    for (int g = wave; g < INW / 64; g += 4) {
        float v = Z[(size_t)r * INW + g * 64 + lane] * rs;
        const float* gain = nullptr; float sc = 1.f;
        if (g < 8) { gain = qn_a; sc = C2; } else if (g < 10) { gain = kn_a; } else if (g < 12) { } else if (g < 20) { gain = qn_b; sc = C2; } else if (g < 28) { gain = kn_b; }
        if (gain) { const float q = wave_sum(v * v); v = v * rsqrtf(q * (1.0f / 64.0f) + EPS) * gain[lane] * sc; }
        zg[(size_t)t * ZG + g * 64 + lane] = f2bf(v);
    }
}
__global__ void __launch_bounds__(256) n_post_gate(const float* __restrict__ G, const float* __restrict__ ss, const float* __restrict__ bg, bf16* __restrict__ zg, int row0) {
    const int r = blockIdx.x, t = row0 + r;
    const float rs = rsqrtf(ss[t] * (1.0f / D) + EPS);
    for (int c = threadIdx.x; c < GW; c += 256) { const float v = G[(size_t)r * GW + c] * rs + bg[c]; zg[(size_t)t * ZG + C_G + c] = f2bf(1.0f / (1.0f + __expf(-v))); }
}

__global__ void __launch_bounds__(64) n_attn_a(bf16* __restrict__ zg, const float* __restrict__ sink, const float* __restrict__ rel_bias) {
    __shared__ float qs[64]; __shared__ float ps[5 * 64];
    const int t = blockIdx.x, h = blockIdx.y, lane = threadIdx.x, b = t / S, s = t % S, kv = h >> 2;
    qs[lane] = bf2f(zg[(size_t)t * ZG + C_QA + h * 64 + lane]);
    __syncthreads();
    const int j0 = s - 128;
    float sc[5]; float m = sink[h] * LOG2E;
#pragma unroll
    for (int i = 0; i < 5; ++i) {
        const int jj = i * 64 + lane, j = j0 + jj; float v = -1e30f;
        if (jj <= 256 && j >= 0 && j < S) {
            const bf16* kp = zg + (size_t)(b * S + j) * ZG + C_KA + kv * 64; float d = 0.f;
            for (int e = 0; e < 64; ++e) d += qs[e] * bf2f(kp[e]);
            v = d + rel_bias[t5_bucket(j - s) * 12 + h] * LOG2E;
        }
        sc[i] = v; m = fmaxf(m, v);
    }
    m = wave_max(m);
    float l = 0.f;
#pragma unroll
    for (int i = 0; i < 5; ++i) { const float p = (sc[i] > -1e29f) ? exp2f(sc[i] - m) : 0.f; ps[i * 64 + lane] = p; l += p; }
    l = wave_sum(l) + exp2f(sink[h] * LOG2E - m);
    __syncthreads();
    float o = 0.f;
    for (int jj = 0; jj <= 256; ++jj) { const int j = j0 + jj; if (j >= 0 && j < S) o += ps[jj] * bf2f(zg[(size_t)(b * S + j) * ZG + C_VA + kv * 64 + lane]); }
    zg[(size_t)t * ZG + C_QA + h * 64 + lane] = f2bf(o / l);
}

__global__ void __launch_bounds__(256) n_attn_b(bf16* __restrict__ zg, const float* __restrict__ rel_bias, const float* __restrict__ lq1, const float* __restrict__ lk1,
                                               const float* __restrict__ lq2, const float* __restrict__ lk2, const float* __restrict__ subg, float lam_init) {
    __shared__ float qs[128]; __shared__ float av[S]; __shared__ float s1s[S]; __shared__ float red[8]; __shared__ float osum[256];
    const int t = blockIdx.x, h = blockIdx.y, tid = threadIdx.x, lane = tid & 63, wave = tid >> 6, b = t / S, s = t % S;
    if (tid < 128) qs[tid] = bf2f(zg[(size_t)t * ZG + C_QB + h * 128 + tid]);
    float d1 = wave_sum(lq1[lane] * lk1[lane]), d2 = wave_sum(lq2[lane] * lk2[lane]);
    const float lam = __expf(d1) - __expf(d2) + lam_init;
    __syncthreads();
    float m0 = -1e30f, m1 = -1e30f;
#pragma unroll 1
    for (int i = 0; i < 8; ++i) {
        const int j = i * 256 + tid; const bf16* kp = zg + (size_t)(b * S + j) * ZG + C_KB + h * 128; float a0 = 0.f, a1 = 0.f;
#pragma unroll 8
        for (int e = 0; e < 64; ++e) { a0 += qs[e] * bf2f(kp[e]); a1 += qs[64 + e] * bf2f(kp[64 + e]); }
        const float bi = rel_bias[t5_bucket(j - s) * 12 + 8 + h] * LOG2E;
        a0 += bi; a1 += bi; av[j] = a0; s1s[j] = a1; m0 = fmaxf(m0, a0); m1 = fmaxf(m1, a1);
    }
    m0 = wave_max(m0); m1 = wave_max(m1);
    if (lane == 0) { red[wave] = m0; red[4 + wave] = m1; }
    __syncthreads();
    m0 = fmaxf(fmaxf(red[0], red[1]), fmaxf(red[2], red[3])); m1 = fmaxf(fmaxf(red[4], red[5]), fmaxf(red[6], red[7]));
    __syncthreads();
    float l0 = 0.f, l1 = 0.f;
#pragma unroll 1
    for (int i = 0; i < 8; ++i) { const int j = i * 256 + tid; const float p0 = exp2f(av[j] - m0), p1 = exp2f(s1s[j] - m1); av[j] = p0; s1s[j] = p1; l0 += p0; l1 += p1; }
    l0 = wave_sum(l0); l1 = wave_sum(l1);
    if (lane == 0) { red[wave] = l0; red[4 + wave] = l1; }
    __syncthreads();
    l0 = (red[0] + red[1]) + (red[2] + red[3]); l1 = (red[4] + red[5]) + (red[6] + red[7]);
#pragma unroll 1
    for (int i = 0; i < 8; ++i) { const int j = i * 256 + tid; av[j] = av[j] / l0 - lam * (s1s[j] / l1); }
    __syncthreads();
    const int e = tid & 127, half = tid >> 7; float o = 0.f;
    for (int j = half * 1024; j < half * 1024 + 1024; ++j) o += av[j] * bf2f(zg[(size_t)(b * S + j) * ZG + C_VB + h * 128 + e]);
    osum[tid] = o;
    __syncthreads();
    float ov = 0.f, q = 0.f;
    if (tid < 128) { ov = osum[tid] + osum[tid + 128]; q = ov * ov; }
    q = wave_sum(q);
    __syncthreads();
    if (lane == 0) red[wave] = q;
    __syncthreads();
    const float qq = red[0] + red[1];
    if (tid < 128) zg[(size_t)t * ZG + C_QB + h * 128 + tid] = f2bf(ov * rsqrtf(qq * (1.0f / 128.0f) + EPS) * subg[tid] * (1.0f - lam_init));
}

__global__ void __launch_bounds__(256) n_post_mix(const float* __restrict__ PA, const float* __restrict__ PB, const bf16* __restrict__ zg, bf16* __restrict__ mix, int row0) {
    const int r = blockIdx.x, t = row0 + r;
    for (int c = threadIdx.x; c < D; c += 256) {
        const float ga = bf2f(zg[(size_t)t * ZG + C_G + c]), gb = bf2f(zg[(size_t)t * ZG + C_G + D + c]);
        mix[(size_t)t * D + c] = f2bf(ga * PA[(size_t)r * D + c] + gb * PB[(size_t)r * D + c]);
    }
}
__global__ void __launch_bounds__(256) n_post_res(const float* __restrict__ tmp, float* __restrict__ xf, bf16* __restrict__ xb, float* __restrict__ ss_out, int row0) {
    __shared__ float red[4];
    const int r = blockIdx.x, t = row0 + r, lane = threadIdx.x & 63, wave = threadIdx.x >> 6; float s = 0.f;
    for (int c = threadIdx.x; c < D; c += 256) { const float v = xf[(size_t)t * D + c] + tmp[(size_t)r * D + c]; xf[(size_t)t * D + c] = v; xb[(size_t)t * D + c] = f2bf(v); s += v * v; }
    s = wave_sum(s); if (lane == 0) red[wave] = s;
    __syncthreads();
    if (threadIdx.x == 0 && ss_out) ss_out[t] = (red[0] + red[1]) + (red[2] + red[3]);
}
constexpr int HW = FF / 2;
__global__ void __launch_bounds__(256) n_post_conv(const float* __restrict__ U, const float* __restrict__ ss, const float* __restrict__ cw, const float* __restrict__ cb, bf16* __restrict__ a, int row0, int j0) {
    const int r = blockIdx.x, t = row0 + r;
    const float rs1 = rsqrtf(ss[t] * (1.0f / D) + EPS);
    const float rs0 = r > 0 ? rsqrtf(ss[t - 1] * (1.0f / D) + EPS) : 0.f;
    const float rs2 = r < S - 1 ? rsqrtf(ss[t + 1] * (1.0f / D) + EPS) : 0.f;
    for (int j = threadIdx.x; j < HW; j += 256) {
        float u[2];
#pragma unroll
        for (int gsel = 0; gsel < 2; ++gsel) {
            const int col = gsel * FF + j0 + j, uc = gsel * HW + j;
            const float y1 = U[(size_t)r * (2 * HW) + uc] * rs1;
            const float y0 = r > 0 ? U[(size_t)(r - 1) * (2 * HW) + uc] * rs0 : 0.f;
            const float y2 = r < S - 1 ? U[(size_t)(r + 1) * (2 * HW) + uc] * rs2 : 0.f;
            u[gsel] = cb[col] + cw[col] * y0 + cw[FF2 + col] * y1 + cw[2 * FF2 + col] * y2;
        }
        const float sg = u[1] / (1.0f + __expf(-u[1]));
        a[(size_t)t * FF + j0 + j] = f2bf(sg * u[0]);
    }
}
}

extern "C" void kernel_launch(void* const* d_in, const int* in_sizes, int n_in, void* d_out, int out_size, void* d_ws, size_t ws_size, hipStream_t stream) {
    using namespace nv;
    const float* x = (const float*)d_in[0]; const float* ln1_g = (const float*)d_in[1]; const float* w_in = (const float*)d_in[2];
    const float* qn_a = (const float*)d_in[3]; const float* kn_a = (const float*)d_in[4]; const float* sink = (const float*)d_in[5];
    const float* qn_b = (const float*)d_in[6]; const float* kn_b = (const float*)d_in[7];
    const float* lq1 = (const float*)d_in[8]; const float* lk1 = (const float*)d_in[9]; const float* lq2 = (const float*)d_in[10]; const float* lk2 = (const float*)d_in[11];
    const float* subg = (const float*)d_in[12]; const float* rel_bias = (const float*)d_in[13]; const float* w_gate = (const float*)d_in[14]; const float* b_gate = (const float*)d_in[15];
    const float* w_a = (const float*)d_in[16]; const float* w_b = (const float*)d_in[17]; const float* w_o = (const float*)d_in[18]; const float* ln2_g = (const float*)d_in[19];
    const float* w_up = (const float*)d_in[20]; const float* conv_w = (const float*)d_in[21]; const float* conv_b = (const float*)d_in[22]; const float* w_down = (const float*)d_in[23];
    float* xf = (float*)d_out;
    unsigned char* ws = (unsigned char*)d_ws;
    constexpr size_t MiB = 1u << 20;
    float* ss = (float*)(ws + 1 * MiB);
    bf16* xb = (bf16*)(ws + 2 * MiB);
    bf16* zg = (bf16*)(ws + 34 * MiB);
    bf16* abuf = (bf16*)(ws + 34 * MiB);
    bf16* mix = (bf16*)(ws + 170 * MiB);
    float* tmpA = (float*)(ws + 202 * MiB);
    float* tmpB = (float*)(ws + 224 * MiB);
    n_init_x<<<T / 4, 256, 0, stream>>>(x, xf, xb, ss);
    for (int l = 0; l < L; ++l) {
        const float lam_init = 0.8f - 0.6f * expf(-0.3f * (float)l);
        float* ss1 = ss + (size_t)(2 * l) * T; float* ss2 = ss + (size_t)(2 * l + 1) * T; float* ss3 = (l + 1 < L) ? ss + (size_t)(2 * l + 2) * T : nullptr;
        for (int b = 0; b < B; ++b) {
            const int row0 = b * S;
            n_gemm<bf16><<<dim3(INW / 64, S / 64), 256, 0, stream>>>(xb + (size_t)row0 * D, D, ln1_g + l * D, w_in + (size_t)l * D * INW, INW, tmpA, INW, D);
            n_post_in<<<S, 256, 0, stream>>>(tmpA, ss1, qn_a + l * 64, kn_a + l * 64, qn_b + l * 64, kn_b + l * 64, zg, row0);
            n_gemm<bf16><<<dim3(GW / 64, S / 64), 256, 0, stream>>>(xb + (size_t)row0 * D, D, ln1_g + l * D, w_gate + (size_t)l * D * GW, GW, tmpA, GW, D);
            n_post_gate<<<S, 256, 0, stream>>>(tmpA, ss1, b_gate + l * GW, zg, row0);
        }
        n_attn_a<<<dim3(T, HA), 64, 0, stream>>>(zg, sink + l * HA, rel_bias);
        n_attn_b<<<dim3(T, HB), 256, 0, stream>>>(zg, rel_bias, lq1 + l * 64, lk1 + l * 64, lq2 + l * 64, lk2 + l * 64, subg + l * 128, lam_init);
        for (int b = 0; b < B; ++b) {
            const int row0 = b * S;
            n_gemm<bf16><<<dim3(D / 64, S / 64), 256, 0, stream>>>(zg + (size_t)row0 * ZG + C_QA, ZG, nullptr, w_a + (size_t)l * 512 * D, D, tmpA, D, 512);
            n_gemm<bf16><<<dim3(D / 64, S / 64), 256, 0, stream>>>(zg + (size_t)row0 * ZG + C_QB, ZG, nullptr, w_b + (size_t)l * 512 * D, D, tmpB, D, 512);
            n_post_mix<<<S, 256, 0, stream>>>(tmpA, tmpB, zg, mix, row0);
        }
        for (int b = 0; b < B; ++b) {
            const int row0 = b * S;
            n_gemm<bf16><<<dim3(D / 64, S / 64), 256, 0, stream>>>(mix + (size_t)row0 * D, D, nullptr, w_o + (size_t)l * D * D, D, tmpA, D, D);
            n_post_res<<<S, 256, 0, stream>>>(tmpA, xf, xb, ss2, row0);
        }
        for (int b = 0; b < B; ++b) {
            const int row0 = b * S;
            for (int hf = 0; hf < 2; ++hf) {
                const int j0 = hf * HW;
                n_gemm<bf16><<<dim3(HW / 64, S / 64), 256, 0, stream>>>(xb + (size_t)row0 * D, D, ln2_g + l * D, w_up + (size_t)l * D * FF2 + j0, FF2, tmpA, 2 * HW, D);
                n_gemm<bf16><<<dim3(HW / 64, S / 64), 256, 0, stream>>>(xb + (size_t)row0 * D, D, ln2_g + l * D, w_up + (size_t)l * D * FF2 + FF + j0, FF2, tmpA + HW, 2 * HW, D);
                n_post_conv<<<S, 256, 0, stream>>>(tmpA, ss2, conv_w + (size_t)l * 3 * FF2, conv_b + (size_t)l * FF2, abuf, row0, j0);
            }
        }
        for (int b = 0; b < B; ++b) {
            const int row0 = b * S;
            n_gemm<bf16><<<dim3(D / 64, S / 64), 256, 0, stream>>>(abuf + (size_t)row0 * FF, FF, nullptr, w_down + (size_t)l * FF * D, D, tmpA, D, FF);
            n_post_res<<<S, 256, 0, stream>>>(tmpA, xf, xb, ss3, row0);
        }
    }
}
```

```cpp
#include <hip/hip_runtime.h>
#include <cstdio>
#include <cstdint>
#include <cmath>

namespace nv {
typedef unsigned short bf16;
constexpr int D = 1024, B = 8, S = 2048, T = B * S, L = 4;
constexpr int HA = 8, KVA = 2, HB = 4, HD = 64;
constexpr int INW = 2304, GW = 2048, ZG = INW + GW;
constexpr int FF = 2816, FF2 = 2 * FF;
constexpr int C_QA = 0, C_KA = 512, C_VA = 640, C_QB = 768, C_KB = 1280, C_VB = 1792, C_G = 2304;
constexpr float EPS = 1e-6f;
constexpr float LOG2E = 1.4426950408889634f;
constexpr float C2 = 0.125f * LOG2E;

__device__ __forceinline__ float bf2f(bf16 v) { return __uint_as_float(((unsigned)v) << 16); }
__device__ __forceinline__ bf16 f2bf(float f) { unsigned u = __float_as_uint(f); return (bf16)((u + 0x7fffu + ((u >> 16) & 1u)) >> 16); }
__device__ __forceinline__ float ldf(const float* p) { return *p; }
__device__ __forceinline__ float ldf(const bf16* p) { return bf2f(*p); }

__device__ __forceinline__ int t5_bucket(int rel) {
    const int n = rel < 0 ? -rel : rel; int v;
    if (n < 8) v = n; else if (n < 12) v = 8; else if (n < 16) v = 9; else if (n < 23) v = 10; else if (n < 32) v = 11;
    else if (n < 46) v = 12; else if (n < 64) v = 13; else if (n < 91) v = 14; else v = 15;
    return (rel > 0 ? 16 : 0) + v;
}
__device__ __forceinline__ float ss16(const float* ss, int t) { const float4* p = (const float4*)(ss + (size_t)t * 16); const float4 a = p[0], b = p[1], c = p[2], d = p[3];
    return ((a.x + a.y) + (a.z + a.w)) + ((b.x + b.y) + (b.z + b.w)) + ((c.x + c.y) + (c.z + c.w)) + ((d.x + d.y) + (d.z + d.w)); }
__device__ __forceinline__ void ss16_store(float* ss, int t, float s, int lane) { if (lane < 16) ss[(size_t)t * 16 + lane] = lane == 0 ? s : 0.f; }
__device__ __forceinline__ float wave_sum(float v) {
#pragma unroll
    for (int o = 1; o < 64; o <<= 1) v += __shfl_xor(v, o);
    return v;
}
__device__ __forceinline__ float wave_max(float v) {
#pragma unroll
    for (int o = 1; o < 64; o <<= 1) v = fmaxf(v, __shfl_xor(v, o));
    return v;
}

template <typename TA>
__global__ void __launch_bounds__(256) n_gemm(const TA* __restrict__ A, int lda, const float* __restrict__ gk, const float* __restrict__ W, int ldw, float* __restrict__ C, int ldc, int K) {
    __shared__ float As[16][68];
    __shared__ float Ws[16][64];
    const int tid = threadIdx.x, tx = tid & 15, ty = tid >> 4;
    const int m0 = blockIdx.y * 64, n0 = blockIdx.x * 64;
    float acc[4][4];
#pragma unroll
    for (int i = 0; i < 4; ++i)
#pragma unroll
        for (int j = 0; j < 4; ++j) acc[i][j] = 0.f;
    for (int k0 = 0; k0 < K; k0 += 16) {
#pragma unroll
        for (int i = 0; i < 4; ++i) { const int e = tid + i * 256, r = e >> 4, c = e & 15; float v = ldf(A + (size_t)(m0 + r) * lda + k0 + c); if (gk) v *= gk[k0 + c]; As[c][r] = v; }
#pragma unroll
        for (int i = 0; i < 4; ++i) { const int e = tid + i * 256, r = e >> 6, c = e & 63; Ws[r][c] = W[(size_t)(k0 + r) * ldw + n0 + c]; }
        __syncthreads();
#pragma unroll
        for (int kk = 0; kk < 16; ++kk) {
            float a[4], b[4];
#pragma unroll
            for (int i = 0; i < 4; ++i) { a[i] = As[kk][ty * 4 + i]; b[i] = Ws[kk][tx * 4 + i]; }
#pragma unroll
            for (int i = 0; i < 4; ++i)
#pragma unroll
                for (int j = 0; j < 4; ++j) acc[i][j] += a[i] * b[j];
        }
        __syncthreads();
    }
#pragma unroll
    for (int i = 0; i < 4; ++i)
#pragma unroll
        for (int j = 0; j < 4; ++j) C[(size_t)(m0 + ty * 4 + i) * ldc + n0 + tx * 4 + j] = acc[i][j];
}

__global__ void __launch_bounds__(256) n_init_x(const float* __restrict__ x, float* __restrict__ xf, bf16* __restrict__ xb, float* __restrict__ ss) {
    const int row = blockIdx.x * 4 + (threadIdx.x >> 6), lane = threadIdx.x & 63;
    float s = 0.f;
    for (int c = lane; c < D; c += 64) { const float v = x[(size_t)row * D + c]; xf[(size_t)row * D + c] = v; xb[(size_t)row * D + c] = f2bf(v); s += v * v; }
    s = wave_sum(s);
    ss16_store(ss, row, s, lane);
}

__global__ void __launch_bounds__(256) n_post_in(const float* __restrict__ Z, const float* __restrict__ ss, const float* __restrict__ qn_a, const float* __restrict__ kn_a,
                                                 const float* __restrict__ qn_b, const float* __restrict__ kn_b, bf16* __restrict__ zg, int row0) {
    const int r = blockIdx.x, t = row0 + r, wave = threadIdx.x >> 6, lane = threadIdx.x & 63;
    const float rs = rsqrtf(ss16(ss, t) * (1.0f / D) + EPS);
    for (int g = wave; g < INW / 64; g += 4) {
        float v = Z[(size_t)r * INW + g * 64 + lane] * rs;
        const float* gain = nullptr; float sc = 1.f;
        if (g < 8) { gain = qn_a; sc = C2; } else if (g < 10) { gain = kn_a; } else if (g < 12) { } else if (g < 20) { gain = qn_b; sc = C2; } else if (g < 28) { gain = kn_b; }
        if (gain) { const float q = wave_sum(v * v); v = v * rsqrtf(q * (1.0f / 64.0f) + EPS) * gain[lane] * sc; }
        zg[(size_t)t * ZG + g * 64 + lane] = f2bf(v);
    }
}
__global__ void __launch_bounds__(256) n_post_gate(const float* __restrict__ G, const float* __restrict__ ss, const float* __restrict__ bg, bf16* __restrict__ zg, int row0) {
    const int r = blockIdx.x, t = row0 + r;
    const float rs = rsqrtf(ss16(ss, t) * (1.0f / D) + EPS);
    for (int c = threadIdx.x; c < GW; c += 256) { const float v = G[(size_t)r * GW + c] * rs + bg[c]; zg[(size_t)t * ZG + C_G + c] = f2bf(1.0f / (1.0f + __expf(-v))); }
}

__global__ void __launch_bounds__(64) n_attn_a(bf16* __restrict__ zg, const float* __restrict__ sink, const float* __restrict__ rel_bias) {
    __shared__ float qs[64]; __shared__ float ps[5 * 64];
    const int t = blockIdx.x, h = blockIdx.y, lane = threadIdx.x, b = t / S, s = t % S, kv = h >> 2;
    qs[lane] = bf2f(zg[(size_t)t * ZG + C_QA + h * 64 + lane]);
    __syncthreads();
    const int j0 = s - 128;
    float sc[5]; float m = sink[h] * LOG2E;
#pragma unroll
    for (int i = 0; i < 5; ++i) {
        const int jj = i * 64 + lane, j = j0 + jj; float v = -1e30f;
        if (jj <= 256 && j >= 0 && j < S) {
            const bf16* kp = zg + (size_t)(b * S + j) * ZG + C_KA + kv * 64; float d = 0.f;
            for (int e = 0; e < 64; ++e) d += qs[e] * bf2f(kp[e]);
            v = d + rel_bias[t5_bucket(j - s) * 12 + h] * LOG2E;
        }
        sc[i] = v; m = fmaxf(m, v);
    }
    m = wave_max(m);
    float l = 0.f;
#pragma unroll
    for (int i = 0; i < 5; ++i) { const float p = (sc[i] > -1e29f) ? exp2f(sc[i] - m) : 0.f; ps[i * 64 + lane] = p; l += p; }
    l = wave_sum(l) + exp2f(sink[h] * LOG2E - m);
    __syncthreads();
    float o = 0.f;
    for (int jj = 0; jj <= 256; ++jj) { const int j = j0 + jj; if (j >= 0 && j < S) o += ps[jj] * bf2f(zg[(size_t)(b * S + j) * ZG + C_VA + kv * 64 + lane]); }
    zg[(size_t)t * ZG + C_QA + h * 64 + lane] = f2bf(o / l);
}

__global__ void __launch_bounds__(256) n_attn_b(bf16* __restrict__ zg, const float* __restrict__ rel_bias, const float* __restrict__ lq1, const float* __restrict__ lk1,
                                               const float* __restrict__ lq2, const float* __restrict__ lk2, const float* __restrict__ subg, float lam_init) {
    __shared__ float qs[128]; __shared__ float av[S]; __shared__ float s1s[S]; __shared__ float red[8]; __shared__ float osum[256];
    const int t = blockIdx.x, h = blockIdx.y, tid = threadIdx.x, lane = tid & 63, wave = tid >> 6, b = t / S, s = t % S;
    if (tid < 128) qs[tid] = bf2f(zg[(size_t)t * ZG + C_QB + h * 128 + tid]);
    float d1 = wave_sum(lq1[lane] * lk1[lane]), d2 = wave_sum(lq2[lane] * lk2[lane]);
    const float lam = __expf(d1) - __expf(d2) + lam_init;
    __syncthreads();
    float m0 = -1e30f, m1 = -1e30f;
#pragma unroll 1
    for (int i = 0; i < 8; ++i) {
        const int j = i * 256 + tid; const bf16* kp = zg + (size_t)(b * S + j) * ZG + C_KB + h * 128; float a0 = 0.f, a1 = 0.f;
#pragma unroll 8
        for (int e = 0; e < 64; ++e) { a0 += qs[e] * bf2f(kp[e]); a1 += qs[64 + e] * bf2f(kp[64 + e]); }
        const float bi = rel_bias[t5_bucket(j - s) * 12 + 8 + h] * LOG2E;
        a0 += bi; a1 += bi; av[j] = a0; s1s[j] = a1; m0 = fmaxf(m0, a0); m1 = fmaxf(m1, a1);
    }
    m0 = wave_max(m0); m1 = wave_max(m1);
    if (lane == 0) { red[wave] = m0; red[4 + wave] = m1; }
    __syncthreads();
    m0 = fmaxf(fmaxf(red[0], red[1]), fmaxf(red[2], red[3])); m1 = fmaxf(fmaxf(red[4], red[5]), fmaxf(red[6], red[7]));
    __syncthreads();
    float l0 = 0.f, l1 = 0.f;
#pragma unroll 1
    for (int i = 0; i < 8; ++i) { const int j = i * 256 + tid; const float p0 = exp2f(av[j] - m0), p1 = exp2f(s1s[j] - m1); av[j] = p0; s1s[j] = p1; l0 += p0; l1 += p1; }
    l0 = wave_sum(l0); l1 = wave_sum(l1);
    if (lane == 0) { red[wave] = l0; red[4 + wave] = l1; }
    __syncthreads();
    l0 = (red[0] + red[1]) + (red[2] + red[3]); l1 = (red[4] + red[5]) + (red[6] + red[7]);
#pragma unroll 1
    for (int i = 0; i < 8; ++i) { const int j = i * 256 + tid; av[j] = av[j] / l0 - lam * (s1s[j] / l1); }
    __syncthreads();
    const int e = tid & 127, half = tid >> 7; float o = 0.f;
    for (int j = half * 1024; j < half * 1024 + 1024; ++j) o += av[j] * bf2f(zg[(size_t)(b * S + j) * ZG + C_VB + h * 128 + e]);
    osum[tid] = o;
    __syncthreads();
    float ov = 0.f, q = 0.f;
    if (tid < 128) { ov = osum[tid] + osum[tid + 128]; q = ov * ov; }
    q = wave_sum(q);
    __syncthreads();
    if (lane == 0) red[wave] = q;
    __syncthreads();
    const float qq = red[0] + red[1];
    if (tid < 128) zg[(size_t)t * ZG + C_QB + h * 128 + tid] = f2bf(ov * rsqrtf(qq * (1.0f / 128.0f) + EPS) * subg[tid] * (1.0f - lam_init));
}

__global__ void __launch_bounds__(256) n_post_mix(const float* __restrict__ PA, const float* __restrict__ PB, const bf16* __restrict__ zg, bf16* __restrict__ mix, int row0) {
    const int r = blockIdx.x, t = row0 + r;
    for (int c = threadIdx.x; c < D; c += 256) {
        const float ga = bf2f(zg[(size_t)t * ZG + C_G + c]), gb = bf2f(zg[(size_t)t * ZG + C_G + D + c]);
        mix[(size_t)t * D + c] = f2bf(ga * PA[(size_t)r * D + c] + gb * PB[(size_t)r * D + c]);
    }
}
__global__ void __launch_bounds__(256) n_post_res(const float* __restrict__ tmp, float* __restrict__ xf, bf16* __restrict__ xb, float* __restrict__ ss_out, int row0) {
    __shared__ float red[4];
    const int r = blockIdx.x, t = row0 + r, lane = threadIdx.x & 63, wave = threadIdx.x >> 6; float s = 0.f;
    for (int c = threadIdx.x; c < D; c += 256) { const float v = xf[(size_t)t * D + c] + tmp[(size_t)r * D + c]; xf[(size_t)t * D + c] = v; xb[(size_t)t * D + c] = f2bf(v); s += v * v; }
    s = wave_sum(s); if (lane == 0) red[wave] = s;
    __syncthreads();
    if (ss_out) ss16_store(ss_out, t, (red[0] + red[1]) + (red[2] + red[3]), threadIdx.x);
}
constexpr int HW = FF / 2;
__global__ void __launch_bounds__(256) n_post_conv(const float* __restrict__ U, const float* __restrict__ ss, const float* __restrict__ cw, const float* __restrict__ cb, bf16* __restrict__ a, int row0, int j0) {
    const int r = blockIdx.x, t = row0 + r;
    const float rs1 = rsqrtf(ss16(ss, t) * (1.0f / D) + EPS);
    const float rs0 = r > 0 ? rsqrtf(ss16(ss, t - 1) * (1.0f / D) + EPS) : 0.f;
    const float rs2 = r < S - 1 ? rsqrtf(ss16(ss, t + 1) * (1.0f / D) + EPS) : 0.f;
    for (int j = threadIdx.x; j < HW; j += 256) {
        float u[2];
#pragma unroll
        for (int gsel = 0; gsel < 2; ++gsel) {
            const int col = gsel * FF + j0 + j, uc = gsel * HW + j;
            const float y1 = U[(size_t)r * (2 * HW) + uc] * rs1;
            const float y0 = r > 0 ? U[(size_t)(r - 1) * (2 * HW) + uc] * rs0 : 0.f;
            const float y2 = r < S - 1 ? U[(size_t)(r + 1) * (2 * HW) + uc] * rs2 : 0.f;
            u[gsel] = cb[col] + cw[col] * y0 + cw[FF2 + col] * y1 + cw[2 * FF2 + col] * y2;
        }
        const float sg = u[1] / (1.0f + __expf(-u[1]));
        a[(size_t)t * FF + j0 + j] = f2bf(sg * u[0]);
    }
}
__global__ void __launch_bounds__(256) n_rowss(const float* __restrict__ xf, float* __restrict__ ss_out) {
    const int row = blockIdx.x * 4 + (threadIdx.x >> 6), lane = threadIdx.x & 63; float s = 0.f;
    for (int c = lane; c < D; c += 64) { const float v = xf[(size_t)row * D + c]; s += v * v; }
    s = wave_sum(s); ss16_store(ss_out, row, s, lane);
}
}


namespace pg8 {
using namespace nv;
#define PG8_LAS __attribute__((address_space(3)))
typedef unsigned short bf16_t;
typedef short bf16x8 __attribute__((ext_vector_type(8)));
typedef float f32x4 __attribute__((ext_vector_type(4)));
typedef unsigned u32x4 __attribute__((ext_vector_type(4)));
typedef unsigned u32x2 __attribute__((ext_vector_type(2)));
constexpr int BM = 256, BK = 64, HALF = 128, HTB = HALF * BK * 2  , STAGE_BYTES = 8 * HTB, NXCD = 8, WGM = 8;
constexpr int XOFF = 131072 + 1024;

__host__ __device__ __forceinline__ int lds_byte(int r, int c) { const int st = (r >> 4) * 2 + (c >> 5), rr = r & 15, cc = c & 31, ob = rr * 64 + cc * 2; return st * 1024 + (ob ^ (((ob >> 9) & 1) << 5)); }
__host__ __device__ __forceinline__ void stage_rc(int b, int& R, int& C) { const int st = b / 1024, sb = b % 1024, swz = sb ^ (((sb >> 9) & 1) << 5); R = (st >> 1) * 16 + swz / 64; C = (st & 1) * 32 + (swz % 64) / 2; }
__host__ __device__ __forceinline__ int perm32(int rho) { const int n = rho >> 4, i = rho & 15; return 8 * (i >> 2) + 4 * n + (i & 3); }

struct Unit { int pm, pn, z; };
typedef float f32x2 __attribute__((ext_vector_type(2))); typedef __bf16 bf16x2_t __attribute__((ext_vector_type(2)));
__device__ __forceinline__ unsigned cvt_pk_bf16(float lo, float hi) { f32x2 v = {lo, hi}; bf16x2_t b = __builtin_convertvector(v, bf16x2_t); return __builtin_bit_cast(unsigned, b); }
__device__ __forceinline__ float bflo(unsigned w) { return __uint_as_float(w << 16); }
__device__ __forceinline__ float bfhi(unsigned w) { return __uint_as_float(w & 0xffff0000u); }

struct SchedStd {
    int nM, nN, nwg, G, c; const char* A; const char* Bt; size_t at, bt;
    __device__ void init(const void* A_, int lda, const void* Bt_, int K, int M, int N, int G_, int c_) { nM = M / BM; nN = N / BM; nwg = nM * nN; G = G_; c = c_; A = (const char*)A_; Bt = (const char*)Bt_; at = (size_t)BM * lda * 2; bt = (size_t)BM * K * 2; }
    __device__ bool next(int i, Unit& u) const {
        const long L = (long)i * G + c; if (L >= nwg) return false;
        int wgid = (int)L; { const int q = nwg / NXCD, r = nwg % NXCD, xcd = wgid % NXCD, off = wgid / NXCD; wgid = (xcd < r ? xcd * (q + 1) : r * (q + 1) + (xcd - r) * q) + off; }
        const int nig = WGM * nN, gid = wgid / nig, fm = gid * WGM, gsz = (nM - fm) < WGM ? (nM - fm) : WGM;
        u.pm = fm + ((wgid % nig) % gsz); u.pn = (wgid % nig) / gsz; u.z = 0; return true;
    }
    __device__ __forceinline__ const char* aptr(const Unit& u) const { return A + (size_t)u.pm * at; }
    __device__ __forceinline__ const char* bptr(const Unit& u) const { return Bt + (size_t)u.pn * bt; }
    __device__ __forceinline__ void a_ready(const Unit&) const {}
    __device__ __forceinline__ void done(const Unit&) const {}
};
struct SchedMix {
    SchedStd b; const char* A1; const char* Bt1;
    __device__ bool next(int i, Unit& u) const { if (!b.next(i >> 1, u)) return false; u.z = i & 1; return true; }
    __device__ __forceinline__ const char* aptr(const Unit& u) const { return (u.z ? A1 : b.A) + (size_t)u.pm * b.at; }
    __device__ __forceinline__ const char* bptr(const Unit& u) const { return (u.z ? Bt1 : b.Bt) + (size_t)u.pn * b.bt; }
    __device__ __forceinline__ void a_ready(const Unit&) const {}
    __device__ __forceinline__ void done(const Unit&) const {}
};
struct SchedDown {
    SchedStd b; const float* yb; const float* cw; const float* cb; bf16_t* a;
    __device__ bool next(int i, Unit& u) const { return b.next(i, u); }
    __device__ __forceinline__ const char* aptr(const Unit& u) const { return b.aptr(u); }
    __device__ __forceinline__ const char* bptr(const Unit& u) const { return b.bptr(u); }
    __device__ __forceinline__ void a_ready(const Unit& u) const {
        const int pm = u.pm;
        if (yb)
        for (int idx = threadIdx.x; idx < 2 * FF; idx += 512) {
            const int which = idx >= FF ? 1 : 0, j = idx - which * FF;
            float uv[2];
#pragma unroll
            for (int gs = 0; gs < 2; ++gs) {
                const int col = gs * FF + j; float y0, y1, y2;
                if (which == 0) { y0 = (pm & 7) ? yb[((size_t)(pm - 1) * 4 + 3) * FF2 + col] : 0.f; y1 = yb[((size_t)pm * 4 + 0) * FF2 + col]; y2 = yb[((size_t)pm * 4 + 1) * FF2 + col]; }
                else { y0 = yb[((size_t)pm * 4 + 2) * FF2 + col]; y1 = yb[((size_t)pm * 4 + 3) * FF2 + col]; y2 = ((pm & 7) != 7) ? yb[((size_t)(pm + 1) * 4 + 0) * FF2 + col] : 0.f; }
                uv[gs] = cb[col] + cw[col] * y0 + cw[FF2 + col] * y1 + cw[2 * FF2 + col] * y2;
            }
            const float sg = uv[1] * __builtin_amdgcn_rcpf(1.0f + __builtin_amdgcn_exp2f(-uv[1] * LOG2E));
            a[(size_t)(pm * BM + which * 255) * FF + j] = f2bf(sg * uv[0]);
        }
        asm volatile("s_waitcnt vmcnt(0)" ::: "memory");
        __builtin_amdgcn_s_barrier();
        asm volatile("" ::: "memory");
    }
    __device__ __forceinline__ void done(const Unit&) const {}
};

struct EpiIn {
    static constexpr bool PERM = true, AFTER_DRAIN = false;
    __device__ static constexpr bool zero_after(const Unit&) { return true; }
    bf16_t* zg; const float* ss; const float *qn_a, *kn_a, *qn_b, *kn_b, *bg;
    __device__ __forceinline__ void operator()(f32x4 (&acc)[2][2][4][2], const Unit& u, int wr, int wc, int fr, int fq, PG8_LAS unsigned char*) const {
        const int g = u.pn * 4 + wc, colb = u.pn * BM + wc * 64 + 8 * fq;
        const float* gain = nullptr; float sc = 1.f; int mode = 0;
        if (g < 8) { gain = qn_a; sc = C2; mode = 1; } else if (g < 10) { gain = kn_a; mode = 1; } else if (g < 12) { mode = 0; } else if (g < 20) { gain = qn_b; sc = C2; mode = 1; }
        else if (g < 28) { gain = kn_b; mode = 1; } else if (g < 36) { mode = 0; } else { mode = 2; }
        f32x4 gv[2][2];
#pragma unroll
        for (int bj = 0; bj < 2; ++bj)
#pragma unroll
            for (int n = 0; n < 2; ++n) {
                if (mode == 1) gv[bj][n] = *(const f32x4*)(gain + 32 * bj + 8 * fq + 4 * n) * sc;
                else if (mode == 2) gv[bj][n] = *(const f32x4*)(bg + (colb - C_G) + 32 * bj + 4 * n);
                else gv[bj][n] = (f32x4){1.f, 1.f, 1.f, 1.f};
            }
#pragma unroll
        for (int ai = 0; ai < 2; ++ai)
#pragma unroll
            for (int m = 0; m < 4; ++m) {
                const int row = u.pm * BM + ai * HALF + wr * 64 + m * 16 + fr;
                const float rs = rsqrtf(ss16(ss, row) * (1.0f / D) + EPS);
                f32x4 v[2][2];
#pragma unroll
                for (int bj = 0; bj < 2; ++bj)
#pragma unroll
                    for (int n = 0; n < 2; ++n) v[bj][n] = acc[ai][bj][m][n] * rs;
                if (mode == 1) {
                    float q = 0.f;
#pragma unroll
                    for (int bj = 0; bj < 2; ++bj)
#pragma unroll
                        for (int n = 0; n < 2; ++n) { const f32x4 x = v[bj][n]; q += (x[0] * x[0] + x[1] * x[1]) + (x[2] * x[2] + x[3] * x[3]); }
                    q += __shfl_xor(q, 16); q += __shfl_xor(q, 32);
                    const float r2 = rsqrtf(q * (1.0f / 64.0f) + EPS);
#pragma unroll
                    for (int bj = 0; bj < 2; ++bj)
#pragma unroll
                        for (int n = 0; n < 2; ++n) v[bj][n] = v[bj][n] * r2 * gv[bj][n];
                } else if (mode == 2) {
#pragma unroll
                    for (int bj = 0; bj < 2; ++bj)
#pragma unroll
                        for (int n = 0; n < 2; ++n) { f32x4 x = v[bj][n] + gv[bj][n];
#pragma unroll
                            for (int e = 0; e < 4; ++e) x[e] = __builtin_amdgcn_rcpf(1.0f + __builtin_amdgcn_exp2f(-x[e] * LOG2E));
                            v[bj][n] = x; }
                }
                bf16_t* rowp = zg + (size_t)row * ZG + colb;
#pragma unroll
                for (int bj = 0; bj < 2; ++bj) { u32x4 w; w.x = cvt_pk_bf16(v[bj][0][0], v[bj][0][1]); w.y = cvt_pk_bf16(v[bj][0][2], v[bj][0][3]); w.z = cvt_pk_bf16(v[bj][1][0], v[bj][1][1]); w.w = cvt_pk_bf16(v[bj][1][2], v[bj][1][3]);
                    *(u32x4*)(rowp + 32 * bj) = w; }
            }
    }
};
struct EpiMix {
    static constexpr bool PERM = true, AFTER_DRAIN = false;
    __device__ static bool zero_after(const Unit& u) { return u.z != 0; }
    const bf16_t* zg; bf16_t* mix;
    __device__ __forceinline__ void operator()(f32x4 (&acc)[2][2][4][2], const Unit& u, int wr, int wc, int fr, int fq, PG8_LAS unsigned char*) const {
        const int col0 = u.pn * BM + wc * 32 + 8 * fq;
#pragma unroll
        for (int ai = 0; ai < 2; ++ai)
#pragma unroll
            for (int m = 0; m < 4; ++m) {
                const int row = u.pm * BM + ai * HALF + wr * 64 + m * 16 + fr;
#pragma unroll
                for (int bj = 0; bj < 2; ++bj) {
                    const int col = col0 + bj * HALF;
                    const u32x4 gb = *(const u32x4*)(zg + (size_t)row * ZG + C_G + D + col);
                    if (u.z == 0) {
                        const u32x4 ga = *(const u32x4*)(zg + (size_t)row * ZG + C_G + col);
                        f32x4 r0, r1;
                        r0[0] = bflo(ga.x) * __builtin_amdgcn_rcpf(bflo(gb.x)); r0[1] = bfhi(ga.x) * __builtin_amdgcn_rcpf(bfhi(gb.x)); r0[2] = bflo(ga.y) * __builtin_amdgcn_rcpf(bflo(gb.y)); r0[3] = bfhi(ga.y) * __builtin_amdgcn_rcpf(bfhi(gb.y));
                        r1[0] = bflo(ga.z) * __builtin_amdgcn_rcpf(bflo(gb.z)); r1[1] = bfhi(ga.z) * __builtin_amdgcn_rcpf(bfhi(gb.z)); r1[2] = bflo(ga.w) * __builtin_amdgcn_rcpf(bflo(gb.w)); r1[3] = bfhi(ga.w) * __builtin_amdgcn_rcpf(bfhi(gb.w));
                        acc[ai][bj][m][0] *= r0; acc[ai][bj][m][1] *= r1;
                    } else {
                        const f32x4 v0 = acc[ai][bj][m][0] * (f32x4){bflo(gb.x), bfhi(gb.x), bflo(gb.y), bfhi(gb.y)}, v1 = acc[ai][bj][m][1] * (f32x4){bflo(gb.z), bfhi(gb.z), bflo(gb.w), bfhi(gb.w)};
                        u32x4 w; w.x = cvt_pk_bf16(v0[0], v0[1]); w.y = cvt_pk_bf16(v0[2], v0[3]); w.z = cvt_pk_bf16(v1[0], v1[1]); w.w = cvt_pk_bf16(v1[2], v1[3]);
                        *(u32x4*)(mix + (size_t)row * D + col) = w;
                    }
                }
            }
    }
};
struct EpiRes {
    static constexpr bool PERM = false, AFTER_DRAIN = false;
    __device__ static constexpr bool zero_after(const Unit&) { return true; }
    const float* base; float* xf; bf16_t* xb; float* ssn;
    __device__ __forceinline__ void operator()(f32x4 (&acc)[2][2][4][2], const Unit& u, int wr, int wc, int fr, int fq, PG8_LAS unsigned char*) const {
        const int col0 = u.pn * BM + wc * 32 + 4 * fq;
#pragma unroll
        for (int ai = 0; ai < 2; ++ai)
#pragma unroll
            for (int m = 0; m < 4; ++m) {
                const int row = u.pm * BM + ai * HALF + wr * 64 + m * 16 + fr; const size_t off = (size_t)row * D + col0; float q = 0.f;
#pragma unroll
                for (int bj = 0; bj < 2; ++bj)
#pragma unroll
                    for (int n = 0; n < 2; ++n) { const f32x4 bs = *(const f32x4*)(base + off + bj * HALF + n * 16); const f32x4 o = bs + acc[ai][bj][m][n];
                        *(f32x4*)(xf + off + bj * HALF + n * 16) = o; q += (o[0] * o[0] + o[1] * o[1]) + (o[2] * o[2] + o[3] * o[3]);
                        if (xb) { u32x2 w; w.x = cvt_pk_bf16(o[0], o[1]); w.y = cvt_pk_bf16(o[2], o[3]); *(u32x2*)(xb + off + bj * HALF + n * 16) = w; } }
                if (ssn) { q += __shfl_xor(q, 16); q += __shfl_xor(q, 32); if (fq == 0) ssn[(size_t)row * 16 + u.pn * 4 + wc] = q; }
                if (m & 1) asm volatile("" ::: "memory");
            }
    }
};
#define DPPF(oldv, src, ctrl, bc) __int_as_float(__builtin_amdgcn_update_dpp(__float_as_int(oldv), __float_as_int(src), (ctrl), 0xF, 0xF, (bc)))
struct EpiUp {
    static constexpr bool PERM = true, AFTER_DRAIN = false;
    __device__ static constexpr bool zero_after(const Unit&) { return true; }
    bf16_t* a; const float* ss; const float* cw; const float* cb; float* yb;
    __device__ __forceinline__ void operator()(f32x4 (&acc)[2][2][4][2], const Unit& u, int wr, int wc, int fr, int fq, PG8_LAS unsigned char* lds) const {
        const int wid = wr * 4 + wc;
        PG8_LAS float* X = (PG8_LAS float*)(lds + XOFF);
#pragma unroll
        for (int ai = 0; ai < 2; ++ai)
#pragma unroll
            for (int m = 0; m < 4; ++m) {
                const int row = u.pm * BM + ai * HALF + wr * 64 + m * 16 + fr;
                const float rs = rsqrtf(ss16(ss, row) * (1.0f / D) + EPS);
#pragma unroll
                for (int bj = 0; bj < 2; ++bj)
#pragma unroll
                    for (int n = 0; n < 2; ++n) acc[ai][bj][m][n] *= rs;
            }
#pragma unroll
        for (int ai = 0; ai < 2; ++ai) {
            if (fr == 0) {
#pragma unroll
                for (int bj = 0; bj < 2; ++bj)
#pragma unroll
                    for (int n = 0; n < 2; ++n) *(PG8_LAS f32x4*)(X + ((wid * 2 + ai) * 2 + 0) * 64 + 32 * bj + 8 * fq + 4 * n) = acc[ai][bj][0][n];
            }
            if (fr == 15) {
#pragma unroll
                for (int bj = 0; bj < 2; ++bj)
#pragma unroll
                    for (int n = 0; n < 2; ++n) *(PG8_LAS f32x4*)(X + ((wid * 2 + ai) * 2 + 1) * 64 + 32 * bj + 8 * fq + 4 * n) = acc[ai][bj][3][n];
            }
        }
        {
            const int ccol = u.pn * 128 + wc * 32 + 8 * fq;
            if (wr == 0 && fr < 2) {
#pragma unroll
                for (int bj = 0; bj < 2; ++bj)
#pragma unroll
                    for (int n = 0; n < 2; ++n) *(f32x4*)(yb + ((size_t)u.pm * 4 + fr) * FF2 + bj * FF + ccol + 4 * n) = acc[0][bj][0][n];
            }
            if (wr == 1 && fr >= 14) {
#pragma unroll
                for (int bj = 0; bj < 2; ++bj)
#pragma unroll
                    for (int n = 0; n < 2; ++n) *(f32x4*)(yb + ((size_t)u.pm * 4 + 2 + (fr - 14)) * FF2 + bj * FF + ccol + 4 * n) = acc[1][bj][3][n];
            }
        }
        asm volatile("s_waitcnt lgkmcnt(0)" ::: "memory"); __builtin_amdgcn_s_barrier(); asm volatile("" ::: "memory");
#pragma unroll
        for (int n = 0; n < 2; ++n) {
            const int ccol = u.pn * 128 + wc * 32 + 8 * fq + 4 * n;
            f32x4 w0[2], w1[2], w2[2], bb[2];
#pragma unroll
            for (int bj = 0; bj < 2; ++bj) { w0[bj] = *(const f32x4*)(cw + bj * FF + ccol); w1[bj] = *(const f32x4*)(cw + FF2 + bj * FF + ccol); w2[bj] = *(const f32x4*)(cw + 2 * FF2 + bj * FF + ccol); bb[bj] = *(const f32x4*)(cb + bj * FF + ccol); }
#pragma unroll
            for (int ai = 0; ai < 2; ++ai) {
                const int pw = wr ? wid - 4 : wid + 4, pai = wr ? ai : 0;
                const int nw = wr ? wid - 4 : wid + 4, nai = wr ? 1 : ai;
                f32x4 xp[2], xn[2];
#pragma unroll
                for (int bj = 0; bj < 2; ++bj) { xp[bj] = *(PG8_LAS f32x4*)(X + ((pw * 2 + pai) * 2 + 1) * 64 + 32 * bj + 8 * fq + 4 * n); xn[bj] = *(PG8_LAS f32x4*)(X + ((nw * 2 + nai) * 2 + 0) * 64 + 32 * bj + 8 * fq + 4 * n); }
#pragma unroll
                for (int m = 0; m < 4; ++m) {
                    const int trow = ai * HALF + wr * 64 + m * 16 + fr;
                    float uv[2][4];
#pragma unroll
                    for (int bj = 0; bj < 2; ++bj)
#pragma unroll
                        for (int e = 0; e < 4; ++e) {
                            const float cur = acc[ai][bj][m][n][e];
                            float rp, rn;
                            if (m > 0) rp = DPPF(0.f, acc[ai][bj][m > 0 ? m - 1 : 0][n][e], 0x121, true); else rp = xp[bj][e];
                            if (m < 3) rn = DPPF(0.f, acc[ai][bj][m < 3 ? m + 1 : 3][n][e], 0x12F, true); else rn = xn[bj][e];
                            const float prev = DPPF(rp, cur, 0x111, false), next = DPPF(rn, cur, 0x101, false);
                            uv[bj][e] = bb[bj][e] + w0[bj][e] * prev + w1[bj][e] * cur + w2[bj][e] * next;
                        }
                    f32x4 o;
#pragma unroll
                    for (int e = 0; e < 4; ++e) o[e] = uv[0][e] * uv[1][e] * __builtin_amdgcn_rcpf(1.0f + __builtin_amdgcn_exp2f(-uv[1][e] * LOG2E));
                    u32x2 w; w.x = cvt_pk_bf16(o[0], o[1]); w.y = cvt_pk_bf16(o[2], o[3]);
                    if (trow != 0 && trow != 255) *(u32x2*)(a + (size_t)(u.pm * BM + trow) * FF + ccol) = w;
                    asm volatile("" ::: "memory");
                }
            }
        }
    }
};

template <class Epi, class Sched, bool ALIGN_EPI = false, bool SP2 = false>
__device__ __forceinline__ void gemm_phase(PG8_LAS unsigned char* lds, const int K, const int lda, const Sched& S, const Epi& E) {
    int tid_ = threadIdx.x; asm volatile("" : "+v"(tid_));
    const int tid = tid_, wid = __builtin_amdgcn_readfirstlane(tid >> 6), lane = tid & 63, wr = wid >> 2, wc = wid & 3, fr = lane & 15, fq = lane >> 4;
    const int nt = K / BK;
    unsigned voffA[2], voffB[2];
#pragma unroll
    for (int i = 0; i < 2; ++i) { int R, C; stage_rc(tid * 16 + i * 8192, R, C); const int Rb = Epi::PERM ? ((R & ~31) + perm32(R & 31)) : R;
        voffA[i] = (unsigned)(R * lda + C) * 2u; voffB[i] = (unsigned)(Rb * K + C) * 2u; }
    const size_t kstep = (size_t)(BK * 2);
    const size_t hstepB = (size_t)HALF * K * 2;
    const size_t hstepA = (size_t)HALF * lda * 2;
    const unsigned ldsw = (unsigned)wid * 1024u;
    const int aoff = lds_byte(wr * 64 + fr, fq * 8), boff = lds_byte(wc * 32 + fr, fq * 8);
#define PG8_SA(b, h) (((b) * 2 + (h)) * HTB)
#define PG8_SB(b, h) ((4 + (b) * 2 + (h)) * HTB)
#define PG8_STAGE(bufoff, gbase, voff) do { _Pragma("unroll") for (int _i = 0; _i < 2; ++_i) \
        __builtin_amdgcn_global_load_lds((const unsigned*)((const char*)(gbase) + (voff)[_i]), (PG8_LAS unsigned*)(lds + (bufoff) + ldsw + _i * 8192), 16, 0, 0); } while (0)
#define PG8_LDA(dst, b, h) do { _Pragma("unroll") for (int m = 0; m < 4; ++m) _Pragma("unroll") for (int k = 0; k < 2; ++k) dst[m][k] = *(const PG8_LAS bf16x8*)(lds + PG8_SA(b, h) + aoff + m * 2048 + k * 1024); } while (0)
#define PG8_LDB(dst, b, h) do { _Pragma("unroll") for (int n = 0; n < 2; ++n) _Pragma("unroll") for (int k = 0; k < 2; ++k) dst[n][k] = *(const PG8_LAS bf16x8*)(lds + PG8_SB(b, h) + boff + n * 2048 + k * 1024); } while (0)
#define PG8_MMA(ai, bj, At, Bt) do { __builtin_amdgcn_s_setprio(1); _Pragma("unroll") for (int m = 0; m < 4; ++m) _Pragma("unroll") for (int n = 0; n < 2; ++n) _Pragma("unroll") for (int k = 0; k < 2; ++k) \
        acc[ai][bj][m][n] = __builtin_amdgcn_mfma_f32_16x16x32_bf16(Bt[n][k], At[m][k], acc[ai][bj][m][n], 0, 0, 0); __builtin_amdgcn_s_setprio(0); } while (0)
#define PG8_WAIT_V(n) asm volatile("s_waitcnt vmcnt(" #n ")" ::: "memory")
#define PG8_WAIT_L(n) asm volatile("s_waitcnt lgkmcnt(" #n ")" ::: "memory")
#define PG8_BAR __builtin_amdgcn_s_barrier()
#define PG8_SCHED __builtin_amdgcn_sched_barrier(0)
    Unit cur, nxt; int ui = 0;
    if (!S.next(0, cur)) return;
    f32x4 acc[2][2][4][2];
#pragma unroll
    for (int a = 0; a < 2; ++a)
#pragma unroll
        for (int b = 0; b < 2; ++b)
#pragma unroll
            for (int m = 0; m < 4; ++m)
#pragma unroll
                for (int n = 0; n < 2; ++n) acc[a][b][m][n] = (f32x4){0.f, 0.f, 0.f, 0.f};
    bf16x8 At[4][2], B0[2][2], B1[2][2];
    const char* cA = S.aptr(cur); const char* cB = S.bptr(cur);
    S.a_ready(cur);
    if constexpr (SP2) {
        PG8_STAGE(PG8_SB(0, 0), cB, voffB); PG8_STAGE(PG8_SB(0, 1), cB + hstepB, voffB); PG8_STAGE(PG8_SA(0, 0), cA, voffA); PG8_STAGE(PG8_SA(0, 1), cA + hstepA, voffA);
        if (wr == 1) PG8_BAR;
        PG8_WAIT_V(2); PG8_BAR;
        PG8_STAGE(PG8_SB(1, 0), cB + kstep, voffB); PG8_STAGE(PG8_SA(1, 0), cA + kstep, voffA); PG8_STAGE(PG8_SB(1, 1), cB + hstepB + kstep, voffB);
        PG8_WAIT_V(6); PG8_BAR;
    } else {
        PG8_STAGE(PG8_SB(0, 0), cB, voffB); PG8_STAGE(PG8_SA(0, 0), cA, voffA); PG8_STAGE(PG8_SB(0, 1), cB + hstepB, voffB); PG8_STAGE(PG8_SA(0, 1), cA + hstepA, voffA);
        if (wr == 1) PG8_BAR;
        PG8_WAIT_V(4); PG8_BAR;
        PG8_STAGE(PG8_SB(1, 0), cB + kstep, voffB); PG8_STAGE(PG8_SA(1, 0), cA + kstep, voffA); PG8_STAGE(PG8_SB(1, 1), cB + hstepB + kstep, voffB);
        PG8_WAIT_V(6); PG8_BAR;
    }
    for (;;) {
        const bool has_next = S.next(ui + 1, nxt);
        const char* nA = has_next ? S.aptr(nxt) : cA; const char* nB = has_next ? S.bptr(nxt) : cB;
        for (int t = 0; t < nt; t += 2) {
            const bool last = (t == nt - 2);
            const char* a1 = cA + (size_t)(t + 1) * kstep;
            const char* a2 = last ? nA : cA + (size_t)(t + 2) * kstep; const char* b2 = last ? nB : cB + (size_t)(t + 2) * kstep;
            const char* a3 = a2 + kstep; const char* b3 = b2 + kstep;
            if (last && has_next) S.a_ready(nxt);
            if constexpr (SP2) {
            PG8_LDB(B0, 0, 0); PG8_LDB(B1, 0, 1); PG8_SCHED; PG8_LDA(At, 0, 0); PG8_STAGE(PG8_SA(1, 1), a1 + hstepA, voffA);
            PG8_WAIT_V(8); PG8_WAIT_L(0); PG8_BAR; PG8_MMA(0, 0, At, B0); PG8_MMA(0, 1, At, B1); PG8_BAR; PG8_SCHED;
            PG8_LDA(At, 0, 1); PG8_STAGE(PG8_SB(0, 0), b2, voffB); PG8_STAGE(PG8_SB(0, 1), b2 + hstepB, voffB); PG8_STAGE(PG8_SA(0, 0), a2, voffA);
            PG8_WAIT_V(8); PG8_WAIT_L(0); PG8_BAR; PG8_MMA(1, 0, At, B0); PG8_MMA(1, 1, At, B1); PG8_BAR; PG8_SCHED;
            PG8_LDB(B0, 1, 0); PG8_LDB(B1, 1, 1); PG8_SCHED; PG8_LDA(At, 1, 0); PG8_STAGE(PG8_SA(0, 1), a2 + hstepA, voffA);
            PG8_WAIT_V(8); PG8_WAIT_L(0); PG8_BAR; PG8_MMA(0, 0, At, B0); PG8_MMA(0, 1, At, B1); PG8_BAR; PG8_SCHED;
            PG8_LDA(At, 1, 1); PG8_STAGE(PG8_SB(1, 0), b3, voffB); PG8_STAGE(PG8_SB(1, 1), b3 + hstepB, voffB); PG8_STAGE(PG8_SA(1, 0), a3, voffA);
            PG8_WAIT_V(8); PG8_WAIT_L(0); PG8_BAR; PG8_MMA(1, 0, At, B0); PG8_MMA(1, 1, At, B1); PG8_BAR; PG8_SCHED;
            } else {
            PG8_LDB(B0, 0, 0); PG8_SCHED; PG8_LDA(At, 0, 0); PG8_STAGE(PG8_SA(1, 1), a1 + hstepA, voffA);
            PG8_WAIT_L(8); PG8_BAR; PG8_WAIT_L(0); PG8_MMA(0, 0, At, B0); PG8_BAR; PG8_SCHED;
            PG8_LDB(B1, 0, 1); PG8_STAGE(PG8_SB(0, 0), b2, voffB);
            PG8_BAR; PG8_WAIT_L(0); PG8_MMA(0, 1, At, B1); PG8_BAR;
            PG8_LDA(At, 0, 1); PG8_STAGE(PG8_SA(0, 0), a2, voffA);
            PG8_BAR; PG8_WAIT_L(0); PG8_MMA(1, 0, At, B0); PG8_BAR; PG8_SCHED;
            PG8_STAGE(PG8_SB(0, 1), b2 + hstepB, voffB);
            PG8_WAIT_V(6); PG8_BAR; PG8_MMA(1, 1, At, B1); PG8_BAR;
            PG8_LDB(B0, 1, 0); PG8_SCHED; PG8_LDA(At, 1, 0); PG8_STAGE(PG8_SA(0, 1), a2 + hstepA, voffA);
            PG8_WAIT_L(8); PG8_BAR; PG8_WAIT_L(0); PG8_MMA(0, 0, At, B0); PG8_BAR; PG8_SCHED;
            PG8_LDB(B1, 1, 1); PG8_STAGE(PG8_SB(1, 0), b3, voffB);
            PG8_BAR; PG8_WAIT_L(0); PG8_MMA(0, 1, At, B1); PG8_BAR;
            PG8_LDA(At, 1, 1); PG8_STAGE(PG8_SA(1, 0), a3, voffA);
            PG8_BAR; PG8_WAIT_L(0); PG8_MMA(1, 0, At, B0); PG8_BAR; PG8_SCHED;
            PG8_STAGE(PG8_SB(1, 1), b3 + hstepB, voffB);
            PG8_WAIT_V(6); PG8_BAR; PG8_MMA(1, 1, At, B1); PG8_BAR;
            }
        }
        if constexpr (ALIGN_EPI) { if (wr == 0) PG8_BAR; }
        if constexpr (!Epi::AFTER_DRAIN) { E(acc, cur, wr, wc, fr, fq, lds); S.done(cur); }
        if (!has_next) break;
        if (Epi::zero_after(cur)) {
#pragma unroll
        for (int a = 0; a < 2; ++a)
#pragma unroll
            for (int b = 0; b < 2; ++b)
#pragma unroll
                for (int m = 0; m < 4; ++m)
#pragma unroll
                    for (int n = 0; n < 2; ++n) acc[a][b][m][n] = (f32x4){0.f, 0.f, 0.f, 0.f};
        }
        cur = nxt; cA = nA; cB = nB; ++ui;
        if constexpr (ALIGN_EPI) { if (wr == 1) PG8_BAR; }
    }
    PG8_WAIT_V(0);
    if constexpr (!ALIGN_EPI) { if (wr == 0) PG8_BAR; }
    PG8_BAR;
    if constexpr (Epi::AFTER_DRAIN) { E.fused(acc, cur, wr, wc, fr, fq, lds, wid, lane); S.done(cur); }
#undef PG8_SA
#undef PG8_SB
#undef PG8_STAGE
#undef PG8_LDA
#undef PG8_LDB
#undef PG8_MMA
#undef PG8_WAIT_V
#undef PG8_WAIT_L
#undef PG8_BAR
#undef PG8_SCHED
}
}

namespace att {
using namespace nv;
#define ALAS __attribute__((address_space(3)))
typedef short bf16x8 __attribute__((ext_vector_type(8)));
typedef short s16x4 __attribute__((ext_vector_type(4)));
typedef float f32x16 __attribute__((ext_vector_type(16)));
typedef float f32x4 __attribute__((ext_vector_type(4)));
typedef unsigned u32x4 __attribute__((ext_vector_type(4)));
typedef unsigned u32x2 __attribute__((ext_vector_type(2)));
typedef short v4i16_t __attribute__((ext_vector_type(4)));
typedef float f32x2_t __attribute__((ext_vector_type(2))); typedef __bf16 bf16x2_t __attribute__((ext_vector_type(2)));
constexpr int BUF_B = 32768, BUF_A = 16384;
constexpr int LUT_OFF = 65536, LUT_STRIDE = 520, GT_OFF = LUT_OFF + 4 * LUT_STRIDE * 4;
constexpr float NEG = -30000.f, THR = 6.f;
__device__ __forceinline__ unsigned cvtpk(float lo, float hi) { f32x2_t v = {lo, hi}; bf16x2_t b = __builtin_convertvector(v, bf16x2_t); return __builtin_bit_cast(unsigned, b); }
__device__ __forceinline__ s16x4 vtr(ALAS const unsigned char* p) { return __builtin_bit_cast(s16x4, __builtin_amdgcn_ds_read_tr16_b64_v4i16((ALAS v4i16_t*)p)); }
__device__ __forceinline__ float swap_add(float v) { auto rr = __builtin_amdgcn_permlane32_swap(__float_as_uint(v), __float_as_uint(v), false, false); return __uint_as_float(rr[0]) + __uint_as_float(rr[1]); }
__device__ __forceinline__ float swap_max(float v) { auto rr = __builtin_amdgcn_permlane32_swap(__float_as_uint(v), __float_as_uint(v), false, false); return fmaxf(__uint_as_float(rr[0]), __uint_as_float(rr[1])); }
#define MX3(a, b, c) __builtin_fmaxf(__builtin_fmaxf((a), (b)), (c))

template <bool ISB>
__device__ __forceinline__ void attn_unit(ALAS unsigned char* lds, bf16* zg, const float* __restrict__ rel_bias, int b, int hsel, int q0, const float* __restrict__ sinkp, float lam, float osc, const float* __restrict__ subg) {
    int tid_ = threadIdx.x; asm volatile("" : "+v"(tid_));
    const int tid = tid_, lane = tid & 63, r32 = lane & 31, hi = lane >> 5; const int wid = __builtin_amdgcn_readfirstlane(tid >> 6);
    constexpr int NDV = ISB ? 4 : 2, BUF = ISB ? BUF_B : BUF_A, VOFF = ISB ? 16384 : 8192;
    const int map = ISB ? (wid >> 2) : 0, qsub = ISB ? (wid & 3) : (wid & 1), gsel = ISB ? 0 : (wid >> 1);
    const int head = ISB ? hsel : hsel * 4 + gsel;
    const int qrow0 = q0 + 32 * qsub;
    const int qcol = ISB ? (C_QB + head * 128 + map * 64) : (C_QA + head * 64);
    const int kcol = ISB ? (C_KB + head * 128) : (C_KA + hsel * 64);
    const int vcol = ISB ? (C_VB + head * 128) : (C_VA + hsel * 64);
    const size_t rowbase = (size_t)b * S;
    int kt0 = 0, kt1 = S / 64;
    if (!ISB) { kt0 = q0 / 64 - 2; if (kt0 < 0) kt0 = 0; kt1 = q0 / 64 + 3; if (kt1 > S / 64) kt1 = S / 64; }
    ALAS float* lut = (ALAS float*)(lds + LUT_OFF);
    ALAS float* gt = (ALAS float*)(lds + GT_OFF);
    if (ISB) {
        for (int i = tid; i < 513; i += 512) { const int rel = i - 256; lut[i] = rel_bias[t5_bucket(rel) * 12 + 8 + head] * LOG2E; }
        if (tid < 128) gt[tid] = subg[tid] * osc;
    } else {
        for (int i = tid; i < 4 * 513; i += 512) { const int g = i / 513, j = i - g * 513, rel = j - 256; const int ar = rel < 0 ? -rel : rel;
            lut[g * LUT_STRIDE + j] = ar <= 128 ? rel_bias[t5_bucket(rel) * 12 + hsel * 4 + g] * LOG2E : NEG; }
    }
    bf16x8 qr[4];
    { const bf16* qp = zg + (rowbase + qrow0 + r32) * ZG + qcol + hi * 8;
#pragma unroll
      for (int d0 = 0; d0 < 4; ++d0) qr[d0] = *(const bf16x8*)(qp + d0 * 16); }
#define ATT_ISSUE(t, bo) do { const size_t kr_ = rowbase + (size_t)(t) * 64; \
        if (ISB) { _Pragma("unroll") for (int i_ = 0; i_ < 2; ++i_) { const int p_ = wid * 2 + i_; \
            __builtin_amdgcn_global_load_lds((const unsigned*)(zg + (kr_ + lane) * ZG + kcol + (p_ >> 3) * 64 + (p_ & 7) * 8), (ALAS unsigned*)(lds + (bo) + p_ * 1024), 16, 0, 0); \
            __builtin_amdgcn_global_load_lds((const unsigned*)(zg + (kr_ + 16 * (p_ & 3) + (lane >> 2)) * ZG + vcol + 32 * (p_ >> 2) + 8 * (lane & 3)), (ALAS unsigned*)(lds + (bo) + VOFF + p_ * 1024), 16, 0, 0); } } \
        else { \
            __builtin_amdgcn_global_load_lds((const unsigned*)(zg + (kr_ + lane) * ZG + kcol + wid * 8), (ALAS unsigned*)(lds + (bo) + wid * 1024), 16, 0, 0); \
            __builtin_amdgcn_global_load_lds((const unsigned*)(zg + (kr_ + 16 * (wid & 3) + (lane >> 2)) * ZG + vcol + 32 * (wid >> 2) + 8 * (lane & 3)), (ALAS unsigned*)(lds + (bo) + VOFF + wid * 1024), 16, 0, 0); } } while (0)
    float mhat = 0.f, l = 0.f;
    f32x16 o[NDV];
#pragma unroll
    for (int d = 0; d < NDV; ++d)
#pragma unroll
        for (int r = 0; r < 16; ++r) o[d][r] = 0.f;
    const int kfo = (ISB ? map * 8192 : 0) + hi * 1024 + r32 * 16;
    const int vfo = VOFF + ((lane >> 4) & 1) * 32 + (lane & 3) * 8 + (4 * hi + ((lane & 15) >> 2)) * 64;
    ATT_ISSUE(kt0, 0);
#pragma unroll 1
    for (int t = kt0; t < kt1; ++t) {
        const int bo = ((t - kt0) & 1) * BUF;
        asm volatile("s_waitcnt vmcnt(0)" ::: "memory");
        __syncthreads();
        if (t + 1 < kt1) ATT_ISSUE(t + 1, bo ^ BUF);
        const int kb = t * 64;
        bool near = true; float cfar = 0.f;
        if (ISB) { if (kb - qrow0 - 31 >= 91) { near = false; cfar = lut[256 + 128]; } else if (kb + 63 - qrow0 <= -91) { near = false; cfar = lut[256 - 128]; } }
        const float c0 = cfar - mhat;
        f32x16 p0, p1;
#pragma unroll
        for (int r = 0; r < 16; ++r) { p0[r] = c0; p1[r] = c0; }
        {
            ALAS const unsigned char* kp = lds + bo + kfo;
#pragma unroll
            for (int d0 = 0; d0 < 4; ++d0) {
                const bf16x8 k0 = *(ALAS const bf16x8*)(kp + d0 * 2048), k1 = *(ALAS const bf16x8*)(kp + d0 * 2048 + 512);
                p0 = __builtin_amdgcn_mfma_f32_32x32x16_bf16(k0, qr[d0], p0, 0, 0, 0);
                p1 = __builtin_amdgcn_mfma_f32_32x32x16_bf16(k1, qr[d0], p1, 0, 0, 0);
            }
        }
        if (near) {
            ALAS const float* lp = lut + gsel * LUT_STRIDE + (kb - (qrow0 + r32) + 256 + 4 * hi);
#pragma unroll
            for (int r = 0; r < 16; ++r) { p0[r] += lp[(r & 3) + 8 * (r >> 2)]; p1[r] += lp[32 + (r & 3) + 8 * (r >> 2)]; }
        }
        float rm;
        { float a = MX3(p0[0], p0[1], p1[0]), c = MX3(p0[2], p0[3], p1[1]); a = MX3(a, p1[2], p1[3]);
#pragma unroll
          for (int r = 4; r < 16; r += 4) { a = MX3(a, p0[r], p0[r + 1]); c = MX3(c, p0[r + 2], p0[r + 3]); a = MX3(a, p1[r], p1[r + 1]); c = MX3(c, p1[r + 2], p1[r + 3]); }
          rm = swap_max(__builtin_fmaxf(a, c)); }
        const bool first = (t == kt0);
        if (first || __any(rm > THR)) {
            const float dl = first ? rm : __builtin_fmaxf(rm, 0.f);
            mhat += dl;
#pragma unroll
            for (int r = 0; r < 16; ++r) { p0[r] -= dl; p1[r] -= dl; }
            if (!first) { const float f = __builtin_amdgcn_exp2f(-dl); l *= f;
#pragma unroll
                for (int d = 0; d < NDV; ++d)
#pragma unroll
                    for (int r = 0; r < 16; ++r) o[d][r] *= f; }
        }
        float sacc = 0.f;
#pragma unroll
        for (int r = 0; r < 16; ++r) { p0[r] = __builtin_amdgcn_exp2f(p0[r]); p1[r] = __builtin_amdgcn_exp2f(p1[r]); sacc += p0[r] + p1[r]; }
        l += sacc;
        u32x4 pw[4];
        pw[0] = (u32x4){cvtpk(p0[0], p0[1]), cvtpk(p0[2], p0[3]), cvtpk(p0[4], p0[5]), cvtpk(p0[6], p0[7])};
        pw[1] = (u32x4){cvtpk(p0[8], p0[9]), cvtpk(p0[10], p0[11]), cvtpk(p0[12], p0[13]), cvtpk(p0[14], p0[15])};
        pw[2] = (u32x4){cvtpk(p1[0], p1[1]), cvtpk(p1[2], p1[3]), cvtpk(p1[4], p1[5]), cvtpk(p1[6], p1[7])};
        pw[3] = (u32x4){cvtpk(p1[8], p1[9]), cvtpk(p1[10], p1[11]), cvtpk(p1[12], p1[13]), cvtpk(p1[14], p1[15])};
        {
            ALAS const unsigned char* vp = lds + bo + vfo;
#pragma unroll
            for (int d = 0; d < NDV; ++d)
#pragma unroll
                for (int ks = 0; ks < 4; ++ks) {
                    const s16x4 lo = vtr(vp + d * 4096 + ks * 1024), hh = vtr(vp + d * 4096 + ks * 1024 + 512);
                    const bf16x8 vf = (bf16x8){lo[0], lo[1], lo[2], lo[3], hh[0], hh[1], hh[2], hh[3]};
                    o[d] = __builtin_amdgcn_mfma_f32_32x32x16_bf16(vf, __builtin_bit_cast(bf16x8, pw[ks]), o[d], 0, 0, 0);
                }
        }
    }
#undef ATT_ISSUE
    l = swap_add(l);
    if (!ISB) l += __builtin_amdgcn_exp2f(sinkp[head] * LOG2E - mhat);
    const float inv = 1.0f / l;
    bf16* orow = zg + (rowbase + qrow0 + r32) * ZG + (ISB ? (C_QB + head * 128) : (C_QA + head * 64));
    if (ISB) {
        __syncthreads();
        ALAS float* cs = (ALAS float*)lds;
        if (map == 1) { const float sc = -lam * inv;
#pragma unroll
            for (int d = 0; d < NDV; ++d)
#pragma unroll
                for (int r = 0; r < 16; ++r) cs[(qsub * 64 + d * 16 + r) * 64 + lane] = o[d][r] * sc; }
        __syncthreads();
        if (map == 0) {
            float q = 0.f;
#pragma unroll
            for (int d = 0; d < NDV; ++d)
#pragma unroll
                for (int r = 0; r < 16; ++r) { const float v = o[d][r] * inv + cs[(qsub * 64 + d * 16 + r) * 64 + lane]; o[d][r] = v; q += v * v; }
            q = swap_add(q);
            const float rstd = rsqrtf(q * (1.0f / 128.0f) + EPS);
#pragma unroll
            for (int d = 0; d < NDV; ++d)
#pragma unroll
                for (int g4 = 0; g4 < 4; ++g4) { const int dv0 = 32 * d + 8 * g4 + 4 * hi; const f32x4 gv = *(ALAS const f32x4*)(gt + dv0);
                    u32x2 w; w.x = cvtpk(o[d][4 * g4] * rstd * gv[0], o[d][4 * g4 + 1] * rstd * gv[1]); w.y = cvtpk(o[d][4 * g4 + 2] * rstd * gv[2], o[d][4 * g4 + 3] * rstd * gv[3]);
                    *(u32x2*)(orow + dv0) = w; }
        }
    } else {
#pragma unroll
        for (int d = 0; d < NDV; ++d)
#pragma unroll
            for (int g4 = 0; g4 < 4; ++g4) { const int dv0 = 32 * d + 8 * g4 + 4 * hi;
                u32x2 w; w.x = cvtpk(o[d][4 * g4] * inv, o[d][4 * g4 + 1] * inv); w.y = cvtpk(o[d][4 * g4 + 2] * inv, o[d][4 * g4 + 3] * inv);
                *(u32x2*)(orow + dv0) = w; }
    }
    __syncthreads();
}
#undef MX3
}

namespace mk {
using namespace nv;
constexpr int NWAVES = 8;
constexpr size_t MiB = 1u << 20;
constexpr size_t WS_CTL = 0, CTL_ZERO_BYTES = 1 * MiB;
constexpr size_t WS_SS = 1 * MiB;
constexpr size_t WS_XB = 6 * MiB;
constexpr size_t WS_ZG = 38 * MiB;
constexpr size_t WS_A = 38 * MiB;
constexpr size_t WS_YB = 126 * MiB;
constexpr size_t WS_MIX = 174 * MiB;
constexpr size_t WS_W = 206 * MiB;
constexpr size_t WL_IN = 0, WL_A = (size_t)ZG * D, WL_B = WL_A + (size_t)D * 512, WL_O = WL_B + (size_t)D * 512, WL_UP = WL_O + (size_t)D * D, WL_DN = WL_UP + (size_t)FF2 * D, WL_END = WL_DN + (size_t)D * FF;
constexpr size_t WS_TMPA = 322 * MiB, WS_TMPB = 344 * MiB;
constexpr size_t WS_END = 352 * MiB;
static_assert(WS_W + 4 * WL_END * 2 <= WS_TMPA && WS_YB + (size_t)64 * 4 * FF2 * 4 <= WS_MIX && WS_A + (size_t)T * FF * 2 <= WS_YB, "d_ws map");
constexpr int CW_BAR = 4096;
constexpr int N_PHASES = 1 + 6 * L;
constexpr int RING_OFF = 0, RING_BYTES = 131072, LDSCTL_OFF = RING_BYTES, MISC_OFF = LDSCTL_OFF + 320;
constexpr int LDS_BYTES = 147456;
static_assert(pg8::XOFF + 8192 <= LDS_BYTES && MISC_OFF + 128 <= pg8::XOFF, "LDS map");

#define GAS __attribute__((address_space(1)))
#define LAS __attribute__((address_space(3)))
typedef unsigned v4u __attribute__((ext_vector_type(4)));
typedef float f32x4 __attribute__((ext_vector_type(4)));
typedef GAS unsigned gu32;
#define RLX_AGENT __ATOMIC_RELAXED, __HIP_MEMORY_SCOPE_AGENT
#define LDS_WAIT() asm volatile("s_waitcnt lgkmcnt(0)" ::: "memory")
#define VM_WAIT() asm volatile("s_waitcnt vmcnt(0)" ::: "memory")
__device__ __forceinline__ unsigned f2bfu(float f) { unsigned u = __builtin_bit_cast(unsigned, f); return (u + 0x7fffu + ((u >> 16) & 1u)) >> 16; }
__device__ __forceinline__ unsigned pk2(float lo, float hi) { return f2bfu(lo) | (f2bfu(hi) << 16); }

#define XB_TMO      128
#define XB_XCNT(j)  (256  + 64 * (j))
#define XB_XSUB(j)  (1280 + 64 * (j))
#define XB_XGEN(j)  (2304 + 64 * (j))
#define XB_TOP      3328
#define XB_TOPGEN   3392
#define XCD_BAR_WORDS 3456
#define XB_SPIN_CAP (1u << 18)

__device__ __forceinline__ unsigned xb_ld(unsigned* p)              { return __hip_atomic_load(p, __ATOMIC_RELAXED, __HIP_MEMORY_SCOPE_AGENT); }
__device__ __forceinline__ unsigned xb_add(unsigned* p, unsigned v) { return __hip_atomic_fetch_add(p, v, __ATOMIC_RELAXED, __HIP_MEMORY_SCOPE_AGENT); }
__device__ __forceinline__ unsigned xb_xcc_id() { return (unsigned)__builtin_amdgcn_s_getreg((3 << 11) | 20) & 0xFu; }
#define XB_SPIN(cond, bar) do { unsigned _sp = 0; while (cond) { __builtin_amdgcn_s_sleep(1); \
    if ((++_sp & 255u) == 0u) { if (xb_ld(&(bar)[XB_TMO])) break; if (_sp > XB_SPIN_CAP) { atomicAdd(&(bar)[XB_TMO], 1u); break; } } } } while (0)

struct XcdBarrier {
    unsigned* bar; unsigned x;
    volatile LAS unsigned* st;
};

__device__ __forceinline__ XcdBarrier xcd_barrier_post(unsigned* bar, volatile LAS unsigned* st) {
    XcdBarrier b; b.bar = bar; b.x = xb_xcc_id(); b.st = st;
    if (threadIdx.x == 0) (void)xb_add(&bar[XB_XCNT(b.x)], 1u);
    return b;
}
__device__ __forceinline__ void xcd_barrier_complete(unsigned* bar, unsigned x, unsigned& nloc, unsigned& nx) {
    const unsigned G = gridDim.x * gridDim.y * gridDim.z;
    unsigned sum, cnt, mine, sp = 0u;
    for (;;) {
        sum = 0u; cnt = 0u; mine = 0u;
#pragma unroll
        for (unsigned j = 0; j < 16; ++j) { const unsigned c = xb_ld(&bar[XB_XCNT(j)]); sum += c; cnt += (c > 0u) ? 1u : 0u; mine = (j == x) ? c : mine; }
        if (sum == G) break;
        __builtin_amdgcn_s_sleep(1);
        if ((++sp & 255u) == 0u) { if (xb_ld(&bar[XB_TMO])) break; if (sp > XB_SPIN_CAP) { atomicAdd(&bar[XB_TMO], 1u); break; } }
    }
    nloc = mine > 0u ? mine : 1u; nx = cnt > 0u ? cnt : 1u;
}

__device__ __forceinline__ void xcd_barrier(const XcdBarrier& b) {
    asm volatile("s_waitcnt vmcnt(0)" ::: "memory");
    __syncthreads();
    if (threadIdx.x == 0) {
        unsigned* bar = b.bar;
        __builtin_amdgcn_s_waitcnt(0);
        unsigned nloc = b.st[0], nx = b.st[1];
        if (nloc == 0u) { xcd_barrier_complete(bar, b.x, nloc, nx); b.st[0] = nloc; b.st[1] = nx; }
        const unsigned old = xb_add(&bar[XB_XSUB(b.x)], 1u);
        const unsigned gen = old / nloc;
        if (old + 1u == (gen + 1u) * nloc) {
            __builtin_amdgcn_fence(__ATOMIC_RELEASE, "agent");
            asm volatile("s_waitcnt vmcnt(0)" ::: "memory");
            const unsigned og = xb_add(&bar[XB_TOP], 1u);
            const unsigned tg = og / nx;
            if (og + 1u == (tg + 1u) * nx) xb_add(&bar[XB_TOPGEN], 1u);
            else XB_SPIN(xb_ld(&bar[XB_TOPGEN]) == tg, bar);
            __builtin_amdgcn_fence(__ATOMIC_ACQUIRE, "agent");
            xb_add(&bar[XB_XGEN(b.x)], 1u);
            asm volatile("s_waitcnt vmcnt(0)" ::: "memory");
        } else {
            XB_SPIN(xb_ld(&bar[XB_XGEN(b.x)]) == gen, bar);
            __builtin_amdgcn_fence(__ATOMIC_ACQUIRE, "agent");
            asm volatile("s_waitcnt vmcnt(0)" ::: "memory");
        }
    }
    __syncthreads();
}


struct Args { const float* in[24]; float* out; unsigned char* ws; int ph_lo, ph_hi, li, pad; };

__device__ __forceinline__ void p0_transpose_item(const float* __restrict__ W, int ldw, int K, int k0, int n0, bf16* __restrict__ WT, int vrow0, const float* __restrict__ gain, LAS float* scr, int lane) {
#pragma unroll 8
    for (int i = 0; i < 32; ++i) { const int kk = 2 * i + (lane >> 5); float v = W[(size_t)(k0 + kk) * ldw + n0 + (lane & 31)]; if (gain) v *= gain[k0 + kk]; scr[kk * 33 + (lane & 31)] = v; }
    LDS_WAIT(); asm volatile("" ::: "memory");
    const int c = lane & 7;
#pragma unroll
    for (int j = 0; j < 4; ++j) { const int n = (lane >> 3) + 8 * j; const LAS float* s = scr + (8 * c) * 33 + n;
        v4u o; o.x = pk2(s[0 * 33], s[1 * 33]); o.y = pk2(s[2 * 33], s[3 * 33]); o.z = pk2(s[4 * 33], s[5 * 33]); o.w = pk2(s[6 * 33], s[7 * 33]);
        *(GAS v4u*)(WT + (size_t)(vrow0 + n) * K + k0 + 8 * c) = o; }
    LDS_WAIT(); asm volatile("" ::: "memory");
}
__device__ __forceinline__ int vrow_in(int c) { const int pn = c >> 8, cr = c & 255, wc = cr >> 6, bj = (cr >> 5) & 1; return pn * 256 + bj * 128 + wc * 32; }
__device__ __forceinline__ int vrow_up(int c) { const int gs = c >= FF ? 1 : 0, cc = c - gs * FF, pn = cc >> 7, wc = (cc >> 5) & 3; return pn * 256 + gs * 128 + wc * 32; }

__global__ void __launch_bounds__(NWAVES * 64, 2) skel_fwd(Args args) {
    extern __shared__ __attribute__((aligned(16))) unsigned char lds_raw[];
    LAS unsigned char* lds = (LAS unsigned char*)lds_raw;
    volatile LAS unsigned* MISC = (volatile LAS unsigned*)(lds + MISC_OFF);
    const int tid = threadIdx.x, lane = tid & 63, wave = __builtin_amdgcn_readfirstlane(tid >> 6);
    const int G = gridDim.x; int vcu; { const int bx = blockIdx.x; vcu = (G % 8 == 0) ? (bx % 8) * (G / 8) + bx / 8 : bx; }
    unsigned char* ws = args.ws;
    gu32* ctl = (gu32*)(ws + WS_CTL);
    float* ss = (float*)(ws + WS_SS); bf16* xb = (bf16*)(ws + WS_XB); bf16* zg = (bf16*)(ws + WS_ZG); bf16* abuf = (bf16*)(ws + WS_A); float* yb = (float*)(ws + WS_YB);
    bf16* mix = (bf16*)(ws + WS_MIX); bf16* wbase = (bf16*)(ws + WS_W); float* xf = args.out;
    for (int u = tid; u < (LDS_BYTES - LDSCTL_OFF) / 4; u += NWAVES * 64) ((LAS unsigned*)(lds + LDSCTL_OFF))[u] = 0u;
    __syncthreads();
    XcdBarrier bar = xcd_barrier_post((unsigned*)(ctl + CW_BAR) + args.li * XCD_BAR_WORDS, MISC + 8);

#pragma unroll 1
    for (int ph = args.ph_lo; ph < args.ph_hi; ++ph) {
        const int l = ph > 0 ? (ph - 1) / 6 : 0, p = ph > 0 ? (ph - 1) % 6 + 1 : 0;
        bf16* wl = wbase + (size_t)l * WL_END;
        float* ss1 = ss + (size_t)((2 * l) & 3) * T * 16; float* ss2 = ss + (size_t)((2 * l + 1) & 3) * T * 16; float* ss3 = (l + 1 < L) ? ss + (size_t)((2 * l + 2) & 3) * T * 16 : nullptr;
#ifndef MK_ONLY
#define MK_ONLY 0x7f
#endif
        if (p == 0 && (MK_ONLY & 1)) {
            int lane0 = lane; asm volatile("" : "+v"(lane0));
            LAS float* scr = (LAS float*)(lds + RING_OFF + wave * 16384);
            const int gw = vcu * NWAVES + wave, NGW = G * NWAVES;
            constexpr int I_IN = (D / 64) * (INW / 32), I_G = (D / 64) * (GW / 32), I_A = (512 / 64) * (D / 32), I_O = (D / 64) * (D / 32), I_UP = (D / 64) * (FF2 / 32), I_DN = (FF / 64) * (D / 32);
            constexpr int I_LAYER = I_IN + I_G + 2 * I_A + I_O + I_UP + I_DN;
            for (int it = gw; it < L * I_LAYER; it += NGW) {
                const int ll = it / I_LAYER; int r = it - ll * I_LAYER; bf16* w = wbase + (size_t)ll * WL_END;
                if (r < I_IN) { const int nb = r % (INW / 32), kb = r / (INW / 32); p0_transpose_item(args.in[2] + (size_t)ll * D * INW, INW, D, 64 * kb, 32 * nb, w + WL_IN, vrow_in(32 * nb), args.in[1] + ll * D, scr, lane0); continue; } r -= I_IN;
                if (r < I_G) { const int nb = r % (GW / 32), kb = r / (GW / 32); p0_transpose_item(args.in[14] + (size_t)ll * D * GW, GW, D, 64 * kb, 32 * nb, w + WL_IN, vrow_in(INW + 32 * nb), args.in[1] + ll * D, scr, lane0); continue; } r -= I_G;
                if (r < I_A) { const int nb = r % (D / 32), kb = r / (D / 32); p0_transpose_item(args.in[16] + (size_t)ll * 512 * D, D, 512, 64 * kb, 32 * nb, w + WL_A, 32 * nb, nullptr, scr, lane0); continue; } r -= I_A;
                if (r < I_A) { const int nb = r % (D / 32), kb = r / (D / 32); p0_transpose_item(args.in[17] + (size_t)ll * 512 * D, D, 512, 64 * kb, 32 * nb, w + WL_B, 32 * nb, nullptr, scr, lane0); continue; } r -= I_A;
                if (r < I_O) { const int nb = r % (D / 32), kb = r / (D / 32); p0_transpose_item(args.in[18] + (size_t)ll * D * D, D, D, 64 * kb, 32 * nb, w + WL_O, 32 * nb, nullptr, scr, lane0); continue; } r -= I_O;
                if (r < I_UP) { const int nb = r % (FF2 / 32), kb = r / (FF2 / 32); p0_transpose_item(args.in[20] + (size_t)ll * D * FF2, FF2, D, 64 * kb, 32 * nb, w + WL_UP, vrow_up(32 * nb), args.in[19] + ll * D, scr, lane0); continue; } r -= I_UP;
                { const int nb = r % (D / 32), kb = r / (D / 32); p0_transpose_item(args.in[23] + (size_t)ll * FF * D, D, FF, 64 * kb, 32 * nb, w + WL_DN, 32 * nb, nullptr, scr, lane0); }
            }
            for (int m = gw; m < T; m += NGW) {
                const GAS f32x4* xr = (const GAS f32x4*)(args.in[0] + (size_t)m * D) + lane0; GAS f32x4* xo = (GAS f32x4*)(xf + (size_t)m * D) + lane0;
                GAS unsigned long long* o8 = (GAS unsigned long long*)(xb + (size_t)m * D) + lane0; float s = 0.f;
#pragma unroll
                for (int j = 0; j < 4; ++j) { const f32x4 v = xr[64 * j]; xo[64 * j] = v; s += (v.x * v.x + v.y * v.y) + (v.z * v.z + v.w * v.w);
                    o8[64 * j] = (unsigned long long)pk2(v.x, v.y) | ((unsigned long long)pk2(v.z, v.w) << 32); }
                s = wave_sum(s);
                ss16_store(ss, m, s, lane0);
            }
        } else if (p == 1 && (MK_ONLY & 2)) {
            pg8::SchedStd S; S.init(xb, D, wl + WL_IN, D, T, ZG, G, (int)blockIdx.x);
            pg8::EpiIn E{zg, ss1, args.in[3] + l * 64, args.in[4] + l * 64, args.in[6] + l * 64, args.in[7] + l * 64, args.in[15] + l * GW};
            pg8::gemm_phase<pg8::EpiIn, pg8::SchedStd, true, true>(lds + RING_OFF, D, D, S, E);
        } else if (p == 2 && (MK_ONLY & 4)) {
            const float lam_init = 0.8f - 0.6f * __expf(-0.3f * (float)l);
            int ln = lane; asm volatile("" : "+v"(ln));
            const float d1 = wave_sum(args.in[8][l * 64 + ln] * args.in[9][l * 64 + ln]), d2 = wave_sum(args.in[10][l * 64 + ln] * args.in[11][l * 64 + ln]);
            const float lam = __expf(d1) - __expf(d2) + lam_init;
            for (int ui = vcu; ui < 512; ui += G) { const int bh = ui >> 4, qb = ui & 15; att::attn_unit<true>(lds, zg, args.in[13], bh >> 2, bh & 3, qb * 128, nullptr, lam, 1.0f - lam_init, args.in[12] + l * 128); }
            for (int ui = vcu; ui < 512; ui += G) { const int bk = ui >> 5, qb = ui & 31; att::attn_unit<false>(lds, zg, args.in[13], bk >> 1, bk & 1, qb * 64, args.in[5] + l * HA, 0.f, 0.f, nullptr); }
        } else if (p == 3 && (MK_ONLY & 8)) {
            pg8::SchedMix S; S.b.init(zg + C_QA, ZG, wl + WL_A, 512, T, D, G, (int)blockIdx.x); S.A1 = (const char*)(zg + C_QB); S.Bt1 = (const char*)(wl + WL_B);
            pg8::EpiMix E{zg, mix};
            pg8::gemm_phase<pg8::EpiMix, pg8::SchedMix, true, true>(lds + RING_OFF, 512, ZG, S, E);
        } else if (p == 4 && (MK_ONLY & 16)) {
            pg8::SchedStd S; S.init(mix, D, wl + WL_O, D, T, D, G, (int)blockIdx.x);
            pg8::EpiRes E{xf, xf, xb, ss2};
            pg8::gemm_phase<pg8::EpiRes, pg8::SchedStd, true, true>(lds + RING_OFF, D, D, S, E);
        } else if (p == 5 && (MK_ONLY & 32)) {
            pg8::SchedStd S; S.init(xb, D, wl + WL_UP, D, T, FF2, G, (int)blockIdx.x);
            pg8::EpiUp E{abuf, ss2, args.in[21] + (size_t)l * 3 * FF2, args.in[22] + (size_t)l * FF2, yb};
            pg8::gemm_phase<pg8::EpiUp, pg8::SchedStd, true, true>(lds + RING_OFF, D, D, S, E);
        } else if (MK_ONLY & 64) {
            pg8::SchedDown S; S.b.init(abuf, FF, wl + WL_DN, FF, T, D, G, (int)blockIdx.x); S.yb = args.pad ? nullptr : yb; S.cw = args.in[21] + (size_t)l * 3 * FF2; S.cb = args.in[22] + (size_t)l * FF2; S.a = abuf;
            pg8::EpiRes E{xf, xf, ss3 ? xb : nullptr, ss3};
            pg8::gemm_phase<pg8::EpiRes, pg8::SchedDown, true, true>(lds + RING_OFF, FF, FF, S, E);
        }
        if (ph + 1 < args.ph_hi) xcd_barrier(bar);
    }
}
}

#ifndef MK_MODE
#define MK_MODE 0x7f
#endif
extern "C" void kernel_launch(void* const* d_in, const int* in_sizes, int n_in, void* d_out, int out_size, void* d_ws, size_t ws_size, hipStream_t stream) {
    using namespace nv;
    static int grid = 0;
    if (grid == 0) {
        if (n_in != 24 || out_size != T * D || ws_size < mk::WS_END) { fprintf(stderr, "kernel_launch: unexpected shapes (n_in %d, out %d, ws %zu)\n", n_in, out_size, ws_size); grid = -1; return; }
        int dev = 0, cus = 0, per_cu = 0;
        if (hipGetDevice(&dev) != hipSuccess || hipDeviceGetAttribute(&cus, hipDeviceAttributeMultiprocessorCount, dev) != hipSuccess) { grid = -1; return; }
        if (hipFuncSetAttribute((const void*)mk::skel_fwd, hipFuncAttributeMaxDynamicSharedMemorySize, mk::LDS_BYTES) != hipSuccess) { fprintf(stderr, "kernel_launch: hipFuncSetAttribute failed\n"); grid = -1; return; }
        if (hipOccupancyMaxActiveBlocksPerMultiprocessor(&per_cu, (const void*)mk::skel_fwd, mk::NWAVES * 64, mk::LDS_BYTES) != hipSuccess || per_cu < 1) fprintf(stderr, "kernel_launch: occupancy query says %d\n", per_cu);
        (void)hipGetLastError();
        grid = cus;
    }
    if (grid < 0) return;
    const float* in[24]; for (int i = 0; i < 24; ++i) in[i] = (const float*)d_in[i];
    unsigned char* ws = (unsigned char*)d_ws;
    float* xf = (float*)d_out; float* ss = (float*)(ws + mk::WS_SS); bf16* xb = (bf16*)(ws + mk::WS_XB); bf16* zg = (bf16*)(ws + mk::WS_ZG); bf16* abuf = (bf16*)(ws + mk::WS_A);
    bf16* mix = (bf16*)(ws + mk::WS_MIX); float* tmpA = (float*)(ws + mk::WS_TMPA); float* tmpB = (float*)(ws + mk::WS_TMPB);
    if (hipMemsetAsync(ws + mk::WS_CTL, 0, mk::CTL_ZERO_BYTES, stream) != hipSuccess) { fprintf(stderr, "kernel_launch: memset failed\n"); return; }
    mk::Args a{}; for (int i = 0; i < 24; ++i) a.in[i] = in[i]; a.out = xf; a.ws = ws;
    int li = 0;
#define MK_RUN(lo, hi) do { a.ph_lo = (lo); a.ph_hi = (hi); a.li = li++; hipLaunchKernelGGL(mk::skel_fwd, dim3(grid), dim3(mk::NWAVES * 64), mk::LDS_BYTES, stream, a); } while (0)
    if (MK_MODE == 0x7f) { MK_RUN(0, mk::N_PHASES); return; }
    MK_RUN(0, 1);
    for (int l = 0; l < L; ++l) {
        const float lam_init = 0.8f - 0.6f * expf(-0.3f * (float)l);
        float* ss1 = ss + (size_t)((2 * l) & 3) * T * 16; float* ss2 = ss + (size_t)((2 * l + 1) & 3) * T * 16; float* ss3 = (l + 1 < L) ? ss + (size_t)((2 * l + 2) & 3) * T * 16 : nullptr;
        const int pb = 1 + 6 * l;
        if (MK_MODE & 2) MK_RUN(pb, pb + 1);
        else for (int b = 0; b < B; ++b) { const int row0 = b * S;
            n_gemm<bf16><<<dim3(INW / 64, S / 64), 256, 0, stream>>>(xb + (size_t)row0 * D, D, in[1] + l * D, in[2] + (size_t)l * D * INW, INW, tmpA, INW, D);
            n_post_in<<<S, 256, 0, stream>>>(tmpA, ss1, in[3] + l * 64, in[4] + l * 64, in[6] + l * 64, in[7] + l * 64, zg, row0);
            n_gemm<bf16><<<dim3(GW / 64, S / 64), 256, 0, stream>>>(xb + (size_t)row0 * D, D, in[1] + l * D, in[14] + (size_t)l * D * GW, GW, tmpA, GW, D);
            n_post_gate<<<S, 256, 0, stream>>>(tmpA, ss1, in[15] + l * GW, zg, row0); }
        if (MK_MODE & 4) MK_RUN(pb + 1, pb + 2);
        else { n_attn_a<<<dim3(T, HA), 64, 0, stream>>>(zg, in[5] + l * HA, in[13]);
               n_attn_b<<<dim3(T, HB), 256, 0, stream>>>(zg, in[13], in[8] + l * 64, in[9] + l * 64, in[10] + l * 64, in[11] + l * 64, in[12] + l * 128, lam_init); }
        if (MK_MODE & 8) MK_RUN(pb + 2, pb + 3);
        else for (int b = 0; b < B; ++b) { const int row0 = b * S;
            n_gemm<bf16><<<dim3(D / 64, S / 64), 256, 0, stream>>>(zg + (size_t)row0 * ZG + C_QA, ZG, nullptr, in[16] + (size_t)l * 512 * D, D, tmpA, D, 512);
            n_gemm<bf16><<<dim3(D / 64, S / 64), 256, 0, stream>>>(zg + (size_t)row0 * ZG + C_QB, ZG, nullptr, in[17] + (size_t)l * 512 * D, D, tmpB, D, 512);
            n_post_mix<<<S, 256, 0, stream>>>(tmpA, tmpB, zg, mix, row0); }
        if (MK_MODE & 16) MK_RUN(pb + 3, pb + 4);
        else for (int b = 0; b < B; ++b) { const int row0 = b * S;
            n_gemm<bf16><<<dim3(D / 64, S / 64), 256, 0, stream>>>(mix + (size_t)row0 * D, D, nullptr, in[18] + (size_t)l * D * D, D, tmpA, D, D);
            n_post_res<<<S, 256, 0, stream>>>(tmpA, xf, xb, ss2, row0); }
        if ((MK_MODE & 32) && (MK_MODE & 64)) { MK_RUN(pb + 4, pb + 6); }
        else {
            for (int b = 0; b < B; ++b) { const int row0 = b * S;
                for (int hf = 0; hf < 2; ++hf) { const int j0 = hf * HW;
                    n_gemm<bf16><<<dim3(HW / 64, S / 64), 256, 0, stream>>>(xb + (size_t)row0 * D, D, in[19] + l * D, in[20] + (size_t)l * D * FF2 + j0, FF2, tmpA, 2 * HW, D);
                    n_gemm<bf16><<<dim3(HW / 64, S / 64), 256, 0, stream>>>(xb + (size_t)row0 * D, D, in[19] + l * D, in[20] + (size_t)l * D * FF2 + FF + j0, FF2, tmpA + HW, 2 * HW, D);
                    n_post_conv<<<S, 256, 0, stream>>>(tmpA, ss2, in[21] + (size_t)l * 3 * FF2, in[22] + (size_t)l * FF2, abuf, row0, j0); } }
            if (MK_MODE & 64) { a.pad = 1; MK_RUN(pb + 5, pb + 6); a.pad = 0; }
            else for (int b = 0; b < B; ++b) { const int row0 = b * S;
                n_gemm<bf16><<<dim3(D / 64, S / 64), 256, 0, stream>>>(abuf + (size_t)row0 * FF, FF, nullptr, in[23] + (size_t)l * FF * D, D, tmpA, D, FF);
                n_post_res<<<S, 256, 0, stream>>>(tmpA, xf, xb, ss3, row0); }
        }
    }
}
```

```cpp
#include <hip/hip_runtime.h>
#include <cstdio>
#include <cstdint>
#include <cmath>

namespace nv {
typedef unsigned short bf16;
constexpr int D = 1024, B = 8, S = 2048, T = B * S, L = 4;
constexpr int HA = 8, KVA = 2, HB = 4, HD = 64;
constexpr int INW = 2304, GW = 2048, ZG = INW + GW;
constexpr int FF = 2816, FF2 = 2 * FF;
constexpr int C_QA = 0, C_KA = 512, C_VA = 640, C_QB = 768, C_KB = 1280, C_VB = 1792, C_G = 2304;
constexpr float EPS = 1e-6f;
constexpr float LOG2E = 1.4426950408889634f;
constexpr float C2 = 0.125f * LOG2E;

__device__ __forceinline__ float bf2f(bf16 v) { return __uint_as_float(((unsigned)v) << 16); }
__device__ __forceinline__ bf16 f2bf(float f) { unsigned u = __float_as_uint(f); return (bf16)((u + 0x7fffu + ((u >> 16) & 1u)) >> 16); }
__device__ __forceinline__ float ldf(const float* p) { return *p; }
__device__ __forceinline__ float ldf(const bf16* p) { return bf2f(*p); }

__device__ __forceinline__ int t5_bucket(int rel) {
    const int n = rel < 0 ? -rel : rel; int v;
    if (n < 8) v = n; else if (n < 12) v = 8; else if (n < 16) v = 9; else if (n < 23) v = 10; else if (n < 32) v = 11;
    else if (n < 46) v = 12; else if (n < 64) v = 13; else if (n < 91) v = 14; else v = 15;
    return (rel > 0 ? 16 : 0) + v;
}
__device__ __forceinline__ float ss16(const float* ss, int t) { const float4* p = (const float4*)(ss + (size_t)t * 16); const float4 a = p[0], b = p[1], c = p[2], d = p[3];
    return ((a.x + a.y) + (a.z + a.w)) + ((b.x + b.y) + (b.z + b.w)) + ((c.x + c.y) + (c.z + c.w)) + ((d.x + d.y) + (d.z + d.w)); }
__device__ __forceinline__ void ss16_store(float* ss, int t, float s, int lane) { if (lane < 16) ss[(size_t)t * 16 + lane] = lane == 0 ? s : 0.f; }
__device__ __forceinline__ float wave_sum(float v) {
#pragma unroll
    for (int o = 1; o < 64; o <<= 1) v += __shfl_xor(v, o);
    return v;
}
__device__ __forceinline__ float wave_max(float v) {
#pragma unroll
    for (int o = 1; o < 64; o <<= 1) v = fmaxf(v, __shfl_xor(v, o));
    return v;
}

template <typename TA>
__global__ void __launch_bounds__(256) n_gemm(const TA* __restrict__ A, int lda, const float* __restrict__ gk, const float* __restrict__ W, int ldw, float* __restrict__ C, int ldc, int K) {
    __shared__ float As[16][68];
    __shared__ float Ws[16][64];
    const int tid = threadIdx.x, tx = tid & 15, ty = tid >> 4;
    const int m0 = blockIdx.y * 64, n0 = blockIdx.x * 64;
    float acc[4][4];
#pragma unroll
    for (int i = 0; i < 4; ++i)
#pragma unroll
        for (int j = 0; j < 4; ++j) acc[i][j] = 0.f;
    for (int k0 = 0; k0 < K; k0 += 16) {
#pragma unroll
        for (int i = 0; i < 4; ++i) { const int e = tid + i * 256, r = e >> 4, c = e & 15; float v = ldf(A + (size_t)(m0 + r) * lda + k0 + c); if (gk) v *= gk[k0 + c]; As[c][r] = v; }
#pragma unroll
        for (int i = 0; i < 4; ++i) { const int e = tid + i * 256, r = e >> 6, c = e & 63; Ws[r][c] = W[(size_t)(k0 + r) * ldw + n0 + c]; }
        __syncthreads();
#pragma unroll
        for (int kk = 0; kk < 16; ++kk) {
            float a[4], b[4];
#pragma unroll
            for (int i = 0; i < 4; ++i) { a[i] = As[kk][ty * 4 + i]; b[i] = Ws[kk][tx * 4 + i]; }
#pragma unroll
            for (int i = 0; i < 4; ++i)
#pragma unroll
                for (int j = 0; j < 4; ++j) acc[i][j] += a[i] * b[j];
        }
        __syncthreads();
    }
#pragma unroll
    for (int i = 0; i < 4; ++i)
#pragma unroll
        for (int j = 0; j < 4; ++j) C[(size_t)(m0 + ty * 4 + i) * ldc + n0 + tx * 4 + j] = acc[i][j];
}

__global__ void __launch_bounds__(256) n_init_x(const float* __restrict__ x, float* __restrict__ xf, bf16* __restrict__ xb, float* __restrict__ ss) {
    const int row = blockIdx.x * 4 + (threadIdx.x >> 6), lane = threadIdx.x & 63;
    float s = 0.f;
    for (int c = lane; c < D; c += 64) { const float v = x[(size_t)row * D + c]; xf[(size_t)row * D + c] = v; xb[(size_t)row * D + c] = f2bf(v); s += v * v; }
    s = wave_sum(s);
    ss16_store(ss, row, s, lane);
}

__global__ void __launch_bounds__(256) n_post_in(const float* __restrict__ Z, const float* __restrict__ ss, const float* __restrict__ qn_a, const float* __restrict__ kn_a,
                                                 const float* __restrict__ qn_b, const float* __restrict__ kn_b, bf16* __restrict__ zg, int row0) {
    const int r = blockIdx.x, t = row0 + r, wave = threadIdx.x >> 6, lane = threadIdx.x & 63;
    const float rs = rsqrtf(ss16(ss, t) * (1.0f / D) + EPS);
    for (int g = wave; g < INW / 64; g += 4) {
        float v = Z[(size_t)r * INW + g * 64 + lane] * rs;
        const float* gain = nullptr; float sc = 1.f;
        if (g < 8) { gain = qn_a; sc = C2; } else if (g < 10) { gain = kn_a; } else if (g < 12) { } else if (g < 20) { gain = qn_b; sc = C2; } else if (g < 28) { gain = kn_b; }
        if (gain) { const float q = wave_sum(v * v); v = v * rsqrtf(q * (1.0f / 64.0f) + EPS) * gain[lane] * sc; }
        zg[(size_t)t * ZG + g * 64 + lane] = f2bf(v);
    }
}
__global__ void __launch_bounds__(256) n_post_gate(const float* __restrict__ G, const float* __restrict__ ss, const float* __restrict__ bg, bf16* __restrict__ zg, int row0) {
    const int r = blockIdx.x, t = row0 + r;
    const float rs = rsqrtf(ss16(ss, t) * (1.0f / D) + EPS);
    for (int c = threadIdx.x; c < GW; c += 256) { const float v = G[(size_t)r * GW + c] * rs + bg[c]; zg[(size_t)t * ZG + C_G + c] = f2bf(1.0f / (1.0f + __expf(-v))); }
}

__global__ void __launch_bounds__(64) n_attn_a(bf16* __restrict__ zg, const float* __restrict__ sink, const float* __restrict__ rel_bias) {
    __shared__ float qs[64]; __shared__ float ps[5 * 64];
    const int t = blockIdx.x, h = blockIdx.y, lane = threadIdx.x, b = t / S, s = t % S, kv = h >> 2;
    qs[lane] = bf2f(zg[(size_t)t * ZG + C_QA + h * 64 + lane]);
    __syncthreads();
    const int j0 = s - 128;
    float sc[5]; float m = sink[h] * LOG2E;
#pragma unroll
    for (int i = 0; i < 5; ++i) {
        const int jj = i * 64 + lane, j = j0 + jj; float v = -1e30f;
        if (jj <= 256 && j >= 0 && j < S) {
            const bf16* kp = zg + (size_t)(b * S + j) * ZG + C_KA + kv * 64; float d = 0.f;
            for (int e = 0; e < 64; ++e) d += qs[e] * bf2f(kp[e]);
            v = d + rel_bias[t5_bucket(j - s) * 12 + h] * LOG2E;
        }
        sc[i] = v; m = fmaxf(m, v);
    }
    m = wave_max(m);
    float l = 0.f;
#pragma unroll
    for (int i = 0; i < 5; ++i) { const float p = (sc[i] > -1e29f) ? exp2f(sc[i] - m) : 0.f; ps[i * 64 + lane] = p; l += p; }
    l = wave_sum(l) + exp2f(sink[h] * LOG2E - m);
    __syncthreads();
    float o = 0.f;
    for (int jj = 0; jj <= 256; ++jj) { const int j = j0 + jj; if (j >= 0 && j < S) o += ps[jj] * bf2f(zg[(size_t)(b * S + j) * ZG + C_VA + kv * 64 + lane]); }
    zg[(size_t)t * ZG + C_QA + h * 64 + lane] = f2bf(o / l);
}

__global__ void __launch_bounds__(256) n_attn_b(bf16* __restrict__ zg, const float* __restrict__ rel_bias, const float* __restrict__ lq1, const float* __restrict__ lk1,
                                               const float* __restrict__ lq2, const float* __restrict__ lk2, const float* __restrict__ subg, float lam_init) {
    __shared__ float qs[128]; __shared__ float av[S]; __shared__ float s1s[S]; __shared__ float red[8]; __shared__ float osum[256];
    const int t = blockIdx.x, h = blockIdx.y, tid = threadIdx.x, lane = tid & 63, wave = tid >> 6, b = t / S, s = t % S;
    if (tid < 128) qs[tid] = bf2f(zg[(size_t)t * ZG + C_QB + h * 128 + tid]);
    float d1 = wave_sum(lq1[lane] * lk1[lane]), d2 = wave_sum(lq2[lane] * lk2[lane]);
    const float lam = __expf(d1) - __expf(d2) + lam_init;
    __syncthreads();
    float m0 = -1e30f, m1 = -1e30f;
#pragma unroll 1
    for (int i = 0; i < 8; ++i) {
        const int j = i * 256 + tid; const bf16* kp = zg + (size_t)(b * S + j) * ZG + C_KB + h * 128; float a0 = 0.f, a1 = 0.f;
#pragma unroll 8
        for (int e = 0; e < 64; ++e) { a0 += qs[e] * bf2f(kp[e]); a1 += qs[64 + e] * bf2f(kp[64 + e]); }
        const float bi = rel_bias[t5_bucket(j - s) * 12 + 8 + h] * LOG2E;
        a0 += bi; a1 += bi; av[j] = a0; s1s[j] = a1; m0 = fmaxf(m0, a0); m1 = fmaxf(m1, a1);
    }
    m0 = wave_max(m0); m1 = wave_max(m1);
    if (lane == 0) { red[wave] = m0; red[4 + wave] = m1; }
    __syncthreads();
    m0 = fmaxf(fmaxf(red[0], red[1]), fmaxf(red[2], red[3])); m1 = fmaxf(fmaxf(red[4], red[5]), fmaxf(red[6], red[7]));
    __syncthreads();
    float l0 = 0.f, l1 = 0.f;
#pragma unroll 1
    for (int i = 0; i < 8; ++i) { const int j = i * 256 + tid; const float p0 = exp2f(av[j] - m0), p1 = exp2f(s1s[j] - m1); av[j] = p0; s1s[j] = p1; l0 += p0; l1 += p1; }
    l0 = wave_sum(l0); l1 = wave_sum(l1);
    if (lane == 0) { red[wave] = l0; red[4 + wave] = l1; }
    __syncthreads();
    l0 = (red[0] + red[1]) + (red[2] + red[3]); l1 = (red[4] + red[5]) + (red[6] + red[7]);
#pragma unroll 1
    for (int i = 0; i < 8; ++i) { const int j = i * 256 + tid; av[j] = av[j] / l0 - lam * (s1s[j] / l1); }
    __syncthreads();
    const int e = tid & 127, half = tid >> 7; float o = 0.f;
    for (int j = half * 1024; j < half * 1024 + 1024; ++j) o += av[j] * bf2f(zg[(size_t)(b * S + j) * ZG + C_VB + h * 128 + e]);
    osum[tid] = o;
    __syncthreads();
    float ov = 0.f, q = 0.f;
    if (tid < 128) { ov = osum[tid] + osum[tid + 128]; q = ov * ov; }
    q = wave_sum(q);
    __syncthreads();
    if (lane == 0) red[wave] = q;
    __syncthreads();
    const float qq = red[0] + red[1];
    if (tid < 128) zg[(size_t)t * ZG + C_QB + h * 128 + tid] = f2bf(ov * rsqrtf(qq * (1.0f / 128.0f) + EPS) * subg[tid] * (1.0f - lam_init));
}

__global__ void __launch_bounds__(256) n_post_mix(const float* __restrict__ PA, const float* __restrict__ PB, const bf16* __restrict__ zg, bf16* __restrict__ mix, int row0) {
    const int r = blockIdx.x, t = row0 + r;
    for (int c = threadIdx.x; c < D; c += 256) {
        const float ga = bf2f(zg[(size_t)t * ZG + C_G + c]), gb = bf2f(zg[(size_t)t * ZG + C_G + D + c]);
        mix[(size_t)t * D + c] = f2bf(ga * PA[(size_t)r * D + c] + gb * PB[(size_t)r * D + c]);
    }
}
__global__ void __launch_bounds__(256) n_post_res(const float* __restrict__ tmp, float* __restrict__ xf, bf16* __restrict__ xb, float* __restrict__ ss_out, int row0) {
    __shared__ float red[4];
    const int r = blockIdx.x, t = row0 + r, lane = threadIdx.x & 63, wave = threadIdx.x >> 6; float s = 0.f;
    for (int c = threadIdx.x; c < D; c += 256) { const float v = xf[(size_t)t * D + c] + tmp[(size_t)r * D + c]; xf[(size_t)t * D + c] = v; xb[(size_t)t * D + c] = f2bf(v); s += v * v; }
    s = wave_sum(s); if (lane == 0) red[wave] = s;
    __syncthreads();
    if (ss_out) ss16_store(ss_out, t, (red[0] + red[1]) + (red[2] + red[3]), threadIdx.x);
}
constexpr int HW = FF / 2;
__global__ void __launch_bounds__(256) n_post_conv(const float* __restrict__ U, const float* __restrict__ ss, const float* __restrict__ cw, const float* __restrict__ cb, bf16* __restrict__ a, int row0, int j0) {
    const int r = blockIdx.x, t = row0 + r;
    const float rs1 = rsqrtf(ss16(ss, t) * (1.0f / D) + EPS);
    const float rs0 = r > 0 ? rsqrtf(ss16(ss, t - 1) * (1.0f / D) + EPS) : 0.f;
    const float rs2 = r < S - 1 ? rsqrtf(ss16(ss, t + 1) * (1.0f / D) + EPS) : 0.f;
    for (int j = threadIdx.x; j < HW; j += 256) {
        float u[2];
#pragma unroll
        for (int gsel = 0; gsel < 2; ++gsel) {
            const int col = gsel * FF + j0 + j, uc = gsel * HW + j;
            const float y1 = U[(size_t)r * (2 * HW) + uc] * rs1;
            const float y0 = r > 0 ? U[(size_t)(r - 1) * (2 * HW) + uc] * rs0 : 0.f;
            const float y2 = r < S - 1 ? U[(size_t)(r + 1) * (2 * HW) + uc] * rs2 : 0.f;
            u[gsel] = cb[col] + cw[col] * y0 + cw[FF2 + col] * y1 + cw[2 * FF2 + col] * y2;
        }
        const float sg = u[1] / (1.0f + __expf(-u[1]));
        a[(size_t)t * FF + j0 + j] = f2bf(sg * u[0]);
    }
}
__global__ void __launch_bounds__(256) n_rowss(const float* __restrict__ xf, float* __restrict__ ss_out) {
    const int row = blockIdx.x * 4 + (threadIdx.x >> 6), lane = threadIdx.x & 63; float s = 0.f;
    for (int c = lane; c < D; c += 64) { const float v = xf[(size_t)row * D + c]; s += v * v; }
    s = wave_sum(s); ss16_store(ss_out, row, s, lane);
}
}


namespace pg8 {
using namespace nv;
#define PG8_LAS __attribute__((address_space(3)))
typedef unsigned short bf16_t;
typedef short bf16x8 __attribute__((ext_vector_type(8)));
typedef float f32x4 __attribute__((ext_vector_type(4)));
typedef unsigned u32x4 __attribute__((ext_vector_type(4)));
typedef unsigned u32x2 __attribute__((ext_vector_type(2)));
constexpr int BM = 256, BK = 64, HALF = 128, HTB = HALF * BK * 2  , STAGE_BYTES = 8 * HTB, NXCD = 8, WGM = 8;
constexpr int XOFF = 131072 + 1024;

__host__ __device__ __forceinline__ int lds_byte(int r, int c) { const int st = (r >> 4) * 2 + (c >> 5), rr = r & 15, cc = c & 31, ob = rr * 64 + cc * 2; return st * 1024 + (ob ^ (((ob >> 9) & 1) << 5)); }
__host__ __device__ __forceinline__ void stage_rc(int b, int& R, int& C) { const int st = b / 1024, sb = b % 1024, swz = sb ^ (((sb >> 9) & 1) << 5); R = (st >> 1) * 16 + swz / 64; C = (st & 1) * 32 + (swz % 64) / 2; }
__host__ __device__ __forceinline__ int perm32(int rho) { const int n = rho >> 4, i = rho & 15; return 8 * (i >> 2) + 4 * n + (i & 3); }

struct Unit { int pm, pn, z; };
typedef float f32x2 __attribute__((ext_vector_type(2))); typedef __bf16 bf16x2_t __attribute__((ext_vector_type(2)));
__device__ __forceinline__ unsigned cvt_pk_bf16(float lo, float hi) { f32x2 v = {lo, hi}; bf16x2_t b = __builtin_convertvector(v, bf16x2_t); return __builtin_bit_cast(unsigned, b); }
__device__ __forceinline__ float bflo(unsigned w) { return __uint_as_float(w << 16); }
__device__ __forceinline__ float bfhi(unsigned w) { return __uint_as_float(w & 0xffff0000u); }

struct SchedStd {
    int nM, nN, nwg, G, c; const char* A; const char* Bt; size_t at, bt;
    __device__ void init(const void* A_, int lda, const void* Bt_, int K, int M, int N, int G_, int c_) { nM = M / BM; nN = N / BM; nwg = nM * nN; G = G_; c = c_; A = (const char*)A_; Bt = (const char*)Bt_; at = (size_t)BM * lda * 2; bt = (size_t)BM * K * 2; }
    __device__ bool next(int i, Unit& u) const {
        const long L = (long)i * G + c; if (L >= nwg) return false;
        int wgid = (int)L; { const int q = nwg / NXCD, r = nwg % NXCD, xcd = wgid % NXCD, off = wgid / NXCD; wgid = (xcd < r ? xcd * (q + 1) : r * (q + 1) + (xcd - r) * q) + off; }
        const int nig = WGM * nN, gid = wgid / nig, fm = gid * WGM, gsz = (nM - fm) < WGM ? (nM - fm) : WGM;
        u.pm = fm + ((wgid % nig) % gsz); u.pn = (wgid % nig) / gsz; u.z = 0; return true;
    }
    __device__ __forceinline__ const char* aptr(const Unit& u) const { return A + (size_t)u.pm * at; }
    __device__ __forceinline__ const char* bptr(const Unit& u) const { return Bt + (size_t)u.pn * bt; }
    __device__ __forceinline__ void a_ready(const Unit&) const {}
    __device__ __forceinline__ void done(const Unit&) const {}
};
struct SchedMix {
    SchedStd b; const char* A1; const char* Bt1;
    __device__ bool next(int i, Unit& u) const { if (!b.next(i >> 1, u)) return false; u.z = i & 1; return true; }
    __device__ __forceinline__ const char* aptr(const Unit& u) const { return (u.z ? A1 : b.A) + (size_t)u.pm * b.at; }
    __device__ __forceinline__ const char* bptr(const Unit& u) const { return (u.z ? Bt1 : b.Bt) + (size_t)u.pn * b.bt; }
    __device__ __forceinline__ void a_ready(const Unit&) const {}
    __device__ __forceinline__ void done(const Unit&) const {}
};
struct SchedDown {
    SchedStd b; const float* yb; const float* cw; const float* cb; bf16_t* a;
    __device__ bool next(int i, Unit& u) const { return b.next(i, u); }
    __device__ __forceinline__ const char* aptr(const Unit& u) const { return b.aptr(u); }
    __device__ __forceinline__ const char* bptr(const Unit& u) const { return b.bptr(u); }
    __device__ __forceinline__ void a_ready(const Unit& u) const {
        const int pm = u.pm;
        if (yb)
        for (int idx = threadIdx.x; idx < 2 * FF; idx += 512) {
            const int which = idx >= FF ? 1 : 0, j = idx - which * FF;
            float uv[2];
#pragma unroll
            for (int gs = 0; gs < 2; ++gs) {
                const int col = gs * FF + j; float y0, y1, y2;
                if (which == 0) { y0 = (pm & 7) ? yb[((size_t)(pm - 1) * 4 + 3) * FF2 + col] : 0.f; y1 = yb[((size_t)pm * 4 + 0) * FF2 + col]; y2 = yb[((size_t)pm * 4 + 1) * FF2 + col]; }
                else { y0 = yb[((size_t)pm * 4 + 2) * FF2 + col]; y1 = yb[((size_t)pm * 4 + 3) * FF2 + col]; y2 = ((pm & 7) != 7) ? yb[((size_t)(pm + 1) * 4 + 0) * FF2 + col] : 0.f; }
                uv[gs] = cb[col] + cw[col] * y0 + cw[FF2 + col] * y1 + cw[2 * FF2 + col] * y2;
            }
            const float sg = uv[1] * __builtin_amdgcn_rcpf(1.0f + __builtin_amdgcn_exp2f(-uv[1] * LOG2E));
            a[(size_t)(pm * BM + which * 255) * FF + j] = f2bf(sg * uv[0]);
        }
        asm volatile("s_waitcnt vmcnt(0)" ::: "memory");
        __builtin_amdgcn_s_barrier();
        asm volatile("" ::: "memory");
    }
    __device__ __forceinline__ void done(const Unit&) const {}
};

struct EpiIn {
    static constexpr bool PERM = true, AFTER_DRAIN = false;
    __device__ static constexpr bool zero_after(const Unit&) { return true; }
    bf16_t* zg; const float* ss; const float *qn_a, *kn_a, *qn_b, *kn_b, *bg;
    __device__ __forceinline__ void operator()(f32x4 (&acc)[2][2][4][2], const Unit& u, int wr, int wc, int fr, int fq, PG8_LAS unsigned char*) const {
        const int g = u.pn * 4 + wc, colb = u.pn * BM + wc * 64 + 8 * fq;
        const float* gain = nullptr; float sc = 1.f; int mode = 0;
        if (g < 8) { gain = qn_a; sc = C2; mode = 1; } else if (g < 10) { gain = kn_a; mode = 1; } else if (g < 12) { mode = 0; } else if (g < 20) { gain = qn_b; sc = C2; mode = 1; }
        else if (g < 28) { gain = kn_b; mode = 1; } else if (g < 36) { mode = 0; } else { mode = 2; }
        f32x4 gv[2][2];
#pragma unroll
        for (int bj = 0; bj < 2; ++bj)
#pragma unroll
            for (int n = 0; n < 2; ++n) {
                if (mode == 1) gv[bj][n] = *(const f32x4*)(gain + 32 * bj + 8 * fq + 4 * n) * sc;
                else if (mode == 2) gv[bj][n] = *(const f32x4*)(bg + (colb - C_G) + 32 * bj + 4 * n);
                else gv[bj][n] = (f32x4){1.f, 1.f, 1.f, 1.f};
            }
#pragma unroll
        for (int ai = 0; ai < 2; ++ai)
#pragma unroll
            for (int m = 0; m < 4; ++m) {
                const int row = u.pm * BM + ai * HALF + wr * 64 + m * 16 + fr;
                const float rs = rsqrtf(ss16(ss, row) * (1.0f / D) + EPS);
                f32x4 v[2][2];
#pragma unroll
                for (int bj = 0; bj < 2; ++bj)
#pragma unroll
                    for (int n = 0; n < 2; ++n) v[bj][n] = acc[ai][bj][m][n] * rs;
                if (mode == 1) {
                    float q = 0.f;
#pragma unroll
                    for (int bj = 0; bj < 2; ++bj)
#pragma unroll
                        for (int n = 0; n < 2; ++n) { const f32x4 x = v[bj][n]; q += (x[0] * x[0] + x[1] * x[1]) + (x[2] * x[2] + x[3] * x[3]); }
                    q += __shfl_xor(q, 16); q += __shfl_xor(q, 32);
                    const float r2 = rsqrtf(q * (1.0f / 64.0f) + EPS);
#pragma unroll
                    for (int bj = 0; bj < 2; ++bj)
#pragma unroll
                        for (int n = 0; n < 2; ++n) v[bj][n] = v[bj][n] * r2 * gv[bj][n];
                } else if (mode == 2) {
#pragma unroll
                    for (int bj = 0; bj < 2; ++bj)
#pragma unroll
                        for (int n = 0; n < 2; ++n) { f32x4 x = v[bj][n] + gv[bj][n];
#pragma unroll
                            for (int e = 0; e < 4; ++e) x[e] = __builtin_amdgcn_rcpf(1.0f + __builtin_amdgcn_exp2f(-x[e] * LOG2E));
                            v[bj][n] = x; }
                }
                bf16_t* rowp = zg + (size_t)row * ZG + colb;
#pragma unroll
                for (int bj = 0; bj < 2; ++bj) { u32x4 w; w.x = cvt_pk_bf16(v[bj][0][0], v[bj][0][1]); w.y = cvt_pk_bf16(v[bj][0][2], v[bj][0][3]); w.z = cvt_pk_bf16(v[bj][1][0], v[bj][1][1]); w.w = cvt_pk_bf16(v[bj][1][2], v[bj][1][3]);
                    *(u32x4*)(rowp + 32 * bj) = w; }
            }
    }
};
struct EpiMix {
    static constexpr bool PERM = true, AFTER_DRAIN = false;
    __device__ static bool zero_after(const Unit& u) { return u.z != 0; }
    const bf16_t* zg; bf16_t* mix;
    __device__ __forceinline__ void operator()(f32x4 (&acc)[2][2][4][2], const Unit& u, int wr, int wc, int fr, int fq, PG8_LAS unsigned char*) const {
        const int col0 = u.pn * BM + wc * 32 + 8 * fq;
#pragma unroll
        for (int ai = 0; ai < 2; ++ai)
#pragma unroll
            for (int m = 0; m < 4; ++m) {
                const int row = u.pm * BM + ai * HALF + wr * 64 + m * 16 + fr;
#pragma unroll
                for (int bj = 0; bj < 2; ++bj) {
                    const int col = col0 + bj * HALF;
                    const u32x4 gb = *(const u32x4*)(zg + (size_t)row * ZG + C_G + D + col);
                    if (u.z == 0) {
                        const u32x4 ga = *(const u32x4*)(zg + (size_t)row * ZG + C_G + col);
                        f32x4 r0, r1;
                        r0[0] = bflo(ga.x) * __builtin_amdgcn_rcpf(bflo(gb.x)); r0[1] = bfhi(ga.x) * __builtin_amdgcn_rcpf(bfhi(gb.x)); r0[2] = bflo(ga.y) * __builtin_amdgcn_rcpf(bflo(gb.y)); r0[3] = bfhi(ga.y) * __builtin_amdgcn_rcpf(bfhi(gb.y));
                        r1[0] = bflo(ga.z) * __builtin_amdgcn_rcpf(bflo(gb.z)); r1[1] = bfhi(ga.z) * __builtin_amdgcn_rcpf(bfhi(gb.z)); r1[2] = bflo(ga.w) * __builtin_amdgcn_rcpf(bflo(gb.w)); r1[3] = bfhi(ga.w) * __builtin_amdgcn_rcpf(bfhi(gb.w));
                        acc[ai][bj][m][0] *= r0; acc[ai][bj][m][1] *= r1;
                    } else {
                        const f32x4 v0 = acc[ai][bj][m][0] * (f32x4){bflo(gb.x), bfhi(gb.x), bflo(gb.y), bfhi(gb.y)}, v1 = acc[ai][bj][m][1] * (f32x4){bflo(gb.z), bfhi(gb.z), bflo(gb.w), bfhi(gb.w)};
                        u32x4 w; w.x = cvt_pk_bf16(v0[0], v0[1]); w.y = cvt_pk_bf16(v0[2], v0[3]); w.z = cvt_pk_bf16(v1[0], v1[1]); w.w = cvt_pk_bf16(v1[2], v1[3]);
                        *(u32x4*)(mix + (size_t)row * D + col) = w;
                    }
                }
            }
    }
};
struct EpiRes {
    static constexpr bool PERM = false, AFTER_DRAIN = false;
    __device__ static constexpr bool zero_after(const Unit&) { return true; }
    const float* base; float* xf; bf16_t* xb; float* ssn;
    __device__ __forceinline__ void operator()(f32x4 (&acc)[2][2][4][2], const Unit& u, int wr, int wc, int fr, int fq, PG8_LAS unsigned char*) const {
        const int col0 = u.pn * BM + wc * 32 + 4 * fq;
#pragma unroll
        for (int ai = 0; ai < 2; ++ai)
#pragma unroll
            for (int m = 0; m < 4; ++m) {
                const int row = u.pm * BM + ai * HALF + wr * 64 + m * 16 + fr; const size_t off = (size_t)row * D + col0; float q = 0.f;
#pragma unroll
                for (int bj = 0; bj < 2; ++bj)
#pragma unroll
                    for (int n = 0; n < 2; ++n) { const f32x4 bs = *(const f32x4*)(base + off + bj * HALF + n * 16); const f32x4 o = bs + acc[ai][bj][m][n];
                        *(f32x4*)(xf + off + bj * HALF + n * 16) = o; q += (o[0] * o[0] + o[1] * o[1]) + (o[2] * o[2] + o[3] * o[3]);
                        if (xb) { u32x2 w; w.x = cvt_pk_bf16(o[0], o[1]); w.y = cvt_pk_bf16(o[2], o[3]); *(u32x2*)(xb + off + bj * HALF + n * 16) = w; } }
                if (ssn) { q += __shfl_xor(q, 16); q += __shfl_xor(q, 32); if (fq == 0) ssn[(size_t)row * 16 + u.pn * 4 + wc] = q; }
                if (m & 1) asm volatile("" ::: "memory");
            }
    }
};
#define DPPF(oldv, src, ctrl, bc) __int_as_float(__builtin_amdgcn_update_dpp(__float_as_int(oldv), __float_as_int(src), (ctrl), 0xF, 0xF, (bc)))
struct EpiUp {
    static constexpr bool PERM = true, AFTER_DRAIN = false;
    __device__ static constexpr bool zero_after(const Unit&) { return true; }
    bf16_t* a; const float* ss; const float* cw; const float* cb; float* yb;
    __device__ __forceinline__ void operator()(f32x4 (&acc)[2][2][4][2], const Unit& u, int wr, int wc, int fr, int fq, PG8_LAS unsigned char* lds) const {
        const int wid = wr * 4 + wc;
        PG8_LAS float* X = (PG8_LAS float*)(lds + XOFF);
#pragma unroll
        for (int ai = 0; ai < 2; ++ai)
#pragma unroll
            for (int m = 0; m < 4; ++m) {
                const int row = u.pm * BM + ai * HALF + wr * 64 + m * 16 + fr;
                const float rs = rsqrtf(ss16(ss, row) * (1.0f / D) + EPS);
#pragma unroll
                for (int bj = 0; bj < 2; ++bj)
#pragma unroll
                    for (int n = 0; n < 2; ++n) acc[ai][bj][m][n] *= rs;
            }
#pragma unroll
        for (int ai = 0; ai < 2; ++ai) {
            if (fr == 0) {
#pragma unroll
                for (int bj = 0; bj < 2; ++bj)
#pragma unroll
                    for (int n = 0; n < 2; ++n) *(PG8_LAS f32x4*)(X + ((wid * 2 + ai) * 2 + 0) * 64 + 32 * bj + 8 * fq + 4 * n) = acc[ai][bj][0][n];
            }
            if (fr == 15) {
#pragma unroll
                for (int bj = 0; bj < 2; ++bj)
#pragma unroll
                    for (int n = 0; n < 2; ++n) *(PG8_LAS f32x4*)(X + ((wid * 2 + ai) * 2 + 1) * 64 + 32 * bj + 8 * fq + 4 * n) = acc[ai][bj][3][n];
            }
        }
        {
            const int ccol = u.pn * 128 + wc * 32 + 8 * fq;
            if (wr == 0 && fr < 2) {
#pragma unroll
                for (int bj = 0; bj < 2; ++bj)
#pragma unroll
                    for (int n = 0; n < 2; ++n) *(f32x4*)(yb + ((size_t)u.pm * 4 + fr) * FF2 + bj * FF + ccol + 4 * n) = acc[0][bj][0][n];
            }
            if (wr == 1 && fr >= 14) {
#pragma unroll
                for (int bj = 0; bj < 2; ++bj)
#pragma unroll
                    for (int n = 0; n < 2; ++n) *(f32x4*)(yb + ((size_t)u.pm * 4 + 2 + (fr - 14)) * FF2 + bj * FF + ccol + 4 * n) = acc[1][bj][3][n];
            }
        }
        asm volatile("s_waitcnt lgkmcnt(0)" ::: "memory"); __builtin_amdgcn_s_barrier(); asm volatile("" ::: "memory");
#pragma unroll
        for (int n = 0; n < 2; ++n) {
            const int ccol = u.pn * 128 + wc * 32 + 8 * fq + 4 * n;
            f32x4 w0[2], w1[2], w2[2], bb[2];
#pragma unroll
            for (int bj = 0; bj < 2; ++bj) { w0[bj] = *(const f32x4*)(cw + bj * FF + ccol); w1[bj] = *(const f32x4*)(cw + FF2 + bj * FF + ccol); w2[bj] = *(const f32x4*)(cw + 2 * FF2 + bj * FF + ccol); bb[bj] = *(const f32x4*)(cb + bj * FF + ccol); }
#pragma unroll
            for (int ai = 0; ai < 2; ++ai) {
                const int pw = wr ? wid - 4 : wid + 4, pai = wr ? ai : 0;
                const int nw = wr ? wid - 4 : wid + 4, nai = wr ? 1 : ai;
                f32x4 xp[2], xn[2];
#pragma unroll
                for (int bj = 0; bj < 2; ++bj) { xp[bj] = *(PG8_LAS f32x4*)(X + ((pw * 2 + pai) * 2 + 1) * 64 + 32 * bj + 8 * fq + 4 * n); xn[bj] = *(PG8_LAS f32x4*)(X + ((nw * 2 + nai) * 2 + 0) * 64 + 32 * bj + 8 * fq + 4 * n); }
#pragma unroll
                for (int m = 0; m < 4; ++m) {
                    const int trow = ai * HALF + wr * 64 + m * 16 + fr;
                    float uv[2][4];
#pragma unroll
                    for (int bj = 0; bj < 2; ++bj)
#pragma unroll
                        for (int e = 0; e < 4; ++e) {
                            const float cur = acc[ai][bj][m][n][e];
                            float rp, rn;
                            if (m > 0) rp = DPPF(0.f, acc[ai][bj][m > 0 ? m - 1 : 0][n][e], 0x121, true); else rp = xp[bj][e];
                            if (m < 3) rn = DPPF(0.f, acc[ai][bj][m < 3 ? m + 1 : 3][n][e], 0x12F, true); else rn = xn[bj][e];
                            const float prev = DPPF(rp, cur, 0x111, false), next = DPPF(rn, cur, 0x101, false);
                            uv[bj][e] = bb[bj][e] + w0[bj][e] * prev + w1[bj][e] * cur + w2[bj][e] * next;
                        }
                    f32x4 o;
#pragma unroll
                    for (int e = 0; e < 4; ++e) o[e] = uv[0][e] * uv[1][e] * __builtin_amdgcn_rcpf(1.0f + __builtin_amdgcn_exp2f(-uv[1][e] * LOG2E));
                    u32x2 w; w.x = cvt_pk_bf16(o[0], o[1]); w.y = cvt_pk_bf16(o[2], o[3]);
                    if (trow != 0 && trow != 255) *(u32x2*)(a + (size_t)(u.pm * BM + trow) * FF + ccol) = w;
                    asm volatile("" ::: "memory");
                }
            }
        }
    }
};

template <class Epi, class Sched, bool ALIGN_EPI = false, bool SP2 = false>
__device__ __forceinline__ void gemm_phase(PG8_LAS unsigned char* lds, const int K, const int lda, const Sched& S, const Epi& E) {
    int tid_ = threadIdx.x; asm volatile("" : "+v"(tid_));
    const int tid = tid_, wid = __builtin_amdgcn_readfirstlane(tid >> 6), lane = tid & 63, wr = wid >> 2, wc = wid & 3, fr = lane & 15, fq = lane >> 4;
    const int nt = K / BK;
    unsigned voffA[2], voffB[2];
#pragma unroll
    for (int i = 0; i < 2; ++i) { int R, C; stage_rc(tid * 16 + i * 8192, R, C); const int Rb = Epi::PERM ? ((R & ~31) + perm32(R & 31)) : R;
        voffA[i] = (unsigned)(R * lda + C) * 2u; voffB[i] = (unsigned)(Rb * K + C) * 2u; }
    const size_t kstep = (size_t)(BK * 2);
    const size_t hstepB = (size_t)HALF * K * 2;
    const size_t hstepA = (size_t)HALF * lda * 2;
    const unsigned ldsw = (unsigned)wid * 1024u;
    const int aoff = lds_byte(wr * 64 + fr, fq * 8), boff = lds_byte(wc * 32 + fr, fq * 8);
#define PG8_SA(b, h) (((b) * 2 + (h)) * HTB)
#define PG8_SB(b, h) ((4 + (b) * 2 + (h)) * HTB)
#define PG8_STAGE(bufoff, gbase, voff) do { _Pragma("unroll") for (int _i = 0; _i < 2; ++_i) \
        __builtin_amdgcn_global_load_lds((const unsigned*)((const char*)(gbase) + (voff)[_i]), (PG8_LAS unsigned*)(lds + (bufoff) + ldsw + _i * 8192), 16, 0, 0); } while (0)
#define PG8_LDA(dst, b, h) do { _Pragma("unroll") for (int m = 0; m < 4; ++m) _Pragma("unroll") for (int k = 0; k < 2; ++k) dst[m][k] = *(const PG8_LAS bf16x8*)(lds + PG8_SA(b, h) + aoff + m * 2048 + k * 1024); } while (0)
#define PG8_LDB(dst, b, h) do { _Pragma("unroll") for (int n = 0; n < 2; ++n) _Pragma("unroll") for (int k = 0; k < 2; ++k) dst[n][k] = *(const PG8_LAS bf16x8*)(lds + PG8_SB(b, h) + boff + n * 2048 + k * 1024); } while (0)
#define PG8_MMA(ai, bj, At, Bt) do { __builtin_amdgcn_s_setprio(1); _Pragma("unroll") for (int m = 0; m < 4; ++m) _Pragma("unroll") for (int n = 0; n < 2; ++n) _Pragma("unroll") for (int k = 0; k < 2; ++k) \
        acc[ai][bj][m][n] = __builtin_amdgcn_mfma_f32_16x16x32_bf16(Bt[n][k], At[m][k], acc[ai][bj][m][n], 0, 0, 0); __builtin_amdgcn_s_setprio(0); } while (0)
#define PG8_WAIT_V(n) asm volatile("s_waitcnt vmcnt(" #n ")" ::: "memory")
#define PG8_WAIT_L(n) asm volatile("s_waitcnt lgkmcnt(" #n ")" ::: "memory")
#define PG8_BAR __builtin_amdgcn_s_barrier()
#define PG8_SCHED __builtin_amdgcn_sched_barrier(0)
    Unit cur, nxt; int ui = 0;
    if (!S.next(0, cur)) return;
    f32x4 acc[2][2][4][2];
#pragma unroll
    for (int a = 0; a < 2; ++a)
#pragma unroll
        for (int b = 0; b < 2; ++b)
#pragma unroll
            for (int m = 0; m < 4; ++m)
#pragma unroll
                for (int n = 0; n < 2; ++n) acc[a][b][m][n] = (f32x4){0.f, 0.f, 0.f, 0.f};
    bf16x8 At[4][2], B0[2][2], B1[2][2];
    const char* cA = S.aptr(cur); const char* cB = S.bptr(cur);
    S.a_ready(cur);
    if constexpr (SP2) {
        PG8_STAGE(PG8_SB(0, 0), cB, voffB); PG8_STAGE(PG8_SB(0, 1), cB + hstepB, voffB); PG8_STAGE(PG8_SA(0, 0), cA, voffA); PG8_STAGE(PG8_SA(0, 1), cA + hstepA, voffA);
        if (wr == 1) PG8_BAR;
        PG8_WAIT_V(2); PG8_BAR;
        PG8_STAGE(PG8_SB(1, 0), cB + kstep, voffB); PG8_STAGE(PG8_SA(1, 0), cA + kstep, voffA); PG8_STAGE(PG8_SB(1, 1), cB + hstepB + kstep, voffB);
        PG8_WAIT_V(6); PG8_BAR;
    } else {
        PG8_STAGE(PG8_SB(0, 0), cB, voffB); PG8_STAGE(PG8_SA(0, 0), cA, voffA); PG8_STAGE(PG8_SB(0, 1), cB + hstepB, voffB); PG8_STAGE(PG8_SA(0, 1), cA + hstepA, voffA);
        if (wr == 1) PG8_BAR;
        PG8_WAIT_V(4); PG8_BAR;
        PG8_STAGE(PG8_SB(1, 0), cB + kstep, voffB); PG8_STAGE(PG8_SA(1, 0), cA + kstep, voffA); PG8_STAGE(PG8_SB(1, 1), cB + hstepB + kstep, voffB);
        PG8_WAIT_V(6); PG8_BAR;
    }
    for (;;) {
        const bool has_next = S.next(ui + 1, nxt);
        const char* nA = has_next ? S.aptr(nxt) : cA; const char* nB = has_next ? S.bptr(nxt) : cB;
        for (int t = 0; t < nt; t += 2) {
            const bool last = (t == nt - 2);
            const char* a1 = cA + (size_t)(t + 1) * kstep;
            const char* a2 = last ? nA : cA + (size_t)(t + 2) * kstep; const char* b2 = last ? nB : cB + (size_t)(t + 2) * kstep;
            const char* a3 = a2 + kstep; const char* b3 = b2 + kstep;
            if (last && has_next) S.a_ready(nxt);
            if constexpr (SP2) {
            PG8_LDB(B0, 0, 0); PG8_LDB(B1, 0, 1); PG8_SCHED; PG8_LDA(At, 0, 0); PG8_STAGE(PG8_SA(1, 1), a1 + hstepA, voffA);
            PG8_WAIT_V(8); PG8_WAIT_L(0); PG8_BAR; PG8_MMA(0, 0, At, B0); PG8_MMA(0, 1, At, B1); PG8_BAR; PG8_SCHED;
            PG8_LDA(At, 0, 1); PG8_STAGE(PG8_SB(0, 0), b2, voffB); PG8_STAGE(PG8_SB(0, 1), b2 + hstepB, voffB); PG8_STAGE(PG8_SA(0, 0), a2, voffA);
            PG8_WAIT_V(8); PG8_WAIT_L(0); PG8_BAR; PG8_MMA(1, 0, At, B0); PG8_MMA(1, 1, At, B1); PG8_BAR; PG8_SCHED;
            PG8_LDB(B0, 1, 0); PG8_LDB(B1, 1, 1); PG8_SCHED; PG8_LDA(At, 1, 0); PG8_STAGE(PG8_SA(0, 1), a2 + hstepA, voffA);
            PG8_WAIT_V(8); PG8_WAIT_L(0); PG8_BAR; PG8_MMA(0, 0, At, B0); PG8_MMA(0, 1, At, B1); PG8_BAR; PG8_SCHED;
            PG8_LDA(At, 1, 1); PG8_STAGE(PG8_SB(1, 0), b3, voffB); PG8_STAGE(PG8_SB(1, 1), b3 + hstepB, voffB); PG8_STAGE(PG8_SA(1, 0), a3, voffA);
            PG8_WAIT_V(8); PG8_WAIT_L(0); PG8_BAR; PG8_MMA(1, 0, At, B0); PG8_MMA(1, 1, At, B1); PG8_BAR; PG8_SCHED;
            } else {
            PG8_LDB(B0, 0, 0); PG8_SCHED; PG8_LDA(At, 0, 0); PG8_STAGE(PG8_SA(1, 1), a1 + hstepA, voffA);
            PG8_WAIT_L(8); PG8_BAR; PG8_WAIT_L(0); PG8_MMA(0, 0, At, B0); PG8_BAR; PG8_SCHED;
            PG8_LDB(B1, 0, 1); PG8_STAGE(PG8_SB(0, 0), b2, voffB);
            PG8_BAR; PG8_WAIT_L(0); PG8_MMA(0, 1, At, B1); PG8_BAR;
            PG8_LDA(At, 0, 1); PG8_STAGE(PG8_SA(0, 0), a2, voffA);
            PG8_BAR; PG8_WAIT_L(0); PG8_MMA(1, 0, At, B0); PG8_BAR; PG8_SCHED;
            PG8_STAGE(PG8_SB(0, 1), b2 + hstepB, voffB);
            PG8_WAIT_V(6); PG8_BAR; PG8_MMA(1, 1, At, B1); PG8_BAR;
            PG8_LDB(B0, 1, 0); PG8_SCHED; PG8_LDA(At, 1, 0); PG8_STAGE(PG8_SA(0, 1), a2 + hstepA, voffA);
            PG8_WAIT_L(8); PG8_BAR; PG8_WAIT_L(0); PG8_MMA(0, 0, At, B0); PG8_BAR; PG8_SCHED;
            PG8_LDB(B1, 1, 1); PG8_STAGE(PG8_SB(1, 0), b3, voffB);
            PG8_BAR; PG8_WAIT_L(0); PG8_MMA(0, 1, At, B1); PG8_BAR;
            PG8_LDA(At, 1, 1); PG8_STAGE(PG8_SA(1, 0), a3, voffA);
            PG8_BAR; PG8_WAIT_L(0); PG8_MMA(1, 0, At, B0); PG8_BAR; PG8_SCHED;
            PG8_STAGE(PG8_SB(1, 1), b3 + hstepB, voffB);
            PG8_WAIT_V(6); PG8_BAR; PG8_MMA(1, 1, At, B1); PG8_BAR;
            }
        }
        if constexpr (ALIGN_EPI) { if (wr == 0) PG8_BAR; }
        if constexpr (!Epi::AFTER_DRAIN) { E(acc, cur, wr, wc, fr, fq, lds); S.done(cur); }
        if (!has_next) break;
        if (Epi::zero_after(cur)) {
#pragma unroll
        for (int a = 0; a < 2; ++a)
#pragma unroll
            for (int b = 0; b < 2; ++b)
#pragma unroll
                for (int m = 0; m < 4; ++m)
#pragma unroll
                    for (int n = 0; n < 2; ++n) acc[a][b][m][n] = (f32x4){0.f, 0.f, 0.f, 0.f};
        }
        cur = nxt; cA = nA; cB = nB; ++ui;
        if constexpr (ALIGN_EPI) { if (wr == 1) PG8_BAR; }
    }
    PG8_WAIT_V(0);
    if constexpr (!ALIGN_EPI) { if (wr == 0) PG8_BAR; }
    PG8_BAR;
    if constexpr (Epi::AFTER_DRAIN) { E.fused(acc, cur, wr, wc, fr, fq, lds, wid, lane); S.done(cur); }
#undef PG8_SA
#undef PG8_SB
#undef PG8_STAGE
#undef PG8_LDA
#undef PG8_LDB
#undef PG8_MMA
#undef PG8_WAIT_V
#undef PG8_WAIT_L
#undef PG8_BAR
#undef PG8_SCHED
}
}

namespace att {
using namespace nv;
#define ALAS __attribute__((address_space(3)))
typedef short bf16x8 __attribute__((ext_vector_type(8)));
typedef short s16x4 __attribute__((ext_vector_type(4)));
typedef float f32x16 __attribute__((ext_vector_type(16)));
typedef float f32x4 __attribute__((ext_vector_type(4)));
typedef unsigned u32x4 __attribute__((ext_vector_type(4)));
typedef unsigned u32x2 __attribute__((ext_vector_type(2)));
typedef short v4i16_t __attribute__((ext_vector_type(4)));
typedef float f32x2_t __attribute__((ext_vector_type(2))); typedef __bf16 bf16x2_t __attribute__((ext_vector_type(2)));
constexpr int LUT_OFF = 98304, LUT_STRIDE = 520, GT_OFF = LUT_OFF + 4 * LUT_STRIDE * 4;
constexpr float NEG = -30000.f, THR = 6.f;
__device__ __forceinline__ unsigned cvtpk(float lo, float hi) { f32x2_t v = {lo, hi}; bf16x2_t b = __builtin_convertvector(v, bf16x2_t); return __builtin_bit_cast(unsigned, b); }
__device__ __forceinline__ s16x4 vtr(ALAS const unsigned char* p) { return __builtin_bit_cast(s16x4, __builtin_amdgcn_ds_read_tr16_b64_v4i16((ALAS v4i16_t*)p)); }
__device__ __forceinline__ float swap_add(float v) { auto rr = __builtin_amdgcn_permlane32_swap(__float_as_uint(v), __float_as_uint(v), false, false); return __uint_as_float(rr[0]) + __uint_as_float(rr[1]); }
__device__ __forceinline__ float swap_max(float v) { auto rr = __builtin_amdgcn_permlane32_swap(__float_as_uint(v), __float_as_uint(v), false, false); return fmaxf(__uint_as_float(rr[0]), __uint_as_float(rr[1])); }
#define MX3(a, b, c) __builtin_fmaxf(__builtin_fmaxf((a), (b)), (c))

template <bool ISB, int VAR = 0>
__device__ __forceinline__ void attn_unit(ALAS unsigned char* lds, bf16* zg, const float* __restrict__ lutg, int b, int hsel, int q0, const float* __restrict__ sinkp, float lam, float osc, const float* __restrict__ subg, bf16* odry) {
    int tid_ = threadIdx.x; asm volatile("" : "+v"(tid_));
    const int tid = tid_, lane = tid & 63, r32 = lane & 31, hi = lane >> 5; const int wid = __builtin_amdgcn_readfirstlane(tid >> 6);
    constexpr int BUF_B = 32768, BUF_A = 16384;
    constexpr int NDV = ISB ? 4 : 2, BUF = ISB ? BUF_B : BUF_A, VOFF = ISB ? 16384 : 8192;
    const int map = ISB ? (wid >> 2) : 0, qsub = ISB ? (wid & 3) : (wid & 1), gsel = ISB ? 0 : (wid >> 1);
    const int head = ISB ? hsel : hsel * 4 + gsel;
    const int qrow0 = q0 + 32 * qsub;
    const int qcol = ISB ? (C_QB + head * 128 + map * 64) : (C_QA + head * 64);
    const int kcol = ISB ? (C_KB + head * 128) : (C_KA + hsel * 64);
    const int vcol = ISB ? (C_VB + head * 128) : (C_VA + hsel * 64);
    const size_t rowbase = (size_t)b * S;
    int kt0 = 0, kt1 = S / 64;
    if (!ISB) { kt0 = q0 / 64 - 2; if (kt0 < 0) kt0 = 0; kt1 = q0 / 64 + 3; if (kt1 > S / 64) kt1 = S / 64; }
    ALAS float* lut = (ALAS float*)(lds + LUT_OFF);
    ALAS float* gt = (ALAS float*)(lds + GT_OFF);
    if (ISB) { const float* src = lutg + (8 + head) * LUT_STRIDE; for (int i = tid; i < LUT_STRIDE; i += 512) lut[i] = src[i]; if (tid < 128) gt[tid] = subg[tid] * osc; }
    else { const float* src = lutg + (hsel * 4) * LUT_STRIDE; for (int i = tid; i < 4 * LUT_STRIDE; i += 512) lut[i] = src[i]; }
    bf16x8 qr[4];
    { const bf16* qp = zg + (rowbase + qrow0 + r32) * ZG + qcol + hi * 8;
#pragma unroll
      for (int d0 = 0; d0 < 4; ++d0) qr[d0] = *(const bf16x8*)(qp + d0 * 16); }
#define ATT_ISSUE(t, bo) do { const size_t kr_ = rowbase + (size_t)(t) * 64; \
        if (ISB) { _Pragma("unroll") for (int i_ = 0; i_ < 2; ++i_) { const int p_ = wid * 2 + i_; \
            __builtin_amdgcn_global_load_lds((const unsigned*)(zg + (kr_ + lane) * ZG + kcol + (p_ >> 3) * 64 + (p_ & 7) * 8), (ALAS unsigned*)(lds + (bo) + p_ * 1024), 16, 0, 0); \
            __builtin_amdgcn_global_load_lds((const unsigned*)(zg + (kr_ + 16 * (p_ & 3) + (lane >> 2)) * ZG + vcol + 32 * (p_ >> 2) + 8 * (lane & 3)), (ALAS unsigned*)(lds + (bo) + VOFF + p_ * 1024), 16, 0, 0); } } \
        else { \
            __builtin_amdgcn_global_load_lds((const unsigned*)(zg + (kr_ + lane) * ZG + kcol + wid * 8), (ALAS unsigned*)(lds + (bo) + wid * 1024), 16, 0, 0); \
            __builtin_amdgcn_global_load_lds((const unsigned*)(zg + (kr_ + 16 * (wid & 3) + (lane >> 2)) * ZG + vcol + 32 * (wid >> 2) + 8 * (lane & 3)), (ALAS unsigned*)(lds + (bo) + VOFF + wid * 1024), 16, 0, 0); } } while (0)
    float mhat = 0.f, l = 0.f;
    f32x16 o[NDV];
#pragma unroll
    for (int d = 0; d < NDV; ++d)
#pragma unroll
        for (int r = 0; r < 16; ++r) o[d][r] = 0.f;
    const int kfo = (ISB ? map * 8192 : 0) + hi * 1024 + r32 * 16;
    const int vfo = VOFF + ((lane >> 4) & 1) * 32 + (lane & 3) * 8 + (4 * hi + ((lane & 15) >> 2)) * 64;
    ATT_ISSUE(kt0, 0);
#pragma unroll 1
    for (int t = kt0; t < kt1; ++t) {
        const int bo = ((t - kt0) & 1) * BUF;
        asm volatile("s_waitcnt vmcnt(0)" ::: "memory");
        __syncthreads();
        if (t + 1 < kt1) ATT_ISSUE(t + 1, bo ^ BUF);
        const int kb = t * 64;
        bool near = true; float cfar = 0.f;
        if (ISB) { if (kb - qrow0 - 31 >= 91) { near = false; cfar = lut[256 + 128]; } else if (kb + 63 - qrow0 <= -91) { near = false; cfar = lut[256 - 128]; } }
        const float c0 = cfar - mhat;
        f32x16 p0, p1;
#pragma unroll
        for (int r = 0; r < 16; ++r) { p0[r] = c0; p1[r] = c0; }
        {
            ALAS const unsigned char* kp = lds + bo + kfo;
            bf16x8 kf[8];
#pragma unroll
            for (int d0 = 0; d0 < 4; ++d0) { kf[2 * d0] = *(ALAS const bf16x8*)(kp + d0 * 2048); kf[2 * d0 + 1] = *(ALAS const bf16x8*)(kp + d0 * 2048 + 512); }
            __builtin_amdgcn_sched_barrier(0);
#pragma unroll
            for (int d0 = 0; d0 < 4; ++d0) {
                p0 = __builtin_amdgcn_mfma_f32_32x32x16_bf16(kf[2 * d0], qr[d0], p0, 0, 0, 0);
                p1 = __builtin_amdgcn_mfma_f32_32x32x16_bf16(kf[2 * d0 + 1], qr[d0], p1, 0, 0, 0);
            }
        }
        if (near) {
            ALAS const float* lp = lut + gsel * LUT_STRIDE + (kb - (qrow0 + r32) + 256 + 4 * hi);
#pragma unroll
            for (int r = 0; r < 16; ++r) { p0[r] += lp[(r & 3) + 8 * (r >> 2)]; p1[r] += lp[32 + (r & 3) + 8 * (r >> 2)]; }
        }
        float rm;
        { float a = MX3(p0[0], p0[1], p1[0]), c = MX3(p0[2], p0[3], p1[1]); a = MX3(a, p1[2], p1[3]);
#pragma unroll
          for (int r = 4; r < 16; r += 4) { a = MX3(a, p0[r], p0[r + 1]); c = MX3(c, p0[r + 2], p0[r + 3]); a = MX3(a, p1[r], p1[r + 1]); c = MX3(c, p1[r + 2], p1[r + 3]); }
          rm = swap_max(__builtin_fmaxf(a, c)); }
        const bool first = (t == kt0);
        if (first || __any(rm > THR)) {
            const float dl = first ? rm : __builtin_fmaxf(rm, 0.f);
            mhat += dl;
#pragma unroll
            for (int r = 0; r < 16; ++r) { p0[r] -= dl; p1[r] -= dl; }
            if (!first) { const float f = __builtin_amdgcn_exp2f(-dl); l *= f;
#pragma unroll
                for (int d = 0; d < NDV; ++d)
#pragma unroll
                    for (int r = 0; r < 16; ++r) o[d][r] *= f; }
        }
        float sacc = 0.f;
#pragma unroll
        for (int r = 0; r < 16; ++r) { p0[r] = __builtin_amdgcn_exp2f(p0[r]); p1[r] = __builtin_amdgcn_exp2f(p1[r]); sacc += p0[r] + p1[r]; }
        l += sacc;
        u32x4 pw[4];
        pw[0] = (u32x4){cvtpk(p0[0], p0[1]), cvtpk(p0[2], p0[3]), cvtpk(p0[4], p0[5]), cvtpk(p0[6], p0[7])};
        pw[1] = (u32x4){cvtpk(p0[8], p0[9]), cvtpk(p0[10], p0[11]), cvtpk(p0[12], p0[13]), cvtpk(p0[14], p0[15])};
        pw[2] = (u32x4){cvtpk(p1[0], p1[1]), cvtpk(p1[2], p1[3]), cvtpk(p1[4], p1[5]), cvtpk(p1[6], p1[7])};
        pw[3] = (u32x4){cvtpk(p1[8], p1[9]), cvtpk(p1[10], p1[11]), cvtpk(p1[12], p1[13]), cvtpk(p1[14], p1[15])};
        {
            ALAS const unsigned char* vp = lds + bo + vfo;
            s16x4 va[8], vb[8];
#define ATT_LDV(dst, d) do { _Pragma("unroll") for (int ks = 0; ks < 4; ++ks) { dst[2 * ks] = vtr(vp + (d) * 4096 + ks * 1024); dst[2 * ks + 1] = vtr(vp + (d) * 4096 + ks * 1024 + 512); } } while (0)
#define ATT_VF(src, ks) (bf16x8){src[2 * (ks)][0], src[2 * (ks)][1], src[2 * (ks)][2], src[2 * (ks)][3], src[2 * (ks) + 1][0], src[2 * (ks) + 1][1], src[2 * (ks) + 1][2], src[2 * (ks) + 1][3]}
#define ATT_PV(src, d) do { _Pragma("unroll") for (int ks = 0; ks < 4; ++ks) o[d] = __builtin_amdgcn_mfma_f32_32x32x16_bf16(ATT_VF(src, ks), __builtin_bit_cast(bf16x8, pw[ks]), o[d], 0, 0, 0); } while (0)
#define ATT_SB() __builtin_amdgcn_sched_barrier(0)
            ATT_LDV(va, 0); ATT_SB();
            ATT_LDV(vb, 1); ATT_SB();
            ATT_PV(va, 0); ATT_SB();
            if (NDV == 4) {
                ATT_LDV(va, 2); ATT_SB();
                ATT_PV(vb, 1); ATT_SB();
                ATT_LDV(vb, 3); ATT_SB();
                ATT_PV(va, 2); ATT_SB();
                ATT_PV(vb, 3);
            } else {
                ATT_PV(vb, 1);
            }
#undef ATT_LDV
#undef ATT_VF
#undef ATT_PV
#undef ATT_SB
        }
    }
#undef ATT_ISSUE
    l = swap_add(l);
    if (!ISB) l += __builtin_amdgcn_exp2f(sinkp[head] * LOG2E - mhat);
    const float inv = 1.0f / l;
    bf16* orow = odry ? odry + (rowbase + qrow0 + r32) * D + (ISB ? (512 + head * 128) : (head * 64)) : zg + (rowbase + qrow0 + r32) * ZG + (ISB ? (C_QB + head * 128) : (C_QA + head * 64));
    if (ISB) {
        __syncthreads();
        ALAS float* cs = (ALAS float*)lds;
        if (map == 1) { const float sc = -lam * inv;
#pragma unroll
            for (int d = 0; d < NDV; ++d)
#pragma unroll
                for (int r = 0; r < 16; ++r) cs[(qsub * 64 + d * 16 + r) * 64 + lane] = o[d][r] * sc; }
        __syncthreads();
        if (map == 0) {
            float q = 0.f;
#pragma unroll
            for (int d = 0; d < NDV; ++d)
#pragma unroll
                for (int r = 0; r < 16; ++r) { const float v = o[d][r] * inv + cs[(qsub * 64 + d * 16 + r) * 64 + lane]; o[d][r] = v; q += v * v; }
            q = swap_add(q);
            const float rstd = rsqrtf(q * (1.0f / 128.0f) + EPS);
#pragma unroll
            for (int d = 0; d < NDV; ++d)
#pragma unroll
                for (int g4 = 0; g4 < 4; ++g4) { const int dv0 = 32 * d + 8 * g4 + 4 * hi; const f32x4 gv = *(ALAS const f32x4*)(gt + dv0);
                    u32x2 w; w.x = cvtpk(o[d][4 * g4] * rstd * gv[0], o[d][4 * g4 + 1] * rstd * gv[1]); w.y = cvtpk(o[d][4 * g4 + 2] * rstd * gv[2], o[d][4 * g4 + 3] * rstd * gv[3]);
                    *(u32x2*)(orow + dv0) = w; }
        }
    } else {
#pragma unroll
        for (int d = 0; d < NDV; ++d)
#pragma unroll
            for (int g4 = 0; g4 < 4; ++g4) { const int dv0 = 32 * d + 8 * g4 + 4 * hi;
                u32x2 w; w.x = cvtpk(o[d][4 * g4] * inv, o[d][4 * g4 + 1] * inv); w.y = cvtpk(o[d][4 * g4 + 2] * inv, o[d][4 * g4 + 3] * inv);
                *(u32x2*)(orow + dv0) = w; }
    }
    __syncthreads();
}
#undef MX3
}

#ifndef MK_VAR
#define MK_VAR 0
#endif
namespace mk {
using namespace nv;
constexpr int NWAVES = 8;
constexpr size_t MiB = 1u << 20;
constexpr size_t WS_CTL = 0, CTL_ZERO_BYTES = 1 * MiB;
constexpr size_t WS_LUT = 512 * 1024;
constexpr size_t WS_SS = 1 * MiB;
constexpr size_t WS_XB = 6 * MiB;
constexpr size_t WS_ZG = 38 * MiB;
constexpr size_t WS_A = 38 * MiB;
constexpr size_t WS_YB = 126 * MiB;
constexpr size_t WS_MIX = 174 * MiB;
constexpr size_t WS_W = 206 * MiB;
constexpr size_t WL_IN = 0, WL_A = (size_t)ZG * D, WL_B = WL_A + (size_t)D * 512, WL_O = WL_B + (size_t)D * 512, WL_UP = WL_O + (size_t)D * D, WL_DN = WL_UP + (size_t)FF2 * D, WL_END = WL_DN + (size_t)D * FF;
constexpr size_t WS_TMPA = 322 * MiB, WS_TMPB = 344 * MiB;
constexpr size_t WS_END = 352 * MiB;
static_assert(WS_W + 4 * WL_END * 2 <= WS_TMPA && WS_YB + (size_t)64 * 4 * FF2 * 4 <= WS_MIX && WS_A + (size_t)T * FF * 2 <= WS_YB, "d_ws map");
constexpr int CW_BAR = 4096;
constexpr int N_PHASES = 1 + 6 * L;
constexpr int RING_OFF = 0, RING_BYTES = 131072, LDSCTL_OFF = RING_BYTES, MISC_OFF = LDSCTL_OFF + 320;
constexpr int LDS_BYTES = 147456;
static_assert(pg8::XOFF + 8192 <= LDS_BYTES && MISC_OFF + 128 <= pg8::XOFF, "LDS map");

#define GAS __attribute__((address_space(1)))
#define LAS __attribute__((address_space(3)))
typedef unsigned v4u __attribute__((ext_vector_type(4)));
typedef float f32x4 __attribute__((ext_vector_type(4)));
typedef GAS unsigned gu32;
#define RLX_AGENT __ATOMIC_RELAXED, __HIP_MEMORY_SCOPE_AGENT
#define LDS_WAIT() asm volatile("s_waitcnt lgkmcnt(0)" ::: "memory")
#define VM_WAIT() asm volatile("s_waitcnt vmcnt(0)" ::: "memory")
__device__ __forceinline__ unsigned f2bfu(float f) { unsigned u = __builtin_bit_cast(unsigned, f); return (u + 0x7fffu + ((u >> 16) & 1u)) >> 16; }
__device__ __forceinline__ unsigned pk2(float lo, float hi) { return f2bfu(lo) | (f2bfu(hi) << 16); }

#define XB_TMO      128
#define XB_XCNT(j)  (256  + 64 * (j))
#define XB_XSUB(j)  (1280 + 64 * (j))
#define XB_XGEN(j)  (2304 + 64 * (j))
#define XB_TOP      3328
#define XB_TOPGEN   3392
#define XCD_BAR_WORDS 3456
#define XB_SPIN_CAP (1u << 18)

__device__ __forceinline__ unsigned xb_ld(unsigned* p)              { return __hip_atomic_load(p, __ATOMIC_RELAXED, __HIP_MEMORY_SCOPE_AGENT); }
__device__ __forceinline__ unsigned xb_add(unsigned* p, unsigned v) { return __hip_atomic_fetch_add(p, v, __ATOMIC_RELAXED, __HIP_MEMORY_SCOPE_AGENT); }
__device__ __forceinline__ unsigned xb_xcc_id() { return (unsigned)__builtin_amdgcn_s_getreg((3 << 11) | 20) & 0xFu; }
#define XB_SPIN(cond, bar) do { unsigned _sp = 0; while (cond) { __builtin_amdgcn_s_sleep(1); \
    if ((++_sp & 255u) == 0u) { if (xb_ld(&(bar)[XB_TMO])) break; if (_sp > XB_SPIN_CAP) { atomicAdd(&(bar)[XB_TMO], 1u); break; } } } } while (0)

struct XcdBarrier {
    unsigned* bar; unsigned x;
    volatile LAS unsigned* st;
};

__device__ __forceinline__ XcdBarrier xcd_barrier_post(unsigned* bar, volatile LAS unsigned* st) {
    XcdBarrier b; b.bar = bar; b.x = xb_xcc_id(); b.st = st;
    if (threadIdx.x == 0) (void)xb_add(&bar[XB_XCNT(b.x)], 1u);
    return b;
}
__device__ __forceinline__ void xcd_barrier_complete(unsigned* bar, unsigned x, unsigned& nloc, unsigned& nx) {
    const unsigned G = gridDim.x * gridDim.y * gridDim.z;
    unsigned sum, cnt, mine, sp = 0u;
    for (;;) {
        sum = 0u; cnt = 0u; mine = 0u;
#pragma unroll
        for (unsigned j = 0; j < 16; ++j) { const unsigned c = xb_ld(&bar[XB_XCNT(j)]); sum += c; cnt += (c > 0u) ? 1u : 0u; mine = (j == x) ? c : mine; }
        if (sum == G) break;
        __builtin_amdgcn_s_sleep(1);
        if ((++sp & 255u) == 0u) { if (xb_ld(&bar[XB_TMO])) break; if (sp > XB_SPIN_CAP) { atomicAdd(&bar[XB_TMO], 1u); break; } }
    }
    nloc = mine > 0u ? mine : 1u; nx = cnt > 0u ? cnt : 1u;
}

__device__ __forceinline__ void xcd_barrier(const XcdBarrier& b) {
    asm volatile("s_waitcnt vmcnt(0)" ::: "memory");
    __syncthreads();
    if (threadIdx.x == 0) {
        unsigned* bar = b.bar;
        __builtin_amdgcn_s_waitcnt(0);
        unsigned nloc = b.st[0], nx = b.st[1];
        if (nloc == 0u) { xcd_barrier_complete(bar, b.x, nloc, nx); b.st[0] = nloc; b.st[1] = nx; }
        const unsigned old = xb_add(&bar[XB_XSUB(b.x)], 1u);
        const unsigned gen = old / nloc;
        if (old + 1u == (gen + 1u) * nloc) {
            __builtin_amdgcn_fence(__ATOMIC_RELEASE, "agent");
            asm volatile("s_waitcnt vmcnt(0)" ::: "memory");
            const unsigned og = xb_add(&bar[XB_TOP], 1u);
            const unsigned tg = og / nx;
            if (og + 1u == (tg + 1u) * nx) xb_add(&bar[XB_TOPGEN], 1u);
            else XB_SPIN(xb_ld(&bar[XB_TOPGEN]) == tg, bar);
            __builtin_amdgcn_fence(__ATOMIC_ACQUIRE, "agent");
            xb_add(&bar[XB_XGEN(b.x)], 1u);
            asm volatile("s_waitcnt vmcnt(0)" ::: "memory");
        } else {
            XB_SPIN(xb_ld(&bar[XB_XGEN(b.x)]) == gen, bar);
            __builtin_amdgcn_fence(__ATOMIC_ACQUIRE, "agent");
            asm volatile("s_waitcnt vmcnt(0)" ::: "memory");
        }
    }
    __syncthreads();
}


struct Args { const float* in[24]; float* out; unsigned char* ws; int ph_lo, ph_hi, li, pad; };

__device__ __forceinline__ void p0_transpose_item(const float* __restrict__ W, int ldw, int K, int k0, int n0, bf16* __restrict__ WT, int vrow0, const float* __restrict__ gain, LAS float* scr, int lane) {
    float v[32];
    const float* wp = W + (size_t)(k0 + (lane >> 5)) * ldw + n0 + (lane & 31);
#pragma unroll
    for (int i = 0; i < 32; ++i) v[i] = __builtin_nontemporal_load(wp + (size_t)(2 * i) * ldw);
    if (gain) {
#pragma unroll
        for (int i = 0; i < 32; ++i) v[i] *= gain[k0 + 2 * i + (lane >> 5)];
    }
#pragma unroll
    for (int i = 0; i < 32; ++i) scr[(2 * i + (lane >> 5)) * 33 + (lane & 31)] = v[i];
    LDS_WAIT(); asm volatile("" ::: "memory");
    const int c = lane & 7;
#pragma unroll
    for (int j = 0; j < 4; ++j) { const int n = (lane >> 3) + 8 * j; const LAS float* s = scr + (8 * c) * 33 + n;
        v4u o; o.x = pk2(s[0 * 33], s[1 * 33]); o.y = pk2(s[2 * 33], s[3 * 33]); o.z = pk2(s[4 * 33], s[5 * 33]); o.w = pk2(s[6 * 33], s[7 * 33]);
        *(GAS v4u*)(WT + (size_t)(vrow0 + n) * K + k0 + 8 * c) = o; }
    LDS_WAIT(); asm volatile("" ::: "memory");
}
__device__ __forceinline__ int vrow_in(int c) { const int pn = c >> 8, cr = c & 255, wc = cr >> 6, bj = (cr >> 5) & 1; return pn * 256 + bj * 128 + wc * 32; }
__device__ __forceinline__ int vrow_up(int c) { const int gs = c >= FF ? 1 : 0, cc = c - gs * FF, pn = cc >> 7, wc = (cc >> 5) & 3; return pn * 256 + gs * 128 + wc * 32; }

__global__ void __launch_bounds__(NWAVES * 64, 2) skel_fwd(Args args) {
    extern __shared__ __attribute__((aligned(16))) unsigned char lds_raw[];
    LAS unsigned char* lds = (LAS unsigned char*)lds_raw;
    volatile LAS unsigned* MISC = (volatile LAS unsigned*)(lds + MISC_OFF);
    const int G = gridDim.x; int vcu; { const int bx = blockIdx.x; vcu = (G % 8 == 0) ? (bx % 8) * (G / 8) + bx / 8 : bx; }
    unsigned char* ws = args.ws;
    gu32* ctl = (gu32*)(ws + WS_CTL);
    float* ss = (float*)(ws + WS_SS); bf16* xb = (bf16*)(ws + WS_XB); bf16* zg = (bf16*)(ws + WS_ZG); bf16* abuf = (bf16*)(ws + WS_A); float* yb = (float*)(ws + WS_YB);
    bf16* mix = (bf16*)(ws + WS_MIX); bf16* wbase = (bf16*)(ws + WS_W); float* xf = args.out;
    float* lutg = (float*)(ws + WS_LUT);
    for (int u = threadIdx.x; u < (LDS_BYTES - LDSCTL_OFF) / 4; u += NWAVES * 64) ((LAS unsigned*)(lds + LDSCTL_OFF))[u] = 0u;
    __syncthreads();
    XcdBarrier bar = xcd_barrier_post((unsigned*)(ctl + CW_BAR) + args.li * XCD_BAR_WORDS, MISC + 8);

#pragma unroll 1
    for (int ph = args.ph_lo; ph < args.ph_hi; ++ph) {
        const int l = ph > 0 ? (ph - 1) / 6 : 0, p = ph > 0 ? (ph - 1) % 6 + 1 : 0;
        bf16* wl = wbase + (size_t)l * WL_END;
        float* ss1 = ss + (size_t)((2 * l) & 3) * T * 16; float* ss2 = ss + (size_t)((2 * l + 1) & 3) * T * 16; float* ss3 = (l + 1 < L) ? ss + (size_t)((2 * l + 2) & 3) * T * 16 : nullptr;
#ifndef MK_ONLY
#define MK_ONLY 0x7f
#endif
        const int dupp = ((args.pad >> 8) & 0xff) - 1;
#pragma unroll 1
        for (int rep = (p == dupp) ? 0 : 1; rep < 2; ++rep) {
        if (p == 0 && (MK_ONLY & 1)) {
            int tid0 = threadIdx.x; asm volatile("" : "+v"(tid0));
            const int lane0 = tid0 & 63, wave = __builtin_amdgcn_readfirstlane(tid0 >> 6);
            LAS float* scr = (LAS float*)(lds + RING_OFF + wave * 16384);
            const int gw = vcu * NWAVES + wave, NGW = G * NWAVES;
            constexpr int I_IN = (D / 64) * (INW / 32), I_G = (D / 64) * (GW / 32), I_A = (512 / 64) * (D / 32), I_O = (D / 64) * (D / 32), I_UP = (D / 64) * (FF2 / 32), I_DN = (FF / 64) * (D / 32);
            constexpr int I_LAYER = I_IN + I_G + 2 * I_A + I_O + I_UP + I_DN;
            for (int i = gw * 64 + lane0; i < 12 * att::LUT_STRIDE; i += NGW * 64) { const int hh = i / att::LUT_STRIDE, j = i - hh * att::LUT_STRIDE, rel = j - 256, ar = rel < 0 ? -rel : rel;
                float v = 0.f; if (j <= 512) v = (hh < 8 && ar > 128) ? att::NEG : args.in[13][t5_bucket(rel) * 12 + hh] * LOG2E;
                lutg[i] = v; }
            for (int it = gw; it < L * I_LAYER; it += NGW) {
                const int ll = it / I_LAYER; int r = it - ll * I_LAYER; bf16* w = wbase + (size_t)ll * WL_END;
                if (r < I_IN) { const int nb = r % (INW / 32), kb = r / (INW / 32); p0_transpose_item(args.in[2] + (size_t)ll * D * INW, INW, D, 64 * kb, 32 * nb, w + WL_IN, vrow_in(32 * nb), args.in[1] + ll * D, scr, lane0); continue; } r -= I_IN;
                if (r < I_G) { const int nb = r % (GW / 32), kb = r / (GW / 32); p0_transpose_item(args.in[14] + (size_t)ll * D * GW, GW, D, 64 * kb, 32 * nb, w + WL_IN, vrow_in(INW + 32 * nb), args.in[1] + ll * D, scr, lane0); continue; } r -= I_G;
                if (r < I_A) { const int nb = r % (D / 32), kb = r / (D / 32); p0_transpose_item(args.in[16] + (size_t)ll * 512 * D, D, 512, 64 * kb, 32 * nb, w + WL_A, 32 * nb, nullptr, scr, lane0); continue; } r -= I_A;
                if (r < I_A) { const int nb = r % (D / 32), kb = r / (D / 32); p0_transpose_item(args.in[17] + (size_t)ll * 512 * D, D, 512, 64 * kb, 32 * nb, w + WL_B, 32 * nb, nullptr, scr, lane0); continue; } r -= I_A;
                if (r < I_O) { const int nb = r % (D / 32), kb = r / (D / 32); p0_transpose_item(args.in[18] + (size_t)ll * D * D, D, D, 64 * kb, 32 * nb, w + WL_O, 32 * nb, nullptr, scr, lane0); continue; } r -= I_O;
                if (r < I_UP) { const int nb = r % (FF2 / 32), kb = r / (FF2 / 32); p0_transpose_item(args.in[20] + (size_t)ll * D * FF2, FF2, D, 64 * kb, 32 * nb, w + WL_UP, vrow_up(32 * nb), args.in[19] + ll * D, scr, lane0); continue; } r -= I_UP;
                { const int nb = r % (D / 32), kb = r / (D / 32); p0_transpose_item(args.in[23] + (size_t)ll * FF * D, D, FF, 64 * kb, 32 * nb, w + WL_DN, 32 * nb, nullptr, scr, lane0); }
            }
            for (int m = gw; m < T; m += 2 * NGW) {
                const int m2 = m + NGW;
                const GAS f32x4* xr = (const GAS f32x4*)(args.in[0] + (size_t)m * D) + lane0; const GAS f32x4* xr2 = (const GAS f32x4*)(args.in[0] + (size_t)m2 * D) + lane0;
                GAS unsigned long long* o8 = (GAS unsigned long long*)(xb + (size_t)m * D) + lane0; GAS unsigned long long* o82 = (GAS unsigned long long*)(xb + (size_t)m2 * D) + lane0;
                f32x4 va[4], vb[4];
#pragma unroll
                for (int j = 0; j < 4; ++j) { va[j] = xr[64 * j]; vb[j] = xr2[64 * j]; }
                float s = 0.f, s2 = 0.f;
#pragma unroll
                for (int j = 0; j < 4; ++j) { const f32x4 v = va[j], w = vb[j]; s += (v.x * v.x + v.y * v.y) + (v.z * v.z + v.w * v.w); s2 += (w.x * w.x + w.y * w.y) + (w.z * w.z + w.w * w.w);
                    o8[64 * j] = (unsigned long long)pk2(v.x, v.y) | ((unsigned long long)pk2(v.z, v.w) << 32); o82[64 * j] = (unsigned long long)pk2(w.x, w.y) | ((unsigned long long)pk2(w.z, w.w) << 32); }
                s = wave_sum(s); s2 = wave_sum(s2);
                ss16_store(ss, m, s, lane0); ss16_store(ss, m2, s2, lane0);
            }
        } else if (p == 1 && (MK_ONLY & 2)) {
            pg8::SchedStd S; S.init(xb, D, wl + WL_IN, D, T, ZG, G, (int)blockIdx.x);
            pg8::EpiIn E{zg, ss1, args.in[3] + l * 64, args.in[4] + l * 64, args.in[6] + l * 64, args.in[7] + l * 64, args.in[15] + l * GW};
            pg8::gemm_phase<pg8::EpiIn, pg8::SchedStd, true, true>(lds + RING_OFF, D, D, S, E);
        } else if (p == 2 && (MK_ONLY & 4)) {
            const float lam_init = 0.8f - 0.6f * __expf(-0.3f * (float)l);
            int ln = threadIdx.x; asm volatile("" : "+v"(ln)); ln &= 63;
            const float d1 = wave_sum(args.in[8][l * 64 + ln] * args.in[9][l * 64 + ln]), d2 = wave_sum(args.in[10][l * 64 + ln] * args.in[11][l * 64 + ln]);
            const float lam = __expf(d1) - __expf(d2) + lam_init;
            const int dsel = args.pad >> 16;
            if (rep == 1 || dsel != 2)
            for (int ui = vcu; ui < 512; ui += G) { const int bh = ui >> 4, qb = ui & 15; if (rep == 0) att::attn_unit<true, MK_VAR>(lds, zg, lutg, bh >> 2, bh & 3, qb * 128, nullptr, lam, 1.0f - lam_init, args.in[12] + l * 128, mix);
                else att::attn_unit<true, 0>(lds, zg, lutg, bh >> 2, bh & 3, qb * 128, nullptr, lam, 1.0f - lam_init, args.in[12] + l * 128, nullptr); }
            if (rep == 1 || dsel != 1)
            for (int ui = vcu; ui < 512; ui += G) { const int bk = ui >> 5, qb = ui & 31; att::attn_unit<false>(lds, zg, lutg, bk >> 1, bk & 1, qb * 64, args.in[5] + l * HA, 0.f, 0.f, nullptr, rep == 0 ? mix : nullptr); }
        } else if (p == 3 && (MK_ONLY & 8)) {
            pg8::SchedMix S; S.b.init(zg + C_QA, ZG, wl + WL_A, 512, T, D, G, (int)blockIdx.x); S.A1 = (const char*)(zg + C_QB); S.Bt1 = (const char*)(wl + WL_B);
            pg8::EpiMix E{zg, mix};
            pg8::gemm_phase<pg8::EpiMix, pg8::SchedMix, true, true>(lds + RING_OFF, 512, ZG, S, E);
        } else if (p == 4 && (MK_ONLY & 16)) {
            pg8::SchedStd S; S.init(mix, D, wl + WL_O, D, T, D, G, (int)blockIdx.x);
            pg8::EpiRes E{l == 0 ? args.in[0] : xf, xf, xb, ss2};
            pg8::gemm_phase<pg8::EpiRes, pg8::SchedStd, true, true>(lds + RING_OFF, D, D, S, E);
        } else if (p == 5 && (MK_ONLY & 32)) {
            pg8::SchedStd S; S.init(xb, D, wl + WL_UP, D, T, FF2, G, (int)blockIdx.x);
            pg8::EpiUp E{abuf, ss2, args.in[21] + (size_t)l * 3 * FF2, args.in[22] + (size_t)l * FF2, yb};
            pg8::gemm_phase<pg8::EpiUp, pg8::SchedStd, true, true>(lds + RING_OFF, D, D, S, E);
        } else if (MK_ONLY & 64) {
            pg8::SchedDown S; S.b.init(abuf, FF, wl + WL_DN, FF, T, D, G, (int)blockIdx.x); S.yb = (args.pad & 1) ? nullptr : yb; S.cw = args.in[21] + (size_t)l * 3 * FF2; S.cb = args.in[22] + (size_t)l * FF2; S.a = abuf;
            pg8::EpiRes E{xf, xf, ss3 ? xb : nullptr, ss3};
            pg8::gemm_phase<pg8::EpiRes, pg8::SchedDown, true, true>(lds + RING_OFF, FF, FF, S, E);
        }
        }
        if (ph + 1 < args.ph_hi) xcd_barrier(bar);
    }
}
}

#ifndef MK_MODE
#define MK_MODE 0x7f
#endif
extern "C" void kernel_launch(void* const* d_in, const int* in_sizes, int n_in, void* d_out, int out_size, void* d_ws, size_t ws_size, hipStream_t stream) {
    using namespace nv;
    static int grid = 0;
    if (grid == 0) {
        if (n_in != 24 || out_size != T * D || ws_size < mk::WS_END) { fprintf(stderr, "kernel_launch: unexpected shapes (n_in %d, out %d, ws %zu)\n", n_in, out_size, ws_size); grid = -1; return; }
        int dev = 0, cus = 0, per_cu = 0;
        if (hipGetDevice(&dev) != hipSuccess || hipDeviceGetAttribute(&cus, hipDeviceAttributeMultiprocessorCount, dev) != hipSuccess) { grid = -1; return; }
        if (hipFuncSetAttribute((const void*)mk::skel_fwd, hipFuncAttributeMaxDynamicSharedMemorySize, mk::LDS_BYTES) != hipSuccess) { fprintf(stderr, "kernel_launch: hipFuncSetAttribute failed\n"); grid = -1; return; }
        if (hipOccupancyMaxActiveBlocksPerMultiprocessor(&per_cu, (const void*)mk::skel_fwd, mk::NWAVES * 64, mk::LDS_BYTES) != hipSuccess || per_cu < 1) fprintf(stderr, "kernel_launch: occupancy query says %d\n", per_cu);
        (void)hipGetLastError();
        grid = cus;
    }
    if (grid < 0) return;
    const float* in[24]; for (int i = 0; i < 24; ++i) in[i] = (const float*)d_in[i];
    unsigned char* ws = (unsigned char*)d_ws;
    float* xf = (float*)d_out; float* ss = (float*)(ws + mk::WS_SS); bf16* xb = (bf16*)(ws + mk::WS_XB); bf16* zg = (bf16*)(ws + mk::WS_ZG); bf16* abuf = (bf16*)(ws + mk::WS_A);
    bf16* mix = (bf16*)(ws + mk::WS_MIX); float* tmpA = (float*)(ws + mk::WS_TMPA); float* tmpB = (float*)(ws + mk::WS_TMPB);
    if (hipMemsetAsync(ws + mk::WS_CTL, 0, mk::CTL_ZERO_BYTES, stream) != hipSuccess) { fprintf(stderr, "kernel_launch: memset failed\n"); return; }
    mk::Args a{}; for (int i = 0; i < 24; ++i) a.in[i] = in[i]; a.out = xf; a.ws = ws;
    int li = 0;
#define MK_RUN(lo, hi) do { a.ph_lo = (lo); a.ph_hi = (hi); a.li = li++; hipLaunchKernelGGL(mk::skel_fwd, dim3(grid), dim3(mk::NWAVES * 64), mk::LDS_BYTES, stream, a); } while (0)
#ifndef MK_DUP
#define MK_DUP 0
#endif
#define MK_DSEL 0
    if (MK_MODE == 0x7f) { a.pad = (MK_DUP << 8) | (MK_DSEL << 16); MK_RUN(0, mk::N_PHASES); return; }
    MK_RUN(0, 1);
    for (int l = 0; l < L; ++l) {
        const float lam_init = 0.8f - 0.6f * expf(-0.3f * (float)l);
        float* ss1 = ss + (size_t)((2 * l) & 3) * T * 16; float* ss2 = ss + (size_t)((2 * l + 1) & 3) * T * 16; float* ss3 = (l + 1 < L) ? ss + (size_t)((2 * l + 2) & 3) * T * 16 : nullptr;
        const int pb = 1 + 6 * l;
        if (MK_MODE & 2) MK_RUN(pb, pb + 1);
        else for (int b = 0; b < B; ++b) { const int row0 = b * S;
            n_gemm<bf16><<<dim3(INW / 64, S / 64), 256, 0, stream>>>(xb + (size_t)row0 * D, D, in[1] + l * D, in[2] + (size_t)l * D * INW, INW, tmpA, INW, D);
            n_post_in<<<S, 256, 0, stream>>>(tmpA, ss1, in[3] + l * 64, in[4] + l * 64, in[6] + l * 64, in[7] + l * 64, zg, row0);
            n_gemm<bf16><<<dim3(GW / 64, S / 64), 256, 0, stream>>>(xb + (size_t)row0 * D, D, in[1] + l * D, in[14] + (size_t)l * D * GW, GW, tmpA, GW, D);
            n_post_gate<<<S, 256, 0, stream>>>(tmpA, ss1, in[15] + l * GW, zg, row0); }
        if (MK_MODE & 4) MK_RUN(pb + 1, pb + 2);
        else { n_attn_a<<<dim3(T, HA), 64, 0, stream>>>(zg, in[5] + l * HA, in[13]);
               n_attn_b<<<dim3(T, HB), 256, 0, stream>>>(zg, in[13], in[8] + l * 64, in[9] + l * 64, in[10] + l * 64, in[11] + l * 64, in[12] + l * 128, lam_init); }
        if (MK_MODE & 8) MK_RUN(pb + 2, pb + 3);
        else for (int b = 0; b < B; ++b) { const int row0 = b * S;
            n_gemm<bf16><<<dim3(D / 64, S / 64), 256, 0, stream>>>(zg + (size_t)row0 * ZG + C_QA, ZG, nullptr, in[16] + (size_t)l * 512 * D, D, tmpA, D, 512);
            n_gemm<bf16><<<dim3(D / 64, S / 64), 256, 0, stream>>>(zg + (size_t)row0 * ZG + C_QB, ZG, nullptr, in[17] + (size_t)l * 512 * D, D, tmpB, D, 512);
            n_post_mix<<<S, 256, 0, stream>>>(tmpA, tmpB, zg, mix, row0); }
        if (MK_MODE & 16) MK_RUN(pb + 3, pb + 4);
        else for (int b = 0; b < B; ++b) { const int row0 = b * S;
            n_gemm<bf16><<<dim3(D / 64, S / 64), 256, 0, stream>>>(mix + (size_t)row0 * D, D, nullptr, in[18] + (size_t)l * D * D, D, tmpA, D, D);
            n_post_res<<<S, 256, 0, stream>>>(tmpA, xf, xb, ss2, row0); }
        if ((MK_MODE & 32) && (MK_MODE & 64)) { MK_RUN(pb + 4, pb + 6); }
        else {
            for (int b = 0; b < B; ++b) { const int row0 = b * S;
                for (int hf = 0; hf < 2; ++hf) { const int j0 = hf * HW;
                    n_gemm<bf16><<<dim3(HW / 64, S / 64), 256, 0, stream>>>(xb + (size_t)row0 * D, D, in[19] + l * D, in[20] + (size_t)l * D * FF2 + j0, FF2, tmpA, 2 * HW, D);
                    n_gemm<bf16><<<dim3(HW / 64, S / 64), 256, 0, stream>>>(xb + (size_t)row0 * D, D, in[19] + l * D, in[20] + (size_t)l * D * FF2 + FF + j0, FF2, tmpA + HW, 2 * HW, D);
                    n_post_conv<<<S, 256, 0, stream>>>(tmpA, ss2, in[21] + (size_t)l * 3 * FF2, in[22] + (size_t)l * FF2, abuf, row0, j0); } }
            if (MK_MODE & 64) { a.pad = 1; MK_RUN(pb + 5, pb + 6); a.pad = 0; }
            else for (int b = 0; b < B; ++b) { const int row0 = b * S;
                n_gemm<bf16><<<dim3(D / 64, S / 64), 256, 0, stream>>>(abuf + (size_t)row0 * FF, FF, nullptr, in[23] + (size_t)l * FF * D, D, tmpA, D, FF);
                n_post_res<<<S, 256, 0, stream>>>(tmpA, xf, xb, ss3, row0); }
        }
    }
}
```

```cpp
#include <hip/hip_runtime.h>
#include <cstdio>
#include <cstdint>
#include <cmath>
#define MK_EDUP 0

namespace nv {
typedef unsigned short bf16;
constexpr int D = 1024, B = 8, S = 2048, T = B * S, L = 4;
constexpr int HA = 8, KVA = 2, HB = 4, HD = 64;
constexpr int INW = 2304, GW = 2048, ZG = INW + GW;
constexpr int FF = 2816, FF2 = 2 * FF;
constexpr int C_QA = 0, C_KA = 512, C_VA = 640, C_QB = 768, C_KB = 1280, C_VB = 1792, C_G = 2304;
constexpr float EPS = 1e-6f;
constexpr float LOG2E = 1.4426950408889634f;
constexpr float C2 = 0.125f * LOG2E;

__device__ __forceinline__ float bf2f(bf16 v) { return __uint_as_float(((unsigned)v) << 16); }
__device__ __forceinline__ bf16 f2bf(float f) { unsigned u = __float_as_uint(f); return (bf16)((u + 0x7fffu + ((u >> 16) & 1u)) >> 16); }
__device__ __forceinline__ float ldf(const float* p) { return *p; }
__device__ __forceinline__ float ldf(const bf16* p) { return bf2f(*p); }

__device__ __forceinline__ int t5_bucket(int rel) {
    const int n = rel < 0 ? -rel : rel; int v;
    if (n < 8) v = n; else if (n < 12) v = 8; else if (n < 16) v = 9; else if (n < 23) v = 10; else if (n < 32) v = 11;
    else if (n < 46) v = 12; else if (n < 64) v = 13; else if (n < 91) v = 14; else v = 15;
    return (rel > 0 ? 16 : 0) + v;
}
__device__ __forceinline__ float ss16(const float* ss, int t) { const float4* p = (const float4*)(ss + (size_t)t * 16); const float4 a = p[0], b = p[1], c = p[2], d = p[3];
    return ((a.x + a.y) + (a.z + a.w)) + ((b.x + b.y) + (b.z + b.w)) + ((c.x + c.y) + (c.z + c.w)) + ((d.x + d.y) + (d.z + d.w)); }
__device__ __forceinline__ void ss16_store(float* ss, int t, float s, int lane) { if (lane < 16) ss[(size_t)t * 16 + lane] = lane == 0 ? s : 0.f; }
__device__ __forceinline__ float wave_sum(float v) {
#pragma unroll
    for (int o = 1; o < 64; o <<= 1) v += __shfl_xor(v, o);
    return v;
}
__device__ __forceinline__ float wave_max(float v) {
#pragma unroll
    for (int o = 1; o < 64; o <<= 1) v = fmaxf(v, __shfl_xor(v, o));
    return v;
}

template <typename TA>
__global__ void __launch_bounds__(256) n_gemm(const TA* __restrict__ A, int lda, const float* __restrict__ gk, const float* __restrict__ W, int ldw, float* __restrict__ C, int ldc, int K) {
    __shared__ float As[16][68];
    __shared__ float Ws[16][64];
    const int tid = threadIdx.x, tx = tid & 15, ty = tid >> 4;
    const int m0 = blockIdx.y * 64, n0 = blockIdx.x * 64;
    float acc[4][4];
#pragma unroll
    for (int i = 0; i < 4; ++i)
#pragma unroll
        for (int j = 0; j < 4; ++j) acc[i][j] = 0.f;
    for (int k0 = 0; k0 < K; k0 += 16) {
#pragma unroll
        for (int i = 0; i < 4; ++i) { const int e = tid + i * 256, r = e >> 4, c = e & 15; float v = ldf(A + (size_t)(m0 + r) * lda + k0 + c); if (gk) v *= gk[k0 + c]; As[c][r] = v; }
#pragma unroll
        for (int i = 0; i < 4; ++i) { const int e = tid + i * 256, r = e >> 6, c = e & 63; Ws[r][c] = W[(size_t)(k0 + r) * ldw + n0 + c]; }
        __syncthreads();
#pragma unroll
        for (int kk = 0; kk < 16; ++kk) {
            float a[4], b[4];
#pragma unroll
            for (int i = 0; i < 4; ++i) { a[i] = As[kk][ty * 4 + i]; b[i] = Ws[kk][tx * 4 + i]; }
#pragma unroll
            for (int i = 0; i < 4; ++i)
#pragma unroll
                for (int j = 0; j < 4; ++j) acc[i][j] += a[i] * b[j];
        }
        __syncthreads();
    }
#pragma unroll
    for (int i = 0; i < 4; ++i)
#pragma unroll
        for (int j = 0; j < 4; ++j) C[(size_t)(m0 + ty * 4 + i) * ldc + n0 + tx * 4 + j] = acc[i][j];
}

__global__ void __launch_bounds__(256) n_init_x(const float* __restrict__ x, float* __restrict__ xf, bf16* __restrict__ xb, float* __restrict__ ss) {
    const int row = blockIdx.x * 4 + (threadIdx.x >> 6), lane = threadIdx.x & 63;
    float s = 0.f;
    for (int c = lane; c < D; c += 64) { const float v = x[(size_t)row * D + c]; xf[(size_t)row * D + c] = v; xb[(size_t)row * D + c] = f2bf(v); s += v * v; }
    s = wave_sum(s);
    ss16_store(ss, row, s, lane);
}

__global__ void __launch_bounds__(256) n_post_in(const float* __restrict__ Z, const float* __restrict__ ss, const float* __restrict__ qn_a, const float* __restrict__ kn_a,
                                                 const float* __restrict__ qn_b, const float* __restrict__ kn_b, bf16* __restrict__ zg, int row0) {
    const int r = blockIdx.x, t = row0 + r, wave = threadIdx.x >> 6, lane = threadIdx.x & 63;
    const float rs = rsqrtf(ss16(ss, t) * (1.0f / D) + EPS);
    for (int g = wave; g < INW / 64; g += 4) {
        float v = Z[(size_t)r * INW + g * 64 + lane] * rs;
        const float* gain = nullptr; float sc = 1.f;
        if (g < 8) { gain = qn_a; sc = C2; } else if (g < 10) { gain = kn_a; } else if (g < 12) { } else if (g < 20) { gain = qn_b; sc = C2; } else if (g < 28) { gain = kn_b; }
        if (gain) { const float q = wave_sum(v * v); v = v * rsqrtf(q * (1.0f / 64.0f) + EPS) * gain[lane] * sc; }
        zg[(size_t)t * ZG + g * 64 + lane] = f2bf(v);
    }
}
__global__ void __launch_bounds__(256) n_post_gate(const float* __restrict__ G, const float* __restrict__ ss, const float* __restrict__ bg, bf16* __restrict__ zg, int row0) {
    const int r = blockIdx.x, t = row0 + r;
    const float rs = rsqrtf(ss16(ss, t) * (1.0f / D) + EPS);
    for (int c = threadIdx.x; c < GW; c += 256) { const float v = G[(size_t)r * GW + c] * rs + bg[c]; zg[(size_t)t * ZG + C_G + c] = f2bf(1.0f / (1.0f + __expf(-v))); }
}

__global__ void __launch_bounds__(64) n_attn_a(bf16* __restrict__ zg, const float* __restrict__ sink, const float* __restrict__ rel_bias) {
    __shared__ float qs[64]; __shared__ float ps[5 * 64];
    const int t = blockIdx.x, h = blockIdx.y, lane = threadIdx.x, b = t / S, s = t % S, kv = h >> 2;
    qs[lane] = bf2f(zg[(size_t)t * ZG + C_QA + h * 64 + lane]);
    __syncthreads();
    const int j0 = s - 128;
    float sc[5]; float m = sink[h] * LOG2E;
#pragma unroll
    for (int i = 0; i < 5; ++i) {
        const int jj = i * 64 + lane, j = j0 + jj; float v = -1e30f;
        if (jj <= 256 && j >= 0 && j < S) {
            const bf16* kp = zg + (size_t)(b * S + j) * ZG + C_KA + kv * 64; float d = 0.f;
            for (int e = 0; e < 64; ++e) d += qs[e] * bf2f(kp[e]);
            v = d + rel_bias[t5_bucket(j - s) * 12 + h] * LOG2E;
        }
        sc[i] = v; m = fmaxf(m, v);
    }
    m = wave_max(m);
    float l = 0.f;
#pragma unroll
    for (int i = 0; i < 5; ++i) { const float p = (sc[i] > -1e29f) ? exp2f(sc[i] - m) : 0.f; ps[i * 64 + lane] = p; l += p; }
    l = wave_sum(l) + exp2f(sink[h] * LOG2E - m);
    __syncthreads();
    float o = 0.f;
    for (int jj = 0; jj <= 256; ++jj) { const int j = j0 + jj; if (j >= 0 && j < S) o += ps[jj] * bf2f(zg[(size_t)(b * S + j) * ZG + C_VA + kv * 64 + lane]); }
    zg[(size_t)t * ZG + C_QA + h * 64 + lane] = f2bf(o / l);
}

__global__ void __launch_bounds__(256) n_attn_b(bf16* __restrict__ zg, const float* __restrict__ rel_bias, const float* __restrict__ lq1, const float* __restrict__ lk1,
                                               const float* __restrict__ lq2, const float* __restrict__ lk2, const float* __restrict__ subg, float lam_init) {
    __shared__ float qs[128]; __shared__ float av[S]; __shared__ float s1s[S]; __shared__ float red[8]; __shared__ float osum[256];
    const int t = blockIdx.x, h = blockIdx.y, tid = threadIdx.x, lane = tid & 63, wave = tid >> 6, b = t / S, s = t % S;
    if (tid < 128) qs[tid] = bf2f(zg[(size_t)t * ZG + C_QB + h * 128 + tid]);
    float d1 = wave_sum(lq1[lane] * lk1[lane]), d2 = wave_sum(lq2[lane] * lk2[lane]);
    const float lam = __expf(d1) - __expf(d2) + lam_init;
    __syncthreads();
    float m0 = -1e30f, m1 = -1e30f;
#pragma unroll 1
    for (int i = 0; i < 8; ++i) {
        const int j = i * 256 + tid; const bf16* kp = zg + (size_t)(b * S + j) * ZG + C_KB + h * 128; float a0 = 0.f, a1 = 0.f;
#pragma unroll 8
        for (int e = 0; e < 64; ++e) { a0 += qs[e] * bf2f(kp[e]); a1 += qs[64 + e] * bf2f(kp[64 + e]); }
        const float bi = rel_bias[t5_bucket(j - s) * 12 + 8 + h] * LOG2E;
        a0 += bi; a1 += bi; av[j] = a0; s1s[j] = a1; m0 = fmaxf(m0, a0); m1 = fmaxf(m1, a1);
    }
    m0 = wave_max(m0); m1 = wave_max(m1);
    if (lane == 0) { red[wave] = m0; red[4 + wave] = m1; }
    __syncthreads();
    m0 = fmaxf(fmaxf(red[0], red[1]), fmaxf(red[2], red[3])); m1 = fmaxf(fmaxf(red[4], red[5]), fmaxf(red[6], red[7]));
    __syncthreads();
    float l0 = 0.f, l1 = 0.f;
#pragma unroll 1
    for (int i = 0; i < 8; ++i) { const int j = i * 256 + tid; const float p0 = exp2f(av[j] - m0), p1 = exp2f(s1s[j] - m1); av[j] = p0; s1s[j] = p1; l0 += p0; l1 += p1; }
    l0 = wave_sum(l0); l1 = wave_sum(l1);
    if (lane == 0) { red[wave] = l0; red[4 + wave] = l1; }
    __syncthreads();
    l0 = (red[0] + red[1]) + (red[2] + red[3]); l1 = (red[4] + red[5]) + (red[6] + red[7]);
#pragma unroll 1
    for (int i = 0; i < 8; ++i) { const int j = i * 256 + tid; av[j] = av[j] / l0 - lam * (s1s[j] / l1); }
    __syncthreads();
    const int e = tid & 127, half = tid >> 7; float o = 0.f;
    for (int j = half * 1024; j < half * 1024 + 1024; ++j) o += av[j] * bf2f(zg[(size_t)(b * S + j) * ZG + C_VB + h * 128 + e]);
    osum[tid] = o;
    __syncthreads();
    float ov = 0.f, q = 0.f;
    if (tid < 128) { ov = osum[tid] + osum[tid + 128]; q = ov * ov; }
    q = wave_sum(q);
    __syncthreads();
    if (lane == 0) red[wave] = q;
    __syncthreads();
    const float qq = red[0] + red[1];
    if (tid < 128) zg[(size_t)t * ZG + C_QB + h * 128 + tid] = f2bf(ov * rsqrtf(qq * (1.0f / 128.0f) + EPS) * subg[tid] * (1.0f - lam_init));
}

__global__ void __launch_bounds__(256) n_post_mix(const float* __restrict__ PA, const float* __restrict__ PB, const bf16* __restrict__ zg, bf16* __restrict__ mix, int row0) {
    const int r = blockIdx.x, t = row0 + r;
    for (int c = threadIdx.x; c < D; c += 256) {
        const float ga = bf2f(zg[(size_t)t * ZG + C_G + c]), gb = bf2f(zg[(size_t)t * ZG + C_G + D + c]);
        mix[(size_t)t * D + c] = f2bf(ga * PA[(size_t)r * D + c] + gb * PB[(size_t)r * D + c]);
    }
}
__global__ void __launch_bounds__(256) n_post_res(const float* __restrict__ tmp, float* __restrict__ xf, bf16* __restrict__ xb, float* __restrict__ ss_out, int row0) {
    __shared__ float red[4];
    const int r = blockIdx.x, t = row0 + r, lane = threadIdx.x & 63, wave = threadIdx.x >> 6; float s = 0.f;
    for (int c = threadIdx.x; c < D; c += 256) { const float v = xf[(size_t)t * D + c] + tmp[(size_t)r * D + c]; xf[(size_t)t * D + c] = v; xb[(size_t)t * D + c] = f2bf(v); s += v * v; }
    s = wave_sum(s); if (lane == 0) red[wave] = s;
    __syncthreads();
    if (ss_out) ss16_store(ss_out, t, (red[0] + red[1]) + (red[2] + red[3]), threadIdx.x);
}
constexpr int HW = FF / 2;
__global__ void __launch_bounds__(256) n_post_conv(const float* __restrict__ U, const float* __restrict__ ss, const float* __restrict__ cw, const float* __restrict__ cb, bf16* __restrict__ a, int row0, int j0) {
    const int r = blockIdx.x, t = row0 + r;
    const float rs1 = rsqrtf(ss16(ss, t) * (1.0f / D) + EPS);
    const float rs0 = r > 0 ? rsqrtf(ss16(ss, t - 1) * (1.0f / D) + EPS) : 0.f;
    const float rs2 = r < S - 1 ? rsqrtf(ss16(ss, t + 1) * (1.0f / D) + EPS) : 0.f;
    for (int j = threadIdx.x; j < HW; j += 256) {
        float u[2];
#pragma unroll
        for (int gsel = 0; gsel < 2; ++gsel) {
            const int col = gsel * FF + j0 + j, uc = gsel * HW + j;
            const float y1 = U[(size_t)r * (2 * HW) + uc] * rs1;
            const float y0 = r > 0 ? U[(size_t)(r - 1) * (2 * HW) + uc] * rs0 : 0.f;
            const float y2 = r < S - 1 ? U[(size_t)(r + 1) * (2 * HW) + uc] * rs2 : 0.f;
            u[gsel] = cb[col] + cw[col] * y0 + cw[FF2 + col] * y1 + cw[2 * FF2 + col] * y2;
        }
        const float sg = u[1] / (1.0f + __expf(-u[1]));
        a[(size_t)t * FF + j0 + j] = f2bf(sg * u[0]);
    }
}
__global__ void __launch_bounds__(256) n_rowss(const float* __restrict__ xf, float* __restrict__ ss_out) {
    const int row = blockIdx.x * 4 + (threadIdx.x >> 6), lane = threadIdx.x & 63; float s = 0.f;
    for (int c = lane; c < D; c += 64) { const float v = xf[(size_t)row * D + c]; s += v * v; }
    s = wave_sum(s); ss16_store(ss_out, row, s, lane);
}
}


namespace pg8 {
using namespace nv;
#define PG8_LAS __attribute__((address_space(3)))
typedef unsigned short bf16_t;
typedef short bf16x8 __attribute__((ext_vector_type(8)));
typedef float f32x4 __attribute__((ext_vector_type(4)));
typedef unsigned u32x4 __attribute__((ext_vector_type(4)));
typedef unsigned u32x2 __attribute__((ext_vector_type(2)));
constexpr int BM = 256, BK = 64, HALF = 128, HTB = HALF * BK * 2  , STAGE_BYTES = 8 * HTB, NXCD = 8, WGM = 8;
constexpr int XOFF = 131072 + 1024;

__host__ __device__ __forceinline__ int lds_byte(int r, int c) { const int st = (r >> 4) * 2 + (c >> 5), rr = r & 15, cc = c & 31, ob = rr * 64 + cc * 2; return st * 1024 + (ob ^ (((ob >> 9) & 1) << 5)); }
__host__ __device__ __forceinline__ void stage_rc(int b, int& R, int& C) { const int st = b / 1024, sb = b % 1024, swz = sb ^ (((sb >> 9) & 1) << 5); R = (st >> 1) * 16 + swz / 64; C = (st & 1) * 32 + (swz % 64) / 2; }
__host__ __device__ __forceinline__ int perm32(int rho) { const int n = rho >> 4, i = rho & 15; return 8 * (i >> 2) + 4 * n + (i & 3); }

struct Unit { int pm, pn, z; };
typedef float f32x2 __attribute__((ext_vector_type(2))); typedef __bf16 bf16x2_t __attribute__((ext_vector_type(2)));
__device__ __forceinline__ unsigned cvt_pk_bf16(float lo, float hi) { f32x2 v = {lo, hi}; bf16x2_t b = __builtin_convertvector(v, bf16x2_t); return __builtin_bit_cast(unsigned, b); }
__device__ __forceinline__ float bflo(unsigned w) { return __uint_as_float(w << 16); }
__device__ __forceinline__ float bfhi(unsigned w) { return __uint_as_float(w & 0xffff0000u); }

struct SchedStd {
    int nM, nN, nwg, G, c, fix; const char* A; const char* Bt; size_t at, bt;
    __device__ void init(const void* A_, int lda, const void* Bt_, int K, int M, int N, int G_, int c_) { fix = 0; nM = M / BM; nN = N / BM; nwg = nM * nN; G = G_; c = c_; A = (const char*)A_; Bt = (const char*)Bt_; at = (size_t)BM * lda * 2; bt = (size_t)BM * K * 2; }
    __device__ bool next(int i, Unit& u) const {
        const long L = (long)i * G + c; if (L >= nwg) return false;
        int wgid = (int)L; { const int q = nwg / NXCD, r = nwg % NXCD, xcd = wgid % NXCD, off = wgid / NXCD; wgid = (xcd < r ? xcd * (q + 1) : r * (q + 1) + (xcd - r) * q) + off; }
        const int nig = WGM * nN, gid = wgid / nig, fm = gid * WGM, gsz = (nM - fm) < WGM ? (nM - fm) : WGM;
        u.pm = fm + ((wgid % nig) % gsz); u.pn = (wgid % nig) / gsz; u.z = 0; if (fix) { u.pm = 0; u.pn = 0; } return true;
    }
    __device__ __forceinline__ const char* aptr(const Unit& u) const { return A + (size_t)u.pm * at; }
    __device__ __forceinline__ const char* bptr(const Unit& u) const { return Bt + (size_t)u.pn * bt; }
    __device__ __forceinline__ void a_ready(const Unit&) const {}
    __device__ __forceinline__ void done(const Unit&) const {}
};
struct SchedMix {
    SchedStd b; const char* A1; const char* Bt1;
    __device__ bool next(int i, Unit& u) const { if (!b.next(i >> 1, u)) return false; u.z = i & 1; return true; }
    __device__ __forceinline__ const char* aptr(const Unit& u) const { return (u.z ? A1 : b.A) + (size_t)u.pm * b.at; }
    __device__ __forceinline__ const char* bptr(const Unit& u) const { return (u.z ? Bt1 : b.Bt) + (size_t)u.pn * b.bt; }
    __device__ __forceinline__ void a_ready(const Unit&) const {}
    __device__ __forceinline__ void done(const Unit&) const {}
};
struct SchedDown {
    SchedStd b; const float* yb; const float* cw; const float* cb; bf16_t* a;
    __device__ bool next(int i, Unit& u) const { return b.next(i, u); }
    __device__ __forceinline__ const char* aptr(const Unit& u) const { return b.aptr(u); }
    __device__ __forceinline__ const char* bptr(const Unit& u) const { return b.bptr(u); }
    __device__ __forceinline__ void a_ready(const Unit& u) const {
        const int pm = u.pm;
        if (yb)
        for (int idx = threadIdx.x; idx < 2 * FF; idx += 512) {
            const int which = idx >= FF ? 1 : 0, j = idx - which * FF;
            float uv[2];
#pragma unroll
            for (int gs = 0; gs < 2; ++gs) {
                const int col = gs * FF + j; float y0, y1, y2;
                if (which == 0) { y0 = (pm & 7) ? yb[((size_t)(pm - 1) * 4 + 3) * FF2 + col] : 0.f; y1 = yb[((size_t)pm * 4 + 0) * FF2 + col]; y2 = yb[((size_t)pm * 4 + 1) * FF2 + col]; }
                else { y0 = yb[((size_t)pm * 4 + 2) * FF2 + col]; y1 = yb[((size_t)pm * 4 + 3) * FF2 + col]; y2 = ((pm & 7) != 7) ? yb[((size_t)(pm + 1) * 4 + 0) * FF2 + col] : 0.f; }
                uv[gs] = cb[col] + cw[col] * y0 + cw[FF2 + col] * y1 + cw[2 * FF2 + col] * y2;
            }
            const float sg = uv[1] * __builtin_amdgcn_rcpf(1.0f + __builtin_amdgcn_exp2f(-uv[1] * LOG2E));
            a[(size_t)(pm * BM + which * 255) * FF + j] = f2bf(sg * uv[0]);
        }
        asm volatile("s_waitcnt vmcnt(0)" ::: "memory");
        __builtin_amdgcn_s_barrier();
        asm volatile("" ::: "memory");
    }
    __device__ __forceinline__ void done(const Unit&) const {}
};

struct EpiIn {
    static constexpr bool PERM = true, AFTER_DRAIN = false;
    __device__ static constexpr bool zero_after(const Unit&) { return true; }
    bf16_t* zg; const float* ss; const float *qn_a, *kn_a, *qn_b, *kn_b, *bg; int dup;
    __device__ __forceinline__ void operator()(f32x4 (&acc)[2][2][4][2], const Unit& u, int wr, int wc, int fr, int fq, PG8_LAS unsigned char*) const {
#pragma unroll
        for (int rep_ = 0; rep_ <= ((MK_EDUP & 2) ? 1 : 0); ++rep_) {
        if (rep_) {
#pragma unroll
            for (int ai = 0; ai < 2; ++ai)
#pragma unroll
                for (int bj = 0; bj < 2; ++bj)
#pragma unroll
                    for (int m = 0; m < 4; ++m)
#pragma unroll
                        for (int n = 0; n < 2; ++n) asm volatile("" : "+v"(acc[ai][bj][m][n]) :: "memory");
        }
        const int g = u.pn * 4 + wc, colb = u.pn * BM + wc * 64 + 8 * fq;
        const float* gain = nullptr; float sc = 1.f; int mode = 0;
        if (g < 8) { gain = qn_a; sc = C2; mode = 1; } else if (g < 10) { gain = kn_a; mode = 1; } else if (g < 12) { mode = 0; } else if (g < 20) { gain = qn_b; sc = C2; mode = 1; }
        else if (g < 28) { gain = kn_b; mode = 1; } else if (g < 36) { mode = 0; } else { mode = 2; }
        f32x4 gv[2][2];
#pragma unroll
        for (int bj = 0; bj < 2; ++bj)
#pragma unroll
            for (int n = 0; n < 2; ++n) {
                if (mode == 1) gv[bj][n] = *(const f32x4*)(gain + 32 * bj + 8 * fq + 4 * n) * sc;
                else if (mode == 2) gv[bj][n] = *(const f32x4*)(bg + (colb - C_G) + 32 * bj + 4 * n);
                else gv[bj][n] = (f32x4){1.f, 1.f, 1.f, 1.f};
            }
#pragma unroll
        for (int ai = 0; ai < 2; ++ai)
#pragma unroll
            for (int m = 0; m < 4; ++m) {
                const int row = u.pm * BM + ai * HALF + wr * 64 + m * 16 + fr;
                const float rs = rsqrtf(ss16(ss, row) * (1.0f / D) + EPS);
                f32x4 v[2][2];
#pragma unroll
                for (int bj = 0; bj < 2; ++bj)
#pragma unroll
                    for (int n = 0; n < 2; ++n) v[bj][n] = acc[ai][bj][m][n] * rs;
                if (mode == 1) {
                    float q = 0.f;
#pragma unroll
                    for (int bj = 0; bj < 2; ++bj)
#pragma unroll
                        for (int n = 0; n < 2; ++n) { const f32x4 x = v[bj][n]; q += (x[0] * x[0] + x[1] * x[1]) + (x[2] * x[2] + x[3] * x[3]); }
                    q += __shfl_xor(q, 16); q += __shfl_xor(q, 32);
                    const float r2 = rsqrtf(q * (1.0f / 64.0f) + EPS);
#pragma unroll
                    for (int bj = 0; bj < 2; ++bj)
#pragma unroll
                        for (int n = 0; n < 2; ++n) v[bj][n] = v[bj][n] * r2 * gv[bj][n];
                } else if (mode == 2) {
#pragma unroll
                    for (int bj = 0; bj < 2; ++bj)
#pragma unroll
                        for (int n = 0; n < 2; ++n) { f32x4 x = v[bj][n] + gv[bj][n];
#pragma unroll
                            for (int e = 0; e < 4; ++e) x[e] = __builtin_amdgcn_rcpf(1.0f + __builtin_amdgcn_exp2f(-x[e] * LOG2E));
                            v[bj][n] = x; }
                }
                bf16_t* rowp = zg + (size_t)row * ZG + colb;
#pragma unroll
                for (int bj = 0; bj < 2; ++bj) { u32x4 w; w.x = cvt_pk_bf16(v[bj][0][0], v[bj][0][1]); w.y = cvt_pk_bf16(v[bj][0][2], v[bj][0][3]); w.z = cvt_pk_bf16(v[bj][1][0], v[bj][1][1]); w.w = cvt_pk_bf16(v[bj][1][2], v[bj][1][3]);
                    *(u32x4*)(rowp + 32 * bj) = w; }
            }
        }
    }
};
struct EpiMix {
    static constexpr bool PERM = true, AFTER_DRAIN = false;
    __device__ static bool zero_after(const Unit& u) { return u.z != 0; }
    const bf16_t* zg; bf16_t* mix;
    __device__ __forceinline__ void operator()(f32x4 (&acc)[2][2][4][2], const Unit& u, int wr, int wc, int fr, int fq, PG8_LAS unsigned char*) const {
        const int col0 = u.pn * BM + wc * 32 + 8 * fq;
#pragma unroll
        for (int ai = 0; ai < 2; ++ai)
#pragma unroll
            for (int m = 0; m < 4; ++m) {
                const int row = u.pm * BM + ai * HALF + wr * 64 + m * 16 + fr;
#pragma unroll
                for (int bj = 0; bj < 2; ++bj) {
                    const int col = col0 + bj * HALF;
                    const u32x4 gb = *(const u32x4*)(zg + (size_t)row * ZG + C_G + D + col);
                    if (u.z == 0) {
                        const u32x4 ga = *(const u32x4*)(zg + (size_t)row * ZG + C_G + col);
                        f32x4 r0, r1;
                        r0[0] = bflo(ga.x) * __builtin_amdgcn_rcpf(bflo(gb.x)); r0[1] = bfhi(ga.x) * __builtin_amdgcn_rcpf(bfhi(gb.x)); r0[2] = bflo(ga.y) * __builtin_amdgcn_rcpf(bflo(gb.y)); r0[3] = bfhi(ga.y) * __builtin_amdgcn_rcpf(bfhi(gb.y));
                        r1[0] = bflo(ga.z) * __builtin_amdgcn_rcpf(bflo(gb.z)); r1[1] = bfhi(ga.z) * __builtin_amdgcn_rcpf(bfhi(gb.z)); r1[2] = bflo(ga.w) * __builtin_amdgcn_rcpf(bflo(gb.w)); r1[3] = bfhi(ga.w) * __builtin_amdgcn_rcpf(bfhi(gb.w));
                        acc[ai][bj][m][0] *= r0; acc[ai][bj][m][1] *= r1;
                    } else {
                        const f32x4 v0 = acc[ai][bj][m][0] * (f32x4){bflo(gb.x), bfhi(gb.x), bflo(gb.y), bfhi(gb.y)}, v1 = acc[ai][bj][m][1] * (f32x4){bflo(gb.z), bfhi(gb.z), bflo(gb.w), bfhi(gb.w)};
                        u32x4 w; w.x = cvt_pk_bf16(v0[0], v0[1]); w.y = cvt_pk_bf16(v0[2], v0[3]); w.z = cvt_pk_bf16(v1[0], v1[1]); w.w = cvt_pk_bf16(v1[2], v1[3]);
                        *(u32x4*)(mix + (size_t)row * D + col) = w;
                    }
                }
            }
    }
};
struct EpiRes {
    static constexpr bool PERM = false, AFTER_DRAIN = false;
    __device__ static constexpr bool zero_after(const Unit&) { return true; }
    const float* base; float* xf; bf16_t* xb; float* ssn;
    __device__ __forceinline__ void operator()(f32x4 (&acc)[2][2][4][2], const Unit& u, int wr, int wc, int fr, int fq, PG8_LAS unsigned char*) const {
        const int col0 = u.pn * BM + wc * 32 + 4 * fq;
#pragma unroll
        for (int ai = 0; ai < 2; ++ai)
#pragma unroll
            for (int m = 0; m < 4; ++m) {
                const int row = u.pm * BM + ai * HALF + wr * 64 + m * 16 + fr; const size_t off = (size_t)row * D + col0; float q = 0.f;
#pragma unroll
                for (int bj = 0; bj < 2; ++bj)
#pragma unroll
                    for (int n = 0; n < 2; ++n) { const f32x4 bs = *(const f32x4*)(base + off + bj * HALF + n * 16); const f32x4 o = bs + acc[ai][bj][m][n];
                        *(f32x4*)(xf + off + bj * HALF + n * 16) = o; q += (o[0] * o[0] + o[1] * o[1]) + (o[2] * o[2] + o[3] * o[3]);
                        if (xb) { u32x2 w; w.x = cvt_pk_bf16(o[0], o[1]); w.y = cvt_pk_bf16(o[2], o[3]); *(u32x2*)(xb + off + bj * HALF + n * 16) = w; } }
                if (ssn) { q += __shfl_xor(q, 16); q += __shfl_xor(q, 32); if (fq == 0) ssn[(size_t)row * 16 + u.pn * 4 + wc] = q; }
                if (m & 1) asm volatile("" ::: "memory");
            }
    }
};
#define DPPF(oldv, src, ctrl, bc) __int_as_float(__builtin_amdgcn_update_dpp(__float_as_int(oldv), __float_as_int(src), (ctrl), 0xF, 0xF, (bc)))
struct EpiUp {
    static constexpr bool PERM = true, AFTER_DRAIN = false;
    __device__ static constexpr bool zero_after(const Unit&) { return true; }
    bf16_t* a; const float* ss; const float* cw; const float* cb; float* yb; int dup;
    __device__ __forceinline__ void operator()(f32x4 (&acc)[2][2][4][2], const Unit& u, int wr, int wc, int fr, int fq, PG8_LAS unsigned char* lds) const {
        const int wid = wr * 4 + wc;
        PG8_LAS float* X = (PG8_LAS float*)(lds + XOFF);
#pragma unroll
        for (int ai = 0; ai < 2; ++ai)
#pragma unroll
            for (int m = 0; m < 4; ++m) {
                const int row = u.pm * BM + ai * HALF + wr * 64 + m * 16 + fr;
                const float rs = rsqrtf(ss16(ss, row) * (1.0f / D) + EPS);
#pragma unroll
                for (int bj = 0; bj < 2; ++bj)
#pragma unroll
                    for (int n = 0; n < 2; ++n) acc[ai][bj][m][n] *= rs;
            }
#pragma unroll
        for (int ai = 0; ai < 2; ++ai) {
            if (fr == 0) {
#pragma unroll
                for (int bj = 0; bj < 2; ++bj)
#pragma unroll
                    for (int n = 0; n < 2; ++n) *(PG8_LAS f32x4*)(X + ((wid * 2 + ai) * 2 + 0) * 64 + 32 * bj + 8 * fq + 4 * n) = acc[ai][bj][0][n];
            }
            if (fr == 15) {
#pragma unroll
                for (int bj = 0; bj < 2; ++bj)
#pragma unroll
                    for (int n = 0; n < 2; ++n) *(PG8_LAS f32x4*)(X + ((wid * 2 + ai) * 2 + 1) * 64 + 32 * bj + 8 * fq + 4 * n) = acc[ai][bj][3][n];
            }
        }
        {
            const int ccol = u.pn * 128 + wc * 32 + 8 * fq;
            if (wr == 0 && fr < 2) {
#pragma unroll
                for (int bj = 0; bj < 2; ++bj)
#pragma unroll
                    for (int n = 0; n < 2; ++n) *(f32x4*)(yb + ((size_t)u.pm * 4 + fr) * FF2 + bj * FF + ccol + 4 * n) = acc[0][bj][0][n];
            }
            if (wr == 1 && fr >= 14) {
#pragma unroll
                for (int bj = 0; bj < 2; ++bj)
#pragma unroll
                    for (int n = 0; n < 2; ++n) *(f32x4*)(yb + ((size_t)u.pm * 4 + 2 + (fr - 14)) * FF2 + bj * FF + ccol + 4 * n) = acc[1][bj][3][n];
            }
        }
        asm volatile("s_waitcnt lgkmcnt(0)" ::: "memory"); __builtin_amdgcn_s_barrier(); asm volatile("" ::: "memory");
#pragma unroll
        for (int rep_ = 0; rep_ <= ((MK_EDUP & 1) ? 1 : 0); ++rep_) {
        if (rep_) {
#pragma unroll
            for (int ai = 0; ai < 2; ++ai)
#pragma unroll
                for (int bj = 0; bj < 2; ++bj)
#pragma unroll
                    for (int m = 0; m < 4; ++m)
#pragma unroll
                        for (int n = 0; n < 2; ++n) asm volatile("" : "+v"(acc[ai][bj][m][n]) :: "memory");
        }
#pragma unroll
        for (int n = 0; n < 2; ++n) {
            const int ccol = u.pn * 128 + wc * 32 + 8 * fq + 4 * n;
            f32x4 w0[2], w1[2], w2[2], bb[2];
#pragma unroll
            for (int bj = 0; bj < 2; ++bj) { w0[bj] = *(const f32x4*)(cw + bj * FF + ccol); w1[bj] = *(const f32x4*)(cw + FF2 + bj * FF + ccol); w2[bj] = *(const f32x4*)(cw + 2 * FF2 + bj * FF + ccol); bb[bj] = *(const f32x4*)(cb + bj * FF + ccol); }
#pragma unroll
            for (int ai = 0; ai < 2; ++ai) {
                const int pw = wr ? wid - 4 : wid + 4, pai = wr ? ai : 0;
                const int nw = wr ? wid - 4 : wid + 4, nai = wr ? 1 : ai;
                f32x4 xp[2], xn[2];
#pragma unroll
                for (int bj = 0; bj < 2; ++bj) { xp[bj] = *(PG8_LAS f32x4*)(X + ((pw * 2 + pai) * 2 + 1) * 64 + 32 * bj + 8 * fq + 4 * n); xn[bj] = *(PG8_LAS f32x4*)(X + ((nw * 2 + nai) * 2 + 0) * 64 + 32 * bj + 8 * fq + 4 * n); }
#pragma unroll
                for (int m = 0; m < 4; ++m) {
                    const int trow = ai * HALF + wr * 64 + m * 16 + fr;
                    float uv[2][4];
#pragma unroll
                    for (int bj = 0; bj < 2; ++bj)
#pragma unroll
                        for (int e = 0; e < 4; ++e) {
                            const float cur = acc[ai][bj][m][n][e];
                            float rp, rn;
                            if (m > 0) rp = DPPF(0.f, acc[ai][bj][m > 0 ? m - 1 : 0][n][e], 0x121, true); else rp = xp[bj][e];
                            if (m < 3) rn = DPPF(0.f, acc[ai][bj][m < 3 ? m + 1 : 3][n][e], 0x12F, true); else rn = xn[bj][e];
                            const float prev = DPPF(rp, cur, 0x111, false), next = DPPF(rn, cur, 0x101, false);
                            uv[bj][e] = bb[bj][e] + w0[bj][e] * prev + w1[bj][e] * cur + w2[bj][e] * next;
                        }
                    f32x4 o;
#pragma unroll
                    for (int e = 0; e < 4; ++e) o[e] = uv[0][e] * uv[1][e] * __builtin_amdgcn_rcpf(1.0f + __builtin_amdgcn_exp2f(-uv[1][e] * LOG2E));
                    u32x2 w; w.x = cvt_pk_bf16(o[0], o[1]); w.y = cvt_pk_bf16(o[2], o[3]);
                    if (trow != 0 && trow != 255) *(u32x2*)(a + (size_t)(u.pm * BM + trow) * FF + ccol) = w;
                    asm volatile("" ::: "memory");
                }
            }
        }
        }
    }
};

template <class Epi, class Sched, bool ALIGN_EPI = false, bool SP2 = false>
__device__ __forceinline__ void gemm_phase(PG8_LAS unsigned char* lds, const int K, const int lda, const Sched& S, const Epi& E) {
    int tid_ = threadIdx.x; asm volatile("" : "+v"(tid_));
    const int tid = tid_, wid = __builtin_amdgcn_readfirstlane(tid >> 6), lane = tid & 63, wr = wid >> 2, wc = wid & 3, fr = lane & 15, fq = lane >> 4;
    const int nt = K / BK;
    unsigned voffA[2], voffB[2];
#pragma unroll
    for (int i = 0; i < 2; ++i) { int R, C; stage_rc(tid * 16 + i * 8192, R, C); const int Rb = Epi::PERM ? ((R & ~31) + perm32(R & 31)) : R;
        voffA[i] = (unsigned)(R * lda + C) * 2u; voffB[i] = (unsigned)(Rb * K + C) * 2u; }
    const size_t kstep = (size_t)(BK * 2);
    const size_t hstepB = (size_t)HALF * K * 2;
    const size_t hstepA = (size_t)HALF * lda * 2;
    const unsigned ldsw = (unsigned)wid * 1024u;
    const int aoff = lds_byte(wr * 64 + fr, fq * 8), boff = lds_byte(wc * 32 + fr, fq * 8);
#define PG8_SA(b, h) (((b) * 2 + (h)) * HTB)
#define PG8_SB(b, h) ((4 + (b) * 2 + (h)) * HTB)
#define PG8_STAGE(bufoff, gbase, voff) do { _Pragma("unroll") for (int _i = 0; _i < 2; ++_i) \
        __builtin_amdgcn_global_load_lds((const unsigned*)((const char*)(gbase) + (voff)[_i]), (PG8_LAS unsigned*)(lds + (bufoff) + ldsw + _i * 8192), 16, 0, 0); } while (0)
#define PG8_LDA(dst, b, h) do { _Pragma("unroll") for (int m = 0; m < 4; ++m) _Pragma("unroll") for (int k = 0; k < 2; ++k) dst[m][k] = *(const PG8_LAS bf16x8*)(lds + PG8_SA(b, h) + aoff + m * 2048 + k * 1024); } while (0)
#define PG8_LDB(dst, b, h) do { _Pragma("unroll") for (int n = 0; n < 2; ++n) _Pragma("unroll") for (int k = 0; k < 2; ++k) dst[n][k] = *(const PG8_LAS bf16x8*)(lds + PG8_SB(b, h) + boff + n * 2048 + k * 1024); } while (0)
#define PG8_MMA(ai, bj, At, Bt) do { __builtin_amdgcn_s_setprio(1); _Pragma("unroll") for (int m = 0; m < 4; ++m) _Pragma("unroll") for (int n = 0; n < 2; ++n) _Pragma("unroll") for (int k = 0; k < 2; ++k) \
        acc[ai][bj][m][n] = __builtin_amdgcn_mfma_f32_16x16x32_bf16(Bt[n][k], At[m][k], acc[ai][bj][m][n], 0, 0, 0); __builtin_amdgcn_s_setprio(0); } while (0)
#define PG8_WAIT_V(n) asm volatile("s_waitcnt vmcnt(" #n ")" ::: "memory")
#define PG8_WAIT_L(n) asm volatile("s_waitcnt lgkmcnt(" #n ")" ::: "memory")
#define PG8_BAR __builtin_amdgcn_s_barrier()
#define PG8_SCHED __builtin_amdgcn_sched_barrier(0)
    Unit cur, nxt; int ui = 0;
    if (!S.next(0, cur)) return;
    f32x4 acc[2][2][4][2];
#pragma unroll
    for (int a = 0; a < 2; ++a)
#pragma unroll
        for (int b = 0; b < 2; ++b)
#pragma unroll
            for (int m = 0; m < 4; ++m)
#pragma unroll
                for (int n = 0; n < 2; ++n) acc[a][b][m][n] = (f32x4){0.f, 0.f, 0.f, 0.f};
    bf16x8 At[4][2], B0[2][2], B1[2][2];
    const char* cA = S.aptr(cur); const char* cB = S.bptr(cur);
    S.a_ready(cur);
    if constexpr (SP2) {
        PG8_STAGE(PG8_SB(0, 0), cB, voffB); PG8_STAGE(PG8_SB(0, 1), cB + hstepB, voffB); PG8_STAGE(PG8_SA(0, 0), cA, voffA); PG8_STAGE(PG8_SA(0, 1), cA + hstepA, voffA);
        if (wr == 1) PG8_BAR;
        PG8_WAIT_V(2); PG8_BAR;
        PG8_STAGE(PG8_SB(1, 0), cB + kstep, voffB); PG8_STAGE(PG8_SA(1, 0), cA + kstep, voffA); PG8_STAGE(PG8_SB(1, 1), cB + hstepB + kstep, voffB);
        PG8_WAIT_V(6); PG8_BAR;
    } else {
        PG8_STAGE(PG8_SB(0, 0), cB, voffB); PG8_STAGE(PG8_SA(0, 0), cA, voffA); PG8_STAGE(PG8_SB(0, 1), cB + hstepB, voffB); PG8_STAGE(PG8_SA(0, 1), cA + hstepA, voffA);
        if (wr == 1) PG8_BAR;
        PG8_WAIT_V(4); PG8_BAR;
        PG8_STAGE(PG8_SB(1, 0), cB + kstep, voffB); PG8_STAGE(PG8_SA(1, 0), cA + kstep, voffA); PG8_STAGE(PG8_SB(1, 1), cB + hstepB + kstep, voffB);
        PG8_WAIT_V(6); PG8_BAR;
    }
    for (;;) {
        const bool has_next = S.next(ui + 1, nxt);
        const char* nA = has_next ? S.aptr(nxt) : cA; const char* nB = has_next ? S.bptr(nxt) : cB;
        for (int t = 0; t < nt; t += 2) {
            const bool last = (t == nt - 2);
            const char* a1 = cA + (size_t)(t + 1) * kstep;
            const char* a2 = last ? nA : cA + (size_t)(t + 2) * kstep; const char* b2 = last ? nB : cB + (size_t)(t + 2) * kstep;
            const char* a3 = a2 + kstep; const char* b3 = b2 + kstep;
            if (last && has_next) S.a_ready(nxt);
            if constexpr (SP2) {
            PG8_LDB(B0, 0, 0); PG8_LDB(B1, 0, 1); PG8_SCHED; PG8_LDA(At, 0, 0); PG8_STAGE(PG8_SA(1, 1), a1 + hstepA, voffA);
            PG8_WAIT_V(8); PG8_WAIT_L(0); PG8_BAR; PG8_MMA(0, 0, At, B0); PG8_MMA(0, 1, At, B1); PG8_BAR; PG8_SCHED;
            PG8_LDA(At, 0, 1); PG8_STAGE(PG8_SB(0, 0), b2, voffB); PG8_STAGE(PG8_SB(0, 1), b2 + hstepB, voffB); PG8_STAGE(PG8_SA(0, 0), a2, voffA);
            PG8_WAIT_V(8); PG8_WAIT_L(0); PG8_BAR; PG8_MMA(1, 0, At, B0); PG8_MMA(1, 1, At, B1); PG8_BAR; PG8_SCHED;
            PG8_LDB(B0, 1, 0); PG8_LDB(B1, 1, 1); PG8_SCHED; PG8_LDA(At, 1, 0); PG8_STAGE(PG8_SA(0, 1), a2 + hstepA, voffA);
            PG8_WAIT_V(8); PG8_WAIT_L(0); PG8_BAR; PG8_MMA(0, 0, At, B0); PG8_MMA(0, 1, At, B1); PG8_BAR; PG8_SCHED;
            PG8_LDA(At, 1, 1); PG8_STAGE(PG8_SB(1, 0), b3, voffB); PG8_STAGE(PG8_SB(1, 1), b3 + hstepB, voffB); PG8_STAGE(PG8_SA(1, 0), a3, voffA);
            PG8_WAIT_V(8); PG8_WAIT_L(0); PG8_BAR; PG8_MMA(1, 0, At, B0); PG8_MMA(1, 1, At, B1); PG8_BAR; PG8_SCHED;
            } else {
            PG8_LDB(B0, 0, 0); PG8_SCHED; PG8_LDA(At, 0, 0); PG8_STAGE(PG8_SA(1, 1), a1 + hstepA, voffA);
            PG8_WAIT_L(8); PG8_BAR; PG8_WAIT_L(0); PG8_MMA(0, 0, At, B0); PG8_BAR; PG8_SCHED;
            PG8_LDB(B1, 0, 1); PG8_STAGE(PG8_SB(0, 0), b2, voffB);
            PG8_BAR; PG8_WAIT_L(0); PG8_MMA(0, 1, At, B1); PG8_BAR;
            PG8_LDA(At, 0, 1); PG8_STAGE(PG8_SA(0, 0), a2, voffA);
            PG8_BAR; PG8_WAIT_L(0); PG8_MMA(1, 0, At, B0); PG8_BAR; PG8_SCHED;
            PG8_STAGE(PG8_SB(0, 1), b2 + hstepB, voffB);
            PG8_WAIT_V(6); PG8_BAR; PG8_MMA(1, 1, At, B1); PG8_BAR;
            PG8_LDB(B0, 1, 0); PG8_SCHED; PG8_LDA(At, 1, 0); PG8_STAGE(PG8_SA(0, 1), a2 + hstepA, voffA);
            PG8_WAIT_L(8); PG8_BAR; PG8_WAIT_L(0); PG8_MMA(0, 0, At, B0); PG8_BAR; PG8_SCHED;
            PG8_LDB(B1, 1, 1); PG8_STAGE(PG8_SB(1, 0), b3, voffB);
            PG8_BAR; PG8_WAIT_L(0); PG8_MMA(0, 1, At, B1); PG8_BAR;
            PG8_LDA(At, 1, 1); PG8_STAGE(PG8_SA(1, 0), a3, voffA);
            PG8_BAR; PG8_WAIT_L(0); PG8_MMA(1, 0, At, B0); PG8_BAR; PG8_SCHED;
            PG8_STAGE(PG8_SB(1, 1), b3 + hstepB, voffB);
            PG8_WAIT_V(6); PG8_BAR; PG8_MMA(1, 1, At, B1); PG8_BAR;
            }
        }
        if constexpr (ALIGN_EPI) { if (wr == 0) PG8_BAR; }
        if constexpr (!Epi::AFTER_DRAIN) { E(acc, cur, wr, wc, fr, fq, lds); S.done(cur); }
        if (!has_next) break;
        if (Epi::zero_after(cur)) {
#pragma unroll
        for (int a = 0; a < 2; ++a)
#pragma unroll
            for (int b = 0; b < 2; ++b)
#pragma unroll
                for (int m = 0; m < 4; ++m)
#pragma unroll
                    for (int n = 0; n < 2; ++n) acc[a][b][m][n] = (f32x4){0.f, 0.f, 0.f, 0.f};
        }
        cur = nxt; cA = nA; cB = nB; ++ui;
        if constexpr (ALIGN_EPI) { if (wr == 1) PG8_BAR; }
    }
    PG8_WAIT_V(0);
    if constexpr (!ALIGN_EPI) { if (wr == 0) PG8_BAR; }
    PG8_BAR;
    if constexpr (Epi::AFTER_DRAIN) { E.fused(acc, cur, wr, wc, fr, fq, lds, wid, lane); S.done(cur); }
#undef PG8_SA
#undef PG8_SB
#undef PG8_STAGE
#undef PG8_LDA
#undef PG8_LDB
#undef PG8_MMA
#undef PG8_WAIT_V
#undef PG8_WAIT_L
#undef PG8_BAR
#undef PG8_SCHED
}
}

namespace att {
using namespace nv;
#define ALAS __attribute__((address_space(3)))
typedef short bf16x8 __attribute__((ext_vector_type(8)));
typedef short s16x4 __attribute__((ext_vector_type(4)));
typedef float f32x16 __attribute__((ext_vector_type(16)));
typedef float f32x4 __attribute__((ext_vector_type(4)));
typedef unsigned u32x4 __attribute__((ext_vector_type(4)));
typedef unsigned u32x2 __attribute__((ext_vector_type(2)));
typedef short v4i16_t __attribute__((ext_vector_type(4)));
typedef float f32x2_t __attribute__((ext_vector_type(2))); typedef __bf16 bf16x2_t __attribute__((ext_vector_type(2)));
constexpr int LUT_OFF = 98304, LUT_STRIDE = 520, GT_OFF = LUT_OFF + 12 * LUT_STRIDE * 4;
static_assert(GT_OFF + 512 <= 131072, "attention tables inside the ring region");
constexpr float NEG = -30000.f, THR = 6.f;
__device__ __forceinline__ unsigned cvtpk(float lo, float hi) { f32x2_t v = {lo, hi}; bf16x2_t b = __builtin_convertvector(v, bf16x2_t); return __builtin_bit_cast(unsigned, b); }
__device__ __forceinline__ s16x4 vtr(ALAS const unsigned char* p) { return __builtin_bit_cast(s16x4, __builtin_amdgcn_ds_read_tr16_b64_v4i16((ALAS v4i16_t*)p)); }
__device__ __forceinline__ void glds16(const void* gsrc, unsigned lds_dst) { unsigned keep;
    asm volatile("s_mov_b32 %0, m0\n\ts_mov_b32 m0, %2\n\ts_nop 0\n\tglobal_load_lds_dwordx4 %1, off\n\ts_mov_b32 m0, %0" : "=&s"(keep) : "v"(gsrc), "s"(lds_dst) : "memory"); }
__device__ __forceinline__ float swap_add(float v) { auto rr = __builtin_amdgcn_permlane32_swap(__float_as_uint(v), __float_as_uint(v), false, false); return __uint_as_float(rr[0]) + __uint_as_float(rr[1]); }
__device__ __forceinline__ float swap_max(float v) { auto rr = __builtin_amdgcn_permlane32_swap(__float_as_uint(v), __float_as_uint(v), false, false); return fmaxf(__uint_as_float(rr[0]), __uint_as_float(rr[1])); }
#define MX3(a, b, c) __builtin_fmaxf(__builtin_fmaxf((a), (b)), (c))

__device__ __forceinline__ void attn_tables(ALAS unsigned char* lds, const float* __restrict__ lutg, const float* __restrict__ subg, float osc) {
    int tid = threadIdx.x; asm volatile("" : "+v"(tid));
    ALAS float* lut = (ALAS float*)(lds + LUT_OFF); ALAS float* gt = (ALAS float*)(lds + GT_OFF);
    for (int i = tid; i < 12 * LUT_STRIDE; i += 512) lut[i] = lutg[i];
    if (tid < 128) gt[tid] = subg[tid] * osc;
    __syncthreads();
}
template <bool ISB, int VAR = 0>
__device__ __forceinline__ void attn_unit(ALAS unsigned char* lds, bf16* zg, const float* __restrict__ lutg, int b, int hsel, int q0, const float* __restrict__ sinkp, float lam, float osc, const float* __restrict__ subg, bf16* odry) {
    int tid_ = threadIdx.x; asm volatile("" : "+v"(tid_));
    const int tid = tid_, lane = tid & 63, r32 = lane & 31, hi = lane >> 5; const int wid = __builtin_amdgcn_readfirstlane(tid >> 6);
    constexpr int NDV = ISB ? 4 : 2, BUF = ISB ? 32768 : 16384, VOFF = ISB ? 16384 : 8192;
    const int map = ISB ? (wid >> 2) : 0, qsub = ISB ? (wid & 3) : (wid & 1), gsel = ISB ? 0 : (wid >> 1);
    const int head = ISB ? hsel : hsel * 4 + gsel;
    const int qrow0 = q0 + 32 * qsub;
    const int qcol = ISB ? (C_QB + head * 128 + map * 64) : (C_QA + head * 64);
    const int kcol = ISB ? (C_KB + head * 128) : (C_KA + hsel * 64);
    const int vcol = ISB ? (C_VB + head * 128) : (C_VA + hsel * 64);
    const size_t rowbase = (size_t)b * S;
    int kt0 = 0, kt1 = S / 64;
    if (!ISB) { kt0 = q0 / 64 - 2; if (kt0 < 0) kt0 = 0; kt1 = q0 / 64 + 3; if (kt1 > S / 64) kt1 = S / 64; }
    const int nt = kt1 - kt0;
    ALAS float* lut = (ALAS float*)(lds + LUT_OFF) + (ISB ? 8 + head : hsel * 4 + gsel) * LUT_STRIDE;
    ALAS float* gt = (ALAS float*)(lds + GT_OFF);
    const float sink2 = ISB ? 0.f : sinkp[head] * LOG2E;
    bf16x8 qr[4];
    { const bf16* qp = zg + (rowbase + qrow0 + r32) * ZG + qcol + hi * 8;
#pragma unroll
      for (int d0 = 0; d0 < 4; ++d0) qr[d0] = *(const bf16x8*)(qp + d0 * 16); }
    const unsigned lds0 = (unsigned)(size_t)lds;
    const bf16* kp_[2]; const bf16* vp_[2];
#pragma unroll
    for (int i_ = 0; i_ < 2; ++i_) { const int p_ = ISB ? wid * 2 + i_ : wid;
        kp_[i_] = zg + (rowbase + (size_t)kt0 * 64 + lane) * ZG + kcol + (ISB ? (p_ >> 3) * 64 + (p_ & 7) * 8 : wid * 8);
        vp_[i_] = zg + (rowbase + (size_t)kt0 * 64 + 16 * (p_ & 3) + (lane >> 2)) * ZG + vcol + 32 * (p_ >> 2) + 8 * (lane & 3); }
#define ATT_ISSUE(bo) do { \
        _Pragma("unroll") for (int i_ = 0; i_ < (ISB ? 2 : 1); ++i_) { const int p_ = ISB ? wid * 2 + i_ : wid; \
            glds16(kp_[i_], (unsigned)__builtin_amdgcn_readfirstlane((int)(lds0 + (bo) + p_ * 1024))); \
            glds16(vp_[i_], (unsigned)__builtin_amdgcn_readfirstlane((int)(lds0 + (bo) + VOFF + p_ * 1024))); \
            kp_[i_] += 64 * ZG; vp_[i_] += 64 * ZG; } } while (0)
#define ATT_SB() __builtin_amdgcn_sched_barrier(0)
    float mhat = 0.f, l = 0.f;
    f32x16 o[NDV];
#pragma unroll
    for (int d = 0; d < NDV; ++d)
#pragma unroll
        for (int r = 0; r < 16; ++r) o[d][r] = 0.f;
    const int kfo = (ISB ? map * 8192 : 0) + hi * 1024 + r32 * 16;
    const int vfo = VOFF + ((lane >> 4) & 1) * 32 + (lane & 3) * 8 + (4 * hi + ((lane & 15) >> 2)) * 64;
    u32x4 pw[4];
#define ATT_QK(P0, P1, t, so) do { const int kb_ = (t) * 64; float cf_ = 0.f; \
        if (ISB) { if (kb_ - qrow0 - 31 >= 91) cf_ = lut[256 + 128]; else if (kb_ + 63 - qrow0 <= -91) cf_ = lut[256 - 128]; } \
        const float c0_ = cf_ - mhat; f32x16 ci_; _Pragma("unroll") for (int r = 0; r < 16; ++r) ci_[r] = c0_; \
        ALAS const unsigned char* kp = lds + (so) + kfo; \
        P0 = __builtin_amdgcn_mfma_f32_32x32x16_bf16(*(ALAS const bf16x8*)(kp), qr[0], ci_, 0, 0, 0); \
        P1 = __builtin_amdgcn_mfma_f32_32x32x16_bf16(*(ALAS const bf16x8*)(kp + 512), qr[0], ci_, 0, 0, 0); \
        _Pragma("unroll") for (int d0 = 1; d0 < 4; ++d0) { \
            P0 = __builtin_amdgcn_mfma_f32_32x32x16_bf16(*(ALAS const bf16x8*)(kp + d0 * 2048), qr[d0], P0, 0, 0, 0); \
            P1 = __builtin_amdgcn_mfma_f32_32x32x16_bf16(*(ALAS const bf16x8*)(kp + d0 * 2048 + 512), qr[d0], P1, 0, 0, 0); } } while (0)
#define ATT_DECIDE(P0, P1, t, first) do { const int kb_ = (t) * 64; \
        if (!ISB || !((kb_ - qrow0 - 31 >= 91) || (kb_ + 63 - qrow0 <= -91))) { \
            ALAS const float* lp = lut + (kb_ - (qrow0 + r32) + 256 + 4 * hi); \
            _Pragma("unroll") for (int r = 0; r < 16; ++r) { P0[r] += lp[(r & 3) + 8 * (r >> 2)]; P1[r] += lp[32 + (r & 3) + 8 * (r >> 2)]; } } \
        float rm_; { float a = MX3(P0[0], P0[1], P1[0]), c = MX3(P0[2], P0[3], P1[1]); a = MX3(a, P1[2], P1[3]); \
            _Pragma("unroll") for (int r = 4; r < 16; r += 4) { a = MX3(a, P0[r], P0[r + 1]); c = MX3(c, P0[r + 2], P0[r + 3]); a = MX3(a, P1[r], P1[r + 1]); c = MX3(c, P1[r + 2], P1[r + 3]); } \
            rm_ = swap_max(__builtin_fmaxf(a, c)); } \
        if ((first) || __any(rm_ > THR)) { const float dl = (first) ? rm_ : __builtin_fmaxf(rm_, 0.f); mhat += dl; \
            _Pragma("unroll") for (int r = 0; r < 16; ++r) { P0[r] -= dl; P1[r] -= dl; } \
            if (!(first)) { const float f = __builtin_amdgcn_exp2f(-dl); l *= f; \
                _Pragma("unroll") for (int d = 0; d < NDV; ++d) _Pragma("unroll") for (int r = 0; r < 16; ++r) o[d][r] *= f; } } } while (0)
#define ATT_FINISH(P0, P1) do { float sacc = 0.f; \
        _Pragma("unroll") for (int r = 0; r < 16; ++r) { P0[r] = __builtin_amdgcn_exp2f(P0[r]); P1[r] = __builtin_amdgcn_exp2f(P1[r]); sacc += P0[r] + P1[r]; } \
        l += sacc; \
        pw[0] = (u32x4){cvtpk(P0[0], P0[1]), cvtpk(P0[2], P0[3]), cvtpk(P0[4], P0[5]), cvtpk(P0[6], P0[7])}; \
        pw[1] = (u32x4){cvtpk(P0[8], P0[9]), cvtpk(P0[10], P0[11]), cvtpk(P0[12], P0[13]), cvtpk(P0[14], P0[15])}; \
        pw[2] = (u32x4){cvtpk(P1[0], P1[1]), cvtpk(P1[2], P1[3]), cvtpk(P1[4], P1[5]), cvtpk(P1[6], P1[7])}; \
        pw[3] = (u32x4){cvtpk(P1[8], P1[9]), cvtpk(P1[10], P1[11]), cvtpk(P1[12], P1[13]), cvtpk(P1[14], P1[15])}; } while (0)
#define ATT_LDV(dst, d) do { _Pragma("unroll") for (int ks = 0; ks < 4; ++ks) { dst[2 * ks] = vtr(vp + (d) * 4096 + ks * 1024); dst[2 * ks + 1] = vtr(vp + (d) * 4096 + ks * 1024 + 512); } } while (0)
#define ATT_VF(src, ks) (bf16x8){src[2 * (ks)][0], src[2 * (ks)][1], src[2 * (ks)][2], src[2 * (ks)][3], src[2 * (ks) + 1][0], src[2 * (ks) + 1][1], src[2 * (ks) + 1][2], src[2 * (ks) + 1][3]}
#define ATT_PVD(src, d) do { __builtin_amdgcn_s_setprio(1); _Pragma("unroll") for (int ks = 0; ks < 4; ++ks) o[d] = __builtin_amdgcn_mfma_f32_32x32x16_bf16(ATT_VF(src, ks), __builtin_bit_cast(bf16x8, pw[ks]), o[d], 0, 0, 0); __builtin_amdgcn_s_setprio(0); } while (0)
#define ATT_PV(so) do { ALAS const unsigned char* vp = lds + (so) + vfo; s16x4 va[8], vb[8]; \
        ATT_LDV(va, 0); ATT_LDV(vb, 1); ATT_SB(); ATT_PVD(va, 0); ATT_SB(); \
        if (NDV == 4) { ATT_LDV(va, 2); ATT_SB(); ATT_PVD(vb, 1); ATT_SB(); ATT_LDV(vb, 3); ATT_SB(); ATT_PVD(va, 2); ATT_SB(); ATT_PVD(vb, 3); } \
        else { ATT_PVD(vb, 1); } } while (0)
#define ATT_SLOT(i) (ISB ? (((i) % 3) * BUF) : ((i) * BUF))
#define ATT_STEP(i, PC0, PC1, PP0, PP1) do { \
        if (ISB) { asm volatile("s_waitcnt vmcnt(0)" ::: "memory"); __syncthreads(); if ((i) + 1 < nt) ATT_ISSUE(ATT_SLOT((i) + 1)); } \
        ATT_QK(PC0, PC1, kt0 + (i), ATT_SLOT(i)); ATT_SB(); \
        ATT_FINISH(PP0, PP1); ATT_SB(); \
        ATT_PV(ATT_SLOT((i) - 1)); ATT_SB(); \
        ATT_DECIDE(PC0, PC1, kt0 + (i), false); ATT_SB(); } while (0)
    f32x16 pA0, pA1, pB0, pB1;
    if (ISB) { ATT_ISSUE(0); asm volatile("s_waitcnt vmcnt(0)" ::: "memory"); __syncthreads(); if (nt > 1) ATT_ISSUE(BUF); }
    else {
#pragma unroll 1
        for (int i = 0; i < nt; ++i) ATT_ISSUE(i * BUF);
        asm volatile("s_waitcnt vmcnt(0)" ::: "memory"); __syncthreads();
    }
    ATT_QK(pA0, pA1, kt0, 0); ATT_SB();
    ATT_DECIDE(pA0, pA1, kt0, true); ATT_SB();
    int i = 1;
#pragma unroll 1
    for (; i + 1 < nt; i += 2) {
        ATT_STEP(i, pB0, pB1, pA0, pA1);
        ATT_STEP(i + 1, pA0, pA1, pB0, pB1);
    }
    if (i < nt) {
        ATT_STEP(i, pB0, pB1, pA0, pA1);
        ATT_FINISH(pB0, pB1); ATT_SB(); ATT_PV(ATT_SLOT(nt - 1));
    } else {
        ATT_FINISH(pA0, pA1); ATT_SB(); ATT_PV(ATT_SLOT(nt - 1));
    }
#undef ATT_ISSUE
#undef ATT_SB
#undef ATT_QK
#undef ATT_DECIDE
#undef ATT_FINISH
#undef ATT_PV
#undef ATT_LDV
#undef ATT_VF
#undef ATT_PVD
#undef ATT_SLOT
#undef ATT_STEP
    l = swap_add(l);
    if (!ISB) l += __builtin_amdgcn_exp2f(sink2 - mhat);
    const float inv = 1.0f / l;
    bf16* orow = odry ? odry + (rowbase + qrow0 + r32) * D + (ISB ? (512 + head * 128) : (head * 64)) : zg + (rowbase + qrow0 + r32) * ZG + (ISB ? (C_QB + head * 128) : (C_QA + head * 64));
    if (ISB) {
        __syncthreads();
        ALAS float* cs = (ALAS float*)lds;
        if (map == 1) { const float sc = -lam * inv;
#pragma unroll
            for (int d = 0; d < NDV; ++d)
#pragma unroll
                for (int r = 0; r < 16; ++r) cs[(qsub * 64 + d * 16 + r) * 64 + lane] = o[d][r] * sc; }
        __syncthreads();
        if (map == 0) {
            float q = 0.f;
#pragma unroll
            for (int d = 0; d < NDV; ++d)
#pragma unroll
                for (int r = 0; r < 16; ++r) { const float v = o[d][r] * inv + cs[(qsub * 64 + d * 16 + r) * 64 + lane]; o[d][r] = v; q += v * v; }
            q = swap_add(q);
            const float rstd = rsqrtf(q * (1.0f / 128.0f) + EPS);
#pragma unroll
            for (int d = 0; d < NDV; ++d)
#pragma unroll
                for (int g4 = 0; g4 < 4; ++g4) { const int dv0 = 32 * d + 8 * g4 + 4 * hi; const f32x4 gv = *(ALAS const f32x4*)(gt + dv0);
                    u32x2 w; w.x = cvtpk(o[d][4 * g4] * rstd * gv[0], o[d][4 * g4 + 1] * rstd * gv[1]); w.y = cvtpk(o[d][4 * g4 + 2] * rstd * gv[2], o[d][4 * g4 + 3] * rstd * gv[3]);
                    *(u32x2*)(orow + dv0) = w; }
        }
    } else {
#pragma unroll
        for (int d = 0; d < NDV; ++d)
#pragma unroll
            for (int g4 = 0; g4 < 4; ++g4) { const int dv0 = 32 * d + 8 * g4 + 4 * hi;
                u32x2 w; w.x = cvtpk(o[d][4 * g4] * inv, o[d][4 * g4 + 1] * inv); w.y = cvtpk(o[d][4 * g4 + 2] * inv, o[d][4 * g4 + 3] * inv);
                *(u32x2*)(orow + dv0) = w; }
    }
    __syncthreads();
}
#undef MX3
}

#ifndef MK_VAR
#define MK_VAR 0
#endif
namespace mk {
using namespace nv;
constexpr int NWAVES = 8;
constexpr size_t MiB = 1u << 20;
constexpr size_t WS_CTL = 0, CTL_ZERO_BYTES = 1 * MiB;
constexpr size_t WS_LUT = 512 * 1024;
constexpr size_t WS_SS = 1 * MiB;
constexpr size_t WS_XB = 6 * MiB;
constexpr size_t WS_ZG = 38 * MiB;
constexpr size_t WS_A = 38 * MiB;
constexpr size_t WS_YB = 126 * MiB;
constexpr size_t WS_MIX = 174 * MiB;
constexpr size_t WS_W = 206 * MiB;
constexpr size_t WL_IN = 0, WL_A = (size_t)ZG * D, WL_B = WL_A + (size_t)D * 512, WL_O = WL_B + (size_t)D * 512, WL_UP = WL_O + (size_t)D * D, WL_DN = WL_UP + (size_t)FF2 * D, WL_END = WL_DN + (size_t)D * FF;
constexpr size_t WS_TMPA = 322 * MiB, WS_TMPB = 344 * MiB;
constexpr size_t WS_END = 352 * MiB;
static_assert(WS_W + 4 * WL_END * 2 <= WS_TMPA && WS_YB + (size_t)64 * 4 * FF2 * 4 <= WS_MIX && WS_A + (size_t)T * FF * 2 <= WS_YB, "d_ws map");
constexpr int CW_BAR = 4096;
constexpr int N_PHASES = 1 + 6 * L;
constexpr int RING_OFF = 0, RING_BYTES = 131072, LDSCTL_OFF = RING_BYTES, MISC_OFF = LDSCTL_OFF + 320;
constexpr int LDS_BYTES = 147456;
static_assert(pg8::XOFF + 8192 <= LDS_BYTES && MISC_OFF + 128 <= pg8::XOFF, "LDS map");

#define GAS __attribute__((address_space(1)))
#define LAS __attribute__((address_space(3)))
typedef unsigned v4u __attribute__((ext_vector_type(4)));
typedef float f32x4 __attribute__((ext_vector_type(4)));
typedef GAS unsigned gu32;
#define RLX_AGENT __ATOMIC_RELAXED, __HIP_MEMORY_SCOPE_AGENT
#define LDS_WAIT() asm volatile("s_waitcnt lgkmcnt(0)" ::: "memory")
#define VM_WAIT() asm volatile("s_waitcnt vmcnt(0)" ::: "memory")
__device__ __forceinline__ unsigned f2bfu(float f) { unsigned u = __builtin_bit_cast(unsigned, f); return (u + 0x7fffu + ((u >> 16) & 1u)) >> 16; }
__device__ __forceinline__ unsigned pk2(float lo, float hi) { return f2bfu(lo) | (f2bfu(hi) << 16); }

#define XB_TMO      128
#define XB_XCNT(j)  (256  + 64 * (j))
#define XB_XSUB(j)  (1280 + 64 * (j))
#define XB_XGEN(j)  (2304 + 64 * (j))
#define XB_TOP      3328
#define XB_TOPGEN   3392
#define XCD_BAR_WORDS 3456
#define XB_SPIN_CAP (1u << 18)

__device__ __forceinline__ unsigned xb_ld(unsigned* p)              { return __hip_atomic_load(p, __ATOMIC_RELAXED, __HIP_MEMORY_SCOPE_AGENT); }
__device__ __forceinline__ unsigned xb_add(unsigned* p, unsigned v) { return __hip_atomic_fetch_add(p, v, __ATOMIC_RELAXED, __HIP_MEMORY_SCOPE_AGENT); }
__device__ __forceinline__ unsigned xb_xcc_id() { return (unsigned)__builtin_amdgcn_s_getreg((3 << 11) | 20) & 0xFu; }
#define XB_SPIN(cond, bar) do { unsigned _sp = 0; while (cond) { __builtin_amdgcn_s_sleep(1); \
    if ((++_sp & 255u) == 0u) { if (xb_ld(&(bar)[XB_TMO])) break; if (_sp > XB_SPIN_CAP) { atomicAdd(&(bar)[XB_TMO], 1u); break; } } } } while (0)

struct XcdBarrier {
    unsigned* bar; unsigned x;
    volatile LAS unsigned* st;
};

__device__ __forceinline__ XcdBarrier xcd_barrier_post(unsigned* bar, volatile LAS unsigned* st) {
    XcdBarrier b; b.bar = bar; b.x = xb_xcc_id(); b.st = st;
    if (threadIdx.x == 0) (void)xb_add(&bar[XB_XCNT(b.x)], 1u);
    return b;
}
__device__ __forceinline__ void xcd_barrier_complete(unsigned* bar, unsigned x, unsigned& nloc, unsigned& nx) {
    const unsigned G = gridDim.x * gridDim.y * gridDim.z;
    unsigned sum, cnt, mine, sp = 0u;
    for (;;) {
        sum = 0u; cnt = 0u; mine = 0u;
#pragma unroll
        for (unsigned j = 0; j < 16; ++j) { const unsigned c = xb_ld(&bar[XB_XCNT(j)]); sum += c; cnt += (c > 0u) ? 1u : 0u; mine = (j == x) ? c : mine; }
        if (sum == G) break;
        __builtin_amdgcn_s_sleep(1);
        if ((++sp & 255u) == 0u) { if (xb_ld(&bar[XB_TMO])) break; if (sp > XB_SPIN_CAP) { atomicAdd(&bar[XB_TMO], 1u); break; } }
    }
    nloc = mine > 0u ? mine : 1u; nx = cnt > 0u ? cnt : 1u;
}

__device__ __forceinline__ void xcd_barrier(const XcdBarrier& b) {
    asm volatile("s_waitcnt vmcnt(0)" ::: "memory");
    __syncthreads();
    if (threadIdx.x == 0) {
        unsigned* bar = b.bar;
        __builtin_amdgcn_s_waitcnt(0);
        unsigned nloc = b.st[0], nx = b.st[1];
        if (nloc == 0u) { xcd_barrier_complete(bar, b.x, nloc, nx); b.st[0] = nloc; b.st[1] = nx; }
        const unsigned old = xb_add(&bar[XB_XSUB(b.x)], 1u);
        const unsigned gen = old / nloc;
        if (old + 1u == (gen + 1u) * nloc) {
            __builtin_amdgcn_fence(__ATOMIC_RELEASE, "agent");
            asm volatile("s_waitcnt vmcnt(0)" ::: "memory");
            const unsigned og = xb_add(&bar[XB_TOP], 1u);
            const unsigned tg = og / nx;
            if (og + 1u == (tg + 1u) * nx) xb_add(&bar[XB_TOPGEN], 1u);
            else XB_SPIN(xb_ld(&bar[XB_TOPGEN]) == tg, bar);
            __builtin_amdgcn_fence(__ATOMIC_ACQUIRE, "agent");
            xb_add(&bar[XB_XGEN(b.x)], 1u);
            asm volatile("s_waitcnt vmcnt(0)" ::: "memory");
        } else {
            XB_SPIN(xb_ld(&bar[XB_XGEN(b.x)]) == gen, bar);
            __builtin_amdgcn_fence(__ATOMIC_ACQUIRE, "agent");
            asm volatile("s_waitcnt vmcnt(0)" ::: "memory");
        }
    }
    __syncthreads();
}


struct Args { const float* in[24]; float* out; unsigned char* ws; int ph_lo, ph_hi, li, pad; };

__device__ __forceinline__ void p0_transpose_item(const float* __restrict__ W, int ldw, int K, int k0, int n0, bf16* __restrict__ WT, int vrow0, const float* __restrict__ gain, LAS float* scr, int lane) {
    float v[32];
    const float* wp = W + (size_t)(k0 + (lane >> 5)) * ldw + n0 + (lane & 31);
#pragma unroll
    for (int i = 0; i < 32; ++i) v[i] = __builtin_nontemporal_load(wp + (size_t)(2 * i) * ldw);
    if (gain) {
#pragma unroll
        for (int i = 0; i < 32; ++i) v[i] *= gain[k0 + 2 * i + (lane >> 5)];
    }
#pragma unroll
    for (int i = 0; i < 32; ++i) scr[(2 * i + (lane >> 5)) * 33 + (lane & 31)] = v[i];
    LDS_WAIT(); asm volatile("" ::: "memory");
    const int c = lane & 7;
#pragma unroll
    for (int j = 0; j < 4; ++j) { const int n = (lane >> 3) + 8 * j; const LAS float* s = scr + (8 * c) * 33 + n;
        v4u o; o.x = pk2(s[0 * 33], s[1 * 33]); o.y = pk2(s[2 * 33], s[3 * 33]); o.z = pk2(s[4 * 33], s[5 * 33]); o.w = pk2(s[6 * 33], s[7 * 33]);
        *(GAS v4u*)(WT + (size_t)(vrow0 + n) * K + k0 + 8 * c) = o; }
    LDS_WAIT(); asm volatile("" ::: "memory");
}
__device__ __forceinline__ int vrow_in(int c) { const int pn = c >> 8, cr = c & 255, wc = cr >> 6, bj = (cr >> 5) & 1; return pn * 256 + bj * 128 + wc * 32; }
__device__ __forceinline__ int vrow_up(int c) { const int gs = c >= FF ? 1 : 0, cc = c - gs * FF, pn = cc >> 7, wc = (cc >> 5) & 3; return pn * 256 + gs * 128 + wc * 32; }

__global__ void __launch_bounds__(NWAVES * 64, 2) skel_fwd(Args args) {
    extern __shared__ __attribute__((aligned(16))) unsigned char lds_raw[];
    LAS unsigned char* lds = (LAS unsigned char*)lds_raw;
    volatile LAS unsigned* MISC = (volatile LAS unsigned*)(lds + MISC_OFF);
    const int G = gridDim.x; int vcu; { const int bx = blockIdx.x; vcu = (G % 8 == 0) ? (bx % 8) * (G / 8) + bx / 8 : bx; }
    unsigned char* ws = args.ws;
    gu32* ctl = (gu32*)(ws + WS_CTL);
    float* ss = (float*)(ws + WS_SS); bf16* xb = (bf16*)(ws + WS_XB); bf16* zg = (bf16*)(ws + WS_ZG); bf16* abuf = (bf16*)(ws + WS_A); float* yb = (float*)(ws + WS_YB);
    bf16* mix = (bf16*)(ws + WS_MIX); bf16* wbase = (bf16*)(ws + WS_W); float* xf = args.out;
    float* lutg = (float*)(ws + WS_LUT);
    for (int u = threadIdx.x; u < (LDS_BYTES - LDSCTL_OFF) / 4; u += NWAVES * 64) ((LAS unsigned*)(lds + LDSCTL_OFF))[u] = 0u;
    __syncthreads();
    XcdBarrier bar = xcd_barrier_post((unsigned*)(ctl + CW_BAR) + args.li * XCD_BAR_WORDS, MISC + 8);

#pragma unroll 1
    for (int ph = args.ph_lo; ph < args.ph_hi; ++ph) {
        const int l = ph > 0 ? (ph - 1) / 6 : 0, p = ph > 0 ? (ph - 1) % 6 + 1 : 0;
        bf16* wl = wbase + (size_t)l * WL_END;
        float* ss1 = ss + (size_t)((2 * l) & 3) * T * 16; float* ss2 = ss + (size_t)((2 * l + 1) & 3) * T * 16; float* ss3 = (l + 1 < L) ? ss + (size_t)((2 * l + 2) & 3) * T * 16 : nullptr;
#ifndef MK_ONLY
#define MK_ONLY 0x7f
#endif
        const int dupp = ((args.pad >> 8) & 0xff) - 1;
#pragma unroll 1
        for (int rep = (p == dupp) ? 0 : 1; rep < 2; ++rep) {
        if (p == 0 && (MK_ONLY & 1)) {
            int tid0 = threadIdx.x; asm volatile("" : "+v"(tid0));
            const int lane0 = tid0 & 63, wave = __builtin_amdgcn_readfirstlane(tid0 >> 6);
            LAS float* scr = (LAS float*)(lds + RING_OFF + wave * 16384);
            const int gw = vcu * NWAVES + wave, NGW = G * NWAVES;
            constexpr int I_IN = (D / 64) * (INW / 32), I_G = (D / 64) * (GW / 32), I_A = (512 / 64) * (D / 32), I_O = (D / 64) * (D / 32), I_UP = (D / 64) * (FF2 / 32), I_DN = (FF / 64) * (D / 32);
            constexpr int I_LAYER = I_IN + I_G + 2 * I_A + I_O + I_UP + I_DN;
            for (int i = gw * 64 + lane0; i < 12 * att::LUT_STRIDE; i += NGW * 64) { const int hh = i / att::LUT_STRIDE, j = i - hh * att::LUT_STRIDE, rel = j - 256, ar = rel < 0 ? -rel : rel;
                float v = 0.f; if (j <= 512) v = (hh < 8 && ar > 128) ? att::NEG : args.in[13][t5_bucket(rel) * 12 + hh] * LOG2E;
                lutg[i] = v; }
            for (int it = gw; it < L * I_LAYER; it += NGW) {
                const int ll = it / I_LAYER; int r = it - ll * I_LAYER; bf16* w = wbase + (size_t)ll * WL_END;
                if (r < I_IN) { const int nb = r % (INW / 32), kb = r / (INW / 32); p0_transpose_item(args.in[2] + (size_t)ll * D * INW, INW, D, 64 * kb, 32 * nb, w + WL_IN, vrow_in(32 * nb), args.in[1] + ll * D, scr, lane0); continue; } r -= I_IN;
                if (r < I_G) { const int nb = r % (GW / 32), kb = r / (GW / 32); p0_transpose_item(args.in[14] + (size_t)ll * D * GW, GW, D, 64 * kb, 32 * nb, w + WL_IN, vrow_in(INW + 32 * nb), args.in[1] + ll * D, scr, lane0); continue; } r -= I_G;
                if (r < I_A) { const int nb = r % (D / 32), kb = r / (D / 32); p0_transpose_item(args.in[16] + (size_t)ll * 512 * D, D, 512, 64 * kb, 32 * nb, w + WL_A, 32 * nb, nullptr, scr, lane0); continue; } r -= I_A;
                if (r < I_A) { const int nb = r % (D / 32), kb = r / (D / 32); p0_transpose_item(args.in[17] + (size_t)ll * 512 * D, D, 512, 64 * kb, 32 * nb, w + WL_B, 32 * nb, nullptr, scr, lane0); continue; } r -= I_A;
                if (r < I_O) { const int nb = r % (D / 32), kb = r / (D / 32); p0_transpose_item(args.in[18] + (size_t)ll * D * D, D, D, 64 * kb, 32 * nb, w + WL_O, 32 * nb, nullptr, scr, lane0); continue; } r -= I_O;
                if (r < I_UP) { const int nb = r % (FF2 / 32), kb = r / (FF2 / 32); p0_transpose_item(args.in[20] + (size_t)ll * D * FF2, FF2, D, 64 * kb, 32 * nb, w + WL_UP, vrow_up(32 * nb), args.in[19] + ll * D, scr, lane0); continue; } r -= I_UP;
                { const int nb = r % (D / 32), kb = r / (D / 32); p0_transpose_item(args.in[23] + (size_t)ll * FF * D, D, FF, 64 * kb, 32 * nb, w + WL_DN, 32 * nb, nullptr, scr, lane0); }
            }
            for (int m = gw; m < T; m += 2 * NGW) {
                const int m2 = m + NGW;
                const GAS f32x4* xr = (const GAS f32x4*)(args.in[0] + (size_t)m * D) + lane0; const GAS f32x4* xr2 = (const GAS f32x4*)(args.in[0] + (size_t)m2 * D) + lane0;
                GAS unsigned long long* o8 = (GAS unsigned long long*)(xb + (size_t)m * D) + lane0; GAS unsigned long long* o82 = (GAS unsigned long long*)(xb + (size_t)m2 * D) + lane0;
                f32x4 va[4], vb[4];
#pragma unroll
                for (int j = 0; j < 4; ++j) { va[j] = xr[64 * j]; vb[j] = xr2[64 * j]; }
                float s = 0.f, s2 = 0.f;
#pragma unroll
                for (int j = 0; j < 4; ++j) { const f32x4 v = va[j], w = vb[j]; s += (v.x * v.x + v.y * v.y) + (v.z * v.z + v.w * v.w); s2 += (w.x * w.x + w.y * w.y) + (w.z * w.z + w.w * w.w);
                    o8[64 * j] = (unsigned long long)pk2(v.x, v.y) | ((unsigned long long)pk2(v.z, v.w) << 32); o82[64 * j] = (unsigned long long)pk2(w.x, w.y) | ((unsigned long long)pk2(w.z, w.w) << 32); }
                s = wave_sum(s); s2 = wave_sum(s2);
                ss16_store(ss, m, s, lane0); ss16_store(ss, m2, s2, lane0);
            }
        } else if (p == 1 && (MK_ONLY & 2)) {
            pg8::SchedStd S; S.init(xb, D, wl + WL_IN, D, T, ZG, G, (int)blockIdx.x);
            S.fix = (rep == 0 && MK_VAR == 8) ? 1 : 0;
            pg8::EpiIn E{zg, ss1, args.in[3] + l * 64, args.in[4] + l * 64, args.in[6] + l * 64, args.in[7] + l * 64, args.in[15] + l * GW, (args.pad >> 25) & 1};
            pg8::gemm_phase<pg8::EpiIn, pg8::SchedStd, true, true>(lds + RING_OFF, D, D, S, E);
        } else if (p == 2 && (MK_ONLY & 4)) {
            const float lam_init = 0.8f - 0.6f * __expf(-0.3f * (float)l);
            int ln = threadIdx.x; asm volatile("" : "+v"(ln)); ln &= 63;
            const float d1 = wave_sum(args.in[8][l * 64 + ln] * args.in[9][l * 64 + ln]), d2 = wave_sum(args.in[10][l * 64 + ln] * args.in[11][l * 64 + ln]);
            const float lam = __expf(d1) - __expf(d2) + lam_init;
            att::attn_tables(lds, lutg, args.in[12] + l * 128, 1.0f - lam_init);
            const int dsel = args.pad >> 16;
            if (rep == 1 || dsel != 2)
            for (int ui = vcu; ui < 512; ui += G) { const int bh = ui >> 4, qb = ui & 15; if (rep == 0 && MK_VAR == 7 && (vcu & 1)) {} else if (rep == 0) att::attn_unit<true, (MK_VAR == 7 ? 0 : MK_VAR)>(lds, zg, lutg, bh >> 2, bh & 3, qb * 128, nullptr, lam, 1.0f - lam_init, args.in[12] + l * 128, mix);
                else att::attn_unit<true, 0>(lds, zg, lutg, bh >> 2, bh & 3, qb * 128, nullptr, lam, 1.0f - lam_init, args.in[12] + l * 128, nullptr); }
            if (rep == 1 || dsel != 1)
            for (int ui = vcu; ui < 512; ui += G) { const int bk = ui >> 5, qb = ui & 31; att::attn_unit<false>(lds, zg, lutg, bk >> 1, bk & 1, qb * 64, args.in[5] + l * HA, 0.f, 0.f, nullptr, rep == 0 ? mix : nullptr); }
        } else if (p == 3 && (MK_ONLY & 8)) {
            pg8::SchedMix S; S.b.init(zg + C_QA, ZG, wl + WL_A, 512, T, D, G, (int)blockIdx.x); S.A1 = (const char*)(zg + C_QB); S.Bt1 = (const char*)(wl + WL_B);
            pg8::EpiMix E{zg, mix};
            pg8::gemm_phase<pg8::EpiMix, pg8::SchedMix, true, true>(lds + RING_OFF, 512, ZG, S, E);
        } else if (p == 4 && (MK_ONLY & 16)) {
            pg8::SchedStd S; S.init(mix, D, wl + WL_O, D, T, D, G, (int)blockIdx.x);
            pg8::EpiRes E{l == 0 ? args.in[0] : xf, xf, xb, ss2};
            pg8::gemm_phase<pg8::EpiRes, pg8::SchedStd, true, true>(lds + RING_OFF, D, D, S, E);
        } else if (p == 5 && (MK_ONLY & 32)) {
            pg8::SchedStd S; S.init(xb, D, wl + WL_UP, D, T, FF2, G, (int)blockIdx.x);
            pg8::EpiUp E{abuf, ss2, args.in[21] + (size_t)l * 3 * FF2, args.in[22] + (size_t)l * FF2, yb, (args.pad >> 24) & 1};
            pg8::gemm_phase<pg8::EpiUp, pg8::SchedStd, true, true>(lds + RING_OFF, D, D, S, E);
        } else if (MK_ONLY & 64) {
            pg8::SchedDown S; S.b.init(abuf, FF, wl + WL_DN, FF, T, D, G, (int)blockIdx.x); S.yb = (args.pad & 1) ? nullptr : yb; S.cw = args.in[21] + (size_t)l * 3 * FF2; S.cb = args.in[22] + (size_t)l * FF2; S.a = abuf;
            pg8::EpiRes E{xf, xf, ss3 ? xb : nullptr, ss3};
            pg8::gemm_phase<pg8::EpiRes, pg8::SchedDown, true, true>(lds + RING_OFF, FF, FF, S, E);
        }
        }
        if (ph + 1 < args.ph_hi) xcd_barrier(bar);
    }
}
}

#ifndef MK_MODE
#define MK_MODE 0x7f
#endif
extern "C" void kernel_launch(void* const* d_in, const int* in_sizes, int n_in, void* d_out, int out_size, void* d_ws, size_t ws_size, hipStream_t stream) {
    using namespace nv;
    static int grid = 0;
    if (grid == 0) {
        if (n_in != 24 || out_size != T * D || ws_size < mk::WS_END) { fprintf(stderr, "kernel_launch: unexpected shapes (n_in %d, out %d, ws %zu)\n", n_in, out_size, ws_size); grid = -1; return; }
        int dev = 0, cus = 0, per_cu = 0;
        if (hipGetDevice(&dev) != hipSuccess || hipDeviceGetAttribute(&cus, hipDeviceAttributeMultiprocessorCount, dev) != hipSuccess) { grid = -1; return; }
        if (hipFuncSetAttribute((const void*)mk::skel_fwd, hipFuncAttributeMaxDynamicSharedMemorySize, mk::LDS_BYTES) != hipSuccess) { fprintf(stderr, "kernel_launch: hipFuncSetAttribute failed\n"); grid = -1; return; }
        if (hipOccupancyMaxActiveBlocksPerMultiprocessor(&per_cu, (const void*)mk::skel_fwd, mk::NWAVES * 64, mk::LDS_BYTES) != hipSuccess || per_cu < 1) fprintf(stderr, "kernel_launch: occupancy query says %d\n", per_cu);
        (void)hipGetLastError();
        grid = cus;
    }
    if (grid < 0) return;
    const float* in[24]; for (int i = 0; i < 24; ++i) in[i] = (const float*)d_in[i];
    unsigned char* ws = (unsigned char*)d_ws;
    float* xf = (float*)d_out; float* ss = (float*)(ws + mk::WS_SS); bf16* xb = (bf16*)(ws + mk::WS_XB); bf16* zg = (bf16*)(ws + mk::WS_ZG); bf16* abuf = (bf16*)(ws + mk::WS_A);
    bf16* mix = (bf16*)(ws + mk::WS_MIX); float* tmpA = (float*)(ws + mk::WS_TMPA); float* tmpB = (float*)(ws + mk::WS_TMPB);
    if (hipMemsetAsync(ws + mk::WS_CTL, 0, mk::CTL_ZERO_BYTES, stream) != hipSuccess) { fprintf(stderr, "kernel_launch: memset failed\n"); return; }
    mk::Args a{}; for (int i = 0; i < 24; ++i) a.in[i] = in[i]; a.out = xf; a.ws = ws;
    int li = 0;
#define MK_RUN(lo, hi) do { a.ph_lo = (lo); a.ph_hi = (hi); a.li = li++; hipLaunchKernelGGL(mk::skel_fwd, dim3(grid), dim3(mk::NWAVES * 64), mk::LDS_BYTES, stream, a); } while (0)
#ifndef MK_DUP
#define MK_DUP 0
#endif
#define MK_DSEL 0
    if (MK_MODE == 0x7f) { a.pad = (MK_DUP << 8) | (MK_DSEL << 16) | (MK_EDUP << 24); MK_RUN(0, mk::N_PHASES); return; }
    MK_RUN(0, 1);
    for (int l = 0; l < L; ++l) {
        const float lam_init = 0.8f - 0.6f * expf(-0.3f * (float)l);
        float* ss1 = ss + (size_t)((2 * l) & 3) * T * 16; float* ss2 = ss + (size_t)((2 * l + 1) & 3) * T * 16; float* ss3 = (l + 1 < L) ? ss + (size_t)((2 * l + 2) & 3) * T * 16 : nullptr;
        const int pb = 1 + 6 * l;
        if (MK_MODE & 2) MK_RUN(pb, pb + 1);
        else for (int b = 0; b < B; ++b) { const int row0 = b * S;
            n_gemm<bf16><<<dim3(INW / 64, S / 64), 256, 0, stream>>>(xb + (size_t)row0 * D, D, in[1] + l * D, in[2] + (size_t)l * D * INW, INW, tmpA, INW, D);
            n_post_in<<<S, 256, 0, stream>>>(tmpA, ss1, in[3] + l * 64, in[4] + l * 64, in[6] + l * 64, in[7] + l * 64, zg, row0);
            n_gemm<bf16><<<dim3(GW / 64, S / 64), 256, 0, stream>>>(xb + (size_t)row0 * D, D, in[1] + l * D, in[14] + (size_t)l * D * GW, GW, tmpA, GW, D);
            n_post_gate<<<S, 256, 0, stream>>>(tmpA, ss1, in[15] + l * GW, zg, row0); }
        if (MK_MODE & 4) MK_RUN(pb + 1, pb + 2);
        else { n_attn_a<<<dim3(T, HA), 64, 0, stream>>>(zg, in[5] + l * HA, in[13]);
               n_attn_b<<<dim3(T, HB), 256, 0, stream>>>(zg, in[13], in[8] + l * 64, in[9] + l * 64, in[10] + l * 64, in[11] + l * 64, in[12] + l * 128, lam_init); }
        if (MK_MODE & 8) MK_RUN(pb + 2, pb + 3);
        else for (int b = 0; b < B; ++b) { const int row0 = b * S;
            n_gemm<bf16><<<dim3(D / 64, S / 64), 256, 0, stream>>>(zg + (size_t)row0 * ZG + C_QA, ZG, nullptr, in[16] + (size_t)l * 512 * D, D, tmpA, D, 512);
            n_gemm<bf16><<<dim3(D / 64, S / 64), 256, 0, stream>>>(zg + (size_t)row0 * ZG + C_QB, ZG, nullptr, in[17] + (size_t)l * 512 * D, D, tmpB, D, 512);
            n_post_mix<<<S, 256, 0, stream>>>(tmpA, tmpB, zg, mix, row0); }
        if (MK_MODE & 16) MK_RUN(pb + 3, pb + 4);
        else for (int b = 0; b < B; ++b) { const int row0 = b * S;
            n_gemm<bf16><<<dim3(D / 64, S / 64), 256, 0, stream>>>(mix + (size_t)row0 * D, D, nullptr, in[18] + (size_t)l * D * D, D, tmpA, D, D);
            n_post_res<<<S, 256, 0, stream>>>(tmpA, xf, xb, ss2, row0); }
        if ((MK_MODE & 32) && (MK_MODE & 64)) { MK_RUN(pb + 4, pb + 6); }
        else {
            for (int b = 0; b < B; ++b) { const int row0 = b * S;
                for (int hf = 0; hf < 2; ++hf) { const int j0 = hf * HW;
                    n_gemm<bf16><<<dim3(HW / 64, S / 64), 256, 0, stream>>>(xb + (size_t)row0 * D, D, in[19] + l * D, in[20] + (size_t)l * D * FF2 + j0, FF2, tmpA, 2 * HW, D);
                    n_gemm<bf16><<<dim3(HW / 64, S / 64), 256, 0, stream>>>(xb + (size_t)row0 * D, D, in[19] + l * D, in[20] + (size_t)l * D * FF2 + FF + j0, FF2, tmpA + HW, 2 * HW, D);
                    n_post_conv<<<S, 256, 0, stream>>>(tmpA, ss2, in[21] + (size_t)l * 3 * FF2, in[22] + (size_t)l * FF2, abuf, row0, j0); } }
            if (MK_MODE & 64) { a.pad = 1; MK_RUN(pb + 5, pb + 6); a.pad = 0; }
            else for (int b = 0; b < B; ++b) { const int row0 = b * S;
                n_gemm<bf16><<<dim3(D / 64, S / 64), 256, 0, stream>>>(abuf + (size_t)row0 * FF, FF, nullptr, in[23] + (size_t)l * FF * D, D, tmpA, D, FF);
                n_post_res<<<S, 256, 0, stream>>>(tmpA, xf, xb, ss3, row0); }
        }
    }
}
```

```cpp
#include <hip/hip_runtime.h>
#include <cstdio>
#include <cstdint>
#include <cmath>
#define MK_EDUP 0

namespace nv {
typedef unsigned short bf16;
constexpr int D = 1024, B = 8, S = 2048, T = B * S, L = 4;
constexpr int HA = 8, KVA = 2, HB = 4, HD = 64;
constexpr int INW = 2304, GW = 2048, ZG = INW + GW;
constexpr int FF = 2816, FF2 = 2 * FF;
constexpr int C_QA = 0, C_KA = 512, C_VA = 640, C_QB = 768, C_KB = 1280, C_VB = 1792, C_G = 2304;
constexpr float EPS = 1e-6f;
constexpr float LOG2E = 1.4426950408889634f;
constexpr float C2 = 0.125f * LOG2E;

__device__ __forceinline__ float bf2f(bf16 v) { return __uint_as_float(((unsigned)v) << 16); }
__device__ __forceinline__ bf16 f2bf(float f) { unsigned u = __float_as_uint(f); return (bf16)((u + 0x7fffu + ((u >> 16) & 1u)) >> 16); }
__device__ __forceinline__ float ldf(const float* p) { return *p; }
__device__ __forceinline__ float ldf(const bf16* p) { return bf2f(*p); }

__device__ __forceinline__ int t5_bucket(int rel) {
    const int n = rel < 0 ? -rel : rel; int v;
    if (n < 8) v = n; else if (n < 12) v = 8; else if (n < 16) v = 9; else if (n < 23) v = 10; else if (n < 32) v = 11;
    else if (n < 46) v = 12; else if (n < 64) v = 13; else if (n < 91) v = 14; else v = 15;
    return (rel > 0 ? 16 : 0) + v;
}
__device__ __forceinline__ float ss16(const float* ss, int t) { const float4* p = (const float4*)(ss + (size_t)t * 16); const float4 a = p[0], b = p[1], c = p[2], d = p[3];
    return ((a.x + a.y) + (a.z + a.w)) + ((b.x + b.y) + (b.z + b.w)) + ((c.x + c.y) + (c.z + c.w)) + ((d.x + d.y) + (d.z + d.w)); }
__device__ __forceinline__ void ss16_store(float* ss, int t, float s, int lane) { if (lane < 16) ss[(size_t)t * 16 + lane] = lane == 0 ? s : 0.f; }
__device__ __forceinline__ float wave_sum(float v) {
#pragma unroll
    for (int o = 1; o < 64; o <<= 1) v += __shfl_xor(v, o);
    return v;
}
__device__ __forceinline__ float wave_max(float v) {
#pragma unroll
    for (int o = 1; o < 64; o <<= 1) v = fmaxf(v, __shfl_xor(v, o));
    return v;
}

template <typename TA>
__global__ void __launch_bounds__(256) n_gemm(const TA* __restrict__ A, int lda, const float* __restrict__ gk, const float* __restrict__ W, int ldw, float* __restrict__ C, int ldc, int K) {
    __shared__ float As[16][68];
    __shared__ float Ws[16][64];
    const int tid = threadIdx.x, tx = tid & 15, ty = tid >> 4;
    const int m0 = blockIdx.y * 64, n0 = blockIdx.x * 64;
    float acc[4][4];
#pragma unroll
    for (int i = 0; i < 4; ++i)
#pragma unroll
        for (int j = 0; j < 4; ++j) acc[i][j] = 0.f;
    for (int k0 = 0; k0 < K; k0 += 16) {
#pragma unroll
        for (int i = 0; i < 4; ++i) { const int e = tid + i * 256, r = e >> 4, c = e & 15; float v = ldf(A + (size_t)(m0 + r) * lda + k0 + c); if (gk) v *= gk[k0 + c]; As[c][r] = v; }
#pragma unroll
        for (int i = 0; i < 4; ++i) { const int e = tid + i * 256, r = e >> 6, c = e & 63; Ws[r][c] = W[(size_t)(k0 + r) * ldw + n0 + c]; }
        __syncthreads();
#pragma unroll
        for (int kk = 0; kk < 16; ++kk) {
            float a[4], b[4];
#pragma unroll
            for (int i = 0; i < 4; ++i) { a[i] = As[kk][ty * 4 + i]; b[i] = Ws[kk][tx * 4 + i]; }
#pragma unroll
            for (int i = 0; i < 4; ++i)
#pragma unroll
                for (int j = 0; j < 4; ++j) acc[i][j] += a[i] * b[j];
        }
        __syncthreads();
    }
#pragma unroll
    for (int i = 0; i < 4; ++i)
#pragma unroll
        for (int j = 0; j < 4; ++j) C[(size_t)(m0 + ty * 4 + i) * ldc + n0 + tx * 4 + j] = acc[i][j];
}

__global__ void __launch_bounds__(256) n_init_x(const float* __restrict__ x, float* __restrict__ xf, bf16* __restrict__ xb, float* __restrict__ ss) {
    const int row = blockIdx.x * 4 + (threadIdx.x >> 6), lane = threadIdx.x & 63;
    float s = 0.f;
    for (int c = lane; c < D; c += 64) { const float v = x[(size_t)row * D + c]; xf[(size_t)row * D + c] = v; xb[(size_t)row * D + c] = f2bf(v); s += v * v; }
    s = wave_sum(s);
    ss16_store(ss, row, s, lane);
}

__global__ void __launch_bounds__(256) n_post_in(const float* __restrict__ Z, const float* __restrict__ ss, const float* __restrict__ qn_a, const float* __restrict__ kn_a,
                                                 const float* __restrict__ qn_b, const float* __restrict__ kn_b, bf16* __restrict__ zg, int row0) {
    const int r = blockIdx.x, t = row0 + r, wave = threadIdx.x >> 6, lane = threadIdx.x & 63;
    const float rs = rsqrtf(ss16(ss, t) * (1.0f / D) + EPS);
    for (int g = wave; g < INW / 64; g += 4) {
        float v = Z[(size_t)r * INW + g * 64 + lane] * rs;
        const float* gain = nullptr; float sc = 1.f;
        if (g < 8) { gain = qn_a; sc = C2; } else if (g < 10) { gain = kn_a; } else if (g < 12) { } else if (g < 20) { gain = qn_b; sc = C2; } else if (g < 28) { gain = kn_b; }
        if (gain) { const float q = wave_sum(v * v); v = v * rsqrtf(q * (1.0f / 64.0f) + EPS) * gain[lane] * sc; }
        zg[(size_t)t * ZG + g * 64 + lane] = f2bf(v);
    }
}
__global__ void __launch_bounds__(256) n_post_gate(const float* __restrict__ G, const float* __restrict__ ss, const float* __restrict__ bg, bf16* __restrict__ zg, int row0) {
    const int r = blockIdx.x, t = row0 + r;
    const float rs = rsqrtf(ss16(ss, t) * (1.0f / D) + EPS);
    for (int c = threadIdx.x; c < GW; c += 256) { const float v = G[(size_t)r * GW + c] * rs + bg[c]; zg[(size_t)t * ZG + C_G + c] = f2bf(1.0f / (1.0f + __expf(-v))); }
}

__global__ void __launch_bounds__(64) n_attn_a(bf16* __restrict__ zg, const float* __restrict__ sink, const float* __restrict__ rel_bias) {
    __shared__ float qs[64]; __shared__ float ps[5 * 64];
    const int t = blockIdx.x, h = blockIdx.y, lane = threadIdx.x, b = t / S, s = t % S, kv = h >> 2;
    qs[lane] = bf2f(zg[(size_t)t * ZG + C_QA + h * 64 + lane]);
    __syncthreads();
    const int j0 = s - 128;
    float sc[5]; float m = sink[h] * LOG2E;
#pragma unroll
    for (int i = 0; i < 5; ++i) {
        const int jj = i * 64 + lane, j = j0 + jj; float v = -1e30f;
        if (jj <= 256 && j >= 0 && j < S) {
            const bf16* kp = zg + (size_t)(b * S + j) * ZG + C_KA + kv * 64; float d = 0.f;
            for (int e = 0; e < 64; ++e) d += qs[e] * bf2f(kp[e]);
            v = d + rel_bias[t5_bucket(j - s) * 12 + h] * LOG2E;
        }
        sc[i] = v; m = fmaxf(m, v);
    }
    m = wave_max(m);
    float l = 0.f;
#pragma unroll
    for (int i = 0; i < 5; ++i) { const float p = (sc[i] > -1e29f) ? exp2f(sc[i] - m) : 0.f; ps[i * 64 + lane] = p; l += p; }
    l = wave_sum(l) + exp2f(sink[h] * LOG2E - m);
    __syncthreads();
    float o = 0.f;
    for (int jj = 0; jj <= 256; ++jj) { const int j = j0 + jj; if (j >= 0 && j < S) o += ps[jj] * bf2f(zg[(size_t)(b * S + j) * ZG + C_VA + kv * 64 + lane]); }
    zg[(size_t)t * ZG + C_QA + h * 64 + lane] = f2bf(o / l);
}

__global__ void __launch_bounds__(256) n_attn_b(bf16* __restrict__ zg, const float* __restrict__ rel_bias, const float* __restrict__ lq1, const float* __restrict__ lk1,
                                               const float* __restrict__ lq2, const float* __restrict__ lk2, const float* __restrict__ subg, float lam_init) {
    __shared__ float qs[128]; __shared__ float av[S]; __shared__ float s1s[S]; __shared__ float red[8]; __shared__ float osum[256];
    const int t = blockIdx.x, h = blockIdx.y, tid = threadIdx.x, lane = tid & 63, wave = tid >> 6, b = t / S, s = t % S;
    if (tid < 128) qs[tid] = bf2f(zg[(size_t)t * ZG + C_QB + h * 128 + tid]);
    float d1 = wave_sum(lq1[lane] * lk1[lane]), d2 = wave_sum(lq2[lane] * lk2[lane]);
    const float lam = __expf(d1) - __expf(d2) + lam_init;
    __syncthreads();
    float m0 = -1e30f, m1 = -1e30f;
#pragma unroll 1
    for (int i = 0; i < 8; ++i) {
        const int j = i * 256 + tid; const bf16* kp = zg + (size_t)(b * S + j) * ZG + C_KB + h * 128; float a0 = 0.f, a1 = 0.f;
#pragma unroll 8
        for (int e = 0; e < 64; ++e) { a0 += qs[e] * bf2f(kp[e]); a1 += qs[64 + e] * bf2f(kp[64 + e]); }
        const float bi = rel_bias[t5_bucket(j - s) * 12 + 8 + h] * LOG2E;
        a0 += bi; a1 += bi; av[j] = a0; s1s[j] = a1; m0 = fmaxf(m0, a0); m1 = fmaxf(m1, a1);
    }
    m0 = wave_max(m0); m1 = wave_max(m1);
    if (lane == 0) { red[wave] = m0; red[4 + wave] = m1; }
    __syncthreads();
    m0 = fmaxf(fmaxf(red[0], red[1]), fmaxf(red[2], red[3])); m1 = fmaxf(fmaxf(red[4], red[5]), fmaxf(red[6], red[7]));
    __syncthreads();
    float l0 = 0.f, l1 = 0.f;
#pragma unroll 1
    for (int i = 0; i < 8; ++i) { const int j = i * 256 + tid; const float p0 = exp2f(av[j] - m0), p1 = exp2f(s1s[j] - m1); av[j] = p0; s1s[j] = p1; l0 += p0; l1 += p1; }
    l0 = wave_sum(l0); l1 = wave_sum(l1);
    if (lane == 0) { red[wave] = l0; red[4 + wave] = l1; }
    __syncthreads();
    l0 = (red[0] + red[1]) + (red[2] + red[3]); l1 = (red[4] + red[5]) + (red[6] + red[7]);
#pragma unroll 1
    for (int i = 0; i < 8; ++i) { const int j = i * 256 + tid; av[j] = av[j] / l0 - lam * (s1s[j] / l1); }
    __syncthreads();
    const int e = tid & 127, half = tid >> 7; float o = 0.f;
    for (int j = half * 1024; j < half * 1024 + 1024; ++j) o += av[j] * bf2f(zg[(size_t)(b * S + j) * ZG + C_VB + h * 128 + e]);
    osum[tid] = o;
    __syncthreads();
    float ov = 0.f, q = 0.f;
    if (tid < 128) { ov = osum[tid] + osum[tid + 128]; q = ov * ov; }
    q = wave_sum(q);
    __syncthreads();
    if (lane == 0) red[wave] = q;
    __syncthreads();
    const float qq = red[0] + red[1];
    if (tid < 128) zg[(size_t)t * ZG + C_QB + h * 128 + tid] = f2bf(ov * rsqrtf(qq * (1.0f / 128.0f) + EPS) * subg[tid] * (1.0f - lam_init));
}

__global__ void __launch_bounds__(256) n_post_mix(const float* __restrict__ PA, const float* __restrict__ PB, const bf16* __restrict__ zg, bf16* __restrict__ mix, int row0) {
    const int r = blockIdx.x, t = row0 + r;
    for (int c = threadIdx.x; c < D; c += 256) {
        const float ga = bf2f(zg[(size_t)t * ZG + C_G + c]), gb = bf2f(zg[(size_t)t * ZG + C_G + D + c]);
        mix[(size_t)t * D + c] = f2bf(ga * PA[(size_t)r * D + c] + gb * PB[(size_t)r * D + c]);
    }
}
__global__ void __launch_bounds__(256) n_post_res(const float* __restrict__ tmp, float* __restrict__ xf, bf16* __restrict__ xb, float* __restrict__ ss_out, int row0) {
    __shared__ float red[4];
    const int r = blockIdx.x, t = row0 + r, lane = threadIdx.x & 63, wave = threadIdx.x >> 6; float s = 0.f;
    for (int c = threadIdx.x; c < D; c += 256) { const float v = xf[(size_t)t * D + c] + tmp[(size_t)r * D + c]; xf[(size_t)t * D + c] = v; xb[(size_t)t * D + c] = f2bf(v); s += v * v; }
    s = wave_sum(s); if (lane == 0) red[wave] = s;
    __syncthreads();
    if (ss_out) ss16_store(ss_out, t, (red[0] + red[1]) + (red[2] + red[3]), threadIdx.x);
}
constexpr int HW = FF / 2;
__global__ void __launch_bounds__(256) n_post_conv(const float* __restrict__ U, const float* __restrict__ ss, const float* __restrict__ cw, const float* __restrict__ cb, bf16* __restrict__ a, int row0, int j0) {
    const int r = blockIdx.x, t = row0 + r;
    const float rs1 = rsqrtf(ss16(ss, t) * (1.0f / D) + EPS);
    const float rs0 = r > 0 ? rsqrtf(ss16(ss, t - 1) * (1.0f / D) + EPS) : 0.f;
    const float rs2 = r < S - 1 ? rsqrtf(ss16(ss, t + 1) * (1.0f / D) + EPS) : 0.f;
    for (int j = threadIdx.x; j < HW; j += 256) {
        float u[2];
#pragma unroll
        for (int gsel = 0; gsel < 2; ++gsel) {
            const int col = gsel * FF + j0 + j, uc = gsel * HW + j;
            const float y1 = U[(size_t)r * (2 * HW) + uc] * rs1;
            const float y0 = r > 0 ? U[(size_t)(r - 1) * (2 * HW) + uc] * rs0 : 0.f;
            const float y2 = r < S - 1 ? U[(size_t)(r + 1) * (2 * HW) + uc] * rs2 : 0.f;
            u[gsel] = cb[col] + cw[col] * y0 + cw[FF2 + col] * y1 + cw[2 * FF2 + col] * y2;
        }
        const float sg = u[1] / (1.0f + __expf(-u[1]));
        a[(size_t)t * FF + j0 + j] = f2bf(sg * u[0]);
    }
}
__global__ void __launch_bounds__(256) n_rowss(const float* __restrict__ xf, float* __restrict__ ss_out) {
    const int row = blockIdx.x * 4 + (threadIdx.x >> 6), lane = threadIdx.x & 63; float s = 0.f;
    for (int c = lane; c < D; c += 64) { const float v = xf[(size_t)row * D + c]; s += v * v; }
    s = wave_sum(s); ss16_store(ss_out, row, s, lane);
}
}


namespace pg8 {
using namespace nv;
#define PG8_LAS __attribute__((address_space(3)))
typedef unsigned short bf16_t;
typedef short bf16x8 __attribute__((ext_vector_type(8)));
typedef float f32x4 __attribute__((ext_vector_type(4)));
typedef unsigned u32x4 __attribute__((ext_vector_type(4)));
typedef unsigned u32x2 __attribute__((ext_vector_type(2)));
constexpr int BM = 256, BK = 64, HALF = 128, HTB = HALF * BK * 2  , STAGE_BYTES = 8 * HTB, NXCD = 8, WGM = 8;
constexpr int XOFF = 131072 + 1024;

__host__ __device__ __forceinline__ int lds_byte(int r, int c) { const int st = (r >> 4) * 2 + (c >> 5), rr = r & 15, cc = c & 31, ob = rr * 64 + cc * 2; return st * 1024 + (ob ^ (((ob >> 9) & 1) << 5)); }
__host__ __device__ __forceinline__ void stage_rc(int b, int& R, int& C) { const int st = b / 1024, sb = b % 1024, swz = sb ^ (((sb >> 9) & 1) << 5); R = (st >> 1) * 16 + swz / 64; C = (st & 1) * 32 + (swz % 64) / 2; }
__host__ __device__ __forceinline__ int perm32(int rho) { const int n = rho >> 4, i = rho & 15; return 8 * (i >> 2) + 4 * n + (i & 3); }

struct Unit { int pm, pn, z; };
typedef float f32x2 __attribute__((ext_vector_type(2))); typedef __bf16 bf16x2_t __attribute__((ext_vector_type(2)));
__device__ __forceinline__ unsigned cvt_pk_bf16(float lo, float hi) { f32x2 v = {lo, hi}; bf16x2_t b = __builtin_convertvector(v, bf16x2_t); return __builtin_bit_cast(unsigned, b); }
__device__ __forceinline__ float bflo(unsigned w) { return __uint_as_float(w << 16); }
__device__ __forceinline__ float bfhi(unsigned w) { return __uint_as_float(w & 0xffff0000u); }

struct SchedStd {
    int nM, nN, nwg, G, c, fix, one, opm, opn; const char* A; const char* Bt; size_t at, bt;
    __device__ void init(const void* A_, int lda, const void* Bt_, int K, int M, int N, int G_, int c_) { fix = 0; one = 0; opm = 0; opn = 0; nM = M / BM; nN = N / BM; nwg = nM * nN; G = G_; c = c_; A = (const char*)A_; Bt = (const char*)Bt_; at = (size_t)BM * lda * 2; bt = (size_t)BM * K * 2; }
    __device__ bool next(int i, Unit& u) const {
        if (one) { if (i > 0) return false; u.pm = opm; u.pn = opn; u.z = 0; return true; }
        const long L = (long)i * G + c; if (L >= nwg) return false;
        int wgid = (int)L; { const int q = nwg / NXCD, r = nwg % NXCD, xcd = wgid % NXCD, off = wgid / NXCD; wgid = (xcd < r ? xcd * (q + 1) : r * (q + 1) + (xcd - r) * q) + off; }
        const int nig = WGM * nN, gid = wgid / nig, fm = gid * WGM, gsz = (nM - fm) < WGM ? (nM - fm) : WGM;
        u.pm = fm + ((wgid % nig) % gsz); u.pn = (wgid % nig) / gsz; u.z = 0; if (fix) { u.pm = 0; u.pn = 0; } return true;
    }
    __device__ __forceinline__ const char* aptr(const Unit& u) const { return A + (size_t)u.pm * at; }
    __device__ __forceinline__ const char* bptr(const Unit& u) const { return Bt + (size_t)u.pn * bt; }
    __device__ __forceinline__ void a_ready(const Unit&) const {}
    __device__ __forceinline__ void done(const Unit&) const {}
};
struct SchedMix {
    SchedStd b; const char* A1; const char* Bt1;
    __device__ bool next(int i, Unit& u) const { if (!b.next(i >> 1, u)) return false; u.z = i & 1; return true; }
    __device__ __forceinline__ const char* aptr(const Unit& u) const { return (u.z ? A1 : b.A) + (size_t)u.pm * b.at; }
    __device__ __forceinline__ const char* bptr(const Unit& u) const { return (u.z ? Bt1 : b.Bt) + (size_t)u.pn * b.bt; }
    __device__ __forceinline__ void a_ready(const Unit&) const {}
    __device__ __forceinline__ void done(const Unit&) const {}
};
struct SchedDown {
    SchedStd b; const float* yb; const float* cw; const float* cb; bf16_t* a;
    __device__ bool next(int i, Unit& u) const { return b.next(i, u); }
    __device__ __forceinline__ const char* aptr(const Unit& u) const { return b.aptr(u); }
    __device__ __forceinline__ const char* bptr(const Unit& u) const { return b.bptr(u); }
    __device__ __forceinline__ void a_ready(const Unit& u) const {
        const int pm = u.pm;
        if (yb)
        for (int idx = threadIdx.x; idx < 2 * FF; idx += 512) {
            const int which = idx >= FF ? 1 : 0, j = idx - which * FF;
            float uv[2];
#pragma unroll
            for (int gs = 0; gs < 2; ++gs) {
                const int col = gs * FF + j; float y0, y1, y2;
                if (which == 0) { y0 = (pm & 7) ? yb[((size_t)(pm - 1) * 4 + 3) * FF2 + col] : 0.f; y1 = yb[((size_t)pm * 4 + 0) * FF2 + col]; y2 = yb[((size_t)pm * 4 + 1) * FF2 + col]; }
                else { y0 = yb[((size_t)pm * 4 + 2) * FF2 + col]; y1 = yb[((size_t)pm * 4 + 3) * FF2 + col]; y2 = ((pm & 7) != 7) ? yb[((size_t)(pm + 1) * 4 + 0) * FF2 + col] : 0.f; }
                uv[gs] = cb[col] + cw[col] * y0 + cw[FF2 + col] * y1 + cw[2 * FF2 + col] * y2;
            }
            const float sg = uv[1] * __builtin_amdgcn_rcpf(1.0f + __builtin_amdgcn_exp2f(-uv[1] * LOG2E));
            a[(size_t)(pm * BM + which * 255) * FF + j] = f2bf(sg * uv[0]);
        }
        asm volatile("s_waitcnt vmcnt(0)" ::: "memory");
        __builtin_amdgcn_s_barrier();
        asm volatile("" ::: "memory");
    }
    __device__ __forceinline__ void done(const Unit&) const {}
};

struct EpiIn {
    static constexpr bool PERM = true, AFTER_DRAIN = false;
    __device__ static constexpr bool zero_after(const Unit&) { return true; }
    bf16_t* zg; const float* ss; const float *qn_a, *kn_a, *qn_b, *kn_b, *bg; int dup;
    __device__ __forceinline__ void operator()(f32x4 (&acc)[2][2][4][2], const Unit& u, int wr, int wc, int fr, int fq, PG8_LAS unsigned char*) const {
#pragma unroll
        for (int rep_ = 0; rep_ <= ((MK_EDUP & 2) ? 1 : 0); ++rep_) {
        if (rep_) {
#pragma unroll
            for (int ai = 0; ai < 2; ++ai)
#pragma unroll
                for (int bj = 0; bj < 2; ++bj)
#pragma unroll
                    for (int m = 0; m < 4; ++m)
#pragma unroll
                        for (int n = 0; n < 2; ++n) asm volatile("" : "+v"(acc[ai][bj][m][n]) :: "memory");
        }
        const int g = u.pn * 4 + wc, colb = u.pn * BM + wc * 64 + 8 * fq;
        const float* gain = nullptr; float sc = 1.f; int mode = 0;
        if (g < 8) { gain = qn_a; sc = C2; mode = 1; } else if (g < 10) { gain = kn_a; mode = 1; } else if (g < 12) { mode = 0; } else if (g < 20) { gain = qn_b; sc = C2; mode = 1; }
        else if (g < 28) { gain = kn_b; mode = 1; } else if (g < 36) { mode = 0; } else { mode = 2; }
        f32x4 gv[2][2];
#pragma unroll
        for (int bj = 0; bj < 2; ++bj)
#pragma unroll
            for (int n = 0; n < 2; ++n) {
                if (mode == 1) gv[bj][n] = *(const f32x4*)(gain + 32 * bj + 8 * fq + 4 * n) * sc;
                else if (mode == 2) gv[bj][n] = *(const f32x4*)(bg + (colb - C_G) + 32 * bj + 4 * n);
                else gv[bj][n] = (f32x4){1.f, 1.f, 1.f, 1.f};
            }
#pragma unroll
        for (int ai = 0; ai < 2; ++ai)
#pragma unroll
            for (int m = 0; m < 4; ++m) {
                const int row = u.pm * BM + ai * HALF + wr * 64 + m * 16 + fr;
                const float rs = rsqrtf(ss16(ss, row) * (1.0f / D) + EPS);
                f32x4 v[2][2];
#pragma unroll
                for (int bj = 0; bj < 2; ++bj)
#pragma unroll
                    for (int n = 0; n < 2; ++n) v[bj][n] = acc[ai][bj][m][n] * rs;
                if (mode == 1) {
                    float q = 0.f;
#pragma unroll
                    for (int bj = 0; bj < 2; ++bj)
#pragma unroll
                        for (int n = 0; n < 2; ++n) { const f32x4 x = v[bj][n]; q += (x[0] * x[0] + x[1] * x[1]) + (x[2] * x[2] + x[3] * x[3]); }
                    q += __shfl_xor(q, 16); q += __shfl_xor(q, 32);
                    const float r2 = rsqrtf(q * (1.0f / 64.0f) + EPS);
#pragma unroll
                    for (int bj = 0; bj < 2; ++bj)
#pragma unroll
                        for (int n = 0; n < 2; ++n) v[bj][n] = v[bj][n] * r2 * gv[bj][n];
                } else if (mode == 2) {
#pragma unroll
                    for (int bj = 0; bj < 2; ++bj)
#pragma unroll
                        for (int n = 0; n < 2; ++n) { f32x4 x = v[bj][n] + gv[bj][n];
#pragma unroll
                            for (int e = 0; e < 4; ++e) x[e] = __builtin_amdgcn_rcpf(1.0f + __builtin_amdgcn_exp2f(-x[e] * LOG2E));
                            v[bj][n] = x; }
                }
                bf16_t* rowp = zg + (size_t)row * ZG + colb;
#pragma unroll
                for (int bj = 0; bj < 2; ++bj) { u32x4 w; w.x = cvt_pk_bf16(v[bj][0][0], v[bj][0][1]); w.y = cvt_pk_bf16(v[bj][0][2], v[bj][0][3]); w.z = cvt_pk_bf16(v[bj][1][0], v[bj][1][1]); w.w = cvt_pk_bf16(v[bj][1][2], v[bj][1][3]);
                    *(u32x4*)(rowp + 32 * bj) = w; }
            }
        }
    }
};
struct EpiMix {
    static constexpr bool PERM = true, AFTER_DRAIN = false;
    __device__ static bool zero_after(const Unit& u) { return u.z != 0; }
    const bf16_t* zg; bf16_t* mix;
    __device__ __forceinline__ void operator()(f32x4 (&acc)[2][2][4][2], const Unit& u, int wr, int wc, int fr, int fq, PG8_LAS unsigned char*) const {
        const int col0 = u.pn * BM + wc * 32 + 8 * fq;
#pragma unroll
        for (int ai = 0; ai < 2; ++ai)
#pragma unroll
            for (int m = 0; m < 4; ++m) {
                const int row = u.pm * BM + ai * HALF + wr * 64 + m * 16 + fr;
#pragma unroll
                for (int bj = 0; bj < 2; ++bj) {
                    const int col = col0 + bj * HALF;
                    const u32x4 gb = *(const u32x4*)(zg + (size_t)row * ZG + C_G + D + col);
                    if (u.z == 0) {
                        const u32x4 ga = *(const u32x4*)(zg + (size_t)row * ZG + C_G + col);
                        f32x4 r0, r1;
                        r0[0] = bflo(ga.x) * __builtin_amdgcn_rcpf(bflo(gb.x)); r0[1] = bfhi(ga.x) * __builtin_amdgcn_rcpf(bfhi(gb.x)); r0[2] = bflo(ga.y) * __builtin_amdgcn_rcpf(bflo(gb.y)); r0[3] = bfhi(ga.y) * __builtin_amdgcn_rcpf(bfhi(gb.y));
                        r1[0] = bflo(ga.z) * __builtin_amdgcn_rcpf(bflo(gb.z)); r1[1] = bfhi(ga.z) * __builtin_amdgcn_rcpf(bfhi(gb.z)); r1[2] = bflo(ga.w) * __builtin_amdgcn_rcpf(bflo(gb.w)); r1[3] = bfhi(ga.w) * __builtin_amdgcn_rcpf(bfhi(gb.w));
                        acc[ai][bj][m][0] *= r0; acc[ai][bj][m][1] *= r1;
                    } else {
                        const f32x4 v0 = acc[ai][bj][m][0] * (f32x4){bflo(gb.x), bfhi(gb.x), bflo(gb.y), bfhi(gb.y)}, v1 = acc[ai][bj][m][1] * (f32x4){bflo(gb.z), bfhi(gb.z), bflo(gb.w), bfhi(gb.w)};
                        u32x4 w; w.x = cvt_pk_bf16(v0[0], v0[1]); w.y = cvt_pk_bf16(v0[2], v0[3]); w.z = cvt_pk_bf16(v1[0], v1[1]); w.w = cvt_pk_bf16(v1[2], v1[3]);
                        *(u32x4*)(mix + (size_t)row * D + col) = w;
                    }
                }
            }
    }
};
struct EpiRes {
    static constexpr bool PERM = false, AFTER_DRAIN = false;
    __device__ static constexpr bool zero_after(const Unit&) { return true; }
    const float* base; float* xf; bf16_t* xb; float* ssn;
    __device__ __forceinline__ void operator()(f32x4 (&acc)[2][2][4][2], const Unit& u, int wr, int wc, int fr, int fq, PG8_LAS unsigned char*) const {
        const int col0 = u.pn * BM + wc * 32 + 4 * fq;
#pragma unroll
        for (int ai = 0; ai < 2; ++ai)
#pragma unroll
            for (int m = 0; m < 4; ++m) {
                const int row = u.pm * BM + ai * HALF + wr * 64 + m * 16 + fr; const size_t off = (size_t)row * D + col0; float q = 0.f;
#pragma unroll
                for (int bj = 0; bj < 2; ++bj)
#pragma unroll
                    for (int n = 0; n < 2; ++n) { const f32x4 bs = *(const f32x4*)(base + off + bj * HALF + n * 16); const f32x4 o = bs + acc[ai][bj][m][n];
                        *(f32x4*)(xf + off + bj * HALF + n * 16) = o; q += (o[0] * o[0] + o[1] * o[1]) + (o[2] * o[2] + o[3] * o[3]);
                        if (xb) { u32x2 w; w.x = cvt_pk_bf16(o[0], o[1]); w.y = cvt_pk_bf16(o[2], o[3]); *(u32x2*)(xb + off + bj * HALF + n * 16) = w; } }
                if (ssn) { q += __shfl_xor(q, 16); q += __shfl_xor(q, 32); if (fq == 0) ssn[(size_t)row * 16 + u.pn * 4 + wc] = q; }
                if (m & 1) asm volatile("" ::: "memory");
            }
    }
};
#define DPPF(oldv, src, ctrl, bc) __int_as_float(__builtin_amdgcn_update_dpp(__float_as_int(oldv), __float_as_int(src), (ctrl), 0xF, 0xF, (bc)))
struct EpiUp {
    static constexpr bool PERM = true, AFTER_DRAIN = false;
    __device__ static constexpr bool zero_after(const Unit&) { return true; }
    bf16_t* a; const float* ss; const float* cw; const float* cb; float* yb; int dup;
    __device__ __forceinline__ void operator()(f32x4 (&acc)[2][2][4][2], const Unit& u, int wr, int wc, int fr, int fq, PG8_LAS unsigned char* lds) const {
        const int wid = wr * 4 + wc;
        PG8_LAS float* X = (PG8_LAS float*)(lds + XOFF);
#pragma unroll
        for (int ai = 0; ai < 2; ++ai)
#pragma unroll
            for (int m = 0; m < 4; ++m) {
                const int row = u.pm * BM + ai * HALF + wr * 64 + m * 16 + fr;
                const float rs = rsqrtf(ss16(ss, row) * (1.0f / D) + EPS);
#pragma unroll
                for (int bj = 0; bj < 2; ++bj)
#pragma unroll
                    for (int n = 0; n < 2; ++n) acc[ai][bj][m][n] *= rs;
            }
#pragma unroll
        for (int ai = 0; ai < 2; ++ai) {
            if (fr == 0) {
#pragma unroll
                for (int bj = 0; bj < 2; ++bj)
#pragma unroll
                    for (int n = 0; n < 2; ++n) *(PG8_LAS f32x4*)(X + ((wid * 2 + ai) * 2 + 0) * 64 + 32 * bj + 8 * fq + 4 * n) = acc[ai][bj][0][n];
            }
            if (fr == 15) {
#pragma unroll
                for (int bj = 0; bj < 2; ++bj)
#pragma unroll
                    for (int n = 0; n < 2; ++n) *(PG8_LAS f32x4*)(X + ((wid * 2 + ai) * 2 + 1) * 64 + 32 * bj + 8 * fq + 4 * n) = acc[ai][bj][3][n];
            }
        }
        {
            const int ccol = u.pn * 128 + wc * 32 + 8 * fq;
            if (wr == 0 && fr < 2) {
#pragma unroll
                for (int bj = 0; bj < 2; ++bj)
#pragma unroll
                    for (int n = 0; n < 2; ++n) *(f32x4*)(yb + ((size_t)u.pm * 4 + fr) * FF2 + bj * FF + ccol + 4 * n) = acc[0][bj][0][n];
            }
            if (wr == 1 && fr >= 14) {
#pragma unroll
                for (int bj = 0; bj < 2; ++bj)
#pragma unroll
                    for (int n = 0; n < 2; ++n) *(f32x4*)(yb + ((size_t)u.pm * 4 + 2 + (fr - 14)) * FF2 + bj * FF + ccol + 4 * n) = acc[1][bj][3][n];
            }
        }
        asm volatile("s_waitcnt lgkmcnt(0)" ::: "memory"); __builtin_amdgcn_s_barrier(); asm volatile("" ::: "memory");
#pragma unroll
        for (int rep_ = 0; rep_ <= ((MK_EDUP & 1) ? 1 : 0); ++rep_) {
        if (rep_) {
#pragma unroll
            for (int ai = 0; ai < 2; ++ai)
#pragma unroll
                for (int bj = 0; bj < 2; ++bj)
#pragma unroll
                    for (int m = 0; m < 4; ++m)
#pragma unroll
                        for (int n = 0; n < 2; ++n) asm volatile("" : "+v"(acc[ai][bj][m][n]) :: "memory");
        }
#pragma unroll
        for (int n = 0; n < 2; ++n) {
            const int ccol = u.pn * 128 + wc * 32 + 8 * fq + 4 * n;
            f32x4 w0[2], w1[2], w2[2], bb[2];
#pragma unroll
            for (int bj = 0; bj < 2; ++bj) { w0[bj] = *(const f32x4*)(cw + bj * FF + ccol); w1[bj] = *(const f32x4*)(cw + FF2 + bj * FF + ccol); w2[bj] = *(const f32x4*)(cw + 2 * FF2 + bj * FF + ccol); bb[bj] = *(const f32x4*)(cb + bj * FF + ccol); }
#pragma unroll
            for (int ai = 0; ai < 2; ++ai) {
                const int pw = wr ? wid - 4 : wid + 4, pai = wr ? ai : 0;
                const int nw = wr ? wid - 4 : wid + 4, nai = wr ? 1 : ai;
                f32x4 xp[2], xn[2];
#pragma unroll
                for (int bj = 0; bj < 2; ++bj) { xp[bj] = *(PG8_LAS f32x4*)(X + ((pw * 2 + pai) * 2 + 1) * 64 + 32 * bj + 8 * fq + 4 * n); xn[bj] = *(PG8_LAS f32x4*)(X + ((nw * 2 + nai) * 2 + 0) * 64 + 32 * bj + 8 * fq + 4 * n); }
#pragma unroll
                for (int m = 0; m < 4; ++m) {
                    const int trow = ai * HALF + wr * 64 + m * 16 + fr;
                    float uv[2][4];
#pragma unroll
                    for (int bj = 0; bj < 2; ++bj)
#pragma unroll
                        for (int e = 0; e < 4; ++e) {
                            const float cur = acc[ai][bj][m][n][e];
                            float rp, rn;
                            if (m > 0) rp = DPPF(0.f, acc[ai][bj][m > 0 ? m - 1 : 0][n][e], 0x121, true); else rp = xp[bj][e];
                            if (m < 3) rn = DPPF(0.f, acc[ai][bj][m < 3 ? m + 1 : 3][n][e], 0x12F, true); else rn = xn[bj][e];
                            const float prev = DPPF(rp, cur, 0x111, false), next = DPPF(rn, cur, 0x101, false);
                            uv[bj][e] = bb[bj][e] + w0[bj][e] * prev + w1[bj][e] * cur + w2[bj][e] * next;
                        }
                    f32x4 o;
#pragma unroll
                    for (int e = 0; e < 4; ++e) o[e] = uv[0][e] * uv[1][e] * __builtin_amdgcn_rcpf(1.0f + __builtin_amdgcn_exp2f(-uv[1][e] * LOG2E));
                    u32x2 w; w.x = cvt_pk_bf16(o[0], o[1]); w.y = cvt_pk_bf16(o[2], o[3]);
                    if (trow != 0 && trow != 255) *(u32x2*)(a + (size_t)(u.pm * BM + trow) * FF + ccol) = w;
                    asm volatile("" ::: "memory");
                }
            }
        }
        }
    }
};

template <class Epi, class Sched, bool ALIGN_EPI = false, bool SP2 = false>
__device__ __forceinline__ void gemm_phase(PG8_LAS unsigned char* lds, const int K, const int lda, const Sched& S, const Epi& E) {
    int tid_ = threadIdx.x; asm volatile("" : "+v"(tid_));
    const int tid = tid_, wid = __builtin_amdgcn_readfirstlane(tid >> 6), lane = tid & 63, wr = wid >> 2, wc = wid & 3, fr = lane & 15, fq = lane >> 4;
    const int nt = K / BK;
    unsigned voffA[2], voffB[2];
#pragma unroll
    for (int i = 0; i < 2; ++i) { int R, C; stage_rc(tid * 16 + i * 8192, R, C); const int Rb = Epi::PERM ? ((R & ~31) + perm32(R & 31)) : R;
        voffA[i] = (unsigned)(R * lda + C) * 2u; voffB[i] = (unsigned)(Rb * K + C) * 2u; }
    const size_t kstep = (size_t)(BK * 2);
    const size_t hstepB = (size_t)HALF * K * 2;
    const size_t hstepA = (size_t)HALF * lda * 2;
    const unsigned ldsw = (unsigned)wid * 1024u;
    const int aoff = lds_byte(wr * 64 + fr, fq * 8), boff = lds_byte(wc * 32 + fr, fq * 8);
#define PG8_SA(b, h) (((b) * 2 + (h)) * HTB)
#define PG8_SB(b, h) ((4 + (b) * 2 + (h)) * HTB)
#define PG8_STAGE(bufoff, gbase, voff) do { _Pragma("unroll") for (int _i = 0; _i < 2; ++_i) \
        __builtin_amdgcn_global_load_lds((const unsigned*)((const char*)(gbase) + (voff)[_i]), (PG8_LAS unsigned*)(lds + (bufoff) + ldsw + _i * 8192), 16, 0, 0); } while (0)
#define PG8_LDA(dst, b, h) do { _Pragma("unroll") for (int m = 0; m < 4; ++m) _Pragma("unroll") for (int k = 0; k < 2; ++k) dst[m][k] = *(const PG8_LAS bf16x8*)(lds + PG8_SA(b, h) + aoff + m * 2048 + k * 1024); } while (0)
#define PG8_LDB(dst, b, h) do { _Pragma("unroll") for (int n = 0; n < 2; ++n) _Pragma("unroll") for (int k = 0; k < 2; ++k) dst[n][k] = *(const PG8_LAS bf16x8*)(lds + PG8_SB(b, h) + boff + n * 2048 + k * 1024); } while (0)
#define PG8_MMA(ai, bj, At, Bt) do { __builtin_amdgcn_s_setprio(1); _Pragma("unroll") for (int m = 0; m < 4; ++m) _Pragma("unroll") for (int n = 0; n < 2; ++n) _Pragma("unroll") for (int k = 0; k < 2; ++k) \
        acc[ai][bj][m][n] = __builtin_amdgcn_mfma_f32_16x16x32_bf16(Bt[n][k], At[m][k], acc[ai][bj][m][n], 0, 0, 0); __builtin_amdgcn_s_setprio(0); } while (0)
#define PG8_WAIT_V(n) asm volatile("s_waitcnt vmcnt(" #n ")" ::: "memory")
#define PG8_WAIT_L(n) asm volatile("s_waitcnt lgkmcnt(" #n ")" ::: "memory")
#define PG8_BAR __builtin_amdgcn_s_barrier()
#define PG8_SCHED __builtin_amdgcn_sched_barrier(0)
    Unit cur, nxt; int ui = 0;
    if (!S.next(0, cur)) return;
    f32x4 acc[2][2][4][2];
#pragma unroll
    for (int a = 0; a < 2; ++a)
#pragma unroll
        for (int b = 0; b < 2; ++b)
#pragma unroll
            for (int m = 0; m < 4; ++m)
#pragma unroll
                for (int n = 0; n < 2; ++n) acc[a][b][m][n] = (f32x4){0.f, 0.f, 0.f, 0.f};
    bf16x8 At[4][2], B0[2][2], B1[2][2];
    const char* cA = S.aptr(cur); const char* cB = S.bptr(cur);
    S.a_ready(cur);
    if constexpr (SP2) {
        PG8_STAGE(PG8_SB(0, 0), cB, voffB); PG8_STAGE(PG8_SB(0, 1), cB + hstepB, voffB); PG8_STAGE(PG8_SA(0, 0), cA, voffA); PG8_STAGE(PG8_SA(0, 1), cA + hstepA, voffA);
        if (wr == 1) PG8_BAR;
        PG8_WAIT_V(2); PG8_BAR;
        PG8_STAGE(PG8_SB(1, 0), cB + kstep, voffB); PG8_STAGE(PG8_SA(1, 0), cA + kstep, voffA); PG8_STAGE(PG8_SB(1, 1), cB + hstepB + kstep, voffB);
        PG8_WAIT_V(6); PG8_BAR;
    } else {
        PG8_STAGE(PG8_SB(0, 0), cB, voffB); PG8_STAGE(PG8_SA(0, 0), cA, voffA); PG8_STAGE(PG8_SB(0, 1), cB + hstepB, voffB); PG8_STAGE(PG8_SA(0, 1), cA + hstepA, voffA);
        if (wr == 1) PG8_BAR;
        PG8_WAIT_V(4); PG8_BAR;
        PG8_STAGE(PG8_SB(1, 0), cB + kstep, voffB); PG8_STAGE(PG8_SA(1, 0), cA + kstep, voffA); PG8_STAGE(PG8_SB(1, 1), cB + hstepB + kstep, voffB);
        PG8_WAIT_V(6); PG8_BAR;
    }
    for (;;) {
        const bool has_next = S.next(ui + 1, nxt);
        const char* nA = has_next ? S.aptr(nxt) : cA; const char* nB = has_next ? S.bptr(nxt) : cB;
        for (int t = 0; t < nt; t += 2) {
            const bool last = (t == nt - 2);
            const char* a1 = cA + (size_t)(t + 1) * kstep;
            const char* a2 = last ? nA : cA + (size_t)(t + 2) * kstep; const char* b2 = last ? nB : cB + (size_t)(t + 2) * kstep;
            const char* a3 = a2 + kstep; const char* b3 = b2 + kstep;
            if (last && has_next) S.a_ready(nxt);
            if constexpr (SP2) {
            PG8_LDB(B0, 0, 0); PG8_LDB(B1, 0, 1); PG8_SCHED; PG8_LDA(At, 0, 0); PG8_STAGE(PG8_SA(1, 1), a1 + hstepA, voffA);
            PG8_WAIT_V(8); PG8_WAIT_L(0); PG8_BAR; PG8_MMA(0, 0, At, B0); PG8_MMA(0, 1, At, B1); PG8_BAR; PG8_SCHED;
            PG8_LDA(At, 0, 1); PG8_STAGE(PG8_SB(0, 0), b2, voffB); PG8_STAGE(PG8_SB(0, 1), b2 + hstepB, voffB); PG8_STAGE(PG8_SA(0, 0), a2, voffA);
            PG8_WAIT_V(8); PG8_WAIT_L(0); PG8_BAR; PG8_MMA(1, 0, At, B0); PG8_MMA(1, 1, At, B1); PG8_BAR; PG8_SCHED;
            PG8_LDB(B0, 1, 0); PG8_LDB(B1, 1, 1); PG8_SCHED; PG8_LDA(At, 1, 0); PG8_STAGE(PG8_SA(0, 1), a2 + hstepA, voffA);
            PG8_WAIT_V(8); PG8_WAIT_L(0); PG8_BAR; PG8_MMA(0, 0, At, B0); PG8_MMA(0, 1, At, B1); PG8_BAR; PG8_SCHED;
            PG8_LDA(At, 1, 1); PG8_STAGE(PG8_SB(1, 0), b3, voffB); PG8_STAGE(PG8_SB(1, 1), b3 + hstepB, voffB); PG8_STAGE(PG8_SA(1, 0), a3, voffA);
            PG8_WAIT_V(8); PG8_WAIT_L(0); PG8_BAR; PG8_MMA(1, 0, At, B0); PG8_MMA(1, 1, At, B1); PG8_BAR; PG8_SCHED;
            } else {
            PG8_LDB(B0, 0, 0); PG8_SCHED; PG8_LDA(At, 0, 0); PG8_STAGE(PG8_SA(1, 1), a1 + hstepA, voffA);
            PG8_WAIT_L(8); PG8_BAR; PG8_WAIT_L(0); PG8_MMA(0, 0, At, B0); PG8_BAR; PG8_SCHED;
            PG8_LDB(B1, 0, 1); PG8_STAGE(PG8_SB(0, 0), b2, voffB);
            PG8_BAR; PG8_WAIT_L(0); PG8_MMA(0, 1, At, B1); PG8_BAR;
            PG8_LDA(At, 0, 1); PG8_STAGE(PG8_SA(0, 0), a2, voffA);
            PG8_BAR; PG8_WAIT_L(0); PG8_MMA(1, 0, At, B0); PG8_BAR; PG8_SCHED;
            PG8_STAGE(PG8_SB(0, 1), b2 + hstepB, voffB);
            PG8_WAIT_V(6); PG8_BAR; PG8_MMA(1, 1, At, B1); PG8_BAR;
            PG8_LDB(B0, 1, 0); PG8_SCHED; PG8_LDA(At, 1, 0); PG8_STAGE(PG8_SA(0, 1), a2 + hstepA, voffA);
            PG8_WAIT_L(8); PG8_BAR; PG8_WAIT_L(0); PG8_MMA(0, 0, At, B0); PG8_BAR; PG8_SCHED;
            PG8_LDB(B1, 1, 1); PG8_STAGE(PG8_SB(1, 0), b3, voffB);
            PG8_BAR; PG8_WAIT_L(0); PG8_MMA(0, 1, At, B1); PG8_BAR;
            PG8_LDA(At, 1, 1); PG8_STAGE(PG8_SA(1, 0), a3, voffA);
            PG8_BAR; PG8_WAIT_L(0); PG8_MMA(1, 0, At, B0); PG8_BAR; PG8_SCHED;
            PG8_STAGE(PG8_SB(1, 1), b3 + hstepB, voffB);
            PG8_WAIT_V(6); PG8_BAR; PG8_MMA(1, 1, At, B1); PG8_BAR;
            }
        }
        if constexpr (ALIGN_EPI) { if (wr == 0) PG8_BAR; }
        if constexpr (!Epi::AFTER_DRAIN) { E(acc, cur, wr, wc, fr, fq, lds); S.done(cur); }
        if (!has_next) break;
        if (Epi::zero_after(cur)) {
#pragma unroll
        for (int a = 0; a < 2; ++a)
#pragma unroll
            for (int b = 0; b < 2; ++b)
#pragma unroll
                for (int m = 0; m < 4; ++m)
#pragma unroll
                    for (int n = 0; n < 2; ++n) acc[a][b][m][n] = (f32x4){0.f, 0.f, 0.f, 0.f};
        }
        cur = nxt; cA = nA; cB = nB; ++ui;
        if constexpr (ALIGN_EPI) { if (wr == 1) PG8_BAR; }
    }
    PG8_WAIT_V(0);
    if constexpr (!ALIGN_EPI) { if (wr == 0) PG8_BAR; }
    PG8_BAR;
    if constexpr (Epi::AFTER_DRAIN) { E.fused(acc, cur, wr, wc, fr, fq, lds, wid, lane); S.done(cur); }
#undef PG8_SA
#undef PG8_SB
#undef PG8_STAGE
#undef PG8_LDA
#undef PG8_LDB
#undef PG8_MMA
#undef PG8_WAIT_V
#undef PG8_WAIT_L
#undef PG8_BAR
#undef PG8_SCHED
}
}

namespace att {
using namespace nv;
#define ALAS __attribute__((address_space(3)))
typedef short bf16x8 __attribute__((ext_vector_type(8)));
typedef short s16x4 __attribute__((ext_vector_type(4)));
typedef float f32x16 __attribute__((ext_vector_type(16)));
typedef float f32x4 __attribute__((ext_vector_type(4)));
typedef unsigned u32x4 __attribute__((ext_vector_type(4)));
typedef unsigned u32x2 __attribute__((ext_vector_type(2)));
typedef short v4i16_t __attribute__((ext_vector_type(4)));
typedef float f32x2_t __attribute__((ext_vector_type(2))); typedef __bf16 bf16x2_t __attribute__((ext_vector_type(2)));
constexpr int LUT_OFF = 98304, LUT_STRIDE = 520, GT_OFF = LUT_OFF + 12 * LUT_STRIDE * 4;
static_assert(GT_OFF + 512 <= 131072, "attention tables inside the ring region");
constexpr float NEG = -30000.f, THR = 6.f;
__device__ __forceinline__ unsigned cvtpk(float lo, float hi) { f32x2_t v = {lo, hi}; bf16x2_t b = __builtin_convertvector(v, bf16x2_t); return __builtin_bit_cast(unsigned, b); }
__device__ __forceinline__ s16x4 vtr(ALAS const unsigned char* p) { return __builtin_bit_cast(s16x4, __builtin_amdgcn_ds_read_tr16_b64_v4i16((ALAS v4i16_t*)p)); }
__device__ __forceinline__ void glds16(const void* gsrc, unsigned lds_dst) { unsigned keep;
    asm volatile("s_mov_b32 %0, m0\n\ts_mov_b32 m0, %2\n\ts_nop 0\n\tglobal_load_lds_dwordx4 %1, off\n\ts_mov_b32 m0, %0" : "=&s"(keep) : "v"(gsrc), "s"(lds_dst) : "memory"); }
__device__ __forceinline__ float swap_add(float v) { auto rr = __builtin_amdgcn_permlane32_swap(__float_as_uint(v), __float_as_uint(v), false, false); return __uint_as_float(rr[0]) + __uint_as_float(rr[1]); }
__device__ __forceinline__ float swap_max(float v) { auto rr = __builtin_amdgcn_permlane32_swap(__float_as_uint(v), __float_as_uint(v), false, false); return fmaxf(__uint_as_float(rr[0]), __uint_as_float(rr[1])); }
#define MX3(a, b, c) __builtin_fmaxf(__builtin_fmaxf((a), (b)), (c))

__device__ __forceinline__ void attn_tables(ALAS unsigned char* lds, const float* __restrict__ lutg, const float* __restrict__ subg, float osc) {
    int tid = threadIdx.x; asm volatile("" : "+v"(tid));
    ALAS float* lut = (ALAS float*)(lds + LUT_OFF); ALAS float* gt = (ALAS float*)(lds + GT_OFF);
    for (int i = tid; i < 12 * LUT_STRIDE; i += 512) lut[i] = lutg[i];
    if (tid < 128) gt[tid] = subg[tid] * osc;
    __syncthreads();
}
template <bool ISB, int VAR = 0>
__device__ __forceinline__ void attn_unit(ALAS unsigned char* lds, bf16* zg, const float* __restrict__ lutg, int b, int hsel, int q0, const float* __restrict__ sinkp, float lam, float osc, const float* __restrict__ subg, bf16* odry) {
    int tid_ = threadIdx.x; asm volatile("" : "+v"(tid_));
    const int tid = tid_, lane = tid & 63, r32 = lane & 31, hi = lane >> 5; const int wid = __builtin_amdgcn_readfirstlane(tid >> 6);
    constexpr int NDV = ISB ? 4 : 2, BUF = ISB ? 32768 : 16384, VOFF = ISB ? 16384 : 8192;
    const int map = ISB ? (wid >> 2) : 0, qsub = ISB ? (wid & 3) : (wid & 1), gsel = ISB ? 0 : (wid >> 1);
    const int head = ISB ? hsel : hsel * 4 + gsel;
    const int qrow0 = q0 + 32 * qsub;
    const int qcol = ISB ? (C_QB + head * 128 + map * 64) : (C_QA + head * 64);
    const int kcol = ISB ? (C_KB + head * 128) : (C_KA + hsel * 64);
    const int vcol = ISB ? (C_VB + head * 128) : (C_VA + hsel * 64);
    const size_t rowbase = (size_t)b * S;
    int kt0 = 0, kt1 = S / 64;
    if (!ISB) { kt0 = q0 / 64 - 2; if (kt0 < 0) kt0 = 0; kt1 = q0 / 64 + 3; if (kt1 > S / 64) kt1 = S / 64; }
    const int nt = kt1 - kt0;
    ALAS float* lut = (ALAS float*)(lds + LUT_OFF) + (ISB ? 8 + head : hsel * 4 + gsel) * LUT_STRIDE;
    ALAS float* gt = (ALAS float*)(lds + GT_OFF);
    const float sink2 = ISB ? 0.f : sinkp[head] * LOG2E;
    bf16x8 qr[4];
    { const bf16* qp = zg + (rowbase + qrow0 + r32) * ZG + qcol + hi * 8;
#pragma unroll
      for (int d0 = 0; d0 < 4; ++d0) qr[d0] = *(const bf16x8*)(qp + d0 * 16); }
    const unsigned lds0 = (unsigned)(size_t)lds;
    const bf16* kp_[2]; const bf16* vp_[2];
#pragma unroll
    for (int i_ = 0; i_ < 2; ++i_) { const int p_ = ISB ? wid * 2 + i_ : wid;
        kp_[i_] = zg + (rowbase + (size_t)kt0 * 64 + lane) * ZG + kcol + (ISB ? (p_ >> 3) * 64 + (p_ & 7) * 8 : wid * 8);
        vp_[i_] = zg + (rowbase + (size_t)kt0 * 64 + 16 * (p_ & 3) + (lane >> 2)) * ZG + vcol + 32 * (p_ >> 2) + 8 * (lane & 3); }
#define ATT_ISSUE(bo) do { \
        _Pragma("unroll") for (int i_ = 0; i_ < (ISB ? 2 : 1); ++i_) { const int p_ = ISB ? wid * 2 + i_ : wid; \
            glds16(kp_[i_], (unsigned)__builtin_amdgcn_readfirstlane((int)(lds0 + (bo) + p_ * 1024))); \
            glds16(vp_[i_], (unsigned)__builtin_amdgcn_readfirstlane((int)(lds0 + (bo) + VOFF + p_ * 1024))); \
            kp_[i_] += 64 * ZG; vp_[i_] += 64 * ZG; } } while (0)
#define ATT_SB() __builtin_amdgcn_sched_barrier(0)
    float mhat = 0.f, l = 0.f;
    f32x16 o[NDV];
#pragma unroll
    for (int d = 0; d < NDV; ++d)
#pragma unroll
        for (int r = 0; r < 16; ++r) o[d][r] = 0.f;
    const int kfo = (ISB ? map * 8192 : 0) + hi * 1024 + r32 * 16;
    const int vfo = VOFF + ((lane >> 4) & 1) * 32 + (lane & 3) * 8 + (4 * hi + ((lane & 15) >> 2)) * 64;
    u32x4 pw[4];
#define ATT_QK(P0, P1, t, so) do { const int kb_ = (t) * 64; float cf_ = 0.f; \
        if (ISB) { if (kb_ - qrow0 - 31 >= 91) cf_ = lut[256 + 128]; else if (kb_ + 63 - qrow0 <= -91) cf_ = lut[256 - 128]; } \
        const float c0_ = cf_ - mhat; f32x16 ci_; _Pragma("unroll") for (int r = 0; r < 16; ++r) ci_[r] = c0_; \
        ALAS const unsigned char* kp = lds + (so) + kfo; \
        P0 = __builtin_amdgcn_mfma_f32_32x32x16_bf16(*(ALAS const bf16x8*)(kp), qr[0], ci_, 0, 0, 0); \
        P1 = __builtin_amdgcn_mfma_f32_32x32x16_bf16(*(ALAS const bf16x8*)(kp + 512), qr[0], ci_, 0, 0, 0); \
        _Pragma("unroll") for (int d0 = 1; d0 < 4; ++d0) { \
            P0 = __builtin_amdgcn_mfma_f32_32x32x16_bf16(*(ALAS const bf16x8*)(kp + d0 * 2048), qr[d0], P0, 0, 0, 0); \
            P1 = __builtin_amdgcn_mfma_f32_32x32x16_bf16(*(ALAS const bf16x8*)(kp + d0 * 2048 + 512), qr[d0], P1, 0, 0, 0); } } while (0)
#define ATT_DECIDE(P0, P1, t, first) do { const int kb_ = (t) * 64; \
        if (!ISB || !((kb_ - qrow0 - 31 >= 91) || (kb_ + 63 - qrow0 <= -91))) { \
            ALAS const float* lp = lut + (kb_ - (qrow0 + r32) + 256 + 4 * hi); \
            _Pragma("unroll") for (int r = 0; r < 16; ++r) { P0[r] += lp[(r & 3) + 8 * (r >> 2)]; P1[r] += lp[32 + (r & 3) + 8 * (r >> 2)]; } } \
        float rm_; { float a = MX3(P0[0], P0[1], P1[0]), c = MX3(P0[2], P0[3], P1[1]); a = MX3(a, P1[2], P1[3]); \
            _Pragma("unroll") for (int r = 4; r < 16; r += 4) { a = MX3(a, P0[r], P0[r + 1]); c = MX3(c, P0[r + 2], P0[r + 3]); a = MX3(a, P1[r], P1[r + 1]); c = MX3(c, P1[r + 2], P1[r + 3]); } \
            rm_ = swap_max(__builtin_fmaxf(a, c)); } \
        if ((first) || __any(rm_ > THR)) { const float dl = (first) ? rm_ : __builtin_fmaxf(rm_, 0.f); mhat += dl; \
            _Pragma("unroll") for (int r = 0; r < 16; ++r) { P0[r] -= dl; P1[r] -= dl; } \
            if (!(first)) { const float f = __builtin_amdgcn_exp2f(-dl); l *= f; \
                _Pragma("unroll") for (int d = 0; d < NDV; ++d) _Pragma("unroll") for (int r = 0; r < 16; ++r) o[d][r] *= f; } } } while (0)
#define ATT_FINISH(P0, P1) do { float sacc = 0.f; \
        _Pragma("unroll") for (int r = 0; r < 16; ++r) { P0[r] = __builtin_amdgcn_exp2f(P0[r]); P1[r] = __builtin_amdgcn_exp2f(P1[r]); sacc += P0[r] + P1[r]; } \
        l += sacc; \
        pw[0] = (u32x4){cvtpk(P0[0], P0[1]), cvtpk(P0[2], P0[3]), cvtpk(P0[4], P0[5]), cvtpk(P0[6], P0[7])}; \
        pw[1] = (u32x4){cvtpk(P0[8], P0[9]), cvtpk(P0[10], P0[11]), cvtpk(P0[12], P0[13]), cvtpk(P0[14], P0[15])}; \
        pw[2] = (u32x4){cvtpk(P1[0], P1[1]), cvtpk(P1[2], P1[3]), cvtpk(P1[4], P1[5]), cvtpk(P1[6], P1[7])}; \
        pw[3] = (u32x4){cvtpk(P1[8], P1[9]), cvtpk(P1[10], P1[11]), cvtpk(P1[12], P1[13]), cvtpk(P1[14], P1[15])}; } while (0)
#define ATT_LDV(dst, d) do { _Pragma("unroll") for (int ks = 0; ks < 4; ++ks) { dst[2 * ks] = vtr(vp + (d) * 4096 + ks * 1024); dst[2 * ks + 1] = vtr(vp + (d) * 4096 + ks * 1024 + 512); } } while (0)
#define ATT_VF(src, ks) (bf16x8){src[2 * (ks)][0], src[2 * (ks)][1], src[2 * (ks)][2], src[2 * (ks)][3], src[2 * (ks) + 1][0], src[2 * (ks) + 1][1], src[2 * (ks) + 1][2], src[2 * (ks) + 1][3]}
#define ATT_PVD(src, d) do { __builtin_amdgcn_s_setprio(1); _Pragma("unroll") for (int ks = 0; ks < 4; ++ks) o[d] = __builtin_amdgcn_mfma_f32_32x32x16_bf16(ATT_VF(src, ks), __builtin_bit_cast(bf16x8, pw[ks]), o[d], 0, 0, 0); __builtin_amdgcn_s_setprio(0); } while (0)
#define ATT_PV(so) do { ALAS const unsigned char* vp = lds + (so) + vfo; s16x4 va[8], vb[8]; \
        ATT_LDV(va, 0); ATT_LDV(vb, 1); ATT_SB(); ATT_PVD(va, 0); ATT_SB(); \
        if (NDV == 4) { ATT_LDV(va, 2); ATT_SB(); ATT_PVD(vb, 1); ATT_SB(); ATT_LDV(vb, 3); ATT_SB(); ATT_PVD(va, 2); ATT_SB(); ATT_PVD(vb, 3); } \
        else { ATT_PVD(vb, 1); } } while (0)
#define ATT_SLOT(i) (ISB ? (((i) % 3) * BUF) : ((i) * BUF))
#define ATT_STEP(i, PC0, PC1, PP0, PP1) do { \
        if (ISB) { asm volatile("s_waitcnt vmcnt(0)" ::: "memory"); __syncthreads(); if ((i) + 1 < nt) ATT_ISSUE(ATT_SLOT((i) + 1)); } \
        ATT_QK(PC0, PC1, kt0 + (i), ATT_SLOT(i)); ATT_SB(); \
        ATT_FINISH(PP0, PP1); ATT_SB(); \
        ATT_PV(ATT_SLOT((i) - 1)); ATT_SB(); \
        ATT_DECIDE(PC0, PC1, kt0 + (i), false); ATT_SB(); } while (0)
    f32x16 pA0, pA1, pB0, pB1;
    if (ISB) { ATT_ISSUE(0); asm volatile("s_waitcnt vmcnt(0)" ::: "memory"); __syncthreads(); if (nt > 1) ATT_ISSUE(BUF); }
    else {
#pragma unroll 1
        for (int i = 0; i < nt; ++i) ATT_ISSUE(i * BUF);
        asm volatile("s_waitcnt vmcnt(0)" ::: "memory"); __syncthreads();
    }
    ATT_QK(pA0, pA1, kt0, 0); ATT_SB();
    ATT_DECIDE(pA0, pA1, kt0, true); ATT_SB();
    int i = 1;
#pragma unroll 1
    for (; i + 1 < nt; i += 2) {
        ATT_STEP(i, pB0, pB1, pA0, pA1);
        ATT_STEP(i + 1, pA0, pA1, pB0, pB1);
    }
    if (i < nt) {
        ATT_STEP(i, pB0, pB1, pA0, pA1);
        ATT_FINISH(pB0, pB1); ATT_SB(); ATT_PV(ATT_SLOT(nt - 1));
    } else {
        ATT_FINISH(pA0, pA1); ATT_SB(); ATT_PV(ATT_SLOT(nt - 1));
    }
#undef ATT_ISSUE
#undef ATT_SB
#undef ATT_QK
#undef ATT_DECIDE
#undef ATT_FINISH
#undef ATT_PV
#undef ATT_LDV
#undef ATT_VF
#undef ATT_PVD
#undef ATT_SLOT
#undef ATT_STEP
    l = swap_add(l);
    if (!ISB) l += __builtin_amdgcn_exp2f(sink2 - mhat);
    const float inv = 1.0f / l;
    bf16* orow = odry ? odry + (rowbase + qrow0 + r32) * D + (ISB ? (512 + head * 128) : (head * 64)) : zg + (rowbase + qrow0 + r32) * ZG + (ISB ? (C_QB + head * 128) : (C_QA + head * 64));
    if (ISB) {
        __syncthreads();
        ALAS float* cs = (ALAS float*)lds;
        if (map == 1) { const float sc = -lam * inv;
#pragma unroll
            for (int d = 0; d < NDV; ++d)
#pragma unroll
                for (int r = 0; r < 16; ++r) cs[(qsub * 64 + d * 16 + r) * 64 + lane] = o[d][r] * sc; }
        __syncthreads();
        if (map == 0) {
            float q = 0.f;
#pragma unroll
            for (int d = 0; d < NDV; ++d)
#pragma unroll
                for (int r = 0; r < 16; ++r) { const float v = o[d][r] * inv + cs[(qsub * 64 + d * 16 + r) * 64 + lane]; o[d][r] = v; q += v * v; }
            q = swap_add(q);
            const float rstd = rsqrtf(q * (1.0f / 128.0f) + EPS);
#pragma unroll
            for (int d = 0; d < NDV; ++d)
#pragma unroll
                for (int g4 = 0; g4 < 4; ++g4) { const int dv0 = 32 * d + 8 * g4 + 4 * hi; const f32x4 gv = *(ALAS const f32x4*)(gt + dv0);
                    u32x2 w; w.x = cvtpk(o[d][4 * g4] * rstd * gv[0], o[d][4 * g4 + 1] * rstd * gv[1]); w.y = cvtpk(o[d][4 * g4 + 2] * rstd * gv[2], o[d][4 * g4 + 3] * rstd * gv[3]);
                    *(u32x2*)(orow + dv0) = w; }
        }
    } else {
#pragma unroll
        for (int d = 0; d < NDV; ++d)
#pragma unroll
            for (int g4 = 0; g4 < 4; ++g4) { const int dv0 = 32 * d + 8 * g4 + 4 * hi;
                u32x2 w; w.x = cvtpk(o[d][4 * g4] * inv, o[d][4 * g4 + 1] * inv); w.y = cvtpk(o[d][4 * g4 + 2] * inv, o[d][4 * g4 + 3] * inv);
                *(u32x2*)(orow + dv0) = w; }
    }
    __syncthreads();
}
#undef MX3
}

#ifndef MK_VAR
#define MK_VAR 0
#endif
namespace mk {
using namespace nv;
constexpr int NWAVES = 8;
constexpr size_t MiB = 1u << 20;
constexpr size_t WS_CTL = 0, CTL_ZERO_BYTES = 1 * MiB;
constexpr size_t WS_LUT = 512 * 1024;
constexpr size_t WS_SS = 1 * MiB;
constexpr size_t WS_XB = 6 * MiB;
constexpr size_t WS_ZG = 38 * MiB;
constexpr size_t WS_A = 38 * MiB;
constexpr size_t WS_YB = 126 * MiB;
constexpr size_t WS_MIX = 174 * MiB;
constexpr size_t WS_W = 206 * MiB;
constexpr size_t WL_IN = 0, WL_A = (size_t)ZG * D, WL_B = WL_A + (size_t)D * 512, WL_O = WL_B + (size_t)D * 512, WL_UP = WL_O + (size_t)D * D, WL_DN = WL_UP + (size_t)FF2 * D, WL_END = WL_DN + (size_t)D * FF;
constexpr size_t WS_TMPA = 322 * MiB, WS_TMPB = 344 * MiB;
constexpr size_t WS_END = 352 * MiB;
static_assert(WS_W + 4 * WL_END * 2 <= WS_TMPA && WS_YB + (size_t)64 * 4 * FF2 * 4 <= WS_MIX && WS_A + (size_t)T * FF * 2 <= WS_YB, "d_ws map");
constexpr int CW_Q = 2048;
constexpr int CW_BAR = 4096;
constexpr int N_PHASES = 1 + 6 * L;
constexpr int RING_OFF = 0, RING_BYTES = 131072, LDSCTL_OFF = RING_BYTES, MISC_OFF = LDSCTL_OFF + 320;
constexpr int LDS_BYTES = 147456;
static_assert(pg8::XOFF + 8192 <= LDS_BYTES && MISC_OFF + 128 <= pg8::XOFF, "LDS map");

#define GAS __attribute__((address_space(1)))
#define LAS __attribute__((address_space(3)))
typedef unsigned v4u __attribute__((ext_vector_type(4)));
typedef float f32x4 __attribute__((ext_vector_type(4)));
typedef GAS unsigned gu32;
#define RLX_AGENT __ATOMIC_RELAXED, __HIP_MEMORY_SCOPE_AGENT
#define LDS_WAIT() asm volatile("s_waitcnt lgkmcnt(0)" ::: "memory")
#define VM_WAIT() asm volatile("s_waitcnt vmcnt(0)" ::: "memory")
__device__ __forceinline__ unsigned f2bfu(float f) { unsigned u = __builtin_bit_cast(unsigned, f); return (u + 0x7fffu + ((u >> 16) & 1u)) >> 16; }
__device__ __forceinline__ unsigned pk2(float lo, float hi) { return f2bfu(lo) | (f2bfu(hi) << 16); }

#define XB_TMO      128
#define XB_XCNT(j)  (256  + 64 * (j))
#define XB_XSUB(j)  (1280 + 64 * (j))
#define XB_XGEN(j)  (2304 + 64 * (j))
#define XB_TOP      3328
#define XB_TOPGEN   3392
#define XCD_BAR_WORDS 3456
#define XB_SPIN_CAP (1u << 18)

__device__ __forceinline__ unsigned xb_ld(unsigned* p)              { return __hip_atomic_load(p, __ATOMIC_RELAXED, __HIP_MEMORY_SCOPE_AGENT); }
__device__ __forceinline__ unsigned xb_add(unsigned* p, unsigned v) { return __hip_atomic_fetch_add(p, v, __ATOMIC_RELAXED, __HIP_MEMORY_SCOPE_AGENT); }
__device__ __forceinline__ unsigned xb_xcc_id() { return (unsigned)__builtin_amdgcn_s_getreg((3 << 11) | 20) & 0xFu; }
#define XB_SPIN(cond, bar) do { unsigned _sp = 0; while (cond) { __builtin_amdgcn_s_sleep(1); \
    if ((++_sp & 255u) == 0u) { if (xb_ld(&(bar)[XB_TMO])) break; if (_sp > XB_SPIN_CAP) { atomicAdd(&(bar)[XB_TMO], 1u); break; } } } } while (0)

struct XcdBarrier {
    unsigned* bar; unsigned x;
    volatile LAS unsigned* st;
};

__device__ __forceinline__ XcdBarrier xcd_barrier_post(unsigned* bar, volatile LAS unsigned* st) {
    XcdBarrier b; b.bar = bar; b.x = xb_xcc_id(); b.st = st;
    if (threadIdx.x == 0) (void)xb_add(&bar[XB_XCNT(b.x)], 1u);
    return b;
}
__device__ __forceinline__ void xcd_barrier_complete(unsigned* bar, unsigned x, unsigned& nloc, unsigned& nx) {
    const unsigned G = gridDim.x * gridDim.y * gridDim.z;
    unsigned sum, cnt, mine, sp = 0u;
    for (;;) {
        sum = 0u; cnt = 0u; mine = 0u;
#pragma unroll
        for (unsigned j = 0; j < 16; ++j) { const unsigned c = xb_ld(&bar[XB_XCNT(j)]); sum += c; cnt += (c > 0u) ? 1u : 0u; mine = (j == x) ? c : mine; }
        if (sum == G) break;
        __builtin_amdgcn_s_sleep(1);
        if ((++sp & 255u) == 0u) { if (xb_ld(&bar[XB_TMO])) break; if (sp > XB_SPIN_CAP) { atomicAdd(&bar[XB_TMO], 1u); break; } }
    }
    nloc = mine > 0u ? mine : 1u; nx = cnt > 0u ? cnt : 1u;
}

__device__ __forceinline__ void xcd_barrier(const XcdBarrier& b) {
    asm volatile("s_waitcnt vmcnt(0)" ::: "memory");
    __syncthreads();
    if (threadIdx.x == 0) {
        unsigned* bar = b.bar;
        __builtin_amdgcn_s_waitcnt(0);
        unsigned nloc = b.st[0], nx = b.st[1];
        if (nloc == 0u) { xcd_barrier_complete(bar, b.x, nloc, nx); b.st[0] = nloc; b.st[1] = nx; }
        const unsigned old = xb_add(&bar[XB_XSUB(b.x)], 1u);
        const unsigned gen = old / nloc;
        if (old + 1u == (gen + 1u) * nloc) {
            __builtin_amdgcn_fence(__ATOMIC_RELEASE, "agent");
            asm volatile("s_waitcnt vmcnt(0)" ::: "memory");
            const unsigned og = xb_add(&bar[XB_TOP], 1u);
            const unsigned tg = og / nx;
            if (og + 1u == (tg + 1u) * nx) xb_add(&bar[XB_TOPGEN], 1u);
            else XB_SPIN(xb_ld(&bar[XB_TOPGEN]) == tg, bar);
            __builtin_amdgcn_fence(__ATOMIC_ACQUIRE, "agent");
            xb_add(&bar[XB_XGEN(b.x)], 1u);
            asm volatile("s_waitcnt vmcnt(0)" ::: "memory");
        } else {
            XB_SPIN(xb_ld(&bar[XB_XGEN(b.x)]) == gen, bar);
            __builtin_amdgcn_fence(__ATOMIC_ACQUIRE, "agent");
            asm volatile("s_waitcnt vmcnt(0)" ::: "memory");
        }
    }
    __syncthreads();
}


struct Args { const float* in[24]; float* out; unsigned char* ws; int ph_lo, ph_hi, li, pad; };

__device__ __forceinline__ void p0_transpose_item(const float* __restrict__ W, int ldw, int K, int k0, int n0, bf16* __restrict__ WT, int vrow0, const float* __restrict__ gain, LAS float* scr, int lane) {
    float v[32];
    const float* wp = W + (size_t)(k0 + (lane >> 5)) * ldw + n0 + (lane & 31);
#pragma unroll
    for (int i = 0; i < 32; ++i) v[i] = __builtin_nontemporal_load(wp + (size_t)(2 * i) * ldw);
    if (gain) {
#pragma unroll
        for (int i = 0; i < 32; ++i) v[i] *= gain[k0 + 2 * i + (lane >> 5)];
    }
#pragma unroll
    for (int i = 0; i < 32; ++i) scr[(2 * i + (lane >> 5)) * 33 + (lane & 31)] = v[i];
    LDS_WAIT(); asm volatile("" ::: "memory");
    const int c = lane & 7;
#pragma unroll
    for (int j = 0; j < 4; ++j) { const int n = (lane >> 3) + 8 * j; const LAS float* s = scr + (8 * c) * 33 + n;
        v4u o; o.x = pk2(s[0 * 33], s[1 * 33]); o.y = pk2(s[2 * 33], s[3 * 33]); o.z = pk2(s[4 * 33], s[5 * 33]); o.w = pk2(s[6 * 33], s[7 * 33]);
        *(GAS v4u*)(WT + (size_t)(vrow0 + n) * K + k0 + 8 * c) = o; }
    LDS_WAIT(); asm volatile("" ::: "memory");
}
__device__ __forceinline__ int vrow_in(int c) { const int pn = c >> 8, cr = c & 255, wc = cr >> 6, bj = (cr >> 5) & 1; return pn * 256 + bj * 128 + wc * 32; }
__device__ __forceinline__ int vrow_up(int c) { const int gs = c >= FF ? 1 : 0, cc = c - gs * FF, pn = cc >> 7, wc = (cc >> 5) & 3; return pn * 256 + gs * 128 + wc * 32; }

__global__ void __launch_bounds__(NWAVES * 64, 2) skel_fwd(Args args) {
    extern __shared__ __attribute__((aligned(16))) unsigned char lds_raw[];
    LAS unsigned char* lds = (LAS unsigned char*)lds_raw;
    volatile LAS unsigned* MISC = (volatile LAS unsigned*)(lds + MISC_OFF);
    const int G = gridDim.x; int vcu; { const int bx = blockIdx.x; vcu = (G % 8 == 0) ? (bx % 8) * (G / 8) + bx / 8 : bx; }
    unsigned char* ws = args.ws;
    gu32* ctl = (gu32*)(ws + WS_CTL);
    float* ss = (float*)(ws + WS_SS); bf16* xb = (bf16*)(ws + WS_XB); bf16* zg = (bf16*)(ws + WS_ZG); bf16* abuf = (bf16*)(ws + WS_A); float* yb = (float*)(ws + WS_YB);
    bf16* mix = (bf16*)(ws + WS_MIX); bf16* wbase = (bf16*)(ws + WS_W); float* xf = args.out;
    float* lutg = (float*)(ws + WS_LUT);
    for (int u = threadIdx.x; u < (LDS_BYTES - LDSCTL_OFF) / 4; u += NWAVES * 64) ((LAS unsigned*)(lds + LDSCTL_OFF))[u] = 0u;
    __syncthreads();
    XcdBarrier bar = xcd_barrier_post((unsigned*)(ctl + CW_BAR) + args.li * XCD_BAR_WORDS, MISC + 8);

#pragma unroll 1
    for (int ph = args.ph_lo; ph < args.ph_hi; ++ph) {
        const int l = ph > 0 ? (ph - 1) / 6 : 0, p = ph > 0 ? (ph - 1) % 6 + 1 : 0;
        bf16* wl = wbase + (size_t)l * WL_END;
        float* ss1 = ss + (size_t)((2 * l) & 3) * T * 16; float* ss2 = ss + (size_t)((2 * l + 1) & 3) * T * 16; float* ss3 = (l + 1 < L) ? ss + (size_t)((2 * l + 2) & 3) * T * 16 : nullptr;
#ifndef MK_ONLY
#define MK_ONLY 0x7f
#endif
        const int dupp = ((args.pad >> 8) & 0xff) - 1;
#pragma unroll 1
        for (int rep = (p == dupp) ? 0 : 1; rep < 2; ++rep) {
        if (p == 0 && (MK_ONLY & 1)) {
            int tid0 = threadIdx.x; asm volatile("" : "+v"(tid0));
            const int lane0 = tid0 & 63, wave = __builtin_amdgcn_readfirstlane(tid0 >> 6);
            LAS float* scr = (LAS float*)(lds + RING_OFF + wave * 16384);
            const int gw = vcu * NWAVES + wave, NGW = G * NWAVES;
            constexpr int I_IN = (D / 64) * (INW / 32), I_G = (D / 64) * (GW / 32), I_A = (512 / 64) * (D / 32), I_O = (D / 64) * (D / 32), I_UP = (D / 64) * (FF2 / 32), I_DN = (FF / 64) * (D / 32);
            constexpr int I_LAYER = I_IN + I_G + 2 * I_A + I_O + I_UP + I_DN;
            for (int i = gw * 64 + lane0; i < 12 * att::LUT_STRIDE; i += NGW * 64) { const int hh = i / att::LUT_STRIDE, j = i - hh * att::LUT_STRIDE, rel = j - 256, ar = rel < 0 ? -rel : rel;
                float v = 0.f; if (j <= 512) v = (hh < 8 && ar > 128) ? att::NEG : args.in[13][t5_bucket(rel) * 12 + hh] * LOG2E;
                lutg[i] = v; }
            for (int it = gw; it < L * I_LAYER; it += NGW) {
                const int ll = it / I_LAYER; int r = it - ll * I_LAYER; bf16* w = wbase + (size_t)ll * WL_END;
                if (r < I_IN) { const int nb = r % (INW / 32), kb = r / (INW / 32); p0_transpose_item(args.in[2] + (size_t)ll * D * INW, INW, D, 64 * kb, 32 * nb, w + WL_IN, vrow_in(32 * nb), args.in[1] + ll * D, scr, lane0); continue; } r -= I_IN;
                if (r < I_G) { const int nb = r % (GW / 32), kb = r / (GW / 32); p0_transpose_item(args.in[14] + (size_t)ll * D * GW, GW, D, 64 * kb, 32 * nb, w + WL_IN, vrow_in(INW + 32 * nb), args.in[1] + ll * D, scr, lane0); continue; } r -= I_G;
                if (r < I_A) { const int nb = r % (D / 32), kb = r / (D / 32); p0_transpose_item(args.in[16] + (size_t)ll * 512 * D, D, 512, 64 * kb, 32 * nb, w + WL_A, 32 * nb, nullptr, scr, lane0); continue; } r -= I_A;
                if (r < I_A) { const int nb = r % (D / 32), kb = r / (D / 32); p0_transpose_item(args.in[17] + (size_t)ll * 512 * D, D, 512, 64 * kb, 32 * nb, w + WL_B, 32 * nb, nullptr, scr, lane0); continue; } r -= I_A;
                if (r < I_O) { const int nb = r % (D / 32), kb = r / (D / 32); p0_transpose_item(args.in[18] + (size_t)ll * D * D, D, D, 64 * kb, 32 * nb, w + WL_O, 32 * nb, nullptr, scr, lane0); continue; } r -= I_O;
                if (r < I_UP) { const int nb = r % (FF2 / 32), kb = r / (FF2 / 32); p0_transpose_item(args.in[20] + (size_t)ll * D * FF2, FF2, D, 64 * kb, 32 * nb, w + WL_UP, vrow_up(32 * nb), args.in[19] + ll * D, scr, lane0); continue; } r -= I_UP;
                { const int nb = r % (D / 32), kb = r / (D / 32); p0_transpose_item(args.in[23] + (size_t)ll * FF * D, D, FF, 64 * kb, 32 * nb, w + WL_DN, 32 * nb, nullptr, scr, lane0); }
            }
            for (int m = gw; m < T; m += 2 * NGW) {
                const int m2 = m + NGW;
                const GAS f32x4* xr = (const GAS f32x4*)(args.in[0] + (size_t)m * D) + lane0; const GAS f32x4* xr2 = (const GAS f32x4*)(args.in[0] + (size_t)m2 * D) + lane0;
                GAS unsigned long long* o8 = (GAS unsigned long long*)(xb + (size_t)m * D) + lane0; GAS unsigned long long* o82 = (GAS unsigned long long*)(xb + (size_t)m2 * D) + lane0;
                f32x4 va[4], vb[4];
#pragma unroll
                for (int j = 0; j < 4; ++j) { va[j] = xr[64 * j]; vb[j] = xr2[64 * j]; }
                float s = 0.f, s2 = 0.f;
#pragma unroll
                for (int j = 0; j < 4; ++j) { const f32x4 v = va[j], w = vb[j]; s += (v.x * v.x + v.y * v.y) + (v.z * v.z + v.w * v.w); s2 += (w.x * w.x + w.y * w.y) + (w.z * w.z + w.w * w.w);
                    o8[64 * j] = (unsigned long long)pk2(v.x, v.y) | ((unsigned long long)pk2(v.z, v.w) << 32); o82[64 * j] = (unsigned long long)pk2(w.x, w.y) | ((unsigned long long)pk2(w.z, w.w) << 32); }
                s = wave_sum(s); s2 = wave_sum(s2);
                ss16_store(ss, m, s, lane0); ss16_store(ss, m2, s2, lane0);
            }
        } else if (p == 1 && (MK_ONLY & 2)) {
            pg8::SchedStd S; S.init(xb, D, wl + WL_IN, D, T, ZG - 256, G, (int)blockIdx.x);
            S.fix = (rep == 0 && MK_VAR == 8) ? 1 : 0;
            pg8::EpiIn E{zg, ss1, args.in[3] + l * 64, args.in[4] + l * 64, args.in[6] + l * 64, args.in[7] + l * 64, args.in[15] + l * GW, (args.pad >> 25) & 1};
            pg8::gemm_phase<pg8::EpiIn, pg8::SchedStd, true, true>(lds + RING_OFF, D, D, S, E);
        } else if (p == 2 && (MK_ONLY & 4)) {
            const float lam_init = 0.8f - 0.6f * __expf(-0.3f * (float)l);
            int ln = threadIdx.x; asm volatile("" : "+v"(ln)); ln &= 63;
            const float d1 = wave_sum(args.in[8][l * 64 + ln] * args.in[9][l * 64 + ln]), d2 = wave_sum(args.in[10][l * 64 + ln] * args.in[11][l * 64 + ln]);
            const float lam = __expf(d1) - __expf(d2) + lam_init;
            if ((vcu & 3) == 0 && rep == 1) {
                pg8::SchedStd S1; S1.init(xb, D, wl + WL_IN, D, T, ZG, G, (int)blockIdx.x); S1.one = 1; S1.opm = 8 * (vcu >> 5) + ((vcu & 31) >> 2); S1.opn = 16;
                pg8::EpiIn E1{zg, ss1, args.in[3] + l * 64, args.in[4] + l * 64, args.in[6] + l * 64, args.in[7] + l * 64, args.in[15] + l * GW, 0};
                pg8::gemm_phase<pg8::EpiIn, pg8::SchedStd, true, true>(lds + RING_OFF, D, D, S1, E1);
            }
            att::attn_tables(lds, lutg, args.in[12] + l * 128, 1.0f - lam_init);
            const int dsel = args.pad >> 16;
            if (rep == 1 || dsel != 2)
            for (int ui = vcu; ui < 512; ui += G) { const int bh = ui >> 4, qb = ui & 15; if (rep == 0 && MK_VAR == 7 && (vcu & 1)) {} else if (rep == 0) att::attn_unit<true, (MK_VAR == 7 ? 0 : MK_VAR)>(lds, zg, lutg, bh >> 2, bh & 3, qb * 128, nullptr, lam, 1.0f - lam_init, args.in[12] + l * 128, mix);
                else att::attn_unit<true, 0>(lds, zg, lutg, bh >> 2, bh & 3, qb * 128, nullptr, lam, 1.0f - lam_init, args.in[12] + l * 128, nullptr); }
            if (rep == 1 || dsel != 1) {
                unsigned* qctr = (unsigned*)(ctl + CW_Q + 64 * (2 * l + rep));
                for (;;) {
                    if (threadIdx.x == 0) MISC[4] = __hip_atomic_fetch_add(qctr, 1u, __ATOMIC_RELAXED, __HIP_MEMORY_SCOPE_AGENT);
                    __syncthreads();
                    const int ui = (int)MISC[4];
                    __syncthreads();
                    if (ui >= 512) break;
                    const int bk = ui >> 5, qb = ui & 31; att::attn_unit<false>(lds, zg, lutg, bk >> 1, bk & 1, qb * 64, args.in[5] + l * HA, 0.f, 0.f, nullptr, rep == 0 ? mix : nullptr);
                }
            }
        } else if (p == 3 && (MK_ONLY & 8)) {
            pg8::SchedMix S; S.b.init(zg + C_QA, ZG, wl + WL_A, 512, T, D, G, (int)blockIdx.x); S.A1 = (const char*)(zg + C_QB); S.Bt1 = (const char*)(wl + WL_B);
            pg8::EpiMix E{zg, mix};
            pg8::gemm_phase<pg8::EpiMix, pg8::SchedMix, true, true>(lds + RING_OFF, 512, ZG, S, E);
        } else if (p == 4 && (MK_ONLY & 16)) {
            pg8::SchedStd S; S.init(mix, D, wl + WL_O, D, T, D, G, (int)blockIdx.x);
            pg8::EpiRes E{l == 0 ? args.in[0] : xf, xf, xb, ss2};
            pg8::gemm_phase<pg8::EpiRes, pg8::SchedStd, true, true>(lds + RING_OFF, D, D, S, E);
        } else if (p == 5 && (MK_ONLY & 32)) {
            pg8::SchedStd S; S.init(xb, D, wl + WL_UP, D, T, FF2, G, (int)blockIdx.x);
            pg8::EpiUp E{abuf, ss2, args.in[21] + (size_t)l * 3 * FF2, args.in[22] + (size_t)l * FF2, yb, (args.pad >> 24) & 1};
            pg8::gemm_phase<pg8::EpiUp, pg8::SchedStd, true, true>(lds + RING_OFF, D, D, S, E);
        } else if (MK_ONLY & 64) {
            pg8::SchedDown S; S.b.init(abuf, FF, wl + WL_DN, FF, T, D, G, (int)blockIdx.x); S.yb = (args.pad & 1) ? nullptr : yb; S.cw = args.in[21] + (size_t)l * 3 * FF2; S.cb = args.in[22] + (size_t)l * FF2; S.a = abuf;
            pg8::EpiRes E{xf, xf, ss3 ? xb : nullptr, ss3};
            pg8::gemm_phase<pg8::EpiRes, pg8::SchedDown, true, true>(lds + RING_OFF, FF, FF, S, E);
        }
        }
        if (ph + 1 < args.ph_hi) xcd_barrier(bar);
    }
}
}

#ifndef MK_MODE
#define MK_MODE 0x7f
#endif
extern "C" void kernel_launch(void* const* d_in, const int* in_sizes, int n_in, void* d_out, int out_size, void* d_ws, size_t ws_size, hipStream_t stream) {
    using namespace nv;
    static int grid = 0;
    if (grid == 0) {
        if (n_in != 24 || out_size != T * D || ws_size < mk::WS_END) { fprintf(stderr, "kernel_launch: unexpected shapes (n_in %d, out %d, ws %zu)\n", n_in, out_size, ws_size); grid = -1; return; }
        int dev = 0, cus = 0, per_cu = 0;
        if (hipGetDevice(&dev) != hipSuccess || hipDeviceGetAttribute(&cus, hipDeviceAttributeMultiprocessorCount, dev) != hipSuccess) { grid = -1; return; }
        if (hipFuncSetAttribute((const void*)mk::skel_fwd, hipFuncAttributeMaxDynamicSharedMemorySize, mk::LDS_BYTES) != hipSuccess) { fprintf(stderr, "kernel_launch: hipFuncSetAttribute failed\n"); grid = -1; return; }
        if (hipOccupancyMaxActiveBlocksPerMultiprocessor(&per_cu, (const void*)mk::skel_fwd, mk::NWAVES * 64, mk::LDS_BYTES) != hipSuccess || per_cu < 1) fprintf(stderr, "kernel_launch: occupancy query says %d\n", per_cu);
        (void)hipGetLastError();
        grid = cus;
    }
    if (grid < 0) return;
    const float* in[24]; for (int i = 0; i < 24; ++i) in[i] = (const float*)d_in[i];
    unsigned char* ws = (unsigned char*)d_ws;
    float* xf = (float*)d_out; float* ss = (float*)(ws + mk::WS_SS); bf16* xb = (bf16*)(ws + mk::WS_XB); bf16* zg = (bf16*)(ws + mk::WS_ZG); bf16* abuf = (bf16*)(ws + mk::WS_A);
    bf16* mix = (bf16*)(ws + mk::WS_MIX); float* tmpA = (float*)(ws + mk::WS_TMPA); float* tmpB = (float*)(ws + mk::WS_TMPB);
    if (hipMemsetAsync(ws + mk::WS_CTL, 0, mk::CTL_ZERO_BYTES, stream) != hipSuccess) { fprintf(stderr, "kernel_launch: memset failed\n"); return; }
    mk::Args a{}; for (int i = 0; i < 24; ++i) a.in[i] = in[i]; a.out = xf; a.ws = ws;
    int li = 0;
#define MK_RUN(lo, hi) do { a.ph_lo = (lo); a.ph_hi = (hi); a.li = li++; hipLaunchKernelGGL(mk::skel_fwd, dim3(grid), dim3(mk::NWAVES * 64), mk::LDS_BYTES, stream, a); } while (0)
#ifndef MK_DUP
#define MK_DUP 0
#endif
#define MK_DSEL 0
    if (MK_MODE == 0x7f) { a.pad = (MK_DUP << 8) | (MK_DSEL << 16) | (MK_EDUP << 24); MK_RUN(0, mk::N_PHASES); return; }
    MK_RUN(0, 1);
    for (int l = 0; l < L; ++l) {
        const float lam_init = 0.8f - 0.6f * expf(-0.3f * (float)l);
        float* ss1 = ss + (size_t)((2 * l) & 3) * T * 16; float* ss2 = ss + (size_t)((2 * l + 1) & 3) * T * 16; float* ss3 = (l + 1 < L) ? ss + (size_t)((2 * l + 2) & 3) * T * 16 : nullptr;
        const int pb = 1 + 6 * l;
        if (MK_MODE & 2) MK_RUN(pb, pb + 1);
        else for (int b = 0; b < B; ++b) { const int row0 = b * S;
            n_gemm<bf16><<<dim3(INW / 64, S / 64), 256, 0, stream>>>(xb + (size_t)row0 * D, D, in[1] + l * D, in[2] + (size_t)l * D * INW, INW, tmpA, INW, D);
            n_post_in<<<S, 256, 0, stream>>>(tmpA, ss1, in[3] + l * 64, in[4] + l * 64, in[6] + l * 64, in[7] + l * 64, zg, row0);
            n_gemm<bf16><<<dim3(GW / 64, S / 64), 256, 0, stream>>>(xb + (size_t)row0 * D, D, in[1] + l * D, in[14] + (size_t)l * D * GW, GW, tmpA, GW, D);
            n_post_gate<<<S, 256, 0, stream>>>(tmpA, ss1, in[15] + l * GW, zg, row0); }
        if (MK_MODE & 4) MK_RUN(pb + 1, pb + 2);
        else { n_attn_a<<<dim3(T, HA), 64, 0, stream>>>(zg, in[5] + l * HA, in[13]);
               n_attn_b<<<dim3(T, HB), 256, 0, stream>>>(zg, in[13], in[8] + l * 64, in[9] + l * 64, in[10] + l * 64, in[11] + l * 64, in[12] + l * 128, lam_init); }
        if (MK_MODE & 8) MK_RUN(pb + 2, pb + 3);
        else for (int b = 0; b < B; ++b) { const int row0 = b * S;
            n_gemm<bf16><<<dim3(D / 64, S / 64), 256, 0, stream>>>(zg + (size_t)row0 * ZG + C_QA, ZG, nullptr, in[16] + (size_t)l * 512 * D, D, tmpA, D, 512);
            n_gemm<bf16><<<dim3(D / 64, S / 64), 256, 0, stream>>>(zg + (size_t)row0 * ZG + C_QB, ZG, nullptr, in[17] + (size_t)l * 512 * D, D, tmpB, D, 512);
            n_post_mix<<<S, 256, 0, stream>>>(tmpA, tmpB, zg, mix, row0); }
        if (MK_MODE & 16) MK_RUN(pb + 3, pb + 4);
        else for (int b = 0; b < B; ++b) { const int row0 = b * S;
            n_gemm<bf16><<<dim3(D / 64, S / 64), 256, 0, stream>>>(mix + (size_t)row0 * D, D, nullptr, in[18] + (size_t)l * D * D, D, tmpA, D, D);
            n_post_res<<<S, 256, 0, stream>>>(tmpA, xf, xb, ss2, row0); }
        if ((MK_MODE & 32) && (MK_MODE & 64)) { MK_RUN(pb + 4, pb + 6); }
        else {
            for (int b = 0; b < B; ++b) { const int row0 = b * S;
                for (int hf = 0; hf < 2; ++hf) { const int j0 = hf * HW;
                    n_gemm<bf16><<<dim3(HW / 64, S / 64), 256, 0, stream>>>(xb + (size_t)row0 * D, D, in[19] + l * D, in[20] + (size_t)l * D * FF2 + j0, FF2, tmpA, 2 * HW, D);
                    n_gemm<bf16><<<dim3(HW / 64, S / 64), 256, 0, stream>>>(xb + (size_t)row0 * D, D, in[19] + l * D, in[20] + (size_t)l * D * FF2 + FF + j0, FF2, tmpA + HW, 2 * HW, D);
                    n_post_conv<<<S, 256, 0, stream>>>(tmpA, ss2, in[21] + (size_t)l * 3 * FF2, in[22] + (size_t)l * FF2, abuf, row0, j0); } }
            if (MK_MODE & 64) { a.pad = 1; MK_RUN(pb + 5, pb + 6); a.pad = 0; }
            else for (int b = 0; b < B; ++b) { const int row0 = b * S;
                n_gemm<bf16><<<dim3(D / 64, S / 64), 256, 0, stream>>>(abuf + (size_t)row0 * FF, FF, nullptr, in[23] + (size_t)l * FF * D, D, tmpA, D, FF);
                n_post_res<<<S, 256, 0, stream>>>(tmpA, xf, xb, ss3, row0); }
        }
    }
}
```

```cpp
#include <hip/hip_runtime.h>
#include <cstdio>
#include <cstdint>
#include <cmath>
#define MK_EDUP 0

namespace nv {
typedef unsigned short bf16;
constexpr int D = 1024, B = 8, S = 2048, T = B * S, L = 4;
constexpr int HA = 8, KVA = 2, HB = 4, HD = 64;
constexpr int INW = 2304, GW = 2048, ZG = INW + GW;
constexpr int FF = 2816, FF2 = 2 * FF;
constexpr int C_QA = 0, C_KA = 512, C_VA = 640, C_QB = 768, C_KB = 1280, C_VB = 1792, C_G = 2304;
constexpr float EPS = 1e-6f;
constexpr float LOG2E = 1.4426950408889634f;
constexpr float C2 = 0.125f * LOG2E;

__device__ __forceinline__ float bf2f(bf16 v) { return __uint_as_float(((unsigned)v) << 16); }
__device__ __forceinline__ bf16 f2bf(float f) { unsigned u = __float_as_uint(f); return (bf16)((u + 0x7fffu + ((u >> 16) & 1u)) >> 16); }
__device__ __forceinline__ float ldf(const float* p) { return *p; }
__device__ __forceinline__ float ldf(const bf16* p) { return bf2f(*p); }

__device__ __forceinline__ int t5_bucket(int rel) {
    const int n = rel < 0 ? -rel : rel; int v;
    if (n < 8) v = n; else if (n < 12) v = 8; else if (n < 16) v = 9; else if (n < 23) v = 10; else if (n < 32) v = 11;
    else if (n < 46) v = 12; else if (n < 64) v = 13; else if (n < 91) v = 14; else v = 15;
    return (rel > 0 ? 16 : 0) + v;
}
__device__ __forceinline__ float ss16(const float* ss, int t) { const float4* p = (const float4*)(ss + (size_t)t * 16); const float4 a = p[0], b = p[1], c = p[2], d = p[3];
    return ((a.x + a.y) + (a.z + a.w)) + ((b.x + b.y) + (b.z + b.w)) + ((c.x + c.y) + (c.z + c.w)) + ((d.x + d.y) + (d.z + d.w)); }
__device__ __forceinline__ float ss16_q(const float* ss, int t, int fq) { const float4 a = *(const float4*)(ss + (size_t)t * 16 + 4 * fq); float s = (a.x + a.y) + (a.z + a.w); s += __shfl_xor(s, 16); s += __shfl_xor(s, 32); return s; }
__device__ __forceinline__ void ss16_store(float* ss, int t, float s, int lane) { if (lane < 16) ss[(size_t)t * 16 + lane] = lane == 0 ? s : 0.f; }
__device__ __forceinline__ float wave_sum(float v) {
#pragma unroll
    for (int o = 1; o < 64; o <<= 1) v += __shfl_xor(v, o);
    return v;
}
__device__ __forceinline__ float wave_max(float v) {
#pragma unroll
    for (int o = 1; o < 64; o <<= 1) v = fmaxf(v, __shfl_xor(v, o));
    return v;
}

template <typename TA>
__global__ void __launch_bounds__(256) n_gemm(const TA* __restrict__ A, int lda, const float* __restrict__ gk, const float* __restrict__ W, int ldw, float* __restrict__ C, int ldc, int K) {
    __shared__ float As[16][68];
    __shared__ float Ws[16][64];
    const int tid = threadIdx.x, tx = tid & 15, ty = tid >> 4;
    const int m0 = blockIdx.y * 64, n0 = blockIdx.x * 64;
    float acc[4][4];
#pragma unroll
    for (int i = 0; i < 4; ++i)
#pragma unroll
        for (int j = 0; j < 4; ++j) acc[i][j] = 0.f;
    for (int k0 = 0; k0 < K; k0 += 16) {
#pragma unroll
        for (int i = 0; i < 4; ++i) { const int e = tid + i * 256, r = e >> 4, c = e & 15; float v = ldf(A + (size_t)(m0 + r) * lda + k0 + c); if (gk) v *= gk[k0 + c]; As[c][r] = v; }
#pragma unroll
        for (int i = 0; i < 4; ++i) { const int e = tid + i * 256, r = e >> 6, c = e & 63; Ws[r][c] = W[(size_t)(k0 + r) * ldw + n0 + c]; }
        __syncthreads();
#pragma unroll
        for (int kk = 0; kk < 16; ++kk) {
            float a[4], b[4];
#pragma unroll
            for (int i = 0; i < 4; ++i) { a[i] = As[kk][ty * 4 + i]; b[i] = Ws[kk][tx * 4 + i]; }
#pragma unroll
            for (int i = 0; i < 4; ++i)
#pragma unroll
                for (int j = 0; j < 4; ++j) acc[i][j] += a[i] * b[j];
        }
        __syncthreads();
    }
#pragma unroll
    for (int i = 0; i < 4; ++i)
#pragma unroll
        for (int j = 0; j < 4; ++j) C[(size_t)(m0 + ty * 4 + i) * ldc + n0 + tx * 4 + j] = acc[i][j];
}

__global__ void __launch_bounds__(256) n_init_x(const float* __restrict__ x, float* __restrict__ xf, bf16* __restrict__ xb, float* __restrict__ ss) {
    const int row = blockIdx.x * 4 + (threadIdx.x >> 6), lane = threadIdx.x & 63;
    float s = 0.f;
    for (int c = lane; c < D; c += 64) { const float v = x[(size_t)row * D + c]; xf[(size_t)row * D + c] = v; xb[(size_t)row * D + c] = f2bf(v); s += v * v; }
    s = wave_sum(s);
    ss16_store(ss, row, s, lane);
}

__global__ void __launch_bounds__(256) n_post_in(const float* __restrict__ Z, const float* __restrict__ ss, const float* __restrict__ qn_a, const float* __restrict__ kn_a,
                                                 const float* __restrict__ qn_b, const float* __restrict__ kn_b, bf16* __restrict__ zg, int row0) {
    const int r = blockIdx.x, t = row0 + r, wave = threadIdx.x >> 6, lane = threadIdx.x & 63;
    const float rs = rsqrtf(ss16(ss, t) * (1.0f / D) + EPS);
    for (int g = wave; g < INW / 64; g += 4) {
        float v = Z[(size_t)r * INW + g * 64 + lane] * rs;
        const float* gain = nullptr; float sc = 1.f;
        if (g < 8) { gain = qn_a; sc = C2; } else if (g < 10) { gain = kn_a; } else if (g < 12) { } else if (g < 20) { gain = qn_b; sc = C2; } else if (g < 28) { gain = kn_b; }
        if (gain) { const float q = wave_sum(v * v); v = v * rsqrtf(q * (1.0f / 64.0f) + EPS) * gain[lane] * sc; }
        zg[(size_t)t * ZG + g * 64 + lane] = f2bf(v);
    }
}
__global__ void __launch_bounds__(256) n_post_gate(const float* __restrict__ G, const float* __restrict__ ss, const float* __restrict__ bg, bf16* __restrict__ zg, int row0) {
    const int r = blockIdx.x, t = row0 + r;
    const float rs = rsqrtf(ss16(ss, t) * (1.0f / D) + EPS);
    for (int c = threadIdx.x; c < GW; c += 256) { const float v = G[(size_t)r * GW + c] * rs + bg[c]; zg[(size_t)t * ZG + C_G + c] = f2bf(1.0f / (1.0f + __expf(-v))); }
}

__global__ void __launch_bounds__(64) n_attn_a(bf16* __restrict__ zg, const float* __restrict__ sink, const float* __restrict__ rel_bias) {
    __shared__ float qs[64]; __shared__ float ps[5 * 64];
    const int t = blockIdx.x, h = blockIdx.y, lane = threadIdx.x, b = t / S, s = t % S, kv = h >> 2;
    qs[lane] = bf2f(zg[(size_t)t * ZG + C_QA + h * 64 + lane]);
    __syncthreads();
    const int j0 = s - 128;
    float sc[5]; float m = sink[h] * LOG2E;
#pragma unroll
    for (int i = 0; i < 5; ++i) {
        const int jj = i * 64 + lane, j = j0 + jj; float v = -1e30f;
        if (jj <= 256 && j >= 0 && j < S) {
            const bf16* kp = zg + (size_t)(b * S + j) * ZG + C_KA + kv * 64; float d = 0.f;
            for (int e = 0; e < 64; ++e) d += qs[e] * bf2f(kp[e]);
            v = d + rel_bias[t5_bucket(j - s) * 12 + h] * LOG2E;
        }
        sc[i] = v; m = fmaxf(m, v);
    }
    m = wave_max(m);
    float l = 0.f;
#pragma unroll
    for (int i = 0; i < 5; ++i) { const float p = (sc[i] > -1e29f) ? exp2f(sc[i] - m) : 0.f; ps[i * 64 + lane] = p; l += p; }
    l = wave_sum(l) + exp2f(sink[h] * LOG2E - m);
    __syncthreads();
    float o = 0.f;
    for (int jj = 0; jj <= 256; ++jj) { const int j = j0 + jj; if (j >= 0 && j < S) o += ps[jj] * bf2f(zg[(size_t)(b * S + j) * ZG + C_VA + kv * 64 + lane]); }
    zg[(size_t)t * ZG + C_QA + h * 64 + lane] = f2bf(o / l);
}

__global__ void __launch_bounds__(256) n_attn_b(bf16* __restrict__ zg, const float* __restrict__ rel_bias, const float* __restrict__ lq1, const float* __restrict__ lk1,
                                               const float* __restrict__ lq2, const float* __restrict__ lk2, const float* __restrict__ subg, float lam_init) {
    __shared__ float qs[128]; __shared__ float av[S]; __shared__ float s1s[S]; __shared__ float red[8]; __shared__ float osum[256];
    const int t = blockIdx.x, h = blockIdx.y, tid = threadIdx.x, lane = tid & 63, wave = tid >> 6, b = t / S, s = t % S;
    if (tid < 128) qs[tid] = bf2f(zg[(size_t)t * ZG + C_QB + h * 128 + tid]);
    float d1 = wave_sum(lq1[lane] * lk1[lane]), d2 = wave_sum(lq2[lane] * lk2[lane]);
    const float lam = __expf(d1) - __expf(d2) + lam_init;
    __syncthreads();
    float m0 = -1e30f, m1 = -1e30f;
#pragma unroll 1
    for (int i = 0; i < 8; ++i) {
        const int j = i * 256 + tid; const bf16* kp = zg + (size_t)(b * S + j) * ZG + C_KB + h * 128; float a0 = 0.f, a1 = 0.f;
#pragma unroll 8
        for (int e = 0; e < 64; ++e) { a0 += qs[e] * bf2f(kp[e]); a1 += qs[64 + e] * bf2f(kp[64 + e]); }
        const float bi = rel_bias[t5_bucket(j - s) * 12 + 8 + h] * LOG2E;
        a0 += bi; a1 += bi; av[j] = a0; s1s[j] = a1; m0 = fmaxf(m0, a0); m1 = fmaxf(m1, a1);
    }
    m0 = wave_max(m0); m1 = wave_max(m1);
    if (lane == 0) { red[wave] = m0; red[4 + wave] = m1; }
    __syncthreads();
    m0 = fmaxf(fmaxf(red[0], red[1]), fmaxf(red[2], red[3])); m1 = fmaxf(fmaxf(red[4], red[5]), fmaxf(red[6], red[7]));
    __syncthreads();
    float l0 = 0.f, l1 = 0.f;
#pragma unroll 1
    for (int i = 0; i < 8; ++i) { const int j = i * 256 + tid; const float p0 = exp2f(av[j] - m0), p1 = exp2f(s1s[j] - m1); av[j] = p0; s1s[j] = p1; l0 += p0; l1 += p1; }
    l0 = wave_sum(l0); l1 = wave_sum(l1);
    if (lane == 0) { red[wave] = l0; red[4 + wave] = l1; }
    __syncthreads();
    l0 = (red[0] + red[1]) + (red[2] + red[3]); l1 = (red[4] + red[5]) + (red[6] + red[7]);
#pragma unroll 1
    for (int i = 0; i < 8; ++i) { const int j = i * 256 + tid; av[j] = av[j] / l0 - lam * (s1s[j] / l1); }
    __syncthreads();
    const int e = tid & 127, half = tid >> 7; float o = 0.f;
    for (int j = half * 1024; j < half * 1024 + 1024; ++j) o += av[j] * bf2f(zg[(size_t)(b * S + j) * ZG + C_VB + h * 128 + e]);
    osum[tid] = o;
    __syncthreads();
    float ov = 0.f, q = 0.f;
    if (tid < 128) { ov = osum[tid] + osum[tid + 128]; q = ov * ov; }
    q = wave_sum(q);
    __syncthreads();
    if (lane == 0) red[wave] = q;
    __syncthreads();
    const float qq = red[0] + red[1];
    if (tid < 128) zg[(size_t)t * ZG + C_QB + h * 128 + tid] = f2bf(ov * rsqrtf(qq * (1.0f / 128.0f) + EPS) * subg[tid] * (1.0f - lam_init));
}

__global__ void __launch_bounds__(256) n_post_mix(const float* __restrict__ PA, const float* __restrict__ PB, const bf16* __restrict__ zg, bf16* __restrict__ mix, int row0) {
    const int r = blockIdx.x, t = row0 + r;
    for (int c = threadIdx.x; c < D; c += 256) {
        const float ga = bf2f(zg[(size_t)t * ZG + C_G + c]), gb = bf2f(zg[(size_t)t * ZG + C_G + D + c]);
        mix[(size_t)t * D + c] = f2bf(ga * PA[(size_t)r * D + c] + gb * PB[(size_t)r * D + c]);
    }
}
__global__ void __launch_bounds__(256) n_post_res(const float* __restrict__ tmp, float* __restrict__ xf, bf16* __restrict__ xb, float* __restrict__ ss_out, int row0) {
    __shared__ float red[4];
    const int r = blockIdx.x, t = row0 + r, lane = threadIdx.x & 63, wave = threadIdx.x >> 6; float s = 0.f;
    for (int c = threadIdx.x; c < D; c += 256) { const float v = xf[(size_t)t * D + c] + tmp[(size_t)r * D + c]; xf[(size_t)t * D + c] = v; xb[(size_t)t * D + c] = f2bf(v); s += v * v; }
    s = wave_sum(s); if (lane == 0) red[wave] = s;
    __syncthreads();
    if (ss_out) ss16_store(ss_out, t, (red[0] + red[1]) + (red[2] + red[3]), threadIdx.x);
}
constexpr int HW = FF / 2;
__global__ void __launch_bounds__(256) n_post_conv(const float* __restrict__ U, const float* __restrict__ ss, const float* __restrict__ cw, const float* __restrict__ cb, bf16* __restrict__ a, int row0, int j0) {
    const int r = blockIdx.x, t = row0 + r;
    const float rs1 = rsqrtf(ss16(ss, t) * (1.0f / D) + EPS);
    const float rs0 = r > 0 ? rsqrtf(ss16(ss, t - 1) * (1.0f / D) + EPS) : 0.f;
    const float rs2 = r < S - 1 ? rsqrtf(ss16(ss, t + 1) * (1.0f / D) + EPS) : 0.f;
    for (int j = threadIdx.x; j < HW; j += 256) {
        float u[2];
#pragma unroll
        for (int gsel = 0; gsel < 2; ++gsel) {
            const int col = gsel * FF + j0 + j, uc = gsel * HW + j;
            const float y1 = U[(size_t)r * (2 * HW) + uc] * rs1;
            const float y0 = r > 0 ? U[(size_t)(r - 1) * (2 * HW) + uc] * rs0 : 0.f;
            const float y2 = r < S - 1 ? U[(size_t)(r + 1) * (2 * HW) + uc] * rs2 : 0.f;
            u[gsel] = cb[col] + cw[col] * y0 + cw[FF2 + col] * y1 + cw[2 * FF2 + col] * y2;
        }
        const float sg = u[1] / (1.0f + __expf(-u[1]));
        a[(size_t)t * FF + j0 + j] = f2bf(sg * u[0]);
    }
}
__global__ void __launch_bounds__(256) n_rowss(const float* __restrict__ xf, float* __restrict__ ss_out) {
    const int row = blockIdx.x * 4 + (threadIdx.x >> 6), lane = threadIdx.x & 63; float s = 0.f;
    for (int c = lane; c < D; c += 64) { const float v = xf[(size_t)row * D + c]; s += v * v; }
    s = wave_sum(s); ss16_store(ss_out, row, s, lane);
}
}


namespace pg8 {
using namespace nv;
#define PG8_LAS __attribute__((address_space(3)))
typedef unsigned short bf16_t;
typedef short bf16x8 __attribute__((ext_vector_type(8)));
typedef float f32x4 __attribute__((ext_vector_type(4)));
typedef unsigned u32x4 __attribute__((ext_vector_type(4)));
typedef unsigned u32x2 __attribute__((ext_vector_type(2)));
constexpr int BM = 256, BK = 64, HALF = 128, HTB = HALF * BK * 2  , STAGE_BYTES = 8 * HTB, NXCD = 8, WGM = 8;
constexpr int XOFF = 131072 + 1024;

__host__ __device__ __forceinline__ int lds_byte(int r, int c) { const int st = (r >> 4) * 2 + (c >> 5), rr = r & 15, cc = c & 31, ob = rr * 64 + cc * 2; return st * 1024 + (ob ^ (((ob >> 9) & 1) << 5)); }
__host__ __device__ __forceinline__ void stage_rc(int b, int& R, int& C) { const int st = b / 1024, sb = b % 1024, swz = sb ^ (((sb >> 9) & 1) << 5); R = (st >> 1) * 16 + swz / 64; C = (st & 1) * 32 + (swz % 64) / 2; }
__host__ __device__ __forceinline__ int perm32(int rho) { const int n = rho >> 4, i = rho & 15; return 8 * (i >> 2) + 4 * n + (i & 3); }

struct Unit { int pm, pn, z; };
typedef float f32x2 __attribute__((ext_vector_type(2))); typedef __bf16 bf16x2_t __attribute__((ext_vector_type(2)));
__device__ __forceinline__ unsigned cvt_pk_bf16(float lo, float hi) { f32x2 v = {lo, hi}; bf16x2_t b = __builtin_convertvector(v, bf16x2_t); return __builtin_bit_cast(unsigned, b); }
__device__ __forceinline__ float bflo(unsigned w) { return __uint_as_float(w << 16); }
__device__ __forceinline__ float bfhi(unsigned w) { return __uint_as_float(w & 0xffff0000u); }

struct SchedStd {
    int nM, nN, nwg, G, c, fix, one, opm, opn; const char* A; const char* Bt; size_t at, bt;
    __device__ void init(const void* A_, int lda, const void* Bt_, int K, int M, int N, int G_, int c_) { fix = 0; one = 0; opm = 0; opn = 0; nM = M / BM; nN = N / BM; nwg = nM * nN; G = G_; c = c_; A = (const char*)A_; Bt = (const char*)Bt_; at = (size_t)BM * lda * 2; bt = (size_t)BM * K * 2; }
    __device__ bool next(int i, Unit& u) const {
        if (one) { if (i > 0) return false; u.pm = opm; u.pn = opn; u.z = 0; return true; }
        const long L = (long)i * G + c; if (L >= nwg) return false;
        int wgid = (int)L; { const int q = nwg / NXCD, r = nwg % NXCD, xcd = wgid % NXCD, off = wgid / NXCD; wgid = (xcd < r ? xcd * (q + 1) : r * (q + 1) + (xcd - r) * q) + off; }
        const int nig = WGM * nN, gid = wgid / nig, fm = gid * WGM, gsz = (nM - fm) < WGM ? (nM - fm) : WGM;
        u.pm = fm + ((wgid % nig) % gsz); u.pn = (wgid % nig) / gsz; u.z = 0; if (fix) { u.pm = 0; u.pn = 0; } return true;
    }
    __device__ __forceinline__ const char* aptr(const Unit& u) const { return A + (size_t)u.pm * at; }
    __device__ __forceinline__ const char* bptr(const Unit& u) const { return Bt + (size_t)u.pn * bt; }
    __device__ __forceinline__ void a_ready(const Unit&) const {}
    __device__ __forceinline__ void done(const Unit&) const {}
};
struct SchedMix {
    SchedStd b; const char* A1; const char* Bt1;
    __device__ bool next(int i, Unit& u) const { if (!b.next(i >> 1, u)) return false; u.z = i & 1; return true; }
    __device__ __forceinline__ const char* aptr(const Unit& u) const { return (u.z ? A1 : b.A) + (size_t)u.pm * b.at; }
    __device__ __forceinline__ const char* bptr(const Unit& u) const { return (u.z ? Bt1 : b.Bt) + (size_t)u.pn * b.bt; }
    __device__ __forceinline__ void a_ready(const Unit&) const {}
    __device__ __forceinline__ void done(const Unit&) const {}
};
struct SchedDown {
    SchedStd b; const float* yb; const float* cw; const float* cb; bf16_t* a;
    __device__ bool next(int i, Unit& u) const { return b.next(i, u); }
    __device__ __forceinline__ const char* aptr(const Unit& u) const { return b.aptr(u); }
    __device__ __forceinline__ const char* bptr(const Unit& u) const { return b.bptr(u); }
    __device__ __forceinline__ void a_ready(const Unit& u) const {
        const int pm = u.pm;
        if (yb)
        for (int idx = threadIdx.x; idx < 2 * FF; idx += 512) {
            const int which = idx >= FF ? 1 : 0, j = idx - which * FF;
            float uv[2];
#pragma unroll
            for (int gs = 0; gs < 2; ++gs) {
                const int col = gs * FF + j; float y0, y1, y2;
                if (which == 0) { y0 = (pm & 7) ? yb[((size_t)(pm - 1) * 4 + 3) * FF2 + col] : 0.f; y1 = yb[((size_t)pm * 4 + 0) * FF2 + col]; y2 = yb[((size_t)pm * 4 + 1) * FF2 + col]; }
                else { y0 = yb[((size_t)pm * 4 + 2) * FF2 + col]; y1 = yb[((size_t)pm * 4 + 3) * FF2 + col]; y2 = ((pm & 7) != 7) ? yb[((size_t)(pm + 1) * 4 + 0) * FF2 + col] : 0.f; }
                uv[gs] = cb[col] + cw[col] * y0 + cw[FF2 + col] * y1 + cw[2 * FF2 + col] * y2;
            }
            const float sg = uv[1] * __builtin_amdgcn_rcpf(1.0f + __builtin_amdgcn_exp2f(-uv[1] * LOG2E));
            a[(size_t)(pm * BM + which * 255) * FF + j] = f2bf(sg * uv[0]);
        }
        asm volatile("s_waitcnt vmcnt(0)" ::: "memory");
        __builtin_amdgcn_s_barrier();
        asm volatile("" ::: "memory");
    }
    __device__ __forceinline__ void done(const Unit&) const {}
};

struct EpiIn {
    static constexpr bool PERM = true, AFTER_DRAIN = false;
    __device__ static constexpr bool zero_after(const Unit&) { return true; }
    bf16_t* zg; const float* ss; const float *qn_a, *kn_a, *qn_b, *kn_b, *bg; int dup;
    __device__ __forceinline__ void operator()(f32x4 (&acc)[2][2][4][2], const Unit& u, int wr, int wc, int fr, int fq, PG8_LAS unsigned char*) const {
#pragma unroll
        for (int rep_ = 0; rep_ <= ((MK_EDUP & 2) ? 1 : 0); ++rep_) {
        if (rep_) {
#pragma unroll
            for (int ai = 0; ai < 2; ++ai)
#pragma unroll
                for (int bj = 0; bj < 2; ++bj)
#pragma unroll
                    for (int m = 0; m < 4; ++m)
#pragma unroll
                        for (int n = 0; n < 2; ++n) asm volatile("" : "+v"(acc[ai][bj][m][n]) :: "memory");
        }
        const int g = u.pn * 4 + wc, colb = u.pn * BM + wc * 64 + 8 * fq;
        const float* gain = nullptr; float sc = 1.f; int mode = 0;
        if (g < 8) { gain = qn_a; sc = C2; mode = 1; } else if (g < 10) { gain = kn_a; mode = 1; } else if (g < 12) { mode = 0; } else if (g < 20) { gain = qn_b; sc = C2; mode = 1; }
        else if (g < 28) { gain = kn_b; mode = 1; } else if (g < 36) { mode = 0; } else { mode = 2; }
        float rsv[2][4];
#pragma unroll
        for (int ai = 0; ai < 2; ++ai)
#pragma unroll
            for (int m = 0; m < 4; ++m) rsv[ai][m] = rsqrtf(ss16_q(ss, u.pm * BM + ai * HALF + wr * 64 + m * 16 + fr, fq) * (1.0f / D) + EPS);
        f32x4 gv[2][2];
#pragma unroll
        for (int bj = 0; bj < 2; ++bj)
#pragma unroll
            for (int n = 0; n < 2; ++n) {
                if (mode == 1) gv[bj][n] = *(const f32x4*)(gain + 32 * bj + 8 * fq + 4 * n) * sc;
                else if (mode == 2) gv[bj][n] = *(const f32x4*)(bg + (colb - C_G) + 32 * bj + 4 * n);
                else gv[bj][n] = (f32x4){1.f, 1.f, 1.f, 1.f};
            }
#pragma unroll
        for (int ai = 0; ai < 2; ++ai)
#pragma unroll
            for (int m = 0; m < 4; ++m) {
                const int row = u.pm * BM + ai * HALF + wr * 64 + m * 16 + fr;
                const float rs = rsv[ai][m];
                f32x4 v[2][2];
#pragma unroll
                for (int bj = 0; bj < 2; ++bj)
#pragma unroll
                    for (int n = 0; n < 2; ++n) v[bj][n] = acc[ai][bj][m][n] * rs;
                if (mode == 1) {
                    float q = 0.f;
#pragma unroll
                    for (int bj = 0; bj < 2; ++bj)
#pragma unroll
                        for (int n = 0; n < 2; ++n) { const f32x4 x = v[bj][n]; q += (x[0] * x[0] + x[1] * x[1]) + (x[2] * x[2] + x[3] * x[3]); }
                    q += __shfl_xor(q, 16); q += __shfl_xor(q, 32);
                    const float r2 = rsqrtf(q * (1.0f / 64.0f) + EPS);
#pragma unroll
                    for (int bj = 0; bj < 2; ++bj)
#pragma unroll
                        for (int n = 0; n < 2; ++n) v[bj][n] = v[bj][n] * r2 * gv[bj][n];
                } else if (mode == 2) {
#pragma unroll
                    for (int bj = 0; bj < 2; ++bj)
#pragma unroll
                        for (int n = 0; n < 2; ++n) { f32x4 x = v[bj][n] + gv[bj][n];
#pragma unroll
                            for (int e = 0; e < 4; ++e) x[e] = __builtin_amdgcn_rcpf(1.0f + __builtin_amdgcn_exp2f(-x[e] * LOG2E));
                            v[bj][n] = x; }
                }
                bf16_t* rowp = zg + (size_t)row * ZG + colb;
#pragma unroll
                for (int bj = 0; bj < 2; ++bj) { u32x4 w; w.x = cvt_pk_bf16(v[bj][0][0], v[bj][0][1]); w.y = cvt_pk_bf16(v[bj][0][2], v[bj][0][3]); w.z = cvt_pk_bf16(v[bj][1][0], v[bj][1][1]); w.w = cvt_pk_bf16(v[bj][1][2], v[bj][1][3]);
                    *(u32x4*)(rowp + 32 * bj) = w; }
            }
        }
    }
};
struct EpiMix {
    static constexpr bool PERM = true, AFTER_DRAIN = false;
    __device__ static bool zero_after(const Unit& u) { return u.z != 0; }
    const bf16_t* zg; bf16_t* mix;
    __device__ __forceinline__ void operator()(f32x4 (&acc)[2][2][4][2], const Unit& u, int wr, int wc, int fr, int fq, PG8_LAS unsigned char*) const {
        const int col0 = u.pn * BM + wc * 32 + 8 * fq;
#pragma unroll
        for (int ai = 0; ai < 2; ++ai) {
            u32x4 gbv[4][2], gav[4][2];
#pragma unroll
            for (int m = 0; m < 4; ++m)
#pragma unroll
                for (int bj = 0; bj < 2; ++bj) { const size_t go = (size_t)(u.pm * BM + ai * HALF + wr * 64 + m * 16 + fr) * ZG + C_G + col0 + bj * HALF;
                    gbv[m][bj] = *(const u32x4*)(zg + go + D); if (u.z == 0) gav[m][bj] = *(const u32x4*)(zg + go); else gav[m][bj] = (u32x4){0u, 0u, 0u, 0u}; }
#pragma unroll
            for (int m = 0; m < 4; ++m) {
                const int row = u.pm * BM + ai * HALF + wr * 64 + m * 16 + fr;
#pragma unroll
                for (int bj = 0; bj < 2; ++bj) {
                    const int col = col0 + bj * HALF;
                    const u32x4 gb = gbv[m][bj];
                    if (u.z == 0) {
                        const u32x4 ga = gav[m][bj];
                        f32x4 r0, r1;
                        r0[0] = bflo(ga.x) * __builtin_amdgcn_rcpf(bflo(gb.x)); r0[1] = bfhi(ga.x) * __builtin_amdgcn_rcpf(bfhi(gb.x)); r0[2] = bflo(ga.y) * __builtin_amdgcn_rcpf(bflo(gb.y)); r0[3] = bfhi(ga.y) * __builtin_amdgcn_rcpf(bfhi(gb.y));
                        r1[0] = bflo(ga.z) * __builtin_amdgcn_rcpf(bflo(gb.z)); r1[1] = bfhi(ga.z) * __builtin_amdgcn_rcpf(bfhi(gb.z)); r1[2] = bflo(ga.w) * __builtin_amdgcn_rcpf(bflo(gb.w)); r1[3] = bfhi(ga.w) * __builtin_amdgcn_rcpf(bfhi(gb.w));
                        acc[ai][bj][m][0] *= r0; acc[ai][bj][m][1] *= r1;
                    } else {
                        const f32x4 v0 = acc[ai][bj][m][0] * (f32x4){bflo(gb.x), bfhi(gb.x), bflo(gb.y), bfhi(gb.y)}, v1 = acc[ai][bj][m][1] * (f32x4){bflo(gb.z), bfhi(gb.z), bflo(gb.w), bfhi(gb.w)};
                        u32x4 w; w.x = cvt_pk_bf16(v0[0], v0[1]); w.y = cvt_pk_bf16(v0[2], v0[3]); w.z = cvt_pk_bf16(v1[0], v1[1]); w.w = cvt_pk_bf16(v1[2], v1[3]);
                        *(u32x4*)(mix + (size_t)row * D + col) = w;
                    }
                }
            }
            asm volatile("" ::: "memory");
        }
    }
};
struct EpiRes {
    static constexpr bool PERM = false, AFTER_DRAIN = false;
    __device__ static constexpr bool zero_after(const Unit&) { return true; }
    const float* base; float* xf; bf16_t* xb; float* ssn;
    __device__ __forceinline__ void operator()(f32x4 (&acc)[2][2][4][2], const Unit& u, int wr, int wc, int fr, int fq, PG8_LAS unsigned char*) const {
        const int col0 = u.pn * BM + wc * 32 + 4 * fq;
#pragma unroll
        for (int ai = 0; ai < 2; ++ai)
#pragma unroll
            for (int m = 0; m < 4; ++m) {
                const int row = u.pm * BM + ai * HALF + wr * 64 + m * 16 + fr; const size_t off = (size_t)row * D + col0; float q = 0.f;
#pragma unroll
                for (int bj = 0; bj < 2; ++bj)
#pragma unroll
                    for (int n = 0; n < 2; ++n) { const f32x4 bs = *(const f32x4*)(base + off + bj * HALF + n * 16); const f32x4 o = bs + acc[ai][bj][m][n];
                        *(f32x4*)(xf + off + bj * HALF + n * 16) = o; q += (o[0] * o[0] + o[1] * o[1]) + (o[2] * o[2] + o[3] * o[3]);
                        if (xb) { u32x2 w; w.x = cvt_pk_bf16(o[0], o[1]); w.y = cvt_pk_bf16(o[2], o[3]); *(u32x2*)(xb + off + bj * HALF + n * 16) = w; } }
                if (ssn) { q += __shfl_xor(q, 16); q += __shfl_xor(q, 32); if (fq == 0) ssn[(size_t)row * 16 + u.pn * 4 + wc] = q; }
                if (m == 3) asm volatile("" ::: "memory");
            }
    }
};
#define DPPF(oldv, src, ctrl, bc) __int_as_float(__builtin_amdgcn_update_dpp(__float_as_int(oldv), __float_as_int(src), (ctrl), 0xF, 0xF, (bc)))
struct EpiUp {
    static constexpr bool PERM = true, AFTER_DRAIN = false;
    __device__ static constexpr bool zero_after(const Unit&) { return true; }
    bf16_t* a; const float* ss; const float* cw; const float* cb; float* yb; int dup;
    __device__ __forceinline__ void operator()(f32x4 (&acc)[2][2][4][2], const Unit& u, int wr, int wc, int fr, int fq, PG8_LAS unsigned char* lds) const {
        const int wid = wr * 4 + wc;
        PG8_LAS float* X = (PG8_LAS float*)(lds + XOFF);
        float rsv[2][4];
#pragma unroll
        for (int ai = 0; ai < 2; ++ai)
#pragma unroll
            for (int m = 0; m < 4; ++m) rsv[ai][m] = rsqrtf(ss16_q(ss, u.pm * BM + ai * HALF + wr * 64 + m * 16 + fr, fq) * (1.0f / D) + EPS);
#pragma unroll
        for (int ai = 0; ai < 2; ++ai)
#pragma unroll
            for (int m = 0; m < 4; ++m) {
#pragma unroll
                for (int bj = 0; bj < 2; ++bj)
#pragma unroll
                    for (int n = 0; n < 2; ++n) acc[ai][bj][m][n] *= rsv[ai][m];
            }
#pragma unroll
        for (int ai = 0; ai < 2; ++ai) {
            if (fr == 0) {
#pragma unroll
                for (int bj = 0; bj < 2; ++bj)
#pragma unroll
                    for (int n = 0; n < 2; ++n) *(PG8_LAS f32x4*)(X + ((wid * 2 + ai) * 2 + 0) * 64 + 32 * bj + 8 * fq + 4 * n) = acc[ai][bj][0][n];
            }
            if (fr == 15) {
#pragma unroll
                for (int bj = 0; bj < 2; ++bj)
#pragma unroll
                    for (int n = 0; n < 2; ++n) *(PG8_LAS f32x4*)(X + ((wid * 2 + ai) * 2 + 1) * 64 + 32 * bj + 8 * fq + 4 * n) = acc[ai][bj][3][n];
            }
        }
        {
            const int ccol = u.pn * 128 + wc * 32 + 8 * fq;
            if (wr == 0 && fr < 2) {
#pragma unroll
                for (int bj = 0; bj < 2; ++bj)
#pragma unroll
                    for (int n = 0; n < 2; ++n) *(f32x4*)(yb + ((size_t)u.pm * 4 + fr) * FF2 + bj * FF + ccol + 4 * n) = acc[0][bj][0][n];
            }
            if (wr == 1 && fr >= 14) {
#pragma unroll
                for (int bj = 0; bj < 2; ++bj)
#pragma unroll
                    for (int n = 0; n < 2; ++n) *(f32x4*)(yb + ((size_t)u.pm * 4 + 2 + (fr - 14)) * FF2 + bj * FF + ccol + 4 * n) = acc[1][bj][3][n];
            }
        }
        asm volatile("s_waitcnt lgkmcnt(0)" ::: "memory"); __builtin_amdgcn_s_barrier(); asm volatile("" ::: "memory");
#pragma unroll
        for (int rep_ = 0; rep_ <= ((MK_EDUP & 1) ? 1 : 0); ++rep_) {
        if (rep_) {
#pragma unroll
            for (int ai = 0; ai < 2; ++ai)
#pragma unroll
                for (int bj = 0; bj < 2; ++bj)
#pragma unroll
                    for (int m = 0; m < 4; ++m)
#pragma unroll
                        for (int n = 0; n < 2; ++n) asm volatile("" : "+v"(acc[ai][bj][m][n]) :: "memory");
        }
#pragma unroll
        for (int n = 0; n < 2; ++n) {
            const int ccol = u.pn * 128 + wc * 32 + 8 * fq + 4 * n;
            f32x4 w0[2], w1[2], w2[2], bb[2];
#pragma unroll
            for (int bj = 0; bj < 2; ++bj) { w0[bj] = *(const f32x4*)(cw + bj * FF + ccol); w1[bj] = *(const f32x4*)(cw + FF2 + bj * FF + ccol); w2[bj] = *(const f32x4*)(cw + 2 * FF2 + bj * FF + ccol); bb[bj] = *(const f32x4*)(cb + bj * FF + ccol); }
#pragma unroll
            for (int ai = 0; ai < 2; ++ai) {
                const int pw = wr ? wid - 4 : wid + 4, pai = wr ? ai : 0;
                const int nw = wr ? wid - 4 : wid + 4, nai = wr ? 1 : ai;
                f32x4 xp[2], xn[2];
#pragma unroll
                for (int bj = 0; bj < 2; ++bj) { xp[bj] = *(PG8_LAS f32x4*)(X + ((pw * 2 + pai) * 2 + 1) * 64 + 32 * bj + 8 * fq + 4 * n); xn[bj] = *(PG8_LAS f32x4*)(X + ((nw * 2 + nai) * 2 + 0) * 64 + 32 * bj + 8 * fq + 4 * n); }
#pragma unroll
                for (int m = 0; m < 4; ++m) {
                    const int trow = ai * HALF + wr * 64 + m * 16 + fr;
                    float uv[2][4];
#pragma unroll
                    for (int bj = 0; bj < 2; ++bj)
#pragma unroll
                        for (int e = 0; e < 4; ++e) {
                            const float cur = acc[ai][bj][m][n][e];
                            float rp, rn;
                            if (m > 0) rp = DPPF(0.f, acc[ai][bj][m > 0 ? m - 1 : 0][n][e], 0x121, true); else rp = xp[bj][e];
                            if (m < 3) rn = DPPF(0.f, acc[ai][bj][m < 3 ? m + 1 : 3][n][e], 0x12F, true); else rn = xn[bj][e];
                            const float prev = DPPF(rp, cur, 0x111, false), next = DPPF(rn, cur, 0x101, false);
                            uv[bj][e] = bb[bj][e] + w0[bj][e] * prev + w1[bj][e] * cur + w2[bj][e] * next;
                        }
                    f32x4 o;
#pragma unroll
                    for (int e = 0; e < 4; ++e) o[e] = uv[0][e] * uv[1][e] * __builtin_amdgcn_rcpf(1.0f + __builtin_amdgcn_exp2f(-uv[1][e] * LOG2E));
                    u32x2 w; w.x = cvt_pk_bf16(o[0], o[1]); w.y = cvt_pk_bf16(o[2], o[3]);
                    if (trow != 0 && trow != 255) *(u32x2*)(a + (size_t)(u.pm * BM + trow) * FF + ccol) = w;
                    asm volatile("" ::: "memory");
                }
            }
        }
        }
    }
};

template <class Epi, class Sched, bool ALIGN_EPI = false, bool SP2 = false>
__device__ __forceinline__ void gemm_phase(PG8_LAS unsigned char* lds, const int K, const int lda, const Sched& S, const Epi& E) {
    int tid_ = threadIdx.x; asm volatile("" : "+v"(tid_));
    const int tid = tid_, wid = __builtin_amdgcn_readfirstlane(tid >> 6), lane = tid & 63, wr = wid >> 2, wc = wid & 3, fr = lane & 15, fq = lane >> 4;
    const int nt = K / BK;
    unsigned voffA[2], voffB[2];
#pragma unroll
    for (int i = 0; i < 2; ++i) { int R, C; stage_rc(tid * 16 + i * 8192, R, C); const int Rb = Epi::PERM ? ((R & ~31) + perm32(R & 31)) : R;
        voffA[i] = (unsigned)(R * lda + C) * 2u; voffB[i] = (unsigned)(Rb * K + C) * 2u; }
    const size_t kstep = (size_t)(BK * 2);
    const size_t hstepB = (size_t)HALF * K * 2;
    const size_t hstepA = (size_t)HALF * lda * 2;
    const unsigned ldsw = (unsigned)wid * 1024u;
    const int aoff = lds_byte(wr * 64 + fr, fq * 8), boff = lds_byte(wc * 32 + fr, fq * 8);
#define PG8_SA(b, h) (((b) * 2 + (h)) * HTB)
#define PG8_SB(b, h) ((4 + (b) * 2 + (h)) * HTB)
#define PG8_STAGE(bufoff, gbase, voff) do { _Pragma("unroll") for (int _i = 0; _i < 2; ++_i) \
        __builtin_amdgcn_global_load_lds((const unsigned*)((const char*)(gbase) + (voff)[_i]), (PG8_LAS unsigned*)(lds + (bufoff) + ldsw + _i * 8192), 16, 0, 0); } while (0)
#define PG8_LDA(dst, b, h) do { _Pragma("unroll") for (int m = 0; m < 4; ++m) _Pragma("unroll") for (int k = 0; k < 2; ++k) dst[m][k] = *(const PG8_LAS bf16x8*)(lds + PG8_SA(b, h) + aoff + m * 2048 + k * 1024); } while (0)
#define PG8_LDB(dst, b, h) do { _Pragma("unroll") for (int n = 0; n < 2; ++n) _Pragma("unroll") for (int k = 0; k < 2; ++k) dst[n][k] = *(const PG8_LAS bf16x8*)(lds + PG8_SB(b, h) + boff + n * 2048 + k * 1024); } while (0)
#define PG8_MMA(ai, bj, At, Bt) do { __builtin_amdgcn_s_setprio(1); _Pragma("unroll") for (int m = 0; m < 4; ++m) _Pragma("unroll") for (int n = 0; n < 2; ++n) _Pragma("unroll") for (int k = 0; k < 2; ++k) \
        acc[ai][bj][m][n] = __builtin_amdgcn_mfma_f32_16x16x32_bf16(Bt[n][k], At[m][k], acc[ai][bj][m][n], 0, 0, 0); __builtin_amdgcn_s_setprio(0); } while (0)
#define PG8_WAIT_V(n) asm volatile("s_waitcnt vmcnt(" #n ")" ::: "memory")
#define PG8_WAIT_L(n) asm volatile("s_waitcnt lgkmcnt(" #n ")" ::: "memory")
#define PG8_BAR __builtin_amdgcn_s_barrier()
#define PG8_SCHED __builtin_amdgcn_sched_barrier(0)
    Unit cur, nxt; int ui = 0;
    if (!S.next(0, cur)) return;
    f32x4 acc[2][2][4][2];
#pragma unroll
    for (int a = 0; a < 2; ++a)
#pragma unroll
        for (int b = 0; b < 2; ++b)
#pragma unroll
            for (int m = 0; m < 4; ++m)
#pragma unroll
                for (int n = 0; n < 2; ++n) acc[a][b][m][n] = (f32x4){0.f, 0.f, 0.f, 0.f};
    bf16x8 At[4][2], B0[2][2], B1[2][2];
    const char* cA = S.aptr(cur); const char* cB = S.bptr(cur);
    S.a_ready(cur);
    if constexpr (SP2) {
        PG8_STAGE(PG8_SB(0, 0), cB, voffB); PG8_STAGE(PG8_SB(0, 1), cB + hstepB, voffB); PG8_STAGE(PG8_SA(0, 0), cA, voffA); PG8_STAGE(PG8_SA(0, 1), cA + hstepA, voffA);
        if (wr == 1) PG8_BAR;
        PG8_WAIT_V(2); PG8_BAR;
        PG8_STAGE(PG8_SB(1, 0), cB + kstep, voffB); PG8_STAGE(PG8_SA(1, 0), cA + kstep, voffA); PG8_STAGE(PG8_SB(1, 1), cB + hstepB + kstep, voffB);
        PG8_WAIT_V(6); PG8_BAR;
    } else {
        PG8_STAGE(PG8_SB(0, 0), cB, voffB); PG8_STAGE(PG8_SA(0, 0), cA, voffA); PG8_STAGE(PG8_SB(0, 1), cB + hstepB, voffB); PG8_STAGE(PG8_SA(0, 1), cA + hstepA, voffA);
        if (wr == 1) PG8_BAR;
        PG8_WAIT_V(4); PG8_BAR;
        PG8_STAGE(PG8_SB(1, 0), cB + kstep, voffB); PG8_STAGE(PG8_SA(1, 0), cA + kstep, voffA); PG8_STAGE(PG8_SB(1, 1), cB + hstepB + kstep, voffB);
        PG8_WAIT_V(6); PG8_BAR;
    }
    for (;;) {
        const bool has_next = S.next(ui + 1, nxt);
        const char* nA = has_next ? S.aptr(nxt) : cA; const char* nB = has_next ? S.bptr(nxt) : cB;
        for (int t = 0; t < nt; t += 2) {
            const bool last = (t == nt - 2);
            const char* a1 = cA + (size_t)(t + 1) * kstep;
            const char* a2 = last ? nA : cA + (size_t)(t + 2) * kstep; const char* b2 = last ? nB : cB + (size_t)(t + 2) * kstep;
            const char* a3 = a2 + kstep; const char* b3 = b2 + kstep;
            if (last && has_next) S.a_ready(nxt);
            if constexpr (SP2) {
            PG8_LDB(B0, 0, 0); PG8_LDB(B1, 0, 1); PG8_SCHED; PG8_LDA(At, 0, 0); PG8_STAGE(PG8_SA(1, 1), a1 + hstepA, voffA);
            PG8_WAIT_V(8); PG8_WAIT_L(0); PG8_BAR; PG8_MMA(0, 0, At, B0); PG8_MMA(0, 1, At, B1); PG8_BAR; PG8_SCHED;
            PG8_LDA(At, 0, 1); PG8_STAGE(PG8_SB(0, 0), b2, voffB); PG8_STAGE(PG8_SB(0, 1), b2 + hstepB, voffB); PG8_STAGE(PG8_SA(0, 0), a2, voffA);
            PG8_WAIT_V(8); PG8_WAIT_L(0); PG8_BAR; PG8_MMA(1, 0, At, B0); PG8_MMA(1, 1, At, B1); PG8_BAR; PG8_SCHED;
            PG8_LDB(B0, 1, 0); PG8_LDB(B1, 1, 1); PG8_SCHED; PG8_LDA(At, 1, 0); PG8_STAGE(PG8_SA(0, 1), a2 + hstepA, voffA);
            PG8_WAIT_V(8); PG8_WAIT_L(0); PG8_BAR; PG8_MMA(0, 0, At, B0); PG8_MMA(0, 1, At, B1); PG8_BAR; PG8_SCHED;
            PG8_LDA(At, 1, 1); PG8_STAGE(PG8_SB(1, 0), b3, voffB); PG8_STAGE(PG8_SB(1, 1), b3 + hstepB, voffB); PG8_STAGE(PG8_SA(1, 0), a3, voffA);
            PG8_WAIT_V(8); PG8_WAIT_L(0); PG8_BAR; PG8_MMA(1, 0, At, B0); PG8_MMA(1, 1, At, B1); PG8_BAR; PG8_SCHED;
            } else {
            PG8_LDB(B0, 0, 0); PG8_SCHED; PG8_LDA(At, 0, 0); PG8_STAGE(PG8_SA(1, 1), a1 + hstepA, voffA);
            PG8_WAIT_L(8); PG8_BAR; PG8_WAIT_L(0); PG8_MMA(0, 0, At, B0); PG8_BAR; PG8_SCHED;
            PG8_LDB(B1, 0, 1); PG8_STAGE(PG8_SB(0, 0), b2, voffB);
            PG8_BAR; PG8_WAIT_L(0); PG8_MMA(0, 1, At, B1); PG8_BAR;
            PG8_LDA(At, 0, 1); PG8_STAGE(PG8_SA(0, 0), a2, voffA);
            PG8_BAR; PG8_WAIT_L(0); PG8_MMA(1, 0, At, B0); PG8_BAR; PG8_SCHED;
            PG8_STAGE(PG8_SB(0, 1), b2 + hstepB, voffB);
            PG8_WAIT_V(6); PG8_BAR; PG8_MMA(1, 1, At, B1); PG8_BAR;
            PG8_LDB(B0, 1, 0); PG8_SCHED; PG8_LDA(At, 1, 0); PG8_STAGE(PG8_SA(0, 1), a2 + hstepA, voffA);
            PG8_WAIT_L(8); PG8_BAR; PG8_WAIT_L(0); PG8_MMA(0, 0, At, B0); PG8_BAR; PG8_SCHED;
            PG8_LDB(B1, 1, 1); PG8_STAGE(PG8_SB(1, 0), b3, voffB);
            PG8_BAR; PG8_WAIT_L(0); PG8_MMA(0, 1, At, B1); PG8_BAR;
            PG8_LDA(At, 1, 1); PG8_STAGE(PG8_SA(1, 0), a3, voffA);
            PG8_BAR; PG8_WAIT_L(0); PG8_MMA(1, 0, At, B0); PG8_BAR; PG8_SCHED;
            PG8_STAGE(PG8_SB(1, 1), b3 + hstepB, voffB);
            PG8_WAIT_V(6); PG8_BAR; PG8_MMA(1, 1, At, B1); PG8_BAR;
            }
        }
        if constexpr (ALIGN_EPI) { if (wr == 0) PG8_BAR; }
        if constexpr (!Epi::AFTER_DRAIN) { E(acc, cur, wr, wc, fr, fq, lds); S.done(cur); }
        if (!has_next) break;
        if (Epi::zero_after(cur)) {
#pragma unroll
        for (int a = 0; a < 2; ++a)
#pragma unroll
            for (int b = 0; b < 2; ++b)
#pragma unroll
                for (int m = 0; m < 4; ++m)
#pragma unroll
                    for (int n = 0; n < 2; ++n) acc[a][b][m][n] = (f32x4){0.f, 0.f, 0.f, 0.f};
        }
        cur = nxt; cA = nA; cB = nB; ++ui;
        if constexpr (ALIGN_EPI) { if (wr == 1) PG8_BAR; }
    }
    PG8_WAIT_V(0);
    if constexpr (!ALIGN_EPI) { if (wr == 0) PG8_BAR; }
    PG8_BAR;
    if constexpr (Epi::AFTER_DRAIN) { E.fused(acc, cur, wr, wc, fr, fq, lds, wid, lane); S.done(cur); }
#undef PG8_SA
#undef PG8_SB
#undef PG8_STAGE
#undef PG8_LDA
#undef PG8_LDB
#undef PG8_MMA
#undef PG8_WAIT_V
#undef PG8_WAIT_L
#undef PG8_BAR
#undef PG8_SCHED
}
}

namespace att {
using namespace nv;
#define ALAS __attribute__((address_space(3)))
typedef short bf16x8 __attribute__((ext_vector_type(8)));
typedef short s16x4 __attribute__((ext_vector_type(4)));
typedef float f32x16 __attribute__((ext_vector_type(16)));
typedef float f32x4 __attribute__((ext_vector_type(4)));
typedef unsigned u32x4 __attribute__((ext_vector_type(4)));
typedef unsigned u32x2 __attribute__((ext_vector_type(2)));
typedef short v4i16_t __attribute__((ext_vector_type(4)));
typedef float f32x2_t __attribute__((ext_vector_type(2))); typedef __bf16 bf16x2_t __attribute__((ext_vector_type(2)));
constexpr int LUT_OFF = 98304, LUT_STRIDE = 520, GT_OFF = LUT_OFF + 12 * LUT_STRIDE * 4;
static_assert(GT_OFF + 512 <= 131072, "attention tables inside the ring region");
constexpr float NEG = -30000.f, THR = 6.f;
__device__ __forceinline__ unsigned cvtpk(float lo, float hi) { f32x2_t v = {lo, hi}; bf16x2_t b = __builtin_convertvector(v, bf16x2_t); return __builtin_bit_cast(unsigned, b); }
__device__ __forceinline__ s16x4 vtr(ALAS const unsigned char* p) { return __builtin_bit_cast(s16x4, __builtin_amdgcn_ds_read_tr16_b64_v4i16((ALAS v4i16_t*)p)); }
__device__ __forceinline__ void glds16(const void* gsrc, unsigned lds_dst) { unsigned keep;
    asm volatile("s_mov_b32 %0, m0\n\ts_mov_b32 m0, %2\n\ts_nop 0\n\tglobal_load_lds_dwordx4 %1, off\n\ts_mov_b32 m0, %0" : "=&s"(keep) : "v"(gsrc), "s"(lds_dst) : "memory"); }
__device__ __forceinline__ float swap_add(float v) { auto rr = __builtin_amdgcn_permlane32_swap(__float_as_uint(v), __float_as_uint(v), false, false); return __uint_as_float(rr[0]) + __uint_as_float(rr[1]); }
__device__ __forceinline__ float swap_max(float v) { auto rr = __builtin_amdgcn_permlane32_swap(__float_as_uint(v), __float_as_uint(v), false, false); return fmaxf(__uint_as_float(rr[0]), __uint_as_float(rr[1])); }
#define MX3(a, b, c) __builtin_fmaxf(__builtin_fmaxf((a), (b)), (c))

__device__ __forceinline__ void attn_tables(ALAS unsigned char* lds, const float* __restrict__ lutg, const float* __restrict__ subg, float osc) {
    int tid = threadIdx.x; asm volatile("" : "+v"(tid));
    ALAS float* lut = (ALAS float*)(lds + LUT_OFF); ALAS float* gt = (ALAS float*)(lds + GT_OFF);
    for (int i = tid; i < 12 * LUT_STRIDE; i += 512) lut[i] = lutg[i];
    if (tid < 128) gt[tid] = subg[tid] * osc;
    __syncthreads();
}
template <bool ISB, int VAR = 0>
__device__ __forceinline__ void attn_unit(ALAS unsigned char* lds, bf16* zg, const float* __restrict__ lutg, int b, int hsel, int q0, const float* __restrict__ sinkp, float lam, float osc, const float* __restrict__ subg, bf16* odry) {
    int tid_ = threadIdx.x; asm volatile("" : "+v"(tid_));
    const int tid = tid_, lane = tid & 63, r32 = lane & 31, hi = lane >> 5; const int wid = __builtin_amdgcn_readfirstlane(tid >> 6);
    constexpr int NDV = ISB ? 4 : 2, BUF = ISB ? 32768 : 16384, VOFF = ISB ? 16384 : 8192;
    const int map = ISB ? (wid >> 2) : 0, qsub = ISB ? (wid & 3) : (wid & 1), gsel = ISB ? 0 : (wid >> 1);
    const int head = ISB ? hsel : hsel * 4 + gsel;
    const int qrow0 = q0 + 32 * qsub;
    const int qcol = ISB ? (C_QB + head * 128 + map * 64) : (C_QA + head * 64);
    const int kcol = ISB ? (C_KB + head * 128) : (C_KA + hsel * 64);
    const int vcol = ISB ? (C_VB + head * 128) : (C_VA + hsel * 64);
    const size_t rowbase = (size_t)b * S;
    int kt0 = 0, kt1 = S / 64;
    if (!ISB) { kt0 = q0 / 64 - 2; if (kt0 < 0) kt0 = 0; kt1 = q0 / 64 + 3; if (kt1 > S / 64) kt1 = S / 64; }
    const int nt = kt1 - kt0;
    ALAS float* lut = (ALAS float*)(lds + LUT_OFF) + (ISB ? 8 + head : hsel * 4 + gsel) * LUT_STRIDE;
    ALAS float* gt = (ALAS float*)(lds + GT_OFF);
    const float sink2 = ISB ? 0.f : sinkp[head] * LOG2E;
    bf16x8 qr[4];
    { const bf16* qp = zg + (rowbase + qrow0 + r32) * ZG + qcol + hi * 8;
#pragma unroll
      for (int d0 = 0; d0 < 4; ++d0) qr[d0] = *(const bf16x8*)(qp + d0 * 16); }
    const unsigned lds0 = (unsigned)(size_t)lds;
    const bf16* kp_[2]; const bf16* vp_[2];
#pragma unroll
    for (int i_ = 0; i_ < 2; ++i_) { const int p_ = ISB ? wid * 2 + i_ : wid;
        kp_[i_] = zg + (rowbase + (size_t)kt0 * 64 + lane) * ZG + kcol + (ISB ? (p_ >> 3) * 64 + (p_ & 7) * 8 : wid * 8);
        vp_[i_] = zg + (rowbase + (size_t)kt0 * 64 + 16 * (p_ & 3) + (lane >> 2)) * ZG + vcol + 32 * (p_ >> 2) + 8 * (lane & 3); }
#define ATT_ISSUE(bo) do { \
        _Pragma("unroll") for (int i_ = 0; i_ < (ISB ? 2 : 1); ++i_) { const int p_ = ISB ? wid * 2 + i_ : wid; \
            glds16(kp_[i_], (unsigned)__builtin_amdgcn_readfirstlane((int)(lds0 + (bo) + p_ * 1024))); \
            glds16(vp_[i_], (unsigned)__builtin_amdgcn_readfirstlane((int)(lds0 + (bo) + VOFF + p_ * 1024))); \
            kp_[i_] += 64 * ZG; vp_[i_] += 64 * ZG; } } while (0)
#define ATT_SB() __builtin_amdgcn_sched_barrier(0)
    float mhat = 0.f, l = 0.f;
    f32x16 o[NDV];
#pragma unroll
    for (int d = 0; d < NDV; ++d)
#pragma unroll
        for (int r = 0; r < 16; ++r) o[d][r] = 0.f;
    const int kfo = (ISB ? map * 8192 : 0) + hi * 1024 + r32 * 16;
    const int vfo = VOFF + ((lane >> 4) & 1) * 32 + (lane & 3) * 8 + (4 * hi + ((lane & 15) >> 2)) * 64;
    u32x4 pw[4];
#define ATT_QK(P0, P1, t, so) do { const int kb_ = (t) * 64; float cf_ = 0.f; \
        if (ISB) { if (kb_ - qrow0 - 31 >= 91) cf_ = lut[256 + 128]; else if (kb_ + 63 - qrow0 <= -91) cf_ = lut[256 - 128]; } \
        const float c0_ = cf_ - mhat; f32x16 ci_; _Pragma("unroll") for (int r = 0; r < 16; ++r) ci_[r] = c0_; \
        ALAS const unsigned char* kp = lds + (so) + kfo; \
        P0 = __builtin_amdgcn_mfma_f32_32x32x16_bf16(*(ALAS const bf16x8*)(kp), qr[0], ci_, 0, 0, 0); \
        P1 = __builtin_amdgcn_mfma_f32_32x32x16_bf16(*(ALAS const bf16x8*)(kp + 512), qr[0], ci_, 0, 0, 0); \
        _Pragma("unroll") for (int d0 = 1; d0 < 4; ++d0) { \
            P0 = __builtin_amdgcn_mfma_f32_32x32x16_bf16(*(ALAS const bf16x8*)(kp + d0 * 2048), qr[d0], P0, 0, 0, 0); \
            P1 = __builtin_amdgcn_mfma_f32_32x32x16_bf16(*(ALAS const bf16x8*)(kp + d0 * 2048 + 512), qr[d0], P1, 0, 0, 0); } } while (0)
#define ATT_DECIDE(P0, P1, t, first) do { const int kb_ = (t) * 64; \
        if (!ISB || !((kb_ - qrow0 - 31 >= 91) || (kb_ + 63 - qrow0 <= -91))) { \
            ALAS const float* lp = lut + (kb_ - (qrow0 + r32) + 256 + 4 * hi); \
            _Pragma("unroll") for (int r = 0; r < 16; ++r) { P0[r] += lp[(r & 3) + 8 * (r >> 2)]; P1[r] += lp[32 + (r & 3) + 8 * (r >> 2)]; } } \
        float rm_; { float a = MX3(P0[0], P0[1], P1[0]), c = MX3(P0[2], P0[3], P1[1]); a = MX3(a, P1[2], P1[3]); \
            _Pragma("unroll") for (int r = 4; r < 16; r += 4) { a = MX3(a, P0[r], P0[r + 1]); c = MX3(c, P0[r + 2], P0[r + 3]); a = MX3(a, P1[r], P1[r + 1]); c = MX3(c, P1[r + 2], P1[r + 3]); } \
            rm_ = swap_max(__builtin_fmaxf(a, c)); } \
        if ((first) || __any(rm_ > THR)) { const float dl = (first) ? rm_ : __builtin_fmaxf(rm_, 0.f); mhat += dl; \
            _Pragma("unroll") for (int r = 0; r < 16; ++r) { P0[r] -= dl; P1[r] -= dl; } \
            if (!(first)) { const float f = __builtin_amdgcn_exp2f(-dl); l *= f; \
                _Pragma("unroll") for (int d = 0; d < NDV; ++d) _Pragma("unroll") for (int r = 0; r < 16; ++r) o[d][r] *= f; } } } while (0)
#define ATT_FINISH(P0, P1) do { float sacc = 0.f; \
        _Pragma("unroll") for (int r = 0; r < 16; ++r) { P0[r] = __builtin_amdgcn_exp2f(P0[r]); P1[r] = __builtin_amdgcn_exp2f(P1[r]); sacc += P0[r] + P1[r]; } \
        l += sacc; \
        pw[0] = (u32x4){cvtpk(P0[0], P0[1]), cvtpk(P0[2], P0[3]), cvtpk(P0[4], P0[5]), cvtpk(P0[6], P0[7])}; \
        pw[1] = (u32x4){cvtpk(P0[8], P0[9]), cvtpk(P0[10], P0[11]), cvtpk(P0[12], P0[13]), cvtpk(P0[14], P0[15])}; \
        pw[2] = (u32x4){cvtpk(P1[0], P1[1]), cvtpk(P1[2], P1[3]), cvtpk(P1[4], P1[5]), cvtpk(P1[6], P1[7])}; \
        pw[3] = (u32x4){cvtpk(P1[8], P1[9]), cvtpk(P1[10], P1[11]), cvtpk(P1[12], P1[13]), cvtpk(P1[14], P1[15])}; } while (0)
#define ATT_LDV(dst, d) do { _Pragma("unroll") for (int ks = 0; ks < 4; ++ks) { dst[2 * ks] = vtr(vp + (d) * 4096 + ks * 1024); dst[2 * ks + 1] = vtr(vp + (d) * 4096 + ks * 1024 + 512); } } while (0)
#define ATT_VF(src, ks) (bf16x8){src[2 * (ks)][0], src[2 * (ks)][1], src[2 * (ks)][2], src[2 * (ks)][3], src[2 * (ks) + 1][0], src[2 * (ks) + 1][1], src[2 * (ks) + 1][2], src[2 * (ks) + 1][3]}
#define ATT_PVD(src, d) do { __builtin_amdgcn_s_setprio(1); _Pragma("unroll") for (int ks = 0; ks < 4; ++ks) o[d] = __builtin_amdgcn_mfma_f32_32x32x16_bf16(ATT_VF(src, ks), __builtin_bit_cast(bf16x8, pw[ks]), o[d], 0, 0, 0); __builtin_amdgcn_s_setprio(0); } while (0)
#define ATT_PV(so) do { ALAS const unsigned char* vp = lds + (so) + vfo; s16x4 va[8], vb[8]; \
        ATT_LDV(va, 0); ATT_LDV(vb, 1); ATT_SB(); ATT_PVD(va, 0); ATT_SB(); \
        if (NDV == 4) { ATT_LDV(va, 2); ATT_SB(); ATT_PVD(vb, 1); ATT_SB(); ATT_LDV(vb, 3); ATT_SB(); ATT_PVD(va, 2); ATT_SB(); ATT_PVD(vb, 3); } \
        else { ATT_PVD(vb, 1); } } while (0)
#define ATT_SLOT(i) (ISB ? (((i) % 3) * BUF) : ((i) * BUF))
#define ATT_STEP(i, PC0, PC1, PP0, PP1) do { \
        if (ISB) { asm volatile("s_waitcnt vmcnt(0)" ::: "memory"); __syncthreads(); if ((i) + 1 < nt) ATT_ISSUE(ATT_SLOT((i) + 1)); } \
        ATT_QK(PC0, PC1, kt0 + (i), ATT_SLOT(i)); ATT_SB(); \
        ATT_FINISH(PP0, PP1); ATT_SB(); \
        ATT_PV(ATT_SLOT((i) - 1)); ATT_SB(); \
        ATT_DECIDE(PC0, PC1, kt0 + (i), false); ATT_SB(); } while (0)
    f32x16 pA0, pA1, pB0, pB1;
    if (ISB) { ATT_ISSUE(0); asm volatile("s_waitcnt vmcnt(0)" ::: "memory"); __syncthreads(); if (nt > 1) ATT_ISSUE(BUF); }
    else {
#pragma unroll 1
        for (int i = 0; i < nt; ++i) ATT_ISSUE(i * BUF);
        asm volatile("s_waitcnt vmcnt(0)" ::: "memory"); __syncthreads();
    }
    ATT_QK(pA0, pA1, kt0, 0); ATT_SB();
    ATT_DECIDE(pA0, pA1, kt0, true); ATT_SB();
    int i = 1;
#pragma unroll 1
    for (; i + 1 < nt; i += 2) {
        ATT_STEP(i, pB0, pB1, pA0, pA1);
        ATT_STEP(i + 1, pA0, pA1, pB0, pB1);
    }
    if (i < nt) {
        ATT_STEP(i, pB0, pB1, pA0, pA1);
        ATT_FINISH(pB0, pB1); ATT_SB(); ATT_PV(ATT_SLOT(nt - 1));
    } else {
        ATT_FINISH(pA0, pA1); ATT_SB(); ATT_PV(ATT_SLOT(nt - 1));
    }
#undef ATT_ISSUE
#undef ATT_SB
#undef ATT_QK
#undef ATT_DECIDE
#undef ATT_FINISH
#undef ATT_PV
#undef ATT_LDV
#undef ATT_VF
#undef ATT_PVD
#undef ATT_SLOT
#undef ATT_STEP
    l = swap_add(l);
    if (!ISB) l += __builtin_amdgcn_exp2f(sink2 - mhat);
    const float inv = 1.0f / l;
    bf16* orow = odry ? odry + (rowbase + qrow0 + r32) * D + (ISB ? (512 + head * 128) : (head * 64)) : zg + (rowbase + qrow0 + r32) * ZG + (ISB ? (C_QB + head * 128) : (C_QA + head * 64));
    if (ISB) {
        __syncthreads();
        ALAS float* cs = (ALAS float*)lds;
        if (map == 1) { const float sc = -lam * inv;
#pragma unroll
            for (int d = 0; d < NDV; ++d)
#pragma unroll
                for (int r = 0; r < 16; ++r) cs[(qsub * 64 + d * 16 + r) * 64 + lane] = o[d][r] * sc; }
        __syncthreads();
        if (map == 0) {
            float q = 0.f;
#pragma unroll
            for (int d = 0; d < NDV; ++d)
#pragma unroll
                for (int r = 0; r < 16; ++r) { const float v = o[d][r] * inv + cs[(qsub * 64 + d * 16 + r) * 64 + lane]; o[d][r] = v; q += v * v; }
            q = swap_add(q);
            const float rstd = rsqrtf(q * (1.0f / 128.0f) + EPS);
#pragma unroll
            for (int d = 0; d < NDV; ++d)
#pragma unroll
                for (int g4 = 0; g4 < 4; ++g4) { const int dv0 = 32 * d + 8 * g4 + 4 * hi; const f32x4 gv = *(ALAS const f32x4*)(gt + dv0);
                    u32x2 w; w.x = cvtpk(o[d][4 * g4] * rstd * gv[0], o[d][4 * g4 + 1] * rstd * gv[1]); w.y = cvtpk(o[d][4 * g4 + 2] * rstd * gv[2], o[d][4 * g4 + 3] * rstd * gv[3]);
                    *(u32x2*)(orow + dv0) = w; }
        }
    } else {
#pragma unroll
        for (int d = 0; d < NDV; ++d)
#pragma unroll
            for (int g4 = 0; g4 < 4; ++g4) { const int dv0 = 32 * d + 8 * g4 + 4 * hi;
                u32x2 w; w.x = cvtpk(o[d][4 * g4] * inv, o[d][4 * g4 + 1] * inv); w.y = cvtpk(o[d][4 * g4 + 2] * inv, o[d][4 * g4 + 3] * inv);
                *(u32x2*)(orow + dv0) = w; }
    }
    __syncthreads();
}
#undef MX3
}

#ifndef MK_VAR
#define MK_VAR 0
#endif
namespace mk {
using namespace nv;
constexpr int NWAVES = 8;
constexpr size_t MiB = 1u << 20;
constexpr size_t WS_CTL = 0, CTL_ZERO_BYTES = 1 * MiB;
constexpr size_t WS_LUT = 512 * 1024;
constexpr size_t WS_SS = 1 * MiB;
constexpr size_t WS_XB = 6 * MiB;
constexpr size_t WS_ZG = 38 * MiB;
constexpr size_t WS_A = 38 * MiB;
constexpr size_t WS_YB = 126 * MiB;
constexpr size_t WS_MIX = 174 * MiB;
constexpr size_t WS_W = 206 * MiB;
constexpr size_t WL_IN = 0, WL_A = (size_t)ZG * D, WL_B = WL_A + (size_t)D * 512, WL_O = WL_B + (size_t)D * 512, WL_UP = WL_O + (size_t)D * D, WL_DN = WL_UP + (size_t)FF2 * D, WL_END = WL_DN + (size_t)D * FF;
constexpr size_t WS_TMPA = 322 * MiB, WS_TMPB = 344 * MiB;
constexpr size_t WS_END = 352 * MiB;
static_assert(WS_W + 4 * WL_END * 2 <= WS_TMPA && WS_YB + (size_t)64 * 4 * FF2 * 4 <= WS_MIX && WS_A + (size_t)T * FF * 2 <= WS_YB, "d_ws map");
constexpr int CW_Q = 2048;
constexpr int CW_BAR = 4096;
constexpr int N_PHASES = 1 + 6 * L;
constexpr int RING_OFF = 0, RING_BYTES = 131072, LDSCTL_OFF = RING_BYTES, MISC_OFF = LDSCTL_OFF + 320;
constexpr int LDS_BYTES = 147456;
static_assert(pg8::XOFF + 8192 <= LDS_BYTES && MISC_OFF + 128 <= pg8::XOFF, "LDS map");

#define GAS __attribute__((address_space(1)))
#define LAS __attribute__((address_space(3)))
typedef unsigned v4u __attribute__((ext_vector_type(4)));
typedef float f32x4 __attribute__((ext_vector_type(4)));
typedef GAS unsigned gu32;
#define RLX_AGENT __ATOMIC_RELAXED, __HIP_MEMORY_SCOPE_AGENT
#define LDS_WAIT() asm volatile("s_waitcnt lgkmcnt(0)" ::: "memory")
#define VM_WAIT() asm volatile("s_waitcnt vmcnt(0)" ::: "memory")
__device__ __forceinline__ unsigned f2bfu(float f) { unsigned u = __builtin_bit_cast(unsigned, f); return (u + 0x7fffu + ((u >> 16) & 1u)) >> 16; }
__device__ __forceinline__ unsigned pk2(float lo, float hi) { return f2bfu(lo) | (f2bfu(hi) << 16); }

#define XB_TMO      128
#define XB_XCNT(j)  (256  + 64 * (j))
#define XB_XSUB(j)  (1280 + 64 * (j))
#define XB_XGEN(j)  (2304 + 64 * (j))
#define XB_TOP      3328
#define XB_TOPGEN   3392
#define XCD_BAR_WORDS 3456
#define XB_SPIN_CAP (1u << 18)

__device__ __forceinline__ unsigned xb_ld(unsigned* p)              { return __hip_atomic_load(p, __ATOMIC_RELAXED, __HIP_MEMORY_SCOPE_AGENT); }
__device__ __forceinline__ unsigned xb_add(unsigned* p, unsigned v) { return __hip_atomic_fetch_add(p, v, __ATOMIC_RELAXED, __HIP_MEMORY_SCOPE_AGENT); }
__device__ __forceinline__ unsigned xb_xcc_id() { return (unsigned)__builtin_amdgcn_s_getreg((3 << 11) | 20) & 0xFu; }
#define XB_SPIN(cond, bar) do { unsigned _sp = 0; while (cond) { __builtin_amdgcn_s_sleep(1); \
    if ((++_sp & 255u) == 0u) { if (xb_ld(&(bar)[XB_TMO])) break; if (_sp > XB_SPIN_CAP) { atomicAdd(&(bar)[XB_TMO], 1u); break; } } } } while (0)

struct XcdBarrier {
    unsigned* bar; unsigned x;
    volatile LAS unsigned* st;
};

__device__ __forceinline__ XcdBarrier xcd_barrier_post(unsigned* bar, volatile LAS unsigned* st) {
    XcdBarrier b; b.bar = bar; b.x = xb_xcc_id(); b.st = st;
    if (threadIdx.x == 0) (void)xb_add(&bar[XB_XCNT(b.x)], 1u);
    return b;
}
__device__ __forceinline__ void xcd_barrier_complete(unsigned* bar, unsigned x, unsigned& nloc, unsigned& nx) {
    const unsigned G = gridDim.x * gridDim.y * gridDim.z;
    unsigned sum, cnt, mine, sp = 0u;
    for (;;) {
        sum = 0u; cnt = 0u; mine = 0u;
#pragma unroll
        for (unsigned j = 0; j < 16; ++j) { const unsigned c = xb_ld(&bar[XB_XCNT(j)]); sum += c; cnt += (c > 0u) ? 1u : 0u; mine = (j == x) ? c : mine; }
        if (sum == G) break;
        __builtin_amdgcn_s_sleep(1);
        if ((++sp & 255u) == 0u) { if (xb_ld(&bar[XB_TMO])) break; if (sp > XB_SPIN_CAP) { atomicAdd(&bar[XB_TMO], 1u); break; } }
    }
    nloc = mine > 0u ? mine : 1u; nx = cnt > 0u ? cnt : 1u;
}

__device__ __forceinline__ void xcd_barrier(const XcdBarrier& b) {
    asm volatile("s_waitcnt vmcnt(0)" ::: "memory");
    __syncthreads();
    if (threadIdx.x == 0) {
        unsigned* bar = b.bar;
        __builtin_amdgcn_s_waitcnt(0);
        unsigned nloc = b.st[0], nx = b.st[1];
        if (nloc == 0u) { xcd_barrier_complete(bar, b.x, nloc, nx); b.st[0] = nloc; b.st[1] = nx; }
        const unsigned old = xb_add(&bar[XB_XSUB(b.x)], 1u);
        const unsigned gen = old / nloc;
        if (old + 1u == (gen + 1u) * nloc) {
            __builtin_amdgcn_fence(__ATOMIC_RELEASE, "agent");
            asm volatile("s_waitcnt vmcnt(0)" ::: "memory");
            const unsigned og = xb_add(&bar[XB_TOP], 1u);
            const unsigned tg = og / nx;
            if (og + 1u == (tg + 1u) * nx) xb_add(&bar[XB_TOPGEN], 1u);
            else XB_SPIN(xb_ld(&bar[XB_TOPGEN]) == tg, bar);
            __builtin_amdgcn_fence(__ATOMIC_ACQUIRE, "agent");
            xb_add(&bar[XB_XGEN(b.x)], 1u);
            asm volatile("s_waitcnt vmcnt(0)" ::: "memory");
        } else {
            XB_SPIN(xb_ld(&bar[XB_XGEN(b.x)]) == gen, bar);
            __builtin_amdgcn_fence(__ATOMIC_ACQUIRE, "agent");
            asm volatile("s_waitcnt vmcnt(0)" ::: "memory");
        }
    }
    __syncthreads();
}


struct Args { const float* in[24]; float* out; unsigned char* ws; int ph_lo, ph_hi, li, pad; };

__device__ __forceinline__ void p0_transpose_item(const float* __restrict__ W, int ldw, int K, int k0, int n0, bf16* __restrict__ WT, int vrow0, const float* __restrict__ gain, LAS float* scr, int lane) {
    float v[32];
    const float* wp = W + (size_t)(k0 + (lane >> 5)) * ldw + n0 + (lane & 31);
#pragma unroll
    for (int i = 0; i < 32; ++i) v[i] = __builtin_nontemporal_load(wp + (size_t)(2 * i) * ldw);
    if (gain) {
#pragma unroll
        for (int i = 0; i < 32; ++i) v[i] *= gain[k0 + 2 * i + (lane >> 5)];
    }
#pragma unroll
    for (int i = 0; i < 32; ++i) scr[(2 * i + (lane >> 5)) * 33 + (lane & 31)] = v[i];
    LDS_WAIT(); asm volatile("" ::: "memory");
    const int c = lane & 7;
#pragma unroll
    for (int j = 0; j < 4; ++j) { const int n = (lane >> 3) + 8 * j; const LAS float* s = scr + (8 * c) * 33 + n;
        v4u o; o.x = pk2(s[0 * 33], s[1 * 33]); o.y = pk2(s[2 * 33], s[3 * 33]); o.z = pk2(s[4 * 33], s[5 * 33]); o.w = pk2(s[6 * 33], s[7 * 33]);
        *(GAS v4u*)(WT + (size_t)(vrow0 + n) * K + k0 + 8 * c) = o; }
    LDS_WAIT(); asm volatile("" ::: "memory");
}
__device__ __forceinline__ int vrow_in(int c) { const int pn = c >> 8, cr = c & 255, wc = cr >> 6, bj = (cr >> 5) & 1; return pn * 256 + bj * 128 + wc * 32; }
__device__ __forceinline__ int vrow_up(int c) { const int gs = c >= FF ? 1 : 0, cc = c - gs * FF, pn = cc >> 7, wc = (cc >> 5) & 3; return pn * 256 + gs * 128 + wc * 32; }

__global__ void __launch_bounds__(NWAVES * 64, 2) skel_fwd(Args args) {
    extern __shared__ __attribute__((aligned(16))) unsigned char lds_raw[];
    LAS unsigned char* lds = (LAS unsigned char*)lds_raw;
    volatile LAS unsigned* MISC = (volatile LAS unsigned*)(lds + MISC_OFF);
    const int G = gridDim.x; int vcu; { const int bx = blockIdx.x; vcu = (G % 8 == 0) ? (bx % 8) * (G / 8) + bx / 8 : bx; }
    unsigned char* ws = args.ws;
    gu32* ctl = (gu32*)(ws + WS_CTL);
    float* ss = (float*)(ws + WS_SS); bf16* xb = (bf16*)(ws + WS_XB); bf16* zg = (bf16*)(ws + WS_ZG); bf16* abuf = (bf16*)(ws + WS_A); float* yb = (float*)(ws + WS_YB);
    bf16* mix = (bf16*)(ws + WS_MIX); bf16* wbase = (bf16*)(ws + WS_W); float* xf = args.out;
    float* lutg = (float*)(ws + WS_LUT);
    for (int u = threadIdx.x; u < (LDS_BYTES - LDSCTL_OFF) / 4; u += NWAVES * 64) ((LAS unsigned*)(lds + LDSCTL_OFF))[u] = 0u;
    __syncthreads();
    XcdBarrier bar = xcd_barrier_post((unsigned*)(ctl + CW_BAR) + args.li * XCD_BAR_WORDS, MISC + 8);

#pragma unroll 1
    for (int ph = args.ph_lo; ph < args.ph_hi; ++ph) {
        const int l = ph > 0 ? (ph - 1) / 6 : 0, p = ph > 0 ? (ph - 1) % 6 + 1 : 0;
        bf16* wl = wbase + (size_t)l * WL_END;
        float* ss1 = ss + (size_t)((2 * l) & 3) * T * 16; float* ss2 = ss + (size_t)((2 * l + 1) & 3) * T * 16; float* ss3 = (l + 1 < L) ? ss + (size_t)((2 * l + 2) & 3) * T * 16 : nullptr;
#ifndef MK_ONLY
#define MK_ONLY 0x7f
#endif
        const int dupp = ((args.pad >> 8) & 0xff) - 1;
#pragma unroll 1
        for (int rep = (p == dupp) ? 0 : 1; rep < 2; ++rep) {
        if (p == 0 && (MK_ONLY & 1)) {
            int tid0 = threadIdx.x; asm volatile("" : "+v"(tid0));
            const int lane0 = tid0 & 63, wave = __builtin_amdgcn_readfirstlane(tid0 >> 6);
            LAS float* scr = (LAS float*)(lds + RING_OFF + wave * 16384);
            const int gw = vcu * NWAVES + wave, NGW = G * NWAVES;
            constexpr int I_IN = (D / 64) * (INW / 32), I_G = (D / 64) * (GW / 32), I_A = (512 / 64) * (D / 32), I_O = (D / 64) * (D / 32), I_UP = (D / 64) * (FF2 / 32), I_DN = (FF / 64) * (D / 32);
            constexpr int I_LAYER = I_IN + I_G + 2 * I_A + I_O + I_UP + I_DN;
            for (int i = gw * 64 + lane0; i < 12 * att::LUT_STRIDE; i += NGW * 64) { const int hh = i / att::LUT_STRIDE, j = i - hh * att::LUT_STRIDE, rel = j - 256, ar = rel < 0 ? -rel : rel;
                float v = 0.f; if (j <= 512) v = (hh < 8 && ar > 128) ? att::NEG : args.in[13][t5_bucket(rel) * 12 + hh] * LOG2E;
                lutg[i] = v; }
            for (int it = gw; it < L * I_LAYER; it += NGW) {
                const int ll = it / I_LAYER; int r = it - ll * I_LAYER; bf16* w = wbase + (size_t)ll * WL_END;
                if (r < I_IN) { const int nb = r % (INW / 32), kb = r / (INW / 32); p0_transpose_item(args.in[2] + (size_t)ll * D * INW, INW, D, 64 * kb, 32 * nb, w + WL_IN, vrow_in(32 * nb), args.in[1] + ll * D, scr, lane0); continue; } r -= I_IN;
                if (r < I_G) { const int nb = r % (GW / 32), kb = r / (GW / 32); p0_transpose_item(args.in[14] + (size_t)ll * D * GW, GW, D, 64 * kb, 32 * nb, w + WL_IN, vrow_in(INW + 32 * nb), args.in[1] + ll * D, scr, lane0); continue; } r -= I_G;
                if (r < I_A) { const int nb = r % (D / 32), kb = r / (D / 32); p0_transpose_item(args.in[16] + (size_t)ll * 512 * D, D, 512, 64 * kb, 32 * nb, w + WL_A, 32 * nb, nullptr, scr, lane0); continue; } r -= I_A;
                if (r < I_A) { const int nb = r % (D / 32), kb = r / (D / 32); p0_transpose_item(args.in[17] + (size_t)ll * 512 * D, D, 512, 64 * kb, 32 * nb, w + WL_B, 32 * nb, nullptr, scr, lane0); continue; } r -= I_A;
                if (r < I_O) { const int nb = r % (D / 32), kb = r / (D / 32); p0_transpose_item(args.in[18] + (size_t)ll * D * D, D, D, 64 * kb, 32 * nb, w + WL_O, 32 * nb, nullptr, scr, lane0); continue; } r -= I_O;
                if (r < I_UP) { const int nb = r % (FF2 / 32), kb = r / (FF2 / 32); p0_transpose_item(args.in[20] + (size_t)ll * D * FF2, FF2, D, 64 * kb, 32 * nb, w + WL_UP, vrow_up(32 * nb), args.in[19] + ll * D, scr, lane0); continue; } r -= I_UP;
                { const int nb = r % (D / 32), kb = r / (D / 32); p0_transpose_item(args.in[23] + (size_t)ll * FF * D, D, FF, 64 * kb, 32 * nb, w + WL_DN, 32 * nb, nullptr, scr, lane0); }
            }
            for (int m = gw; m < T; m += 2 * NGW) {
                const int m2 = m + NGW;
                const GAS f32x4* xr = (const GAS f32x4*)(args.in[0] + (size_t)m * D) + lane0; const GAS f32x4* xr2 = (const GAS f32x4*)(args.in[0] + (size_t)m2 * D) + lane0;
                GAS unsigned long long* o8 = (GAS unsigned long long*)(xb + (size_t)m * D) + lane0; GAS unsigned long long* o82 = (GAS unsigned long long*)(xb + (size_t)m2 * D) + lane0;
                f32x4 va[4], vb[4];
#pragma unroll
                for (int j = 0; j < 4; ++j) { va[j] = xr[64 * j]; vb[j] = xr2[64 * j]; }
                float s = 0.f, s2 = 0.f;
#pragma unroll
                for (int j = 0; j < 4; ++j) { const f32x4 v = va[j], w = vb[j]; s += (v.x * v.x + v.y * v.y) + (v.z * v.z + v.w * v.w); s2 += (w.x * w.x + w.y * w.y) + (w.z * w.z + w.w * w.w);
                    o8[64 * j] = (unsigned long long)pk2(v.x, v.y) | ((unsigned long long)pk2(v.z, v.w) << 32); o82[64 * j] = (unsigned long long)pk2(w.x, w.y) | ((unsigned long long)pk2(w.z, w.w) << 32); }
                s = wave_sum(s); s2 = wave_sum(s2);
                ss16_store(ss, m, s, lane0); ss16_store(ss, m2, s2, lane0);
            }
        } else if (p == 1 && (MK_ONLY & 2)) {
            pg8::SchedStd S; S.init(xb, D, wl + WL_IN, D, T, ZG - 256, G, (int)blockIdx.x);
            S.fix = (rep == 0 && MK_VAR == 8) ? 1 : 0;
            pg8::EpiIn E{zg, ss1, args.in[3] + l * 64, args.in[4] + l * 64, args.in[6] + l * 64, args.in[7] + l * 64, args.in[15] + l * GW, (args.pad >> 25) & 1};
            pg8::gemm_phase<pg8::EpiIn, pg8::SchedStd, true, true>(lds + RING_OFF, D, D, S, E);
        } else if (p == 2 && (MK_ONLY & 4)) {
            int lop = l; asm volatile("" : "+s"(lop));
            const float lam_init = 0.8f - 0.6f * __expf(-0.3f * (float)lop);
            int ln = threadIdx.x; asm volatile("" : "+v"(ln)); ln &= 63;
            const float d1 = wave_sum(args.in[8][l * 64 + ln] * args.in[9][l * 64 + ln]), d2 = wave_sum(args.in[10][l * 64 + ln] * args.in[11][l * 64 + ln]);
            const float lam = __expf(d1) - __expf(d2) + lam_init;
            if ((vcu & 3) == 0 && rep == 1) {
                pg8::SchedStd S1; S1.init(xb, D, wl + WL_IN, D, T, ZG, G, (int)blockIdx.x); S1.one = 1; S1.opm = 8 * (vcu >> 5) + ((vcu & 31) >> 2); S1.opn = 16;
                pg8::EpiIn E1{zg, ss1, args.in[3] + l * 64, args.in[4] + l * 64, args.in[6] + l * 64, args.in[7] + l * 64, args.in[15] + l * GW, 0};
                pg8::gemm_phase<pg8::EpiIn, pg8::SchedStd, true, true>(lds + RING_OFF, D, D, S1, E1);
            }
            att::attn_tables(lds, lutg, args.in[12] + l * 128, 1.0f - lam_init);
            const int dsel = args.pad >> 16;
            if (rep == 1 || dsel != 2)
            for (int ui = vcu; ui < 512; ui += G) { const int bh = ui >> 4, qb = ui & 15; if (rep == 0 && MK_VAR == 7 && (vcu & 1)) {} else if (rep == 0) att::attn_unit<true, (MK_VAR == 7 ? 0 : MK_VAR)>(lds, zg, lutg, bh >> 2, bh & 3, qb * 128, nullptr, lam, 1.0f - lam_init, args.in[12] + l * 128, mix);
                else att::attn_unit<true, 0>(lds, zg, lutg, bh >> 2, bh & 3, qb * 128, nullptr, lam, 1.0f - lam_init, args.in[12] + l * 128, nullptr); }
            if (rep == 1 || dsel != 1) {
                unsigned* qctr = (unsigned*)(ctl + CW_Q + 64 * (2 * l + rep));
                for (;;) {
                    if (threadIdx.x == 0) MISC[4] = __hip_atomic_fetch_add(qctr, 1u, __ATOMIC_RELAXED, __HIP_MEMORY_SCOPE_AGENT);
                    __syncthreads();
                    const int ui = (int)MISC[4];
                    __syncthreads();
                    if (ui >= 512) break;
                    const int bk = ui >> 5, qb = ui & 31; att::attn_unit<false>(lds, zg, lutg, bk >> 1, bk & 1, qb * 64, args.in[5] + l * HA, 0.f, 0.f, nullptr, rep == 0 ? mix : nullptr);
                }
            }
        } else if (p == 3 && (MK_ONLY & 8)) {
            pg8::SchedMix S; S.b.init(zg + C_QA, ZG, wl + WL_A, 512, T, D, G, (int)blockIdx.x); S.A1 = (const char*)(zg + C_QB); S.Bt1 = (const char*)(wl + WL_B);
            pg8::EpiMix E{zg, mix};
            pg8::gemm_phase<pg8::EpiMix, pg8::SchedMix, true, true>(lds + RING_OFF, 512, ZG, S, E);
        } else if (p == 4 && (MK_ONLY & 16)) {
            pg8::SchedStd S; S.init(mix, D, wl + WL_O, D, T, D, G, (int)blockIdx.x);
            pg8::EpiRes E{l == 0 ? args.in[0] : xf, xf, xb, ss2};
            pg8::gemm_phase<pg8::EpiRes, pg8::SchedStd, true, true>(lds + RING_OFF, D, D, S, E);
        } else if (p == 5 && (MK_ONLY & 32)) {
            pg8::SchedStd S; S.init(xb, D, wl + WL_UP, D, T, FF2, G, (int)blockIdx.x);
            pg8::EpiUp E{abuf, ss2, args.in[21] + (size_t)l * 3 * FF2, args.in[22] + (size_t)l * FF2, yb, (args.pad >> 24) & 1};
            pg8::gemm_phase<pg8::EpiUp, pg8::SchedStd, true, true>(lds + RING_OFF, D, D, S, E);
        } else if (MK_ONLY & 64) {
            pg8::SchedDown S; S.b.init(abuf, FF, wl + WL_DN, FF, T, D, G, (int)blockIdx.x); S.yb = (args.pad & 1) ? nullptr : yb; S.cw = args.in[21] + (size_t)l * 3 * FF2; S.cb = args.in[22] + (size_t)l * FF2; S.a = abuf;
            pg8::EpiRes E{xf, xf, ss3 ? xb : nullptr, ss3};
            pg8::gemm_phase<pg8::EpiRes, pg8::SchedDown, true, true>(lds + RING_OFF, FF, FF, S, E);
        }
        }
        if (ph + 1 < args.ph_hi) xcd_barrier(bar);
    }
}
}

#ifndef MK_MODE
#define MK_MODE 0x7f
#endif
extern "C" void kernel_launch(void* const* d_in, const int* in_sizes, int n_in, void* d_out, int out_size, void* d_ws, size_t ws_size, hipStream_t stream) {
    using namespace nv;
    static int grid = 0;
    if (grid == 0) {
        if (n_in != 24 || out_size != T * D || ws_size < mk::WS_END) { fprintf(stderr, "kernel_launch: unexpected shapes (n_in %d, out %d, ws %zu)\n", n_in, out_size, ws_size); grid = -1; return; }
        int dev = 0, cus = 0, per_cu = 0;
        if (hipGetDevice(&dev) != hipSuccess || hipDeviceGetAttribute(&cus, hipDeviceAttributeMultiprocessorCount, dev) != hipSuccess) { grid = -1; return; }
        if (hipFuncSetAttribute((const void*)mk::skel_fwd, hipFuncAttributeMaxDynamicSharedMemorySize, mk::LDS_BYTES) != hipSuccess) { fprintf(stderr, "kernel_launch: hipFuncSetAttribute failed\n"); grid = -1; return; }
        if (hipOccupancyMaxActiveBlocksPerMultiprocessor(&per_cu, (const void*)mk::skel_fwd, mk::NWAVES * 64, mk::LDS_BYTES) != hipSuccess || per_cu < 1) fprintf(stderr, "kernel_launch: occupancy query says %d\n", per_cu);
        (void)hipGetLastError();
        grid = cus;
    }
    if (grid < 0) return;
    const float* in[24]; for (int i = 0; i < 24; ++i) in[i] = (const float*)d_in[i];
    unsigned char* ws = (unsigned char*)d_ws;
    float* xf = (float*)d_out; float* ss = (float*)(ws + mk::WS_SS); bf16* xb = (bf16*)(ws + mk::WS_XB); bf16* zg = (bf16*)(ws + mk::WS_ZG); bf16* abuf = (bf16*)(ws + mk::WS_A);
    bf16* mix = (bf16*)(ws + mk::WS_MIX); float* tmpA = (float*)(ws + mk::WS_TMPA); float* tmpB = (float*)(ws + mk::WS_TMPB);
    if (hipMemsetAsync(ws + mk::WS_CTL, 0, mk::CTL_ZERO_BYTES, stream) != hipSuccess) { fprintf(stderr, "kernel_launch: memset failed\n"); return; }
    mk::Args a{}; for (int i = 0; i < 24; ++i) a.in[i] = in[i]; a.out = xf; a.ws = ws;
    int li = 0;
#define MK_RUN(lo, hi) do { a.ph_lo = (lo); a.ph_hi = (hi); a.li = li++; hipLaunchKernelGGL(mk::skel_fwd, dim3(grid), dim3(mk::NWAVES * 64), mk::LDS_BYTES, stream, a); } while (0)
#ifndef MK_DUP
#define MK_DUP 0
#endif
#define MK_DSEL 0
    if (MK_MODE == 0x7f) { a.pad = (MK_DUP << 8) | (MK_DSEL << 16) | (MK_EDUP << 24); MK_RUN(0, mk::N_PHASES); return; }
    MK_RUN(0, 1);
    for (int l = 0; l < L; ++l) {
        const float lam_init = 0.8f - 0.6f * expf(-0.3f * (float)l);
        float* ss1 = ss + (size_t)((2 * l) & 3) * T * 16; float* ss2 = ss + (size_t)((2 * l + 1) & 3) * T * 16; float* ss3 = (l + 1 < L) ? ss + (size_t)((2 * l + 2) & 3) * T * 16 : nullptr;
        const int pb = 1 + 6 * l;
        if (MK_MODE & 2) MK_RUN(pb, pb + 1);
        else for (int b = 0; b < B; ++b) { const int row0 = b * S;
            n_gemm<bf16><<<dim3(INW / 64, S / 64), 256, 0, stream>>>(xb + (size_t)row0 * D, D, in[1] + l * D, in[2] + (size_t)l * D * INW, INW, tmpA, INW, D);
            n_post_in<<<S, 256, 0, stream>>>(tmpA, ss1, in[3] + l * 64, in[4] + l * 64, in[6] + l * 64, in[7] + l * 64, zg, row0);
            n_gemm<bf16><<<dim3(GW / 64, S / 64), 256, 0, stream>>>(xb + (size_t)row0 * D, D, in[1] + l * D, in[14] + (size_t)l * D * GW, GW, tmpA, GW, D);
            n_post_gate<<<S, 256, 0, stream>>>(tmpA, ss1, in[15] + l * GW, zg, row0); }
        if (MK_MODE & 4) MK_RUN(pb + 1, pb + 2);
        else { n_attn_a<<<dim3(T, HA), 64, 0, stream>>>(zg, in[5] + l * HA, in[13]);
               n_attn_b<<<dim3(T, HB), 256, 0, stream>>>(zg, in[13], in[8] + l * 64, in[9] + l * 64, in[10] + l * 64, in[11] + l * 64, in[12] + l * 128, lam_init); }
        if (MK_MODE & 8) MK_RUN(pb + 2, pb + 3);
        else for (int b = 0; b < B; ++b) { const int row0 = b * S;
            n_gemm<bf16><<<dim3(D / 64, S / 64), 256, 0, stream>>>(zg + (size_t)row0 * ZG + C_QA, ZG, nullptr, in[16] + (size_t)l * 512 * D, D, tmpA, D, 512);
            n_gemm<bf16><<<dim3(D / 64, S / 64), 256, 0, stream>>>(zg + (size_t)row0 * ZG + C_QB, ZG, nullptr, in[17] + (size_t)l * 512 * D, D, tmpB, D, 512);
            n_post_mix<<<S, 256, 0, stream>>>(tmpA, tmpB, zg, mix, row0); }
        if (MK_MODE & 16) MK_RUN(pb + 3, pb + 4);
        else for (int b = 0; b < B; ++b) { const int row0 = b * S;
            n_gemm<bf16><<<dim3(D / 64, S / 64), 256, 0, stream>>>(mix + (size_t)row0 * D, D, nullptr, in[18] + (size_t)l * D * D, D, tmpA, D, D);
            n_post_res<<<S, 256, 0, stream>>>(tmpA, xf, xb, ss2, row0); }
        if ((MK_MODE & 32) && (MK_MODE & 64)) { MK_RUN(pb + 4, pb + 6); }
        else {
            for (int b = 0; b < B; ++b) { const int row0 = b * S;
                for (int hf = 0; hf < 2; ++hf) { const int j0 = hf * HW;
                    n_gemm<bf16><<<dim3(HW / 64, S / 64), 256, 0, stream>>>(xb + (size_t)row0 * D, D, in[19] + l * D, in[20] + (size_t)l * D * FF2 + j0, FF2, tmpA, 2 * HW, D);
                    n_gemm<bf16><<<dim3(HW / 64, S / 64), 256, 0, stream>>>(xb + (size_t)row0 * D, D, in[19] + l * D, in[20] + (size_t)l * D * FF2 + FF + j0, FF2, tmpA + HW, 2 * HW, D);
                    n_post_conv<<<S, 256, 0, stream>>>(tmpA, ss2, in[21] + (size_t)l * 3 * FF2, in[22] + (size_t)l * FF2, abuf, row0, j0); } }
            if (MK_MODE & 64) { a.pad = 1; MK_RUN(pb + 5, pb + 6); a.pad = 0; }
            else for (int b = 0; b < B; ++b) { const int row0 = b * S;
                n_gemm<bf16><<<dim3(D / 64, S / 64), 256, 0, stream>>>(abuf + (size_t)row0 * FF, FF, nullptr, in[23] + (size_t)l * FF * D, D, tmpA, D, FF);
                n_post_res<<<S, 256, 0, stream>>>(tmpA, xf, xb, ss3, row0); }
        }
    }
}
```

```cpp
#include <hip/hip_runtime.h>
#include <cstdio>
#include <cstdint>
#include <cmath>
#define MK_EDUP 0

namespace nv {
typedef unsigned short bf16;
constexpr int D = 1024, B = 8, S = 2048, T = B * S, L = 4;
constexpr int HA = 8, KVA = 2, HB = 4, HD = 64;
constexpr int INW = 2304, GW = 2048, ZG = INW + GW;
constexpr int FF = 2816, FF2 = 2 * FF;
constexpr int C_QA = 0, C_KA = 512, C_VA = 640, C_QB = 768, C_KB = 1280, C_VB = 1792, C_G = 2304;
constexpr float EPS = 1e-6f;
constexpr float LOG2E = 1.4426950408889634f;
constexpr float C2 = 0.125f * LOG2E;

__device__ __forceinline__ float bf2f(bf16 v) { return __uint_as_float(((unsigned)v) << 16); }
__device__ __forceinline__ bf16 f2bf(float f) { unsigned u = __float_as_uint(f); return (bf16)((u + 0x7fffu + ((u >> 16) & 1u)) >> 16); }
__device__ __forceinline__ float ldf(const float* p) { return *p; }
__device__ __forceinline__ float ldf(const bf16* p) { return bf2f(*p); }

__device__ __forceinline__ int t5_bucket(int rel) {
    const int n = rel < 0 ? -rel : rel; int v;
    if (n < 8) v = n; else if (n < 12) v = 8; else if (n < 16) v = 9; else if (n < 23) v = 10; else if (n < 32) v = 11;
    else if (n < 46) v = 12; else if (n < 64) v = 13; else if (n < 91) v = 14; else v = 15;
    return (rel > 0 ? 16 : 0) + v;
}
__device__ __forceinline__ float ss16(const float* ss, int t) { const float4* p = (const float4*)(ss + (size_t)t * 16); const float4 a = p[0], b = p[1], c = p[2], d = p[3];
    return ((a.x + a.y) + (a.z + a.w)) + ((b.x + b.y) + (b.z + b.w)) + ((c.x + c.y) + (c.z + c.w)) + ((d.x + d.y) + (d.z + d.w)); }
__device__ __forceinline__ float ss16_q(const float* ss, int t, int fq) { const float4 a = *(const float4*)(ss + (size_t)t * 16 + 4 * fq); float s = (a.x + a.y) + (a.z + a.w); s += __shfl_xor(s, 16); s += __shfl_xor(s, 32); return s; }
__device__ __forceinline__ void ss16_store(float* ss, int t, float s, int lane) { if (lane < 16) ss[(size_t)t * 16 + lane] = lane == 0 ? s : 0.f; }
__device__ __forceinline__ float wave_sum(float v) {
#pragma unroll
    for (int o = 1; o < 64; o <<= 1) v += __shfl_xor(v, o);
    return v;
}
__device__ __forceinline__ float wave_max(float v) {
#pragma unroll
    for (int o = 1; o < 64; o <<= 1) v = fmaxf(v, __shfl_xor(v, o));
    return v;
}

template <typename TA>
__global__ void __launch_bounds__(256) n_gemm(const TA* __restrict__ A, int lda, const float* __restrict__ gk, const float* __restrict__ W, int ldw, float* __restrict__ C, int ldc, int K) {
    __shared__ float As[16][68];
    __shared__ float Ws[16][64];
    const int tid = threadIdx.x, tx = tid & 15, ty = tid >> 4;
    const int m0 = blockIdx.y * 64, n0 = blockIdx.x * 64;
    float acc[4][4];
#pragma unroll
    for (int i = 0; i < 4; ++i)
#pragma unroll
        for (int j = 0; j < 4; ++j) acc[i][j] = 0.f;
    for (int k0 = 0; k0 < K; k0 += 16) {
#pragma unroll
        for (int i = 0; i < 4; ++i) { const int e = tid + i * 256, r = e >> 4, c = e & 15; float v = ldf(A + (size_t)(m0 + r) * lda + k0 + c); if (gk) v *= gk[k0 + c]; As[c][r] = v; }
#pragma unroll
        for (int i = 0; i < 4; ++i) { const int e = tid + i * 256, r = e >> 6, c = e & 63; Ws[r][c] = W[(size_t)(k0 + r) * ldw + n0 + c]; }
        __syncthreads();
#pragma unroll
        for (int kk = 0; kk < 16; ++kk) {
            float a[4], b[4];
#pragma unroll
            for (int i = 0; i < 4; ++i) { a[i] = As[kk][ty * 4 + i]; b[i] = Ws[kk][tx * 4 + i]; }
#pragma unroll
            for (int i = 0; i < 4; ++i)
#pragma unroll
                for (int j = 0; j < 4; ++j) acc[i][j] += a[i] * b[j];
        }
        __syncthreads();
    }
#pragma unroll
    for (int i = 0; i < 4; ++i)
#pragma unroll
        for (int j = 0; j < 4; ++j) C[(size_t)(m0 + ty * 4 + i) * ldc + n0 + tx * 4 + j] = acc[i][j];
}

__global__ void __launch_bounds__(256) n_init_x(const float* __restrict__ x, float* __restrict__ xf, bf16* __restrict__ xb, float* __restrict__ ss) {
    const int row = blockIdx.x * 4 + (threadIdx.x >> 6), lane = threadIdx.x & 63;
    float s = 0.f;
    for (int c = lane; c < D; c += 64) { const float v = x[(size_t)row * D + c]; xf[(size_t)row * D + c] = v; xb[(size_t)row * D + c] = f2bf(v); s += v * v; }
    s = wave_sum(s);
    ss16_store(ss, row, s, lane);
}

__global__ void __launch_bounds__(256) n_post_in(const float* __restrict__ Z, const float* __restrict__ ss, const float* __restrict__ qn_a, const float* __restrict__ kn_a,
                                                 const float* __restrict__ qn_b, const float* __restrict__ kn_b, bf16* __restrict__ zg, int row0) {
    const int r = blockIdx.x, t = row0 + r, wave = threadIdx.x >> 6, lane = threadIdx.x & 63;
    const float rs = rsqrtf(ss16(ss, t) * (1.0f / D) + EPS);
    for (int g = wave; g < INW / 64; g += 4) {
        float v = Z[(size_t)r * INW + g * 64 + lane] * rs;
        const float* gain = nullptr; float sc = 1.f;
        if (g < 8) { gain = qn_a; sc = C2; } else if (g < 10) { gain = kn_a; } else if (g < 12) { } else if (g < 20) { gain = qn_b; sc = C2; } else if (g < 28) { gain = kn_b; }
        if (gain) { const float q = wave_sum(v * v); v = v * rsqrtf(q * (1.0f / 64.0f) + EPS) * gain[lane] * sc; }
        zg[(size_t)t * ZG + g * 64 + lane] = f2bf(v);
    }
}
__global__ void __launch_bounds__(256) n_post_gate(const float* __restrict__ G, const float* __restrict__ ss, const float* __restrict__ bg, bf16* __restrict__ zg, int row0) {
    const int r = blockIdx.x, t = row0 + r;
    const float rs = rsqrtf(ss16(ss, t) * (1.0f / D) + EPS);
    for (int c = threadIdx.x; c < GW; c += 256) { const float v = G[(size_t)r * GW + c] * rs + bg[c]; zg[(size_t)t * ZG + C_G + c] = f2bf(1.0f / (1.0f + __expf(-v))); }
}

__global__ void __launch_bounds__(64) n_attn_a(bf16* __restrict__ zg, const float* __restrict__ sink, const float* __restrict__ rel_bias) {
    __shared__ float qs[64]; __shared__ float ps[5 * 64];
    const int t = blockIdx.x, h = blockIdx.y, lane = threadIdx.x, b = t / S, s = t % S, kv = h >> 2;
    qs[lane] = bf2f(zg[(size_t)t * ZG + C_QA + h * 64 + lane]);
    __syncthreads();
    const int j0 = s - 128;
    float sc[5]; float m = sink[h] * LOG2E;
#pragma unroll
    for (int i = 0; i < 5; ++i) {
        const int jj = i * 64 + lane, j = j0 + jj; float v = -1e30f;
        if (jj <= 256 && j >= 0 && j < S) {
            const bf16* kp = zg + (size_t)(b * S + j) * ZG + C_KA + kv * 64; float d = 0.f;
            for (int e = 0; e < 64; ++e) d += qs[e] * bf2f(kp[e]);
            v = d + rel_bias[t5_bucket(j - s) * 12 + h] * LOG2E;
        }
        sc[i] = v; m = fmaxf(m, v);
    }
    m = wave_max(m);
    float l = 0.f;
#pragma unroll
    for (int i = 0; i < 5; ++i) { const float p = (sc[i] > -1e29f) ? exp2f(sc[i] - m) : 0.f; ps[i * 64 + lane] = p; l += p; }
    l = wave_sum(l) + exp2f(sink[h] * LOG2E - m);
    __syncthreads();
    float o = 0.f;
    for (int jj = 0; jj <= 256; ++jj) { const int j = j0 + jj; if (j >= 0 && j < S) o += ps[jj] * bf2f(zg[(size_t)(b * S + j) * ZG + C_VA + kv * 64 + lane]); }
    zg[(size_t)t * ZG + C_QA + h * 64 + lane] = f2bf(o / l);
}

__global__ void __launch_bounds__(256) n_attn_b(bf16* __restrict__ zg, const float* __restrict__ rel_bias, const float* __restrict__ lq1, const float* __restrict__ lk1,
                                               const float* __restrict__ lq2, const float* __restrict__ lk2, const float* __restrict__ subg, float lam_init) {
    __shared__ float qs[128]; __shared__ float av[S]; __shared__ float s1s[S]; __shared__ float red[8]; __shared__ float osum[256];
    const int t = blockIdx.x, h = blockIdx.y, tid = threadIdx.x, lane = tid & 63, wave = tid >> 6, b = t / S, s = t % S;
    if (tid < 128) qs[tid] = bf2f(zg[(size_t)t * ZG + C_QB + h * 128 + tid]);
    float d1 = wave_sum(lq1[lane] * lk1[lane]), d2 = wave_sum(lq2[lane] * lk2[lane]);
    const float lam = __expf(d1) - __expf(d2) + lam_init;
    __syncthreads();
    float m0 = -1e30f, m1 = -1e30f;
#pragma unroll 1
    for (int i = 0; i < 8; ++i) {
        const int j = i * 256 + tid; const bf16* kp = zg + (size_t)(b * S + j) * ZG + C_KB + h * 128; float a0 = 0.f, a1 = 0.f;
#pragma unroll 8
        for (int e = 0; e < 64; ++e) { a0 += qs[e] * bf2f(kp[e]); a1 += qs[64 + e] * bf2f(kp[64 + e]); }
        const float bi = rel_bias[t5_bucket(j - s) * 12 + 8 + h] * LOG2E;
        a0 += bi; a1 += bi; av[j] = a0; s1s[j] = a1; m0 = fmaxf(m0, a0); m1 = fmaxf(m1, a1);
    }
    m0 = wave_max(m0); m1 = wave_max(m1);
    if (lane == 0) { red[wave] = m0; red[4 + wave] = m1; }
    __syncthreads();
    m0 = fmaxf(fmaxf(red[0], red[1]), fmaxf(red[2], red[3])); m1 = fmaxf(fmaxf(red[4], red[5]), fmaxf(red[6], red[7]));
    __syncthreads();
    float l0 = 0.f, l1 = 0.f;
#pragma unroll 1
    for (int i = 0; i < 8; ++i) { const int j = i * 256 + tid; const float p0 = exp2f(av[j] - m0), p1 = exp2f(s1s[j] - m1); av[j] = p0; s1s[j] = p1; l0 += p0; l1 += p1; }
    l0 = wave_sum(l0); l1 = wave_sum(l1);
    if (lane == 0) { red[wave] = l0; red[4 + wave] = l1; }
    __syncthreads();
    l0 = (red[0] + red[1]) + (red[2] + red[3]); l1 = (red[4] + red[5]) + (red[6] + red[7]);
#pragma unroll 1
    for (int i = 0; i < 8; ++i) { const int j = i * 256 + tid; av[j] = av[j] / l0 - lam * (s1s[j] / l1); }
    __syncthreads();
    const int e = tid & 127, half = tid >> 7; float o = 0.f;
    for (int j = half * 1024; j < half * 1024 + 1024; ++j) o += av[j] * bf2f(zg[(size_t)(b * S + j) * ZG + C_VB + h * 128 + e]);
    osum[tid] = o;
    __syncthreads();
    float ov = 0.f, q = 0.f;
    if (tid < 128) { ov = osum[tid] + osum[tid + 128]; q = ov * ov; }
    q = wave_sum(q);
    __syncthreads();
    if (lane == 0) red[wave] = q;
    __syncthreads();
    const float qq = red[0] + red[1];
    if (tid < 128) zg[(size_t)t * ZG + C_QB + h * 128 + tid] = f2bf(ov * rsqrtf(qq * (1.0f / 128.0f) + EPS) * subg[tid] * (1.0f - lam_init));
}

__global__ void __launch_bounds__(256) n_post_mix(const float* __restrict__ PA, const float* __restrict__ PB, const bf16* __restrict__ zg, bf16* __restrict__ mix, int row0) {
    const int r = blockIdx.x, t = row0 + r;
    for (int c = threadIdx.x; c < D; c += 256) {
        const float ga = bf2f(zg[(size_t)t * ZG + C_G + c]), gb = bf2f(zg[(size_t)t * ZG + C_G + D + c]);
        mix[(size_t)t * D + c] = f2bf(ga * PA[(size_t)r * D + c] + gb * PB[(size_t)r * D + c]);
    }
}
__global__ void __launch_bounds__(256) n_post_res(const float* __restrict__ tmp, float* __restrict__ xf, bf16* __restrict__ xb, float* __restrict__ ss_out, int row0) {
    __shared__ float red[4];
    const int r = blockIdx.x, t = row0 + r, lane = threadIdx.x & 63, wave = threadIdx.x >> 6; float s = 0.f;
    for (int c = threadIdx.x; c < D; c += 256) { const float v = xf[(size_t)t * D + c] + tmp[(size_t)r * D + c]; xf[(size_t)t * D + c] = v; xb[(size_t)t * D + c] = f2bf(v); s += v * v; }
    s = wave_sum(s); if (lane == 0) red[wave] = s;
    __syncthreads();
    if (ss_out) ss16_store(ss_out, t, (red[0] + red[1]) + (red[2] + red[3]), threadIdx.x);
}
constexpr int HW = FF / 2;
__global__ void __launch_bounds__(256) n_post_conv(const float* __restrict__ U, const float* __restrict__ ss, const float* __restrict__ cw, const float* __restrict__ cb, bf16* __restrict__ a, int row0, int j0) {
    const int r = blockIdx.x, t = row0 + r;
    const float rs1 = rsqrtf(ss16(ss, t) * (1.0f / D) + EPS);
    const float rs0 = r > 0 ? rsqrtf(ss16(ss, t - 1) * (1.0f / D) + EPS) : 0.f;
    const float rs2 = r < S - 1 ? rsqrtf(ss16(ss, t + 1) * (1.0f / D) + EPS) : 0.f;
    for (int j = threadIdx.x; j < HW; j += 256) {
        float u[2];
#pragma unroll
        for (int gsel = 0; gsel < 2; ++gsel) {
            const int col = gsel * FF + j0 + j, uc = gsel * HW + j;
            const float y1 = U[(size_t)r * (2 * HW) + uc] * rs1;
            const float y0 = r > 0 ? U[(size_t)(r - 1) * (2 * HW) + uc] * rs0 : 0.f;
            const float y2 = r < S - 1 ? U[(size_t)(r + 1) * (2 * HW) + uc] * rs2 : 0.f;
            u[gsel] = cb[col] + cw[col] * y0 + cw[FF2 + col] * y1 + cw[2 * FF2 + col] * y2;
        }
        const float sg = u[1] / (1.0f + __expf(-u[1]));
        a[(size_t)t * FF + j0 + j] = f2bf(sg * u[0]);
    }
}
__global__ void __launch_bounds__(256) n_rowss(const float* __restrict__ xf, float* __restrict__ ss_out) {
    const int row = blockIdx.x * 4 + (threadIdx.x >> 6), lane = threadIdx.x & 63; float s = 0.f;
    for (int c = lane; c < D; c += 64) { const float v = xf[(size_t)row * D + c]; s += v * v; }
    s = wave_sum(s); ss16_store(ss_out, row, s, lane);
}
}


namespace pg8 {
using namespace nv;
#define PG8_LAS __attribute__((address_space(3)))
typedef unsigned short bf16_t;
typedef short bf16x8 __attribute__((ext_vector_type(8)));
typedef float f32x4 __attribute__((ext_vector_type(4)));
typedef unsigned u32x4 __attribute__((ext_vector_type(4)));
typedef unsigned u32x2 __attribute__((ext_vector_type(2)));
constexpr int BM = 256, BK = 64, HALF = 128, HTB = HALF * BK * 2  , STAGE_BYTES = 8 * HTB, NXCD = 8, WGM = 8;
constexpr int XOFF = 131072 + 1024;

__host__ __device__ __forceinline__ int lds_byte(int r, int c) { const int st = (r >> 4) * 2 + (c >> 5), rr = r & 15, cc = c & 31, ob = rr * 64 + cc * 2; return st * 1024 + (ob ^ (((ob >> 9) & 1) << 5)); }
__host__ __device__ __forceinline__ void stage_rc(int b, int& R, int& C) { const int st = b / 1024, sb = b % 1024, swz = sb ^ (((sb >> 9) & 1) << 5); R = (st >> 1) * 16 + swz / 64; C = (st & 1) * 32 + (swz % 64) / 2; }
__host__ __device__ __forceinline__ int perm32(int rho) { const int n = rho >> 4, i = rho & 15; return 8 * (i >> 2) + 4 * n + (i & 3); }

struct Unit { int pm, pn, z; };
typedef float f32x2 __attribute__((ext_vector_type(2))); typedef __bf16 bf16x2_t __attribute__((ext_vector_type(2)));
__device__ __forceinline__ unsigned cvt_pk_bf16(float lo, float hi) { f32x2 v = {lo, hi}; bf16x2_t b = __builtin_convertvector(v, bf16x2_t); return __builtin_bit_cast(unsigned, b); }
__device__ __forceinline__ float bflo(unsigned w) { return __uint_as_float(w << 16); }
__device__ __forceinline__ float bfhi(unsigned w) { return __uint_as_float(w & 0xffff0000u); }

struct SchedStd {
    int nM, nN, nwg, G, c, fix, one, opm, opn; const char* A; const char* Bt; size_t at, bt;
    __device__ void init(const void* A_, int lda, const void* Bt_, int K, int M, int N, int G_, int c_) { fix = 0; one = 0; opm = 0; opn = 0; nM = M / BM; nN = N / BM; nwg = nM * nN; G = G_; c = c_; A = (const char*)A_; Bt = (const char*)Bt_; at = (size_t)BM * lda * 2; bt = (size_t)BM * K * 2; }
    __device__ bool next(int i, Unit& u) const {
        if (one) { if (i > 0) return false; u.pm = opm; u.pn = opn; u.z = 0; return true; }
        const long L = (long)i * G + c; if (L >= nwg) return false;
        int wgid = (int)L; { const int q = nwg / NXCD, r = nwg % NXCD, xcd = wgid % NXCD, off = wgid / NXCD; wgid = (xcd < r ? xcd * (q + 1) : r * (q + 1) + (xcd - r) * q) + off; }
        const int nig = WGM * nN, gid = wgid / nig, fm = gid * WGM, gsz = (nM - fm) < WGM ? (nM - fm) : WGM;
        u.pm = fm + ((wgid % nig) % gsz); u.pn = (wgid % nig) / gsz; u.z = 0; if (fix) { u.pm = 0; u.pn = 0; } return true;
    }
    __device__ __forceinline__ const char* aptr(const Unit& u) const { return A + (size_t)u.pm * at; }
    __device__ __forceinline__ const char* bptr(const Unit& u) const { return Bt + (size_t)u.pn * bt; }
    __device__ __forceinline__ void a_ready(const Unit&) const {}
    __device__ __forceinline__ void done(const Unit&) const {}
};
struct SchedMix {
    SchedStd b; const char* A1; const char* Bt1;
    __device__ bool next(int i, Unit& u) const { if (!b.next(i >> 1, u)) return false; u.z = i & 1; return true; }
    __device__ __forceinline__ const char* aptr(const Unit& u) const { return (u.z ? A1 : b.A) + (size_t)u.pm * b.at; }
    __device__ __forceinline__ const char* bptr(const Unit& u) const { return (u.z ? Bt1 : b.Bt) + (size_t)u.pn * b.bt; }
    __device__ __forceinline__ void a_ready(const Unit&) const {}
    __device__ __forceinline__ void done(const Unit&) const {}
};
struct SchedDown {
    SchedStd b; const float* yb; const float* cw; const float* cb; bf16_t* a;
    __device__ bool next(int i, Unit& u) const { return b.next(i, u); }
    __device__ __forceinline__ const char* aptr(const Unit& u) const { return b.aptr(u); }
    __device__ __forceinline__ const char* bptr(const Unit& u) const { return b.bptr(u); }
    __device__ __forceinline__ void a_ready(const Unit& u) const {
        const int pm = u.pm;
        if (yb)
        for (int idx = threadIdx.x; idx < 2 * FF; idx += 512) {
            const int which = idx >= FF ? 1 : 0, j = idx - which * FF;
            float uv[2];
#pragma unroll
            for (int gs = 0; gs < 2; ++gs) {
                const int col = gs * FF + j; float y0, y1, y2;
                if (which == 0) { y0 = (pm & 7) ? yb[((size_t)(pm - 1) * 4 + 3) * FF2 + col] : 0.f; y1 = yb[((size_t)pm * 4 + 0) * FF2 + col]; y2 = yb[((size_t)pm * 4 + 1) * FF2 + col]; }
                else { y0 = yb[((size_t)pm * 4 + 2) * FF2 + col]; y1 = yb[((size_t)pm * 4 + 3) * FF2 + col]; y2 = ((pm & 7) != 7) ? yb[((size_t)(pm + 1) * 4 + 0) * FF2 + col] : 0.f; }
                uv[gs] = cb[col] + cw[col] * y0 + cw[FF2 + col] * y1 + cw[2 * FF2 + col] * y2;
            }
            const float sg = uv[1] * __builtin_amdgcn_rcpf(1.0f + __builtin_amdgcn_exp2f(-uv[1] * LOG2E));
            a[(size_t)(pm * BM + which * 255) * FF + j] = f2bf(sg * uv[0]);
        }
        asm volatile("s_waitcnt vmcnt(0)" ::: "memory");
        __builtin_amdgcn_s_barrier();
        asm volatile("" ::: "memory");
    }
    __device__ __forceinline__ void done(const Unit&) const {}
};

struct EpiIn {
    static constexpr bool PERM = true, AFTER_DRAIN = false;
    __device__ static constexpr bool zero_after(const Unit&) { return true; }
    bf16_t* zg; const float* ss; const float *qn_a, *kn_a, *qn_b, *kn_b, *bg; int dup;
    __device__ __forceinline__ void operator()(f32x4 (&acc)[2][2][4][2], const Unit& u, int wr, int wc, int fr, int fq, PG8_LAS unsigned char*) const {
#pragma unroll
        for (int rep_ = 0; rep_ <= ((MK_EDUP & 2) ? 1 : 0); ++rep_) {
        if (rep_) {
#pragma unroll
            for (int ai = 0; ai < 2; ++ai)
#pragma unroll
                for (int bj = 0; bj < 2; ++bj)
#pragma unroll
                    for (int m = 0; m < 4; ++m)
#pragma unroll
                        for (int n = 0; n < 2; ++n) asm volatile("" : "+v"(acc[ai][bj][m][n]) :: "memory");
        }
        const int g = u.pn * 4 + wc, colb = u.pn * BM + wc * 64 + 8 * fq;
        const float* gain = nullptr; float sc = 1.f; int mode = 0;
        if (g < 8) { gain = qn_a; sc = C2; mode = 1; } else if (g < 10) { gain = kn_a; mode = 1; } else if (g < 12) { mode = 0; } else if (g < 20) { gain = qn_b; sc = C2; mode = 1; }
        else if (g < 28) { gain = kn_b; mode = 1; } else if (g < 36) { mode = 0; } else { mode = 2; }
        float rsv[2][4];
#pragma unroll
        for (int ai = 0; ai < 2; ++ai)
#pragma unroll
            for (int m = 0; m < 4; ++m) rsv[ai][m] = rsqrtf(ss16_q(ss, u.pm * BM + ai * HALF + wr * 64 + m * 16 + fr, fq) * (1.0f / D) + EPS);
        f32x4 gv[2][2];
#pragma unroll
        for (int bj = 0; bj < 2; ++bj)
#pragma unroll
            for (int n = 0; n < 2; ++n) {
                if (mode == 1) gv[bj][n] = *(const f32x4*)(gain + 32 * bj + 8 * fq + 4 * n) * sc;
                else if (mode == 2) gv[bj][n] = *(const f32x4*)(bg + (colb - C_G) + 32 * bj + 4 * n);
                else gv[bj][n] = (f32x4){1.f, 1.f, 1.f, 1.f};
            }
#pragma unroll
        for (int ai = 0; ai < 2; ++ai)
#pragma unroll
            for (int m = 0; m < 4; ++m) {
                const int row = u.pm * BM + ai * HALF + wr * 64 + m * 16 + fr;
                const float rs = rsv[ai][m];
                f32x4 v[2][2];
#pragma unroll
                for (int bj = 0; bj < 2; ++bj)
#pragma unroll
                    for (int n = 0; n < 2; ++n) v[bj][n] = acc[ai][bj][m][n] * rs;
                if (mode == 1) {
                    float q = 0.f;
#pragma unroll
                    for (int bj = 0; bj < 2; ++bj)
#pragma unroll
                        for (int n = 0; n < 2; ++n) { const f32x4 x = v[bj][n]; q += (x[0] * x[0] + x[1] * x[1]) + (x[2] * x[2] + x[3] * x[3]); }
                    q += __shfl_xor(q, 16); q += __shfl_xor(q, 32);
                    const float r2 = rsqrtf(q * (1.0f / 64.0f) + EPS);
#pragma unroll
                    for (int bj = 0; bj < 2; ++bj)
#pragma unroll
                        for (int n = 0; n < 2; ++n) v[bj][n] = v[bj][n] * r2 * gv[bj][n];
                } else if (mode == 2) {
#pragma unroll
                    for (int bj = 0; bj < 2; ++bj)
#pragma unroll
                        for (int n = 0; n < 2; ++n) { f32x4 x = v[bj][n] + gv[bj][n];
#pragma unroll
                            for (int e = 0; e < 4; ++e) x[e] = __builtin_fmaxf(__builtin_amdgcn_rcpf(1.0f + __builtin_amdgcn_exp2f(-x[e] * LOG2E)), 9.5367431640625e-07f);
                            v[bj][n] = x; }
                }
                bf16_t* rowp = zg + (size_t)row * ZG + colb;
#pragma unroll
                for (int bj = 0; bj < 2; ++bj) { u32x4 w; w.x = cvt_pk_bf16(v[bj][0][0], v[bj][0][1]); w.y = cvt_pk_bf16(v[bj][0][2], v[bj][0][3]); w.z = cvt_pk_bf16(v[bj][1][0], v[bj][1][1]); w.w = cvt_pk_bf16(v[bj][1][2], v[bj][1][3]);
                    *(u32x4*)(rowp + 32 * bj) = w; }
            }
        }
    }
};
struct EpiMix {
    static constexpr bool PERM = true, AFTER_DRAIN = false;
    __device__ static bool zero_after(const Unit& u) { return u.z != 0; }
    const bf16_t* zg; bf16_t* mix;
    __device__ __forceinline__ void operator()(f32x4 (&acc)[2][2][4][2], const Unit& u, int wr, int wc, int fr, int fq, PG8_LAS unsigned char*) const {
        const int col0 = u.pn * BM + wc * 32 + 8 * fq;
#pragma unroll
        for (int ai = 0; ai < 2; ++ai) {
            u32x4 gbv[4][2], gav[4][2];
#pragma unroll
            for (int m = 0; m < 4; ++m)
#pragma unroll
                for (int bj = 0; bj < 2; ++bj) { const size_t go = (size_t)(u.pm * BM + ai * HALF + wr * 64 + m * 16 + fr) * ZG + C_G + col0 + bj * HALF;
                    gbv[m][bj] = *(const u32x4*)(zg + go + D); if (u.z == 0) gav[m][bj] = *(const u32x4*)(zg + go); else gav[m][bj] = (u32x4){0u, 0u, 0u, 0u}; }
#pragma unroll
            for (int m = 0; m < 4; ++m) {
                const int row = u.pm * BM + ai * HALF + wr * 64 + m * 16 + fr;
#pragma unroll
                for (int bj = 0; bj < 2; ++bj) {
                    const int col = col0 + bj * HALF;
                    const u32x4 gb = gbv[m][bj];
                    if (u.z == 0) {
                        const u32x4 ga = gav[m][bj];
                        f32x4 r0, r1;
                        r0[0] = bflo(ga.x) * __builtin_amdgcn_rcpf(bflo(gb.x)); r0[1] = bfhi(ga.x) * __builtin_amdgcn_rcpf(bfhi(gb.x)); r0[2] = bflo(ga.y) * __builtin_amdgcn_rcpf(bflo(gb.y)); r0[3] = bfhi(ga.y) * __builtin_amdgcn_rcpf(bfhi(gb.y));
                        r1[0] = bflo(ga.z) * __builtin_amdgcn_rcpf(bflo(gb.z)); r1[1] = bfhi(ga.z) * __builtin_amdgcn_rcpf(bfhi(gb.z)); r1[2] = bflo(ga.w) * __builtin_amdgcn_rcpf(bflo(gb.w)); r1[3] = bfhi(ga.w) * __builtin_amdgcn_rcpf(bfhi(gb.w));
                        acc[ai][bj][m][0] *= r0; acc[ai][bj][m][1] *= r1;
                    } else {
                        const f32x4 v0 = acc[ai][bj][m][0] * (f32x4){bflo(gb.x), bfhi(gb.x), bflo(gb.y), bfhi(gb.y)}, v1 = acc[ai][bj][m][1] * (f32x4){bflo(gb.z), bfhi(gb.z), bflo(gb.w), bfhi(gb.w)};
                        u32x4 w; w.x = cvt_pk_bf16(v0[0], v0[1]); w.y = cvt_pk_bf16(v0[2], v0[3]); w.z = cvt_pk_bf16(v1[0], v1[1]); w.w = cvt_pk_bf16(v1[2], v1[3]);
                        *(u32x4*)(mix + (size_t)row * D + col) = w;
                    }
                }
            }
            asm volatile("" ::: "memory");
        }
    }
};
struct EpiRes {
    static constexpr bool PERM = false, AFTER_DRAIN = false;
    __device__ static constexpr bool zero_after(const Unit&) { return true; }
    const float* base; float* xf; bf16_t* xb; float* ssn;
    __device__ __forceinline__ void operator()(f32x4 (&acc)[2][2][4][2], const Unit& u, int wr, int wc, int fr, int fq, PG8_LAS unsigned char*) const {
        const int col0 = u.pn * BM + wc * 32 + 4 * fq;
#pragma unroll
        for (int ai = 0; ai < 2; ++ai)
#pragma unroll
            for (int m = 0; m < 4; ++m) {
                const int row = u.pm * BM + ai * HALF + wr * 64 + m * 16 + fr; const size_t off = (size_t)row * D + col0; float q = 0.f;
#pragma unroll
                for (int bj = 0; bj < 2; ++bj)
#pragma unroll
                    for (int n = 0; n < 2; ++n) { const f32x4 bs = *(const f32x4*)(base + off + bj * HALF + n * 16); const f32x4 o = bs + acc[ai][bj][m][n];
                        *(f32x4*)(xf + off + bj * HALF + n * 16) = o; q += (o[0] * o[0] + o[1] * o[1]) + (o[2] * o[2] + o[3] * o[3]);
                        if (xb) { u32x2 w; w.x = cvt_pk_bf16(o[0], o[1]); w.y = cvt_pk_bf16(o[2], o[3]); *(u32x2*)(xb + off + bj * HALF + n * 16) = w; } }
                if (ssn) { q += __shfl_xor(q, 16); q += __shfl_xor(q, 32); if (fq == 0) ssn[(size_t)row * 16 + u.pn * 4 + wc] = q; }
                if (m == 3) asm volatile("" ::: "memory");
            }
    }
};
#define DPPF(oldv, src, ctrl, bc) __int_as_float(__builtin_amdgcn_update_dpp(__float_as_int(oldv), __float_as_int(src), (ctrl), 0xF, 0xF, (bc)))
struct EpiUp {
    static constexpr bool PERM = true, AFTER_DRAIN = false;
    __device__ static constexpr bool zero_after(const Unit&) { return true; }
    bf16_t* a; const float* ss; const float* cw; const float* cb; float* yb; int dup;
    __device__ __forceinline__ void operator()(f32x4 (&acc)[2][2][4][2], const Unit& u, int wr, int wc, int fr, int fq, PG8_LAS unsigned char* lds) const {
        const int wid = wr * 4 + wc;
        PG8_LAS float* X = (PG8_LAS float*)(lds + XOFF);
        float rsv[2][4];
#pragma unroll
        for (int ai = 0; ai < 2; ++ai)
#pragma unroll
            for (int m = 0; m < 4; ++m) rsv[ai][m] = rsqrtf(ss16_q(ss, u.pm * BM + ai * HALF + wr * 64 + m * 16 + fr, fq) * (1.0f / D) + EPS);
#pragma unroll
        for (int ai = 0; ai < 2; ++ai)
#pragma unroll
            for (int m = 0; m < 4; ++m) {
#pragma unroll
                for (int bj = 0; bj < 2; ++bj)
#pragma unroll
                    for (int n = 0; n < 2; ++n) acc[ai][bj][m][n] *= rsv[ai][m];
            }
#pragma unroll
        for (int ai = 0; ai < 2; ++ai) {
            if (fr == 0) {
#pragma unroll
                for (int bj = 0; bj < 2; ++bj)
#pragma unroll
                    for (int n = 0; n < 2; ++n) *(PG8_LAS f32x4*)(X + ((wid * 2 + ai) * 2 + 0) * 64 + 32 * bj + 8 * fq + 4 * n) = acc[ai][bj][0][n];
            }
            if (fr == 15) {
#pragma unroll
                for (int bj = 0; bj < 2; ++bj)
#pragma unroll
                    for (int n = 0; n < 2; ++n) *(PG8_LAS f32x4*)(X + ((wid * 2 + ai) * 2 + 1) * 64 + 32 * bj + 8 * fq + 4 * n) = acc[ai][bj][3][n];
            }
        }
        {
            const int ccol = u.pn * 128 + wc * 32 + 8 * fq;
            if (wr == 0 && fr < 2) {
#pragma unroll
                for (int bj = 0; bj < 2; ++bj)
#pragma unroll
                    for (int n = 0; n < 2; ++n) *(f32x4*)(yb + ((size_t)u.pm * 4 + fr) * FF2 + bj * FF + ccol + 4 * n) = acc[0][bj][0][n];
            }
            if (wr == 1 && fr >= 14) {
#pragma unroll
                for (int bj = 0; bj < 2; ++bj)
#pragma unroll
                    for (int n = 0; n < 2; ++n) *(f32x4*)(yb + ((size_t)u.pm * 4 + 2 + (fr - 14)) * FF2 + bj * FF + ccol + 4 * n) = acc[1][bj][3][n];
            }
        }
        asm volatile("s_waitcnt lgkmcnt(0)" ::: "memory"); __builtin_amdgcn_s_barrier(); asm volatile("" ::: "memory");
#pragma unroll
        for (int rep_ = 0; rep_ <= ((MK_EDUP & 1) ? 1 : 0); ++rep_) {
        if (rep_) {
#pragma unroll
            for (int ai = 0; ai < 2; ++ai)
#pragma unroll
                for (int bj = 0; bj < 2; ++bj)
#pragma unroll
                    for (int m = 0; m < 4; ++m)
#pragma unroll
                        for (int n = 0; n < 2; ++n) asm volatile("" : "+v"(acc[ai][bj][m][n]) :: "memory");
        }
#pragma unroll
        for (int n = 0; n < 2; ++n) {
            const int ccol = u.pn * 128 + wc * 32 + 8 * fq + 4 * n;
            f32x4 w0[2], w1[2], w2[2], bb[2];
#pragma unroll
            for (int bj = 0; bj < 2; ++bj) { w0[bj] = *(const f32x4*)(cw + bj * FF + ccol); w1[bj] = *(const f32x4*)(cw + FF2 + bj * FF + ccol); w2[bj] = *(const f32x4*)(cw + 2 * FF2 + bj * FF + ccol); bb[bj] = *(const f32x4*)(cb + bj * FF + ccol); }
#pragma unroll
            for (int ai = 0; ai < 2; ++ai) {
                const int pw = wr ? wid - 4 : wid + 4, pai = wr ? ai : 0;
                const int nw = wr ? wid - 4 : wid + 4, nai = wr ? 1 : ai;
                f32x4 xp[2], xn[2];
#pragma unroll
                for (int bj = 0; bj < 2; ++bj) { xp[bj] = *(PG8_LAS f32x4*)(X + ((pw * 2 + pai) * 2 + 1) * 64 + 32 * bj + 8 * fq + 4 * n); xn[bj] = *(PG8_LAS f32x4*)(X + ((nw * 2 + nai) * 2 + 0) * 64 + 32 * bj + 8 * fq + 4 * n); }
#pragma unroll
                for (int m = 0; m < 4; ++m) {
                    const int trow = ai * HALF + wr * 64 + m * 16 + fr;
                    float uv[2][4];
#pragma unroll
                    for (int bj = 0; bj < 2; ++bj)
#pragma unroll
                        for (int e = 0; e < 4; ++e) {
                            const float cur = acc[ai][bj][m][n][e];
                            float rp, rn;
                            if (m > 0) rp = DPPF(0.f, acc[ai][bj][m > 0 ? m - 1 : 0][n][e], 0x121, true); else rp = xp[bj][e];
                            if (m < 3) rn = DPPF(0.f, acc[ai][bj][m < 3 ? m + 1 : 3][n][e], 0x12F, true); else rn = xn[bj][e];
                            const float prev = DPPF(rp, cur, 0x111, false), next = DPPF(rn, cur, 0x101, false);
                            uv[bj][e] = bb[bj][e] + w0[bj][e] * prev + w1[bj][e] * cur + w2[bj][e] * next;
                        }
                    f32x4 o;
#pragma unroll
                    for (int e = 0; e < 4; ++e) o[e] = uv[0][e] * uv[1][e] * __builtin_amdgcn_rcpf(1.0f + __builtin_amdgcn_exp2f(-uv[1][e] * LOG2E));
                    u32x2 w; w.x = cvt_pk_bf16(o[0], o[1]); w.y = cvt_pk_bf16(o[2], o[3]);
                    if (trow != 0 && trow != 255) *(u32x2*)(a + (size_t)(u.pm * BM + trow) * FF + ccol) = w;
                    asm volatile("" ::: "memory");
                }
            }
        }
        }
    }
};

template <class Epi, class Sched, bool ALIGN_EPI = false, bool SP2 = false>
__device__ __forceinline__ void gemm_phase(PG8_LAS unsigned char* lds, const int K, const int lda, const Sched& S, const Epi& E) {
    int tid_ = threadIdx.x; asm volatile("" : "+v"(tid_));
    const int tid = tid_, wid = __builtin_amdgcn_readfirstlane(tid >> 6), lane = tid & 63, wr = wid >> 2, wc = wid & 3, fr = lane & 15, fq = lane >> 4;
    const int nt = K / BK;
    unsigned voffA[2], voffB[2];
#pragma unroll
    for (int i = 0; i < 2; ++i) { int R, C; stage_rc(tid * 16 + i * 8192, R, C); const int Rb = Epi::PERM ? ((R & ~31) + perm32(R & 31)) : R;
        voffA[i] = (unsigned)(R * lda + C) * 2u; voffB[i] = (unsigned)(Rb * K + C) * 2u; }
    const size_t kstep = (size_t)(BK * 2);
    const size_t hstepB = (size_t)HALF * K * 2;
    const size_t hstepA = (size_t)HALF * lda * 2;
    const unsigned ldsw = (unsigned)wid * 1024u;
    const int aoff = lds_byte(wr * 64 + fr, fq * 8), boff = lds_byte(wc * 32 + fr, fq * 8);
#define PG8_SA(b, h) (((b) * 2 + (h)) * HTB)
#define PG8_SB(b, h) ((4 + (b) * 2 + (h)) * HTB)
#define PG8_STAGE(bufoff, gbase, voff) do { _Pragma("unroll") for (int _i = 0; _i < 2; ++_i) \
        __builtin_amdgcn_global_load_lds((const unsigned*)((const char*)(gbase) + (voff)[_i]), (PG8_LAS unsigned*)(lds + (bufoff) + ldsw + _i * 8192), 16, 0, 0); } while (0)
#define PG8_LDA(dst, b, h) do { _Pragma("unroll") for (int m = 0; m < 4; ++m) _Pragma("unroll") for (int k = 0; k < 2; ++k) dst[m][k] = *(const PG8_LAS bf16x8*)(lds + PG8_SA(b, h) + aoff + m * 2048 + k * 1024); } while (0)
#define PG8_LDB(dst, b, h) do { _Pragma("unroll") for (int n = 0; n < 2; ++n) _Pragma("unroll") for (int k = 0; k < 2; ++k) dst[n][k] = *(const PG8_LAS bf16x8*)(lds + PG8_SB(b, h) + boff + n * 2048 + k * 1024); } while (0)
#define PG8_MMA(ai, bj, At, Bt) do { __builtin_amdgcn_s_setprio(1); _Pragma("unroll") for (int m = 0; m < 4; ++m) _Pragma("unroll") for (int n = 0; n < 2; ++n) _Pragma("unroll") for (int k = 0; k < 2; ++k) \
        acc[ai][bj][m][n] = __builtin_amdgcn_mfma_f32_16x16x32_bf16(Bt[n][k], At[m][k], acc[ai][bj][m][n], 0, 0, 0); __builtin_amdgcn_s_setprio(0); } while (0)
#define PG8_WAIT_V(n) asm volatile("s_waitcnt vmcnt(" #n ")" ::: "memory")
#define PG8_WAIT_L(n) asm volatile("s_waitcnt lgkmcnt(" #n ")" ::: "memory")
#define PG8_BAR __builtin_amdgcn_s_barrier()
#define PG8_SCHED __builtin_amdgcn_sched_barrier(0)
    Unit cur, nxt; int ui = 0;
    if (!S.next(0, cur)) return;
    f32x4 acc[2][2][4][2];
#pragma unroll
    for (int a = 0; a < 2; ++a)
#pragma unroll
        for (int b = 0; b < 2; ++b)
#pragma unroll
            for (int m = 0; m < 4; ++m)
#pragma unroll
                for (int n = 0; n < 2; ++n) acc[a][b][m][n] = (f32x4){0.f, 0.f, 0.f, 0.f};
    bf16x8 At[4][2], B0[2][2], B1[2][2];
    const char* cA = S.aptr(cur); const char* cB = S.bptr(cur);
    S.a_ready(cur);
    if constexpr (SP2) {
        PG8_STAGE(PG8_SB(0, 0), cB, voffB); PG8_STAGE(PG8_SB(0, 1), cB + hstepB, voffB); PG8_STAGE(PG8_SA(0, 0), cA, voffA); PG8_STAGE(PG8_SA(0, 1), cA + hstepA, voffA);
        if (wr == 1) PG8_BAR;
        PG8_WAIT_V(2); PG8_BAR;
        PG8_STAGE(PG8_SB(1, 0), cB + kstep, voffB); PG8_STAGE(PG8_SA(1, 0), cA + kstep, voffA); PG8_STAGE(PG8_SB(1, 1), cB + hstepB + kstep, voffB);
        PG8_WAIT_V(6); PG8_BAR;
    } else {
        PG8_STAGE(PG8_SB(0, 0), cB, voffB); PG8_STAGE(PG8_SA(0, 0), cA, voffA); PG8_STAGE(PG8_SB(0, 1), cB + hstepB, voffB); PG8_STAGE(PG8_SA(0, 1), cA + hstepA, voffA);
        if (wr == 1) PG8_BAR;
        PG8_WAIT_V(4); PG8_BAR;
        PG8_STAGE(PG8_SB(1, 0), cB + kstep, voffB); PG8_STAGE(PG8_SA(1, 0), cA + kstep, voffA); PG8_STAGE(PG8_SB(1, 1), cB + hstepB + kstep, voffB);
        PG8_WAIT_V(6); PG8_BAR;
    }
    for (;;) {
        const bool has_next = S.next(ui + 1, nxt);
        const char* nA = has_next ? S.aptr(nxt) : cA; const char* nB = has_next ? S.bptr(nxt) : cB;
        for (int t = 0; t < nt; t += 2) {
            const bool last = (t == nt - 2);
            const char* a1 = cA + (size_t)(t + 1) * kstep;
            const char* a2 = last ? nA : cA + (size_t)(t + 2) * kstep; const char* b2 = last ? nB : cB + (size_t)(t + 2) * kstep;
            const char* a3 = a2 + kstep; const char* b3 = b2 + kstep;
            if (last && has_next) S.a_ready(nxt);
            if constexpr (SP2) {
            PG8_LDB(B0, 0, 0); PG8_LDB(B1, 0, 1); PG8_SCHED; PG8_LDA(At, 0, 0); PG8_STAGE(PG8_SA(1, 1), a1 + hstepA, voffA);
            PG8_WAIT_V(8); PG8_WAIT_L(0); PG8_BAR; PG8_MMA(0, 0, At, B0); PG8_MMA(0, 1, At, B1); PG8_BAR; PG8_SCHED;
            PG8_LDA(At, 0, 1); PG8_STAGE(PG8_SB(0, 0), b2, voffB); PG8_STAGE(PG8_SB(0, 1), b2 + hstepB, voffB); PG8_STAGE(PG8_SA(0, 0), a2, voffA);
            PG8_WAIT_V(8); PG8_WAIT_L(0); PG8_BAR; PG8_MMA(1, 0, At, B0); PG8_MMA(1, 1, At, B1); PG8_BAR; PG8_SCHED;
            PG8_LDB(B0, 1, 0); PG8_LDB(B1, 1, 1); PG8_SCHED; PG8_LDA(At, 1, 0); PG8_STAGE(PG8_SA(0, 1), a2 + hstepA, voffA);
            PG8_WAIT_V(8); PG8_WAIT_L(0); PG8_BAR; PG8_MMA(0, 0, At, B0); PG8_MMA(0, 1, At, B1); PG8_BAR; PG8_SCHED;
            PG8_LDA(At, 1, 1); PG8_STAGE(PG8_SB(1, 0), b3, voffB); PG8_STAGE(PG8_SB(1, 1), b3 + hstepB, voffB); PG8_STAGE(PG8_SA(1, 0), a3, voffA);
            PG8_WAIT_V(8); PG8_WAIT_L(0); PG8_BAR; PG8_MMA(1, 0, At, B0); PG8_MMA(1, 1, At, B1); PG8_BAR; PG8_SCHED;
            } else {
            PG8_LDB(B0, 0, 0); PG8_SCHED; PG8_LDA(At, 0, 0); PG8_STAGE(PG8_SA(1, 1), a1 + hstepA, voffA);
            PG8_WAIT_L(8); PG8_BAR; PG8_WAIT_L(0); PG8_MMA(0, 0, At, B0); PG8_BAR; PG8_SCHED;
            PG8_LDB(B1, 0, 1); PG8_STAGE(PG8_SB(0, 0), b2, voffB);
            PG8_BAR; PG8_WAIT_L(0); PG8_MMA(0, 1, At, B1); PG8_BAR;
            PG8_LDA(At, 0, 1); PG8_STAGE(PG8_SA(0, 0), a2, voffA);
            PG8_BAR; PG8_WAIT_L(0); PG8_MMA(1, 0, At, B0); PG8_BAR; PG8_SCHED;
            PG8_STAGE(PG8_SB(0, 1), b2 + hstepB, voffB);
            PG8_WAIT_V(6); PG8_BAR; PG8_MMA(1, 1, At, B1); PG8_BAR;
            PG8_LDB(B0, 1, 0); PG8_SCHED; PG8_LDA(At, 1, 0); PG8_STAGE(PG8_SA(0, 1), a2 + hstepA, voffA);
            PG8_WAIT_L(8); PG8_BAR; PG8_WAIT_L(0); PG8_MMA(0, 0, At, B0); PG8_BAR; PG8_SCHED;
            PG8_LDB(B1, 1, 1); PG8_STAGE(PG8_SB(1, 0), b3, voffB);
            PG8_BAR; PG8_WAIT_L(0); PG8_MMA(0, 1, At, B1); PG8_BAR;
            PG8_LDA(At, 1, 1); PG8_STAGE(PG8_SA(1, 0), a3, voffA);
            PG8_BAR; PG8_WAIT_L(0); PG8_MMA(1, 0, At, B0); PG8_BAR; PG8_SCHED;
            PG8_STAGE(PG8_SB(1, 1), b3 + hstepB, voffB);
            PG8_WAIT_V(6); PG8_BAR; PG8_MMA(1, 1, At, B1); PG8_BAR;
            }
        }
        if constexpr (ALIGN_EPI) { if (wr == 0) PG8_BAR; }
        if constexpr (!Epi::AFTER_DRAIN) { E(acc, cur, wr, wc, fr, fq, lds); S.done(cur); }
        if (!has_next) break;
        if (Epi::zero_after(cur)) {
#pragma unroll
        for (int a = 0; a < 2; ++a)
#pragma unroll
            for (int b = 0; b < 2; ++b)
#pragma unroll
                for (int m = 0; m < 4; ++m)
#pragma unroll
                    for (int n = 0; n < 2; ++n) acc[a][b][m][n] = (f32x4){0.f, 0.f, 0.f, 0.f};
        }
        cur = nxt; cA = nA; cB = nB; ++ui;
        if constexpr (ALIGN_EPI) { if (wr == 1) PG8_BAR; }
    }
    PG8_WAIT_V(0);
    if constexpr (!ALIGN_EPI) { if (wr == 0) PG8_BAR; }
    PG8_BAR;
    if constexpr (Epi::AFTER_DRAIN) { E.fused(acc, cur, wr, wc, fr, fq, lds, wid, lane); S.done(cur); }
#undef PG8_SA
#undef PG8_SB
#undef PG8_STAGE
#undef PG8_LDA
#undef PG8_LDB
#undef PG8_MMA
#undef PG8_WAIT_V
#undef PG8_WAIT_L
#undef PG8_BAR
#undef PG8_SCHED
}
}

namespace att {
using namespace nv;
#define ALAS __attribute__((address_space(3)))
typedef short bf16x8 __attribute__((ext_vector_type(8)));
typedef short s16x4 __attribute__((ext_vector_type(4)));
typedef float f32x16 __attribute__((ext_vector_type(16)));
typedef float f32x4 __attribute__((ext_vector_type(4)));
typedef unsigned u32x4 __attribute__((ext_vector_type(4)));
typedef unsigned u32x2 __attribute__((ext_vector_type(2)));
typedef short v4i16_t __attribute__((ext_vector_type(4)));
typedef float f32x2_t __attribute__((ext_vector_type(2))); typedef __bf16 bf16x2_t __attribute__((ext_vector_type(2)));
constexpr int LUT_OFF = 98304, LUT_STRIDE = 520, GT_OFF = LUT_OFF + 12 * LUT_STRIDE * 4;
static_assert(GT_OFF + 512 <= 131072, "attention tables inside the ring region");
constexpr float NEG = -30000.f, THR = 6.f;
__device__ __forceinline__ unsigned cvtpk(float lo, float hi) { f32x2_t v = {lo, hi}; bf16x2_t b = __builtin_convertvector(v, bf16x2_t); return __builtin_bit_cast(unsigned, b); }
__device__ __forceinline__ s16x4 vtr(ALAS const unsigned char* p) { return __builtin_bit_cast(s16x4, __builtin_amdgcn_ds_read_tr16_b64_v4i16((ALAS v4i16_t*)p)); }
__device__ __forceinline__ void glds16(const void* gsrc, unsigned lds_dst) { unsigned keep;
    asm volatile("s_mov_b32 %0, m0\n\ts_mov_b32 m0, %2\n\ts_nop 0\n\tglobal_load_lds_dwordx4 %1, off\n\ts_mov_b32 m0, %0" : "=&s"(keep) : "v"(gsrc), "s"(lds_dst) : "memory"); }
__device__ __forceinline__ float swap_add(float v) { auto rr = __builtin_amdgcn_permlane32_swap(__float_as_uint(v), __float_as_uint(v), false, false); return __uint_as_float(rr[0]) + __uint_as_float(rr[1]); }
__device__ __forceinline__ float swap_max(float v) { auto rr = __builtin_amdgcn_permlane32_swap(__float_as_uint(v), __float_as_uint(v), false, false); return fmaxf(__uint_as_float(rr[0]), __uint_as_float(rr[1])); }
#define MX3(a, b, c) __builtin_fmaxf(__builtin_fmaxf((a), (b)), (c))

__device__ __forceinline__ void attn_tables(ALAS unsigned char* lds, const float* __restrict__ lutg, const float* __restrict__ subg, float osc) {
    int tid = threadIdx.x; asm volatile("" : "+v"(tid));
    ALAS float* lut = (ALAS float*)(lds + LUT_OFF); ALAS float* gt = (ALAS float*)(lds + GT_OFF);
    for (int i = tid; i < 12 * LUT_STRIDE; i += 512) lut[i] = lutg[i];
    if (tid < 128) gt[tid] = subg[tid] * osc;
    __syncthreads();
}
template <bool ISB, int VAR = 0>
__device__ __forceinline__ void attn_unit(ALAS unsigned char* lds, bf16* zg, const float* __restrict__ lutg, int b, int hsel, int q0, const float* __restrict__ sinkp, float lam, float osc, const float* __restrict__ subg, bf16* odry) {
    int tid_ = threadIdx.x; asm volatile("" : "+v"(tid_));
    const int tid = tid_, lane = tid & 63, r32 = lane & 31, hi = lane >> 5; const int wid = __builtin_amdgcn_readfirstlane(tid >> 6);
    constexpr int NDV = ISB ? 4 : 2, BUF = ISB ? 32768 : 16384, VOFF = ISB ? 16384 : 8192;
    const int map = ISB ? (wid >> 2) : 0, qsub = ISB ? (wid & 3) : (wid & 1), gsel = ISB ? 0 : (wid >> 1);
    const int head = ISB ? hsel : hsel * 4 + gsel;
    const int qrow0 = q0 + 32 * qsub;
    const int qcol = ISB ? (C_QB + head * 128 + map * 64) : (C_QA + head * 64);
    const int kcol = ISB ? (C_KB + head * 128) : (C_KA + hsel * 64);
    const int vcol = ISB ? (C_VB + head * 128) : (C_VA + hsel * 64);
    const size_t rowbase = (size_t)b * S;
    int kt0 = 0, kt1 = S / 64;
    if (!ISB) { kt0 = q0 / 64 - 2; if (kt0 < 0) kt0 = 0; kt1 = q0 / 64 + 3; if (kt1 > S / 64) kt1 = S / 64; }
    const int nt = kt1 - kt0;
    ALAS float* lut = (ALAS float*)(lds + LUT_OFF) + (ISB ? 8 + head : hsel * 4 + gsel) * LUT_STRIDE;
    ALAS float* gt = (ALAS float*)(lds + GT_OFF);
    const float sink2 = ISB ? 0.f : sinkp[head] * LOG2E;
    bf16x8 qr[4];
    { const bf16* qp = zg + (rowbase + qrow0 + r32) * ZG + qcol + hi * 8;
#pragma unroll
      for (int d0 = 0; d0 < 4; ++d0) qr[d0] = *(const bf16x8*)(qp + d0 * 16); }
    const unsigned lds0 = (unsigned)(size_t)lds;
    const bf16* kp_[2]; const bf16* vp_[2];
#pragma unroll
    for (int i_ = 0; i_ < 2; ++i_) { const int p_ = ISB ? wid * 2 + i_ : wid;
        kp_[i_] = zg + (rowbase + (size_t)kt0 * 64 + lane) * ZG + kcol + (ISB ? (p_ >> 3) * 64 + (p_ & 7) * 8 : wid * 8);
        vp_[i_] = zg + (rowbase + (size_t)kt0 * 64 + 16 * (p_ & 3) + (lane >> 2)) * ZG + vcol + 32 * (p_ >> 2) + 8 * (lane & 3); }
#define ATT_ISSUE(bo) do { \
        _Pragma("unroll") for (int i_ = 0; i_ < (ISB ? 2 : 1); ++i_) { const int p_ = ISB ? wid * 2 + i_ : wid; \
            glds16(kp_[i_], (unsigned)__builtin_amdgcn_readfirstlane((int)(lds0 + (bo) + p_ * 1024))); \
            glds16(vp_[i_], (unsigned)__builtin_amdgcn_readfirstlane((int)(lds0 + (bo) + VOFF + p_ * 1024))); \
            kp_[i_] += 64 * ZG; vp_[i_] += 64 * ZG; } } while (0)
#define ATT_SB() __builtin_amdgcn_sched_barrier(0)
    float mhat = 0.f, l = 0.f;
    f32x16 o[NDV];
#pragma unroll
    for (int d = 0; d < NDV; ++d)
#pragma unroll
        for (int r = 0; r < 16; ++r) o[d][r] = 0.f;
    const int kfo = (ISB ? map * 8192 : 0) + hi * 1024 + r32 * 16;
    const int vfo = VOFF + ((lane >> 4) & 1) * 32 + (lane & 3) * 8 + (4 * hi + ((lane & 15) >> 2)) * 64;
    u32x4 pw[4];
#define ATT_QK(P0, P1, t, so) do { const int kb_ = (t) * 64; float cf_ = 0.f; \
        if (ISB) { if (kb_ - qrow0 - 31 >= 91) cf_ = lut[256 + 128]; else if (kb_ + 63 - qrow0 <= -91) cf_ = lut[256 - 128]; } \
        const float c0_ = cf_ - mhat; f32x16 ci_; _Pragma("unroll") for (int r = 0; r < 16; ++r) ci_[r] = c0_; \
        ALAS const unsigned char* kp = lds + (so) + kfo; \
        P0 = __builtin_amdgcn_mfma_f32_32x32x16_bf16(*(ALAS const bf16x8*)(kp), qr[0], ci_, 0, 0, 0); \
        P1 = __builtin_amdgcn_mfma_f32_32x32x16_bf16(*(ALAS const bf16x8*)(kp + 512), qr[0], ci_, 0, 0, 0); \
        _Pragma("unroll") for (int d0 = 1; d0 < 4; ++d0) { \
            P0 = __builtin_amdgcn_mfma_f32_32x32x16_bf16(*(ALAS const bf16x8*)(kp + d0 * 2048), qr[d0], P0, 0, 0, 0); \
            P1 = __builtin_amdgcn_mfma_f32_32x32x16_bf16(*(ALAS const bf16x8*)(kp + d0 * 2048 + 512), qr[d0], P1, 0, 0, 0); } } while (0)
#define ATT_DECIDE(P0, P1, t, first) do { const int kb_ = (t) * 64; \
        if (!ISB || !((kb_ - qrow0 - 31 >= 91) || (kb_ + 63 - qrow0 <= -91))) { \
            ALAS const float* lp = lut + (kb_ - (qrow0 + r32) + 256 + 4 * hi); \
            _Pragma("unroll") for (int r = 0; r < 16; ++r) { P0[r] += lp[(r & 3) + 8 * (r >> 2)]; P1[r] += lp[32 + (r & 3) + 8 * (r >> 2)]; } } \
        float rm_; { float a = MX3(P0[0], P0[1], P1[0]), c = MX3(P0[2], P0[3], P1[1]); a = MX3(a, P1[2], P1[3]); \
            _Pragma("unroll") for (int r = 4; r < 16; r += 4) { a = MX3(a, P0[r], P0[r + 1]); c = MX3(c, P0[r + 2], P0[r + 3]); a = MX3(a, P1[r], P1[r + 1]); c = MX3(c, P1[r + 2], P1[r + 3]); } \
            rm_ = swap_max(__builtin_fmaxf(a, c)); } \
        if ((first) || __any(rm_ > THR)) { const float dl = (first) ? rm_ : __builtin_fmaxf(rm_, 0.f); mhat += dl; \
            _Pragma("unroll") for (int r = 0; r < 16; ++r) { P0[r] -= dl; P1[r] -= dl; } \
            if (!(first)) { const float f = __builtin_amdgcn_exp2f(-dl); l *= f; \
                _Pragma("unroll") for (int d = 0; d < NDV; ++d) _Pragma("unroll") for (int r = 0; r < 16; ++r) o[d][r] *= f; } } } while (0)
#define ATT_FINISH(P0, P1) do { float sacc = 0.f; \
        _Pragma("unroll") for (int r = 0; r < 16; ++r) { P0[r] = __builtin_amdgcn_exp2f(P0[r]); P1[r] = __builtin_amdgcn_exp2f(P1[r]); sacc += P0[r] + P1[r]; } \
        l += sacc; \
        pw[0] = (u32x4){cvtpk(P0[0], P0[1]), cvtpk(P0[2], P0[3]), cvtpk(P0[4], P0[5]), cvtpk(P0[6], P0[7])}; \
        pw[1] = (u32x4){cvtpk(P0[8], P0[9]), cvtpk(P0[10], P0[11]), cvtpk(P0[12], P0[13]), cvtpk(P0[14], P0[15])}; \
        pw[2] = (u32x4){cvtpk(P1[0], P1[1]), cvtpk(P1[2], P1[3]), cvtpk(P1[4], P1[5]), cvtpk(P1[6], P1[7])}; \
        pw[3] = (u32x4){cvtpk(P1[8], P1[9]), cvtpk(P1[10], P1[11]), cvtpk(P1[12], P1[13]), cvtpk(P1[14], P1[15])}; } while (0)
#define ATT_LDV(dst, d) do { _Pragma("unroll") for (int ks = 0; ks < 4; ++ks) { dst[2 * ks] = vtr(vp + (d) * 4096 + ks * 1024); dst[2 * ks + 1] = vtr(vp + (d) * 4096 + ks * 1024 + 512); } } while (0)
#define ATT_VF(src, ks) (bf16x8){src[2 * (ks)][0], src[2 * (ks)][1], src[2 * (ks)][2], src[2 * (ks)][3], src[2 * (ks) + 1][0], src[2 * (ks) + 1][1], src[2 * (ks) + 1][2], src[2 * (ks) + 1][3]}
#define ATT_PVD(src, d) do { __builtin_amdgcn_s_setprio(1); _Pragma("unroll") for (int ks = 0; ks < 4; ++ks) o[d] = __builtin_amdgcn_mfma_f32_32x32x16_bf16(ATT_VF(src, ks), __builtin_bit_cast(bf16x8, pw[ks]), o[d], 0, 0, 0); __builtin_amdgcn_s_setprio(0); } while (0)
#define ATT_PV(so) do { ALAS const unsigned char* vp = lds + (so) + vfo; s16x4 va[8], vb[8]; \
        ATT_LDV(va, 0); ATT_LDV(vb, 1); ATT_SB(); ATT_PVD(va, 0); ATT_SB(); \
        if (NDV == 4) { ATT_LDV(va, 2); ATT_SB(); ATT_PVD(vb, 1); ATT_SB(); ATT_LDV(vb, 3); ATT_SB(); ATT_PVD(va, 2); ATT_SB(); ATT_PVD(vb, 3); } \
        else { ATT_PVD(vb, 1); } } while (0)
#define ATT_SLOT(i) (ISB ? (((i) % 3) * BUF) : ((i) * BUF))
#define ATT_STEP(i, PC0, PC1, PP0, PP1) do { \
        if (ISB) { asm volatile("s_waitcnt vmcnt(0)" ::: "memory"); __syncthreads(); if ((i) + 1 < nt) ATT_ISSUE(ATT_SLOT((i) + 1)); } \
        ATT_QK(PC0, PC1, kt0 + (i), ATT_SLOT(i)); ATT_SB(); \
        ATT_FINISH(PP0, PP1); ATT_SB(); \
        ATT_PV(ATT_SLOT((i) - 1)); ATT_SB(); \
        ATT_DECIDE(PC0, PC1, kt0 + (i), false); ATT_SB(); } while (0)
    f32x16 pA0, pA1, pB0, pB1;
    if (ISB) { ATT_ISSUE(0); asm volatile("s_waitcnt vmcnt(0)" ::: "memory"); __syncthreads(); if (nt > 1) ATT_ISSUE(BUF); }
    else {
#pragma unroll 1
        for (int i = 0; i < nt; ++i) ATT_ISSUE(i * BUF);
        asm volatile("s_waitcnt vmcnt(0)" ::: "memory"); __syncthreads();
    }
    ATT_QK(pA0, pA1, kt0, 0); ATT_SB();
    ATT_DECIDE(pA0, pA1, kt0, true); ATT_SB();
    int i = 1;
#pragma unroll 1
    for (; i + 1 < nt; i += 2) {
        ATT_STEP(i, pB0, pB1, pA0, pA1);
        ATT_STEP(i + 1, pA0, pA1, pB0, pB1);
    }
    if (i < nt) {
        ATT_STEP(i, pB0, pB1, pA0, pA1);
        ATT_FINISH(pB0, pB1); ATT_SB(); ATT_PV(ATT_SLOT(nt - 1));
    } else {
        ATT_FINISH(pA0, pA1); ATT_SB(); ATT_PV(ATT_SLOT(nt - 1));
    }
#undef ATT_ISSUE
#undef ATT_SB
#undef ATT_QK
#undef ATT_DECIDE
#undef ATT_FINISH
#undef ATT_PV
#undef ATT_LDV
#undef ATT_VF
#undef ATT_PVD
#undef ATT_SLOT
#undef ATT_STEP
    l = swap_add(l);
    if (!ISB) l += __builtin_amdgcn_exp2f(sink2 - mhat);
    const float inv = 1.0f / l;
    constexpr int DVE = ISB ? 128 : 64, SPITCH = DVE * 2 + 8;
    bf16* obase = odry ? odry + (rowbase + qrow0) * D + (ISB ? (512 + head * 128) : (head * 64)) : zg + (rowbase + qrow0) * ZG + (ISB ? (C_QB + head * 128) : (C_QA + head * 64));
    const size_t opitch = odry ? D : ZG;
    ALAS unsigned char* stg = lds + (ISB ? qsub * 16384 : wid * 4608);
#define ATT_OUT() do { asm volatile("s_waitcnt lgkmcnt(0)" ::: "memory"); \
        constexpr int LPR = DVE / 8, RPI = 64 / LPR;   \
        _Pragma("unroll") for (int i_ = 0; i_ < 32 / RPI; ++i_) { const int row_ = i_ * RPI + lane / LPR, ch_ = lane % LPR; \
            const u32x2 a_ = *(ALAS const u32x2*)(stg + row_ * SPITCH + ch_ * 16), b_ = *(ALAS const u32x2*)(stg + row_ * SPITCH + ch_ * 16 + 8); \
            *(u32x4*)(obase + (size_t)row_ * opitch + ch_ * 8) = (u32x4){a_.x, a_.y, b_.x, b_.y}; } } while (0)
    if (ISB) {
        __syncthreads();
        ALAS float* cs = (ALAS float*)lds;
        if (map == 1) { const float sc = -lam * inv;
#pragma unroll
            for (int d = 0; d < NDV; ++d)
#pragma unroll
                for (int r = 0; r < 16; ++r) cs[(qsub * 64 + d * 16 + r) * 64 + lane] = o[d][r] * sc; }
        __syncthreads();
        if (map == 0) {
            float q = 0.f;
#pragma unroll
            for (int d = 0; d < NDV; ++d)
#pragma unroll
                for (int r = 0; r < 16; ++r) { const float v = o[d][r] * inv + cs[(qsub * 64 + d * 16 + r) * 64 + lane]; o[d][r] = v; q += v * v; }
            q = swap_add(q);
            const float rstd = rsqrtf(q * (1.0f / 128.0f) + EPS);
            asm volatile("s_waitcnt lgkmcnt(0)" ::: "memory");
#pragma unroll
            for (int d = 0; d < NDV; ++d)
#pragma unroll
                for (int g4 = 0; g4 < 4; ++g4) { const int dv0 = 32 * d + 8 * g4 + 4 * hi; const f32x4 gv = *(ALAS const f32x4*)(gt + dv0);
                    u32x2 w; w.x = cvtpk(o[d][4 * g4] * rstd * gv[0], o[d][4 * g4 + 1] * rstd * gv[1]); w.y = cvtpk(o[d][4 * g4 + 2] * rstd * gv[2], o[d][4 * g4 + 3] * rstd * gv[3]);
                    *(ALAS u32x2*)(stg + r32 * SPITCH + dv0 * 2) = w; }
            ATT_OUT();
        }
    } else {
        __syncthreads();
#pragma unroll
        for (int d = 0; d < NDV; ++d)
#pragma unroll
            for (int g4 = 0; g4 < 4; ++g4) { const int dv0 = 32 * d + 8 * g4 + 4 * hi;
                u32x2 w; w.x = cvtpk(o[d][4 * g4] * inv, o[d][4 * g4 + 1] * inv); w.y = cvtpk(o[d][4 * g4 + 2] * inv, o[d][4 * g4 + 3] * inv);
                *(ALAS u32x2*)(stg + r32 * SPITCH + dv0 * 2) = w; }
        ATT_OUT();
    }
#undef ATT_OUT
    __syncthreads();
}
#undef MX3
}

#ifndef MK_VAR
#define MK_VAR 0
#endif
namespace mk {
using namespace nv;
constexpr int NWAVES = 8;
constexpr size_t MiB = 1u << 20;
constexpr size_t WS_CTL = 0, CTL_ZERO_BYTES = 1 * MiB;
constexpr size_t WS_LUT = 512 * 1024;
constexpr size_t WS_SS = 1 * MiB;
constexpr size_t WS_XB = 6 * MiB;
constexpr size_t WS_ZG = 38 * MiB;
constexpr size_t WS_A = 38 * MiB;
constexpr size_t WS_YB = 126 * MiB;
constexpr size_t WS_MIX = 174 * MiB;
constexpr size_t WS_W = 206 * MiB;
constexpr size_t WL_IN = 0, WL_A = (size_t)ZG * D, WL_B = WL_A + (size_t)D * 512, WL_O = WL_B + (size_t)D * 512, WL_UP = WL_O + (size_t)D * D, WL_DN = WL_UP + (size_t)FF2 * D, WL_END = WL_DN + (size_t)D * FF;
constexpr size_t WS_TMPA = 322 * MiB, WS_TMPB = 344 * MiB;
constexpr size_t WS_END = 352 * MiB;
static_assert(WS_W + 4 * WL_END * 2 <= WS_TMPA && WS_YB + (size_t)64 * 4 * FF2 * 4 <= WS_MIX && WS_A + (size_t)T * FF * 2 <= WS_YB, "d_ws map");
constexpr int CW_Q = 2048;
constexpr int CW_BAR = 4096;
constexpr int N_PHASES = 1 + 6 * L;
constexpr int RING_OFF = 0, RING_BYTES = 131072, LDSCTL_OFF = RING_BYTES, MISC_OFF = LDSCTL_OFF + 320;
constexpr int LDS_BYTES = 147456;
static_assert(pg8::XOFF + 8192 <= LDS_BYTES && MISC_OFF + 128 <= pg8::XOFF, "LDS map");

#define GAS __attribute__((address_space(1)))
#define LAS __attribute__((address_space(3)))
typedef unsigned v4u __attribute__((ext_vector_type(4)));
typedef float f32x4 __attribute__((ext_vector_type(4)));
typedef GAS unsigned gu32;
#define RLX_AGENT __ATOMIC_RELAXED, __HIP_MEMORY_SCOPE_AGENT
#define LDS_WAIT() asm volatile("s_waitcnt lgkmcnt(0)" ::: "memory")
#define VM_WAIT() asm volatile("s_waitcnt vmcnt(0)" ::: "memory")
__device__ __forceinline__ unsigned f2bfu(float f) { unsigned u = __builtin_bit_cast(unsigned, f); return (u + 0x7fffu + ((u >> 16) & 1u)) >> 16; }
__device__ __forceinline__ unsigned pk2(float lo, float hi) { return f2bfu(lo) | (f2bfu(hi) << 16); }

#define XB_TMO      128
#define XB_XCNT(j)  (256  + 64 * (j))
#define XB_XSUB(j)  (1280 + 64 * (j))
#define XB_XGEN(j)  (2304 + 64 * (j))
#define XB_TOP      3328
#define XB_TOPGEN   3392
#define XCD_BAR_WORDS 3456
#define XB_SPIN_CAP (1u << 18)

__device__ __forceinline__ unsigned xb_ld(unsigned* p)              { return __hip_atomic_load(p, __ATOMIC_RELAXED, __HIP_MEMORY_SCOPE_AGENT); }
__device__ __forceinline__ unsigned xb_add(unsigned* p, unsigned v) { return __hip_atomic_fetch_add(p, v, __ATOMIC_RELAXED, __HIP_MEMORY_SCOPE_AGENT); }
__device__ __forceinline__ unsigned xb_xcc_id() { return (unsigned)__builtin_amdgcn_s_getreg((3 << 11) | 20) & 0xFu; }
#define XB_SPIN(cond, bar) do { unsigned _sp = 0; while (cond) { __builtin_amdgcn_s_sleep(1); \
    if ((++_sp & 255u) == 0u) { if (xb_ld(&(bar)[XB_TMO])) break; if (_sp > XB_SPIN_CAP) { atomicAdd(&(bar)[XB_TMO], 1u); break; } } } } while (0)

struct XcdBarrier {
    unsigned* bar; unsigned x;
    volatile LAS unsigned* st;
};

__device__ __forceinline__ XcdBarrier xcd_barrier_post(unsigned* bar, volatile LAS unsigned* st) {
    XcdBarrier b; b.bar = bar; b.x = xb_xcc_id(); b.st = st;
    if (threadIdx.x == 0) (void)xb_add(&bar[XB_XCNT(b.x)], 1u);
    return b;
}
__device__ __forceinline__ void xcd_barrier_complete(unsigned* bar, unsigned x, unsigned& nloc, unsigned& nx) {
    const unsigned G = gridDim.x * gridDim.y * gridDim.z;
    unsigned sum, cnt, mine, sp = 0u;
    for (;;) {
        sum = 0u; cnt = 0u; mine = 0u;
#pragma unroll
        for (unsigned j = 0; j < 16; ++j) { const unsigned c = xb_ld(&bar[XB_XCNT(j)]); sum += c; cnt += (c > 0u) ? 1u : 0u; mine = (j == x) ? c : mine; }
        if (sum == G) break;
        __builtin_amdgcn_s_sleep(1);
        if ((++sp & 255u) == 0u) { if (xb_ld(&bar[XB_TMO])) break; if (sp > XB_SPIN_CAP) { atomicAdd(&bar[XB_TMO], 1u); break; } }
    }
    nloc = mine > 0u ? mine : 1u; nx = cnt > 0u ? cnt : 1u;
}

__device__ __forceinline__ void xcd_barrier(const XcdBarrier& b) {
    asm volatile("s_waitcnt vmcnt(0)" ::: "memory");
    __syncthreads();
    if (threadIdx.x == 0) {
        unsigned* bar = b.bar;
        __builtin_amdgcn_s_waitcnt(0);
        unsigned nloc = b.st[0], nx = b.st[1];
        if (nloc == 0u) { xcd_barrier_complete(bar, b.x, nloc, nx); b.st[0] = nloc; b.st[1] = nx; }
        const unsigned old = xb_add(&bar[XB_XSUB(b.x)], 1u);
        const unsigned gen = old / nloc;
        if (old + 1u == (gen + 1u) * nloc) {
            __builtin_amdgcn_fence(__ATOMIC_RELEASE, "agent");
            asm volatile("s_waitcnt vmcnt(0)" ::: "memory");
            const unsigned og = xb_add(&bar[XB_TOP], 1u);
            const unsigned tg = og / nx;
            if (og + 1u == (tg + 1u) * nx) xb_add(&bar[XB_TOPGEN], 1u);
            else XB_SPIN(xb_ld(&bar[XB_TOPGEN]) == tg, bar);
            __builtin_amdgcn_fence(__ATOMIC_ACQUIRE, "agent");
            xb_add(&bar[XB_XGEN(b.x)], 1u);
            asm volatile("s_waitcnt vmcnt(0)" ::: "memory");
        } else {
            XB_SPIN(xb_ld(&bar[XB_XGEN(b.x)]) == gen, bar);
            __builtin_amdgcn_fence(__ATOMIC_ACQUIRE, "agent");
            asm volatile("s_waitcnt vmcnt(0)" ::: "memory");
        }
    }
    __syncthreads();
}


struct Args { const float* in[24]; float* out; unsigned char* ws; int ph_lo, ph_hi, li, pad; };

__device__ __forceinline__ void p0_transpose_item(const float* __restrict__ W, int ldw, int K, int k0, int n0, bf16* __restrict__ WT, int vrow0, const float* __restrict__ gain, LAS float* scr, int lane) {
    float v[32];
    const float* wp = W + (size_t)(k0 + (lane >> 5)) * ldw + n0 + (lane & 31);
#pragma unroll
    for (int i = 0; i < 32; ++i) v[i] = __builtin_nontemporal_load(wp + (size_t)(2 * i) * ldw);
    if (gain) {
#pragma unroll
        for (int i = 0; i < 32; ++i) v[i] *= gain[k0 + 2 * i + (lane >> 5)];
    }
#pragma unroll
    for (int i = 0; i < 32; ++i) scr[(2 * i + (lane >> 5)) * 33 + (lane & 31)] = v[i];
    LDS_WAIT(); asm volatile("" ::: "memory");
    const int c = lane & 7;
#pragma unroll
    for (int j = 0; j < 4; ++j) { const int n = (lane >> 3) + 8 * j; const LAS float* s = scr + (8 * c) * 33 + n;
        v4u o; o.x = pk2(s[0 * 33], s[1 * 33]); o.y = pk2(s[2 * 33], s[3 * 33]); o.z = pk2(s[4 * 33], s[5 * 33]); o.w = pk2(s[6 * 33], s[7 * 33]);
        *(GAS v4u*)(WT + (size_t)(vrow0 + n) * K + k0 + 8 * c) = o; }
    LDS_WAIT(); asm volatile("" ::: "memory");
}
__device__ __forceinline__ int vrow_in(int c) { const int pn = c >> 8, cr = c & 255, wc = cr >> 6, bj = (cr >> 5) & 1; return pn * 256 + bj * 128 + wc * 32; }
__device__ __forceinline__ int vrow_up(int c) { const int gs = c >= FF ? 1 : 0, cc = c - gs * FF, pn = cc >> 7, wc = (cc >> 5) & 3; return pn * 256 + gs * 128 + wc * 32; }

__global__ void __launch_bounds__(NWAVES * 64, 2) skel_fwd(Args args) {
    extern __shared__ __attribute__((aligned(16))) unsigned char lds_raw[];
    LAS unsigned char* lds = (LAS unsigned char*)lds_raw;
    volatile LAS unsigned* MISC = (volatile LAS unsigned*)(lds + MISC_OFF);
    const int G = gridDim.x; int vcu; { const int bx = blockIdx.x; vcu = (G % 8 == 0) ? (bx % 8) * (G / 8) + bx / 8 : bx; }
    unsigned char* ws = args.ws;
    gu32* ctl = (gu32*)(ws + WS_CTL);
    float* ss = (float*)(ws + WS_SS); bf16* xb = (bf16*)(ws + WS_XB); bf16* zg = (bf16*)(ws + WS_ZG); bf16* abuf = (bf16*)(ws + WS_A); float* yb = (float*)(ws + WS_YB);
    bf16* mix = (bf16*)(ws + WS_MIX); bf16* wbase = (bf16*)(ws + WS_W); float* xf = args.out;
    float* lutg = (float*)(ws + WS_LUT);
    for (int u = threadIdx.x; u < (LDS_BYTES - LDSCTL_OFF) / 4; u += NWAVES * 64) ((LAS unsigned*)(lds + LDSCTL_OFF))[u] = 0u;
    __syncthreads();
    XcdBarrier bar = xcd_barrier_post((unsigned*)(ctl + CW_BAR) + args.li * XCD_BAR_WORDS, MISC + 8);

#pragma unroll 1
    for (int ph = args.ph_lo; ph < args.ph_hi; ++ph) {
        const int l = ph > 0 ? (ph - 1) / 6 : 0, p = ph > 0 ? (ph - 1) % 6 + 1 : 0;
        bf16* wl = wbase + (size_t)l * WL_END;
        float* ss1 = ss + (size_t)((2 * l) & 3) * T * 16; float* ss2 = ss + (size_t)((2 * l + 1) & 3) * T * 16; float* ss3 = (l + 1 < L) ? ss + (size_t)((2 * l + 2) & 3) * T * 16 : nullptr;
#ifndef MK_ONLY
#define MK_ONLY 0x7f
#endif
        const int dupp = ((args.pad >> 8) & 0xff) - 1;
#pragma unroll 1
        for (int rep = (p == dupp) ? 0 : 1; rep < 2; ++rep) {
        if (p == 0 && (MK_ONLY & 1)) {
            int tid0 = threadIdx.x; asm volatile("" : "+v"(tid0));
            const int lane0 = tid0 & 63, wave = __builtin_amdgcn_readfirstlane(tid0 >> 6);
            LAS float* scr = (LAS float*)(lds + RING_OFF + wave * 16384);
            const int gw = vcu * NWAVES + wave, NGW = G * NWAVES;
            constexpr int I_IN = (D / 64) * (INW / 32), I_G = (D / 64) * (GW / 32), I_A = (512 / 64) * (D / 32), I_O = (D / 64) * (D / 32), I_UP = (D / 64) * (FF2 / 32), I_DN = (FF / 64) * (D / 32);
            constexpr int I_LAYER = I_IN + I_G + 2 * I_A + I_O + I_UP + I_DN;
            for (int i = gw * 64 + lane0; i < 12 * att::LUT_STRIDE; i += NGW * 64) { const int hh = i / att::LUT_STRIDE, j = i - hh * att::LUT_STRIDE, rel = j - 256, ar = rel < 0 ? -rel : rel;
                float v = 0.f; if (j <= 512) v = (hh < 8 && ar > 128) ? att::NEG : args.in[13][t5_bucket(rel) * 12 + hh] * LOG2E;
                lutg[i] = v; }
            for (int it = gw; it < L * I_LAYER; it += NGW) {
                const int ll = it / I_LAYER; int r = it - ll * I_LAYER; bf16* w = wbase + (size_t)ll * WL_END;
                if (r < I_IN) { const int nb = r % (INW / 32), kb = r / (INW / 32); p0_transpose_item(args.in[2] + (size_t)ll * D * INW, INW, D, 64 * kb, 32 * nb, w + WL_IN, vrow_in(32 * nb), args.in[1] + ll * D, scr, lane0); continue; } r -= I_IN;
                if (r < I_G) { const int nb = r % (GW / 32), kb = r / (GW / 32); p0_transpose_item(args.in[14] + (size_t)ll * D * GW, GW, D, 64 * kb, 32 * nb, w + WL_IN, vrow_in(INW + 32 * nb), args.in[1] + ll * D, scr, lane0); continue; } r -= I_G;
                if (r < I_A) { const int nb = r % (D / 32), kb = r / (D / 32); p0_transpose_item(args.in[16] + (size_t)ll * 512 * D, D, 512, 64 * kb, 32 * nb, w + WL_A, 32 * nb, nullptr, scr, lane0); continue; } r -= I_A;
                if (r < I_A) { const int nb = r % (D / 32), kb = r / (D / 32); p0_transpose_item(args.in[17] + (size_t)ll * 512 * D, D, 512, 64 * kb, 32 * nb, w + WL_B, 32 * nb, nullptr, scr, lane0); continue; } r -= I_A;
                if (r < I_O) { const int nb = r % (D / 32), kb = r / (D / 32); p0_transpose_item(args.in[18] + (size_t)ll * D * D, D, D, 64 * kb, 32 * nb, w + WL_O, 32 * nb, nullptr, scr, lane0); continue; } r -= I_O;
                if (r < I_UP) { const int nb = r % (FF2 / 32), kb = r / (FF2 / 32); p0_transpose_item(args.in[20] + (size_t)ll * D * FF2, FF2, D, 64 * kb, 32 * nb, w + WL_UP, vrow_up(32 * nb), args.in[19] + ll * D, scr, lane0); continue; } r -= I_UP;
                { const int nb = r % (D / 32), kb = r / (D / 32); p0_transpose_item(args.in[23] + (size_t)ll * FF * D, D, FF, 64 * kb, 32 * nb, w + WL_DN, 32 * nb, nullptr, scr, lane0); }
            }
            for (int m = gw; m < T; m += 2 * NGW) {
                const int m2 = m + NGW;
                const GAS f32x4* xr = (const GAS f32x4*)(args.in[0] + (size_t)m * D) + lane0; const GAS f32x4* xr2 = (const GAS f32x4*)(args.in[0] + (size_t)m2 * D) + lane0;
                GAS unsigned long long* o8 = (GAS unsigned long long*)(xb + (size_t)m * D) + lane0; GAS unsigned long long* o82 = (GAS unsigned long long*)(xb + (size_t)m2 * D) + lane0;
                f32x4 va[4], vb[4];
#pragma unroll
                for (int j = 0; j < 4; ++j) { va[j] = xr[64 * j]; vb[j] = xr2[64 * j]; }
                float s = 0.f, s2 = 0.f;
#pragma unroll
                for (int j = 0; j < 4; ++j) { const f32x4 v = va[j], w = vb[j]; s += (v.x * v.x + v.y * v.y) + (v.z * v.z + v.w * v.w); s2 += (w.x * w.x + w.y * w.y) + (w.z * w.z + w.w * w.w);
                    o8[64 * j] = (unsigned long long)pk2(v.x, v.y) | ((unsigned long long)pk2(v.z, v.w) << 32); o82[64 * j] = (unsigned long long)pk2(w.x, w.y) | ((unsigned long long)pk2(w.z, w.w) << 32); }
                s = wave_sum(s); s2 = wave_sum(s2);
                ss16_store(ss, m, s, lane0); ss16_store(ss, m2, s2, lane0);
            }
        } else if (p == 1 && (MK_ONLY & 2)) {
            pg8::SchedStd S; S.init(xb, D, wl + WL_IN, D, T, ZG - 256, G, (int)blockIdx.x);
            S.fix = (rep == 0 && MK_VAR == 8) ? 1 : 0;
            pg8::EpiIn E{zg, ss1, args.in[3] + l * 64, args.in[4] + l * 64, args.in[6] + l * 64, args.in[7] + l * 64, args.in[15] + l * GW, (args.pad >> 25) & 1};
            pg8::gemm_phase<pg8::EpiIn, pg8::SchedStd, true, true>(lds + RING_OFF, D, D, S, E);
        } else if (p == 2 && (MK_ONLY & 4)) {
            int lop = l; asm volatile("" : "+s"(lop));
            const float lam_init = 0.8f - 0.6f * __expf(-0.3f * (float)lop);
            int ln = threadIdx.x; asm volatile("" : "+v"(ln)); ln &= 63;
            const float d1 = wave_sum(args.in[8][l * 64 + ln] * args.in[9][l * 64 + ln]), d2 = wave_sum(args.in[10][l * 64 + ln] * args.in[11][l * 64 + ln]);
            const float lam = __expf(d1) - __expf(d2) + lam_init;
            if ((vcu & 3) == 0 && rep == 1) {
                pg8::SchedStd S1; S1.init(xb, D, wl + WL_IN, D, T, ZG, G, (int)blockIdx.x); S1.one = 1; S1.opm = 8 * (vcu >> 5) + ((vcu & 31) >> 2); S1.opn = 16;
                pg8::EpiIn E1{zg, ss1, args.in[3] + l * 64, args.in[4] + l * 64, args.in[6] + l * 64, args.in[7] + l * 64, args.in[15] + l * GW, 0};
                pg8::gemm_phase<pg8::EpiIn, pg8::SchedStd, true, true>(lds + RING_OFF, D, D, S1, E1);
            }
            att::attn_tables(lds, lutg, args.in[12] + l * 128, 1.0f - lam_init);
            const int dsel = args.pad >> 16;
            if (rep == 1 || dsel != 2)
            for (int ui = vcu; ui < 512; ui += G) { const int bh = ui >> 4, qb = ui & 15; if (rep == 0 && MK_VAR == 7 && (vcu & 1)) {} else if (rep == 0) att::attn_unit<true, (MK_VAR == 7 ? 0 : MK_VAR)>(lds, zg, lutg, bh >> 2, bh & 3, qb * 128, nullptr, lam, 1.0f - lam_init, args.in[12] + l * 128, mix);
                else att::attn_unit<true, 0>(lds, zg, lutg, bh >> 2, bh & 3, qb * 128, nullptr, lam, 1.0f - lam_init, args.in[12] + l * 128, nullptr); }
            if (rep == 1 || dsel != 1) {
                unsigned* qctr = (unsigned*)(ctl + CW_Q + 64 * (2 * l + rep));
                for (;;) {
                    if (threadIdx.x == 0) MISC[4] = __hip_atomic_fetch_add(qctr, 1u, __ATOMIC_RELAXED, __HIP_MEMORY_SCOPE_AGENT);
                    __syncthreads();
                    const int ui = (int)MISC[4];
                    __syncthreads();
                    if (ui >= 512) break;
                    const int bk = ui >> 5, qb = ui & 31; att::attn_unit<false>(lds, zg, lutg, bk >> 1, bk & 1, qb * 64, args.in[5] + l * HA, 0.f, 0.f, nullptr, rep == 0 ? mix : nullptr);
                }
            }
        } else if (p == 3 && (MK_ONLY & 8)) {
            pg8::SchedMix S; S.b.init(zg + C_QA, ZG, wl + WL_A, 512, T, D, G, (int)blockIdx.x); S.A1 = (const char*)(zg + C_QB); S.Bt1 = (const char*)(wl + WL_B);
            pg8::EpiMix E{zg, mix};
            pg8::gemm_phase<pg8::EpiMix, pg8::SchedMix, true, true>(lds + RING_OFF, 512, ZG, S, E);
        } else if (p == 4 && (MK_ONLY & 16)) {
            pg8::SchedStd S; S.init(mix, D, wl + WL_O, D, T, D, G, (int)blockIdx.x);
            pg8::EpiRes E{l == 0 ? args.in[0] : xf, xf, xb, ss2};
            pg8::gemm_phase<pg8::EpiRes, pg8::SchedStd, true, true>(lds + RING_OFF, D, D, S, E);
        } else if (p == 5 && (MK_ONLY & 32)) {
            pg8::SchedStd S; S.init(xb, D, wl + WL_UP, D, T, FF2, G, (int)blockIdx.x);
            pg8::EpiUp E{abuf, ss2, args.in[21] + (size_t)l * 3 * FF2, args.in[22] + (size_t)l * FF2, yb, (args.pad >> 24) & 1};
            pg8::gemm_phase<pg8::EpiUp, pg8::SchedStd, true, true>(lds + RING_OFF, D, D, S, E);
        } else if (MK_ONLY & 64) {
            pg8::SchedDown S; S.b.init(abuf, FF, wl + WL_DN, FF, T, D, G, (int)blockIdx.x); S.yb = (args.pad & 1) ? nullptr : yb; S.cw = args.in[21] + (size_t)l * 3 * FF2; S.cb = args.in[22] + (size_t)l * FF2; S.a = abuf;
            pg8::EpiRes E{xf, xf, ss3 ? xb : nullptr, ss3};
            pg8::gemm_phase<pg8::EpiRes, pg8::SchedDown, true, true>(lds + RING_OFF, FF, FF, S, E);
        }
        }
        if (ph + 1 < args.ph_hi) xcd_barrier(bar);
    }
}
}

#ifndef MK_MODE
#define MK_MODE 0x7f
#endif
extern "C" void kernel_launch(void* const* d_in, const int* in_sizes, int n_in, void* d_out, int out_size, void* d_ws, size_t ws_size, hipStream_t stream) {
    using namespace nv;
    static int grid = 0;
    if (grid == 0) {
        if (n_in != 24 || out_size != T * D || ws_size < mk::WS_END) { fprintf(stderr, "kernel_launch: unexpected shapes (n_in %d, out %d, ws %zu)\n", n_in, out_size, ws_size); grid = -1; return; }
        int dev = 0, cus = 0, per_cu = 0;
        if (hipGetDevice(&dev) != hipSuccess || hipDeviceGetAttribute(&cus, hipDeviceAttributeMultiprocessorCount, dev) != hipSuccess) { grid = -1; return; }
        if (hipFuncSetAttribute((const void*)mk::skel_fwd, hipFuncAttributeMaxDynamicSharedMemorySize, mk::LDS_BYTES) != hipSuccess) { fprintf(stderr, "kernel_launch: hipFuncSetAttribute failed\n"); grid = -1; return; }
        if (hipOccupancyMaxActiveBlocksPerMultiprocessor(&per_cu, (const void*)mk::skel_fwd, mk::NWAVES * 64, mk::LDS_BYTES) != hipSuccess || per_cu < 1) fprintf(stderr, "kernel_launch: occupancy query says %d\n", per_cu);
        (void)hipGetLastError();
        grid = cus;
    }
    if (grid < 0) return;
    const float* in[24]; for (int i = 0; i < 24; ++i) in[i] = (const float*)d_in[i];
    unsigned char* ws = (unsigned char*)d_ws;
    float* xf = (float*)d_out; float* ss = (float*)(ws + mk::WS_SS); bf16* xb = (bf16*)(ws + mk::WS_XB); bf16* zg = (bf16*)(ws + mk::WS_ZG); bf16* abuf = (bf16*)(ws + mk::WS_A);
    bf16* mix = (bf16*)(ws + mk::WS_MIX); float* tmpA = (float*)(ws + mk::WS_TMPA); float* tmpB = (float*)(ws + mk::WS_TMPB);
    if (hipMemsetAsync(ws + mk::WS_CTL, 0, mk::CTL_ZERO_BYTES, stream) != hipSuccess) { fprintf(stderr, "kernel_launch: memset failed\n"); return; }
    mk::Args a{}; for (int i = 0; i < 24; ++i) a.in[i] = in[i]; a.out = xf; a.ws = ws;
    int li = 0;
#define MK_RUN(lo, hi) do { a.ph_lo = (lo); a.ph_hi = (hi); a.li = li++; hipLaunchKernelGGL(mk::skel_fwd, dim3(grid), dim3(mk::NWAVES * 64), mk::LDS_BYTES, stream, a); } while (0)
#ifndef MK_DUP
#define MK_DUP 0
#endif
#define MK_DSEL 0
    if (MK_MODE == 0x7f) { a.pad = (MK_DUP << 8) | (MK_DSEL << 16) | (MK_EDUP << 24); MK_RUN(0, mk::N_PHASES); return; }
    MK_RUN(0, 1);
    for (int l = 0; l < L; ++l) {
        const float lam_init = 0.8f - 0.6f * expf(-0.3f * (float)l);
        float* ss1 = ss + (size_t)((2 * l) & 3) * T * 16; float* ss2 = ss + (size_t)((2 * l + 1) & 3) * T * 16; float* ss3 = (l + 1 < L) ? ss + (size_t)((2 * l + 2) & 3) * T * 16 : nullptr;
        const int pb = 1 + 6 * l;
        if (MK_MODE & 2) MK_RUN(pb, pb + 1);
        else for (int b = 0; b < B; ++b) { const int row0 = b * S;
            n_gemm<bf16><<<dim3(INW / 64, S / 64), 256, 0, stream>>>(xb + (size_t)row0 * D, D, in[1] + l * D, in[2] + (size_t)l * D * INW, INW, tmpA, INW, D);
            n_post_in<<<S, 256, 0, stream>>>(tmpA, ss1, in[3] + l * 64, in[4] + l * 64, in[6] + l * 64, in[7] + l * 64, zg, row0);
            n_gemm<bf16><<<dim3(GW / 64, S / 64), 256, 0, stream>>>(xb + (size_t)row0 * D, D, in[1] + l * D, in[14] + (size_t)l * D * GW, GW, tmpA, GW, D);
            n_post_gate<<<S, 256, 0, stream>>>(tmpA, ss1, in[15] + l * GW, zg, row0); }
        if (MK_MODE & 4) MK_RUN(pb + 1, pb + 2);
        else { n_attn_a<<<dim3(T, HA), 64, 0, stream>>>(zg, in[5] + l * HA, in[13]);
               n_attn_b<<<dim3(T, HB), 256, 0, stream>>>(zg, in[13], in[8] + l * 64, in[9] + l * 64, in[10] + l * 64, in[11] + l * 64, in[12] + l * 128, lam_init); }
        if (MK_MODE & 8) MK_RUN(pb + 2, pb + 3);
        else for (int b = 0; b < B; ++b) { const int row0 = b * S;
            n_gemm<bf16><<<dim3(D / 64, S / 64), 256, 0, stream>>>(zg + (size_t)row0 * ZG + C_QA, ZG, nullptr, in[16] + (size_t)l * 512 * D, D, tmpA, D, 512);
            n_gemm<bf16><<<dim3(D / 64, S / 64), 256, 0, stream>>>(zg + (size_t)row0 * ZG + C_QB, ZG, nullptr, in[17] + (size_t)l * 512 * D, D, tmpB, D, 512);
            n_post_mix<<<S, 256, 0, stream>>>(tmpA, tmpB, zg, mix, row0); }
        if (MK_MODE & 16) MK_RUN(pb + 3, pb + 4);
        else for (int b = 0; b < B; ++b) { const int row0 = b * S;
            n_gemm<bf16><<<dim3(D / 64, S / 64), 256, 0, stream>>>(mix + (size_t)row0 * D, D, nullptr, in[18] + (size_t)l * D * D, D, tmpA, D, D);
            n_post_res<<<S, 256, 0, stream>>>(tmpA, xf, xb, ss2, row0); }
        if ((MK_MODE & 32) && (MK_MODE & 64)) { MK_RUN(pb + 4, pb + 6); }
        else {
            for (int b = 0; b < B; ++b) { const int row0 = b * S;
                for (int hf = 0; hf < 2; ++hf) { const int j0 = hf * HW;
                    n_gemm<bf16><<<dim3(HW / 64, S / 64), 256, 0, stream>>>(xb + (size_t)row0 * D, D, in[19] + l * D, in[20] + (size_t)l * D * FF2 + j0, FF2, tmpA, 2 * HW, D);
                    n_gemm<bf16><<<dim3(HW / 64, S / 64), 256, 0, stream>>>(xb + (size_t)row0 * D, D, in[19] + l * D, in[20] + (size_t)l * D * FF2 + FF + j0, FF2, tmpA + HW, 2 * HW, D);
                    n_post_conv<<<S, 256, 0, stream>>>(tmpA, ss2, in[21] + (size_t)l * 3 * FF2, in[22] + (size_t)l * FF2, abuf, row0, j0); } }
            if (MK_MODE & 64) { a.pad = 1; MK_RUN(pb + 5, pb + 6); a.pad = 0; }
            else for (int b = 0; b < B; ++b) { const int row0 = b * S;
                n_gemm<bf16><<<dim3(D / 64, S / 64), 256, 0, stream>>>(abuf + (size_t)row0 * FF, FF, nullptr, in[23] + (size_t)l * FF * D, D, tmpA, D, FF);
                n_post_res<<<S, 256, 0, stream>>>(tmpA, xf, xb, ss3, row0); }
        }
    }
}
```

```cpp
#include <hip/hip_runtime.h>
#include <cstdio>
#include <cstdint>
#include <cmath>
#define MK_EDUP 0

namespace nv {
typedef unsigned short bf16;
constexpr int D = 1024, B = 8, S = 2048, T = B * S, L = 4;
constexpr int HA = 8, KVA = 2, HB = 4, HD = 64;
constexpr int INW = 2304, GW = 2048, ZG = INW + GW;
constexpr int FF = 2816, FF2 = 2 * FF;
constexpr int C_QA = 0, C_KA = 512, C_VA = 640, C_QB = 768, C_KB = 1280, C_VB = 1792, C_G = 2304;
constexpr float EPS = 1e-6f;
constexpr float LOG2E = 1.4426950408889634f;
constexpr float C2 = 0.125f * LOG2E;

__device__ __forceinline__ float bf2f(bf16 v) { return __uint_as_float(((unsigned)v) << 16); }
__device__ __forceinline__ bf16 f2bf(float f) { unsigned u = __float_as_uint(f); return (bf16)((u + 0x7fffu + ((u >> 16) & 1u)) >> 16); }
__device__ __forceinline__ float ldf(const float* p) { return *p; }
__device__ __forceinline__ float ldf(const bf16* p) { return bf2f(*p); }

__device__ __forceinline__ int t5_bucket(int rel) {
    const int n = rel < 0 ? -rel : rel; int v;
    if (n < 8) v = n; else if (n < 12) v = 8; else if (n < 16) v = 9; else if (n < 23) v = 10; else if (n < 32) v = 11;
    else if (n < 46) v = 12; else if (n < 64) v = 13; else if (n < 91) v = 14; else v = 15;
    return (rel > 0 ? 16 : 0) + v;
}
__device__ __forceinline__ float ss16(const float* ss, int t) { const float4* p = (const float4*)(ss + (size_t)t * 16); const float4 a = p[0], b = p[1], c = p[2], d = p[3];
    return ((a.x + a.y) + (a.z + a.w)) + ((b.x + b.y) + (b.z + b.w)) + ((c.x + c.y) + (c.z + c.w)) + ((d.x + d.y) + (d.z + d.w)); }
__device__ __forceinline__ float ss16_q(const float* ss, int t, int fq) { const float4 a = *(const float4*)(ss + (size_t)t * 16 + 4 * fq); float s = (a.x + a.y) + (a.z + a.w); s += __shfl_xor(s, 16); s += __shfl_xor(s, 32); return s; }
__device__ __forceinline__ void ss16_store(float* ss, int t, float s, int lane) { if (lane < 16) ss[(size_t)t * 16 + lane] = lane == 0 ? s : 0.f; }
__device__ __forceinline__ float wave_sum(float v) {
#pragma unroll
    for (int o = 1; o < 64; o <<= 1) v += __shfl_xor(v, o);
    return v;
}
__device__ __forceinline__ float wave_max(float v) {
#pragma unroll
    for (int o = 1; o < 64; o <<= 1) v = fmaxf(v, __shfl_xor(v, o));
    return v;
}

}


namespace pg8 {
using namespace nv;
#define PG8_LAS __attribute__((address_space(3)))
typedef unsigned short bf16_t;
typedef short bf16x8 __attribute__((ext_vector_type(8)));
typedef float f32x4 __attribute__((ext_vector_type(4)));
typedef unsigned u32x4 __attribute__((ext_vector_type(4)));
typedef unsigned u32x2 __attribute__((ext_vector_type(2)));
constexpr int BM = 256, BK = 64, HALF = 128, HTB = HALF * BK * 2  , STAGE_BYTES = 8 * HTB, NXCD = 8, WGM = 8;
constexpr int XOFF = 131072 + 1024;

__host__ __device__ __forceinline__ int lds_byte(int r, int c) { const int st = (r >> 4) * 2 + (c >> 5), rr = r & 15, cc = c & 31, ob = rr * 64 + cc * 2; return st * 1024 + (ob ^ (((ob >> 9) & 1) << 5)); }
__host__ __device__ __forceinline__ void stage_rc(int b, int& R, int& C) { const int st = b / 1024, sb = b % 1024, swz = sb ^ (((sb >> 9) & 1) << 5); R = (st >> 1) * 16 + swz / 64; C = (st & 1) * 32 + (swz % 64) / 2; }
__host__ __device__ __forceinline__ int perm32(int rho) { const int n = rho >> 4, i = rho & 15; return 8 * (i >> 2) + 4 * n + (i & 3); }

struct Unit { int pm, pn, z; };
typedef float f32x2 __attribute__((ext_vector_type(2))); typedef __bf16 bf16x2_t __attribute__((ext_vector_type(2)));
__device__ __forceinline__ unsigned cvt_pk_bf16(float lo, float hi) { f32x2 v = {lo, hi}; bf16x2_t b = __builtin_convertvector(v, bf16x2_t); return __builtin_bit_cast(unsigned, b); }
__device__ __forceinline__ float bflo(unsigned w) { return __uint_as_float(w << 16); }
__device__ __forceinline__ float bfhi(unsigned w) { return __uint_as_float(w & 0xffff0000u); }

struct SchedStd {
    int nM, nN, nwg, G, c, fix, one, opm, opn; const char* A; const char* Bt; size_t at, bt;
    __device__ void init(const void* A_, int lda, const void* Bt_, int K, int M, int N, int G_, int c_) { fix = 0; one = 0; opm = 0; opn = 0; nM = M / BM; nN = N / BM; nwg = nM * nN; G = G_; c = c_; A = (const char*)A_; Bt = (const char*)Bt_; at = (size_t)BM * lda * 2; bt = (size_t)BM * K * 2; }
    __device__ bool next(int i, Unit& u) const {
        if (one) { if (i > 0) return false; u.pm = opm; u.pn = opn; u.z = 0; return true; }
        const long L = (long)i * G + c; if (L >= nwg) return false;
        int wgid = (int)L; { const int q = nwg / NXCD, r = nwg % NXCD, xcd = wgid % NXCD, off = wgid / NXCD; wgid = (xcd < r ? xcd * (q + 1) : r * (q + 1) + (xcd - r) * q) + off; }
        const int nig = WGM * nN, gid = wgid / nig, fm = gid * WGM, gsz = (nM - fm) < WGM ? (nM - fm) : WGM;
        u.pm = fm + ((wgid % nig) % gsz); u.pn = (wgid % nig) / gsz; u.z = 0; if (fix) { u.pm = 0; u.pn = 0; } return true;
    }
    __device__ __forceinline__ const char* aptr(const Unit& u) const { return A + (size_t)u.pm * at; }
    __device__ __forceinline__ const char* bptr(const Unit& u) const { return Bt + (size_t)u.pn * bt; }
    __device__ __forceinline__ void a_ready(const Unit&) const {}
    __device__ __forceinline__ void done(const Unit&) const {}
};
struct SchedMix {
    SchedStd b; const char* A1; const char* Bt1;
    __device__ bool next(int i, Unit& u) const { if (!b.next(i >> 1, u)) return false; u.z = i & 1; return true; }
    __device__ __forceinline__ const char* aptr(const Unit& u) const { return (u.z ? A1 : b.A) + (size_t)u.pm * b.at; }
    __device__ __forceinline__ const char* bptr(const Unit& u) const { return (u.z ? Bt1 : b.Bt) + (size_t)u.pn * b.bt; }
    __device__ __forceinline__ void a_ready(const Unit&) const {}
    __device__ __forceinline__ void done(const Unit&) const {}
};
struct SchedDown {
    SchedStd b; const float* yb; const float* cw; const float* cb; bf16_t* a;
    __device__ bool next(int i, Unit& u) const { return b.next(i, u); }
    __device__ __forceinline__ const char* aptr(const Unit& u) const { return b.aptr(u); }
    __device__ __forceinline__ const char* bptr(const Unit& u) const { return b.bptr(u); }
    __device__ __forceinline__ void a_ready(const Unit& u) const {
        const int pm = u.pm;
        if (yb)
        for (int idx = threadIdx.x; idx < 2 * FF; idx += 512) {
            const int which = idx >= FF ? 1 : 0, j = idx - which * FF;
            float uv[2];
#pragma unroll
            for (int gs = 0; gs < 2; ++gs) {
                const int col = gs * FF + j; float y0, y1, y2;
                if (which == 0) { y0 = (pm & 7) ? yb[((size_t)(pm - 1) * 4 + 3) * FF2 + col] : 0.f; y1 = yb[((size_t)pm * 4 + 0) * FF2 + col]; y2 = yb[((size_t)pm * 4 + 1) * FF2 + col]; }
                else { y0 = yb[((size_t)pm * 4 + 2) * FF2 + col]; y1 = yb[((size_t)pm * 4 + 3) * FF2 + col]; y2 = ((pm & 7) != 7) ? yb[((size_t)(pm + 1) * 4 + 0) * FF2 + col] : 0.f; }
                uv[gs] = cb[col] + cw[col] * y0 + cw[FF2 + col] * y1 + cw[2 * FF2 + col] * y2;
            }
            const float sg = uv[1] * __builtin_amdgcn_rcpf(1.0f + __builtin_amdgcn_exp2f(-uv[1] * LOG2E));
            a[(size_t)(pm * BM + which * 255) * FF + j] = f2bf(sg * uv[0]);
        }
        asm volatile("s_waitcnt vmcnt(0)" ::: "memory");
        __builtin_amdgcn_s_barrier();
        asm volatile("" ::: "memory");
    }
    __device__ __forceinline__ void done(const Unit&) const {}
};

struct EpiIn {
    static constexpr bool PERM = true, AFTER_DRAIN = false;
    __device__ static constexpr bool zero_after(const Unit&) { return true; }
    bf16_t* zg; const float* ss; const float *qn_a, *kn_a, *qn_b, *kn_b, *bg; int dup;
    __device__ __forceinline__ void operator()(f32x4 (&acc)[2][2][4][2], const Unit& u, int wr, int wc, int fr, int fq, PG8_LAS unsigned char*) const {
#pragma unroll
        for (int rep_ = 0; rep_ <= ((MK_EDUP & 2) ? 1 : 0); ++rep_) {
        if (rep_) {
#pragma unroll
            for (int ai = 0; ai < 2; ++ai)
#pragma unroll
                for (int bj = 0; bj < 2; ++bj)
#pragma unroll
                    for (int m = 0; m < 4; ++m)
#pragma unroll
                        for (int n = 0; n < 2; ++n) asm volatile("" : "+v"(acc[ai][bj][m][n]) :: "memory");
        }
        const int g = u.pn * 4 + wc, colb = u.pn * BM + wc * 64 + 8 * fq;
        const float* gain = nullptr; float sc = 1.f; int mode = 0;
        if (g < 8) { gain = qn_a; sc = C2; mode = 1; } else if (g < 10) { gain = kn_a; mode = 1; } else if (g < 12) { mode = 0; } else if (g < 20) { gain = qn_b; sc = C2; mode = 1; }
        else if (g < 28) { gain = kn_b; mode = 1; } else if (g < 36) { mode = 0; } else { mode = 2; }
        float rsv[2][4];
#pragma unroll
        for (int ai = 0; ai < 2; ++ai)
#pragma unroll
            for (int m = 0; m < 4; ++m) rsv[ai][m] = rsqrtf(ss16_q(ss, u.pm * BM + ai * HALF + wr * 64 + m * 16 + fr, fq) * (1.0f / D) + EPS);
        f32x4 gv[2][2];
#pragma unroll
        for (int bj = 0; bj < 2; ++bj)
#pragma unroll
            for (int n = 0; n < 2; ++n) {
                if (mode == 1) gv[bj][n] = *(const f32x4*)(gain + 32 * bj + 8 * fq + 4 * n) * sc;
                else if (mode == 2) gv[bj][n] = *(const f32x4*)(bg + (colb - C_G) + 32 * bj + 4 * n);
                else gv[bj][n] = (f32x4){1.f, 1.f, 1.f, 1.f};
            }
#pragma unroll
        for (int ai = 0; ai < 2; ++ai)
#pragma unroll
            for (int m = 0; m < 4; ++m) {
                const int row = u.pm * BM + ai * HALF + wr * 64 + m * 16 + fr;
                const float rs = rsv[ai][m];
                f32x4 v[2][2];
#pragma unroll
                for (int bj = 0; bj < 2; ++bj)
#pragma unroll
                    for (int n = 0; n < 2; ++n) v[bj][n] = acc[ai][bj][m][n] * rs;
                if (mode == 1) {
                    float q = 0.f;
#pragma unroll
                    for (int bj = 0; bj < 2; ++bj)
#pragma unroll
                        for (int n = 0; n < 2; ++n) { const f32x4 x = v[bj][n]; q += (x[0] * x[0] + x[1] * x[1]) + (x[2] * x[2] + x[3] * x[3]); }
                    q += __shfl_xor(q, 16); q += __shfl_xor(q, 32);
                    const float r2 = rsqrtf(q * (1.0f / 64.0f) + EPS);
#pragma unroll
                    for (int bj = 0; bj < 2; ++bj)
#pragma unroll
                        for (int n = 0; n < 2; ++n) v[bj][n] = v[bj][n] * r2 * gv[bj][n];
                } else if (mode == 2) {
#pragma unroll
                    for (int bj = 0; bj < 2; ++bj)
#pragma unroll
                        for (int n = 0; n < 2; ++n) { f32x4 x = v[bj][n] + gv[bj][n];
#pragma unroll
                            for (int e = 0; e < 4; ++e) x[e] = __builtin_fmaxf(__builtin_amdgcn_rcpf(1.0f + __builtin_amdgcn_exp2f(-x[e] * LOG2E)), 9.5367431640625e-07f);
                            v[bj][n] = x; }
                }
                bf16_t* rowp = zg + (size_t)row * ZG + colb;
#pragma unroll
                for (int bj = 0; bj < 2; ++bj) { u32x4 w; w.x = cvt_pk_bf16(v[bj][0][0], v[bj][0][1]); w.y = cvt_pk_bf16(v[bj][0][2], v[bj][0][3]); w.z = cvt_pk_bf16(v[bj][1][0], v[bj][1][1]); w.w = cvt_pk_bf16(v[bj][1][2], v[bj][1][3]);
                    *(u32x4*)(rowp + 32 * bj) = w; }
            }
        }
    }
};
struct EpiMix {
    static constexpr bool PERM = true, AFTER_DRAIN = false;
    __device__ static bool zero_after(const Unit& u) { return u.z != 0; }
    const bf16_t* zg; bf16_t* mix;
    __device__ __forceinline__ void operator()(f32x4 (&acc)[2][2][4][2], const Unit& u, int wr, int wc, int fr, int fq, PG8_LAS unsigned char*) const {
        const int col0 = u.pn * BM + wc * 32 + 8 * fq;
#pragma unroll
        for (int ai = 0; ai < 2; ++ai) {
            u32x4 gbv[4][2], gav[4][2];
#pragma unroll
            for (int m = 0; m < 4; ++m)
#pragma unroll
                for (int bj = 0; bj < 2; ++bj) { const size_t go = (size_t)(u.pm * BM + ai * HALF + wr * 64 + m * 16 + fr) * ZG + C_G + col0 + bj * HALF;
                    gbv[m][bj] = *(const u32x4*)(zg + go + D); if (u.z == 0) gav[m][bj] = *(const u32x4*)(zg + go); else gav[m][bj] = (u32x4){0u, 0u, 0u, 0u}; }
#pragma unroll
            for (int m = 0; m < 4; ++m) {
                const int row = u.pm * BM + ai * HALF + wr * 64 + m * 16 + fr;
#pragma unroll
                for (int bj = 0; bj < 2; ++bj) {
                    const int col = col0 + bj * HALF;
                    const u32x4 gb = gbv[m][bj];
                    if (u.z == 0) {
                        const u32x4 ga = gav[m][bj];
                        f32x4 r0, r1;
                        r0[0] = bflo(ga.x) * __builtin_amdgcn_rcpf(bflo(gb.x)); r0[1] = bfhi(ga.x) * __builtin_amdgcn_rcpf(bfhi(gb.x)); r0[2] = bflo(ga.y) * __builtin_amdgcn_rcpf(bflo(gb.y)); r0[3] = bfhi(ga.y) * __builtin_amdgcn_rcpf(bfhi(gb.y));
                        r1[0] = bflo(ga.z) * __builtin_amdgcn_rcpf(bflo(gb.z)); r1[1] = bfhi(ga.z) * __builtin_amdgcn_rcpf(bfhi(gb.z)); r1[2] = bflo(ga.w) * __builtin_amdgcn_rcpf(bflo(gb.w)); r1[3] = bfhi(ga.w) * __builtin_amdgcn_rcpf(bfhi(gb.w));
                        acc[ai][bj][m][0] *= r0; acc[ai][bj][m][1] *= r1;
                    } else {
                        const f32x4 v0 = acc[ai][bj][m][0] * (f32x4){bflo(gb.x), bfhi(gb.x), bflo(gb.y), bfhi(gb.y)}, v1 = acc[ai][bj][m][1] * (f32x4){bflo(gb.z), bfhi(gb.z), bflo(gb.w), bfhi(gb.w)};
                        u32x4 w; w.x = cvt_pk_bf16(v0[0], v0[1]); w.y = cvt_pk_bf16(v0[2], v0[3]); w.z = cvt_pk_bf16(v1[0], v1[1]); w.w = cvt_pk_bf16(v1[2], v1[3]);
                        *(u32x4*)(mix + (size_t)row * D + col) = w;
                    }
                }
            }
            asm volatile("" ::: "memory");
        }
    }
};
struct EpiRes {
    static constexpr bool PERM = false, AFTER_DRAIN = false;
    __device__ static constexpr bool zero_after(const Unit&) { return true; }
    const float* base; float* xf; bf16_t* xb; float* ssn;
    __device__ __forceinline__ void operator()(f32x4 (&acc)[2][2][4][2], const Unit& u, int wr, int wc, int fr, int fq, PG8_LAS unsigned char*) const {
        const int col0 = u.pn * BM + wc * 32 + 4 * fq;
#pragma unroll
        for (int ai = 0; ai < 2; ++ai)
#pragma unroll
            for (int m = 0; m < 4; ++m) {
                const int row = u.pm * BM + ai * HALF + wr * 64 + m * 16 + fr; const size_t off = (size_t)row * D + col0; float q = 0.f;
#pragma unroll
                for (int bj = 0; bj < 2; ++bj)
#pragma unroll
                    for (int n = 0; n < 2; ++n) { const f32x4 bs = *(const f32x4*)(base + off + bj * HALF + n * 16); const f32x4 o = bs + acc[ai][bj][m][n];
                        *(f32x4*)(xf + off + bj * HALF + n * 16) = o; q += (o[0] * o[0] + o[1] * o[1]) + (o[2] * o[2] + o[3] * o[3]);
                        if (xb) { u32x2 w; w.x = cvt_pk_bf16(o[0], o[1]); w.y = cvt_pk_bf16(o[2], o[3]); *(u32x2*)(xb + off + bj * HALF + n * 16) = w; } }
                if (ssn) { q += __shfl_xor(q, 16); q += __shfl_xor(q, 32); if (fq == 0) ssn[(size_t)row * 16 + u.pn * 4 + wc] = q; }
                if (m == 3) asm volatile("" ::: "memory");
            }
    }
};
#define DPPF(oldv, src, ctrl, bc) __int_as_float(__builtin_amdgcn_update_dpp(__float_as_int(oldv), __float_as_int(src), (ctrl), 0xF, 0xF, (bc)))
struct EpiUp {
    static constexpr bool PERM = true, AFTER_DRAIN = false;
    __device__ static constexpr bool zero_after(const Unit&) { return true; }
    bf16_t* a; const float* ss; const float* cw; const float* cb; float* yb; int dup;
    __device__ __forceinline__ void operator()(f32x4 (&acc)[2][2][4][2], const Unit& u, int wr, int wc, int fr, int fq, PG8_LAS unsigned char* lds) const {
        const int wid = wr * 4 + wc;
        PG8_LAS float* X = (PG8_LAS float*)(lds + XOFF);
        float rsv[2][4];
#pragma unroll
        for (int ai = 0; ai < 2; ++ai)
#pragma unroll
            for (int m = 0; m < 4; ++m) rsv[ai][m] = rsqrtf(ss16_q(ss, u.pm * BM + ai * HALF + wr * 64 + m * 16 + fr, fq) * (1.0f / D) + EPS);
#pragma unroll
        for (int ai = 0; ai < 2; ++ai)
#pragma unroll
            for (int m = 0; m < 4; ++m) {
#pragma unroll
                for (int bj = 0; bj < 2; ++bj)
#pragma unroll
                    for (int n = 0; n < 2; ++n) acc[ai][bj][m][n] *= rsv[ai][m];
            }
#pragma unroll
        for (int ai = 0; ai < 2; ++ai) {
            if (fr == 0) {
#pragma unroll
                for (int bj = 0; bj < 2; ++bj)
#pragma unroll
                    for (int n = 0; n < 2; ++n) *(PG8_LAS f32x4*)(X + ((wid * 2 + ai) * 2 + 0) * 64 + 32 * bj + 8 * fq + 4 * n) = acc[ai][bj][0][n];
            }
            if (fr == 15) {
#pragma unroll
                for (int bj = 0; bj < 2; ++bj)
#pragma unroll
                    for (int n = 0; n < 2; ++n) *(PG8_LAS f32x4*)(X + ((wid * 2 + ai) * 2 + 1) * 64 + 32 * bj + 8 * fq + 4 * n) = acc[ai][bj][3][n];
            }
        }
        {
            const int ccol = u.pn * 128 + wc * 32 + 8 * fq;
            if (wr == 0 && fr < 2) {
#pragma unroll
                for (int bj = 0; bj < 2; ++bj)
#pragma unroll
                    for (int n = 0; n < 2; ++n) *(f32x4*)(yb + ((size_t)u.pm * 4 + fr) * FF2 + bj * FF + ccol + 4 * n) = acc[0][bj][0][n];
            }
            if (wr == 1 && fr >= 14) {
#pragma unroll
                for (int bj = 0; bj < 2; ++bj)
#pragma unroll
                    for (int n = 0; n < 2; ++n) *(f32x4*)(yb + ((size_t)u.pm * 4 + 2 + (fr - 14)) * FF2 + bj * FF + ccol + 4 * n) = acc[1][bj][3][n];
            }
        }
        asm volatile("s_waitcnt lgkmcnt(0)" ::: "memory"); __builtin_amdgcn_s_barrier(); asm volatile("" ::: "memory");
#pragma unroll
        for (int rep_ = 0; rep_ <= ((MK_EDUP & 1) ? 1 : 0); ++rep_) {
        if (rep_) {
#pragma unroll
            for (int ai = 0; ai < 2; ++ai)
#pragma unroll
                for (int bj = 0; bj < 2; ++bj)
#pragma unroll
                    for (int m = 0; m < 4; ++m)
#pragma unroll
                        for (int n = 0; n < 2; ++n) asm volatile("" : "+v"(acc[ai][bj][m][n]) :: "memory");
        }
#pragma unroll
        for (int n = 0; n < 2; ++n) {
            const int ccol = u.pn * 128 + wc * 32 + 8 * fq + 4 * n;
            f32x4 w0[2], w1[2], w2[2], bb[2];
#pragma unroll
            for (int bj = 0; bj < 2; ++bj) { w0[bj] = *(const f32x4*)(cw + bj * FF + ccol); w1[bj] = *(const f32x4*)(cw + FF2 + bj * FF + ccol); w2[bj] = *(const f32x4*)(cw + 2 * FF2 + bj * FF + ccol); bb[bj] = *(const f32x4*)(cb + bj * FF + ccol); }
#pragma unroll
            for (int ai = 0; ai < 2; ++ai) {
                const int pw = wr ? wid - 4 : wid + 4, pai = wr ? ai : 0;
                const int nw = wr ? wid - 4 : wid + 4, nai = wr ? 1 : ai;
                f32x4 xp[2], xn[2];
#pragma unroll
                for (int bj = 0; bj < 2; ++bj) { xp[bj] = *(PG8_LAS f32x4*)(X + ((pw * 2 + pai) * 2 + 1) * 64 + 32 * bj + 8 * fq + 4 * n); xn[bj] = *(PG8_LAS f32x4*)(X + ((nw * 2 + nai) * 2 + 0) * 64 + 32 * bj + 8 * fq + 4 * n); }
#pragma unroll
                for (int m = 0; m < 4; ++m) {
                    const int trow = ai * HALF + wr * 64 + m * 16 + fr;
                    float uv[2][4];
#pragma unroll
                    for (int bj = 0; bj < 2; ++bj)
#pragma unroll
                        for (int e = 0; e < 4; ++e) {
                            const float cur = acc[ai][bj][m][n][e];
                            float rp, rn;
                            if (m > 0) rp = DPPF(0.f, acc[ai][bj][m > 0 ? m - 1 : 0][n][e], 0x121, true); else rp = xp[bj][e];
                            if (m < 3) rn = DPPF(0.f, acc[ai][bj][m < 3 ? m + 1 : 3][n][e], 0x12F, true); else rn = xn[bj][e];
                            const float prev = DPPF(rp, cur, 0x111, false), next = DPPF(rn, cur, 0x101, false);
                            uv[bj][e] = bb[bj][e] + w0[bj][e] * prev + w1[bj][e] * cur + w2[bj][e] * next;
                        }
                    f32x4 o;
#pragma unroll
                    for (int e = 0; e < 4; ++e) o[e] = uv[0][e] * uv[1][e] * __builtin_amdgcn_rcpf(1.0f + __builtin_amdgcn_exp2f(-uv[1][e] * LOG2E));
                    u32x2 w; w.x = cvt_pk_bf16(o[0], o[1]); w.y = cvt_pk_bf16(o[2], o[3]);
                    if (trow != 0 && trow != 255) *(u32x2*)(a + (size_t)(u.pm * BM + trow) * FF + ccol) = w;
                    asm volatile("" ::: "memory");
                }
            }
        }
        }
    }
};

template <class Epi, class Sched, bool ALIGN_EPI = false, bool SP2 = false>
__device__ __forceinline__ void gemm_phase(PG8_LAS unsigned char* lds, const int K, const int lda, const Sched& S, const Epi& E) {
    int tid_ = threadIdx.x; asm volatile("" : "+v"(tid_));
    const int tid = tid_, wid = __builtin_amdgcn_readfirstlane(tid >> 6), lane = tid & 63, wr = wid >> 2, wc = wid & 3, fr = lane & 15, fq = lane >> 4;
    const int nt = K / BK;
    unsigned voffA[2], voffB[2];
#pragma unroll
    for (int i = 0; i < 2; ++i) { int R, C; stage_rc(tid * 16 + i * 8192, R, C); const int Rb = Epi::PERM ? ((R & ~31) + perm32(R & 31)) : R;
        voffA[i] = (unsigned)(R * lda + C) * 2u; voffB[i] = (unsigned)(Rb * K + C) * 2u; }
    const size_t kstep = (size_t)(BK * 2);
    const size_t hstepB = (size_t)HALF * K * 2;
    const size_t hstepA = (size_t)HALF * lda * 2;
    const unsigned ldsw = (unsigned)wid * 1024u;
    const int aoff = lds_byte(wr * 64 + fr, fq * 8), boff = lds_byte(wc * 32 + fr, fq * 8);
#define PG8_SA(b, h) (((b) * 2 + (h)) * HTB)
#define PG8_SB(b, h) ((4 + (b) * 2 + (h)) * HTB)
#define PG8_STAGE(bufoff, gbase, voff) do { _Pragma("unroll") for (int _i = 0; _i < 2; ++_i) \
        __builtin_amdgcn_global_load_lds((const unsigned*)((const char*)(gbase) + (voff)[_i]), (PG8_LAS unsigned*)(lds + (bufoff) + ldsw + _i * 8192), 16, 0, 0); } while (0)
#define PG8_LDA(dst, b, h) do { _Pragma("unroll") for (int m = 0; m < 4; ++m) _Pragma("unroll") for (int k = 0; k < 2; ++k) dst[m][k] = *(const PG8_LAS bf16x8*)(lds + PG8_SA(b, h) + aoff + m * 2048 + k * 1024); } while (0)
#define PG8_LDB(dst, b, h) do { _Pragma("unroll") for (int n = 0; n < 2; ++n) _Pragma("unroll") for (int k = 0; k < 2; ++k) dst[n][k] = *(const PG8_LAS bf16x8*)(lds + PG8_SB(b, h) + boff + n * 2048 + k * 1024); } while (0)
#define PG8_MMA(ai, bj, At, Bt) do { __builtin_amdgcn_s_setprio(1); _Pragma("unroll") for (int m = 0; m < 4; ++m) _Pragma("unroll") for (int n = 0; n < 2; ++n) _Pragma("unroll") for (int k = 0; k < 2; ++k) \
        acc[ai][bj][m][n] = __builtin_amdgcn_mfma_f32_16x16x32_bf16(Bt[n][k], At[m][k], acc[ai][bj][m][n], 0, 0, 0); __builtin_amdgcn_s_setprio(0); } while (0)
#define PG8_WAIT_V(n) asm volatile("s_waitcnt vmcnt(" #n ")" ::: "memory")
#define PG8_WAIT_L(n) asm volatile("s_waitcnt lgkmcnt(" #n ")" ::: "memory")
#define PG8_BAR __builtin_amdgcn_s_barrier()
#define PG8_SCHED __builtin_amdgcn_sched_barrier(0)
    Unit cur, nxt; int ui = 0;
    if (!S.next(0, cur)) return;
    f32x4 acc[2][2][4][2];
#pragma unroll
    for (int a = 0; a < 2; ++a)
#pragma unroll
        for (int b = 0; b < 2; ++b)
#pragma unroll
            for (int m = 0; m < 4; ++m)
#pragma unroll
                for (int n = 0; n < 2; ++n) acc[a][b][m][n] = (f32x4){0.f, 0.f, 0.f, 0.f};
    bf16x8 At[4][2], B0[2][2], B1[2][2];
    const char* cA = S.aptr(cur); const char* cB = S.bptr(cur);
    S.a_ready(cur);
    if constexpr (SP2) {
        PG8_STAGE(PG8_SB(0, 0), cB, voffB); PG8_STAGE(PG8_SB(0, 1), cB + hstepB, voffB); PG8_STAGE(PG8_SA(0, 0), cA, voffA); PG8_STAGE(PG8_SA(0, 1), cA + hstepA, voffA);
        if (wr == 1) PG8_BAR;
        PG8_WAIT_V(2); PG8_BAR;
        PG8_STAGE(PG8_SB(1, 0), cB + kstep, voffB); PG8_STAGE(PG8_SA(1, 0), cA + kstep, voffA); PG8_STAGE(PG8_SB(1, 1), cB + hstepB + kstep, voffB);
        PG8_WAIT_V(6); PG8_BAR;
    } else {
        PG8_STAGE(PG8_SB(0, 0), cB, voffB); PG8_STAGE(PG8_SA(0, 0), cA, voffA); PG8_STAGE(PG8_SB(0, 1), cB + hstepB, voffB); PG8_STAGE(PG8_SA(0, 1), cA + hstepA, voffA);
        if (wr == 1) PG8_BAR;
        PG8_WAIT_V(4); PG8_BAR;
        PG8_STAGE(PG8_SB(1, 0), cB + kstep, voffB); PG8_STAGE(PG8_SA(1, 0), cA + kstep, voffA); PG8_STAGE(PG8_SB(1, 1), cB + hstepB + kstep, voffB);
        PG8_WAIT_V(6); PG8_BAR;
    }
    for (;;) {
        const bool has_next = S.next(ui + 1, nxt);
        const char* nA = has_next ? S.aptr(nxt) : cA; const char* nB = has_next ? S.bptr(nxt) : cB;
        for (int t = 0; t < nt; t += 2) {
            const bool last = (t == nt - 2);
            const char* a1 = cA + (size_t)(t + 1) * kstep;
            const char* a2 = last ? nA : cA + (size_t)(t + 2) * kstep; const char* b2 = last ? nB : cB + (size_t)(t + 2) * kstep;
            const char* a3 = a2 + kstep; const char* b3 = b2 + kstep;
            if (last && has_next) S.a_ready(nxt);
            if constexpr (SP2) {
            PG8_LDB(B0, 0, 0); PG8_LDB(B1, 0, 1); PG8_SCHED; PG8_LDA(At, 0, 0); PG8_STAGE(PG8_SA(1, 1), a1 + hstepA, voffA);
            PG8_WAIT_V(8); PG8_WAIT_L(0); PG8_BAR; PG8_MMA(0, 0, At, B0); PG8_MMA(0, 1, At, B1); PG8_BAR; PG8_SCHED;
            PG8_LDA(At, 0, 1); PG8_STAGE(PG8_SB(0, 0), b2, voffB); PG8_STAGE(PG8_SB(0, 1), b2 + hstepB, voffB); PG8_STAGE(PG8_SA(0, 0), a2, voffA);
            PG8_WAIT_V(8); PG8_WAIT_L(0); PG8_BAR; PG8_MMA(1, 0, At, B0); PG8_MMA(1, 1, At, B1); PG8_BAR; PG8_SCHED;
            PG8_LDB(B0, 1, 0); PG8_LDB(B1, 1, 1); PG8_SCHED; PG8_LDA(At, 1, 0); PG8_STAGE(PG8_SA(0, 1), a2 + hstepA, voffA);
            PG8_WAIT_V(8); PG8_WAIT_L(0); PG8_BAR; PG8_MMA(0, 0, At, B0); PG8_MMA(0, 1, At, B1); PG8_BAR; PG8_SCHED;
            PG8_LDA(At, 1, 1); PG8_STAGE(PG8_SB(1, 0), b3, voffB); PG8_STAGE(PG8_SB(1, 1), b3 + hstepB, voffB); PG8_STAGE(PG8_SA(1, 0), a3, voffA);
            PG8_WAIT_V(8); PG8_WAIT_L(0); PG8_BAR; PG8_MMA(1, 0, At, B0); PG8_MMA(1, 1, At, B1); PG8_BAR; PG8_SCHED;
            } else {
            PG8_LDB(B0, 0, 0); PG8_SCHED; PG8_LDA(At, 0, 0); PG8_STAGE(PG8_SA(1, 1), a1 + hstepA, voffA);
            PG8_WAIT_L(8); PG8_BAR; PG8_WAIT_L(0); PG8_MMA(0, 0, At, B0); PG8_BAR; PG8_SCHED;
            PG8_LDB(B1, 0, 1); PG8_STAGE(PG8_SB(0, 0), b2, voffB);
            PG8_BAR; PG8_WAIT_L(0); PG8_MMA(0, 1, At, B1); PG8_BAR;
            PG8_LDA(At, 0, 1); PG8_STAGE(PG8_SA(0, 0), a2, voffA);
            PG8_BAR; PG8_WAIT_L(0); PG8_MMA(1, 0, At, B0); PG8_BAR; PG8_SCHED;
            PG8_STAGE(PG8_SB(0, 1), b2 + hstepB, voffB);
            PG8_WAIT_V(6); PG8_BAR; PG8_MMA(1, 1, At, B1); PG8_BAR;
            PG8_LDB(B0, 1, 0); PG8_SCHED; PG8_LDA(At, 1, 0); PG8_STAGE(PG8_SA(0, 1), a2 + hstepA, voffA);
            PG8_WAIT_L(8); PG8_BAR; PG8_WAIT_L(0); PG8_MMA(0, 0, At, B0); PG8_BAR; PG8_SCHED;
            PG8_LDB(B1, 1, 1); PG8_STAGE(PG8_SB(1, 0), b3, voffB);
            PG8_BAR; PG8_WAIT_L(0); PG8_MMA(0, 1, At, B1); PG8_BAR;
            PG8_LDA(At, 1, 1); PG8_STAGE(PG8_SA(1, 0), a3, voffA);
            PG8_BAR; PG8_WAIT_L(0); PG8_MMA(1, 0, At, B0); PG8_BAR; PG8_SCHED;
            PG8_STAGE(PG8_SB(1, 1), b3 + hstepB, voffB);
            PG8_WAIT_V(6); PG8_BAR; PG8_MMA(1, 1, At, B1); PG8_BAR;
            }
        }
        if constexpr (ALIGN_EPI) { if (wr == 0) PG8_BAR; }
        if constexpr (!Epi::AFTER_DRAIN) { E(acc, cur, wr, wc, fr, fq, lds); S.done(cur); }
        if (!has_next) break;
        if (Epi::zero_after(cur)) {
#pragma unroll
        for (int a = 0; a < 2; ++a)
#pragma unroll
            for (int b = 0; b < 2; ++b)
#pragma unroll
                for (int m = 0; m < 4; ++m)
#pragma unroll
                    for (int n = 0; n < 2; ++n) acc[a][b][m][n] = (f32x4){0.f, 0.f, 0.f, 0.f};
        }
        cur = nxt; cA = nA; cB = nB; ++ui;
        if constexpr (ALIGN_EPI) { if (wr == 1) PG8_BAR; }
    }
    PG8_WAIT_V(0);
    if constexpr (!ALIGN_EPI) { if (wr == 0) PG8_BAR; }
    PG8_BAR;
    if constexpr (Epi::AFTER_DRAIN) { E.fused(acc, cur, wr, wc, fr, fq, lds, wid, lane); S.done(cur); }
#undef PG8_SA
#undef PG8_SB
#undef PG8_STAGE
#undef PG8_LDA
#undef PG8_LDB
#undef PG8_MMA
#undef PG8_WAIT_V
#undef PG8_WAIT_L
#undef PG8_BAR
#undef PG8_SCHED
}
}

namespace att {
using namespace nv;
#define ALAS __attribute__((address_space(3)))
typedef short bf16x8 __attribute__((ext_vector_type(8)));
typedef short s16x4 __attribute__((ext_vector_type(4)));
typedef float f32x16 __attribute__((ext_vector_type(16)));
typedef float f32x4 __attribute__((ext_vector_type(4)));
typedef unsigned u32x4 __attribute__((ext_vector_type(4)));
typedef unsigned u32x2 __attribute__((ext_vector_type(2)));
typedef short v4i16_t __attribute__((ext_vector_type(4)));
typedef float f32x2_t __attribute__((ext_vector_type(2))); typedef __bf16 bf16x2_t __attribute__((ext_vector_type(2)));
constexpr int LUT_OFF = 98304, LUT_STRIDE = 520, GT_OFF = LUT_OFF + 12 * LUT_STRIDE * 4;
static_assert(GT_OFF + 512 <= 131072, "attention tables inside the ring region");
constexpr float NEG = -30000.f, THR = 6.f;
__device__ __forceinline__ unsigned cvtpk(float lo, float hi) { f32x2_t v = {lo, hi}; bf16x2_t b = __builtin_convertvector(v, bf16x2_t); return __builtin_bit_cast(unsigned, b); }
__device__ __forceinline__ s16x4 vtr(ALAS const unsigned char* p) { return __builtin_bit_cast(s16x4, __builtin_amdgcn_ds_read_tr16_b64_v4i16((ALAS v4i16_t*)p)); }
__device__ __forceinline__ void glds16(const void* gsrc, unsigned lds_dst) { unsigned keep;
    asm volatile("s_mov_b32 %0, m0\n\ts_mov_b32 m0, %2\n\ts_nop 0\n\tglobal_load_lds_dwordx4 %1, off\n\ts_mov_b32 m0, %0" : "=&s"(keep) : "v"(gsrc), "s"(lds_dst) : "memory"); }
__device__ __forceinline__ float swap_add(float v) { auto rr = __builtin_amdgcn_permlane32_swap(__float_as_uint(v), __float_as_uint(v), false, false); return __uint_as_float(rr[0]) + __uint_as_float(rr[1]); }
__device__ __forceinline__ float swap_max(float v) { auto rr = __builtin_amdgcn_permlane32_swap(__float_as_uint(v), __float_as_uint(v), false, false); return fmaxf(__uint_as_float(rr[0]), __uint_as_float(rr[1])); }
#define MX3(a, b, c) __builtin_fmaxf(__builtin_fmaxf((a), (b)), (c))

__device__ __forceinline__ void attn_tables(ALAS unsigned char* lds, const float* __restrict__ lutg, const float* __restrict__ subg, float osc) {
    int tid = threadIdx.x; asm volatile("" : "+v"(tid));
    ALAS float* lut = (ALAS float*)(lds + LUT_OFF); ALAS float* gt = (ALAS float*)(lds + GT_OFF);
    for (int i = tid; i < 12 * LUT_STRIDE; i += 512) lut[i] = lutg[i];
    if (tid < 128) gt[tid] = subg[tid] * osc;
    __syncthreads();
}
__device__ __forceinline__ float g4_max(float v) { v = fmaxf(v, __shfl_xor(v, 16)); return fmaxf(v, __shfl_xor(v, 32)); }
__device__ __forceinline__ float g4_sum(float v) { v += __shfl_xor(v, 16); return v + __shfl_xor(v, 32); }

template <bool ISB, int VAR = 0>
__device__ __forceinline__ void attn_unit(ALAS unsigned char* lds, bf16* zg, const float* __restrict__ lutg, int b, int hsel, int q0, const float* __restrict__ sinkp, float lam, float osc, const float* __restrict__ subg, bf16* odry) {
    int tid_ = threadIdx.x; asm volatile("" : "+v"(tid_));
    const int tid = tid_, lane = tid & 63, c16 = lane & 15, g = lane >> 4; const int wid = __builtin_amdgcn_readfirstlane(tid >> 6);
    constexpr int NDVB = ISB ? 8 : 4, BUF = ISB ? 32768 : 16384, VOFF = ISB ? 16384 : 8192, VROW = ISB ? 256 : 128;
    const int map = ISB ? (wid >> 2) : 0, qsub = ISB ? (wid & 3) : (wid & 1), gsel = ISB ? 0 : (wid >> 1);
    const int head = ISB ? hsel : hsel * 4 + gsel;
    const int qrow0 = q0 + 32 * qsub;
    const int qcol = ISB ? (C_QB + head * 128 + map * 64) : (C_QA + head * 64);
    const int kcol = ISB ? (C_KB + head * 128) : (C_KA + hsel * 64);
    const int vcol = ISB ? (C_VB + head * 128) : (C_VA + hsel * 64);
    const size_t rowbase = (size_t)b * S;
    int kt0 = 0, kt1 = S / 64;
    if (!ISB) { kt0 = q0 / 64 - 2; if (kt0 < 0) kt0 = 0; kt1 = q0 / 64 + 3; if (kt1 > S / 64) kt1 = S / 64; }
    const int nt = kt1 - kt0;
    ALAS float* lut = (ALAS float*)(lds + LUT_OFF) + (ISB ? 8 + head : hsel * 4 + gsel) * LUT_STRIDE;
    ALAS float* gt = (ALAS float*)(lds + GT_OFF);
    const float sink2 = ISB ? 0.f : sinkp[head] * LOG2E;
    bf16x8 qr[2][2];
#pragma unroll
    for (int qb = 0; qb < 2; ++qb) { const bf16* qp = zg + (rowbase + qrow0 + 16 * qb + c16) * ZG + qcol + 8 * g;
#pragma unroll
        for (int ks = 0; ks < 2; ++ks) qr[qb][ks] = *(const bf16x8*)(qp + 32 * ks); }
    const unsigned lds0 = (unsigned)(size_t)lds;
    const bf16* kp_[2]; const bf16* vp_[2];
#pragma unroll
    for (int i_ = 0; i_ < 2; ++i_) { const int p_ = ISB ? wid * 2 + i_ : wid;
        kp_[i_] = zg + (rowbase + (size_t)kt0 * 64 + (p_ & 7) * 8 + (lane >> 3)) * ZG + kcol + (ISB ? (p_ >> 3) * 64 : 0) + ((lane & 7) ^ (lane >> 3)) * 8;
        vp_[i_] = ISB ? zg + (rowbase + (size_t)kt0 * 64 + 4 * p_ + (lane >> 4)) * ZG + vcol + ((((lane & 15) >> 1) ^ (4 * (p_ & 1) + (lane >> 4))) * 16) + 8 * (lane & 1)
                      : zg + (rowbase + (size_t)kt0 * 64 + 8 * p_ + (lane >> 3)) * ZG + vcol + ((((lane & 7) >> 1) ^ ((lane >> 4) & 3)) * 16) + 8 * (lane & 1); }
#define ATT_ISSUE(bo) do { \
        _Pragma("unroll") for (int i_ = 0; i_ < (ISB ? 2 : 1); ++i_) { const int p_ = ISB ? wid * 2 + i_ : wid; \
            glds16(kp_[i_], (unsigned)__builtin_amdgcn_readfirstlane((int)(lds0 + (bo) + p_ * 1024))); \
            glds16(vp_[i_], (unsigned)__builtin_amdgcn_readfirstlane((int)(lds0 + (bo) + VOFF + p_ * 1024))); \
            kp_[i_] += 64 * ZG; vp_[i_] += 64 * ZG; } } while (0)
#define ATT_SB() __builtin_amdgcn_sched_barrier(0)
    float mhat[2] = {0.f, 0.f}, lsum[2] = {0.f, 0.f};
    f32x4 o[2][NDVB];
#pragma unroll
    for (int qb = 0; qb < 2; ++qb)
#pragma unroll
        for (int d = 0; d < NDVB; ++d) o[qb][d] = (f32x4){0.f, 0.f, 0.f, 0.f};
    const int kfo = (ISB ? map * 8192 : 0) + c16 * 128 + ((g ^ (c16 & 7)) * 16);
    const int vq = (lane & 15) >> 2, vsw = ISB ? (4 * (g & 1) + vq) : (2 * (g & 1) + (vq >> 1));
    const int vfo = VOFF + (4 * g + vq) * VROW + (lane & 3) * 8;
    u32x4 pw[2][2];
    const float cfar_r = ISB ? lut[256 + 128] : 0.f, cfar_l = ISB ? lut[256 - 128] : 0.f;
#define ATT_QK(P, t, so) do { const int kb_ = (t) * 64; float cf_ = 0.f; \
        if (ISB) { if (kb_ - qrow0 - 31 >= 91) cf_ = cfar_r; else if (kb_ + 63 - qrow0 <= -91) cf_ = cfar_l; } \
        const float c0_ = cf_ - mhat[0], c1_ = cf_ - mhat[1]; const f32x4 ci0_ = (f32x4){c0_, c0_, c0_, c0_}, ci1_ = (f32x4){c1_, c1_, c1_, c1_}; \
        ALAS const unsigned char* kp = lds + (so) + kfo; \
        _Pragma("unroll") for (int kb = 0; kb < 4; ++kb) { \
            const bf16x8 k0_ = *(ALAS const bf16x8*)(kp + kb * 2048), k1_ = *(ALAS const bf16x8*)((ALAS const unsigned char*)((unsigned)(size_t)kp ^ 64u) + kb * 2048); \
            P[0][kb] = __builtin_amdgcn_mfma_f32_16x16x32_bf16(k0_, qr[0][0], ci0_, 0, 0, 0); P[1][kb] = __builtin_amdgcn_mfma_f32_16x16x32_bf16(k0_, qr[1][0], ci1_, 0, 0, 0); \
            P[0][kb] = __builtin_amdgcn_mfma_f32_16x16x32_bf16(k1_, qr[0][1], P[0][kb], 0, 0, 0); P[1][kb] = __builtin_amdgcn_mfma_f32_16x16x32_bf16(k1_, qr[1][1], P[1][kb], 0, 0, 0); } } while (0)
#define ATT_DECIDE(P, t, first) do { const int kb_ = (t) * 64; \
        if (!ISB || !((kb_ - qrow0 - 31 >= 91) || (kb_ + 63 - qrow0 <= -91))) { \
            ALAS const float* lp = lut + (kb_ - (qrow0 + c16) + 256 + 4 * g); \
            _Pragma("unroll") for (int qb = 0; qb < 2; ++qb) { float lv_[16]; \
                _Pragma("unroll") for (int kb = 0; kb < 4; ++kb) _Pragma("unroll") for (int r = 0; r < 4; ++r) lv_[4 * kb + r] = lp[16 * kb - 16 * qb + r]; \
                _Pragma("unroll") for (int kb = 0; kb < 4; ++kb) _Pragma("unroll") for (int r = 0; r < 4; ++r) P[qb][kb][r] += lv_[4 * kb + r]; } } \
        float rm0_ = MX3(MX3(P[0][0][0], P[0][0][1], P[0][0][2]), P[0][0][3], P[0][1][0]), rm1_ = MX3(MX3(P[1][0][0], P[1][0][1], P[1][0][2]), P[1][0][3], P[1][1][0]); \
        rm0_ = MX3(MX3(rm0_, P[0][1][1], P[0][1][2]), P[0][1][3], P[0][2][0]); rm1_ = MX3(MX3(rm1_, P[1][1][1], P[1][1][2]), P[1][1][3], P[1][2][0]); \
        rm0_ = MX3(MX3(rm0_, P[0][2][1], P[0][2][2]), P[0][2][3], P[0][3][0]); rm1_ = MX3(MX3(rm1_, P[1][2][1], P[1][2][2]), P[1][2][3], P[1][3][0]); \
        rm0_ = MX3(MX3(rm0_, P[0][3][1], P[0][3][2]), P[0][3][3], rm0_); rm1_ = MX3(MX3(rm1_, P[1][3][1], P[1][3][2]), P[1][3][3], rm1_); \
        if ((first) || __any(__builtin_fmaxf(rm0_, rm1_) > THR)) { \
            const float f0_ = g4_max(rm0_), f1_ = g4_max(rm1_); \
            const float dl0 = (first) ? f0_ : __builtin_fmaxf(f0_, 0.f), dl1 = (first) ? f1_ : __builtin_fmaxf(f1_, 0.f); \
            mhat[0] += dl0; mhat[1] += dl1; \
            _Pragma("unroll") for (int kb = 0; kb < 4; ++kb) { P[0][kb] -= dl0; P[1][kb] -= dl1; } \
            if (!(first)) { const float s0_ = __builtin_amdgcn_exp2f(-dl0), s1_ = __builtin_amdgcn_exp2f(-dl1); lsum[0] *= s0_; lsum[1] *= s1_; \
                _Pragma("unroll") for (int d = 0; d < NDVB; ++d) { o[0][d] *= s0_; o[1][d] *= s1_; } } } } while (0)
#define ATT_FINISH(P) do { \
        _Pragma("unroll") for (int qb = 0; qb < 2; ++qb) { float sa_ = 0.f; \
            _Pragma("unroll") for (int kb = 0; kb < 4; ++kb) _Pragma("unroll") for (int r = 0; r < 4; ++r) { P[qb][kb][r] = __builtin_amdgcn_exp2f(P[qb][kb][r]); sa_ += P[qb][kb][r]; } \
            lsum[qb] += sa_; \
            _Pragma("unroll") for (int s_ = 0; s_ < 2; ++s_) pw[qb][s_] = (u32x4){cvtpk(P[qb][2 * s_][0], P[qb][2 * s_][1]), cvtpk(P[qb][2 * s_][2], P[qb][2 * s_][3]), cvtpk(P[qb][2 * s_ + 1][0], P[qb][2 * s_ + 1][1]), cvtpk(P[qb][2 * s_ + 1][2], P[qb][2 * s_ + 1][3])}; } } while (0)
#define ATT_LDV2(dst, s_, d0_) do { _Pragma("unroll") for (int dd = 0; dd < 2; ++dd) { ALAS const unsigned char* a_ = vp + (s_) * 32 * VROW + ((((d0_) + dd) ^ vsw) * 32); dst[2 * dd] = vtr(a_); dst[2 * dd + 1] = vtr(a_ + 16 * VROW); } } while (0)
#define ATT_PV2(src, s_, d0_) do { __builtin_amdgcn_s_setprio(1); _Pragma("unroll") for (int dd = 0; dd < 2; ++dd) { \
            const bf16x8 vf_ = (bf16x8){src[2 * dd][0], src[2 * dd][1], src[2 * dd][2], src[2 * dd][3], src[2 * dd + 1][0], src[2 * dd + 1][1], src[2 * dd + 1][2], src[2 * dd + 1][3]}; \
            o[0][(d0_) + dd] = __builtin_amdgcn_mfma_f32_16x16x32_bf16(vf_, __builtin_bit_cast(bf16x8, pw[0][s_]), o[0][(d0_) + dd], 0, 0, 0); \
            o[1][(d0_) + dd] = __builtin_amdgcn_mfma_f32_16x16x32_bf16(vf_, __builtin_bit_cast(bf16x8, pw[1][s_]), o[1][(d0_) + dd], 0, 0, 0); } __builtin_amdgcn_s_setprio(0); } while (0)
#define ATT_PV(so) do { ALAS const unsigned char* vp = lds + (so) + vfo; s16x4 va[4], vb[4]; constexpr int NG_ = NDVB / 2; \
        ATT_LDV2(va, 0, 0); ATT_SB(); \
        _Pragma("unroll") for (int k_ = 0; k_ < 2 * NG_; k_ += 2) { \
            ATT_LDV2(vb, (k_ + 1) / NG_, 2 * ((k_ + 1) % NG_)); ATT_SB(); \
            ATT_PV2(va, k_ / NG_, 2 * (k_ % NG_)); ATT_SB(); \
            if (k_ + 2 < 2 * NG_) { ATT_LDV2(va, (k_ + 2) / NG_, 2 * ((k_ + 2) % NG_)); ATT_SB(); } \
            ATT_PV2(vb, (k_ + 1) / NG_, 2 * ((k_ + 1) % NG_)); ATT_SB(); } } while (0)
#define ATT_SLOT(i) (ISB ? (((i) % 3) * BUF) : ((i) * BUF))
#define ATT_STEP(i, PC, PP) do { \
        if (ISB) { asm volatile("s_waitcnt vmcnt(0)" ::: "memory"); __syncthreads(); if ((i) + 1 < nt) ATT_ISSUE(ATT_SLOT((i) + 1)); } \
        ATT_QK(PC, kt0 + (i), ATT_SLOT(i)); ATT_SB(); \
        ATT_FINISH(PP); ATT_SB(); \
        ATT_PV(ATT_SLOT((i) - 1)); ATT_SB(); \
        ATT_DECIDE(PC, kt0 + (i), false); ATT_SB(); } while (0)
    f32x4 pA[2][4], pB[2][4];
    if (ISB) { ATT_ISSUE(0); asm volatile("s_waitcnt vmcnt(0)" ::: "memory"); __syncthreads(); if (nt > 1) ATT_ISSUE(BUF); }
    else {
#pragma unroll 1
        for (int i = 0; i < nt; ++i) ATT_ISSUE(i * BUF);
        asm volatile("s_waitcnt vmcnt(0)" ::: "memory"); __syncthreads();
    }
    ATT_QK(pA, kt0, 0); ATT_SB();
    ATT_DECIDE(pA, kt0, true); ATT_SB();
    int i = 1;
#pragma unroll 1
    for (; i + 1 < nt; i += 2) {
        ATT_STEP(i, pB, pA);
        ATT_STEP(i + 1, pA, pB);
    }
    if (i < nt) {
        ATT_STEP(i, pB, pA);
        ATT_FINISH(pB); ATT_SB(); ATT_PV(ATT_SLOT(nt - 1));
    } else {
        ATT_FINISH(pA); ATT_SB(); ATT_PV(ATT_SLOT(nt - 1));
    }
#undef ATT_ISSUE
#undef ATT_SB
#undef ATT_QK
#undef ATT_DECIDE
#undef ATT_FINISH
#undef ATT_LDV2
#undef ATT_PV2
#undef ATT_PV
#undef ATT_SLOT
#undef ATT_STEP
    float inv[2];
#pragma unroll
    for (int qb = 0; qb < 2; ++qb) { float l_ = g4_sum(lsum[qb]); if (!ISB) l_ += __builtin_amdgcn_exp2f(sink2 - mhat[qb]); inv[qb] = 1.0f / l_; }
    constexpr int DVE = ISB ? 128 : 64, SPITCH = DVE * 2 + 8;
    bf16* obase = odry ? odry + (rowbase + qrow0) * D + (ISB ? (512 + head * 128) : (head * 64)) : zg + (rowbase + qrow0) * ZG + (ISB ? (C_QB + head * 128) : (C_QA + head * 64));
    const size_t opitch = odry ? D : ZG;
    ALAS unsigned char* stg = lds + (ISB ? qsub * 16384 : wid * 4608);
#define ATT_OUT() do { asm volatile("s_waitcnt lgkmcnt(0)" ::: "memory"); \
        constexpr int LPR = DVE / 8, RPI = 64 / LPR; \
        _Pragma("unroll") for (int i_ = 0; i_ < 32 / RPI; ++i_) { const int row_ = i_ * RPI + lane / LPR, ch_ = lane % LPR; \
            const u32x2 a_ = *(ALAS const u32x2*)(stg + row_ * SPITCH + ch_ * 16), b_ = *(ALAS const u32x2*)(stg + row_ * SPITCH + ch_ * 16 + 8); \
            *(u32x4*)(obase + (size_t)row_ * opitch + ch_ * 8) = (u32x4){a_.x, a_.y, b_.x, b_.y}; } } while (0)
    if (ISB) {
        __syncthreads();
        ALAS float* cs = (ALAS float*)lds;
        if (map == 1) {
#pragma unroll
            for (int qb = 0; qb < 2; ++qb) { const float sc = -lam * inv[qb];
#pragma unroll
                for (int d = 0; d < NDVB; ++d)
#pragma unroll
                    for (int r = 0; r < 4; ++r) cs[(qsub * 64 + (qb * NDVB + d) * 4 + r) * 64 + lane] = o[qb][d][r] * sc; } }
        __syncthreads();
        if (map == 0) {
            float rstd[2];
#pragma unroll
            for (int qb = 0; qb < 2; ++qb) { float q = 0.f;
#pragma unroll
                for (int d = 0; d < NDVB; ++d)
#pragma unroll
                    for (int r = 0; r < 4; ++r) { const float v = o[qb][d][r] * inv[qb] + cs[(qsub * 64 + (qb * NDVB + d) * 4 + r) * 64 + lane]; o[qb][d][r] = v; q += v * v; }
                rstd[qb] = rsqrtf(g4_sum(q) * (1.0f / 128.0f) + EPS); }
            asm volatile("s_waitcnt lgkmcnt(0)" ::: "memory");
#pragma unroll
            for (int qb = 0; qb < 2; ++qb)
#pragma unroll
                for (int d = 0; d < NDVB; ++d) { const int dv0 = 16 * d + 4 * g; const f32x4 gv = *(ALAS const f32x4*)(gt + dv0);
                    u32x2 w; w.x = cvtpk(o[qb][d][0] * rstd[qb] * gv[0], o[qb][d][1] * rstd[qb] * gv[1]); w.y = cvtpk(o[qb][d][2] * rstd[qb] * gv[2], o[qb][d][3] * rstd[qb] * gv[3]);
                    *(ALAS u32x2*)(stg + (16 * qb + c16) * SPITCH + dv0 * 2) = w; }
            ATT_OUT();
        }
    } else {
        __syncthreads();
#pragma unroll
        for (int qb = 0; qb < 2; ++qb)
#pragma unroll
            for (int d = 0; d < NDVB; ++d) { const int dv0 = 16 * d + 4 * g;
                u32x2 w; w.x = cvtpk(o[qb][d][0] * inv[qb], o[qb][d][1] * inv[qb]); w.y = cvtpk(o[qb][d][2] * inv[qb], o[qb][d][3] * inv[qb]);
                *(ALAS u32x2*)(stg + (16 * qb + c16) * SPITCH + dv0 * 2) = w; }
        ATT_OUT();
    }
#undef ATT_OUT
    __syncthreads();
}
#undef MX3
}

#ifndef MK_VAR
#define MK_VAR 0
#endif
#define MK_DUP 0
#define MK_DSEL 0
namespace mk {
using namespace nv;
constexpr int NWAVES = 8;
constexpr size_t MiB = 1u << 20;
constexpr size_t WS_CTL = 0, CTL_ZERO_BYTES = 1 * MiB;
constexpr size_t WS_LUT = 512 * 1024;
constexpr size_t WS_SS = 1 * MiB;
constexpr size_t WS_XB = 6 * MiB;
constexpr size_t WS_ZG = 38 * MiB;
constexpr size_t WS_A = 38 * MiB;
constexpr size_t WS_YB = 126 * MiB;
constexpr size_t WS_MIX = 174 * MiB;
constexpr size_t WS_W = 206 * MiB;
constexpr size_t WL_IN = 0, WL_A = (size_t)ZG * D, WL_B = WL_A + (size_t)D * 512, WL_O = WL_B + (size_t)D * 512, WL_UP = WL_O + (size_t)D * D, WL_DN = WL_UP + (size_t)FF2 * D, WL_END = WL_DN + (size_t)D * FF;
constexpr size_t WS_END = 322 * MiB;
static_assert(WS_W + 4 * WL_END * 2 <= WS_END && WS_YB + (size_t)64 * 4 * FF2 * 4 <= WS_MIX && WS_A + (size_t)T * FF * 2 <= WS_YB, "d_ws map");
constexpr int CW_Q = 2048;
constexpr int CW_BAR = 4096;
constexpr int N_PHASES = 1 + 6 * L;
constexpr int RING_OFF = 0, RING_BYTES = 131072, LDSCTL_OFF = RING_BYTES, MISC_OFF = LDSCTL_OFF + 320;
constexpr int LDS_BYTES = 147456;
static_assert(pg8::XOFF + 8192 <= LDS_BYTES && MISC_OFF + 128 <= pg8::XOFF, "LDS map");

#define GAS __attribute__((address_space(1)))
#define LAS __attribute__((address_space(3)))
typedef unsigned v4u __attribute__((ext_vector_type(4)));
typedef float f32x4 __attribute__((ext_vector_type(4)));
typedef GAS unsigned gu32;
#define RLX_AGENT __ATOMIC_RELAXED, __HIP_MEMORY_SCOPE_AGENT
#define LDS_WAIT() asm volatile("s_waitcnt lgkmcnt(0)" ::: "memory")
#define VM_WAIT() asm volatile("s_waitcnt vmcnt(0)" ::: "memory")
__device__ __forceinline__ unsigned f2bfu(float f) { unsigned u = __builtin_bit_cast(unsigned, f); return (u + 0x7fffu + ((u >> 16) & 1u)) >> 16; }
__device__ __forceinline__ unsigned pk2(float lo, float hi) { return f2bfu(lo) | (f2bfu(hi) << 16); }

#define XB_TMO      128
#define XB_XCNT(j)  (256  + 64 * (j))
#define XB_XSUB(j)  (1280 + 64 * (j))
#define XB_XGEN(j)  (2304 + 64 * (j))
#define XB_TOP      3328
#define XB_TOPGEN   3392
#define XCD_BAR_WORDS 3456
#define XB_SPIN_CAP (1u << 18)

__device__ __forceinline__ unsigned xb_ld(unsigned* p)              { return __hip_atomic_load(p, __ATOMIC_RELAXED, __HIP_MEMORY_SCOPE_AGENT); }
__device__ __forceinline__ unsigned xb_add(unsigned* p, unsigned v) { return __hip_atomic_fetch_add(p, v, __ATOMIC_RELAXED, __HIP_MEMORY_SCOPE_AGENT); }
__device__ __forceinline__ unsigned xb_xcc_id() { return (unsigned)__builtin_amdgcn_s_getreg((3 << 11) | 20) & 0xFu; }
#define XB_SPIN(cond, bar) do { unsigned _sp = 0; while (cond) { __builtin_amdgcn_s_sleep(1); \
    if ((++_sp & 255u) == 0u) { if (xb_ld(&(bar)[XB_TMO])) break; if (_sp > XB_SPIN_CAP) { atomicAdd(&(bar)[XB_TMO], 1u); break; } } } } while (0)

struct XcdBarrier {
    unsigned* bar; unsigned x;
    volatile LAS unsigned* st;
};

__device__ __forceinline__ XcdBarrier xcd_barrier_post(unsigned* bar, volatile LAS unsigned* st) {
    XcdBarrier b; b.bar = bar; b.x = xb_xcc_id(); b.st = st;
    if (threadIdx.x == 0) (void)xb_add(&bar[XB_XCNT(b.x)], 1u);
    return b;
}
__device__ __forceinline__ void xcd_barrier_complete(unsigned* bar, unsigned x, unsigned& nloc, unsigned& nx) {
    const unsigned G = gridDim.x * gridDim.y * gridDim.z;
    unsigned sum, cnt, mine, sp = 0u;
    for (;;) {
        sum = 0u; cnt = 0u; mine = 0u;
#pragma unroll
        for (unsigned j = 0; j < 16; ++j) { const unsigned c = xb_ld(&bar[XB_XCNT(j)]); sum += c; cnt += (c > 0u) ? 1u : 0u; mine = (j == x) ? c : mine; }
        if (sum == G) break;
        __builtin_amdgcn_s_sleep(1);
        if ((++sp & 255u) == 0u) { if (xb_ld(&bar[XB_TMO])) break; if (sp > XB_SPIN_CAP) { atomicAdd(&bar[XB_TMO], 1u); break; } }
    }
    nloc = mine > 0u ? mine : 1u; nx = cnt > 0u ? cnt : 1u;
}

__device__ __forceinline__ void xcd_barrier(const XcdBarrier& b) {
    asm volatile("s_waitcnt vmcnt(0)" ::: "memory");
    __syncthreads();
    if (threadIdx.x == 0) {
        unsigned* bar = b.bar;
        __builtin_amdgcn_s_waitcnt(0);
        unsigned nloc = b.st[0], nx = b.st[1];
        if (nloc == 0u) { xcd_barrier_complete(bar, b.x, nloc, nx); b.st[0] = nloc; b.st[1] = nx; }
        const unsigned old = xb_add(&bar[XB_XSUB(b.x)], 1u);
        const unsigned gen = old / nloc;
        if (old + 1u == (gen + 1u) * nloc) {
            __builtin_amdgcn_fence(__ATOMIC_RELEASE, "agent");
            asm volatile("s_waitcnt vmcnt(0)" ::: "memory");
            const unsigned og = xb_add(&bar[XB_TOP], 1u);
            const unsigned tg = og / nx;
            if (og + 1u == (tg + 1u) * nx) xb_add(&bar[XB_TOPGEN], 1u);
            else XB_SPIN(xb_ld(&bar[XB_TOPGEN]) == tg, bar);
            __builtin_amdgcn_fence(__ATOMIC_ACQUIRE, "agent");
            xb_add(&bar[XB_XGEN(b.x)], 1u);
            asm volatile("s_waitcnt vmcnt(0)" ::: "memory");
        } else {
            XB_SPIN(xb_ld(&bar[XB_XGEN(b.x)]) == gen, bar);
            __builtin_amdgcn_fence(__ATOMIC_ACQUIRE, "agent");
            asm volatile("s_waitcnt vmcnt(0)" ::: "memory");
        }
    }
    __syncthreads();
}


struct Args { const float* in[24]; float* out; unsigned char* ws; int ph_lo, ph_hi, li, pad; };

__device__ __forceinline__ void p0_transpose_item(const float* __restrict__ W, int ldw, int K, int k0, int n0, bf16* __restrict__ WT, int vrow0, const float* __restrict__ gain, LAS float* scr, int lane) {
    f32x4 v[8];
    const float* wp = W + (size_t)(k0 + (lane >> 3)) * ldw + n0 + 4 * (lane & 7);
#pragma unroll
    for (int i = 0; i < 8; ++i) v[i] = __builtin_nontemporal_load((const f32x4*)(wp + (size_t)(8 * i) * ldw));
    if (gain) {
#pragma unroll
        for (int i = 0; i < 8; ++i) v[i] *= gain[k0 + 8 * i + (lane >> 3)];
    }
#pragma unroll
    for (int i = 0; i < 8; ++i) { LAS float* d = scr + (8 * i + (lane >> 3)) * 33 + 4 * (lane & 7); d[0] = v[i].x; d[1] = v[i].y; d[2] = v[i].z; d[3] = v[i].w; }
    LDS_WAIT(); asm volatile("" ::: "memory");
    const int c = lane & 7;
#pragma unroll
    for (int j = 0; j < 4; ++j) { const int n = (lane >> 3) + 8 * j; const LAS float* s = scr + (8 * c) * 33 + n;
        v4u o; o.x = pk2(s[0 * 33], s[1 * 33]); o.y = pk2(s[2 * 33], s[3 * 33]); o.z = pk2(s[4 * 33], s[5 * 33]); o.w = pk2(s[6 * 33], s[7 * 33]);
        *(GAS v4u*)(WT + (size_t)(vrow0 + n) * K + k0 + 8 * c) = o; }
    LDS_WAIT(); asm volatile("" ::: "memory");
}
__device__ __forceinline__ int vrow_in(int c) { const int pn = c >> 8, cr = c & 255, wc = cr >> 6, bj = (cr >> 5) & 1; return pn * 256 + bj * 128 + wc * 32; }
__device__ __forceinline__ int vrow_up(int c) { const int gs = c >= FF ? 1 : 0, cc = c - gs * FF, pn = cc >> 7, wc = (cc >> 5) & 3; return pn * 256 + gs * 128 + wc * 32; }

__global__ void __launch_bounds__(NWAVES * 64, 2) skel_fwd(Args args) {
    extern __shared__ __attribute__((aligned(16))) unsigned char lds_raw[];
    LAS unsigned char* lds = (LAS unsigned char*)lds_raw;
    volatile LAS unsigned* MISC = (volatile LAS unsigned*)(lds + MISC_OFF);
    const int G = gridDim.x; int vcu; { const int bx = blockIdx.x; vcu = (G % 8 == 0) ? (bx % 8) * (G / 8) + bx / 8 : bx; }
    unsigned char* ws = args.ws;
    gu32* ctl = (gu32*)(ws + WS_CTL);
    float* ss = (float*)(ws + WS_SS); bf16* xb = (bf16*)(ws + WS_XB); bf16* zg = (bf16*)(ws + WS_ZG); bf16* abuf = (bf16*)(ws + WS_A); float* yb = (float*)(ws + WS_YB);
    bf16* mix = (bf16*)(ws + WS_MIX); bf16* wbase = (bf16*)(ws + WS_W); float* xf = args.out;
    float* lutg = (float*)(ws + WS_LUT);
    for (int u = threadIdx.x; u < (LDS_BYTES - LDSCTL_OFF) / 4; u += NWAVES * 64) ((LAS unsigned*)(lds + LDSCTL_OFF))[u] = 0u;
    __syncthreads();
    XcdBarrier bar = xcd_barrier_post((unsigned*)(ctl + CW_BAR) + args.li * XCD_BAR_WORDS, MISC + 8);

#pragma unroll 1
    for (int ph = args.ph_lo; ph < args.ph_hi; ++ph) {
        const int l = ph > 0 ? (ph - 1) / 6 : 0, p = ph > 0 ? (ph - 1) % 6 + 1 : 0;
        bf16* wl = wbase + (size_t)l * WL_END;
        float* ss1 = ss + (size_t)((2 * l) & 3) * T * 16; float* ss2 = ss + (size_t)((2 * l + 1) & 3) * T * 16; float* ss3 = (l + 1 < L) ? ss + (size_t)((2 * l + 2) & 3) * T * 16 : nullptr;
#ifndef MK_ONLY
#define MK_ONLY 0x7f
#endif
        const int dupp = ((args.pad >> 8) & 0xff) - 1;
#pragma unroll 1
        for (int rep = (p == dupp) ? 0 : 1; rep < 2; ++rep) {
        if (p == 0 && (MK_ONLY & 1)) {
            int tid0 = threadIdx.x; asm volatile("" : "+v"(tid0));
            const int lane0 = tid0 & 63, wave = __builtin_amdgcn_readfirstlane(tid0 >> 6);
            LAS float* scr = (LAS float*)(lds + RING_OFF + wave * 16384);
            const int gw = vcu * NWAVES + wave, NGW = G * NWAVES;
            constexpr int I_IN = (D / 64) * (INW / 32), I_G = (D / 64) * (GW / 32), I_A = (512 / 64) * (D / 32), I_O = (D / 64) * (D / 32), I_UP = (D / 64) * (FF2 / 32), I_DN = (FF / 64) * (D / 32);
            constexpr int I_LAYER = I_IN + I_G + 2 * I_A + I_O + I_UP + I_DN;
            for (int i = gw * 64 + lane0; i < 12 * att::LUT_STRIDE; i += NGW * 64) { const int hh = i / att::LUT_STRIDE, j = i - hh * att::LUT_STRIDE, rel = j - 256, ar = rel < 0 ? -rel : rel;
                float v = 0.f; if (j <= 512) v = (hh < 8 && ar > 128) ? att::NEG : args.in[13][t5_bucket(rel) * 12 + hh] * LOG2E;
                lutg[i] = v; }
            for (int m = gw; m < T; m += 2 * NGW) {
                const int m2 = m + NGW;
                const GAS f32x4* xr = (const GAS f32x4*)(args.in[0] + (size_t)m * D) + lane0; const GAS f32x4* xr2 = (const GAS f32x4*)(args.in[0] + (size_t)m2 * D) + lane0;
                GAS unsigned long long* o8 = (GAS unsigned long long*)(xb + (size_t)m * D) + lane0; GAS unsigned long long* o82 = (GAS unsigned long long*)(xb + (size_t)m2 * D) + lane0;
                f32x4 va[4], vb[4];
#pragma unroll
                for (int j = 0; j < 4; ++j) { va[j] = xr[64 * j]; vb[j] = xr2[64 * j]; }
                float s = 0.f, s2 = 0.f;
#pragma unroll
                for (int j = 0; j < 4; ++j) { const f32x4 v = va[j], w = vb[j]; s += (v.x * v.x + v.y * v.y) + (v.z * v.z + v.w * v.w); s2 += (w.x * w.x + w.y * w.y) + (w.z * w.z + w.w * w.w);
                    o8[64 * j] = (unsigned long long)pk2(v.x, v.y) | ((unsigned long long)pk2(v.z, v.w) << 32); o82[64 * j] = (unsigned long long)pk2(w.x, w.y) | ((unsigned long long)pk2(w.z, w.w) << 32); }
                s = wave_sum(s); s2 = wave_sum(s2);
                ss16_store(ss, m, s, lane0); ss16_store(ss, m2, s2, lane0);
            }
        } else if (p == 1 && (MK_ONLY & 2)) {
            pg8::SchedStd S; S.init(xb, D, wl + WL_IN, D, T, ZG - 256, G, (int)blockIdx.x);
            S.fix = (rep == 0 && MK_VAR == 8) ? 1 : 0;
            pg8::EpiIn E{zg, ss1, args.in[3] + l * 64, args.in[4] + l * 64, args.in[6] + l * 64, args.in[7] + l * 64, args.in[15] + l * GW, (args.pad >> 25) & 1};
            pg8::gemm_phase<pg8::EpiIn, pg8::SchedStd, true, true>(lds + RING_OFF, D, D, S, E);
        } else if (p == 2 && (MK_ONLY & 4)) {
            int lop = l; asm volatile("" : "+s"(lop));
            const float lam_init = 0.8f - 0.6f * __expf(-0.3f * (float)lop);
            int ln = threadIdx.x; asm volatile("" : "+v"(ln)); ln &= 63;
            const float d1 = wave_sum(args.in[8][l * 64 + ln] * args.in[9][l * 64 + ln]), d2 = wave_sum(args.in[10][l * 64 + ln] * args.in[11][l * 64 + ln]);
            const float lam = __expf(d1) - __expf(d2) + lam_init;
            if ((vcu & 3) == 0 && rep == 1) {
                pg8::SchedStd S1; S1.init(xb, D, wl + WL_IN, D, T, ZG, G, (int)blockIdx.x); S1.one = 1; S1.opm = 8 * (vcu >> 5) + ((vcu & 31) >> 2); S1.opn = 16;
                pg8::EpiIn E1{zg, ss1, args.in[3] + l * 64, args.in[4] + l * 64, args.in[6] + l * 64, args.in[7] + l * 64, args.in[15] + l * GW, 0};
                pg8::gemm_phase<pg8::EpiIn, pg8::SchedStd, true, true>(lds + RING_OFF, D, D, S1, E1);
            }
            att::attn_tables(lds, lutg, args.in[12] + l * 128, 1.0f - lam_init);
            const int dsel = args.pad >> 16;
            if (rep == 1 || dsel != 2)
            for (int ui = vcu; ui < 512; ui += G) { const int bh = ui >> 4, qb = ui & 15; if (rep == 0 && MK_VAR == 7 && (vcu & 1)) {} else if (rep == 0) att::attn_unit<true, (MK_VAR == 7 ? 0 : MK_VAR)>(lds, zg, lutg, bh >> 2, bh & 3, qb * 128, nullptr, lam, 1.0f - lam_init, args.in[12] + l * 128, mix);
                else att::attn_unit<true, 0>(lds, zg, lutg, bh >> 2, bh & 3, qb * 128, nullptr, lam, 1.0f - lam_init, args.in[12] + l * 128, nullptr); }
            if (rep == 1 || dsel != 1) {
                unsigned* qctr = (unsigned*)(ctl + CW_Q + 64 * (2 * l + rep));
                for (;;) {
                    if (threadIdx.x == 0) MISC[4] = __hip_atomic_fetch_add(qctr, 1u, __ATOMIC_RELAXED, __HIP_MEMORY_SCOPE_AGENT);
                    __syncthreads();
                    const int ui = (int)MISC[4];
                    __syncthreads();
                    if (ui >= 512) break;
                    const int bk = ui >> 5, qb = ui & 31; att::attn_unit<false>(lds, zg, lutg, bk >> 1, bk & 1, qb * 64, args.in[5] + l * HA, 0.f, 0.f, nullptr, rep == 0 ? mix : nullptr);
                }
            }
        } else if (p == 3 && (MK_ONLY & 8)) {
            pg8::SchedMix S; S.b.init(zg + C_QA, ZG, wl + WL_A, 512, T, D, G, (int)blockIdx.x); S.A1 = (const char*)(zg + C_QB); S.Bt1 = (const char*)(wl + WL_B);
            pg8::EpiMix E{zg, mix};
            pg8::gemm_phase<pg8::EpiMix, pg8::SchedMix, true, true>(lds + RING_OFF, 512, ZG, S, E);
        } else if (p == 4 && (MK_ONLY & 16)) {
            pg8::SchedStd S; S.init(mix, D, wl + WL_O, D, T, D, G, (int)blockIdx.x);
            pg8::EpiRes E{l == 0 ? args.in[0] : xf, xf, xb, ss2};
            pg8::gemm_phase<pg8::EpiRes, pg8::SchedStd, true, true>(lds + RING_OFF, D, D, S, E);
        } else if (p == 5 && (MK_ONLY & 32)) {
            pg8::SchedStd S; S.init(xb, D, wl + WL_UP, D, T, FF2, G, (int)blockIdx.x);
            pg8::EpiUp E{abuf, ss2, args.in[21] + (size_t)l * 3 * FF2, args.in[22] + (size_t)l * FF2, yb, (args.pad >> 24) & 1};
            pg8::gemm_phase<pg8::EpiUp, pg8::SchedStd, true, true>(lds + RING_OFF, D, D, S, E);
        } else if (MK_ONLY & 64) {
            pg8::SchedDown S; S.b.init(abuf, FF, wl + WL_DN, FF, T, D, G, (int)blockIdx.x); S.yb = (args.pad & 1) ? nullptr : yb; S.cw = args.in[21] + (size_t)l * 3 * FF2; S.cb = args.in[22] + (size_t)l * FF2; S.a = abuf;
            pg8::EpiRes E{xf, xf, ss3 ? xb : nullptr, ss3};
            pg8::gemm_phase<pg8::EpiRes, pg8::SchedDown, true, true>(lds + RING_OFF, FF, FF, S, E);
        }
        {
            int ph2 = ph; asm volatile("" : "+s"(ph2));
            const int l2 = ph2 > 0 ? (ph2 - 1) / 6 : 0, p2 = ph2 > 0 ? (ph2 - 1) % 6 + 1 : 0;
            const int G2 = gridDim.x, bx2 = blockIdx.x;
            int cl = -1, cw0 = 0, cnw = 1;
            if (p2 == 0) { cl = 0; cw0 = ((G2 % 8 == 0) ? (bx2 % 8) * (G2 / 8) + bx2 / 8 : bx2) * NWAVES; cnw = G2 * NWAVES; }
            else if (p2 == 5 && l2 + 1 < L && G2 == 256 && bx2 >= 128) { cl = l2 + 1; cw0 = (bx2 - 128) * NWAVES; cnw = 128 * NWAVES; }
            if (cl >= 0) {
                bf16* wbase2 = (bf16*)(args.ws + WS_W);
                int tid0 = threadIdx.x; asm volatile("" : "+v"(tid0));
                const int lane0 = tid0 & 63, wave = __builtin_amdgcn_readfirstlane(tid0 >> 6);
                LAS float* scr = (LAS float*)(lds + RING_OFF + wave * 16384);
                constexpr int I_IN = (D / 64) * (INW / 32), I_G = (D / 64) * (GW / 32), I_A = (512 / 64) * (D / 32), I_O = (D / 64) * (D / 32), I_UP = (D / 64) * (FF2 / 32), I_DN = (FF / 64) * (D / 32);
                constexpr int I_LAYER = I_IN + I_G + 2 * I_A + I_O + I_UP + I_DN;
                const int ll = cl; bf16* w = wbase2 + (size_t)ll * WL_END;
#pragma unroll 1
                for (int it = cw0 + wave; it < I_LAYER; it += cnw) {
                    int r = it;
                    if (r < I_IN) { const int nb = r % (INW / 32), kb = r / (INW / 32); p0_transpose_item(args.in[2] + (size_t)ll * D * INW, INW, D, 64 * kb, 32 * nb, w + WL_IN, vrow_in(32 * nb), args.in[1] + ll * D, scr, lane0); continue; } r -= I_IN;
                    if (r < I_G) { const int nb = r % (GW / 32), kb = r / (GW / 32); p0_transpose_item(args.in[14] + (size_t)ll * D * GW, GW, D, 64 * kb, 32 * nb, w + WL_IN, vrow_in(INW + 32 * nb), args.in[1] + ll * D, scr, lane0); continue; } r -= I_G;
                    if (r < I_A) { const int nb = r % (D / 32), kb = r / (D / 32); p0_transpose_item(args.in[16] + (size_t)ll * 512 * D, D, 512, 64 * kb, 32 * nb, w + WL_A, 32 * nb, nullptr, scr, lane0); continue; } r -= I_A;
                    if (r < I_A) { const int nb = r % (D / 32), kb = r / (D / 32); p0_transpose_item(args.in[17] + (size_t)ll * 512 * D, D, 512, 64 * kb, 32 * nb, w + WL_B, 32 * nb, nullptr, scr, lane0); continue; } r -= I_A;
                    if (r < I_O) { const int nb = r % (D / 32), kb = r / (D / 32); p0_transpose_item(args.in[18] + (size_t)ll * D * D, D, D, 64 * kb, 32 * nb, w + WL_O, 32 * nb, nullptr, scr, lane0); continue; } r -= I_O;
                    if (r < I_UP) { const int nb = r % (FF2 / 32), kb = r / (FF2 / 32); p0_transpose_item(args.in[20] + (size_t)ll * D * FF2, FF2, D, 64 * kb, 32 * nb, w + WL_UP, vrow_up(32 * nb), args.in[19] + ll * D, scr, lane0); continue; } r -= I_UP;
                    { const int nb = r % (D / 32), kb = r / (D / 32); p0_transpose_item(args.in[23] + (size_t)ll * FF * D, D, FF, 64 * kb, 32 * nb, w + WL_DN, 32 * nb, nullptr, scr, lane0); }
                }
            }
        }
        }
        if (ph + 1 < args.ph_hi) xcd_barrier(bar);
    }
}
}

extern "C" void kernel_launch(void* const* d_in, const int* in_sizes, int n_in, void* d_out, int out_size, void* d_ws, size_t ws_size, hipStream_t stream) {
    using namespace nv;
    static int grid = 0;
    if (grid == 0) {
        if (n_in != 24 || in_sizes[0] != T * D || out_size != T * D || ws_size < mk::WS_END) { fprintf(stderr, "kernel_launch: built for 24 inputs, x/out of %d floats, >= %zu bytes of workspace; got n_in %d, out %d, ws %zu; nothing launched\n", T * D, (size_t)mk::WS_END, n_in, out_size, ws_size); grid = -1; return; }
        int dev = 0, cus = 0, per_cu = 0;
        if (hipGetDevice(&dev) != hipSuccess || hipDeviceGetAttribute(&cus, hipDeviceAttributeMultiprocessorCount, dev) != hipSuccess) { fprintf(stderr, "kernel_launch: device query failed; nothing launched\n"); grid = -1; return; }
        if (hipFuncSetAttribute((const void*)mk::skel_fwd, hipFuncAttributeMaxDynamicSharedMemorySize, mk::LDS_BYTES) != hipSuccess) { fprintf(stderr, "kernel_launch: hipFuncSetAttribute failed (needs %d bytes of dynamic LDS)\n", mk::LDS_BYTES); grid = -1; return; }
        if (hipOccupancyMaxActiveBlocksPerMultiprocessor(&per_cu, (const void*)mk::skel_fwd, mk::NWAVES * 64, mk::LDS_BYTES) != hipSuccess || per_cu < 1) fprintf(stderr, "kernel_launch: note: occupancy query reports %d workgroups per CU\n", per_cu);
        (void)hipGetLastError();
        grid = cus;
        if (grid != 256) fprintf(stderr, "kernel_launch: the unit schedules are built for 256 CUs; this device reports %d\n", cus);
    }
    if (grid < 0) return;
    if (hipMemsetAsync((unsigned char*)d_ws + mk::WS_CTL, 0, mk::CTL_ZERO_BYTES, stream) != hipSuccess) { fprintf(stderr, "kernel_launch: memset of the control words failed; nothing launched\n"); return; }
    mk::Args a{};
    for (int i = 0; i < 24; ++i) a.in[i] = (const float*)d_in[i];
    a.out = (float*)d_out; a.ws = (unsigned char*)d_ws; a.ph_lo = 0; a.ph_hi = mk::N_PHASES; a.li = 0;
    a.pad = (MK_DUP << 8) | (MK_DSEL << 16);
    hipLaunchKernelGGL(mk::skel_fwd, dim3(grid), dim3(mk::NWAVES * 64), mk::LDS_BYTES, stream, a);
}
```

```cpp
#include <hip/hip_runtime.h>
#include <cstdio>
#include <cstdint>
#include <cmath>
#define MK_EDUP 0

namespace nv {
typedef unsigned short bf16;
constexpr int D = 1024, B = 8, S = 2048, T = B * S, L = 4;
constexpr int HA = 8, KVA = 2, HB = 4, HD = 64;
constexpr int INW = 2304, GW = 2048, ZG = INW + GW;
constexpr int FF = 2816, FF2 = 2 * FF;
constexpr int C_QA = 0, C_KA = 512, C_VA = 640, C_QB = 768, C_KB = 1280, C_VB = 1792, C_G = 2304;
constexpr float EPS = 1e-6f;
constexpr float LOG2E = 1.4426950408889634f;
constexpr float C2 = 0.125f * LOG2E;

__device__ __forceinline__ float bf2f(bf16 v) { return __uint_as_float(((unsigned)v) << 16); }
__device__ __forceinline__ bf16 f2bf(float f) { unsigned u = __float_as_uint(f); return (bf16)((u + 0x7fffu + ((u >> 16) & 1u)) >> 16); }
__device__ __forceinline__ float ldf(const float* p) { return *p; }
__device__ __forceinline__ float ldf(const bf16* p) { return bf2f(*p); }

__device__ __forceinline__ int t5_bucket(int rel) {
    const int n = rel < 0 ? -rel : rel; int v;
    if (n < 8) v = n; else if (n < 12) v = 8; else if (n < 16) v = 9; else if (n < 23) v = 10; else if (n < 32) v = 11;
    else if (n < 46) v = 12; else if (n < 64) v = 13; else if (n < 91) v = 14; else v = 15;
    return (rel > 0 ? 16 : 0) + v;
}
__device__ __forceinline__ float ss16(const float* ss, int t) { const float4* p = (const float4*)(ss + (size_t)t * 16); const float4 a = p[0], b = p[1], c = p[2], d = p[3];
    return ((a.x + a.y) + (a.z + a.w)) + ((b.x + b.y) + (b.z + b.w)) + ((c.x + c.y) + (c.z + c.w)) + ((d.x + d.y) + (d.z + d.w)); }
__device__ __forceinline__ float ss16_q(const float* ss, int t, int fq) { const float4 a = *(const float4*)(ss + (size_t)t * 16 + 4 * fq); float s = (a.x + a.y) + (a.z + a.w); s += __shfl_xor(s, 16); s += __shfl_xor(s, 32); return s; }
__device__ __forceinline__ void ss16_store(float* ss, int t, float s, int lane) { if (lane < 16) ss[(size_t)t * 16 + lane] = lane == 0 ? s : 0.f; }
__device__ __forceinline__ float wave_sum(float v) {
#pragma unroll
    for (int o = 1; o < 64; o <<= 1) v += __shfl_xor(v, o);
    return v;
}
__device__ __forceinline__ float wave_max(float v) {
#pragma unroll
    for (int o = 1; o < 64; o <<= 1) v = fmaxf(v, __shfl_xor(v, o));
    return v;
}

}


namespace pg8 {
using namespace nv;
#define PG8_LAS __attribute__((address_space(3)))
typedef unsigned short bf16_t;
typedef short bf16x8 __attribute__((ext_vector_type(8)));
typedef float f32x4 __attribute__((ext_vector_type(4)));
typedef unsigned u32x4 __attribute__((ext_vector_type(4)));
typedef unsigned u32x2 __attribute__((ext_vector_type(2)));
constexpr int BM = 256, BK = 64, HALF = 128, HTB = HALF * BK * 2  , STAGE_BYTES = 8 * HTB, NXCD = 8, WGM = 8;
constexpr int XOFF = 131072 + 1024;

__host__ __device__ __forceinline__ int lds_byte(int r, int c) { const int st = (r >> 4) * 2 + (c >> 5), rr = r & 15, cc = c & 31, ob = rr * 64 + cc * 2; return st * 1024 + (ob ^ (((ob >> 9) & 1) << 5)); }
__host__ __device__ __forceinline__ void stage_rc(int b, int& R, int& C) { const int st = b / 1024, sb = b % 1024, swz = sb ^ (((sb >> 9) & 1) << 5); R = (st >> 1) * 16 + swz / 64; C = (st & 1) * 32 + (swz % 64) / 2; }
__host__ __device__ __forceinline__ int perm32(int rho) { const int n = rho >> 4, i = rho & 15; return 8 * (i >> 2) + 4 * n + (i & 3); }

struct Unit { int pm, pn, z; };
typedef float f32x2 __attribute__((ext_vector_type(2))); typedef __bf16 bf16x2_t __attribute__((ext_vector_type(2)));
__device__ __forceinline__ unsigned cvt_pk_bf16(float lo, float hi) { f32x2 v = {lo, hi}; bf16x2_t b = __builtin_convertvector(v, bf16x2_t); return __builtin_bit_cast(unsigned, b); }
__device__ __forceinline__ float bflo(unsigned w) { return __uint_as_float(w << 16); }
__device__ __forceinline__ float bfhi(unsigned w) { return __uint_as_float(w & 0xffff0000u); }

struct SchedStd {
    int nM, nN, nwg, G, c, fix, one, opm, opn; const char* A; const char* Bt; size_t at, bt;
    __device__ void init(const void* A_, int lda, const void* Bt_, int K, int M, int N, int G_, int c_) { fix = 0; one = 0; opm = 0; opn = 0; nM = M / BM; nN = N / BM; nwg = nM * nN; G = G_; c = c_; A = (const char*)A_; Bt = (const char*)Bt_; at = (size_t)BM * lda * 2; bt = (size_t)BM * K * 2; }
    __device__ bool next(int i, Unit& u) const {
        if (one) { if (i > 0) return false; u.pm = opm; u.pn = opn; u.z = 0; return true; }
        const long L = (long)i * G + c; if (L >= nwg) return false;
        int wgid = (int)L; { const int q = nwg / NXCD, r = nwg % NXCD, xcd = wgid % NXCD, off = wgid / NXCD; wgid = (xcd < r ? xcd * (q + 1) : r * (q + 1) + (xcd - r) * q) + off; }
        const int nig = WGM * nN, gid = wgid / nig, fm = gid * WGM, gsz = (nM - fm) < WGM ? (nM - fm) : WGM;
        u.pm = fm + ((wgid % nig) % gsz); u.pn = (wgid % nig) / gsz; u.z = 0; if (fix) { u.pm = 0; u.pn = 0; } return true;
    }
    __device__ __forceinline__ const char* aptr(const Unit& u) const { return A + (size_t)u.pm * at; }
    __device__ __forceinline__ const char* bptr(const Unit& u) const { return Bt + (size_t)u.pn * bt; }
    __device__ __forceinline__ void a_ready(const Unit&) const {}
    __device__ __forceinline__ void done(const Unit&) const {}
};
struct SchedMix {
    SchedStd b; const char* A1; const char* Bt1;
    __device__ bool next(int i, Unit& u) const { if (!b.next(i >> 1, u)) return false; u.z = i & 1; return true; }
    __device__ __forceinline__ const char* aptr(const Unit& u) const { return (u.z ? A1 : b.A) + (size_t)u.pm * b.at; }
    __device__ __forceinline__ const char* bptr(const Unit& u) const { return (u.z ? Bt1 : b.Bt) + (size_t)u.pn * b.bt; }
    __device__ __forceinline__ void a_ready(const Unit&) const {}
    __device__ __forceinline__ void done(const Unit&) const {}
};
struct SchedDown {
    SchedStd b; const float* yb; const float* cw; const float* cb; bf16_t* a;
    __device__ bool next(int i, Unit& u) const { return b.next(i, u); }
    __device__ __forceinline__ const char* aptr(const Unit& u) const { return b.aptr(u); }
    __device__ __forceinline__ const char* bptr(const Unit& u) const { return b.bptr(u); }
    __device__ __forceinline__ void a_ready(const Unit& u) const {
        const int pm = u.pm;
        if (yb)
        for (int idx = threadIdx.x; idx < 2 * FF; idx += 512) {
            const int which = idx >= FF ? 1 : 0, j = idx - which * FF;
            float uv[2];
#pragma unroll
            for (int gs = 0; gs < 2; ++gs) {
                const int col = gs * FF + j; float y0, y1, y2;
                if (which == 0) { y0 = (pm & 7) ? yb[((size_t)(pm - 1) * 4 + 3) * FF2 + col] : 0.f; y1 = yb[((size_t)pm * 4 + 0) * FF2 + col]; y2 = yb[((size_t)pm * 4 + 1) * FF2 + col]; }
                else { y0 = yb[((size_t)pm * 4 + 2) * FF2 + col]; y1 = yb[((size_t)pm * 4 + 3) * FF2 + col]; y2 = ((pm & 7) != 7) ? yb[((size_t)(pm + 1) * 4 + 0) * FF2 + col] : 0.f; }
                uv[gs] = cb[col] + cw[col] * y0 + cw[FF2 + col] * y1 + cw[2 * FF2 + col] * y2;
            }
            const float sg = uv[1] * __builtin_amdgcn_rcpf(1.0f + __builtin_amdgcn_exp2f(-uv[1] * LOG2E));
            a[(size_t)(pm * BM + which * 255) * FF + j] = f2bf(sg * uv[0]);
        }
        asm volatile("s_waitcnt vmcnt(0)" ::: "memory");
        __builtin_amdgcn_s_barrier();
        asm volatile("" ::: "memory");
    }
    __device__ __forceinline__ void done(const Unit&) const {}
};

struct EpiIn {
    static constexpr bool PERM = true, AFTER_DRAIN = false;
    __device__ __forceinline__ void init(f32x4 (&acc)[2][2][4][2], const Unit&, int, int, int, int) const {
#pragma unroll
        for (int a = 0; a < 2; ++a)
#pragma unroll
            for (int b = 0; b < 2; ++b)
#pragma unroll
                for (int m = 0; m < 4; ++m)
#pragma unroll
                    for (int n = 0; n < 2; ++n) acc[a][b][m][n] = (f32x4){0.f, 0.f, 0.f, 0.f};
    }
    __device__ static constexpr bool zero_after(const Unit&) { return true; }
    bf16_t* zg; const float* ss; const float *qn_a, *kn_a, *qn_b, *kn_b, *bg; int dup;
    __device__ __forceinline__ void operator()(f32x4 (&acc)[2][2][4][2], const Unit& u, int wr, int wc, int fr, int fq, PG8_LAS unsigned char*) const {
#pragma unroll
        for (int rep_ = 0; rep_ <= ((MK_EDUP & 2) ? 1 : 0); ++rep_) {
        if (rep_) {
#pragma unroll
            for (int ai = 0; ai < 2; ++ai)
#pragma unroll
                for (int bj = 0; bj < 2; ++bj)
#pragma unroll
                    for (int m = 0; m < 4; ++m)
#pragma unroll
                        for (int n = 0; n < 2; ++n) asm volatile("" : "+v"(acc[ai][bj][m][n]) :: "memory");
        }
        const int g = u.pn * 4 + wc, colb = u.pn * BM + wc * 64 + 8 * fq;
        const float* gain = nullptr; float sc = 1.f; int mode = 0;
        if (g < 8) { gain = qn_a; sc = C2; mode = 1; } else if (g < 10) { gain = kn_a; mode = 1; } else if (g < 12) { mode = 0; } else if (g < 20) { gain = qn_b; sc = C2; mode = 1; }
        else if (g < 28) { gain = kn_b; mode = 1; } else if (g < 36) { mode = 0; } else { mode = 2; }
        float rsv[2][4];
#pragma unroll
        for (int ai = 0; ai < 2; ++ai)
#pragma unroll
            for (int m = 0; m < 4; ++m) rsv[ai][m] = rsqrtf(ss16_q(ss, u.pm * BM + ai * HALF + wr * 64 + m * 16 + fr, fq) * (1.0f / D) + EPS);
        f32x4 gv[2][2];
#pragma unroll
        for (int bj = 0; bj < 2; ++bj)
#pragma unroll
            for (int n = 0; n < 2; ++n) {
                if (mode == 1) gv[bj][n] = *(const f32x4*)(gain + 32 * bj + 8 * fq + 4 * n) * sc;
                else if (mode == 2) gv[bj][n] = *(const f32x4*)(bg + (colb - C_G) + 32 * bj + 4 * n);
                else gv[bj][n] = (f32x4){1.f, 1.f, 1.f, 1.f};
            }
#pragma unroll
        for (int ai = 0; ai < 2; ++ai)
#pragma unroll
            for (int m = 0; m < 4; ++m) {
                const int row = u.pm * BM + ai * HALF + wr * 64 + m * 16 + fr;
                const float rs = rsv[ai][m];
                f32x4 v[2][2];
#pragma unroll
                for (int bj = 0; bj < 2; ++bj)
#pragma unroll
                    for (int n = 0; n < 2; ++n) v[bj][n] = acc[ai][bj][m][n] * rs;
                if (mode == 1) {
                    float q = 0.f;
#pragma unroll
                    for (int bj = 0; bj < 2; ++bj)
#pragma unroll
                        for (int n = 0; n < 2; ++n) { const f32x4 x = v[bj][n]; q += (x[0] * x[0] + x[1] * x[1]) + (x[2] * x[2] + x[3] * x[3]); }
                    q += __shfl_xor(q, 16); q += __shfl_xor(q, 32);
                    const float r2 = rsqrtf(q * (1.0f / 64.0f) + EPS);
#pragma unroll
                    for (int bj = 0; bj < 2; ++bj)
#pragma unroll
                        for (int n = 0; n < 2; ++n) v[bj][n] = v[bj][n] * r2 * gv[bj][n];
                } else if (mode == 2) {
#pragma unroll
                    for (int bj = 0; bj < 2; ++bj)
#pragma unroll
                        for (int n = 0; n < 2; ++n) { f32x4 x = v[bj][n] + gv[bj][n];
#pragma unroll
                            for (int e = 0; e < 4; ++e) x[e] = __builtin_fmaxf(__builtin_amdgcn_rcpf(1.0f + __builtin_amdgcn_exp2f(-x[e] * LOG2E)), 9.5367431640625e-07f);
                            v[bj][n] = x; }
                }
                bf16_t* rowp = zg + (size_t)row * ZG + colb;
#pragma unroll
                for (int bj = 0; bj < 2; ++bj) { u32x4 w; w.x = cvt_pk_bf16(v[bj][0][0], v[bj][0][1]); w.y = cvt_pk_bf16(v[bj][0][2], v[bj][0][3]); w.z = cvt_pk_bf16(v[bj][1][0], v[bj][1][1]); w.w = cvt_pk_bf16(v[bj][1][2], v[bj][1][3]);
                    *(u32x4*)(rowp + 32 * bj) = w; }
            }
        }
    }
};
struct EpiMix {
    static constexpr bool PERM = true, AFTER_DRAIN = false;
    __device__ __forceinline__ void init(f32x4 (&acc)[2][2][4][2], const Unit&, int, int, int, int) const {
#pragma unroll
        for (int a = 0; a < 2; ++a)
#pragma unroll
            for (int b = 0; b < 2; ++b)
#pragma unroll
                for (int m = 0; m < 4; ++m)
#pragma unroll
                    for (int n = 0; n < 2; ++n) acc[a][b][m][n] = (f32x4){0.f, 0.f, 0.f, 0.f};
    }
    __device__ static bool zero_after(const Unit& u) { return u.z != 0; }
    const bf16_t* zg; bf16_t* mix;
    __device__ __forceinline__ void operator()(f32x4 (&acc)[2][2][4][2], const Unit& u, int wr, int wc, int fr, int fq, PG8_LAS unsigned char*) const {
        const int col0 = u.pn * BM + wc * 32 + 8 * fq;
#pragma unroll
        for (int ai = 0; ai < 2; ++ai) {
            u32x4 gbv[4][2], gav[4][2];
#pragma unroll
            for (int m = 0; m < 4; ++m)
#pragma unroll
                for (int bj = 0; bj < 2; ++bj) { const size_t go = (size_t)(u.pm * BM + ai * HALF + wr * 64 + m * 16 + fr) * ZG + C_G + col0 + bj * HALF;
                    gbv[m][bj] = *(const u32x4*)(zg + go + D); if (u.z == 0) gav[m][bj] = *(const u32x4*)(zg + go); else gav[m][bj] = (u32x4){0u, 0u, 0u, 0u}; }
#pragma unroll
            for (int m = 0; m < 4; ++m) {
                const int row = u.pm * BM + ai * HALF + wr * 64 + m * 16 + fr;
#pragma unroll
                for (int bj = 0; bj < 2; ++bj) {
                    const int col = col0 + bj * HALF;
                    const u32x4 gb = gbv[m][bj];
                    if (u.z == 0) {
                        const u32x4 ga = gav[m][bj];
                        f32x4 r0, r1;
                        r0[0] = bflo(ga.x) * __builtin_amdgcn_rcpf(bflo(gb.x)); r0[1] = bfhi(ga.x) * __builtin_amdgcn_rcpf(bfhi(gb.x)); r0[2] = bflo(ga.y) * __builtin_amdgcn_rcpf(bflo(gb.y)); r0[3] = bfhi(ga.y) * __builtin_amdgcn_rcpf(bfhi(gb.y));
                        r1[0] = bflo(ga.z) * __builtin_amdgcn_rcpf(bflo(gb.z)); r1[1] = bfhi(ga.z) * __builtin_amdgcn_rcpf(bfhi(gb.z)); r1[2] = bflo(ga.w) * __builtin_amdgcn_rcpf(bflo(gb.w)); r1[3] = bfhi(ga.w) * __builtin_amdgcn_rcpf(bfhi(gb.w));
                        acc[ai][bj][m][0] *= r0; acc[ai][bj][m][1] *= r1;
                    } else {
                        const f32x4 v0 = acc[ai][bj][m][0] * (f32x4){bflo(gb.x), bfhi(gb.x), bflo(gb.y), bfhi(gb.y)}, v1 = acc[ai][bj][m][1] * (f32x4){bflo(gb.z), bfhi(gb.z), bflo(gb.w), bfhi(gb.w)};
                        u32x4 w; w.x = cvt_pk_bf16(v0[0], v0[1]); w.y = cvt_pk_bf16(v0[2], v0[3]); w.z = cvt_pk_bf16(v1[0], v1[1]); w.w = cvt_pk_bf16(v1[2], v1[3]);
                        *(u32x4*)(mix + (size_t)row * D + col) = w;
                    }
                }
            }
            asm volatile("" ::: "memory");
        }
    }
};
struct EpiRes {
    static constexpr bool PERM = false, AFTER_DRAIN = false;
    __device__ static constexpr bool zero_after(const Unit&) { return true; }
    const float* base; float* xf; bf16_t* xb; float* ssn;
    __device__ __forceinline__ void init(f32x4 (&acc)[2][2][4][2], const Unit& u, int wr, int wc, int fr, int fq) const {
        const int col0 = u.pn * BM + wc * 32 + 4 * fq;
#pragma unroll
        for (int ai = 0; ai < 2; ++ai)
#pragma unroll
            for (int m = 0; m < 4; ++m) { const size_t off = (size_t)(u.pm * BM + ai * HALF + wr * 64 + m * 16 + fr) * D + col0;
#pragma unroll
                for (int bj = 0; bj < 2; ++bj)
#pragma unroll
                    for (int n = 0; n < 2; ++n) acc[ai][bj][m][n] = *(const f32x4*)(base + off + bj * HALF + n * 16); }
    }
    __device__ __forceinline__ void operator()(f32x4 (&acc)[2][2][4][2], const Unit& u, int wr, int wc, int fr, int fq, PG8_LAS unsigned char*) const {
        const int col0 = u.pn * BM + wc * 32 + 4 * fq;
#pragma unroll
        for (int ai = 0; ai < 2; ++ai)
#pragma unroll
            for (int m = 0; m < 4; ++m) {
                const int row = u.pm * BM + ai * HALF + wr * 64 + m * 16 + fr; const size_t off = (size_t)row * D + col0; float q = 0.f;
#pragma unroll
                for (int bj = 0; bj < 2; ++bj)
#pragma unroll
                    for (int n = 0; n < 2; ++n) { const f32x4 o = acc[ai][bj][m][n];
                        *(f32x4*)(xf + off + bj * HALF + n * 16) = o; q += (o[0] * o[0] + o[1] * o[1]) + (o[2] * o[2] + o[3] * o[3]);
                        if (xb) { u32x2 w; w.x = cvt_pk_bf16(o[0], o[1]); w.y = cvt_pk_bf16(o[2], o[3]); *(u32x2*)(xb + off + bj * HALF + n * 16) = w; } }
                if (ssn) { q += __shfl_xor(q, 16); q += __shfl_xor(q, 32); if (fq == 0) ssn[(size_t)row * 16 + u.pn * 4 + wc] = q; }
            }
    }
};
#define DPPF(oldv, src, ctrl, bc) __int_as_float(__builtin_amdgcn_update_dpp(__float_as_int(oldv), __float_as_int(src), (ctrl), 0xF, 0xF, (bc)))
struct EpiUp {
    static constexpr bool PERM = true, AFTER_DRAIN = false;
    __device__ __forceinline__ void init(f32x4 (&acc)[2][2][4][2], const Unit&, int, int, int, int) const {
#pragma unroll
        for (int a = 0; a < 2; ++a)
#pragma unroll
            for (int b = 0; b < 2; ++b)
#pragma unroll
                for (int m = 0; m < 4; ++m)
#pragma unroll
                    for (int n = 0; n < 2; ++n) acc[a][b][m][n] = (f32x4){0.f, 0.f, 0.f, 0.f};
    }
    __device__ static constexpr bool zero_after(const Unit&) { return true; }
    bf16_t* a; const float* ss; const float* cw; const float* cb; float* yb; int dup;
    __device__ __forceinline__ void operator()(f32x4 (&acc)[2][2][4][2], const Unit& u, int wr, int wc, int fr, int fq, PG8_LAS unsigned char* lds) const {
        const int wid = wr * 4 + wc;
        PG8_LAS float* X = (PG8_LAS float*)(lds + XOFF);
        float rsv[2][4];
#pragma unroll
        for (int ai = 0; ai < 2; ++ai)
#pragma unroll
            for (int m = 0; m < 4; ++m) rsv[ai][m] = rsqrtf(ss16_q(ss, u.pm * BM + ai * HALF + wr * 64 + m * 16 + fr, fq) * (1.0f / D) + EPS);
#pragma unroll
        for (int ai = 0; ai < 2; ++ai)
#pragma unroll
            for (int m = 0; m < 4; ++m) {
#pragma unroll
                for (int bj = 0; bj < 2; ++bj)
#pragma unroll
                    for (int n = 0; n < 2; ++n) acc[ai][bj][m][n] *= rsv[ai][m];
            }
#pragma unroll
        for (int ai = 0; ai < 2; ++ai) {
            if (fr == 0) {
#pragma unroll
                for (int bj = 0; bj < 2; ++bj)
#pragma unroll
                    for (int n = 0; n < 2; ++n) *(PG8_LAS f32x4*)(X + ((wid * 2 + ai) * 2 + 0) * 64 + 32 * bj + 8 * fq + 4 * n) = acc[ai][bj][0][n];
            }
            if (fr == 15) {
#pragma unroll
                for (int bj = 0; bj < 2; ++bj)
#pragma unroll
                    for (int n = 0; n < 2; ++n) *(PG8_LAS f32x4*)(X + ((wid * 2 + ai) * 2 + 1) * 64 + 32 * bj + 8 * fq + 4 * n) = acc[ai][bj][3][n];
            }
        }
        {
            const int ccol = u.pn * 128 + wc * 32 + 8 * fq;
            if (wr == 0 && fr < 2) {
#pragma unroll
                for (int bj = 0; bj < 2; ++bj)
#pragma unroll
                    for (int n = 0; n < 2; ++n) *(f32x4*)(yb + ((size_t)u.pm * 4 + fr) * FF2 + bj * FF + ccol + 4 * n) = acc[0][bj][0][n];
            }
            if (wr == 1 && fr >= 14) {
#pragma unroll
                for (int bj = 0; bj < 2; ++bj)
#pragma unroll
                    for (int n = 0; n < 2; ++n) *(f32x4*)(yb + ((size_t)u.pm * 4 + 2 + (fr - 14)) * FF2 + bj * FF + ccol + 4 * n) = acc[1][bj][3][n];
            }
        }
        asm volatile("s_waitcnt lgkmcnt(0)" ::: "memory"); __builtin_amdgcn_s_barrier(); asm volatile("" ::: "memory");
#pragma unroll
        for (int rep_ = 0; rep_ <= ((MK_EDUP & 1) ? 1 : 0); ++rep_) {
        if (rep_) {
#pragma unroll
            for (int ai = 0; ai < 2; ++ai)
#pragma unroll
                for (int bj = 0; bj < 2; ++bj)
#pragma unroll
                    for (int m = 0; m < 4; ++m)
#pragma unroll
                        for (int n = 0; n < 2; ++n) asm volatile("" : "+v"(acc[ai][bj][m][n]) :: "memory");
        }
#pragma unroll
        for (int n = 0; n < 2; ++n) {
            const int ccol = u.pn * 128 + wc * 32 + 8 * fq + 4 * n;
            f32x4 w0[2], w1[2], w2[2], bb[2];
#pragma unroll
            for (int bj = 0; bj < 2; ++bj) { w0[bj] = *(const f32x4*)(cw + bj * FF + ccol); w1[bj] = *(const f32x4*)(cw + FF2 + bj * FF + ccol); w2[bj] = *(const f32x4*)(cw + 2 * FF2 + bj * FF + ccol); bb[bj] = *(const f32x4*)(cb + bj * FF + ccol); }
#pragma unroll
            for (int ai = 0; ai < 2; ++ai) {
                const int pw = wr ? wid - 4 : wid + 4, pai = wr ? ai : 0;
                const int nw = wr ? wid - 4 : wid + 4, nai = wr ? 1 : ai;
                f32x4 xp[2], xn[2];
#pragma unroll
                for (int bj = 0; bj < 2; ++bj) { xp[bj] = *(PG8_LAS f32x4*)(X + ((pw * 2 + pai) * 2 + 1) * 64 + 32 * bj + 8 * fq + 4 * n); xn[bj] = *(PG8_LAS f32x4*)(X + ((nw * 2 + nai) * 2 + 0) * 64 + 32 * bj + 8 * fq + 4 * n); }
#pragma unroll
                for (int m = 0; m < 4; ++m) {
                    const int trow = ai * HALF + wr * 64 + m * 16 + fr;
                    float uv[2][4];
#pragma unroll
                    for (int bj = 0; bj < 2; ++bj)
#pragma unroll
                        for (int e = 0; e < 4; ++e) {
                            const float cur = acc[ai][bj][m][n][e];
                            float rp, rn;
                            if (m > 0) rp = DPPF(0.f, acc[ai][bj][m > 0 ? m - 1 : 0][n][e], 0x121, true); else rp = xp[bj][e];
                            if (m < 3) rn = DPPF(0.f, acc[ai][bj][m < 3 ? m + 1 : 3][n][e], 0x12F, true); else rn = xn[bj][e];
                            const float prev = DPPF(rp, cur, 0x111, false), next = DPPF(rn, cur, 0x101, false);
                            uv[bj][e] = bb[bj][e] + w0[bj][e] * prev + w1[bj][e] * cur + w2[bj][e] * next;
                        }
                    f32x4 o;
#pragma unroll
                    for (int e = 0; e < 4; ++e) o[e] = uv[0][e] * uv[1][e] * __builtin_amdgcn_rcpf(1.0f + __builtin_amdgcn_exp2f(-uv[1][e] * LOG2E));
                    u32x2 w; w.x = cvt_pk_bf16(o[0], o[1]); w.y = cvt_pk_bf16(o[2], o[3]);
                    if (trow != 0 && trow != 255) *(u32x2*)(a + (size_t)(u.pm * BM + trow) * FF + ccol) = w;
                    asm volatile("" ::: "memory");
                }
            }
        }
        }
    }
};

template <class Epi, class Sched, bool ALIGN_EPI = false, bool SP2 = false>
__device__ __forceinline__ void gemm_phase(PG8_LAS unsigned char* lds, const int K, const int lda, const Sched& S, const Epi& E) {
    int tid_ = threadIdx.x; asm volatile("" : "+v"(tid_));
    const int tid = tid_, wid = __builtin_amdgcn_readfirstlane(tid >> 6), lane = tid & 63, wr = wid >> 2, wc = wid & 3, fr = lane & 15, fq = lane >> 4;
    const int nt = K / BK;
    unsigned voffA[2], voffB[2];
#pragma unroll
    for (int i = 0; i < 2; ++i) { int R, C; stage_rc(tid * 16 + i * 8192, R, C); const int Rb = Epi::PERM ? ((R & ~31) + perm32(R & 31)) : R;
        voffA[i] = (unsigned)(R * lda + C) * 2u; voffB[i] = (unsigned)(Rb * K + C) * 2u; }
    const size_t kstep = (size_t)(BK * 2);
    const size_t hstepB = (size_t)HALF * K * 2;
    const size_t hstepA = (size_t)HALF * lda * 2;
    const unsigned ldsw = (unsigned)wid * 1024u;
    const int aoff = lds_byte(wr * 64 + fr, fq * 8), boff = lds_byte(wc * 32 + fr, fq * 8);
#define PG8_SA(b, h) (((b) * 2 + (h)) * HTB)
#define PG8_SB(b, h) ((4 + (b) * 2 + (h)) * HTB)
#define PG8_STAGE(bufoff, gbase, voff) do { _Pragma("unroll") for (int _i = 0; _i < 2; ++_i) \
        __builtin_amdgcn_global_load_lds((const unsigned*)((const char*)(gbase) + (voff)[_i]), (PG8_LAS unsigned*)(lds + (bufoff) + ldsw + _i * 8192), 16, 0, 0); } while (0)
#define PG8_LDA(dst, b, h) do { _Pragma("unroll") for (int m = 0; m < 4; ++m) _Pragma("unroll") for (int k = 0; k < 2; ++k) dst[m][k] = *(const PG8_LAS bf16x8*)(lds + PG8_SA(b, h) + aoff + m * 2048 + k * 1024); } while (0)
#define PG8_LDB(dst, b, h) do { _Pragma("unroll") for (int n = 0; n < 2; ++n) _Pragma("unroll") for (int k = 0; k < 2; ++k) dst[n][k] = *(const PG8_LAS bf16x8*)(lds + PG8_SB(b, h) + boff + n * 2048 + k * 1024); } while (0)
#define PG8_MMA(ai, bj, At, Bt) do { __builtin_amdgcn_s_setprio(1); _Pragma("unroll") for (int m = 0; m < 4; ++m) _Pragma("unroll") for (int n = 0; n < 2; ++n) _Pragma("unroll") for (int k = 0; k < 2; ++k) \
        acc[ai][bj][m][n] = __builtin_amdgcn_mfma_f32_16x16x32_bf16(Bt[n][k], At[m][k], acc[ai][bj][m][n], 0, 0, 0); __builtin_amdgcn_s_setprio(0); } while (0)
#define PG8_WAIT_V(n) asm volatile("s_waitcnt vmcnt(" #n ")" ::: "memory")
#define PG8_WAIT_L(n) asm volatile("s_waitcnt lgkmcnt(" #n ")" ::: "memory")
#define PG8_BAR __builtin_amdgcn_s_barrier()
#define PG8_SCHED __builtin_amdgcn_sched_barrier(0)
    Unit cur, nxt; int ui = 0;
    if (!S.next(0, cur)) return;
    f32x4 acc[2][2][4][2];
    E.init(acc, cur, wr, wc, fr, fq);
    bf16x8 At[4][2], B0[2][2], B1[2][2];
    const char* cA = S.aptr(cur); const char* cB = S.bptr(cur);
    S.a_ready(cur);
    if constexpr (SP2) {
        PG8_STAGE(PG8_SB(0, 0), cB, voffB); PG8_STAGE(PG8_SB(0, 1), cB + hstepB, voffB); PG8_STAGE(PG8_SA(0, 0), cA, voffA); PG8_STAGE(PG8_SA(0, 1), cA + hstepA, voffA);
        if (wr == 1) PG8_BAR;
        PG8_WAIT_V(2); PG8_BAR;
        PG8_STAGE(PG8_SB(1, 0), cB + kstep, voffB); PG8_STAGE(PG8_SA(1, 0), cA + kstep, voffA); PG8_STAGE(PG8_SB(1, 1), cB + hstepB + kstep, voffB);
        PG8_WAIT_V(6); PG8_BAR;
    } else {
        PG8_STAGE(PG8_SB(0, 0), cB, voffB); PG8_STAGE(PG8_SA(0, 0), cA, voffA); PG8_STAGE(PG8_SB(0, 1), cB + hstepB, voffB); PG8_STAGE(PG8_SA(0, 1), cA + hstepA, voffA);
        if (wr == 1) PG8_BAR;
        PG8_WAIT_V(4); PG8_BAR;
        PG8_STAGE(PG8_SB(1, 0), cB + kstep, voffB); PG8_STAGE(PG8_SA(1, 0), cA + kstep, voffA); PG8_STAGE(PG8_SB(1, 1), cB + hstepB + kstep, voffB);
        PG8_WAIT_V(6); PG8_BAR;
    }
    for (;;) {
        const bool has_next = S.next(ui + 1, nxt);
        const char* nA = has_next ? S.aptr(nxt) : cA; const char* nB = has_next ? S.bptr(nxt) : cB;
        for (int t = 0; t < nt; t += 2) {
            const bool last = (t == nt - 2);
            const char* a1 = cA + (size_t)(t + 1) * kstep;
            const char* a2 = last ? nA : cA + (size_t)(t + 2) * kstep; const char* b2 = last ? nB : cB + (size_t)(t + 2) * kstep;
            const char* a3 = a2 + kstep; const char* b3 = b2 + kstep;
            if (last && has_next) S.a_ready(nxt);
            if constexpr (SP2) {
            PG8_LDB(B0, 0, 0); PG8_LDB(B1, 0, 1); PG8_SCHED; PG8_LDA(At, 0, 0); PG8_STAGE(PG8_SA(1, 1), a1 + hstepA, voffA);
            PG8_WAIT_V(8); PG8_WAIT_L(0); PG8_BAR; PG8_MMA(0, 0, At, B0); PG8_MMA(0, 1, At, B1); PG8_BAR; PG8_SCHED;
            PG8_LDA(At, 0, 1); PG8_STAGE(PG8_SB(0, 0), b2, voffB); PG8_STAGE(PG8_SB(0, 1), b2 + hstepB, voffB); PG8_STAGE(PG8_SA(0, 0), a2, voffA);
            PG8_WAIT_V(8); PG8_WAIT_L(0); PG8_BAR; PG8_MMA(1, 0, At, B0); PG8_MMA(1, 1, At, B1); PG8_BAR; PG8_SCHED;
            PG8_LDB(B0, 1, 0); PG8_LDB(B1, 1, 1); PG8_SCHED; PG8_LDA(At, 1, 0); PG8_STAGE(PG8_SA(0, 1), a2 + hstepA, voffA);
            PG8_WAIT_V(8); PG8_WAIT_L(0); PG8_BAR; PG8_MMA(0, 0, At, B0); PG8_MMA(0, 1, At, B1); PG8_BAR; PG8_SCHED;
            PG8_LDA(At, 1, 1); PG8_STAGE(PG8_SB(1, 0), b3, voffB); PG8_STAGE(PG8_SB(1, 1), b3 + hstepB, voffB); PG8_STAGE(PG8_SA(1, 0), a3, voffA);
            PG8_WAIT_V(8); PG8_WAIT_L(0); PG8_BAR; PG8_MMA(1, 0, At, B0); PG8_MMA(1, 1, At, B1); PG8_BAR; PG8_SCHED;
            } else {
            PG8_LDB(B0, 0, 0); PG8_SCHED; PG8_LDA(At, 0, 0); PG8_STAGE(PG8_SA(1, 1), a1 + hstepA, voffA);
            PG8_WAIT_L(8); PG8_BAR; PG8_WAIT_L(0); PG8_MMA(0, 0, At, B0); PG8_BAR; PG8_SCHED;
            PG8_LDB(B1, 0, 1); PG8_STAGE(PG8_SB(0, 0), b2, voffB);
            PG8_BAR; PG8_WAIT_L(0); PG8_MMA(0, 1, At, B1); PG8_BAR;
            PG8_LDA(At, 0, 1); PG8_STAGE(PG8_SA(0, 0), a2, voffA);
            PG8_BAR; PG8_WAIT_L(0); PG8_MMA(1, 0, At, B0); PG8_BAR; PG8_SCHED;
            PG8_STAGE(PG8_SB(0, 1), b2 + hstepB, voffB);
            PG8_WAIT_V(6); PG8_BAR; PG8_MMA(1, 1, At, B1); PG8_BAR;
            PG8_LDB(B0, 1, 0); PG8_SCHED; PG8_LDA(At, 1, 0); PG8_STAGE(PG8_SA(0, 1), a2 + hstepA, voffA);
            PG8_WAIT_L(8); PG8_BAR; PG8_WAIT_L(0); PG8_MMA(0, 0, At, B0); PG8_BAR; PG8_SCHED;
            PG8_LDB(B1, 1, 1); PG8_STAGE(PG8_SB(1, 0), b3, voffB);
            PG8_BAR; PG8_WAIT_L(0); PG8_MMA(0, 1, At, B1); PG8_BAR;
            PG8_LDA(At, 1, 1); PG8_STAGE(PG8_SA(1, 0), a3, voffA);
            PG8_BAR; PG8_WAIT_L(0); PG8_MMA(1, 0, At, B0); PG8_BAR; PG8_SCHED;
            PG8_STAGE(PG8_SB(1, 1), b3 + hstepB, voffB);
            PG8_WAIT_V(6); PG8_BAR; PG8_MMA(1, 1, At, B1); PG8_BAR;
            }
        }
        if constexpr (ALIGN_EPI) { if (wr == 0) PG8_BAR; }
        if constexpr (!Epi::AFTER_DRAIN) { E(acc, cur, wr, wc, fr, fq, lds); S.done(cur); }
        if (!has_next) break;
        if (Epi::zero_after(cur)) E.init(acc, nxt, wr, wc, fr, fq);
        cur = nxt; cA = nA; cB = nB; ++ui;
        if constexpr (ALIGN_EPI) { if (wr == 1) PG8_BAR; }
    }
    PG8_WAIT_V(0);
    if constexpr (!ALIGN_EPI) { if (wr == 0) PG8_BAR; }
    PG8_BAR;
    if constexpr (Epi::AFTER_DRAIN) { E.fused(acc, cur, wr, wc, fr, fq, lds, wid, lane); S.done(cur); }
#undef PG8_SA
#undef PG8_SB
#undef PG8_STAGE
#undef PG8_LDA
#undef PG8_LDB
#undef PG8_MMA
#undef PG8_WAIT_V
#undef PG8_WAIT_L
#undef PG8_BAR
#undef PG8_SCHED
}
}

namespace att {
using namespace nv;
#define ALAS __attribute__((address_space(3)))
typedef short bf16x8 __attribute__((ext_vector_type(8)));
typedef short s16x4 __attribute__((ext_vector_type(4)));
typedef float f32x16 __attribute__((ext_vector_type(16)));
typedef float f32x4 __attribute__((ext_vector_type(4)));
typedef unsigned u32x4 __attribute__((ext_vector_type(4)));
typedef unsigned u32x2 __attribute__((ext_vector_type(2)));
typedef short v4i16_t __attribute__((ext_vector_type(4)));
typedef float f32x2_t __attribute__((ext_vector_type(2))); typedef __bf16 bf16x2_t __attribute__((ext_vector_type(2)));
constexpr int LUT_OFF = 98304, LUT_STRIDE = 520, GT_OFF = LUT_OFF + 12 * LUT_STRIDE * 4;
static_assert(GT_OFF + 512 <= 131072, "attention tables inside the ring region");
constexpr float NEG = -30000.f, THR = 6.f;
__device__ __forceinline__ unsigned cvtpk(float lo, float hi) { f32x2_t v = {lo, hi}; bf16x2_t b = __builtin_convertvector(v, bf16x2_t); return __builtin_bit_cast(unsigned, b); }
__device__ __forceinline__ s16x4 vtr(ALAS const unsigned char* p) { return __builtin_bit_cast(s16x4, __builtin_amdgcn_ds_read_tr16_b64_v4i16((ALAS v4i16_t*)p)); }
__device__ __forceinline__ void glds16(const void* gsrc, unsigned lds_dst) { unsigned keep;
    asm volatile("s_mov_b32 %0, m0\n\ts_mov_b32 m0, %2\n\ts_nop 0\n\tglobal_load_lds_dwordx4 %1, off\n\ts_mov_b32 m0, %0" : "=&s"(keep) : "v"(gsrc), "s"(lds_dst) : "memory"); }
__device__ __forceinline__ float swap_add(float v) { auto rr = __builtin_amdgcn_permlane32_swap(__float_as_uint(v), __float_as_uint(v), false, false); return __uint_as_float(rr[0]) + __uint_as_float(rr[1]); }
__device__ __forceinline__ float swap_max(float v) { auto rr = __builtin_amdgcn_permlane32_swap(__float_as_uint(v), __float_as_uint(v), false, false); return fmaxf(__uint_as_float(rr[0]), __uint_as_float(rr[1])); }
#define MX3(a, b, c) __builtin_fmaxf(__builtin_fmaxf((a), (b)), (c))

__device__ __forceinline__ void attn_tables(ALAS unsigned char* lds, const float* __restrict__ lutg, const float* __restrict__ subg, float osc) {
    int tid = threadIdx.x; asm volatile("" : "+v"(tid));
    ALAS float* lut = (ALAS float*)(lds + LUT_OFF); ALAS float* gt = (ALAS float*)(lds + GT_OFF);
    for (int i = tid; i < 12 * LUT_STRIDE; i += 512) lut[i] = lutg[i];
    if (tid < 128) gt[tid] = subg[tid] * osc;
    __syncthreads();
}
__device__ __forceinline__ float g4_max(float v) { v = fmaxf(v, __shfl_xor(v, 16)); return fmaxf(v, __shfl_xor(v, 32)); }
__device__ __forceinline__ float g4_sum(float v) { v += __shfl_xor(v, 16); return v + __shfl_xor(v, 32); }

template <bool ISB, int VAR = 0>
__device__ __forceinline__ void attn_unit(ALAS unsigned char* lds, bf16* zg, const float* __restrict__ lutg, int b, int hsel, int q0, const float* __restrict__ sinkp, float lam, float osc, const float* __restrict__ subg, bf16* odry) {
    int tid_ = threadIdx.x; asm volatile("" : "+v"(tid_));
    const int tid = tid_, lane = tid & 63, c16 = lane & 15, g = lane >> 4; const int wid = __builtin_amdgcn_readfirstlane(tid >> 6);
    constexpr int NDVB = ISB ? 8 : 4, BUF = ISB ? 32768 : 16384, VOFF = ISB ? 16384 : 8192, VROW = ISB ? 256 : 128;
    const int map = ISB ? (wid >> 2) : 0, qsub = ISB ? (wid & 3) : (wid & 1), gsel = ISB ? 0 : (wid >> 1);
    const int head = ISB ? hsel : hsel * 4 + gsel;
    const int qrow0 = q0 + 32 * qsub;
    const int qcol = ISB ? (C_QB + head * 128 + map * 64) : (C_QA + head * 64);
    const int kcol = ISB ? (C_KB + head * 128) : (C_KA + hsel * 64);
    const int vcol = ISB ? (C_VB + head * 128) : (C_VA + hsel * 64);
    const size_t rowbase = (size_t)b * S;
    int kt0 = 0, kt1 = S / 64;
    if (!ISB) { kt0 = q0 / 64 - 2; if (kt0 < 0) kt0 = 0; kt1 = q0 / 64 + 3; if (kt1 > S / 64) kt1 = S / 64; }
    const int nt = kt1 - kt0;
    ALAS float* lut = (ALAS float*)(lds + LUT_OFF) + (ISB ? 8 + head : hsel * 4 + gsel) * LUT_STRIDE;
    ALAS float* gt = (ALAS float*)(lds + GT_OFF);
    const float sink2 = ISB ? 0.f : sinkp[head] * LOG2E;
    bf16x8 qr[2][2];
#pragma unroll
    for (int qb = 0; qb < 2; ++qb) { const bf16* qp = zg + (rowbase + qrow0 + 16 * qb + c16) * ZG + qcol + 8 * g;
#pragma unroll
        for (int ks = 0; ks < 2; ++ks) qr[qb][ks] = *(const bf16x8*)(qp + 32 * ks); }
    const unsigned lds0 = (unsigned)(size_t)lds;
    const bf16* kp_[2]; const bf16* vp_[2];
#pragma unroll
    for (int i_ = 0; i_ < 2; ++i_) { const int p_ = ISB ? wid * 2 + i_ : wid;
        kp_[i_] = zg + (rowbase + (size_t)kt0 * 64 + (p_ & 7) * 8 + (lane >> 3)) * ZG + kcol + (ISB ? (p_ >> 3) * 64 : 0) + ((lane & 7) ^ (lane >> 3)) * 8;
        vp_[i_] = ISB ? zg + (rowbase + (size_t)kt0 * 64 + 4 * p_ + (lane >> 4)) * ZG + vcol + ((((lane & 15) >> 1) ^ (4 * (p_ & 1) + (lane >> 4))) * 16) + 8 * (lane & 1)
                      : zg + (rowbase + (size_t)kt0 * 64 + 8 * p_ + (lane >> 3)) * ZG + vcol + ((((lane & 7) >> 1) ^ ((lane >> 4) & 3)) * 16) + 8 * (lane & 1); }
#define ATT_ISSUE(bo) do { \
        _Pragma("unroll") for (int i_ = 0; i_ < (ISB ? 2 : 1); ++i_) { const int p_ = ISB ? wid * 2 + i_ : wid; \
            glds16(kp_[i_], (unsigned)__builtin_amdgcn_readfirstlane((int)(lds0 + (bo) + p_ * 1024))); \
            glds16(vp_[i_], (unsigned)__builtin_amdgcn_readfirstlane((int)(lds0 + (bo) + VOFF + p_ * 1024))); \
            kp_[i_] += 64 * ZG; vp_[i_] += 64 * ZG; } } while (0)
#define ATT_SB() __builtin_amdgcn_sched_barrier(0)
    float mhat[2] = {0.f, 0.f}, lsum[2] = {0.f, 0.f};
    f32x4 o[2][NDVB];
#pragma unroll
    for (int qb = 0; qb < 2; ++qb)
#pragma unroll
        for (int d = 0; d < NDVB; ++d) o[qb][d] = (f32x4){0.f, 0.f, 0.f, 0.f};
    const int kfo = (ISB ? map * 8192 : 0) + c16 * 128 + ((g ^ (c16 & 7)) * 16);
    const int vq = (lane & 15) >> 2, vsw = ISB ? (4 * (g & 1) + vq) : (2 * (g & 1) + (vq >> 1));
    const int vfo = VOFF + (4 * g + vq) * VROW + (lane & 3) * 8;
    u32x4 pw[2][2];
    const float cfar_r = ISB ? lut[256 + 128] : 0.f, cfar_l = ISB ? lut[256 - 128] : 0.f;
#define ATT_QK(P, t, so) do { const int kb_ = (t) * 64; float cf_ = 0.f; \
        if (ISB) { if (kb_ - qrow0 - 31 >= 91) cf_ = cfar_r; else if (kb_ + 63 - qrow0 <= -91) cf_ = cfar_l; } \
        const float c0_ = cf_ - mhat[0], c1_ = cf_ - mhat[1]; const f32x4 ci0_ = (f32x4){c0_, c0_, c0_, c0_}, ci1_ = (f32x4){c1_, c1_, c1_, c1_}; \
        ALAS const unsigned char* kp = lds + (so) + kfo; \
        _Pragma("unroll") for (int kb = 0; kb < 4; ++kb) { \
            const bf16x8 k0_ = *(ALAS const bf16x8*)(kp + kb * 2048), k1_ = *(ALAS const bf16x8*)((ALAS const unsigned char*)((unsigned)(size_t)kp ^ 64u) + kb * 2048); \
            P[0][kb] = __builtin_amdgcn_mfma_f32_16x16x32_bf16(k0_, qr[0][0], ci0_, 0, 0, 0); P[1][kb] = __builtin_amdgcn_mfma_f32_16x16x32_bf16(k0_, qr[1][0], ci1_, 0, 0, 0); \
            P[0][kb] = __builtin_amdgcn_mfma_f32_16x16x32_bf16(k1_, qr[0][1], P[0][kb], 0, 0, 0); P[1][kb] = __builtin_amdgcn_mfma_f32_16x16x32_bf16(k1_, qr[1][1], P[1][kb], 0, 0, 0); } } while (0)
#define ATT_DECIDE(P, t, first) do { const int kb_ = (t) * 64; \
        if (!ISB || !((kb_ - qrow0 - 31 >= 91) || (kb_ + 63 - qrow0 <= -91))) { \
            ALAS const float* lp = lut + (kb_ - (qrow0 + c16) + 256 + 4 * g); \
            _Pragma("unroll") for (int qb = 0; qb < 2; ++qb) { float lv_[16]; \
                _Pragma("unroll") for (int kb = 0; kb < 4; ++kb) _Pragma("unroll") for (int r = 0; r < 4; ++r) lv_[4 * kb + r] = lp[16 * kb - 16 * qb + r]; \
                _Pragma("unroll") for (int kb = 0; kb < 4; ++kb) _Pragma("unroll") for (int r = 0; r < 4; ++r) P[qb][kb][r] += lv_[4 * kb + r]; } } \
        float rm0_ = MX3(MX3(P[0][0][0], P[0][0][1], P[0][0][2]), P[0][0][3], P[0][1][0]), rm1_ = MX3(MX3(P[1][0][0], P[1][0][1], P[1][0][2]), P[1][0][3], P[1][1][0]); \
        rm0_ = MX3(MX3(rm0_, P[0][1][1], P[0][1][2]), P[0][1][3], P[0][2][0]); rm1_ = MX3(MX3(rm1_, P[1][1][1], P[1][1][2]), P[1][1][3], P[1][2][0]); \
        rm0_ = MX3(MX3(rm0_, P[0][2][1], P[0][2][2]), P[0][2][3], P[0][3][0]); rm1_ = MX3(MX3(rm1_, P[1][2][1], P[1][2][2]), P[1][2][3], P[1][3][0]); \
        rm0_ = MX3(MX3(rm0_, P[0][3][1], P[0][3][2]), P[0][3][3], rm0_); rm1_ = MX3(MX3(rm1_, P[1][3][1], P[1][3][2]), P[1][3][3], rm1_); \
        if ((first) || __any(__builtin_fmaxf(rm0_, rm1_) > THR)) { \
            const float f0_ = g4_max(rm0_), f1_ = g4_max(rm1_); \
            const float dl0 = (first) ? f0_ : __builtin_fmaxf(f0_, 0.f), dl1 = (first) ? f1_ : __builtin_fmaxf(f1_, 0.f); \
            mhat[0] += dl0; mhat[1] += dl1; \
            _Pragma("unroll") for (int kb = 0; kb < 4; ++kb) { P[0][kb] -= dl0; P[1][kb] -= dl1; } \
            if (!(first)) { const float s0_ = __builtin_amdgcn_exp2f(-dl0), s1_ = __builtin_amdgcn_exp2f(-dl1); lsum[0] *= s0_; lsum[1] *= s1_; \
                _Pragma("unroll") for (int d = 0; d < NDVB; ++d) { o[0][d] *= s0_; o[1][d] *= s1_; } } } } while (0)
#define ATT_FINISH(P) do { \
        _Pragma("unroll") for (int qb = 0; qb < 2; ++qb) { float sa_ = 0.f; \
            _Pragma("unroll") for (int kb = 0; kb < 4; ++kb) _Pragma("unroll") for (int r = 0; r < 4; ++r) { P[qb][kb][r] = __builtin_amdgcn_exp2f(P[qb][kb][r]); sa_ += P[qb][kb][r]; } \
            lsum[qb] += sa_; \
            _Pragma("unroll") for (int s_ = 0; s_ < 2; ++s_) pw[qb][s_] = (u32x4){cvtpk(P[qb][2 * s_][0], P[qb][2 * s_][1]), cvtpk(P[qb][2 * s_][2], P[qb][2 * s_][3]), cvtpk(P[qb][2 * s_ + 1][0], P[qb][2 * s_ + 1][1]), cvtpk(P[qb][2 * s_ + 1][2], P[qb][2 * s_ + 1][3])}; } } while (0)
#define ATT_LDV2(dst, s_, d0_) do { _Pragma("unroll") for (int dd = 0; dd < 2; ++dd) { ALAS const unsigned char* a_ = vp + (s_) * 32 * VROW + ((((d0_) + dd) ^ vsw) * 32); dst[2 * dd] = vtr(a_); dst[2 * dd + 1] = vtr(a_ + 16 * VROW); } } while (0)
#define ATT_PV2(src, s_, d0_) do { __builtin_amdgcn_s_setprio(1); _Pragma("unroll") for (int dd = 0; dd < 2; ++dd) { \
            const bf16x8 vf_ = (bf16x8){src[2 * dd][0], src[2 * dd][1], src[2 * dd][2], src[2 * dd][3], src[2 * dd + 1][0], src[2 * dd + 1][1], src[2 * dd + 1][2], src[2 * dd + 1][3]}; \
            o[0][(d0_) + dd] = __builtin_amdgcn_mfma_f32_16x16x32_bf16(vf_, __builtin_bit_cast(bf16x8, pw[0][s_]), o[0][(d0_) + dd], 0, 0, 0); \
            o[1][(d0_) + dd] = __builtin_amdgcn_mfma_f32_16x16x32_bf16(vf_, __builtin_bit_cast(bf16x8, pw[1][s_]), o[1][(d0_) + dd], 0, 0, 0); } __builtin_amdgcn_s_setprio(0); } while (0)
#define ATT_PV(so) do { ALAS const unsigned char* vp = lds + (so) + vfo; s16x4 va[4], vb[4]; constexpr int NG_ = NDVB / 2; \
        ATT_LDV2(va, 0, 0); ATT_SB(); \
        _Pragma("unroll") for (int k_ = 0; k_ < 2 * NG_; k_ += 2) { \
            ATT_LDV2(vb, (k_ + 1) / NG_, 2 * ((k_ + 1) % NG_)); ATT_SB(); \
            ATT_PV2(va, k_ / NG_, 2 * (k_ % NG_)); ATT_SB(); \
            if (k_ + 2 < 2 * NG_) { ATT_LDV2(va, (k_ + 2) / NG_, 2 * ((k_ + 2) % NG_)); ATT_SB(); } \
            ATT_PV2(vb, (k_ + 1) / NG_, 2 * ((k_ + 1) % NG_)); ATT_SB(); } } while (0)
#define ATT_SLOT(i) (ISB ? (((i) % 3) * BUF) : ((i) * BUF))
#define ATT_STEP(i, PC, PP) do { \
        if (ISB) { asm volatile("s_waitcnt vmcnt(0)" ::: "memory"); __syncthreads(); if ((i) + 1 < nt) ATT_ISSUE(ATT_SLOT((i) + 1)); } \
        ATT_QK(PC, kt0 + (i), ATT_SLOT(i)); ATT_SB(); \
        ATT_FINISH(PP); ATT_SB(); \
        ATT_PV(ATT_SLOT((i) - 1)); ATT_SB(); \
        ATT_DECIDE(PC, kt0 + (i), false); ATT_SB(); } while (0)
    f32x4 pA[2][4], pB[2][4];
    if (ISB) { ATT_ISSUE(0); asm volatile("s_waitcnt vmcnt(0)" ::: "memory"); __syncthreads(); if (nt > 1) ATT_ISSUE(BUF); }
    else {
#pragma unroll 1
        for (int i = 0; i < nt; ++i) ATT_ISSUE(i * BUF);
        asm volatile("s_waitcnt vmcnt(0)" ::: "memory"); __syncthreads();
    }
    ATT_QK(pA, kt0, 0); ATT_SB();
    ATT_DECIDE(pA, kt0, true); ATT_SB();
    int i = 1;
#pragma unroll 1
    for (; i + 1 < nt; i += 2) {
        ATT_STEP(i, pB, pA);
        ATT_STEP(i + 1, pA, pB);
    }
    if (i < nt) {
        ATT_STEP(i, pB, pA);
        ATT_FINISH(pB); ATT_SB(); ATT_PV(ATT_SLOT(nt - 1));
    } else {
        ATT_FINISH(pA); ATT_SB(); ATT_PV(ATT_SLOT(nt - 1));
    }
#undef ATT_ISSUE
#undef ATT_SB
#undef ATT_QK
#undef ATT_DECIDE
#undef ATT_FINISH
#undef ATT_LDV2
#undef ATT_PV2
#undef ATT_PV
#undef ATT_SLOT
#undef ATT_STEP
    float inv[2];
#pragma unroll
    for (int qb = 0; qb < 2; ++qb) { float l_ = g4_sum(lsum[qb]); if (!ISB) l_ += __builtin_amdgcn_exp2f(sink2 - mhat[qb]); inv[qb] = 1.0f / l_; }
    constexpr int DVE = ISB ? 128 : 64, SPITCH = DVE * 2 + 8;
    bf16* obase = odry ? odry + (rowbase + qrow0) * D + (ISB ? (512 + head * 128) : (head * 64)) : zg + (rowbase + qrow0) * ZG + (ISB ? (C_QB + head * 128) : (C_QA + head * 64));
    const size_t opitch = odry ? D : ZG;
    ALAS unsigned char* stg = lds + (ISB ? qsub * 16384 : wid * 4608);
#define ATT_OUT() do { asm volatile("s_waitcnt lgkmcnt(0)" ::: "memory"); \
        constexpr int LPR = DVE / 8, RPI = 64 / LPR; \
        _Pragma("unroll") for (int i_ = 0; i_ < 32 / RPI; ++i_) { const int row_ = i_ * RPI + lane / LPR, ch_ = lane % LPR; \
            const u32x2 a_ = *(ALAS const u32x2*)(stg + row_ * SPITCH + ch_ * 16), b_ = *(ALAS const u32x2*)(stg + row_ * SPITCH + ch_ * 16 + 8); \
            *(u32x4*)(obase + (size_t)row_ * opitch + ch_ * 8) = (u32x4){a_.x, a_.y, b_.x, b_.y}; } } while (0)
    if (ISB) {
        __syncthreads();
        ALAS float* cs = (ALAS float*)lds;
        if (map == 1) {
#pragma unroll
            for (int qb = 0; qb < 2; ++qb) { const float sc = -lam * inv[qb];
#pragma unroll
                for (int d = 0; d < NDVB; ++d)
#pragma unroll
                    for (int r = 0; r < 4; ++r) cs[(qsub * 64 + (qb * NDVB + d) * 4 + r) * 64 + lane] = o[qb][d][r] * sc; } }
        __syncthreads();
        if (map == 0) {
            float rstd[2];
#pragma unroll
            for (int qb = 0; qb < 2; ++qb) { float q = 0.f;
#pragma unroll
                for (int d = 0; d < NDVB; ++d)
#pragma unroll
                    for (int r = 0; r < 4; ++r) { const float v = o[qb][d][r] * inv[qb] + cs[(qsub * 64 + (qb * NDVB + d) * 4 + r) * 64 + lane]; o[qb][d][r] = v; q += v * v; }
                rstd[qb] = rsqrtf(g4_sum(q) * (1.0f / 128.0f) + EPS); }
            asm volatile("s_waitcnt lgkmcnt(0)" ::: "memory");
#pragma unroll
            for (int qb = 0; qb < 2; ++qb)
#pragma unroll
                for (int d = 0; d < NDVB; ++d) { const int dv0 = 16 * d + 4 * g; const f32x4 gv = *(ALAS const f32x4*)(gt + dv0);
                    u32x2 w; w.x = cvtpk(o[qb][d][0] * rstd[qb] * gv[0], o[qb][d][1] * rstd[qb] * gv[1]); w.y = cvtpk(o[qb][d][2] * rstd[qb] * gv[2], o[qb][d][3] * rstd[qb] * gv[3]);
                    *(ALAS u32x2*)(stg + (16 * qb + c16) * SPITCH + dv0 * 2) = w; }
            ATT_OUT();
        }
    } else {
        __syncthreads();
#pragma unroll
        for (int qb = 0; qb < 2; ++qb)
#pragma unroll
            for (int d = 0; d < NDVB; ++d) { const int dv0 = 16 * d + 4 * g;
                u32x2 w; w.x = cvtpk(o[qb][d][0] * inv[qb], o[qb][d][1] * inv[qb]); w.y = cvtpk(o[qb][d][2] * inv[qb], o[qb][d][3] * inv[qb]);
                *(ALAS u32x2*)(stg + (16 * qb + c16) * SPITCH + dv0 * 2) = w; }
        ATT_OUT();
    }
#undef ATT_OUT
    __syncthreads();
}
#undef MX3
}

#ifndef MK_VAR
#define MK_VAR 0
#endif
#define MK_DUP 0
#define MK_DSEL 0
namespace mk {
using namespace nv;
constexpr int NWAVES = 8;
constexpr size_t MiB = 1u << 20;
constexpr size_t WS_CTL = 0, CTL_ZERO_BYTES = 1 * MiB;
constexpr size_t WS_LUT = 512 * 1024;
constexpr size_t WS_SS = 1 * MiB;
constexpr size_t WS_XB = 6 * MiB;
constexpr size_t WS_ZG = 38 * MiB;
constexpr size_t WS_A = 38 * MiB;
constexpr size_t WS_YB = 126 * MiB;
constexpr size_t WS_MIX = 174 * MiB;
constexpr size_t WS_W = 206 * MiB;
constexpr size_t WL_IN = 0, WL_A = (size_t)ZG * D, WL_B = WL_A + (size_t)D * 512, WL_O = WL_B + (size_t)D * 512, WL_UP = WL_O + (size_t)D * D, WL_DN = WL_UP + (size_t)FF2 * D, WL_END = WL_DN + (size_t)D * FF;
constexpr size_t WS_END = 322 * MiB;
static_assert(WS_W + 4 * WL_END * 2 <= WS_END && WS_YB + (size_t)64 * 4 * FF2 * 4 <= WS_MIX && WS_A + (size_t)T * FF * 2 <= WS_YB, "d_ws map");
constexpr int CW_Q = 2048;
constexpr int CW_BAR = 4096;
constexpr int N_PHASES = 1 + 6 * L;
constexpr int RING_OFF = 0, RING_BYTES = 131072, LDSCTL_OFF = RING_BYTES, MISC_OFF = LDSCTL_OFF + 320;
constexpr int LDS_BYTES = 147456;
static_assert(pg8::XOFF + 8192 <= LDS_BYTES && MISC_OFF + 128 <= pg8::XOFF, "LDS map");

#define GAS __attribute__((address_space(1)))
#define LAS __attribute__((address_space(3)))
typedef unsigned v4u __attribute__((ext_vector_type(4)));
typedef float f32x4 __attribute__((ext_vector_type(4)));
typedef GAS unsigned gu32;
#define RLX_AGENT __ATOMIC_RELAXED, __HIP_MEMORY_SCOPE_AGENT
#define LDS_WAIT() asm volatile("s_waitcnt lgkmcnt(0)" ::: "memory")
#define VM_WAIT() asm volatile("s_waitcnt vmcnt(0)" ::: "memory")
__device__ __forceinline__ unsigned f2bfu(float f) { unsigned u = __builtin_bit_cast(unsigned, f); return (u + 0x7fffu + ((u >> 16) & 1u)) >> 16; }
__device__ __forceinline__ unsigned pk2(float lo, float hi) { return f2bfu(lo) | (f2bfu(hi) << 16); }

#define XB_TMO      128
#define XB_XCNT(j)  (256  + 64 * (j))
#define XB_XSUB(j)  (1280 + 64 * (j))
#define XB_XGEN(j)  (2304 + 64 * (j))
#define XB_TOP      3328
#define XB_TOPGEN   3392
#define XCD_BAR_WORDS 3456
#define XB_SPIN_CAP (1u << 18)

__device__ __forceinline__ unsigned xb_ld(unsigned* p)              { return __hip_atomic_load(p, __ATOMIC_RELAXED, __HIP_MEMORY_SCOPE_AGENT); }
__device__ __forceinline__ unsigned xb_add(unsigned* p, unsigned v) { return __hip_atomic_fetch_add(p, v, __ATOMIC_RELAXED, __HIP_MEMORY_SCOPE_AGENT); }
__device__ __forceinline__ unsigned xb_xcc_id() { return (unsigned)__builtin_amdgcn_s_getreg((3 << 11) | 20) & 0xFu; }
#define XB_SPIN(cond, bar) do { unsigned _sp = 0; while (cond) { __builtin_amdgcn_s_sleep(1); \
    if ((++_sp & 255u) == 0u) { if (xb_ld(&(bar)[XB_TMO])) break; if (_sp > XB_SPIN_CAP) { atomicAdd(&(bar)[XB_TMO], 1u); break; } } } } while (0)

struct XcdBarrier {
    unsigned* bar; unsigned x;
    volatile LAS unsigned* st;
};

__device__ __forceinline__ XcdBarrier xcd_barrier_post(unsigned* bar, volatile LAS unsigned* st) {
    XcdBarrier b; b.bar = bar; b.x = xb_xcc_id(); b.st = st;
    if (threadIdx.x == 0) (void)xb_add(&bar[XB_XCNT(b.x)], 1u);
    return b;
}
__device__ __forceinline__ void xcd_barrier_complete(unsigned* bar, unsigned x, unsigned& nloc, unsigned& nx) {
    const unsigned G = gridDim.x * gridDim.y * gridDim.z;
    unsigned sum, cnt, mine, sp = 0u;
    for (;;) {
        sum = 0u; cnt = 0u; mine = 0u;
#pragma unroll
        for (unsigned j = 0; j < 16; ++j) { const unsigned c = xb_ld(&bar[XB_XCNT(j)]); sum += c; cnt += (c > 0u) ? 1u : 0u; mine = (j == x) ? c : mine; }
        if (sum == G) break;
        __builtin_amdgcn_s_sleep(1);
        if ((++sp & 255u) == 0u) { if (xb_ld(&bar[XB_TMO])) break; if (sp > XB_SPIN_CAP) { atomicAdd(&bar[XB_TMO], 1u); break; } }
    }
    nloc = mine > 0u ? mine : 1u; nx = cnt > 0u ? cnt : 1u;
}

__device__ __forceinline__ void xcd_barrier(const XcdBarrier& b) {
    asm volatile("s_waitcnt vmcnt(0)" ::: "memory");
    __syncthreads();
    if (threadIdx.x == 0) {
        unsigned* bar = b.bar;
        __builtin_amdgcn_s_waitcnt(0);
        unsigned nloc = b.st[0], nx = b.st[1];
        if (nloc == 0u) { xcd_barrier_complete(bar, b.x, nloc, nx); b.st[0] = nloc; b.st[1] = nx; }
        const unsigned old = xb_add(&bar[XB_XSUB(b.x)], 1u);
        const unsigned gen = old / nloc;
        if (old + 1u == (gen + 1u) * nloc) {
            __builtin_amdgcn_fence(__ATOMIC_RELEASE, "agent");
            asm volatile("s_waitcnt vmcnt(0)" ::: "memory");
            const unsigned og = xb_add(&bar[XB_TOP], 1u);
            const unsigned tg = og / nx;
            if (og + 1u == (tg + 1u) * nx) xb_add(&bar[XB_TOPGEN], 1u);
            else XB_SPIN(xb_ld(&bar[XB_TOPGEN]) == tg, bar);
            __builtin_amdgcn_fence(__ATOMIC_ACQUIRE, "agent");
            xb_add(&bar[XB_XGEN(b.x)], 1u);
            asm volatile("s_waitcnt vmcnt(0)" ::: "memory");
        } else {
            XB_SPIN(xb_ld(&bar[XB_XGEN(b.x)]) == gen, bar);
            __builtin_amdgcn_fence(__ATOMIC_ACQUIRE, "agent");
            asm volatile("s_waitcnt vmcnt(0)" ::: "memory");
        }
    }
    __syncthreads();
}


struct Args { const float* in[24]; float* out; unsigned char* ws; int ph_lo, ph_hi, li, pad; };

__device__ __forceinline__ void p0_transpose_item(const float* __restrict__ W, int ldw, int K, int k0, int n0, bf16* __restrict__ WT, int vrow0, const float* __restrict__ gain, LAS float* scr, int lane) {
    f32x4 v[8];
    const float* wp = W + (size_t)(k0 + (lane >> 3)) * ldw + n0 + 4 * (lane & 7);
#pragma unroll
    for (int i = 0; i < 8; ++i) v[i] = __builtin_nontemporal_load((const f32x4*)(wp + (size_t)(8 * i) * ldw));
    if (gain) {
#pragma unroll
        for (int i = 0; i < 8; ++i) v[i] *= gain[k0 + 8 * i + (lane >> 3)];
    }
#pragma unroll
    for (int i = 0; i < 8; ++i) { LAS float* d = scr + (8 * i + (lane >> 3)) * 33 + 4 * (lane & 7); d[0] = v[i].x; d[1] = v[i].y; d[2] = v[i].z; d[3] = v[i].w; }
    LDS_WAIT(); asm volatile("" ::: "memory");
    const int c = lane & 7;
#pragma unroll
    for (int j = 0; j < 4; ++j) { const int n = (lane >> 3) + 8 * j; const LAS float* s = scr + (8 * c) * 33 + n;
        v4u o; o.x = pk2(s[0 * 33], s[1 * 33]); o.y = pk2(s[2 * 33], s[3 * 33]); o.z = pk2(s[4 * 33], s[5 * 33]); o.w = pk2(s[6 * 33], s[7 * 33]);
        *(GAS v4u*)(WT + (size_t)(vrow0 + n) * K + k0 + 8 * c) = o; }
    LDS_WAIT(); asm volatile("" ::: "memory");
}
__device__ __forceinline__ int vrow_in(int c) { const int pn = c >> 8, cr = c & 255, wc = cr >> 6, bj = (cr >> 5) & 1; return pn * 256 + bj * 128 + wc * 32; }
__device__ __forceinline__ int vrow_up(int c) { const int gs = c >= FF ? 1 : 0, cc = c - gs * FF, pn = cc >> 7, wc = (cc >> 5) & 3; return pn * 256 + gs * 128 + wc * 32; }

__global__ void __launch_bounds__(NWAVES * 64, 2) skel_fwd(Args args) {
    extern __shared__ __attribute__((aligned(16))) unsigned char lds_raw[];
    LAS unsigned char* lds = (LAS unsigned char*)lds_raw;
    volatile LAS unsigned* MISC = (volatile LAS unsigned*)(lds + MISC_OFF);
    const int G = gridDim.x; int vcu; { const int bx = blockIdx.x; vcu = (G % 8 == 0) ? (bx % 8) * (G / 8) + bx / 8 : bx; }
    unsigned char* ws = args.ws;
    gu32* ctl = (gu32*)(ws + WS_CTL);
    float* ss = (float*)(ws + WS_SS); bf16* xb = (bf16*)(ws + WS_XB); bf16* zg = (bf16*)(ws + WS_ZG); bf16* abuf = (bf16*)(ws + WS_A); float* yb = (float*)(ws + WS_YB);
    bf16* mix = (bf16*)(ws + WS_MIX); bf16* wbase = (bf16*)(ws + WS_W); float* xf = args.out;
    float* lutg = (float*)(ws + WS_LUT);
    for (int u = threadIdx.x; u < (LDS_BYTES - LDSCTL_OFF) / 4; u += NWAVES * 64) ((LAS unsigned*)(lds + LDSCTL_OFF))[u] = 0u;
    __syncthreads();
    XcdBarrier bar = xcd_barrier_post((unsigned*)(ctl + CW_BAR) + args.li * XCD_BAR_WORDS, MISC + 8);

#pragma unroll 1
    for (int ph = args.ph_lo; ph < args.ph_hi; ++ph) {
        const int l = ph > 0 ? (ph - 1) / 6 : 0, p = ph > 0 ? (ph - 1) % 6 + 1 : 0;
        bf16* wl = wbase + (size_t)l * WL_END;
        float* ss1 = ss + (size_t)((2 * l) & 3) * T * 16; float* ss2 = ss + (size_t)((2 * l + 1) & 3) * T * 16; float* ss3 = (l + 1 < L) ? ss + (size_t)((2 * l + 2) & 3) * T * 16 : nullptr;
#ifndef MK_ONLY
#define MK_ONLY 0x7f
#endif
        const int dupp = ((args.pad >> 8) & 0xff) - 1;
#pragma unroll 1
        for (int rep = (p == dupp) ? 0 : 1; rep < 2; ++rep) {
        if (p == 0 && (MK_ONLY & 1)) {
            int tid0 = threadIdx.x; asm volatile("" : "+v"(tid0));
            const int lane0 = tid0 & 63, wave = __builtin_amdgcn_readfirstlane(tid0 >> 6);
            LAS float* scr = (LAS float*)(lds + RING_OFF + wave * 16384);
            const int gw = vcu * NWAVES + wave, NGW = G * NWAVES;
            constexpr int I_IN = (D / 64) * (INW / 32), I_G = (D / 64) * (GW / 32), I_A = (512 / 64) * (D / 32), I_O = (D / 64) * (D / 32), I_UP = (D / 64) * (FF2 / 32), I_DN = (FF / 64) * (D / 32);
            constexpr int I_LAYER = I_IN + I_G + 2 * I_A + I_O + I_UP + I_DN;
            for (int i = gw * 64 + lane0; i < 12 * att::LUT_STRIDE; i += NGW * 64) { const int hh = i / att::LUT_STRIDE, j = i - hh * att::LUT_STRIDE, rel = j - 256, ar = rel < 0 ? -rel : rel;
                float v = 0.f; if (j <= 512) v = (hh < 8 && ar > 128) ? att::NEG : args.in[13][t5_bucket(rel) * 12 + hh] * LOG2E;
                lutg[i] = v; }
            for (int m = gw; m < T; m += 2 * NGW) {
                const int m2 = m + NGW;
                const GAS f32x4* xr = (const GAS f32x4*)(args.in[0] + (size_t)m * D) + lane0; const GAS f32x4* xr2 = (const GAS f32x4*)(args.in[0] + (size_t)m2 * D) + lane0;
                GAS unsigned long long* o8 = (GAS unsigned long long*)(xb + (size_t)m * D) + lane0; GAS unsigned long long* o82 = (GAS unsigned long long*)(xb + (size_t)m2 * D) + lane0;
                f32x4 va[4], vb[4];
#pragma unroll
                for (int j = 0; j < 4; ++j) { va[j] = xr[64 * j]; vb[j] = xr2[64 * j]; }
                float s = 0.f, s2 = 0.f;
#pragma unroll
                for (int j = 0; j < 4; ++j) { const f32x4 v = va[j], w = vb[j]; s += (v.x * v.x + v.y * v.y) + (v.z * v.z + v.w * v.w); s2 += (w.x * w.x + w.y * w.y) + (w.z * w.z + w.w * w.w);
                    o8[64 * j] = (unsigned long long)pk2(v.x, v.y) | ((unsigned long long)pk2(v.z, v.w) << 32); o82[64 * j] = (unsigned long long)pk2(w.x, w.y) | ((unsigned long long)pk2(w.z, w.w) << 32); }
                s = wave_sum(s); s2 = wave_sum(s2);
                ss16_store(ss, m, s, lane0); ss16_store(ss, m2, s2, lane0);
            }
        } else if (p == 1 && (MK_ONLY & 2)) {
            pg8::SchedStd S; S.init(xb, D, wl + WL_IN, D, T, ZG - 256, G, (int)blockIdx.x);
            S.fix = (rep == 0 && MK_VAR == 8) ? 1 : 0;
            pg8::EpiIn E{zg, ss1, args.in[3] + l * 64, args.in[4] + l * 64, args.in[6] + l * 64, args.in[7] + l * 64, args.in[15] + l * GW, (args.pad >> 25) & 1};
            pg8::gemm_phase<pg8::EpiIn, pg8::SchedStd, true, true>(lds + RING_OFF, D, D, S, E);
        } else if (p == 2 && (MK_ONLY & 4)) {
            int lop = l; asm volatile("" : "+s"(lop));
            const float lam_init = 0.8f - 0.6f * __expf(-0.3f * (float)lop);
            int ln = threadIdx.x; asm volatile("" : "+v"(ln)); ln &= 63;
            const float d1 = wave_sum(args.in[8][l * 64 + ln] * args.in[9][l * 64 + ln]), d2 = wave_sum(args.in[10][l * 64 + ln] * args.in[11][l * 64 + ln]);
            const float lam = __expf(d1) - __expf(d2) + lam_init;
            if ((vcu & 3) == 0 && rep == 1) {
                pg8::SchedStd S1; S1.init(xb, D, wl + WL_IN, D, T, ZG, G, (int)blockIdx.x); S1.one = 1; S1.opm = 8 * (vcu >> 5) + ((vcu & 31) >> 2); S1.opn = 16;
                pg8::EpiIn E1{zg, ss1, args.in[3] + l * 64, args.in[4] + l * 64, args.in[6] + l * 64, args.in[7] + l * 64, args.in[15] + l * GW, 0};
                pg8::gemm_phase<pg8::EpiIn, pg8::SchedStd, true, true>(lds + RING_OFF, D, D, S1, E1);
            }
            att::attn_tables(lds, lutg, args.in[12] + l * 128, 1.0f - lam_init);
            const int dsel = args.pad >> 16;
            if (rep == 1 || dsel != 2)
            for (int ui = vcu; ui < 512; ui += G) { const int bh = ui >> 4, qb = ui & 15; if (rep == 0 && MK_VAR == 7 && (vcu & 1)) {} else if (rep == 0) att::attn_unit<true, (MK_VAR == 7 ? 0 : MK_VAR)>(lds, zg, lutg, bh >> 2, bh & 3, qb * 128, nullptr, lam, 1.0f - lam_init, args.in[12] + l * 128, mix);
                else att::attn_unit<true, 0>(lds, zg, lutg, bh >> 2, bh & 3, qb * 128, nullptr, lam, 1.0f - lam_init, args.in[12] + l * 128, nullptr); }
            if (rep == 1 || dsel != 1) {
                unsigned* qctr = (unsigned*)(ctl + CW_Q + 64 * (2 * l + rep));
                for (;;) {
                    if (threadIdx.x == 0) MISC[4] = __hip_atomic_fetch_add(qctr, 1u, __ATOMIC_RELAXED, __HIP_MEMORY_SCOPE_AGENT);
                    __syncthreads();
                    const int ui = (int)MISC[4];
                    __syncthreads();
                    if (ui >= 512) break;
                    const int bk = ui >> 5, qb = ui & 31; att::attn_unit<false>(lds, zg, lutg, bk >> 1, bk & 1, qb * 64, args.in[5] + l * HA, 0.f, 0.f, nullptr, rep == 0 ? mix : nullptr);
                }
            }
        } else if (p == 3 && (MK_ONLY & 8)) {
            pg8::SchedMix S; S.b.init(zg + C_QA, ZG, wl + WL_A, 512, T, D, G, (int)blockIdx.x); S.A1 = (const char*)(zg + C_QB); S.Bt1 = (const char*)(wl + WL_B);
            pg8::EpiMix E{zg, mix};
            pg8::gemm_phase<pg8::EpiMix, pg8::SchedMix, true, true>(lds + RING_OFF, 512, ZG, S, E);
        } else if (p == 4 && (MK_ONLY & 16)) {
            pg8::SchedStd S; S.init(mix, D, wl + WL_O, D, T, D, G, (int)blockIdx.x);
            pg8::EpiRes E{l == 0 ? args.in[0] : xf, xf, xb, ss2};
            pg8::gemm_phase<pg8::EpiRes, pg8::SchedStd, true, true>(lds + RING_OFF, D, D, S, E);
        } else if (p == 5 && (MK_ONLY & 32)) {
            pg8::SchedStd S; S.init(xb, D, wl + WL_UP, D, T, FF2, G, (int)blockIdx.x);
            pg8::EpiUp E{abuf, ss2, args.in[21] + (size_t)l * 3 * FF2, args.in[22] + (size_t)l * FF2, yb, (args.pad >> 24) & 1};
            pg8::gemm_phase<pg8::EpiUp, pg8::SchedStd, true, true>(lds + RING_OFF, D, D, S, E);
        } else if (MK_ONLY & 64) {
            pg8::SchedDown S; S.b.init(abuf, FF, wl + WL_DN, FF, T, D, G, (int)blockIdx.x); S.yb = (args.pad & 1) ? nullptr : yb; S.cw = args.in[21] + (size_t)l * 3 * FF2; S.cb = args.in[22] + (size_t)l * FF2; S.a = abuf;
            pg8::EpiRes E{xf, xf, ss3 ? xb : nullptr, ss3};
            pg8::gemm_phase<pg8::EpiRes, pg8::SchedDown, true, true>(lds + RING_OFF, FF, FF, S, E);
        }
        {
            int ph2 = ph; asm volatile("" : "+s"(ph2));
            const int l2 = ph2 > 0 ? (ph2 - 1) / 6 : 0, p2 = ph2 > 0 ? (ph2 - 1) % 6 + 1 : 0;
            const int G2 = gridDim.x, bx2 = blockIdx.x;
            int cl = -1, cw0 = 0, cnw = 1;
            if (p2 == 0) { cl = 0; cw0 = ((G2 % 8 == 0) ? (bx2 % 8) * (G2 / 8) + bx2 / 8 : bx2) * NWAVES; cnw = G2 * NWAVES; }
            else if (p2 == 5 && l2 + 1 < L && G2 == 256 && bx2 >= 128) { cl = l2 + 1; cw0 = (bx2 - 128) * NWAVES; cnw = 128 * NWAVES; }
            if (cl >= 0) {
                bf16* wbase2 = (bf16*)(args.ws + WS_W);
                int tid0 = threadIdx.x; asm volatile("" : "+v"(tid0));
                const int lane0 = tid0 & 63, wave = __builtin_amdgcn_readfirstlane(tid0 >> 6);
                LAS float* scr = (LAS float*)(lds + RING_OFF + wave * 16384);
                constexpr int I_IN = (D / 64) * (INW / 32), I_G = (D / 64) * (GW / 32), I_A = (512 / 64) * (D / 32), I_O = (D / 64) * (D / 32), I_UP = (D / 64) * (FF2 / 32), I_DN = (FF / 64) * (D / 32);
                constexpr int I_LAYER = I_IN + I_G + 2 * I_A + I_O + I_UP + I_DN;
                const int ll = cl; bf16* w = wbase2 + (size_t)ll * WL_END;
#pragma unroll 1
                for (int it = cw0 + wave; it < I_LAYER; it += cnw) {
                    int r = it;
                    if (r < I_IN) { const int nb = r % (INW / 32), kb = r / (INW / 32); p0_transpose_item(args.in[2] + (size_t)ll * D * INW, INW, D, 64 * kb, 32 * nb, w + WL_IN, vrow_in(32 * nb), args.in[1] + ll * D, scr, lane0); continue; } r -= I_IN;
                    if (r < I_G) { const int nb = r % (GW / 32), kb = r / (GW / 32); p0_transpose_item(args.in[14] + (size_t)ll * D * GW, GW, D, 64 * kb, 32 * nb, w + WL_IN, vrow_in(INW + 32 * nb), args.in[1] + ll * D, scr, lane0); continue; } r -= I_G;
                    if (r < I_A) { const int nb = r % (D / 32), kb = r / (D / 32); p0_transpose_item(args.in[16] + (size_t)ll * 512 * D, D, 512, 64 * kb, 32 * nb, w + WL_A, 32 * nb, nullptr, scr, lane0); continue; } r -= I_A;
                    if (r < I_A) { const int nb = r % (D / 32), kb = r / (D / 32); p0_transpose_item(args.in[17] + (size_t)ll * 512 * D, D, 512, 64 * kb, 32 * nb, w + WL_B, 32 * nb, nullptr, scr, lane0); continue; } r -= I_A;
                    if (r < I_O) { const int nb = r % (D / 32), kb = r / (D / 32); p0_transpose_item(args.in[18] + (size_t)ll * D * D, D, D, 64 * kb, 32 * nb, w + WL_O, 32 * nb, nullptr, scr, lane0); continue; } r -= I_O;
                    if (r < I_UP) { const int nb = r % (FF2 / 32), kb = r / (FF2 / 32); p0_transpose_item(args.in[20] + (size_t)ll * D * FF2, FF2, D, 64 * kb, 32 * nb, w + WL_UP, vrow_up(32 * nb), args.in[19] + ll * D, scr, lane0); continue; } r -= I_UP;
                    { const int nb = r % (D / 32), kb = r / (D / 32); p0_transpose_item(args.in[23] + (size_t)ll * FF * D, D, FF, 64 * kb, 32 * nb, w + WL_DN, 32 * nb, nullptr, scr, lane0); }
                }
            }
        }
        }
        if (ph + 1 < args.ph_hi) xcd_barrier(bar);
    }
}
}

extern "C" void kernel_launch(void* const* d_in, const int* in_sizes, int n_in, void* d_out, int out_size, void* d_ws, size_t ws_size, hipStream_t stream) {
    using namespace nv;
    static int grid = 0;
    if (grid == 0) {
        if (n_in != 24 || in_sizes[0] != T * D || out_size != T * D || ws_size < mk::WS_END) { fprintf(stderr, "kernel_launch: built for 24 inputs, x/out of %d floats, >= %zu bytes of workspace; got n_in %d, out %d, ws %zu; nothing launched\n", T * D, (size_t)mk::WS_END, n_in, out_size, ws_size); grid = -1; return; }
        int dev = 0, cus = 0, per_cu = 0;
        if (hipGetDevice(&dev) != hipSuccess || hipDeviceGetAttribute(&cus, hipDeviceAttributeMultiprocessorCount, dev) != hipSuccess) { fprintf(stderr, "kernel_launch: device query failed; nothing launched\n"); grid = -1; return; }
        if (hipFuncSetAttribute((const void*)mk::skel_fwd, hipFuncAttributeMaxDynamicSharedMemorySize, mk::LDS_BYTES) != hipSuccess) { fprintf(stderr, "kernel_launch: hipFuncSetAttribute failed (needs %d bytes of dynamic LDS)\n", mk::LDS_BYTES); grid = -1; return; }
        if (hipOccupancyMaxActiveBlocksPerMultiprocessor(&per_cu, (const void*)mk::skel_fwd, mk::NWAVES * 64, mk::LDS_BYTES) != hipSuccess || per_cu < 1) fprintf(stderr, "kernel_launch: note: occupancy query reports %d workgroups per CU\n", per_cu);
        (void)hipGetLastError();
        grid = cus;
        if (grid != 256) fprintf(stderr, "kernel_launch: the unit schedules are built for 256 CUs; this device reports %d\n", cus);
    }
    if (grid < 0) return;
    if (hipMemsetAsync((unsigned char*)d_ws + mk::WS_CTL, 0, mk::CTL_ZERO_BYTES, stream) != hipSuccess) { fprintf(stderr, "kernel_launch: memset of the control words failed; nothing launched\n"); return; }
    mk::Args a{};
    for (int i = 0; i < 24; ++i) a.in[i] = (const float*)d_in[i];
    a.out = (float*)d_out; a.ws = (unsigned char*)d_ws; a.ph_lo = 0; a.ph_hi = mk::N_PHASES; a.li = 0;
    a.pad = (MK_DUP << 8) | (MK_DSEL << 16);
    hipLaunchKernelGGL(mk::skel_fwd, dim3(grid), dim3(mk::NWAVES * 64), mk::LDS_BYTES, stream, a);
}
```

```cpp
#include <hip/hip_runtime.h>
#include <cstdio>
#include <cstdint>
#include <cmath>
#define MK_EDUP 0

namespace nv {
typedef unsigned short bf16;
constexpr int D = 1024, B = 8, S = 2048, T = B * S, L = 4;
constexpr int HA = 8, KVA = 2, HB = 4, HD = 64;
constexpr int INW = 2304, GW = 2048, ZG = INW + GW;
constexpr int FF = 2816, FF2 = 2 * FF;
constexpr int C_QA = 0, C_KA = 512, C_VA = 640, C_QB = 768, C_KB = 1280, C_VB = 1792, C_G = 2304;
constexpr float EPS = 1e-6f;
constexpr float LOG2E = 1.4426950408889634f;
constexpr float C2 = 0.125f * LOG2E;

__device__ __forceinline__ float bf2f(bf16 v) { return __uint_as_float(((unsigned)v) << 16); }
__device__ __forceinline__ bf16 f2bf(float f) { unsigned u = __float_as_uint(f); return (bf16)((u + 0x7fffu + ((u >> 16) & 1u)) >> 16); }
__device__ __forceinline__ float ldf(const float* p) { return *p; }
__device__ __forceinline__ float ldf(const bf16* p) { return bf2f(*p); }

__device__ __forceinline__ int t5_bucket(int rel) {
    const int n = rel < 0 ? -rel : rel; int v;
    if (n < 8) v = n; else if (n < 12) v = 8; else if (n < 16) v = 9; else if (n < 23) v = 10; else if (n < 32) v = 11;
    else if (n < 46) v = 12; else if (n < 64) v = 13; else if (n < 91) v = 14; else v = 15;
    return (rel > 0 ? 16 : 0) + v;
}
__device__ __forceinline__ float ss16(const float* ss, int t) { const float4* p = (const float4*)(ss + (size_t)t * 16); const float4 a = p[0], b = p[1], c = p[2], d = p[3];
    return ((a.x + a.y) + (a.z + a.w)) + ((b.x + b.y) + (b.z + b.w)) + ((c.x + c.y) + (c.z + c.w)) + ((d.x + d.y) + (d.z + d.w)); }
__device__ __forceinline__ float ss16_q(const float* ss, int t, int fq) { const float4 a = *(const float4*)(ss + (size_t)t * 16 + 4 * fq); float s = (a.x + a.y) + (a.z + a.w); s += __shfl_xor(s, 16); s += __shfl_xor(s, 32); return s; }
__device__ __forceinline__ void ss16_store(float* ss, int t, float s, int lane) { if (lane < 16) ss[(size_t)t * 16 + lane] = lane == 0 ? s : 0.f; }
__device__ __forceinline__ float wave_sum(float v) {
#pragma unroll
    for (int o = 1; o < 64; o <<= 1) v += __shfl_xor(v, o);
    return v;
}
__device__ __forceinline__ float wave_max(float v) {
#pragma unroll
    for (int o = 1; o < 64; o <<= 1) v = fmaxf(v, __shfl_xor(v, o));
    return v;
}

}


namespace pg8 {
using namespace nv;
#define PG8_LAS __attribute__((address_space(3)))
typedef unsigned short bf16_t;
typedef short bf16x8 __attribute__((ext_vector_type(8)));
typedef float f32x4 __attribute__((ext_vector_type(4)));
typedef unsigned u32x4 __attribute__((ext_vector_type(4)));
typedef unsigned u32x2 __attribute__((ext_vector_type(2)));
constexpr int BM = 256, BK = 64, HALF = 128, HTB = HALF * BK * 2  , STAGE_BYTES = 8 * HTB, NXCD = 8, WGM = 8;
constexpr int XOFF = 131072 + 1024;
constexpr int RTAB_OFF = XOFF + 8192;

__host__ __device__ __forceinline__ int lds_byte(int r, int c) { const int st = (r >> 4) * 2 + (c >> 5), rr = r & 15, cc = c & 31, ob = rr * 64 + cc * 2; return st * 1024 + (ob ^ (((ob >> 9) & 1) << 5)); }
__host__ __device__ __forceinline__ void stage_rc(int b, int& R, int& C) { const int st = b / 1024, sb = b % 1024, swz = sb ^ (((sb >> 9) & 1) << 5); R = (st >> 1) * 16 + swz / 64; C = (st & 1) * 32 + (swz % 64) / 2; }
__host__ __device__ __forceinline__ int perm32(int rho) { const int n = rho >> 4, i = rho & 15; return 8 * (i >> 2) + 4 * n + (i & 3); }

struct Unit { int pm, pn, z; };
typedef float f32x2 __attribute__((ext_vector_type(2))); typedef __bf16 bf16x2_t __attribute__((ext_vector_type(2)));
__device__ __forceinline__ unsigned cvt_pk_bf16(float lo, float hi) { f32x2 v = {lo, hi}; bf16x2_t b = __builtin_convertvector(v, bf16x2_t); return __builtin_bit_cast(unsigned, b); }
__device__ __forceinline__ float bflo(unsigned w) { return __uint_as_float(w << 16); }
__device__ __forceinline__ float bfhi(unsigned w) { return __uint_as_float(w & 0xffff0000u); }

struct SchedStd {
    int nM, nN, nwg, G, c, fix, one, opm, opn; const char* A; const char* Bt; size_t at, bt;
    __device__ void init(const void* A_, int lda, const void* Bt_, int K, int M, int N, int G_, int c_) { fix = 0; one = 0; opm = 0; opn = 0; nM = M / BM; nN = N / BM; nwg = nM * nN; G = G_; c = c_; A = (const char*)A_; Bt = (const char*)Bt_; at = (size_t)BM * lda * 2; bt = (size_t)BM * K * 2; }
    __device__ bool next(int i, Unit& u) const {
        if (one) { if (i > 0) return false; u.pm = opm; u.pn = opn; u.z = 0; return true; }
        const long L = (long)i * G + c; if (L >= nwg) return false;
        int wgid = (int)L; { const int q = nwg / NXCD, r = nwg % NXCD, xcd = wgid % NXCD, off = wgid / NXCD; wgid = (xcd < r ? xcd * (q + 1) : r * (q + 1) + (xcd - r) * q) + off; }
        const int nig = WGM * nN, gid = wgid / nig, fm = gid * WGM, gsz = (nM - fm) < WGM ? (nM - fm) : WGM;
        u.pm = fm + ((wgid % nig) % gsz); u.pn = (wgid % nig) / gsz; u.z = 0; if (fix) { u.pm = 0; u.pn = 0; } return true;
    }
    __device__ __forceinline__ const char* aptr(const Unit& u) const { return A + (size_t)u.pm * at; }
    __device__ __forceinline__ const char* bptr(const Unit& u) const { return Bt + (size_t)u.pn * bt; }
    __device__ __forceinline__ void a_ready(const Unit&) const {}
    __device__ __forceinline__ void done(const Unit&) const {}
};
struct SchedMix {
    SchedStd b; const char* A1; const char* Bt1;
    __device__ bool next(int i, Unit& u) const { if (!b.next(i >> 1, u)) return false; u.z = i & 1; return true; }
    __device__ __forceinline__ const char* aptr(const Unit& u) const { return (u.z ? A1 : b.A) + (size_t)u.pm * b.at; }
    __device__ __forceinline__ const char* bptr(const Unit& u) const { return (u.z ? Bt1 : b.Bt) + (size_t)u.pn * b.bt; }
    __device__ __forceinline__ void a_ready(const Unit&) const {}
    __device__ __forceinline__ void done(const Unit&) const {}
};
struct SchedDown {
    SchedStd b; const float* yb; const float* cw; const float* cb; bf16_t* a;
    __device__ bool next(int i, Unit& u) const { return b.next(i, u); }
    __device__ __forceinline__ const char* aptr(const Unit& u) const { return b.aptr(u); }
    __device__ __forceinline__ const char* bptr(const Unit& u) const { return b.bptr(u); }
    __device__ __forceinline__ void a_ready(const Unit& u) const {
        const int pm = u.pm;
        if (yb)
        for (int idx = threadIdx.x; idx < 2 * FF; idx += 512) {
            const int which = idx >= FF ? 1 : 0, j = idx - which * FF;
            float uv[2];
#pragma unroll
            for (int gs = 0; gs < 2; ++gs) {
                const int col = gs * FF + j; float y0, y1, y2;
                if (which == 0) { y0 = (pm & 7) ? yb[((size_t)(pm - 1) * 4 + 3) * FF2 + col] : 0.f; y1 = yb[((size_t)pm * 4 + 0) * FF2 + col]; y2 = yb[((size_t)pm * 4 + 1) * FF2 + col]; }
                else { y0 = yb[((size_t)pm * 4 + 2) * FF2 + col]; y1 = yb[((size_t)pm * 4 + 3) * FF2 + col]; y2 = ((pm & 7) != 7) ? yb[((size_t)(pm + 1) * 4 + 0) * FF2 + col] : 0.f; }
                uv[gs] = cb[col] + cw[col] * y0 + cw[FF2 + col] * y1 + cw[2 * FF2 + col] * y2;
            }
            const float sg = uv[1] * __builtin_amdgcn_rcpf(1.0f + __builtin_amdgcn_exp2f(-uv[1] * LOG2E));
            a[(size_t)(pm * BM + which * 255) * FF + j] = f2bf(sg * uv[0]);
        }
        asm volatile("s_waitcnt vmcnt(0)" ::: "memory");
        __builtin_amdgcn_s_barrier();
        asm volatile("" ::: "memory");
    }
    __device__ __forceinline__ void done(const Unit&) const {}
};

struct EpiIn {
    static constexpr bool PERM = true, AFTER_DRAIN = false;
    __device__ __forceinline__ void init(f32x4 (&acc)[2][2][4][2], const Unit&, int, int, int, int) const {
#pragma unroll
        for (int a = 0; a < 2; ++a)
#pragma unroll
            for (int b = 0; b < 2; ++b)
#pragma unroll
                for (int m = 0; m < 4; ++m)
#pragma unroll
                    for (int n = 0; n < 2; ++n) acc[a][b][m][n] = (f32x4){0.f, 0.f, 0.f, 0.f};
    }
    __device__ static constexpr bool zero_after(const Unit&) { return true; }
    bf16_t* zg; const float* ss; const float *qn_a, *kn_a, *qn_b, *kn_b, *bg; int dup;
    __device__ __forceinline__ void operator()(f32x4 (&acc)[2][2][4][2], const Unit& u, int wr, int wc, int fr, int fq, PG8_LAS unsigned char* lds_) const {
#pragma unroll
        for (int rep_ = 0; rep_ <= ((MK_EDUP & 2) ? 1 : 0); ++rep_) {
        if (rep_) {
#pragma unroll
            for (int ai = 0; ai < 2; ++ai)
#pragma unroll
                for (int bj = 0; bj < 2; ++bj)
#pragma unroll
                    for (int m = 0; m < 4; ++m)
#pragma unroll
                        for (int n = 0; n < 2; ++n) asm volatile("" : "+v"(acc[ai][bj][m][n]) :: "memory");
        }
        const int g = u.pn * 4 + wc, colb = u.pn * BM + wc * 64 + 8 * fq;
        const float* gain = nullptr; float sc = 1.f; int mode = 0;
        if (g < 8) { gain = qn_a; sc = C2; mode = 1; } else if (g < 10) { gain = kn_a; mode = 1; } else if (g < 12) { mode = 0; } else if (g < 20) { gain = qn_b; sc = C2; mode = 1; }
        else if (g < 28) { gain = kn_b; mode = 1; } else if (g < 36) { mode = 0; } else { mode = 2; }
        float rsv[2][4];
#pragma unroll
        for (int ai = 0; ai < 2; ++ai)
#pragma unroll
            for (int m = 0; m < 4; ++m) rsv[ai][m] = ((const PG8_LAS float*)(lds_ + RTAB_OFF))[(u.pm & 7) * BM + ai * HALF + wr * 64 + m * 16 + fr];
        f32x4 gv[2][2];
#pragma unroll
        for (int bj = 0; bj < 2; ++bj)
#pragma unroll
            for (int n = 0; n < 2; ++n) {
                if (mode == 1) gv[bj][n] = *(const f32x4*)(gain + 32 * bj + 8 * fq + 4 * n) * sc;
                else if (mode == 2) gv[bj][n] = *(const f32x4*)(bg + (colb - C_G) + 32 * bj + 4 * n);
                else gv[bj][n] = (f32x4){1.f, 1.f, 1.f, 1.f};
            }
#pragma unroll
        for (int ai = 0; ai < 2; ++ai)
#pragma unroll
            for (int m = 0; m < 4; ++m) {
                const int row = u.pm * BM + ai * HALF + wr * 64 + m * 16 + fr;
                const float rs = rsv[ai][m];
                f32x4 v[2][2];
#pragma unroll
                for (int bj = 0; bj < 2; ++bj)
#pragma unroll
                    for (int n = 0; n < 2; ++n) v[bj][n] = acc[ai][bj][m][n] * rs;
                if (mode == 1) {
                    float q = 0.f;
#pragma unroll
                    for (int bj = 0; bj < 2; ++bj)
#pragma unroll
                        for (int n = 0; n < 2; ++n) { const f32x4 x = v[bj][n]; q += (x[0] * x[0] + x[1] * x[1]) + (x[2] * x[2] + x[3] * x[3]); }
                    q += __shfl_xor(q, 16); q += __shfl_xor(q, 32);
                    const float r2 = rsqrtf(q * (1.0f / 64.0f) + EPS);
#pragma unroll
                    for (int bj = 0; bj < 2; ++bj)
#pragma unroll
                        for (int n = 0; n < 2; ++n) v[bj][n] = v[bj][n] * r2 * gv[bj][n];
                } else if (mode == 2) {
#pragma unroll
                    for (int bj = 0; bj < 2; ++bj)
#pragma unroll
                        for (int n = 0; n < 2; ++n) { f32x4 x = v[bj][n] + gv[bj][n];
#pragma unroll
                            for (int e = 0; e < 4; ++e) x[e] = __builtin_fmaxf(__builtin_amdgcn_rcpf(1.0f + __builtin_amdgcn_exp2f(-x[e] * LOG2E)), 9.5367431640625e-07f);
                            v[bj][n] = x; }
                }
                bf16_t* rowp = zg + (size_t)row * ZG + colb;
#pragma unroll
                for (int bj = 0; bj < 2; ++bj) { u32x4 w; w.x = cvt_pk_bf16(v[bj][0][0], v[bj][0][1]); w.y = cvt_pk_bf16(v[bj][0][2], v[bj][0][3]); w.z = cvt_pk_bf16(v[bj][1][0], v[bj][1][1]); w.w = cvt_pk_bf16(v[bj][1][2], v[bj][1][3]);
                    *(u32x4*)(rowp + 32 * bj) = w; }
            }
        }
    }
};
struct EpiMix {
    static constexpr bool PERM = true, AFTER_DRAIN = false;
    __device__ __forceinline__ void init(f32x4 (&acc)[2][2][4][2], const Unit&, int, int, int, int) const {
#pragma unroll
        for (int a = 0; a < 2; ++a)
#pragma unroll
            for (int b = 0; b < 2; ++b)
#pragma unroll
                for (int m = 0; m < 4; ++m)
#pragma unroll
                    for (int n = 0; n < 2; ++n) acc[a][b][m][n] = (f32x4){0.f, 0.f, 0.f, 0.f};
    }
    __device__ static bool zero_after(const Unit& u) { return u.z != 0; }
    const bf16_t* zg; bf16_t* mix;
    __device__ __forceinline__ void operator()(f32x4 (&acc)[2][2][4][2], const Unit& u, int wr, int wc, int fr, int fq, PG8_LAS unsigned char*) const {
        const int col0 = u.pn * BM + wc * 32 + 8 * fq;
#pragma unroll
        for (int ai = 0; ai < 2; ++ai) {
            u32x4 gbv[4][2], gav[4][2];
#pragma unroll
            for (int m = 0; m < 4; ++m)
#pragma unroll
                for (int bj = 0; bj < 2; ++bj) { const size_t go = (size_t)(u.pm * BM + ai * HALF + wr * 64 + m * 16 + fr) * ZG + C_G + col0 + bj * HALF;
                    gbv[m][bj] = *(const u32x4*)(zg + go + D); if (u.z == 0) gav[m][bj] = *(const u32x4*)(zg + go); else gav[m][bj] = (u32x4){0u, 0u, 0u, 0u}; }
#pragma unroll
            for (int m = 0; m < 4; ++m) {
                const int row = u.pm * BM + ai * HALF + wr * 64 + m * 16 + fr;
#pragma unroll
                for (int bj = 0; bj < 2; ++bj) {
                    const int col = col0 + bj * HALF;
                    const u32x4 gb = gbv[m][bj];
                    if (u.z == 0) {
                        const u32x4 ga = gav[m][bj];
                        f32x4 r0, r1;
                        r0[0] = bflo(ga.x) * __builtin_amdgcn_rcpf(bflo(gb.x)); r0[1] = bfhi(ga.x) * __builtin_amdgcn_rcpf(bfhi(gb.x)); r0[2] = bflo(ga.y) * __builtin_amdgcn_rcpf(bflo(gb.y)); r0[3] = bfhi(ga.y) * __builtin_amdgcn_rcpf(bfhi(gb.y));
                        r1[0] = bflo(ga.z) * __builtin_amdgcn_rcpf(bflo(gb.z)); r1[1] = bfhi(ga.z) * __builtin_amdgcn_rcpf(bfhi(gb.z)); r1[2] = bflo(ga.w) * __builtin_amdgcn_rcpf(bflo(gb.w)); r1[3] = bfhi(ga.w) * __builtin_amdgcn_rcpf(bfhi(gb.w));
                        acc[ai][bj][m][0] *= r0; acc[ai][bj][m][1] *= r1;
                    } else {
                        const f32x4 v0 = acc[ai][bj][m][0] * (f32x4){bflo(gb.x), bfhi(gb.x), bflo(gb.y), bfhi(gb.y)}, v1 = acc[ai][bj][m][1] * (f32x4){bflo(gb.z), bfhi(gb.z), bflo(gb.w), bfhi(gb.w)};
                        u32x4 w; w.x = cvt_pk_bf16(v0[0], v0[1]); w.y = cvt_pk_bf16(v0[2], v0[3]); w.z = cvt_pk_bf16(v1[0], v1[1]); w.w = cvt_pk_bf16(v1[2], v1[3]);
                        *(u32x4*)(mix + (size_t)row * D + col) = w;
                    }
                }
            }
            asm volatile("" ::: "memory");
        }
    }
};
struct EpiRes {
    static constexpr bool PERM = false, AFTER_DRAIN = false;
    __device__ static constexpr bool zero_after(const Unit&) { return true; }
    const float* base; float* xf; bf16_t* xb; float* ssn;
    __device__ __forceinline__ void init(f32x4 (&acc)[2][2][4][2], const Unit& u, int wr, int wc, int fr, int fq) const {
        const int col0 = u.pn * BM + wc * 32 + 4 * fq;
#pragma unroll
        for (int ai = 0; ai < 2; ++ai)
#pragma unroll
            for (int m = 0; m < 4; ++m) { const size_t off = (size_t)(u.pm * BM + ai * HALF + wr * 64 + m * 16 + fr) * D + col0;
#pragma unroll
                for (int bj = 0; bj < 2; ++bj)
#pragma unroll
                    for (int n = 0; n < 2; ++n) acc[ai][bj][m][n] = *(const f32x4*)(base + off + bj * HALF + n * 16); }
    }
    __device__ __forceinline__ void operator()(f32x4 (&acc)[2][2][4][2], const Unit& u, int wr, int wc, int fr, int fq, PG8_LAS unsigned char*) const {
        const int col0 = u.pn * BM + wc * 32 + 4 * fq;
#pragma unroll
        for (int ai = 0; ai < 2; ++ai)
#pragma unroll
            for (int m = 0; m < 4; ++m) {
                const int row = u.pm * BM + ai * HALF + wr * 64 + m * 16 + fr; const size_t off = (size_t)row * D + col0; float q = 0.f;
#pragma unroll
                for (int bj = 0; bj < 2; ++bj)
#pragma unroll
                    for (int n = 0; n < 2; ++n) { const f32x4 o = acc[ai][bj][m][n];
                        *(f32x4*)(xf + off + bj * HALF + n * 16) = o; q += (o[0] * o[0] + o[1] * o[1]) + (o[2] * o[2] + o[3] * o[3]);
                        if (xb) { u32x2 w; w.x = cvt_pk_bf16(o[0], o[1]); w.y = cvt_pk_bf16(o[2], o[3]); *(u32x2*)(xb + off + bj * HALF + n * 16) = w; } }
                if (ssn) { q += __shfl_xor(q, 16); q += __shfl_xor(q, 32); if (fq == 0) ssn[(size_t)row * 16 + u.pn * 4 + wc] = q; }
            }
    }
};
#define DPPF(oldv, src, ctrl, bc) __int_as_float(__builtin_amdgcn_update_dpp(__float_as_int(oldv), __float_as_int(src), (ctrl), 0xF, 0xF, (bc)))
struct EpiUp {
    static constexpr bool PERM = true, AFTER_DRAIN = false;
    __device__ __forceinline__ void init(f32x4 (&acc)[2][2][4][2], const Unit&, int, int, int, int) const {
#pragma unroll
        for (int a = 0; a < 2; ++a)
#pragma unroll
            for (int b = 0; b < 2; ++b)
#pragma unroll
                for (int m = 0; m < 4; ++m)
#pragma unroll
                    for (int n = 0; n < 2; ++n) acc[a][b][m][n] = (f32x4){0.f, 0.f, 0.f, 0.f};
    }
    __device__ static constexpr bool zero_after(const Unit&) { return true; }
    bf16_t* a; const float* ss; const float* cw; const float* cb; float* yb; int dup;
    __device__ __forceinline__ void operator()(f32x4 (&acc)[2][2][4][2], const Unit& u, int wr, int wc, int fr, int fq, PG8_LAS unsigned char* lds) const {
        PG8_LAS unsigned char* lds_ = lds; const int wid = wr * 4 + wc;
        PG8_LAS float* X = (PG8_LAS float*)(lds + XOFF);
        float rsv[2][4];
#pragma unroll
        for (int ai = 0; ai < 2; ++ai)
#pragma unroll
            for (int m = 0; m < 4; ++m) rsv[ai][m] = ((const PG8_LAS float*)(lds_ + RTAB_OFF))[(u.pm & 7) * BM + ai * HALF + wr * 64 + m * 16 + fr];
#pragma unroll
        for (int ai = 0; ai < 2; ++ai)
#pragma unroll
            for (int m = 0; m < 4; ++m) {
#pragma unroll
                for (int bj = 0; bj < 2; ++bj)
#pragma unroll
                    for (int n = 0; n < 2; ++n) acc[ai][bj][m][n] *= rsv[ai][m];
            }
#pragma unroll
        for (int ai = 0; ai < 2; ++ai) {
            if (fr == 0) {
#pragma unroll
                for (int bj = 0; bj < 2; ++bj)
#pragma unroll
                    for (int n = 0; n < 2; ++n) *(PG8_LAS f32x4*)(X + ((wid * 2 + ai) * 2 + 0) * 64 + 32 * bj + 8 * fq + 4 * n) = acc[ai][bj][0][n];
            }
            if (fr == 15) {
#pragma unroll
                for (int bj = 0; bj < 2; ++bj)
#pragma unroll
                    for (int n = 0; n < 2; ++n) *(PG8_LAS f32x4*)(X + ((wid * 2 + ai) * 2 + 1) * 64 + 32 * bj + 8 * fq + 4 * n) = acc[ai][bj][3][n];
            }
        }
        {
            const int ccol = u.pn * 128 + wc * 32 + 8 * fq;
            if (wr == 0 && fr < 2) {
#pragma unroll
                for (int bj = 0; bj < 2; ++bj)
#pragma unroll
                    for (int n = 0; n < 2; ++n) *(f32x4*)(yb + ((size_t)u.pm * 4 + fr) * FF2 + bj * FF + ccol + 4 * n) = acc[0][bj][0][n];
            }
            if (wr == 1 && fr >= 14) {
#pragma unroll
                for (int bj = 0; bj < 2; ++bj)
#pragma unroll
                    for (int n = 0; n < 2; ++n) *(f32x4*)(yb + ((size_t)u.pm * 4 + 2 + (fr - 14)) * FF2 + bj * FF + ccol + 4 * n) = acc[1][bj][3][n];
            }
        }
        asm volatile("s_waitcnt lgkmcnt(0)" ::: "memory"); __builtin_amdgcn_s_barrier(); asm volatile("" ::: "memory");
#pragma unroll
        for (int rep_ = 0; rep_ <= ((MK_EDUP & 1) ? 1 : 0); ++rep_) {
        if (rep_) {
#pragma unroll
            for (int ai = 0; ai < 2; ++ai)
#pragma unroll
                for (int bj = 0; bj < 2; ++bj)
#pragma unroll
                    for (int m = 0; m < 4; ++m)
#pragma unroll
                        for (int n = 0; n < 2; ++n) asm volatile("" : "+v"(acc[ai][bj][m][n]) :: "memory");
        }
#pragma unroll
        for (int n = 0; n < 2; ++n) {
            const int ccol = u.pn * 128 + wc * 32 + 8 * fq + 4 * n;
            f32x4 w0[2], w1[2], w2[2], bb[2];
#pragma unroll
            for (int bj = 0; bj < 2; ++bj) { w0[bj] = *(const f32x4*)(cw + bj * FF + ccol); w1[bj] = *(const f32x4*)(cw + FF2 + bj * FF + ccol); w2[bj] = *(const f32x4*)(cw + 2 * FF2 + bj * FF + ccol); bb[bj] = *(const f32x4*)(cb + bj * FF + ccol); }
#pragma unroll
            for (int ai = 0; ai < 2; ++ai) {
                const int pw = wr ? wid - 4 : wid + 4, pai = wr ? ai : 0;
                const int nw = wr ? wid - 4 : wid + 4, nai = wr ? 1 : ai;
                f32x4 xp[2], xn[2];
#pragma unroll
                for (int bj = 0; bj < 2; ++bj) { xp[bj] = *(PG8_LAS f32x4*)(X + ((pw * 2 + pai) * 2 + 1) * 64 + 32 * bj + 8 * fq + 4 * n); xn[bj] = *(PG8_LAS f32x4*)(X + ((nw * 2 + nai) * 2 + 0) * 64 + 32 * bj + 8 * fq + 4 * n); }
#pragma unroll
                for (int m = 0; m < 4; ++m) {
                    const int trow = ai * HALF + wr * 64 + m * 16 + fr;
                    float uv[2][4];
#pragma unroll
                    for (int bj = 0; bj < 2; ++bj)
#pragma unroll
                        for (int e = 0; e < 4; ++e) {
                            const float cur = acc[ai][bj][m][n][e];
                            float rp, rn;
                            if (m > 0) rp = DPPF(0.f, acc[ai][bj][m > 0 ? m - 1 : 0][n][e], 0x121, true); else rp = xp[bj][e];
                            if (m < 3) rn = DPPF(0.f, acc[ai][bj][m < 3 ? m + 1 : 3][n][e], 0x12F, true); else rn = xn[bj][e];
                            const float prev = DPPF(rp, cur, 0x111, false), next = DPPF(rn, cur, 0x101, false);
                            uv[bj][e] = bb[bj][e] + w0[bj][e] * prev + w1[bj][e] * cur + w2[bj][e] * next;
                        }
                    f32x4 o;
#pragma unroll
                    for (int e = 0; e < 4; ++e) o[e] = uv[0][e] * uv[1][e] * __builtin_amdgcn_rcpf(1.0f + __builtin_amdgcn_exp2f(-uv[1][e] * LOG2E));
                    u32x2 w; w.x = cvt_pk_bf16(o[0], o[1]); w.y = cvt_pk_bf16(o[2], o[3]);
                    if (trow != 0 && trow != 255) *(u32x2*)(a + (size_t)(u.pm * BM + trow) * FF + ccol) = w;
                    asm volatile("" ::: "memory");
                }
            }
        }
        }
    }
};

template <class Epi, class Sched, bool ALIGN_EPI = false, bool SP2 = false>
__device__ __forceinline__ void gemm_phase(PG8_LAS unsigned char* lds, const int K, const int lda, const Sched& S, const Epi& E) {
    int tid_ = threadIdx.x; asm volatile("" : "+v"(tid_));
    const int tid = tid_, wid = __builtin_amdgcn_readfirstlane(tid >> 6), lane = tid & 63, wr = wid >> 2, wc = wid & 3, fr = lane & 15, fq = lane >> 4;
    const int nt = K / BK;
    unsigned voffA[2], voffB[2];
#pragma unroll
    for (int i = 0; i < 2; ++i) { int R, C; stage_rc(tid * 16 + i * 8192, R, C); const int Rb = Epi::PERM ? ((R & ~31) + perm32(R & 31)) : R;
        voffA[i] = (unsigned)(R * lda + C) * 2u; voffB[i] = (unsigned)(Rb * K + C) * 2u; }
    const size_t kstep = (size_t)(BK * 2);
    const size_t hstepB = (size_t)HALF * K * 2;
    const size_t hstepA = (size_t)HALF * lda * 2;
    const unsigned ldsw = (unsigned)wid * 1024u;
    const int aoff = lds_byte(wr * 64 + fr, fq * 8), boff = lds_byte(wc * 32 + fr, fq * 8);
#define PG8_SA(b, h) (((b) * 2 + (h)) * HTB)
#define PG8_SB(b, h) ((4 + (b) * 2 + (h)) * HTB)
#define PG8_STAGE(bufoff, gbase, voff) do { _Pragma("unroll") for (int _i = 0; _i < 2; ++_i) \
        __builtin_amdgcn_global_load_lds((const unsigned*)((const char*)(gbase) + (voff)[_i]), (PG8_LAS unsigned*)(lds + (bufoff) + ldsw + _i * 8192), 16, 0, 0); } while (0)
#define PG8_LDA(dst, b, h) do { _Pragma("unroll") for (int m = 0; m < 4; ++m) _Pragma("unroll") for (int k = 0; k < 2; ++k) dst[m][k] = *(const PG8_LAS bf16x8*)(lds + PG8_SA(b, h) + aoff + m * 2048 + k * 1024); } while (0)
#define PG8_LDB(dst, b, h) do { _Pragma("unroll") for (int n = 0; n < 2; ++n) _Pragma("unroll") for (int k = 0; k < 2; ++k) dst[n][k] = *(const PG8_LAS bf16x8*)(lds + PG8_SB(b, h) + boff + n * 2048 + k * 1024); } while (0)
#define PG8_MMA(ai, bj, At, Bt) do { __builtin_amdgcn_s_setprio(1); _Pragma("unroll") for (int m = 0; m < 4; ++m) _Pragma("unroll") for (int n = 0; n < 2; ++n) _Pragma("unroll") for (int k = 0; k < 2; ++k) \
        acc[ai][bj][m][n] = __builtin_amdgcn_mfma_f32_16x16x32_bf16(Bt[n][k], At[m][k], acc[ai][bj][m][n], 0, 0, 0); __builtin_amdgcn_s_setprio(0); } while (0)
#define PG8_WAIT_V(n) asm volatile("s_waitcnt vmcnt(" #n ")" ::: "memory")
#define PG8_WAIT_L(n) asm volatile("s_waitcnt lgkmcnt(" #n ")" ::: "memory")
#define PG8_BAR __builtin_amdgcn_s_barrier()
#define PG8_SCHED __builtin_amdgcn_sched_barrier(0)
    Unit cur, nxt; int ui = 0;
    if (!S.next(0, cur)) return;
    f32x4 acc[2][2][4][2];
    E.init(acc, cur, wr, wc, fr, fq);
    bf16x8 At[4][2], B0[2][2], B1[2][2];
    const char* cA = S.aptr(cur); const char* cB = S.bptr(cur);
    S.a_ready(cur);
    if constexpr (SP2) {
        PG8_STAGE(PG8_SB(0, 0), cB, voffB); PG8_STAGE(PG8_SB(0, 1), cB + hstepB, voffB); PG8_STAGE(PG8_SA(0, 0), cA, voffA); PG8_STAGE(PG8_SA(0, 1), cA + hstepA, voffA);
        if (wr == 1) PG8_BAR;
        PG8_WAIT_V(2); PG8_BAR;
        PG8_STAGE(PG8_SB(1, 0), cB + kstep, voffB); PG8_STAGE(PG8_SA(1, 0), cA + kstep, voffA); PG8_STAGE(PG8_SB(1, 1), cB + hstepB + kstep, voffB);
        PG8_WAIT_V(6); PG8_BAR;
    } else {
        PG8_STAGE(PG8_SB(0, 0), cB, voffB); PG8_STAGE(PG8_SA(0, 0), cA, voffA); PG8_STAGE(PG8_SB(0, 1), cB + hstepB, voffB); PG8_STAGE(PG8_SA(0, 1), cA + hstepA, voffA);
        if (wr == 1) PG8_BAR;
        PG8_WAIT_V(4); PG8_BAR;
        PG8_STAGE(PG8_SB(1, 0), cB + kstep, voffB); PG8_STAGE(PG8_SA(1, 0), cA + kstep, voffA); PG8_STAGE(PG8_SB(1, 1), cB + hstepB + kstep, voffB);
        PG8_WAIT_V(6); PG8_BAR;
    }
    for (;;) {
        const bool has_next = S.next(ui + 1, nxt);
        const char* nA = has_next ? S.aptr(nxt) : cA; const char* nB = has_next ? S.bptr(nxt) : cB;
        for (int t = 0; t < nt; t += 2) {
            const bool last = (t == nt - 2);
            const char* a1 = cA + (size_t)(t + 1) * kstep;
            const char* a2 = last ? nA : cA + (size_t)(t + 2) * kstep; const char* b2 = last ? nB : cB + (size_t)(t + 2) * kstep;
            const char* a3 = a2 + kstep; const char* b3 = b2 + kstep;
            if (last && has_next) S.a_ready(nxt);
            if constexpr (SP2) {
            PG8_LDB(B0, 0, 0); PG8_LDB(B1, 0, 1); PG8_SCHED; PG8_LDA(At, 0, 0); PG8_STAGE(PG8_SA(1, 1), a1 + hstepA, voffA);
            PG8_WAIT_V(8); PG8_WAIT_L(0); PG8_BAR; PG8_MMA(0, 0, At, B0); PG8_MMA(0, 1, At, B1); PG8_BAR; PG8_SCHED;
            PG8_LDA(At, 0, 1); PG8_STAGE(PG8_SB(0, 0), b2, voffB); PG8_STAGE(PG8_SB(0, 1), b2 + hstepB, voffB); PG8_STAGE(PG8_SA(0, 0), a2, voffA);
            PG8_WAIT_V(8); PG8_WAIT_L(0); PG8_BAR; PG8_MMA(1, 0, At, B0); PG8_MMA(1, 1, At, B1); PG8_BAR; PG8_SCHED;
            PG8_LDB(B0, 1, 0); PG8_LDB(B1, 1, 1); PG8_SCHED; PG8_LDA(At, 1, 0); PG8_STAGE(PG8_SA(0, 1), a2 + hstepA, voffA);
            PG8_WAIT_V(8); PG8_WAIT_L(0); PG8_BAR; PG8_MMA(0, 0, At, B0); PG8_MMA(0, 1, At, B1); PG8_BAR; PG8_SCHED;
            PG8_LDA(At, 1, 1); PG8_STAGE(PG8_SB(1, 0), b3, voffB); PG8_STAGE(PG8_SB(1, 1), b3 + hstepB, voffB); PG8_STAGE(PG8_SA(1, 0), a3, voffA);
            PG8_WAIT_V(8); PG8_WAIT_L(0); PG8_BAR; PG8_MMA(1, 0, At, B0); PG8_MMA(1, 1, At, B1); PG8_BAR; PG8_SCHED;
            } else {
            PG8_LDB(B0, 0, 0); PG8_SCHED; PG8_LDA(At, 0, 0); PG8_STAGE(PG8_SA(1, 1), a1 + hstepA, voffA);
            PG8_WAIT_L(8); PG8_BAR; PG8_WAIT_L(0); PG8_MMA(0, 0, At, B0); PG8_BAR; PG8_SCHED;
            PG8_LDB(B1, 0, 1); PG8_STAGE(PG8_SB(0, 0), b2, voffB);
            PG8_BAR; PG8_WAIT_L(0); PG8_MMA(0, 1, At, B1); PG8_BAR;
            PG8_LDA(At, 0, 1); PG8_STAGE(PG8_SA(0, 0), a2, voffA);
            PG8_BAR; PG8_WAIT_L(0); PG8_MMA(1, 0, At, B0); PG8_BAR; PG8_SCHED;
            PG8_STAGE(PG8_SB(0, 1), b2 + hstepB, voffB);
            PG8_WAIT_V(6); PG8_BAR; PG8_MMA(1, 1, At, B1); PG8_BAR;
            PG8_LDB(B0, 1, 0); PG8_SCHED; PG8_LDA(At, 1, 0); PG8_STAGE(PG8_SA(0, 1), a2 + hstepA, voffA);
            PG8_WAIT_L(8); PG8_BAR; PG8_WAIT_L(0); PG8_MMA(0, 0, At, B0); PG8_BAR; PG8_SCHED;
            PG8_LDB(B1, 1, 1); PG8_STAGE(PG8_SB(1, 0), b3, voffB);
            PG8_BAR; PG8_WAIT_L(0); PG8_MMA(0, 1, At, B1); PG8_BAR;
            PG8_LDA(At, 1, 1); PG8_STAGE(PG8_SA(1, 0), a3, voffA);
            PG8_BAR; PG8_WAIT_L(0); PG8_MMA(1, 0, At, B0); PG8_BAR; PG8_SCHED;
            PG8_STAGE(PG8_SB(1, 1), b3 + hstepB, voffB);
            PG8_WAIT_V(6); PG8_BAR; PG8_MMA(1, 1, At, B1); PG8_BAR;
            }
        }
        if constexpr (ALIGN_EPI) { if (wr == 0) PG8_BAR; }
        if constexpr (!Epi::AFTER_DRAIN) { E(acc, cur, wr, wc, fr, fq, lds); S.done(cur); }
        if (!has_next) break;
        if (Epi::zero_after(cur)) E.init(acc, nxt, wr, wc, fr, fq);
        cur = nxt; cA = nA; cB = nB; ++ui;
        if constexpr (ALIGN_EPI) { if (wr == 1) PG8_BAR; }
    }
    PG8_WAIT_V(0);
    if constexpr (!ALIGN_EPI) { if (wr == 0) PG8_BAR; }
    PG8_BAR;
    if constexpr (Epi::AFTER_DRAIN) { E.fused(acc, cur, wr, wc, fr, fq, lds, wid, lane); S.done(cur); }
#undef PG8_SA
#undef PG8_SB
#undef PG8_STAGE
#undef PG8_LDA
#undef PG8_LDB
#undef PG8_MMA
#undef PG8_WAIT_V
#undef PG8_WAIT_L
#undef PG8_BAR
#undef PG8_SCHED
}
}

namespace att {
using namespace nv;
#define ALAS __attribute__((address_space(3)))
typedef short bf16x8 __attribute__((ext_vector_type(8)));
typedef short s16x4 __attribute__((ext_vector_type(4)));
typedef float f32x16 __attribute__((ext_vector_type(16)));
typedef float f32x4 __attribute__((ext_vector_type(4)));
typedef unsigned u32x4 __attribute__((ext_vector_type(4)));
typedef unsigned u32x2 __attribute__((ext_vector_type(2)));
typedef short v4i16_t __attribute__((ext_vector_type(4)));
typedef float f32x2_t __attribute__((ext_vector_type(2))); typedef __bf16 bf16x2_t __attribute__((ext_vector_type(2)));
constexpr int LUT_OFF = 98304, LUT_STRIDE = 520, GT_OFF = LUT_OFF + 12 * LUT_STRIDE * 4;
static_assert(GT_OFF + 512 <= 131072, "attention tables inside the ring region");
constexpr float NEG = -30000.f, THR = 6.f;
__device__ __forceinline__ unsigned cvtpk(float lo, float hi) { f32x2_t v = {lo, hi}; bf16x2_t b = __builtin_convertvector(v, bf16x2_t); return __builtin_bit_cast(unsigned, b); }
__device__ __forceinline__ s16x4 vtr(ALAS const unsigned char* p) { return __builtin_bit_cast(s16x4, __builtin_amdgcn_ds_read_tr16_b64_v4i16((ALAS v4i16_t*)p)); }
__device__ __forceinline__ void glds16(const void* gsrc, unsigned lds_dst) { unsigned keep;
    asm volatile("s_mov_b32 %0, m0\n\ts_mov_b32 m0, %2\n\ts_nop 0\n\tglobal_load_lds_dwordx4 %1, off\n\ts_mov_b32 m0, %0" : "=&s"(keep) : "v"(gsrc), "s"(lds_dst) : "memory"); }
__device__ __forceinline__ float swap_add(float v) { auto rr = __builtin_amdgcn_permlane32_swap(__float_as_uint(v), __float_as_uint(v), false, false); return __uint_as_float(rr[0]) + __uint_as_float(rr[1]); }
__device__ __forceinline__ float swap_max(float v) { auto rr = __builtin_amdgcn_permlane32_swap(__float_as_uint(v), __float_as_uint(v), false, false); return fmaxf(__uint_as_float(rr[0]), __uint_as_float(rr[1])); }
#define MX3(a, b, c) __builtin_fmaxf(__builtin_fmaxf((a), (b)), (c))

__device__ __forceinline__ void attn_tables(ALAS unsigned char* lds, const float* __restrict__ lutg, const float* __restrict__ subg, float osc) {
    int tid = threadIdx.x; asm volatile("" : "+v"(tid));
    ALAS float* lut = (ALAS float*)(lds + LUT_OFF); ALAS float* gt = (ALAS float*)(lds + GT_OFF);
    for (int i = tid; i < 12 * LUT_STRIDE; i += 512) lut[i] = lutg[i];
    if (tid < 128) gt[tid] = subg[tid] * osc;
    __syncthreads();
}
__device__ __forceinline__ float g4_max(float v) { v = fmaxf(v, __shfl_xor(v, 16)); return fmaxf(v, __shfl_xor(v, 32)); }
__device__ __forceinline__ float g4_sum(float v) { v += __shfl_xor(v, 16); return v + __shfl_xor(v, 32); }

template <bool ISB, int VAR = 0>
__device__ __forceinline__ void attn_unit(ALAS unsigned char* lds, bf16* zg, const float* __restrict__ lutg, int b, int hsel, int q0, const float* __restrict__ sinkp, float lam, float osc, const float* __restrict__ subg, bf16* odry) {
    int tid_ = threadIdx.x; asm volatile("" : "+v"(tid_));
    const int tid = tid_, lane = tid & 63, c16 = lane & 15, g = lane >> 4; const int wid = __builtin_amdgcn_readfirstlane(tid >> 6);
    constexpr int NDVB = ISB ? 8 : 4, BUF = ISB ? 32768 : 16384, VOFF = ISB ? 16384 : 8192, VROW = ISB ? 256 : 128;
    const int map = ISB ? (wid >> 2) : 0, qsub = ISB ? (wid & 3) : (wid & 1), gsel = ISB ? 0 : (wid >> 1);
    const int head = ISB ? hsel : hsel * 4 + gsel;
    const int qrow0 = q0 + 32 * qsub;
    const int qcol = ISB ? (C_QB + head * 128 + map * 64) : (C_QA + head * 64);
    const int kcol = ISB ? (C_KB + head * 128) : (C_KA + hsel * 64);
    const int vcol = ISB ? (C_VB + head * 128) : (C_VA + hsel * 64);
    const size_t rowbase = (size_t)b * S;
    int kt0 = 0, kt1 = S / 64;
    if (!ISB) { kt0 = q0 / 64 - 2; if (kt0 < 0) kt0 = 0; kt1 = q0 / 64 + 3; if (kt1 > S / 64) kt1 = S / 64; }
    const int nt = kt1 - kt0;
    ALAS float* lut = (ALAS float*)(lds + LUT_OFF) + (ISB ? 8 + head : hsel * 4 + gsel) * LUT_STRIDE;
    ALAS float* gt = (ALAS float*)(lds + GT_OFF);
    const float sink2 = ISB ? 0.f : sinkp[head] * LOG2E;
    bf16x8 qr[2][2];
#pragma unroll
    for (int qb = 0; qb < 2; ++qb) { const bf16* qp = zg + (rowbase + qrow0 + 16 * qb + c16) * ZG + qcol + 8 * g;
#pragma unroll
        for (int ks = 0; ks < 2; ++ks) qr[qb][ks] = *(const bf16x8*)(qp + 32 * ks); }
    const unsigned lds0 = (unsigned)(size_t)lds;
    const bf16* kp_[2]; const bf16* vp_[2];
#pragma unroll
    for (int i_ = 0; i_ < 2; ++i_) { const int p_ = ISB ? wid * 2 + i_ : wid;
        kp_[i_] = zg + (rowbase + (size_t)kt0 * 64 + (p_ & 7) * 8 + (lane >> 3)) * ZG + kcol + (ISB ? (p_ >> 3) * 64 : 0) + ((lane & 7) ^ (lane >> 3)) * 8;
        vp_[i_] = ISB ? zg + (rowbase + (size_t)kt0 * 64 + 4 * p_ + (lane >> 4)) * ZG + vcol + ((((lane & 15) >> 1) ^ (4 * (p_ & 1) + (lane >> 4))) * 16) + 8 * (lane & 1)
                      : zg + (rowbase + (size_t)kt0 * 64 + 8 * p_ + (lane >> 3)) * ZG + vcol + ((((lane & 7) >> 1) ^ ((lane >> 4) & 3)) * 16) + 8 * (lane & 1); }
#define ATT_ISSUE(bo) do { \
        _Pragma("unroll") for (int i_ = 0; i_ < (ISB ? 2 : 1); ++i_) { const int p_ = ISB ? wid * 2 + i_ : wid; \
            glds16(kp_[i_], (unsigned)__builtin_amdgcn_readfirstlane((int)(lds0 + (bo) + p_ * 1024))); \
            glds16(vp_[i_], (unsigned)__builtin_amdgcn_readfirstlane((int)(lds0 + (bo) + VOFF + p_ * 1024))); \
            kp_[i_] += 64 * ZG; vp_[i_] += 64 * ZG; } } while (0)
#define ATT_SB() __builtin_amdgcn_sched_barrier(0)
    float mhat[2] = {0.f, 0.f}, lsum[2] = {0.f, 0.f};
    f32x4 o[2][NDVB];
#pragma unroll
    for (int qb = 0; qb < 2; ++qb)
#pragma unroll
        for (int d = 0; d < NDVB; ++d) o[qb][d] = (f32x4){0.f, 0.f, 0.f, 0.f};
    const int kfo = (ISB ? map * 8192 : 0) + c16 * 128 + ((g ^ (c16 & 7)) * 16);
    const int vq = (lane & 15) >> 2, vsw = ISB ? (4 * (g & 1) + vq) : (2 * (g & 1) + (vq >> 1));
    const int vfo = VOFF + (4 * g + vq) * VROW + (lane & 3) * 8;
    u32x4 pw[2][2];
    const float cfar_r = ISB ? lut[256 + 128] : 0.f, cfar_l = ISB ? lut[256 - 128] : 0.f;
#define ATT_QK(P, t, so) do { const int kb_ = (t) * 64; float cf_ = 0.f; \
        if (ISB) { if (kb_ - qrow0 - 31 >= 91) cf_ = cfar_r; else if (kb_ + 63 - qrow0 <= -91) cf_ = cfar_l; } \
        const float c0_ = cf_ - mhat[0], c1_ = cf_ - mhat[1]; const f32x4 ci0_ = (f32x4){c0_, c0_, c0_, c0_}, ci1_ = (f32x4){c1_, c1_, c1_, c1_}; \
        ALAS const unsigned char* kp = lds + (so) + kfo; \
        _Pragma("unroll") for (int kb = 0; kb < 4; ++kb) { \
            const bf16x8 k0_ = *(ALAS const bf16x8*)(kp + kb * 2048), k1_ = *(ALAS const bf16x8*)((ALAS const unsigned char*)((unsigned)(size_t)kp ^ 64u) + kb * 2048); \
            P[0][kb] = __builtin_amdgcn_mfma_f32_16x16x32_bf16(k0_, qr[0][0], ci0_, 0, 0, 0); P[1][kb] = __builtin_amdgcn_mfma_f32_16x16x32_bf16(k0_, qr[1][0], ci1_, 0, 0, 0); \
            P[0][kb] = __builtin_amdgcn_mfma_f32_16x16x32_bf16(k1_, qr[0][1], P[0][kb], 0, 0, 0); P[1][kb] = __builtin_amdgcn_mfma_f32_16x16x32_bf16(k1_, qr[1][1], P[1][kb], 0, 0, 0); } } while (0)
#define ATT_DECIDE(P, t, first) do { const int kb_ = (t) * 64; \
        if (!ISB || !((kb_ - qrow0 - 31 >= 91) || (kb_ + 63 - qrow0 <= -91))) { \
            ALAS const float* lp = lut + (kb_ - (qrow0 + c16) + 256 + 4 * g); \
            _Pragma("unroll") for (int qb = 0; qb < 2; ++qb) { float lv_[16]; \
                _Pragma("unroll") for (int kb = 0; kb < 4; ++kb) _Pragma("unroll") for (int r = 0; r < 4; ++r) lv_[4 * kb + r] = lp[16 * kb - 16 * qb + r]; \
                _Pragma("unroll") for (int kb = 0; kb < 4; ++kb) _Pragma("unroll") for (int r = 0; r < 4; ++r) P[qb][kb][r] += lv_[4 * kb + r]; } } \
        float rm0_ = MX3(MX3(P[0][0][0], P[0][0][1], P[0][0][2]), P[0][0][3], P[0][1][0]), rm1_ = MX3(MX3(P[1][0][0], P[1][0][1], P[1][0][2]), P[1][0][3], P[1][1][0]); \
        rm0_ = MX3(MX3(rm0_, P[0][1][1], P[0][1][2]), P[0][1][3], P[0][2][0]); rm1_ = MX3(MX3(rm1_, P[1][1][1], P[1][1][2]), P[1][1][3], P[1][2][0]); \
        rm0_ = MX3(MX3(rm0_, P[0][2][1], P[0][2][2]), P[0][2][3], P[0][3][0]); rm1_ = MX3(MX3(rm1_, P[1][2][1], P[1][2][2]), P[1][2][3], P[1][3][0]); \
        rm0_ = MX3(MX3(rm0_, P[0][3][1], P[0][3][2]), P[0][3][3], rm0_); rm1_ = MX3(MX3(rm1_, P[1][3][1], P[1][3][2]), P[1][3][3], rm1_); \
        if ((first) || __any(__builtin_fmaxf(rm0_, rm1_) > THR)) { \
            const float f0_ = g4_max(rm0_), f1_ = g4_max(rm1_); \
            const float dl0 = (first) ? f0_ : __builtin_fmaxf(f0_, 0.f), dl1 = (first) ? f1_ : __builtin_fmaxf(f1_, 0.f); \
            mhat[0] += dl0; mhat[1] += dl1; \
            _Pragma("unroll") for (int kb = 0; kb < 4; ++kb) { P[0][kb] -= dl0; P[1][kb] -= dl1; } \
            if (!(first)) { const float s0_ = __builtin_amdgcn_exp2f(-dl0), s1_ = __builtin_amdgcn_exp2f(-dl1); lsum[0] *= s0_; lsum[1] *= s1_; \
                _Pragma("unroll") for (int d = 0; d < NDVB; ++d) { o[0][d] *= s0_; o[1][d] *= s1_; } } } } while (0)
#define ATT_FINISH(P) do { \
        _Pragma("unroll") for (int qb = 0; qb < 2; ++qb) { float sa_ = 0.f; \
            _Pragma("unroll") for (int kb = 0; kb < 4; ++kb) _Pragma("unroll") for (int r = 0; r < 4; ++r) { P[qb][kb][r] = __builtin_amdgcn_exp2f(P[qb][kb][r]); sa_ += P[qb][kb][r]; } \
            lsum[qb] += sa_; \
            _Pragma("unroll") for (int s_ = 0; s_ < 2; ++s_) pw[qb][s_] = (u32x4){cvtpk(P[qb][2 * s_][0], P[qb][2 * s_][1]), cvtpk(P[qb][2 * s_][2], P[qb][2 * s_][3]), cvtpk(P[qb][2 * s_ + 1][0], P[qb][2 * s_ + 1][1]), cvtpk(P[qb][2 * s_ + 1][2], P[qb][2 * s_ + 1][3])}; } } while (0)
#define ATT_LDV2(dst, s_, d0_) do { _Pragma("unroll") for (int dd = 0; dd < 2; ++dd) { ALAS const unsigned char* a_ = vp + (s_) * 32 * VROW + ((((d0_) + dd) ^ vsw) * 32); dst[2 * dd] = vtr(a_); dst[2 * dd + 1] = vtr(a_ + 16 * VROW); } } while (0)
#define ATT_PV2(src, s_, d0_) do { __builtin_amdgcn_s_setprio(1); _Pragma("unroll") for (int dd = 0; dd < 2; ++dd) { \
            const bf16x8 vf_ = (bf16x8){src[2 * dd][0], src[2 * dd][1], src[2 * dd][2], src[2 * dd][3], src[2 * dd + 1][0], src[2 * dd + 1][1], src[2 * dd + 1][2], src[2 * dd + 1][3]}; \
            o[0][(d0_) + dd] = __builtin_amdgcn_mfma_f32_16x16x32_bf16(vf_, __builtin_bit_cast(bf16x8, pw[0][s_]), o[0][(d0_) + dd], 0, 0, 0); \
            o[1][(d0_) + dd] = __builtin_amdgcn_mfma_f32_16x16x32_bf16(vf_, __builtin_bit_cast(bf16x8, pw[1][s_]), o[1][(d0_) + dd], 0, 0, 0); } __builtin_amdgcn_s_setprio(0); } while (0)
#define ATT_PV(so) do { ALAS const unsigned char* vp = lds + (so) + vfo; s16x4 va[4], vb[4]; constexpr int NG_ = NDVB / 2; \
        ATT_LDV2(va, 0, 0); ATT_SB(); \
        _Pragma("unroll") for (int k_ = 0; k_ < 2 * NG_; k_ += 2) { \
            ATT_LDV2(vb, (k_ + 1) / NG_, 2 * ((k_ + 1) % NG_)); ATT_SB(); \
            ATT_PV2(va, k_ / NG_, 2 * (k_ % NG_)); ATT_SB(); \
            if (k_ + 2 < 2 * NG_) { ATT_LDV2(va, (k_ + 2) / NG_, 2 * ((k_ + 2) % NG_)); ATT_SB(); } \
            ATT_PV2(vb, (k_ + 1) / NG_, 2 * ((k_ + 1) % NG_)); ATT_SB(); } } while (0)
#define ATT_SLOT(i) (ISB ? (((i) % 3) * BUF) : ((i) * BUF))
#define ATT_STEP(i, PC, PP) do { \
        if (ISB) { asm volatile("s_waitcnt vmcnt(0)" ::: "memory"); __syncthreads(); if ((i) + 1 < nt) ATT_ISSUE(ATT_SLOT((i) + 1)); } \
        ATT_QK(PC, kt0 + (i), ATT_SLOT(i)); ATT_SB(); \
        ATT_FINISH(PP); ATT_SB(); \
        ATT_PV(ATT_SLOT((i) - 1)); ATT_SB(); \
        ATT_DECIDE(PC, kt0 + (i), false); ATT_SB(); } while (0)
    f32x4 pA[2][4], pB[2][4];
    if (ISB) { ATT_ISSUE(0); asm volatile("s_waitcnt vmcnt(0)" ::: "memory"); __syncthreads(); if (nt > 1) ATT_ISSUE(BUF); }
    else {
#pragma unroll 1
        for (int i = 0; i < nt; ++i) ATT_ISSUE(i * BUF);
        asm volatile("s_waitcnt vmcnt(0)" ::: "memory"); __syncthreads();
    }
    ATT_QK(pA, kt0, 0); ATT_SB();
    ATT_DECIDE(pA, kt0, true); ATT_SB();
    int i = 1;
#pragma unroll 1
    for (; i + 1 < nt; i += 2) {
        ATT_STEP(i, pB, pA);
        ATT_STEP(i + 1, pA, pB);
    }
    if (i < nt) {
        ATT_STEP(i, pB, pA);
        ATT_FINISH(pB); ATT_SB(); ATT_PV(ATT_SLOT(nt - 1));
    } else {
        ATT_FINISH(pA); ATT_SB(); ATT_PV(ATT_SLOT(nt - 1));
    }
#undef ATT_ISSUE
#undef ATT_SB
#undef ATT_QK
#undef ATT_DECIDE
#undef ATT_FINISH
#undef ATT_LDV2
#undef ATT_PV2
#undef ATT_PV
#undef ATT_SLOT
#undef ATT_STEP
    float inv[2];
#pragma unroll
    for (int qb = 0; qb < 2; ++qb) { float l_ = g4_sum(lsum[qb]); if (!ISB) l_ += __builtin_amdgcn_exp2f(sink2 - mhat[qb]); inv[qb] = 1.0f / l_; }
    constexpr int DVE = ISB ? 128 : 64, SPITCH = DVE * 2 + 8;
    bf16* obase = odry ? odry + (rowbase + qrow0) * D + (ISB ? (512 + head * 128) : (head * 64)) : zg + (rowbase + qrow0) * ZG + (ISB ? (C_QB + head * 128) : (C_QA + head * 64));
    const size_t opitch = odry ? D : ZG;
    ALAS unsigned char* stg = lds + (ISB ? qsub * 16384 : wid * 4608);
#define ATT_OUT() do { asm volatile("s_waitcnt lgkmcnt(0)" ::: "memory"); \
        constexpr int LPR = DVE / 8, RPI = 64 / LPR; \
        _Pragma("unroll") for (int i_ = 0; i_ < 32 / RPI; ++i_) { const int row_ = i_ * RPI + lane / LPR, ch_ = lane % LPR; \
            const u32x2 a_ = *(ALAS const u32x2*)(stg + row_ * SPITCH + ch_ * 16), b_ = *(ALAS const u32x2*)(stg + row_ * SPITCH + ch_ * 16 + 8); \
            *(u32x4*)(obase + (size_t)row_ * opitch + ch_ * 8) = (u32x4){a_.x, a_.y, b_.x, b_.y}; } } while (0)
    if (ISB) {
        __syncthreads();
        ALAS float* cs = (ALAS float*)lds;
        if (map == 1) {
#pragma unroll
            for (int qb = 0; qb < 2; ++qb) { const float sc = -lam * inv[qb];
#pragma unroll
                for (int d = 0; d < NDVB; ++d)
#pragma unroll
                    for (int r = 0; r < 4; ++r) cs[(qsub * 64 + (qb * NDVB + d) * 4 + r) * 64 + lane] = o[qb][d][r] * sc; } }
        __syncthreads();
        if (map == 0) {
            float rstd[2];
#pragma unroll
            for (int qb = 0; qb < 2; ++qb) { float q = 0.f;
#pragma unroll
                for (int d = 0; d < NDVB; ++d)
#pragma unroll
                    for (int r = 0; r < 4; ++r) { const float v = o[qb][d][r] * inv[qb] + cs[(qsub * 64 + (qb * NDVB + d) * 4 + r) * 64 + lane]; o[qb][d][r] = v; q += v * v; }
                rstd[qb] = rsqrtf(g4_sum(q) * (1.0f / 128.0f) + EPS); }
            asm volatile("s_waitcnt lgkmcnt(0)" ::: "memory");
#pragma unroll
            for (int qb = 0; qb < 2; ++qb)
#pragma unroll
                for (int d = 0; d < NDVB; ++d) { const int dv0 = 16 * d + 4 * g; const f32x4 gv = *(ALAS const f32x4*)(gt + dv0);
                    u32x2 w; w.x = cvtpk(o[qb][d][0] * rstd[qb] * gv[0], o[qb][d][1] * rstd[qb] * gv[1]); w.y = cvtpk(o[qb][d][2] * rstd[qb] * gv[2], o[qb][d][3] * rstd[qb] * gv[3]);
                    *(ALAS u32x2*)(stg + (16 * qb + c16) * SPITCH + dv0 * 2) = w; }
            ATT_OUT();
        }
    } else {
        __syncthreads();
#pragma unroll
        for (int qb = 0; qb < 2; ++qb)
#pragma unroll
            for (int d = 0; d < NDVB; ++d) { const int dv0 = 16 * d + 4 * g;
                u32x2 w; w.x = cvtpk(o[qb][d][0] * inv[qb], o[qb][d][1] * inv[qb]); w.y = cvtpk(o[qb][d][2] * inv[qb], o[qb][d][3] * inv[qb]);
                *(ALAS u32x2*)(stg + (16 * qb + c16) * SPITCH + dv0 * 2) = w; }
        ATT_OUT();
    }
#undef ATT_OUT
    __syncthreads();
}
#undef MX3
}

#ifndef MK_VAR
#define MK_VAR 0
#endif
#define MK_DUP 0
#define MK_DSEL 0
namespace mk {
using namespace nv;
constexpr int NWAVES = 8;
constexpr size_t MiB = 1u << 20;
constexpr size_t WS_CTL = 0, CTL_ZERO_BYTES = 1 * MiB;
constexpr size_t WS_LUT = 512 * 1024;
constexpr size_t WS_SS = 1 * MiB;
constexpr size_t WS_XB = 6 * MiB;
constexpr size_t WS_ZG = 38 * MiB;
constexpr size_t WS_A = 38 * MiB;
constexpr size_t WS_YB = 126 * MiB;
constexpr size_t WS_MIX = 174 * MiB;
constexpr size_t WS_W = 206 * MiB;
constexpr size_t WL_IN = 0, WL_A = (size_t)ZG * D, WL_B = WL_A + (size_t)D * 512, WL_O = WL_B + (size_t)D * 512, WL_UP = WL_O + (size_t)D * D, WL_DN = WL_UP + (size_t)FF2 * D, WL_END = WL_DN + (size_t)D * FF;
constexpr size_t WS_END = 322 * MiB;
static_assert(WS_W + 4 * WL_END * 2 <= WS_END && WS_YB + (size_t)64 * 4 * FF2 * 4 <= WS_MIX && WS_A + (size_t)T * FF * 2 <= WS_YB, "d_ws map");
constexpr int CW_Q = 2048;
constexpr int CW_BAR = 4096;
constexpr int N_PHASES = 1 + 6 * L;
constexpr int RING_OFF = 0, RING_BYTES = 131072, LDSCTL_OFF = RING_BYTES, MISC_OFF = LDSCTL_OFF + 320;
constexpr int LDS_BYTES = 149504;
static_assert(pg8::RTAB_OFF + 8192 <= LDS_BYTES && MISC_OFF + 128 <= pg8::XOFF, "LDS map");

#define GAS __attribute__((address_space(1)))
#define LAS __attribute__((address_space(3)))
typedef unsigned v4u __attribute__((ext_vector_type(4)));
typedef float f32x4 __attribute__((ext_vector_type(4)));
typedef GAS unsigned gu32;
#define RLX_AGENT __ATOMIC_RELAXED, __HIP_MEMORY_SCOPE_AGENT
#define LDS_WAIT() asm volatile("s_waitcnt lgkmcnt(0)" ::: "memory")
#define VM_WAIT() asm volatile("s_waitcnt vmcnt(0)" ::: "memory")
__device__ __forceinline__ unsigned f2bfu(float f) { unsigned u = __builtin_bit_cast(unsigned, f); return (u + 0x7fffu + ((u >> 16) & 1u)) >> 16; }
__device__ __forceinline__ unsigned pk2(float lo, float hi) { return f2bfu(lo) | (f2bfu(hi) << 16); }

#define XB_TMO      128
#define XB_XCNT(j)  (256  + 64 * (j))
#define XB_XSUB(j)  (1280 + 64 * (j))
#define XB_XGEN(j)  (2304 + 64 * (j))
#define XB_TOP      3328
#define XB_TOPGEN   3392
#define XCD_BAR_WORDS 3456
#define XB_SPIN_CAP (1u << 18)

__device__ __forceinline__ unsigned xb_ld(unsigned* p)              { return __hip_atomic_load(p, __ATOMIC_RELAXED, __HIP_MEMORY_SCOPE_AGENT); }
__device__ __forceinline__ unsigned xb_add(unsigned* p, unsigned v) { return __hip_atomic_fetch_add(p, v, __ATOMIC_RELAXED, __HIP_MEMORY_SCOPE_AGENT); }
__device__ __forceinline__ unsigned xb_xcc_id() { return (unsigned)__builtin_amdgcn_s_getreg((3 << 11) | 20) & 0xFu; }
#define XB_SPIN(cond, bar) do { unsigned _sp = 0; while (cond) { __builtin_amdgcn_s_sleep(1); \
    if ((++_sp & 255u) == 0u) { if (xb_ld(&(bar)[XB_TMO])) break; if (_sp > XB_SPIN_CAP) { atomicAdd(&(bar)[XB_TMO], 1u); break; } } } } while (0)

struct XcdBarrier {
    unsigned* bar; unsigned x;
    volatile LAS unsigned* st;
};

__device__ __forceinline__ XcdBarrier xcd_barrier_post(unsigned* bar, volatile LAS unsigned* st) {
    XcdBarrier b; b.bar = bar; b.x = xb_xcc_id(); b.st = st;
    if (threadIdx.x == 0) (void)xb_add(&bar[XB_XCNT(b.x)], 1u);
    return b;
}
__device__ __forceinline__ void xcd_barrier_complete(unsigned* bar, unsigned x, unsigned& nloc, unsigned& nx) {
    const unsigned G = gridDim.x * gridDim.y * gridDim.z;
    unsigned sum, cnt, mine, sp = 0u;
    for (;;) {
        sum = 0u; cnt = 0u; mine = 0u;
#pragma unroll
        for (unsigned j = 0; j < 16; ++j) { const unsigned c = xb_ld(&bar[XB_XCNT(j)]); sum += c; cnt += (c > 0u) ? 1u : 0u; mine = (j == x) ? c : mine; }
        if (sum == G) break;
        __builtin_amdgcn_s_sleep(1);
        if ((++sp & 255u) == 0u) { if (xb_ld(&bar[XB_TMO])) break; if (sp > XB_SPIN_CAP) { atomicAdd(&bar[XB_TMO], 1u); break; } }
    }
    nloc = mine > 0u ? mine : 1u; nx = cnt > 0u ? cnt : 1u;
}

__device__ __forceinline__ void xcd_barrier(const XcdBarrier& b) {
    asm volatile("s_waitcnt vmcnt(0)" ::: "memory");
    __syncthreads();
    if (threadIdx.x == 0) {
        unsigned* bar = b.bar;
        __builtin_amdgcn_s_waitcnt(0);
        unsigned nloc = b.st[0], nx = b.st[1];
        if (nloc == 0u) { xcd_barrier_complete(bar, b.x, nloc, nx); b.st[0] = nloc; b.st[1] = nx; }
        const unsigned old = xb_add(&bar[XB_XSUB(b.x)], 1u);
        const unsigned gen = old / nloc;
        if (old + 1u == (gen + 1u) * nloc) {
            __builtin_amdgcn_fence(__ATOMIC_RELEASE, "agent");
            asm volatile("s_waitcnt vmcnt(0)" ::: "memory");
            const unsigned og = xb_add(&bar[XB_TOP], 1u);
            const unsigned tg = og / nx;
            if (og + 1u == (tg + 1u) * nx) xb_add(&bar[XB_TOPGEN], 1u);
            else XB_SPIN(xb_ld(&bar[XB_TOPGEN]) == tg, bar);
            __builtin_amdgcn_fence(__ATOMIC_ACQUIRE, "agent");
            xb_add(&bar[XB_XGEN(b.x)], 1u);
            asm volatile("s_waitcnt vmcnt(0)" ::: "memory");
        } else {
            XB_SPIN(xb_ld(&bar[XB_XGEN(b.x)]) == gen, bar);
            __builtin_amdgcn_fence(__ATOMIC_ACQUIRE, "agent");
            asm volatile("s_waitcnt vmcnt(0)" ::: "memory");
        }
    }
    __syncthreads();
}


struct Args { const float* in[24]; float* out; unsigned char* ws; int ph_lo, ph_hi, li, pad; };

__device__ __forceinline__ void p0_transpose_item(const float* __restrict__ W, int ldw, int K, int k0, int n0, bf16* __restrict__ WT, int vrow0, const float* __restrict__ gain, LAS float* scr, int lane) {
    f32x4 v[8];
    const float* wp = W + (size_t)(k0 + (lane >> 3)) * ldw + n0 + 4 * (lane & 7);
#pragma unroll
    for (int i = 0; i < 8; ++i) v[i] = __builtin_nontemporal_load((const f32x4*)(wp + (size_t)(8 * i) * ldw));
    if (gain) {
#pragma unroll
        for (int i = 0; i < 8; ++i) v[i] *= gain[k0 + 8 * i + (lane >> 3)];
    }
#pragma unroll
    for (int i = 0; i < 8; ++i) { LAS float* d = scr + (8 * i + (lane >> 3)) * 33 + 4 * (lane & 7); d[0] = v[i].x; d[1] = v[i].y; d[2] = v[i].z; d[3] = v[i].w; }
    LDS_WAIT(); asm volatile("" ::: "memory");
    const int c = lane & 7;
#pragma unroll
    for (int j = 0; j < 4; ++j) { const int n = (lane >> 3) + 8 * j; const LAS float* s = scr + (8 * c) * 33 + n;
        v4u o; o.x = pk2(s[0 * 33], s[1 * 33]); o.y = pk2(s[2 * 33], s[3 * 33]); o.z = pk2(s[4 * 33], s[5 * 33]); o.w = pk2(s[6 * 33], s[7 * 33]);
        *(GAS v4u*)(WT + (size_t)(vrow0 + n) * K + k0 + 8 * c) = o; }
    LDS_WAIT(); asm volatile("" ::: "memory");
}
__device__ __forceinline__ int vrow_in(int c) { const int pn = c >> 8, cr = c & 255, wc = cr >> 6, bj = (cr >> 5) & 1; return pn * 256 + bj * 128 + wc * 32; }
__device__ __forceinline__ int vrow_up(int c) { const int gs = c >= FF ? 1 : 0, cc = c - gs * FF, pn = cc >> 7, wc = (cc >> 5) & 3; return pn * 256 + gs * 128 + wc * 32; }

__device__ __forceinline__ void fill_rtab(LAS unsigned char* lds, const float* __restrict__ ssx) {
    int t = threadIdx.x; asm volatile("" : "+v"(t));
    LAS float* rt = (LAS float*)(lds + pg8::RTAB_OFF); const int row0 = 8 * ((int)blockIdx.x & 7) * 256;
    float v[4];
#pragma unroll
    for (int k = 0; k < 4; ++k) v[k] = ss16(ssx, row0 + t + 512 * k);
#pragma unroll
    for (int k = 0; k < 4; ++k) rt[t + 512 * k] = rsqrtf(v[k] * (1.0f / D) + EPS);
    __syncthreads();
}
__global__ void __launch_bounds__(NWAVES * 64, 2) skel_fwd(Args args) {
    extern __shared__ __attribute__((aligned(16))) unsigned char lds_raw[];
    LAS unsigned char* lds = (LAS unsigned char*)lds_raw;
    volatile LAS unsigned* MISC = (volatile LAS unsigned*)(lds + MISC_OFF);
    const int G = gridDim.x; int vcu; { const int bx = blockIdx.x; vcu = (G % 8 == 0) ? (bx % 8) * (G / 8) + bx / 8 : bx; }
    unsigned char* ws = args.ws;
    gu32* ctl = (gu32*)(ws + WS_CTL);
    float* ss = (float*)(ws + WS_SS); bf16* xb = (bf16*)(ws + WS_XB); bf16* zg = (bf16*)(ws + WS_ZG); bf16* abuf = (bf16*)(ws + WS_A); float* yb = (float*)(ws + WS_YB);
    bf16* mix = (bf16*)(ws + WS_MIX); bf16* wbase = (bf16*)(ws + WS_W); float* xf = args.out;
    float* lutg = (float*)(ws + WS_LUT);
    for (int u = threadIdx.x; u < (LDS_BYTES - LDSCTL_OFF) / 4; u += NWAVES * 64) ((LAS unsigned*)(lds + LDSCTL_OFF))[u] = 0u;
    __syncthreads();
    XcdBarrier bar = xcd_barrier_post((unsigned*)(ctl + CW_BAR) + args.li * XCD_BAR_WORDS, MISC + 8);

#pragma unroll 1
    for (int ph = args.ph_lo; ph < args.ph_hi; ++ph) {
        const int l = ph > 0 ? (ph - 1) / 6 : 0, p = ph > 0 ? (ph - 1) % 6 + 1 : 0;
        bf16* wl = wbase + (size_t)l * WL_END;
        float* ss1 = ss + (size_t)((2 * l) & 3) * T * 16; float* ss2 = ss + (size_t)((2 * l + 1) & 3) * T * 16; float* ss3 = (l + 1 < L) ? ss + (size_t)((2 * l + 2) & 3) * T * 16 : nullptr;
#ifndef MK_ONLY
#define MK_ONLY 0x7f
#endif
        const int dupp = ((args.pad >> 8) & 0xff) - 1;
#pragma unroll 1
        for (int rep = (p == dupp) ? 0 : 1; rep < 2; ++rep) {
        if (p == 0 && (MK_ONLY & 1)) {
            int tid0 = threadIdx.x; asm volatile("" : "+v"(tid0));
            const int lane0 = tid0 & 63, wave = __builtin_amdgcn_readfirstlane(tid0 >> 6);
            LAS float* scr = (LAS float*)(lds + RING_OFF + wave * 16384);
            const int gw = vcu * NWAVES + wave, NGW = G * NWAVES;
            constexpr int I_IN = (D / 64) * (INW / 32), I_G = (D / 64) * (GW / 32), I_A = (512 / 64) * (D / 32), I_O = (D / 64) * (D / 32), I_UP = (D / 64) * (FF2 / 32), I_DN = (FF / 64) * (D / 32);
            constexpr int I_LAYER = I_IN + I_G + 2 * I_A + I_O + I_UP + I_DN;
            for (int i = gw * 64 + lane0; i < 12 * att::LUT_STRIDE; i += NGW * 64) { const int hh = i / att::LUT_STRIDE, j = i - hh * att::LUT_STRIDE, rel = j - 256, ar = rel < 0 ? -rel : rel;
                float v = 0.f; if (j <= 512) v = (hh < 8 && ar > 128) ? att::NEG : args.in[13][t5_bucket(rel) * 12 + hh] * LOG2E;
                lutg[i] = v; }
            for (int m = gw; m < T; m += 2 * NGW) {
                const int m2 = m + NGW;
                const GAS f32x4* xr = (const GAS f32x4*)(args.in[0] + (size_t)m * D) + lane0; const GAS f32x4* xr2 = (const GAS f32x4*)(args.in[0] + (size_t)m2 * D) + lane0;
                GAS unsigned long long* o8 = (GAS unsigned long long*)(xb + (size_t)m * D) + lane0; GAS unsigned long long* o82 = (GAS unsigned long long*)(xb + (size_t)m2 * D) + lane0;
                f32x4 va[4], vb[4];
#pragma unroll
                for (int j = 0; j < 4; ++j) { va[j] = xr[64 * j]; vb[j] = xr2[64 * j]; }
                float s = 0.f, s2 = 0.f;
#pragma unroll
                for (int j = 0; j < 4; ++j) { const f32x4 v = va[j], w = vb[j]; s += (v.x * v.x + v.y * v.y) + (v.z * v.z + v.w * v.w); s2 += (w.x * w.x + w.y * w.y) + (w.z * w.z + w.w * w.w);
                    o8[64 * j] = (unsigned long long)pk2(v.x, v.y) | ((unsigned long long)pk2(v.z, v.w) << 32); o82[64 * j] = (unsigned long long)pk2(w.x, w.y) | ((unsigned long long)pk2(w.z, w.w) << 32); }
                s = wave_sum(s); s2 = wave_sum(s2);
                ss16_store(ss, m, s, lane0); ss16_store(ss, m2, s2, lane0);
            }
        } else if (p == 1 && (MK_ONLY & 2)) {
            pg8::SchedStd S; S.init(xb, D, wl + WL_IN, D, T, ZG - 256, G, (int)blockIdx.x);
            S.fix = (rep == 0 && MK_VAR == 8) ? 1 : 0;
            fill_rtab(lds, ss1);
            pg8::EpiIn E{zg, ss1, args.in[3] + l * 64, args.in[4] + l * 64, args.in[6] + l * 64, args.in[7] + l * 64, args.in[15] + l * GW, (args.pad >> 25) & 1};
            pg8::gemm_phase<pg8::EpiIn, pg8::SchedStd, true, true>(lds + RING_OFF, D, D, S, E);
        } else if (p == 2 && (MK_ONLY & 4)) {
            int lop = l; asm volatile("" : "+s"(lop));
            const float lam_init = 0.8f - 0.6f * __expf(-0.3f * (float)lop);
            int ln = threadIdx.x; asm volatile("" : "+v"(ln)); ln &= 63;
            const float d1 = wave_sum(args.in[8][l * 64 + ln] * args.in[9][l * 64 + ln]), d2 = wave_sum(args.in[10][l * 64 + ln] * args.in[11][l * 64 + ln]);
            const float lam = __expf(d1) - __expf(d2) + lam_init;
            if ((vcu & 3) == 0 && rep == 1) {
                pg8::SchedStd S1; S1.init(xb, D, wl + WL_IN, D, T, ZG, G, (int)blockIdx.x); S1.one = 1; S1.opm = 8 * (vcu >> 5) + ((vcu & 31) >> 2); S1.opn = 16;
                fill_rtab(lds, ss1);
                pg8::EpiIn E1{zg, ss1, args.in[3] + l * 64, args.in[4] + l * 64, args.in[6] + l * 64, args.in[7] + l * 64, args.in[15] + l * GW, 0};
                pg8::gemm_phase<pg8::EpiIn, pg8::SchedStd, true, true>(lds + RING_OFF, D, D, S1, E1);
            }
            att::attn_tables(lds, lutg, args.in[12] + l * 128, 1.0f - lam_init);
            const int dsel = args.pad >> 16;
            if (rep == 1 || dsel != 2)
            for (int ui = vcu; ui < 512; ui += G) { const int bh = ui >> 4, qb = ui & 15; if (rep == 0 && MK_VAR == 7 && (vcu & 1)) {} else if (rep == 0) att::attn_unit<true, (MK_VAR == 7 ? 0 : MK_VAR)>(lds, zg, lutg, bh >> 2, bh & 3, qb * 128, nullptr, lam, 1.0f - lam_init, args.in[12] + l * 128, mix);
                else att::attn_unit<true, 0>(lds, zg, lutg, bh >> 2, bh & 3, qb * 128, nullptr, lam, 1.0f - lam_init, args.in[12] + l * 128, nullptr); }
            if (rep == 1 || dsel != 1) {
                unsigned* qctr = (unsigned*)(ctl + CW_Q + 64 * (2 * l + rep));
                for (;;) {
                    if (threadIdx.x == 0) MISC[4] = __hip_atomic_fetch_add(qctr, 1u, __ATOMIC_RELAXED, __HIP_MEMORY_SCOPE_AGENT);
                    __syncthreads();
                    const int ui = (int)MISC[4];
                    __syncthreads();
                    if (ui >= 512) break;
                    const int bk = ui >> 5, qb = ui & 31; att::attn_unit<false>(lds, zg, lutg, bk >> 1, bk & 1, qb * 64, args.in[5] + l * HA, 0.f, 0.f, nullptr, rep == 0 ? mix : nullptr);
                }
            }
        } else if (p == 3 && (MK_ONLY & 8)) {
            pg8::SchedMix S; S.b.init(zg + C_QA, ZG, wl + WL_A, 512, T, D, G, (int)blockIdx.x); S.A1 = (const char*)(zg + C_QB); S.Bt1 = (const char*)(wl + WL_B);
            pg8::EpiMix E{zg, mix};
            pg8::gemm_phase<pg8::EpiMix, pg8::SchedMix, true, true>(lds + RING_OFF, 512, ZG, S, E);
        } else if (p == 4 && (MK_ONLY & 16)) {
            pg8::SchedStd S; S.init(mix, D, wl + WL_O, D, T, D, G, (int)blockIdx.x);
            pg8::EpiRes E{l == 0 ? args.in[0] : xf, xf, xb, ss2};
            pg8::gemm_phase<pg8::EpiRes, pg8::SchedStd, true, true>(lds + RING_OFF, D, D, S, E);
        } else if (p == 5 && (MK_ONLY & 32)) {
            pg8::SchedStd S; S.init(xb, D, wl + WL_UP, D, T, FF2, G, (int)blockIdx.x);
            fill_rtab(lds, ss2);
            pg8::EpiUp E{abuf, ss2, args.in[21] + (size_t)l * 3 * FF2, args.in[22] + (size_t)l * FF2, yb, (args.pad >> 24) & 1};
            pg8::gemm_phase<pg8::EpiUp, pg8::SchedStd, true, true>(lds + RING_OFF, D, D, S, E);
        } else if (MK_ONLY & 64) {
            pg8::SchedDown S; S.b.init(abuf, FF, wl + WL_DN, FF, T, D, G, (int)blockIdx.x); S.yb = (args.pad & 1) ? nullptr : yb; S.cw = args.in[21] + (size_t)l * 3 * FF2; S.cb = args.in[22] + (size_t)l * FF2; S.a = abuf;
            pg8::EpiRes E{xf, xf, ss3 ? xb : nullptr, ss3};
            pg8::gemm_phase<pg8::EpiRes, pg8::SchedDown, true, true>(lds + RING_OFF, FF, FF, S, E);
        }
        {
            int ph2 = ph; asm volatile("" : "+s"(ph2));
            const int l2 = ph2 > 0 ? (ph2 - 1) / 6 : 0, p2 = ph2 > 0 ? (ph2 - 1) % 6 + 1 : 0;
            const int G2 = gridDim.x, bx2 = blockIdx.x;
            int cl = -1, cw0 = 0, cnw = 1;
            if (p2 == 0) { cl = 0; cw0 = ((G2 % 8 == 0) ? (bx2 % 8) * (G2 / 8) + bx2 / 8 : bx2) * NWAVES; cnw = G2 * NWAVES; }
            else if (p2 == 5 && l2 + 1 < L && G2 == 256 && bx2 >= 128) { cl = l2 + 1; cw0 = (bx2 - 128) * NWAVES; cnw = 128 * NWAVES; }
            if (cl >= 0) {
                bf16* wbase2 = (bf16*)(args.ws + WS_W);
                int tid0 = threadIdx.x; asm volatile("" : "+v"(tid0));
                const int lane0 = tid0 & 63, wave = __builtin_amdgcn_readfirstlane(tid0 >> 6);
                LAS float* scr = (LAS float*)(lds + RING_OFF + wave * 16384);
                constexpr int I_IN = (D / 64) * (INW / 32), I_G = (D / 64) * (GW / 32), I_A = (512 / 64) * (D / 32), I_O = (D / 64) * (D / 32), I_UP = (D / 64) * (FF2 / 32), I_DN = (FF / 64) * (D / 32);
                constexpr int I_LAYER = I_IN + I_G + 2 * I_A + I_O + I_UP + I_DN;
                const int ll = cl; bf16* w = wbase2 + (size_t)ll * WL_END;
#pragma unroll 1
                for (int it = cw0 + wave; it < I_LAYER; it += cnw) {
                    int r = it;
                    if (r < I_IN) { const int nb = r % (INW / 32), kb = r / (INW / 32); p0_transpose_item(args.in[2] + (size_t)ll * D * INW, INW, D, 64 * kb, 32 * nb, w + WL_IN, vrow_in(32 * nb), args.in[1] + ll * D, scr, lane0); continue; } r -= I_IN;
                    if (r < I_G) { const int nb = r % (GW / 32), kb = r / (GW / 32); p0_transpose_item(args.in[14] + (size_t)ll * D * GW, GW, D, 64 * kb, 32 * nb, w + WL_IN, vrow_in(INW + 32 * nb), args.in[1] + ll * D, scr, lane0); continue; } r -= I_G;
                    if (r < I_A) { const int nb = r % (D / 32), kb = r / (D / 32); p0_transpose_item(args.in[16] + (size_t)ll * 512 * D, D, 512, 64 * kb, 32 * nb, w + WL_A, 32 * nb, nullptr, scr, lane0); continue; } r -= I_A;
                    if (r < I_A) { const int nb = r % (D / 32), kb = r / (D / 32); p0_transpose_item(args.in[17] + (size_t)ll * 512 * D, D, 512, 64 * kb, 32 * nb, w + WL_B, 32 * nb, nullptr, scr, lane0); continue; } r -= I_A;
                    if (r < I_O) { const int nb = r % (D / 32), kb = r / (D / 32); p0_transpose_item(args.in[18] + (size_t)ll * D * D, D, D, 64 * kb, 32 * nb, w + WL_O, 32 * nb, nullptr, scr, lane0); continue; } r -= I_O;
                    if (r < I_UP) { const int nb = r % (FF2 / 32), kb = r / (FF2 / 32); p0_transpose_item(args.in[20] + (size_t)ll * D * FF2, FF2, D, 64 * kb, 32 * nb, w + WL_UP, vrow_up(32 * nb), args.in[19] + ll * D, scr, lane0); continue; } r -= I_UP;
                    { const int nb = r % (D / 32), kb = r / (D / 32); p0_transpose_item(args.in[23] + (size_t)ll * FF * D, D, FF, 64 * kb, 32 * nb, w + WL_DN, 32 * nb, nullptr, scr, lane0); }
                }
            }
        }
        }
        if (ph + 1 < args.ph_hi) xcd_barrier(bar);
    }
}
}

extern "C" void kernel_launch(void* const* d_in, const int* in_sizes, int n_in, void* d_out, int out_size, void* d_ws, size_t ws_size, hipStream_t stream) {
    using namespace nv;
    static int grid = 0;
    if (grid == 0) {
        if (n_in != 24 || in_sizes[0] != T * D || out_size != T * D || ws_size < mk::WS_END) { fprintf(stderr, "kernel_launch: built for 24 inputs, x/out of %d floats, >= %zu bytes of workspace; got n_in %d, out %d, ws %zu; nothing launched\n", T * D, (size_t)mk::WS_END, n_in, out_size, ws_size); grid = -1; return; }
        int dev = 0, cus = 0, per_cu = 0;
        if (hipGetDevice(&dev) != hipSuccess || hipDeviceGetAttribute(&cus, hipDeviceAttributeMultiprocessorCount, dev) != hipSuccess) { fprintf(stderr, "kernel_launch: device query failed; nothing launched\n"); grid = -1; return; }
        if (hipFuncSetAttribute((const void*)mk::skel_fwd, hipFuncAttributeMaxDynamicSharedMemorySize, mk::LDS_BYTES) != hipSuccess) { fprintf(stderr, "kernel_launch: hipFuncSetAttribute failed (needs %d bytes of dynamic LDS)\n", mk::LDS_BYTES); grid = -1; return; }
        if (hipOccupancyMaxActiveBlocksPerMultiprocessor(&per_cu, (const void*)mk::skel_fwd, mk::NWAVES * 64, mk::LDS_BYTES) != hipSuccess || per_cu < 1) fprintf(stderr, "kernel_launch: note: occupancy query reports %d workgroups per CU\n", per_cu);
        (void)hipGetLastError();
        grid = cus;
        if (grid != 256) fprintf(stderr, "kernel_launch: the unit schedules are built for 256 CUs; this device reports %d\n", cus);
    }
    if (grid < 0) return;
    if (hipMemsetAsync((unsigned char*)d_ws + mk::WS_CTL, 0, mk::CTL_ZERO_BYTES, stream) != hipSuccess) { fprintf(stderr, "kernel_launch: memset of the control words failed; nothing launched\n"); return; }
    mk::Args a{};
    for (int i = 0; i < 24; ++i) a.in[i] = (const float*)d_in[i];
    a.out = (float*)d_out; a.ws = (unsigned char*)d_ws; a.ph_lo = 0; a.ph_hi = mk::N_PHASES; a.li = 0;
    a.pad = (MK_DUP << 8) | (MK_DSEL << 16);
    hipLaunchKernelGGL(mk::skel_fwd, dim3(grid), dim3(mk::NWAVES * 64), mk::LDS_BYTES, stream, a);
}
```

```cpp
#include <hip/hip_runtime.h>
#include <cstdio>
#include <cstdint>
#include <cmath>
#define MK_EDUP 0

namespace nv {
typedef unsigned short bf16;
constexpr int D = 1024, B = 8, S = 2048, T = B * S, L = 4;
constexpr int HA = 8, KVA = 2, HB = 4, HD = 64;
constexpr int INW = 2304, GW = 2048, ZG = INW + GW;
constexpr int FF = 2816, FF2 = 2 * FF;
constexpr int C_QA = 0, C_KA = 512, C_VA = 640, C_QB = 768, C_KB = 1280, C_VB = 1792, C_G = 2304;
constexpr float EPS = 1e-6f;
constexpr float LOG2E = 1.4426950408889634f;
constexpr float C2 = 0.125f * LOG2E;

__device__ __forceinline__ float bf2f(bf16 v) { return __uint_as_float(((unsigned)v) << 16); }
__device__ __forceinline__ bf16 f2bf(float f) { unsigned u = __float_as_uint(f); return (bf16)((u + 0x7fffu + ((u >> 16) & 1u)) >> 16); }
__device__ __forceinline__ float ldf(const float* p) { return *p; }
__device__ __forceinline__ float ldf(const bf16* p) { return bf2f(*p); }

__device__ __forceinline__ int t5_bucket(int rel) {
    const int n = rel < 0 ? -rel : rel; int v;
    if (n < 8) v = n; else if (n < 12) v = 8; else if (n < 16) v = 9; else if (n < 23) v = 10; else if (n < 32) v = 11;
    else if (n < 46) v = 12; else if (n < 64) v = 13; else if (n < 91) v = 14; else v = 15;
    return (rel > 0 ? 16 : 0) + v;
}
__device__ __forceinline__ float ss16(const float* ss, int t) { const float4* p = (const float4*)(ss + (size_t)t * 16); const float4 a = p[0], b = p[1], c = p[2], d = p[3];
    return ((a.x + a.y) + (a.z + a.w)) + ((b.x + b.y) + (b.z + b.w)) + ((c.x + c.y) + (c.z + c.w)) + ((d.x + d.y) + (d.z + d.w)); }
__device__ __forceinline__ float ss16_q(const float* ss, int t, int fq) { const float4 a = *(const float4*)(ss + (size_t)t * 16 + 4 * fq); float s = (a.x + a.y) + (a.z + a.w); s += __shfl_xor(s, 16); s += __shfl_xor(s, 32); return s; }
__device__ __forceinline__ void ss16_store(float* ss, int t, float s, int lane) { if (lane < 16) ss[(size_t)t * 16 + lane] = lane == 0 ? s : 0.f; }
__device__ __forceinline__ float wave_sum(float v) {
#pragma unroll
    for (int o = 1; o < 64; o <<= 1) v += __shfl_xor(v, o);
    return v;
}
__device__ __forceinline__ float wave_max(float v) {
#pragma unroll
    for (int o = 1; o < 64; o <<= 1) v = fmaxf(v, __shfl_xor(v, o));
    return v;
}

}


namespace pg8 {
using namespace nv;
#define PG8_LAS __attribute__((address_space(3)))
typedef unsigned short bf16_t;
typedef short bf16x8 __attribute__((ext_vector_type(8)));
typedef float f32x4 __attribute__((ext_vector_type(4)));
typedef unsigned u32x4 __attribute__((ext_vector_type(4)));
typedef unsigned u32x2 __attribute__((ext_vector_type(2)));
constexpr int BM = 256, BK = 64, HALF = 128, HTB = HALF * BK * 2  , STAGE_BYTES = 8 * HTB, NXCD = 8, WGM = 8;
constexpr int XOFF = 131072 + 1024;
constexpr int RTAB_OFF = XOFF + 8192;

__host__ __device__ __forceinline__ int lds_byte(int r, int c) { const int st = (r >> 4) * 2 + (c >> 5), rr = r & 15, cc = c & 31, ob = rr * 64 + cc * 2; return st * 1024 + (ob ^ (((ob >> 9) & 1) << 5)); }
__host__ __device__ __forceinline__ void stage_rc(int b, int& R, int& C) { const int st = b / 1024, sb = b % 1024, swz = sb ^ (((sb >> 9) & 1) << 5); R = (st >> 1) * 16 + swz / 64; C = (st & 1) * 32 + (swz % 64) / 2; }
__host__ __device__ __forceinline__ int perm32(int rho) { const int n = rho >> 4, i = rho & 15; return 8 * (i >> 2) + 4 * n + (i & 3); }

struct Unit { int pm, pn, z; };
typedef float f32x2 __attribute__((ext_vector_type(2))); typedef __bf16 bf16x2_t __attribute__((ext_vector_type(2)));
__device__ __forceinline__ unsigned cvt_pk_bf16(float lo, float hi) { f32x2 v = {lo, hi}; bf16x2_t b = __builtin_convertvector(v, bf16x2_t); return __builtin_bit_cast(unsigned, b); }
__device__ __forceinline__ float bflo(unsigned w) { return __uint_as_float(w << 16); }
__device__ __forceinline__ float bfhi(unsigned w) { return __uint_as_float(w & 0xffff0000u); }

struct SchedStd {
    int nM, nN, nwg, G, c, fix, one, opm, opn; const char* A; const char* Bt; size_t at, bt;
    __device__ void init(const void* A_, int lda, const void* Bt_, int K, int M, int N, int G_, int c_) { fix = 0; one = 0; opm = 0; opn = 0; nM = M / BM; nN = N / BM; nwg = nM * nN; G = G_; c = c_; A = (const char*)A_; Bt = (const char*)Bt_; at = (size_t)BM * lda * 2; bt = (size_t)BM * K * 2; }
    __device__ bool next(int i, Unit& u) const {
        if (one) { if (i > 0) return false; u.pm = opm; u.pn = opn; u.z = 0; return true; }
        const long L = (long)i * G + c; if (L >= nwg) return false;
        int wgid = (int)L; { const int q = nwg / NXCD, r = nwg % NXCD, xcd = wgid % NXCD, off = wgid / NXCD; wgid = (xcd < r ? xcd * (q + 1) : r * (q + 1) + (xcd - r) * q) + off; }
        const int nig = WGM * nN, gid = wgid / nig, fm = gid * WGM, gsz = (nM - fm) < WGM ? (nM - fm) : WGM;
        u.pm = fm + ((wgid % nig) % gsz); u.pn = (wgid % nig) / gsz; u.z = 0; if (fix) { u.pm = 0; u.pn = 0; } return true;
    }
    __device__ __forceinline__ const char* aptr(const Unit& u) const { return A + (size_t)u.pm * at; }
    __device__ __forceinline__ const char* bptr(const Unit& u) const { return Bt + (size_t)u.pn * bt; }
    __device__ __forceinline__ void a_ready(const Unit&) const {}
    __device__ __forceinline__ void done(const Unit&) const {}
};
struct SchedMix {
    SchedStd b; const char* A1; const char* Bt1;
    __device__ bool next(int i, Unit& u) const { if (!b.next(i >> 1, u)) return false; u.z = i & 1; return true; }
    __device__ __forceinline__ const char* aptr(const Unit& u) const { return (u.z ? A1 : b.A) + (size_t)u.pm * b.at; }
    __device__ __forceinline__ const char* bptr(const Unit& u) const { return (u.z ? Bt1 : b.Bt) + (size_t)u.pn * b.bt; }
    __device__ __forceinline__ void a_ready(const Unit&) const {}
    __device__ __forceinline__ void done(const Unit&) const {}
};
struct SchedDown {
    SchedStd b; const float* yb; const float* cw; const float* cb; bf16_t* a;
    __device__ bool next(int i, Unit& u) const { return b.next(i, u); }
    __device__ __forceinline__ const char* aptr(const Unit& u) const { return b.aptr(u); }
    __device__ __forceinline__ const char* bptr(const Unit& u) const { return b.bptr(u); }
    __device__ __forceinline__ void a_ready(const Unit& u) const {
        const int pm = u.pm;
        if (yb)
        for (int idx = threadIdx.x; idx < 2 * FF; idx += 512) {
            const int which = idx >= FF ? 1 : 0, j = idx - which * FF;
            float uv[2];
#pragma unroll
            for (int gs = 0; gs < 2; ++gs) {
                const int col = gs * FF + j; float y0, y1, y2;
                if (which == 0) { y0 = (pm & 7) ? yb[((size_t)(pm - 1) * 4 + 3) * FF2 + col] : 0.f; y1 = yb[((size_t)pm * 4 + 0) * FF2 + col]; y2 = yb[((size_t)pm * 4 + 1) * FF2 + col]; }
                else { y0 = yb[((size_t)pm * 4 + 2) * FF2 + col]; y1 = yb[((size_t)pm * 4 + 3) * FF2 + col]; y2 = ((pm & 7) != 7) ? yb[((size_t)(pm + 1) * 4 + 0) * FF2 + col] : 0.f; }
                uv[gs] = cb[col] + cw[col] * y0 + cw[FF2 + col] * y1 + cw[2 * FF2 + col] * y2;
            }
            const float sg = uv[1] * __builtin_amdgcn_rcpf(1.0f + __builtin_amdgcn_exp2f(-uv[1] * LOG2E));
            a[(size_t)(pm * BM + which * 255) * FF + j] = f2bf(sg * uv[0]);
        }
        asm volatile("s_waitcnt vmcnt(0)" ::: "memory");
        __builtin_amdgcn_s_barrier();
        asm volatile("" ::: "memory");
    }
    __device__ __forceinline__ void done(const Unit&) const {}
};

struct EpiIn {
    static constexpr bool PERM = true, AFTER_DRAIN = false;
    __device__ __forceinline__ void init(f32x4 (&acc)[2][2][4][2], const Unit&, int, int, int, int) const {
#pragma unroll
        for (int a = 0; a < 2; ++a)
#pragma unroll
            for (int b = 0; b < 2; ++b)
#pragma unroll
                for (int m = 0; m < 4; ++m)
#pragma unroll
                    for (int n = 0; n < 2; ++n) acc[a][b][m][n] = (f32x4){0.f, 0.f, 0.f, 0.f};
    }
    __device__ static constexpr bool zero_after(const Unit&) { return true; }
    bf16_t* zg; const float* ss; const float *qn_a, *kn_a, *qn_b, *kn_b, *bg; int dup;
    __device__ __forceinline__ void operator()(f32x4 (&acc)[2][2][4][2], const Unit& u, int wr, int wc, int fr, int fq, PG8_LAS unsigned char* lds_) const {
#pragma unroll
        for (int rep_ = 0; rep_ <= ((MK_EDUP & 2) ? 1 : 0); ++rep_) {
        if (rep_) {
#pragma unroll
            for (int ai = 0; ai < 2; ++ai)
#pragma unroll
                for (int bj = 0; bj < 2; ++bj)
#pragma unroll
                    for (int m = 0; m < 4; ++m)
#pragma unroll
                        for (int n = 0; n < 2; ++n) asm volatile("" : "+v"(acc[ai][bj][m][n]) :: "memory");
        }
        const int g = u.pn * 4 + wc, colb = u.pn * BM + wc * 64 + 8 * fq;
        const float* gain = nullptr; float sc = 1.f; int mode = 0;
        if (g < 8) { gain = qn_a; sc = C2; mode = 1; } else if (g < 10) { gain = kn_a; mode = 1; } else if (g < 12) { mode = 0; } else if (g < 20) { gain = qn_b; sc = C2; mode = 1; }
        else if (g < 28) { gain = kn_b; mode = 1; } else if (g < 36) { mode = 0; } else { mode = 2; }
        float rsv[2][4];
#pragma unroll
        for (int ai = 0; ai < 2; ++ai)
#pragma unroll
            for (int m = 0; m < 4; ++m) rsv[ai][m] = ((const PG8_LAS float*)(lds_ + RTAB_OFF))[(u.pm & 7) * BM + ai * HALF + wr * 64 + m * 16 + fr];
        f32x4 gv[2][2];
#pragma unroll
        for (int bj = 0; bj < 2; ++bj)
#pragma unroll
            for (int n = 0; n < 2; ++n) {
                if (mode == 1) gv[bj][n] = *(const f32x4*)(gain + 32 * bj + 8 * fq + 4 * n) * sc;
                else if (mode == 2) gv[bj][n] = *(const f32x4*)(bg + (colb - C_G) + 32 * bj + 4 * n);
                else gv[bj][n] = (f32x4){1.f, 1.f, 1.f, 1.f};
            }
#pragma unroll
        for (int ai = 0; ai < 2; ++ai)
#pragma unroll
            for (int m = 0; m < 4; ++m) {
                const int row = u.pm * BM + ai * HALF + wr * 64 + m * 16 + fr;
                const float rs = rsv[ai][m];
                f32x4 v[2][2];
#pragma unroll
                for (int bj = 0; bj < 2; ++bj)
#pragma unroll
                    for (int n = 0; n < 2; ++n) v[bj][n] = acc[ai][bj][m][n] * rs;
                if (mode == 1) {
                    float q = 0.f;
#pragma unroll
                    for (int bj = 0; bj < 2; ++bj)
#pragma unroll
                        for (int n = 0; n < 2; ++n) { const f32x4 x = v[bj][n]; q += (x[0] * x[0] + x[1] * x[1]) + (x[2] * x[2] + x[3] * x[3]); }
                    q += __shfl_xor(q, 16); q += __shfl_xor(q, 32);
                    const float r2 = rsqrtf(q * (1.0f / 64.0f) + EPS);
#pragma unroll
                    for (int bj = 0; bj < 2; ++bj)
#pragma unroll
                        for (int n = 0; n < 2; ++n) v[bj][n] = v[bj][n] * r2 * gv[bj][n];
                } else if (mode == 2) {
#pragma unroll
                    for (int bj = 0; bj < 2; ++bj)
#pragma unroll
                        for (int n = 0; n < 2; ++n) { f32x4 x = v[bj][n] + gv[bj][n];
#pragma unroll
                            for (int e = 0; e < 4; ++e) x[e] = __builtin_fmaxf(__builtin_amdgcn_rcpf(1.0f + __builtin_amdgcn_exp2f(-x[e] * LOG2E)), 9.5367431640625e-07f);
                            v[bj][n] = x; }
                }
                bf16_t* rowp = zg + (size_t)row * ZG + colb;
#pragma unroll
                for (int bj = 0; bj < 2; ++bj) { u32x4 w; w.x = cvt_pk_bf16(v[bj][0][0], v[bj][0][1]); w.y = cvt_pk_bf16(v[bj][0][2], v[bj][0][3]); w.z = cvt_pk_bf16(v[bj][1][0], v[bj][1][1]); w.w = cvt_pk_bf16(v[bj][1][2], v[bj][1][3]);
                    *(u32x4*)(rowp + 32 * bj) = w; }
            }
        }
    }
};
struct EpiMix {
    static constexpr bool PERM = true, AFTER_DRAIN = false;
    __device__ __forceinline__ void init(f32x4 (&acc)[2][2][4][2], const Unit&, int, int, int, int) const {
#pragma unroll
        for (int a = 0; a < 2; ++a)
#pragma unroll
            for (int b = 0; b < 2; ++b)
#pragma unroll
                for (int m = 0; m < 4; ++m)
#pragma unroll
                    for (int n = 0; n < 2; ++n) acc[a][b][m][n] = (f32x4){0.f, 0.f, 0.f, 0.f};
    }
    __device__ static bool zero_after(const Unit& u) { return u.z != 0; }
    const bf16_t* zg; bf16_t* mix;
    __device__ __forceinline__ void operator()(f32x4 (&acc)[2][2][4][2], const Unit& u, int wr, int wc, int fr, int fq, PG8_LAS unsigned char*) const {
        const int col0 = u.pn * BM + wc * 32 + 8 * fq;
#pragma unroll
        for (int ai = 0; ai < 2; ++ai) {
            u32x4 gbv[4][2], gav[4][2];
#pragma unroll
            for (int m = 0; m < 4; ++m)
#pragma unroll
                for (int bj = 0; bj < 2; ++bj) { const size_t go = (size_t)(u.pm * BM + ai * HALF + wr * 64 + m * 16 + fr) * ZG + C_G + col0 + bj * HALF;
                    gbv[m][bj] = *(const u32x4*)(zg + go + D); if (u.z == 0) gav[m][bj] = *(const u32x4*)(zg + go); else gav[m][bj] = (u32x4){0u, 0u, 0u, 0u}; }
#pragma unroll
            for (int m = 0; m < 4; ++m) {
                const int row = u.pm * BM + ai * HALF + wr * 64 + m * 16 + fr;
#pragma unroll
                for (int bj = 0; bj < 2; ++bj) {
                    const int col = col0 + bj * HALF;
                    const u32x4 gb = gbv[m][bj];
                    if (u.z == 0) {
                        const u32x4 ga = gav[m][bj];
                        f32x4 r0, r1;
                        r0[0] = bflo(ga.x) * __builtin_amdgcn_rcpf(bflo(gb.x)); r0[1] = bfhi(ga.x) * __builtin_amdgcn_rcpf(bfhi(gb.x)); r0[2] = bflo(ga.y) * __builtin_amdgcn_rcpf(bflo(gb.y)); r0[3] = bfhi(ga.y) * __builtin_amdgcn_rcpf(bfhi(gb.y));
                        r1[0] = bflo(ga.z) * __builtin_amdgcn_rcpf(bflo(gb.z)); r1[1] = bfhi(ga.z) * __builtin_amdgcn_rcpf(bfhi(gb.z)); r1[2] = bflo(ga.w) * __builtin_amdgcn_rcpf(bflo(gb.w)); r1[3] = bfhi(ga.w) * __builtin_amdgcn_rcpf(bfhi(gb.w));
                        acc[ai][bj][m][0] *= r0; acc[ai][bj][m][1] *= r1;
                    } else {
                        const f32x4 v0 = acc[ai][bj][m][0] * (f32x4){bflo(gb.x), bfhi(gb.x), bflo(gb.y), bfhi(gb.y)}, v1 = acc[ai][bj][m][1] * (f32x4){bflo(gb.z), bfhi(gb.z), bflo(gb.w), bfhi(gb.w)};
                        u32x4 w; w.x = cvt_pk_bf16(v0[0], v0[1]); w.y = cvt_pk_bf16(v0[2], v0[3]); w.z = cvt_pk_bf16(v1[0], v1[1]); w.w = cvt_pk_bf16(v1[2], v1[3]);
                        *(u32x4*)(mix + (size_t)row * D + col) = w;
                    }
                }
            }
            asm volatile("" ::: "memory");
        }
    }
};
struct EpiRes {
    static constexpr bool PERM = false, AFTER_DRAIN = false;
    __device__ static constexpr bool zero_after(const Unit&) { return true; }
    const float* base; float* xf; bf16_t* xb; float* ssn;
    __device__ __forceinline__ void init(f32x4 (&acc)[2][2][4][2], const Unit& u, int wr, int wc, int fr, int fq) const {
        const int col0 = u.pn * BM + wc * 32 + 4 * fq;
#pragma unroll
        for (int ai = 0; ai < 2; ++ai)
#pragma unroll
            for (int m = 0; m < 4; ++m) { const size_t off = (size_t)(u.pm * BM + ai * HALF + wr * 64 + m * 16 + fr) * D + col0;
#pragma unroll
                for (int bj = 0; bj < 2; ++bj)
#pragma unroll
                    for (int n = 0; n < 2; ++n) acc[ai][bj][m][n] = *(const f32x4*)(base + off + bj * HALF + n * 16); }
    }
    __device__ __forceinline__ void operator()(f32x4 (&acc)[2][2][4][2], const Unit& u, int wr, int wc, int fr, int fq, PG8_LAS unsigned char*) const {
        const int col0 = u.pn * BM + wc * 32 + 4 * fq;
#pragma unroll
        for (int ai = 0; ai < 2; ++ai)
#pragma unroll
            for (int m = 0; m < 4; ++m) {
                const int row = u.pm * BM + ai * HALF + wr * 64 + m * 16 + fr; const size_t off = (size_t)row * D + col0; float q = 0.f;
#pragma unroll
                for (int bj = 0; bj < 2; ++bj)
#pragma unroll
                    for (int n = 0; n < 2; ++n) { const f32x4 o = acc[ai][bj][m][n];
                        *(f32x4*)(xf + off + bj * HALF + n * 16) = o; q += (o[0] * o[0] + o[1] * o[1]) + (o[2] * o[2] + o[3] * o[3]);
                        if (xb) { u32x2 w; w.x = cvt_pk_bf16(o[0], o[1]); w.y = cvt_pk_bf16(o[2], o[3]); *(u32x2*)(xb + off + bj * HALF + n * 16) = w; } }
                if (ssn) { q += __shfl_xor(q, 16); q += __shfl_xor(q, 32); if (fq == 0) ssn[(size_t)row * 16 + u.pn * 4 + wc] = q; }
            }
    }
};
#define DPPF(oldv, src, ctrl, bc) __int_as_float(__builtin_amdgcn_update_dpp(__float_as_int(oldv), __float_as_int(src), (ctrl), 0xF, 0xF, (bc)))
struct EpiUp {
    static constexpr bool PERM = true, AFTER_DRAIN = false;
    __device__ __forceinline__ void init(f32x4 (&acc)[2][2][4][2], const Unit&, int, int, int, int) const {
#pragma unroll
        for (int a = 0; a < 2; ++a)
#pragma unroll
            for (int b = 0; b < 2; ++b)
#pragma unroll
                for (int m = 0; m < 4; ++m)
#pragma unroll
                    for (int n = 0; n < 2; ++n) acc[a][b][m][n] = (f32x4){0.f, 0.f, 0.f, 0.f};
    }
    __device__ static constexpr bool zero_after(const Unit&) { return true; }
    bf16_t* a; const float* ss; const float* cw; const float* cb; float* yb; int dup;
    __device__ __forceinline__ void operator()(f32x4 (&acc)[2][2][4][2], const Unit& u, int wr, int wc, int fr, int fq, PG8_LAS unsigned char* lds) const {
        PG8_LAS unsigned char* lds_ = lds; const int wid = wr * 4 + wc;
        PG8_LAS float* X = (PG8_LAS float*)(lds + XOFF);
        float rsv[2][4];
#pragma unroll
        for (int ai = 0; ai < 2; ++ai)
#pragma unroll
            for (int m = 0; m < 4; ++m) rsv[ai][m] = ((const PG8_LAS float*)(lds_ + RTAB_OFF))[(u.pm & 7) * BM + ai * HALF + wr * 64 + m * 16 + fr];
#pragma unroll
        for (int ai = 0; ai < 2; ++ai)
#pragma unroll
            for (int m = 0; m < 4; ++m) {
#pragma unroll
                for (int bj = 0; bj < 2; ++bj)
#pragma unroll
                    for (int n = 0; n < 2; ++n) acc[ai][bj][m][n] *= rsv[ai][m];
            }
#pragma unroll
        for (int ai = 0; ai < 2; ++ai) {
            if (fr == 0) {
#pragma unroll
                for (int bj = 0; bj < 2; ++bj)
#pragma unroll
                    for (int n = 0; n < 2; ++n) *(PG8_LAS f32x4*)(X + ((wid * 2 + ai) * 2 + 0) * 64 + 32 * bj + 8 * fq + 4 * n) = acc[ai][bj][0][n];
            }
            if (fr == 15) {
#pragma unroll
                for (int bj = 0; bj < 2; ++bj)
#pragma unroll
                    for (int n = 0; n < 2; ++n) *(PG8_LAS f32x4*)(X + ((wid * 2 + ai) * 2 + 1) * 64 + 32 * bj + 8 * fq + 4 * n) = acc[ai][bj][3][n];
            }
        }
        {
            const int ccol = u.pn * 128 + wc * 32 + 8 * fq;
            if (wr == 0 && fr < 2) {
#pragma unroll
                for (int bj = 0; bj < 2; ++bj)
#pragma unroll
                    for (int n = 0; n < 2; ++n) *(f32x4*)(yb + ((size_t)u.pm * 4 + fr) * FF2 + bj * FF + ccol + 4 * n) = acc[0][bj][0][n];
            }
            if (wr == 1 && fr >= 14) {
#pragma unroll
                for (int bj = 0; bj < 2; ++bj)
#pragma unroll
                    for (int n = 0; n < 2; ++n) *(f32x4*)(yb + ((size_t)u.pm * 4 + 2 + (fr - 14)) * FF2 + bj * FF + ccol + 4 * n) = acc[1][bj][3][n];
            }
        }
        asm volatile("s_waitcnt lgkmcnt(0)" ::: "memory"); __builtin_amdgcn_s_barrier(); asm volatile("" ::: "memory");
#pragma unroll
        for (int rep_ = 0; rep_ <= ((MK_EDUP & 1) ? 1 : 0); ++rep_) {
        if (rep_) {
#pragma unroll
            for (int ai = 0; ai < 2; ++ai)
#pragma unroll
                for (int bj = 0; bj < 2; ++bj)
#pragma unroll
                    for (int m = 0; m < 4; ++m)
#pragma unroll
                        for (int n = 0; n < 2; ++n) asm volatile("" : "+v"(acc[ai][bj][m][n]) :: "memory");
        }
#pragma unroll
        for (int n = 0; n < 2; ++n) {
            const int ccol = u.pn * 128 + wc * 32 + 8 * fq + 4 * n;
            f32x4 w0[2], w1[2], w2[2], bb[2];
#pragma unroll
            for (int bj = 0; bj < 2; ++bj) { w0[bj] = *(const f32x4*)(cw + bj * FF + ccol); w1[bj] = *(const f32x4*)(cw + FF2 + bj * FF + ccol); w2[bj] = *(const f32x4*)(cw + 2 * FF2 + bj * FF + ccol); bb[bj] = *(const f32x4*)(cb + bj * FF + ccol); }
#pragma unroll
            for (int ai = 0; ai < 2; ++ai) {
                const int pw = wr ? wid - 4 : wid + 4, pai = wr ? ai : 0;
                const int nw = wr ? wid - 4 : wid + 4, nai = wr ? 1 : ai;
                f32x4 xp[2], xn[2];
#pragma unroll
                for (int bj = 0; bj < 2; ++bj) { xp[bj] = *(PG8_LAS f32x4*)(X + ((pw * 2 + pai) * 2 + 1) * 64 + 32 * bj + 8 * fq + 4 * n); xn[bj] = *(PG8_LAS f32x4*)(X + ((nw * 2 + nai) * 2 + 0) * 64 + 32 * bj + 8 * fq + 4 * n); }
#pragma unroll
                for (int m = 0; m < 4; ++m) {
                    const int trow = ai * HALF + wr * 64 + m * 16 + fr;
                    float uv[2][4];
#pragma unroll
                    for (int bj = 0; bj < 2; ++bj)
#pragma unroll
                        for (int e = 0; e < 4; ++e) {
                            const float cur = acc[ai][bj][m][n][e];
                            float rp, rn;
                            if (m > 0) rp = DPPF(0.f, acc[ai][bj][m > 0 ? m - 1 : 0][n][e], 0x121, true); else rp = xp[bj][e];
                            if (m < 3) rn = DPPF(0.f, acc[ai][bj][m < 3 ? m + 1 : 3][n][e], 0x12F, true); else rn = xn[bj][e];
                            const float prev = DPPF(rp, cur, 0x111, false), next = DPPF(rn, cur, 0x101, false);
                            uv[bj][e] = bb[bj][e] + w0[bj][e] * prev + w1[bj][e] * cur + w2[bj][e] * next;
                        }
                    f32x4 o;
#pragma unroll
                    for (int e = 0; e < 4; ++e) o[e] = uv[0][e] * uv[1][e] * __builtin_amdgcn_rcpf(1.0f + __builtin_amdgcn_exp2f(-uv[1][e] * LOG2E));
                    u32x2 w; w.x = cvt_pk_bf16(o[0], o[1]); w.y = cvt_pk_bf16(o[2], o[3]);
                    if (trow != 0 && trow != 255) *(u32x2*)(a + (size_t)(u.pm * BM + trow) * FF + ccol) = w;
                    asm volatile("" ::: "memory");
                }
            }
        }
        }
    }
};

template <class Epi, class Sched, bool ALIGN_EPI = false, bool SP2 = false>
__device__ __forceinline__ void gemm_phase(PG8_LAS unsigned char* lds, const int K, const int lda, const Sched& S, const Epi& E) {
    int tid_ = threadIdx.x; asm volatile("" : "+v"(tid_));
    const int tid = tid_, wid = __builtin_amdgcn_readfirstlane(tid >> 6), lane = tid & 63, wr = wid >> 2, wc = wid & 3, fr = lane & 15, fq = lane >> 4;
    const int nt = K / BK;
    unsigned voffA[2], voffB[2];
#pragma unroll
    for (int i = 0; i < 2; ++i) { int R, C; stage_rc(tid * 16 + i * 8192, R, C); const int Rb = Epi::PERM ? ((R & ~31) + perm32(R & 31)) : R;
        voffA[i] = (unsigned)(R * lda + C) * 2u; voffB[i] = (unsigned)(Rb * K + C) * 2u; }
    const size_t kstep = (size_t)(BK * 2);
    const size_t hstepB = (size_t)HALF * K * 2;
    const size_t hstepA = (size_t)HALF * lda * 2;
    const unsigned ldsw = (unsigned)wid * 1024u;
    const int aoff = lds_byte(wr * 64 + fr, fq * 8), boff = lds_byte(wc * 32 + fr, fq * 8);
#define PG8_SA(b, h) (((b) * 2 + (h)) * HTB)
#define PG8_SB(b, h) ((4 + (b) * 2 + (h)) * HTB)
#define PG8_STAGE(bufoff, gbase, voff) do { _Pragma("unroll") for (int _i = 0; _i < 2; ++_i) \
        __builtin_amdgcn_global_load_lds((const unsigned*)((const char*)(gbase) + (voff)[_i]), (PG8_LAS unsigned*)(lds + (bufoff) + ldsw + _i * 8192), 16, 0, 0); } while (0)
#define PG8_LDA(dst, b, h) do { _Pragma("unroll") for (int m = 0; m < 4; ++m) _Pragma("unroll") for (int k = 0; k < 2; ++k) dst[m][k] = *(const PG8_LAS bf16x8*)(lds + PG8_SA(b, h) + aoff + m * 2048 + k * 1024); } while (0)
#define PG8_LDB(dst, b, h) do { _Pragma("unroll") for (int n = 0; n < 2; ++n) _Pragma("unroll") for (int k = 0; k < 2; ++k) dst[n][k] = *(const PG8_LAS bf16x8*)(lds + PG8_SB(b, h) + boff + n * 2048 + k * 1024); } while (0)
#define PG8_MMA(ai, bj, At, Bt) do { __builtin_amdgcn_s_setprio(1); _Pragma("unroll") for (int m = 0; m < 4; ++m) _Pragma("unroll") for (int n = 0; n < 2; ++n) _Pragma("unroll") for (int k = 0; k < 2; ++k) \
        acc[ai][bj][m][n] = __builtin_amdgcn_mfma_f32_16x16x32_bf16(Bt[n][k], At[m][k], acc[ai][bj][m][n], 0, 0, 0); __builtin_amdgcn_s_setprio(0); } while (0)
#define PG8_WAIT_V(n) asm volatile("s_waitcnt vmcnt(" #n ")" ::: "memory")
#define PG8_WAIT_L(n) asm volatile("s_waitcnt lgkmcnt(" #n ")" ::: "memory")
#define PG8_BAR __builtin_amdgcn_s_barrier()
#define PG8_SCHED __builtin_amdgcn_sched_barrier(0)
    Unit cur, nxt; int ui = 0;
    if (!S.next(0, cur)) return;
    f32x4 acc[2][2][4][2];
    E.init(acc, cur, wr, wc, fr, fq);
    bf16x8 At[4][2], B0[2][2], B1[2][2];
    const char* cA = S.aptr(cur); const char* cB = S.bptr(cur);
    S.a_ready(cur);
    if constexpr (SP2) {
        PG8_STAGE(PG8_SB(0, 0), cB, voffB); PG8_STAGE(PG8_SB(0, 1), cB + hstepB, voffB); PG8_STAGE(PG8_SA(0, 0), cA, voffA); PG8_STAGE(PG8_SA(0, 1), cA + hstepA, voffA);
        if (wr == 1) PG8_BAR;
        PG8_WAIT_V(2); PG8_BAR;
        PG8_STAGE(PG8_SB(1, 0), cB + kstep, voffB); PG8_STAGE(PG8_SA(1, 0), cA + kstep, voffA); PG8_STAGE(PG8_SB(1, 1), cB + hstepB + kstep, voffB);
        PG8_WAIT_V(6); PG8_BAR;
    } else {
        PG8_STAGE(PG8_SB(0, 0), cB, voffB); PG8_STAGE(PG8_SA(0, 0), cA, voffA); PG8_STAGE(PG8_SB(0, 1), cB + hstepB, voffB); PG8_STAGE(PG8_SA(0, 1), cA + hstepA, voffA);
        if (wr == 1) PG8_BAR;
        PG8_WAIT_V(4); PG8_BAR;
        PG8_STAGE(PG8_SB(1, 0), cB + kstep, voffB); PG8_STAGE(PG8_SA(1, 0), cA + kstep, voffA); PG8_STAGE(PG8_SB(1, 1), cB + hstepB + kstep, voffB);
        PG8_WAIT_V(6); PG8_BAR;
    }
    for (;;) {
        const bool has_next = S.next(ui + 1, nxt);
        const char* nA = has_next ? S.aptr(nxt) : cA; const char* nB = has_next ? S.bptr(nxt) : cB;
        for (int t = 0; t < nt; t += 2) {
            const bool last = (t == nt - 2);
            const char* a1 = cA + (size_t)(t + 1) * kstep;
            const char* a2 = last ? nA : cA + (size_t)(t + 2) * kstep; const char* b2 = last ? nB : cB + (size_t)(t + 2) * kstep;
            const char* a3 = a2 + kstep; const char* b3 = b2 + kstep;
            if (last && has_next) S.a_ready(nxt);
            if constexpr (SP2) {
            PG8_LDB(B0, 0, 0); PG8_LDB(B1, 0, 1); PG8_SCHED; PG8_LDA(At, 0, 0); PG8_STAGE(PG8_SA(1, 1), a1 + hstepA, voffA);
            PG8_WAIT_V(8); PG8_WAIT_L(0); PG8_BAR; PG8_MMA(0, 0, At, B0); PG8_MMA(0, 1, At, B1); PG8_BAR; PG8_SCHED;
            PG8_LDA(At, 0, 1); PG8_STAGE(PG8_SB(0, 0), b2, voffB); PG8_STAGE(PG8_SB(0, 1), b2 + hstepB, voffB); PG8_STAGE(PG8_SA(0, 0), a2, voffA);
            PG8_WAIT_V(8); PG8_WAIT_L(0); PG8_BAR; PG8_MMA(1, 0, At, B0); PG8_MMA(1, 1, At, B1); PG8_BAR; PG8_SCHED;
            PG8_LDB(B0, 1, 0); PG8_LDB(B1, 1, 1); PG8_SCHED; PG8_LDA(At, 1, 0); PG8_STAGE(PG8_SA(0, 1), a2 + hstepA, voffA);
            PG8_WAIT_V(8); PG8_WAIT_L(0); PG8_BAR; PG8_MMA(0, 0, At, B0); PG8_MMA(0, 1, At, B1); PG8_BAR; PG8_SCHED;
            PG8_LDA(At, 1, 1); PG8_STAGE(PG8_SB(1, 0), b3, voffB); PG8_STAGE(PG8_SB(1, 1), b3 + hstepB, voffB); PG8_STAGE(PG8_SA(1, 0), a3, voffA);
            PG8_WAIT_V(8); PG8_WAIT_L(0); PG8_BAR; PG8_MMA(1, 0, At, B0); PG8_MMA(1, 1, At, B1); PG8_BAR; PG8_SCHED;
            } else {
            PG8_LDB(B0, 0, 0); PG8_SCHED; PG8_LDA(At, 0, 0); PG8_STAGE(PG8_SA(1, 1), a1 + hstepA, voffA);
            PG8_WAIT_L(8); PG8_BAR; PG8_WAIT_L(0); PG8_MMA(0, 0, At, B0); PG8_BAR; PG8_SCHED;
            PG8_LDB(B1, 0, 1); PG8_STAGE(PG8_SB(0, 0), b2, voffB);
            PG8_BAR; PG8_WAIT_L(0); PG8_MMA(0, 1, At, B1); PG8_BAR;
            PG8_LDA(At, 0, 1); PG8_STAGE(PG8_SA(0, 0), a2, voffA);
            PG8_BAR; PG8_WAIT_L(0); PG8_MMA(1, 0, At, B0); PG8_BAR; PG8_SCHED;
            PG8_STAGE(PG8_SB(0, 1), b2 + hstepB, voffB);
            PG8_WAIT_V(6); PG8_BAR; PG8_MMA(1, 1, At, B1); PG8_BAR;
            PG8_LDB(B0, 1, 0); PG8_SCHED; PG8_LDA(At, 1, 0); PG8_STAGE(PG8_SA(0, 1), a2 + hstepA, voffA);
            PG8_WAIT_L(8); PG8_BAR; PG8_WAIT_L(0); PG8_MMA(0, 0, At, B0); PG8_BAR; PG8_SCHED;
            PG8_LDB(B1, 1, 1); PG8_STAGE(PG8_SB(1, 0), b3, voffB);
            PG8_BAR; PG8_WAIT_L(0); PG8_MMA(0, 1, At, B1); PG8_BAR;
            PG8_LDA(At, 1, 1); PG8_STAGE(PG8_SA(1, 0), a3, voffA);
            PG8_BAR; PG8_WAIT_L(0); PG8_MMA(1, 0, At, B0); PG8_BAR; PG8_SCHED;
            PG8_STAGE(PG8_SB(1, 1), b3 + hstepB, voffB);
            PG8_WAIT_V(6); PG8_BAR; PG8_MMA(1, 1, At, B1); PG8_BAR;
            }
        }
        if constexpr (ALIGN_EPI) { if (wr == 0) PG8_BAR; }
        if constexpr (!Epi::AFTER_DRAIN) { E(acc, cur, wr, wc, fr, fq, lds); S.done(cur); }
        if (!has_next) break;
        if (Epi::zero_after(cur)) E.init(acc, nxt, wr, wc, fr, fq);
        cur = nxt; cA = nA; cB = nB; ++ui;
        if constexpr (ALIGN_EPI) { if (wr == 1) PG8_BAR; }
    }
    PG8_WAIT_V(0);
    if constexpr (!ALIGN_EPI) { if (wr == 0) PG8_BAR; }
    PG8_BAR;
    if constexpr (Epi::AFTER_DRAIN) { E.fused(acc, cur, wr, wc, fr, fq, lds, wid, lane); S.done(cur); }
#undef PG8_SA
#undef PG8_SB
#undef PG8_STAGE
#undef PG8_LDA
#undef PG8_LDB
#undef PG8_MMA
#undef PG8_WAIT_V
#undef PG8_WAIT_L
#undef PG8_BAR
#undef PG8_SCHED
}
}

namespace att {
using namespace nv;
#define ALAS __attribute__((address_space(3)))
typedef short bf16x8 __attribute__((ext_vector_type(8)));
typedef short s16x4 __attribute__((ext_vector_type(4)));
typedef float f32x16 __attribute__((ext_vector_type(16)));
typedef float f32x4 __attribute__((ext_vector_type(4)));
typedef unsigned u32x4 __attribute__((ext_vector_type(4)));
typedef unsigned u32x2 __attribute__((ext_vector_type(2)));
typedef short v4i16_t __attribute__((ext_vector_type(4)));
typedef float f32x2_t __attribute__((ext_vector_type(2))); typedef __bf16 bf16x2_t __attribute__((ext_vector_type(2)));
constexpr int LUT_OFF = 98304, LUT_STRIDE = 520, GT_OFF = LUT_OFF + 12 * LUT_STRIDE * 4;
static_assert(GT_OFF + 512 <= 131072, "attention tables inside the ring region");
constexpr float NEG = -30000.f, THR = 6.f;
__device__ __forceinline__ unsigned cvtpk(float lo, float hi) { f32x2_t v = {lo, hi}; bf16x2_t b = __builtin_convertvector(v, bf16x2_t); return __builtin_bit_cast(unsigned, b); }
__device__ __forceinline__ s16x4 vtr(ALAS const unsigned char* p) { return __builtin_bit_cast(s16x4, __builtin_amdgcn_ds_read_tr16_b64_v4i16((ALAS v4i16_t*)p)); }
__device__ __forceinline__ void glds16(const void* gsrc, unsigned lds_dst) { unsigned keep;
    asm volatile("s_mov_b32 %0, m0\n\ts_mov_b32 m0, %2\n\ts_nop 0\n\tglobal_load_lds_dwordx4 %1, off\n\ts_mov_b32 m0, %0" : "=&s"(keep) : "v"(gsrc), "s"(lds_dst) : "memory"); }
__device__ __forceinline__ float swap_add(float v) { auto rr = __builtin_amdgcn_permlane32_swap(__float_as_uint(v), __float_as_uint(v), false, false); return __uint_as_float(rr[0]) + __uint_as_float(rr[1]); }
__device__ __forceinline__ float swap_max(float v) { auto rr = __builtin_amdgcn_permlane32_swap(__float_as_uint(v), __float_as_uint(v), false, false); return fmaxf(__uint_as_float(rr[0]), __uint_as_float(rr[1])); }
#define MX3(a, b, c) __builtin_fmaxf(__builtin_fmaxf((a), (b)), (c))

__device__ __forceinline__ void attn_tables(ALAS unsigned char* lds, const float* __restrict__ lutg, const float* __restrict__ subg, float osc) {
    int tid = threadIdx.x; asm volatile("" : "+v"(tid));
    ALAS float* lut = (ALAS float*)(lds + LUT_OFF); ALAS float* gt = (ALAS float*)(lds + GT_OFF);
    for (int i = tid; i < 12 * LUT_STRIDE; i += 512) lut[i] = lutg[i];
    if (tid < 128) gt[tid] = subg[tid] * osc;
    __syncthreads();
}
__device__ __forceinline__ float g4_max(float v) { v = fmaxf(v, __shfl_xor(v, 16)); return fmaxf(v, __shfl_xor(v, 32)); }
__device__ __forceinline__ float g4_sum(float v) { v += __shfl_xor(v, 16); return v + __shfl_xor(v, 32); }

template <bool ISB, int VAR = 0>
__device__ __forceinline__ void attn_unit(ALAS unsigned char* lds, bf16* zg, const float* __restrict__ lutg, int b, int hsel, int q0, const float* __restrict__ sinkp, float lam, float osc, const float* __restrict__ subg, bf16* odry) {
    int tid_ = threadIdx.x; asm volatile("" : "+v"(tid_));
    const int tid = tid_, lane = tid & 63, c16 = lane & 15, g = lane >> 4; const int wid = __builtin_amdgcn_readfirstlane(tid >> 6);
    constexpr int NDVB = ISB ? 8 : 4, BUF = ISB ? 32768 : 16384, VOFF = ISB ? 16384 : 8192, VROW = ISB ? 256 : 128;
    const int map = ISB ? (wid >> 2) : 0, qsub = ISB ? (wid & 3) : (wid & 1), gsel = ISB ? 0 : (wid >> 1);
    const int head = ISB ? hsel : hsel * 4 + gsel;
    const int qrow0 = q0 + 32 * qsub;
    const int qcol = ISB ? (C_QB + head * 128 + map * 64) : (C_QA + head * 64);
    const int kcol = ISB ? (C_KB + head * 128) : (C_KA + hsel * 64);
    const int vcol = ISB ? (C_VB + head * 128) : (C_VA + hsel * 64);
    const size_t rowbase = (size_t)b * S;
    int kt0 = 0, kt1 = S / 64;
    if (!ISB) { kt0 = q0 / 64 - 2; if (kt0 < 0) kt0 = 0; kt1 = q0 / 64 + 3; if (kt1 > S / 64) kt1 = S / 64; }
    const int nt = kt1 - kt0;
    ALAS float* lut = (ALAS float*)(lds + LUT_OFF) + (ISB ? 8 + head : hsel * 4 + gsel) * LUT_STRIDE;
    ALAS float* gt = (ALAS float*)(lds + GT_OFF);
    const float sink2 = ISB ? 0.f : sinkp[head] * LOG2E;
    bf16x8 qr[2][2];
#pragma unroll
    for (int qb = 0; qb < 2; ++qb) { const bf16* qp = zg + (rowbase + qrow0 + 16 * qb + c16) * ZG + qcol + 8 * g;
#pragma unroll
        for (int ks = 0; ks < 2; ++ks) qr[qb][ks] = *(const bf16x8*)(qp + 32 * ks); }
    const unsigned lds0 = (unsigned)(size_t)lds;
    const bf16* kp_[2]; const bf16* vp_[2];
#pragma unroll
    for (int i_ = 0; i_ < 2; ++i_) { const int p_ = ISB ? wid * 2 + i_ : wid;
        kp_[i_] = zg + (rowbase + (size_t)kt0 * 64 + (p_ & 7) * 8 + (lane >> 3)) * ZG + kcol + (ISB ? (p_ >> 3) * 64 : 0) + ((lane & 7) ^ (lane >> 3)) * 8;
        vp_[i_] = ISB ? zg + (rowbase + (size_t)kt0 * 64 + 4 * p_ + (lane >> 4)) * ZG + vcol + ((((lane & 15) >> 1) ^ (4 * (p_ & 1) + (lane >> 4))) * 16) + 8 * (lane & 1)
                      : zg + (rowbase + (size_t)kt0 * 64 + 8 * p_ + (lane >> 3)) * ZG + vcol + ((((lane & 7) >> 1) ^ ((lane >> 4) & 3)) * 16) + 8 * (lane & 1); }
#define ATT_ISSUE(bo) do { \
        _Pragma("unroll") for (int i_ = 0; i_ < (ISB ? 2 : 1); ++i_) { const int p_ = ISB ? wid * 2 + i_ : wid; \
            glds16(kp_[i_], (unsigned)__builtin_amdgcn_readfirstlane((int)(lds0 + (bo) + p_ * 1024))); \
            glds16(vp_[i_], (unsigned)__builtin_amdgcn_readfirstlane((int)(lds0 + (bo) + VOFF + p_ * 1024))); \
            kp_[i_] += 64 * ZG; vp_[i_] += 64 * ZG; } } while (0)
#define ATT_SB() __builtin_amdgcn_sched_barrier(0)
    float mhat[2] = {0.f, 0.f}, lsum[2] = {0.f, 0.f};
    f32x4 o[2][NDVB];
#pragma unroll
    for (int qb = 0; qb < 2; ++qb)
#pragma unroll
        for (int d = 0; d < NDVB; ++d) o[qb][d] = (f32x4){0.f, 0.f, 0.f, 0.f};
    const int kfo = (ISB ? map * 8192 : 0) + c16 * 128 + ((g ^ (c16 & 7)) * 16);
    const int vq = (lane & 15) >> 2, vsw = ISB ? (4 * (g & 1) + vq) : (2 * (g & 1) + (vq >> 1));
    const int vfo = VOFF + (4 * g + vq) * VROW + (lane & 3) * 8;
    u32x4 pw[2][2];
    const float cfar_r = ISB ? lut[256 + 128] : 0.f, cfar_l = ISB ? lut[256 - 128] : 0.f;
#define ATT_QK(P, t, so) do { const int kb_ = (t) * 64; float cf_ = 0.f; \
        if (ISB) { if (kb_ - qrow0 - 31 >= 91) cf_ = cfar_r; else if (kb_ + 63 - qrow0 <= -91) cf_ = cfar_l; } \
        const float c0_ = cf_ - mhat[0], c1_ = cf_ - mhat[1]; const f32x4 ci0_ = (f32x4){c0_, c0_, c0_, c0_}, ci1_ = (f32x4){c1_, c1_, c1_, c1_}; \
        ALAS const unsigned char* kp = lds + (so) + kfo; \
        _Pragma("unroll") for (int kb = 0; kb < 4; ++kb) { \
            const bf16x8 k0_ = *(ALAS const bf16x8*)(kp + kb * 2048), k1_ = *(ALAS const bf16x8*)((ALAS const unsigned char*)((unsigned)(size_t)kp ^ 64u) + kb * 2048); \
            P[0][kb] = __builtin_amdgcn_mfma_f32_16x16x32_bf16(k0_, qr[0][0], ci0_, 0, 0, 0); P[1][kb] = __builtin_amdgcn_mfma_f32_16x16x32_bf16(k0_, qr[1][0], ci1_, 0, 0, 0); \
            P[0][kb] = __builtin_amdgcn_mfma_f32_16x16x32_bf16(k1_, qr[0][1], P[0][kb], 0, 0, 0); P[1][kb] = __builtin_amdgcn_mfma_f32_16x16x32_bf16(k1_, qr[1][1], P[1][kb], 0, 0, 0); } } while (0)
#define ATT_DECIDE(P, t, first) do { const int kb_ = (t) * 64; \
        if (!ISB || !((kb_ - qrow0 - 31 >= 91) || (kb_ + 63 - qrow0 <= -91))) { \
            ALAS const float* lp = lut + (kb_ - (qrow0 + c16) + 256 + 4 * g); \
            _Pragma("unroll") for (int qb = 0; qb < 2; ++qb) { float lv_[16]; \
                _Pragma("unroll") for (int kb = 0; kb < 4; ++kb) _Pragma("unroll") for (int r = 0; r < 4; ++r) lv_[4 * kb + r] = lp[16 * kb - 16 * qb + r]; \
                _Pragma("unroll") for (int kb = 0; kb < 4; ++kb) _Pragma("unroll") for (int r = 0; r < 4; ++r) P[qb][kb][r] += lv_[4 * kb + r]; } } \
        float rm0_ = MX3(MX3(P[0][0][0], P[0][0][1], P[0][0][2]), P[0][0][3], P[0][1][0]), rm1_ = MX3(MX3(P[1][0][0], P[1][0][1], P[1][0][2]), P[1][0][3], P[1][1][0]); \
        rm0_ = MX3(MX3(rm0_, P[0][1][1], P[0][1][2]), P[0][1][3], P[0][2][0]); rm1_ = MX3(MX3(rm1_, P[1][1][1], P[1][1][2]), P[1][1][3], P[1][2][0]); \
        rm0_ = MX3(MX3(rm0_, P[0][2][1], P[0][2][2]), P[0][2][3], P[0][3][0]); rm1_ = MX3(MX3(rm1_, P[1][2][1], P[1][2][2]), P[1][2][3], P[1][3][0]); \
        rm0_ = MX3(MX3(rm0_, P[0][3][1], P[0][3][2]), P[0][3][3], rm0_); rm1_ = MX3(MX3(rm1_, P[1][3][1], P[1][3][2]), P[1][3][3], rm1_); \
        if ((first) || __any(__builtin_fmaxf(rm0_, rm1_) > THR)) { \
            const float f0_ = g4_max(rm0_), f1_ = g4_max(rm1_); \
            const float dl0 = (first) ? f0_ : __builtin_fmaxf(f0_, 0.f), dl1 = (first) ? f1_ : __builtin_fmaxf(f1_, 0.f); \
            mhat[0] += dl0; mhat[1] += dl1; \
            _Pragma("unroll") for (int kb = 0; kb < 4; ++kb) { P[0][kb] -= dl0; P[1][kb] -= dl1; } \
            if (!(first)) { const float s0_ = __builtin_amdgcn_exp2f(-dl0), s1_ = __builtin_amdgcn_exp2f(-dl1); lsum[0] *= s0_; lsum[1] *= s1_; \
                _Pragma("unroll") for (int d = 0; d < NDVB; ++d) { o[0][d] *= s0_; o[1][d] *= s1_; } } } } while (0)
#define ATT_FINISH(P) do { \
        _Pragma("unroll") for (int qb = 0; qb < 2; ++qb) { float sa_ = 0.f; \
            _Pragma("unroll") for (int kb = 0; kb < 4; ++kb) _Pragma("unroll") for (int r = 0; r < 4; ++r) { P[qb][kb][r] = __builtin_amdgcn_exp2f(P[qb][kb][r]); sa_ += P[qb][kb][r]; } \
            lsum[qb] += sa_; \
            _Pragma("unroll") for (int s_ = 0; s_ < 2; ++s_) pw[qb][s_] = (u32x4){cvtpk(P[qb][2 * s_][0], P[qb][2 * s_][1]), cvtpk(P[qb][2 * s_][2], P[qb][2 * s_][3]), cvtpk(P[qb][2 * s_ + 1][0], P[qb][2 * s_ + 1][1]), cvtpk(P[qb][2 * s_ + 1][2], P[qb][2 * s_ + 1][3])}; } } while (0)
#define ATT_LDV2(dst, s_, d0_) do { _Pragma("unroll") for (int dd = 0; dd < 2; ++dd) { ALAS const unsigned char* a_ = vp + (s_) * 32 * VROW + ((((d0_) + dd) ^ vsw) * 32); dst[2 * dd] = vtr(a_); dst[2 * dd + 1] = vtr(a_ + 16 * VROW); } } while (0)
#define ATT_PV2(src, s_, d0_) do { __builtin_amdgcn_s_setprio(1); _Pragma("unroll") for (int dd = 0; dd < 2; ++dd) { \
            const bf16x8 vf_ = (bf16x8){src[2 * dd][0], src[2 * dd][1], src[2 * dd][2], src[2 * dd][3], src[2 * dd + 1][0], src[2 * dd + 1][1], src[2 * dd + 1][2], src[2 * dd + 1][3]}; \
            o[0][(d0_) + dd] = __builtin_amdgcn_mfma_f32_16x16x32_bf16(vf_, __builtin_bit_cast(bf16x8, pw[0][s_]), o[0][(d0_) + dd], 0, 0, 0); \
            o[1][(d0_) + dd] = __builtin_amdgcn_mfma_f32_16x16x32_bf16(vf_, __builtin_bit_cast(bf16x8, pw[1][s_]), o[1][(d0_) + dd], 0, 0, 0); } __builtin_amdgcn_s_setprio(0); } while (0)
#define ATT_PV(so) do { ALAS const unsigned char* vp = lds + (so) + vfo; s16x4 va[4], vb[4]; constexpr int NG_ = NDVB / 2; \
        ATT_LDV2(va, 0, 0); ATT_SB(); \
        _Pragma("unroll") for (int k_ = 0; k_ < 2 * NG_; k_ += 2) { \
            ATT_LDV2(vb, (k_ + 1) / NG_, 2 * ((k_ + 1) % NG_)); ATT_SB(); \
            ATT_PV2(va, k_ / NG_, 2 * (k_ % NG_)); ATT_SB(); \
            if (k_ + 2 < 2 * NG_) { ATT_LDV2(va, (k_ + 2) / NG_, 2 * ((k_ + 2) % NG_)); ATT_SB(); } \
            ATT_PV2(vb, (k_ + 1) / NG_, 2 * ((k_ + 1) % NG_)); ATT_SB(); } } while (0)
#define ATT_SLOT(i) (ISB ? (((i) % 3) * BUF) : ((i) * BUF))
#define ATT_STEP(i, PC, PP) do { \
        if (ISB) { asm volatile("s_waitcnt vmcnt(0)" ::: "memory"); __syncthreads(); if ((i) + 1 < nt) ATT_ISSUE(ATT_SLOT((i) + 1)); } \
        ATT_QK(PC, kt0 + (i), ATT_SLOT(i)); ATT_SB(); \
        ATT_FINISH(PP); ATT_SB(); \
        ATT_PV(ATT_SLOT((i) - 1)); ATT_SB(); \
        ATT_DECIDE(PC, kt0 + (i), false); ATT_SB(); } while (0)
    f32x4 pA[2][4], pB[2][4];
    if (ISB) { ATT_ISSUE(0); asm volatile("s_waitcnt vmcnt(0)" ::: "memory"); __syncthreads(); if (nt > 1) ATT_ISSUE(BUF); }
    else {
#pragma unroll 1
        for (int i = 0; i < nt; ++i) ATT_ISSUE(i * BUF);
        asm volatile("s_waitcnt vmcnt(0)" ::: "memory"); __syncthreads();
    }
    ATT_QK(pA, kt0, 0); ATT_SB();
    ATT_DECIDE(pA, kt0, true); ATT_SB();
    int i = 1;
#pragma unroll 1
    for (; i + 1 < nt; i += 2) {
        ATT_STEP(i, pB, pA);
        ATT_STEP(i + 1, pA, pB);
    }
    if (i < nt) {
        ATT_STEP(i, pB, pA);
        ATT_FINISH(pB); ATT_SB(); ATT_PV(ATT_SLOT(nt - 1));
    } else {
        ATT_FINISH(pA); ATT_SB(); ATT_PV(ATT_SLOT(nt - 1));
    }
#undef ATT_ISSUE
#undef ATT_SB
#undef ATT_QK
#undef ATT_DECIDE
#undef ATT_FINISH
#undef ATT_LDV2
#undef ATT_PV2
#undef ATT_PV
#undef ATT_SLOT
#undef ATT_STEP
    float inv[2];
#pragma unroll
    for (int qb = 0; qb < 2; ++qb) { float l_ = g4_sum(lsum[qb]); if (!ISB) l_ += __builtin_amdgcn_exp2f(sink2 - mhat[qb]); inv[qb] = 1.0f / l_; }
    constexpr int DVE = ISB ? 128 : 64, SPITCH = DVE * 2 + 8;
    bf16* obase = odry ? odry + (rowbase + qrow0) * D + (ISB ? (512 + head * 128) : (head * 64)) : zg + (rowbase + qrow0) * ZG + (ISB ? (C_QB + head * 128) : (C_QA + head * 64));
    const size_t opitch = odry ? D : ZG;
    ALAS unsigned char* stg = lds + (ISB ? qsub * 16384 : wid * 4608);
#define ATT_OUT() do { asm volatile("s_waitcnt lgkmcnt(0)" ::: "memory"); \
        constexpr int LPR = DVE / 8, RPI = 64 / LPR; \
        _Pragma("unroll") for (int i_ = 0; i_ < 32 / RPI; ++i_) { const int row_ = i_ * RPI + lane / LPR, ch_ = lane % LPR; \
            const u32x2 a_ = *(ALAS const u32x2*)(stg + row_ * SPITCH + ch_ * 16), b_ = *(ALAS const u32x2*)(stg + row_ * SPITCH + ch_ * 16 + 8); \
            *(u32x4*)(obase + (size_t)row_ * opitch + ch_ * 8) = (u32x4){a_.x, a_.y, b_.x, b_.y}; } } while (0)
    if (ISB) {
        __syncthreads();
        ALAS float* cs = (ALAS float*)lds;
        if (map == 1) {
#pragma unroll
            for (int qb = 0; qb < 2; ++qb) { const float sc = -lam * inv[qb];
#pragma unroll
                for (int d = 0; d < NDVB; ++d)
#pragma unroll
                    for (int r = 0; r < 4; ++r) cs[(qsub * 64 + (qb * NDVB + d) * 4 + r) * 64 + lane] = o[qb][d][r] * sc; } }
        __syncthreads();
        if (map == 0) {
            float rstd[2];
#pragma unroll
            for (int qb = 0; qb < 2; ++qb) { float q = 0.f;
#pragma unroll
                for (int d = 0; d < NDVB; ++d)
#pragma unroll
                    for (int r = 0; r < 4; ++r) { const float v = o[qb][d][r] * inv[qb] + cs[(qsub * 64 + (qb * NDVB + d) * 4 + r) * 64 + lane]; o[qb][d][r] = v; q += v * v; }
                rstd[qb] = rsqrtf(g4_sum(q) * (1.0f / 128.0f) + EPS); }
            asm volatile("s_waitcnt lgkmcnt(0)" ::: "memory");
#pragma unroll
            for (int qb = 0; qb < 2; ++qb)
#pragma unroll
                for (int d = 0; d < NDVB; ++d) { const int dv0 = 16 * d + 4 * g; const f32x4 gv = *(ALAS const f32x4*)(gt + dv0);
                    u32x2 w; w.x = cvtpk(o[qb][d][0] * rstd[qb] * gv[0], o[qb][d][1] * rstd[qb] * gv[1]); w.y = cvtpk(o[qb][d][2] * rstd[qb] * gv[2], o[qb][d][3] * rstd[qb] * gv[3]);
                    *(ALAS u32x2*)(stg + (16 * qb + c16) * SPITCH + dv0 * 2) = w; }
            ATT_OUT();
        }
    } else {
        __syncthreads();
#pragma unroll
        for (int qb = 0; qb < 2; ++qb)
#pragma unroll
            for (int d = 0; d < NDVB; ++d) { const int dv0 = 16 * d + 4 * g;
                u32x2 w; w.x = cvtpk(o[qb][d][0] * inv[qb], o[qb][d][1] * inv[qb]); w.y = cvtpk(o[qb][d][2] * inv[qb], o[qb][d][3] * inv[qb]);
                *(ALAS u32x2*)(stg + (16 * qb + c16) * SPITCH + dv0 * 2) = w; }
        ATT_OUT();
    }
#undef ATT_OUT
    __syncthreads();
}
#undef MX3
}

#ifndef MK_VAR
#define MK_VAR 0
#endif
#define MK_DUP 1
#define MK_DSEL 0
#define MK_XSW 0
namespace mk {
using namespace nv;
constexpr int NWAVES = 8;
constexpr size_t MiB = 1u << 20;
constexpr size_t WS_CTL = 0, CTL_ZERO_BYTES = 1 * MiB;
constexpr size_t WS_LUT = 512 * 1024;
constexpr size_t WS_SS = 1 * MiB;
constexpr size_t WS_XB = 6 * MiB;
constexpr size_t WS_ZG = 38 * MiB;
constexpr size_t WS_A = 38 * MiB;
constexpr size_t WS_YB = 126 * MiB;
constexpr size_t WS_MIX = 174 * MiB;
constexpr size_t WS_W = 206 * MiB;
constexpr size_t WL_IN = 0, WL_A = (size_t)ZG * D, WL_B = WL_A + (size_t)D * 512, WL_O = WL_B + (size_t)D * 512, WL_UP = WL_O + (size_t)D * D, WL_DN = WL_UP + (size_t)FF2 * D, WL_END = WL_DN + (size_t)D * FF;
constexpr size_t WS_END = 322 * MiB;
static_assert(WS_W + 4 * WL_END * 2 <= WS_END && WS_YB + (size_t)64 * 4 * FF2 * 4 <= WS_MIX && WS_A + (size_t)T * FF * 2 <= WS_YB, "d_ws map");
constexpr int CW_Q = 2048;
constexpr int CW_BAR = 8192;
constexpr int N_PHASES = 1 + 6 * L;
constexpr int RING_OFF = 0, RING_BYTES = 131072, LDSCTL_OFF = RING_BYTES, MISC_OFF = LDSCTL_OFF + 320;
constexpr int LDS_BYTES = 149504;
static_assert(pg8::RTAB_OFF + 8192 <= LDS_BYTES && MISC_OFF + 128 <= pg8::XOFF, "LDS map");

#define GAS __attribute__((address_space(1)))
#define LAS __attribute__((address_space(3)))
typedef unsigned v4u __attribute__((ext_vector_type(4)));
typedef float f32x4 __attribute__((ext_vector_type(4)));
typedef GAS unsigned gu32;
#define RLX_AGENT __ATOMIC_RELAXED, __HIP_MEMORY_SCOPE_AGENT
#define LDS_WAIT() asm volatile("s_waitcnt lgkmcnt(0)" ::: "memory")
#define VM_WAIT() asm volatile("s_waitcnt vmcnt(0)" ::: "memory")
__device__ __forceinline__ unsigned f2bfu(float f) { unsigned u = __builtin_bit_cast(unsigned, f); return (u + 0x7fffu + ((u >> 16) & 1u)) >> 16; }
__device__ __forceinline__ unsigned pk2(float lo, float hi) { return f2bfu(lo) | (f2bfu(hi) << 16); }

#define XB_TMO      128
#define XB_XCNT(j)  (256  + 64 * (j))
#define XB_XSUB(j)  (1280 + 64 * (j))
#define XB_XGEN(j)  (2304 + 64 * (j))
#define XB_TOP      3328
#define XB_TOPGEN   3392
#define XB_LSUB(j)  (3456 + 64 * (j))
#define XB_LGEN(j)  (4480 + 64 * (j))
#define XCD_BAR_WORDS 5504
#define XB_SPIN_CAP (1u << 18)

__device__ __forceinline__ unsigned xb_ld(unsigned* p)              { return __hip_atomic_load(p, __ATOMIC_RELAXED, __HIP_MEMORY_SCOPE_AGENT); }
__device__ __forceinline__ unsigned xb_add(unsigned* p, unsigned v) { return __hip_atomic_fetch_add(p, v, __ATOMIC_RELAXED, __HIP_MEMORY_SCOPE_AGENT); }
__device__ __forceinline__ unsigned xb_xcc_id() { return (unsigned)__builtin_amdgcn_s_getreg((3 << 11) | 20) & 0xFu; }
#define XB_SPIN(cond, bar) do { unsigned _sp = 0; while (cond) { __builtin_amdgcn_s_sleep(1); \
    if ((++_sp & 255u) == 0u) { if (xb_ld(&(bar)[XB_TMO])) break; if (_sp > XB_SPIN_CAP) { atomicAdd(&(bar)[XB_TMO], 1u); break; } } } } while (0)

struct XcdBarrier {
    unsigned* bar; unsigned x;
    volatile LAS unsigned* st;
};

__device__ __forceinline__ XcdBarrier xcd_barrier_post(unsigned* bar, volatile LAS unsigned* st) {
    XcdBarrier b; b.bar = bar; b.x = xb_xcc_id(); b.st = st;
    if (threadIdx.x == 0) { st[2] = b.x; st[3] = xb_add(&bar[XB_XCNT(b.x)], 1u); }
    return b;
}
__device__ __forceinline__ void xcd_barrier_complete(unsigned* bar, unsigned x, unsigned& nloc, unsigned& nx, unsigned& even) {
    const unsigned G = gridDim.x * gridDim.y * gridDim.z;
    unsigned sum, cnt, mine, odd, sp = 0u;
    for (;;) {
        sum = 0u; cnt = 0u; mine = 0u; odd = 0u;
#pragma unroll
        for (unsigned j = 0; j < 16; ++j) { const unsigned c = xb_ld(&bar[XB_XCNT(j)]); sum += c; cnt += (c > 0u) ? 1u : 0u; mine = (j == x) ? c : mine; odd += (c != 0u && c != 32u) ? 1u : 0u; }
        if (sum == G) break;
        __builtin_amdgcn_s_sleep(1);
        if ((++sp & 255u) == 0u) { if (xb_ld(&bar[XB_TMO])) break; if (sp > XB_SPIN_CAP) { atomicAdd(&bar[XB_TMO], 1u); break; } }
    }
    nloc = mine > 0u ? mine : 1u; nx = cnt > 0u ? cnt : 1u;
    even = (sum == G && G == 256u && cnt == 8u && odd == 0u) ? 1u : 0u;
}

__device__ __forceinline__ void xcd_barrier(const XcdBarrier& b) {
    asm volatile("s_waitcnt vmcnt(0)" ::: "memory");
    __syncthreads();
    if (threadIdx.x == 0) {
        unsigned* bar = b.bar;
        __builtin_amdgcn_s_waitcnt(0);
        unsigned nloc = b.st[0], nx = b.st[1];
        if (nloc == 0u) { unsigned even; xcd_barrier_complete(bar, b.x, nloc, nx, even); b.st[0] = nloc; b.st[1] = nx; b.st[4] = even; }
        const unsigned old = xb_add(&bar[XB_XSUB(b.x)], 1u);
        const unsigned gen = old / nloc;
        if (old + 1u == (gen + 1u) * nloc) {
            __builtin_amdgcn_fence(__ATOMIC_RELEASE, "agent");
            asm volatile("s_waitcnt vmcnt(0)" ::: "memory");
            const unsigned og = xb_add(&bar[XB_TOP], 1u);
            const unsigned tg = og / nx;
            if (og + 1u == (tg + 1u) * nx) xb_add(&bar[XB_TOPGEN], 1u);
            else XB_SPIN(xb_ld(&bar[XB_TOPGEN]) == tg, bar);
            __builtin_amdgcn_fence(__ATOMIC_ACQUIRE, "agent");
            xb_add(&bar[XB_XGEN(b.x)], 1u);
            asm volatile("s_waitcnt vmcnt(0)" ::: "memory");
        } else {
            XB_SPIN(xb_ld(&bar[XB_XGEN(b.x)]) == gen, bar);
            __builtin_amdgcn_fence(__ATOMIC_ACQUIRE, "agent");
            asm volatile("s_waitcnt vmcnt(0)" ::: "memory");
        }
    }
    __syncthreads();
}

__device__ __forceinline__ void xcd_local_barrier(const XcdBarrier& b) {
    asm volatile("s_waitcnt vmcnt(0)" ::: "memory");
    __syncthreads();
    if (threadIdx.x == 0) {
        unsigned* bar = b.bar;
        __builtin_amdgcn_s_waitcnt(0);
        const unsigned nloc = b.st[0];
        const unsigned old = xb_add(&bar[XB_LSUB(b.x)], 1u);
        const unsigned gen = old / nloc;
        if (old + 1u == (gen + 1u) * nloc) xb_add(&bar[XB_LGEN(b.x)], 1u);
        else XB_SPIN(xb_ld(&bar[XB_LGEN(b.x)]) == gen, bar);
        __builtin_amdgcn_fence(__ATOMIC_ACQUIRE, "agent");
        asm volatile("s_waitcnt vmcnt(0)" ::: "memory");
    }
    __syncthreads();
}

struct Args { const float* in[24]; float* out; unsigned char* ws; int ph_lo, ph_hi, li, pad; };

__device__ __forceinline__ void p0_transpose_item(const float* __restrict__ W, int ldw, int K, int k0, int n0, bf16* __restrict__ WT, int vrow0, const float* __restrict__ gain, LAS float* scr, int lane) {
    f32x4 v[8];
    const float* wp = W + (size_t)(k0 + (lane >> 3)) * ldw + n0 + 4 * (lane & 7);
#pragma unroll
    for (int i = 0; i < 8; ++i) v[i] = __builtin_nontemporal_load((const f32x4*)(wp + (size_t)(8 * i) * ldw));
    if (gain) {
#pragma unroll
        for (int i = 0; i < 8; ++i) v[i] *= gain[k0 + 8 * i + (lane >> 3)];
    }
#pragma unroll
    for (int i = 0; i < 8; ++i) { LAS float* d = scr + (8 * i + (lane >> 3)) * 33 + 4 * (lane & 7); d[0] = v[i].x; d[1] = v[i].y; d[2] = v[i].z; d[3] = v[i].w; }
    LDS_WAIT(); asm volatile("" ::: "memory");
    const int c = lane & 7;
#pragma unroll
    for (int j = 0; j < 4; ++j) { const int n = (lane >> 3) + 8 * j; const LAS float* s = scr + (8 * c) * 33 + n;
        v4u o; o.x = pk2(s[0 * 33], s[1 * 33]); o.y = pk2(s[2 * 33], s[3 * 33]); o.z = pk2(s[4 * 33], s[5 * 33]); o.w = pk2(s[6 * 33], s[7 * 33]);
        *(GAS v4u*)(WT + (size_t)(vrow0 + n) * K + k0 + 8 * c) = o; }
    LDS_WAIT(); asm volatile("" ::: "memory");
}
__device__ __forceinline__ int vrow_in(int c) { const int pn = c >> 8, cr = c & 255, wc = cr >> 6, bj = (cr >> 5) & 1; return pn * 256 + bj * 128 + wc * 32; }
__device__ __forceinline__ int vrow_up(int c) { const int gs = c >= FF ? 1 : 0, cc = c - gs * FF, pn = cc >> 7, wc = (cc >> 5) & 3; return pn * 256 + gs * 128 + wc * 32; }

__device__ __forceinline__ void fill_rtab(LAS unsigned char* lds, const float* __restrict__ ssx, int bxv) {
    int t = threadIdx.x; asm volatile("" : "+v"(t));
    LAS float* rt = (LAS float*)(lds + pg8::RTAB_OFF); const int row0 = 8 * (bxv & 7) * 256;
    float v[4];
#pragma unroll
    for (int k = 0; k < 4; ++k) v[k] = ss16(ssx, row0 + t + 512 * k);
#pragma unroll
    for (int k = 0; k < 4; ++k) rt[t + 512 * k] = rsqrtf(v[k] * (1.0f / D) + EPS);
    __syncthreads();
}
__device__ __forceinline__ int cur_bxv(volatile LAS unsigned* MISC, int pad = 0) { int b = blockIdx.x; const unsigned ev = MISC[12]; if (ev && !(pad & (1 << 27))) b = (int)(MISC[11] * 8u + MISC[10]); return __builtin_amdgcn_readfirstlane(b); }
__device__ __forceinline__ int cur_vcu(volatile LAS unsigned* MISC, int pad = 0) { const int b = cur_bxv(MISC, pad), G = gridDim.x; return (G % 8 == 0) ? (b % 8) * (G / 8) + b / 8 : b; }
__global__ void __launch_bounds__(NWAVES * 64, 2) skel_fwd(Args args) {
    extern __shared__ __attribute__((aligned(16))) unsigned char lds_raw[];
    LAS unsigned char* lds = (LAS unsigned char*)lds_raw;
    volatile LAS unsigned* MISC = (volatile LAS unsigned*)(lds + MISC_OFF);
    const int G = gridDim.x;
    unsigned char* ws = args.ws;
    gu32* ctl = (gu32*)(ws + WS_CTL);
    float* ss = (float*)(ws + WS_SS); bf16* xb = (bf16*)(ws + WS_XB); bf16* zg = (bf16*)(ws + WS_ZG); bf16* abuf = (bf16*)(ws + WS_A); float* yb = (float*)(ws + WS_YB);
    bf16* mix = (bf16*)(ws + WS_MIX); bf16* wbase = (bf16*)(ws + WS_W); float* xf = args.out;
    float* lutg = (float*)(ws + WS_LUT);
    for (int u = threadIdx.x; u < (LDS_BYTES - LDSCTL_OFF) / 4; u += NWAVES * 64) ((LAS unsigned*)(lds + LDSCTL_OFF))[u] = 0u;
    __syncthreads();
    XcdBarrier bar = xcd_barrier_post((unsigned*)(ctl + CW_BAR) + args.li * XCD_BAR_WORDS, MISC + 8);

#pragma unroll 1
    for (int ph = args.ph_lo; ph < args.ph_hi; ++ph) {
        const int l = ph > 0 ? (ph - 1) / 6 : 0, p = ph > 0 ? (ph - 1) % 6 + 1 : 0;
#define BXV() cur_bxv(MISC, args.pad)
#define VCU() cur_vcu(MISC, args.pad)
        bf16* wl = wbase + (size_t)l * WL_END;
        float* ss1 = ss + (size_t)((2 * l) & 3) * T * 16; float* ss2 = ss + (size_t)((2 * l + 1) & 3) * T * 16; float* ss3 = (l + 1 < L) ? ss + (size_t)((2 * l + 2) & 3) * T * 16 : nullptr;
#ifndef MK_ONLY
#define MK_ONLY 0x7f
#endif
        const int dupp = ((args.pad >> 8) & 0xff) - 1;
#pragma unroll 1
        for (int rep = (p == dupp) ? 0 : 1; rep < 2; ++rep) {
        if (p == 0 && (MK_ONLY & 1)) {
            int tid0 = threadIdx.x; asm volatile("" : "+v"(tid0));
            const int lane0 = tid0 & 63, wave = __builtin_amdgcn_readfirstlane(tid0 >> 6);
            LAS float* scr = (LAS float*)(lds + RING_OFF + wave * 16384);
            const int gw = VCU() * NWAVES + wave, NGW = G * NWAVES;
            constexpr int I_IN = (D / 64) * (INW / 32), I_G = (D / 64) * (GW / 32), I_A = (512 / 64) * (D / 32), I_O = (D / 64) * (D / 32), I_UP = (D / 64) * (FF2 / 32), I_DN = (FF / 64) * (D / 32);
            constexpr int I_LAYER = I_IN + I_G + 2 * I_A + I_O + I_UP + I_DN;
            for (int i = gw * 64 + lane0; i < 12 * att::LUT_STRIDE; i += NGW * 64) { const int hh = i / att::LUT_STRIDE, j = i - hh * att::LUT_STRIDE, rel = j - 256, ar = rel < 0 ? -rel : rel;
                float v = 0.f; if (j <= 512) v = (hh < 8 && ar > 128) ? att::NEG : args.in[13][t5_bucket(rel) * 12 + hh] * LOG2E;
                lutg[i] = v; }
            for (int m = gw; m < T; m += 2 * NGW) {
                const int m2 = m + NGW;
                const GAS f32x4* xr = (const GAS f32x4*)(args.in[0] + (size_t)m * D) + lane0; const GAS f32x4* xr2 = (const GAS f32x4*)(args.in[0] + (size_t)m2 * D) + lane0;
                GAS unsigned long long* o8 = (GAS unsigned long long*)(xb + (size_t)m * D) + lane0; GAS unsigned long long* o82 = (GAS unsigned long long*)(xb + (size_t)m2 * D) + lane0;
                f32x4 va[4], vb[4];
#pragma unroll
                for (int j = 0; j < 4; ++j) { va[j] = xr[64 * j]; vb[j] = xr2[64 * j]; }
                float s = 0.f, s2 = 0.f;
#pragma unroll
                for (int j = 0; j < 4; ++j) { const f32x4 v = va[j], w = vb[j]; s += (v.x * v.x + v.y * v.y) + (v.z * v.z + v.w * v.w); s2 += (w.x * w.x + w.y * w.y) + (w.z * w.z + w.w * w.w);
                    o8[64 * j] = (unsigned long long)pk2(v.x, v.y) | ((unsigned long long)pk2(v.z, v.w) << 32); o82[64 * j] = (unsigned long long)pk2(w.x, w.y) | ((unsigned long long)pk2(w.z, w.w) << 32); }
                s = wave_sum(s); s2 = wave_sum(s2);
                ss16_store(ss, m, s, lane0); ss16_store(ss, m2, s2, lane0);
            }
        } else if (p == 1 && (MK_ONLY & 2)) {
            pg8::SchedStd S; S.init(xb, D, wl + WL_IN, D, T, ZG - 256, G, BXV());
            S.fix = (rep == 0 && MK_VAR == 8) ? 1 : 0;
            fill_rtab(lds, ss1, BXV());
            pg8::EpiIn E{zg, ss1, args.in[3] + l * 64, args.in[4] + l * 64, args.in[6] + l * 64, args.in[7] + l * 64, args.in[15] + l * GW, (args.pad >> 25) & 1};
            pg8::gemm_phase<pg8::EpiIn, pg8::SchedStd, true, true>(lds + RING_OFF, D, D, S, E);
        } else if (p == 2 && (MK_ONLY & 4)) {
            int lop = l; asm volatile("" : "+s"(lop));
            const float lam_init = 0.8f - 0.6f * __expf(-0.3f * (float)lop);
            int ln = threadIdx.x; asm volatile("" : "+v"(ln)); ln &= 63;
            const float d1 = wave_sum(args.in[8][l * 64 + ln] * args.in[9][l * 64 + ln]), d2 = wave_sum(args.in[10][l * 64 + ln] * args.in[11][l * 64 + ln]);
            const float lam = __expf(d1) - __expf(d2) + lam_init;
            if ((VCU() & 3) == 0 && rep == 1) {
                pg8::SchedStd S1; S1.init(xb, D, wl + WL_IN, D, T, ZG, G, BXV()); S1.one = 1; { const int vc = VCU(); S1.opm = 8 * (vc >> 5) + ((vc & 31) >> 2); } S1.opn = 16;
                fill_rtab(lds, ss1, BXV());
                pg8::EpiIn E1{zg, ss1, args.in[3] + l * 64, args.in[4] + l * 64, args.in[6] + l * 64, args.in[7] + l * 64, args.in[15] + l * GW, 0};
                pg8::gemm_phase<pg8::EpiIn, pg8::SchedStd, true, true>(lds + RING_OFF, D, D, S1, E1);
            }
            att::attn_tables(lds, lutg, args.in[12] + l * 128, 1.0f - lam_init);
            const int dsel = args.pad >> 16;
            if (rep == 1 || dsel != 2)
            for (int k_ = 0; k_ < 2; ++k_) { const int vcu = VCU(); const int ui = vcu + k_ * G; if (ui >= 512) break; const int bh = ui >> 4, qb = ui & 15; if (rep == 0 && MK_VAR == 7 && (vcu & 1)) {} else if (rep == 0) att::attn_unit<true, (MK_VAR == 7 ? 0 : MK_VAR)>(lds, zg, lutg, bh >> 2, bh & 3, qb * 128, nullptr, lam, 1.0f - lam_init, args.in[12] + l * 128, mix);
                else att::attn_unit<true, 0>(lds, zg, lutg, bh >> 2, bh & 3, qb * 128, nullptr, lam, 1.0f - lam_init, args.in[12] + l * 128, nullptr); }
            if (rep == 1 || dsel != 1) {
                for (;;) {
                    const int team = 0, per = 512;
                    unsigned* qctr = (unsigned*)(ctl + CW_Q + 64 * ((2 * l + rep) * 8 + team));
                    if (threadIdx.x == 0) MISC[4] = __hip_atomic_fetch_add(qctr, 1u, __ATOMIC_RELAXED, __HIP_MEMORY_SCOPE_AGENT);
                    __syncthreads();
                    const int uq = (int)MISC[4];
                    __syncthreads();
                    if (uq >= per) break;
                    const int ui = team * per + uq;
                    const int bk = ui >> 5, qb = ui & 31; att::attn_unit<false>(lds, zg, lutg, bk >> 1, bk & 1, qb * 64, args.in[5] + l * HA, 0.f, 0.f, nullptr, rep == 0 ? mix : nullptr);
                }
            }
        } else if (p == 3 && (MK_ONLY & 8)) {
            pg8::SchedMix S; S.b.init(zg + C_QA, ZG, wl + WL_A, 512, T, D, G, BXV()); S.A1 = (const char*)(zg + C_QB); S.Bt1 = (const char*)(wl + WL_B);
            pg8::EpiMix E{zg, mix};
            pg8::gemm_phase<pg8::EpiMix, pg8::SchedMix, true, true>(lds + RING_OFF, 512, ZG, S, E);
        } else if (p == 4 && (MK_ONLY & 16)) {
            pg8::SchedStd S; S.init(mix, D, wl + WL_O, D, T, D, G, BXV());
            pg8::EpiRes E{l == 0 ? args.in[0] : xf, xf, xb, ss2};
            pg8::gemm_phase<pg8::EpiRes, pg8::SchedStd, true, true>(lds + RING_OFF, D, D, S, E);
        } else if (p == 5 && (MK_ONLY & 32)) {
            pg8::SchedStd S; S.init(xb, D, wl + WL_UP, D, T, FF2, G, BXV());
            fill_rtab(lds, ss2, BXV());
            pg8::EpiUp E{abuf, ss2, args.in[21] + (size_t)l * 3 * FF2, args.in[22] + (size_t)l * FF2, yb, (args.pad >> 24) & 1};
            pg8::gemm_phase<pg8::EpiUp, pg8::SchedStd, true, true>(lds + RING_OFF, D, D, S, E);
        } else if (MK_ONLY & 64) {
            pg8::SchedDown S; S.b.init(abuf, FF, wl + WL_DN, FF, T, D, G, BXV()); S.yb = (args.pad & 1) ? nullptr : yb; S.cw = args.in[21] + (size_t)l * 3 * FF2; S.cb = args.in[22] + (size_t)l * FF2; S.a = abuf;
            pg8::EpiRes E{xf, xf, ss3 ? xb : nullptr, ss3};
            pg8::gemm_phase<pg8::EpiRes, pg8::SchedDown, true, true>(lds + RING_OFF, FF, FF, S, E);
        }
        {
            int ph2 = ph; asm volatile("" : "+s"(ph2));
            const int l2 = ph2 > 0 ? (ph2 - 1) / 6 : 0, p2 = ph2 > 0 ? (ph2 - 1) % 6 + 1 : 0;
            const int G2 = gridDim.x; int bx2 = blockIdx.x; { const unsigned ev2 = MISC[12]; if (ev2 && !(args.pad & (1 << 27))) bx2 = (int)(MISC[11] * 8u + MISC[10]); } bx2 = __builtin_amdgcn_readfirstlane(bx2);
            int cl = -1, cw0 = 0, cnw = 1;
            if (p2 == 0) { cl = 0; cw0 = ((G2 % 8 == 0) ? (bx2 % 8) * (G2 / 8) + bx2 / 8 : bx2) * NWAVES; cnw = G2 * NWAVES; }
            else if (p2 == 5 && l2 + 1 < L && G2 == 256 && bx2 >= 128) { cl = l2 + 1; cw0 = (bx2 - 128) * NWAVES; cnw = 128 * NWAVES; }
            if (cl >= 0) {
                bf16* wbase2 = (bf16*)(args.ws + WS_W);
                int tid0 = threadIdx.x; asm volatile("" : "+v"(tid0));
                const int lane0 = tid0 & 63, wave = __builtin_amdgcn_readfirstlane(tid0 >> 6);
                LAS float* scr = (LAS float*)(lds + RING_OFF + wave * 16384);
                constexpr int I_IN = (D / 64) * (INW / 32), I_G = (D / 64) * (GW / 32), I_A = (512 / 64) * (D / 32), I_O = (D / 64) * (D / 32), I_UP = (D / 64) * (FF2 / 32), I_DN = (FF / 64) * (D / 32);
                constexpr int I_LAYER = I_IN + I_G + 2 * I_A + I_O + I_UP + I_DN;
                const int ll = cl; bf16* w = wbase2 + (size_t)ll * WL_END;
#pragma unroll 1
                for (int it = cw0 + wave; it < I_LAYER; it += cnw) {
                    int r = it;
                    if (r < I_IN) { const int nb = r % (INW / 32), kb = r / (INW / 32); p0_transpose_item(args.in[2] + (size_t)ll * D * INW, INW, D, 64 * kb, 32 * nb, w + WL_IN, vrow_in(32 * nb), args.in[1] + ll * D, scr, lane0); continue; } r -= I_IN;
                    if (r < I_G) { const int nb = r % (GW / 32), kb = r / (GW / 32); p0_transpose_item(args.in[14] + (size_t)ll * D * GW, GW, D, 64 * kb, 32 * nb, w + WL_IN, vrow_in(INW + 32 * nb), args.in[1] + ll * D, scr, lane0); continue; } r -= I_G;
                    if (r < I_A) { const int nb = r % (D / 32), kb = r / (D / 32); p0_transpose_item(args.in[16] + (size_t)ll * 512 * D, D, 512, 64 * kb, 32 * nb, w + WL_A, 32 * nb, nullptr, scr, lane0); continue; } r -= I_A;
                    if (r < I_A) { const int nb = r % (D / 32), kb = r / (D / 32); p0_transpose_item(args.in[17] + (size_t)ll * 512 * D, D, 512, 64 * kb, 32 * nb, w + WL_B, 32 * nb, nullptr, scr, lane0); continue; } r -= I_A;
                    if (r < I_O) { const int nb = r % (D / 32), kb = r / (D / 32); p0_transpose_item(args.in[18] + (size_t)ll * D * D, D, D, 64 * kb, 32 * nb, w + WL_O, 32 * nb, nullptr, scr, lane0); continue; } r -= I_O;
                    if (r < I_UP) { const int nb = r % (FF2 / 32), kb = r / (FF2 / 32); p0_transpose_item(args.in[20] + (size_t)ll * D * FF2, FF2, D, 64 * kb, 32 * nb, w + WL_UP, vrow_up(32 * nb), args.in[19] + ll * D, scr, lane0); continue; } r -= I_UP;
                    { const int nb = r % (D / 32), kb = r / (D / 32); p0_transpose_item(args.in[23] + (size_t)ll * FF * D, D, FF, 64 * kb, 32 * nb, w + WL_DN, 32 * nb, nullptr, scr, lane0); }
                }
            }
        }
        }
        if (ph + 1 < args.ph_hi) { int pq = ph; asm volatile("" : "+s"(pq)); const unsigned ev3 = MISC[12]; const bool loc = ev3 != 0u && !(args.pad & (1 << 26)) && pq > 0 && (pq - 1) % 6 >= 2 && (pq - 1) % 6 != 5; if (__builtin_amdgcn_readfirstlane((int)loc)) xcd_local_barrier(bar); else xcd_barrier(bar); }
    }
}
}

extern "C" void kernel_launch(void* const* d_in, const int* in_sizes, int n_in, void* d_out, int out_size, void* d_ws, size_t ws_size, hipStream_t stream) {
    using namespace nv;
    static int grid = 0;
    if (grid == 0) {
        if (n_in != 24 || in_sizes[0] != T * D || out_size != T * D || ws_size < mk::WS_END) { fprintf(stderr, "kernel_launch: built for 24 inputs, x/out of %d floats, >= %zu bytes of workspace; got n_in %d, out %d, ws %zu; nothing launched\n", T * D, (size_t)mk::WS_END, n_in, out_size, ws_size); grid = -1; return; }
        int dev = 0, cus = 0, per_cu = 0;
        if (hipGetDevice(&dev) != hipSuccess || hipDeviceGetAttribute(&cus, hipDeviceAttributeMultiprocessorCount, dev) != hipSuccess) { fprintf(stderr, "kernel_launch: device query failed; nothing launched\n"); grid = -1; return; }
        if (hipFuncSetAttribute((const void*)mk::skel_fwd, hipFuncAttributeMaxDynamicSharedMemorySize, mk::LDS_BYTES) != hipSuccess) { fprintf(stderr, "kernel_launch: hipFuncSetAttribute failed (needs %d bytes of dynamic LDS)\n", mk::LDS_BYTES); grid = -1; return; }
        if (hipOccupancyMaxActiveBlocksPerMultiprocessor(&per_cu, (const void*)mk::skel_fwd, mk::NWAVES * 64, mk::LDS_BYTES) != hipSuccess || per_cu < 1) fprintf(stderr, "kernel_launch: note: occupancy query reports %d workgroups per CU\n", per_cu);
        (void)hipGetLastError();
        grid = cus;
        if (grid != 256) fprintf(stderr, "kernel_launch: the unit schedules are built for 256 CUs; this device reports %d\n", cus);
    }
    if (grid < 0) return;
    if (hipMemsetAsync((unsigned char*)d_ws + mk::WS_CTL, 0, mk::CTL_ZERO_BYTES, stream) != hipSuccess) { fprintf(stderr, "kernel_launch: memset of the control words failed; nothing launched\n"); return; }
    mk::Args a{};
    for (int i = 0; i < 24; ++i) a.in[i] = (const float*)d_in[i];
    a.out = (float*)d_out; a.ws = (unsigned char*)d_ws; a.ph_lo = 0; a.ph_hi = mk::N_PHASES; a.li = 0;
    a.pad = (MK_DUP << 8) | (MK_DSEL << 16) | (MK_XSW << 26);
    hipLaunchKernelGGL(mk::skel_fwd, dim3(grid), dim3(mk::NWAVES * 64), mk::LDS_BYTES, stream, a);
}
```

```cpp
#include <hip/hip_runtime.h>
#include <cstdio>
#include <cstdint>
#include <cmath>
#define MK_EDUP 0

namespace nv {
typedef unsigned short bf16;
constexpr int D = 1024, B = 8, S = 2048, T = B * S, L = 4;
constexpr int HA = 8, KVA = 2, HB = 4, HD = 64;
constexpr int INW = 2304, GW = 2048, ZG = INW + GW;
constexpr int FF = 2816, FF2 = 2 * FF;
constexpr int C_QA = 0, C_KA = 512, C_VA = 640, C_QB = 768, C_KB = 1280, C_VB = 1792, C_G = 2304;
constexpr float EPS = 1e-6f;
constexpr float LOG2E = 1.4426950408889634f;
constexpr float C2 = 0.125f * LOG2E;

__device__ __forceinline__ float bf2f(bf16 v) { return __uint_as_float(((unsigned)v) << 16); }
__device__ __forceinline__ bf16 f2bf(float f) { unsigned u = __float_as_uint(f); return (bf16)((u + 0x7fffu + ((u >> 16) & 1u)) >> 16); }
__device__ __forceinline__ float ldf(const float* p) { return *p; }
__device__ __forceinline__ float ldf(const bf16* p) { return bf2f(*p); }

__device__ __forceinline__ int t5_bucket(int rel) {
    const int n = rel < 0 ? -rel : rel; int v;
    if (n < 8) v = n; else if (n < 12) v = 8; else if (n < 16) v = 9; else if (n < 23) v = 10; else if (n < 32) v = 11;
    else if (n < 46) v = 12; else if (n < 64) v = 13; else if (n < 91) v = 14; else v = 15;
    return (rel > 0 ? 16 : 0) + v;
}
__device__ __forceinline__ float ss16(const float* ss, int t) { const float4* p = (const float4*)(ss + (size_t)t * 16); const float4 a = p[0], b = p[1], c = p[2], d = p[3];
    return ((a.x + a.y) + (a.z + a.w)) + ((b.x + b.y) + (b.z + b.w)) + ((c.x + c.y) + (c.z + c.w)) + ((d.x + d.y) + (d.z + d.w)); }
__device__ __forceinline__ float ss16_q(const float* ss, int t, int fq) { const float4 a = *(const float4*)(ss + (size_t)t * 16 + 4 * fq); float s = (a.x + a.y) + (a.z + a.w); s += __shfl_xor(s, 16); s += __shfl_xor(s, 32); return s; }
__device__ __forceinline__ void ss16_store(float* ss, int t, float s, int lane) { if (lane < 16) ss[(size_t)t * 16 + lane] = lane == 0 ? s : 0.f; }
__device__ __forceinline__ float wave_sum(float v) {
#pragma unroll
    for (int o = 1; o < 64; o <<= 1) v += __shfl_xor(v, o);
    return v;
}
__device__ __forceinline__ float wave_max(float v) {
#pragma unroll
    for (int o = 1; o < 64; o <<= 1) v = fmaxf(v, __shfl_xor(v, o));
    return v;
}

}


namespace pg8 {
using namespace nv;
#define PG8_LAS __attribute__((address_space(3)))
typedef unsigned short bf16_t;
typedef short bf16x8 __attribute__((ext_vector_type(8)));
typedef float f32x4 __attribute__((ext_vector_type(4)));
typedef unsigned u32x4 __attribute__((ext_vector_type(4)));
typedef unsigned u32x2 __attribute__((ext_vector_type(2)));
constexpr int BM = 256, BK = 64, HALF = 128, HTB = HALF * BK * 2  , STAGE_BYTES = 8 * HTB, NXCD = 8, WGM = 8;
constexpr int XOFF = 131072 + 1024;
constexpr int RTAB_OFF = XOFF + 8192;

__host__ __device__ __forceinline__ int lds_byte(int r, int c) { const int st = (r >> 4) * 2 + (c >> 5), rr = r & 15, cc = c & 31, ob = rr * 64 + cc * 2; return st * 1024 + (ob ^ (((ob >> 9) & 1) << 5)); }
__host__ __device__ __forceinline__ void stage_rc(int b, int& R, int& C) { const int st = b / 1024, sb = b % 1024, swz = sb ^ (((sb >> 9) & 1) << 5); R = (st >> 1) * 16 + swz / 64; C = (st & 1) * 32 + (swz % 64) / 2; }
__host__ __device__ __forceinline__ int perm32(int rho) { const int n = rho >> 4, i = rho & 15; return 8 * (i >> 2) + 4 * n + (i & 3); }

struct Unit { int pm, pn, z; };
typedef float f32x2 __attribute__((ext_vector_type(2))); typedef __bf16 bf16x2_t __attribute__((ext_vector_type(2)));
__device__ __forceinline__ unsigned cvt_pk_bf16(float lo, float hi) { f32x2 v = {lo, hi}; bf16x2_t b = __builtin_convertvector(v, bf16x2_t); return __builtin_bit_cast(unsigned, b); }
__device__ __forceinline__ float bflo(unsigned w) { return __uint_as_float(w << 16); }
__device__ __forceinline__ float bfhi(unsigned w) { return __uint_as_float(w & 0xffff0000u); }

struct SchedStd {
    int nM, nN, nwg, G, c, fix, one, opm, opn; const char* A; const char* Bt; size_t at, bt;
    __device__ void init(const void* A_, int lda, const void* Bt_, int K, int M, int N, int G_, int c_) { fix = 0; one = 0; opm = 0; opn = 0; nM = M / BM; nN = N / BM; nwg = nM * nN; G = G_; c = c_; A = (const char*)A_; Bt = (const char*)Bt_; at = (size_t)BM * lda * 2; bt = (size_t)BM * K * 2; }
    __device__ bool next(int i, Unit& u) const {
        if (one) { if (i > 0) return false; u.pm = opm; u.pn = opn; u.z = 0; return true; }
        const long L = (long)i * G + c; if (L >= nwg) return false;
        int wgid = (int)L; { const int q = nwg / NXCD, r = nwg % NXCD, xcd = wgid % NXCD, off = wgid / NXCD; wgid = (xcd < r ? xcd * (q + 1) : r * (q + 1) + (xcd - r) * q) + off; }
        const int nig = WGM * nN, gid = wgid / nig, fm = gid * WGM, gsz = (nM - fm) < WGM ? (nM - fm) : WGM;
        u.pm = fm + ((wgid % nig) % gsz); u.pn = (wgid % nig) / gsz; u.z = 0; if (fix) { u.pm = 0; u.pn = 0; } return true;
    }
    __device__ __forceinline__ const char* aptr(const Unit& u) const { return A + (size_t)u.pm * at; }
    __device__ __forceinline__ const char* bptr(const Unit& u) const { return Bt + (size_t)u.pn * bt; }
    __device__ __forceinline__ void a_ready(const Unit&) const {}
    __device__ __forceinline__ void done(const Unit&) const {}
};
struct SchedMix {
    SchedStd b; const char* A1; const char* Bt1;
    __device__ bool next(int i, Unit& u) const { if (!b.next(i >> 1, u)) return false; u.z = i & 1; return true; }
    __device__ __forceinline__ const char* aptr(const Unit& u) const { return (u.z ? A1 : b.A) + (size_t)u.pm * b.at; }
    __device__ __forceinline__ const char* bptr(const Unit& u) const { return (u.z ? Bt1 : b.Bt) + (size_t)u.pn * b.bt; }
    __device__ __forceinline__ void a_ready(const Unit&) const {}
    __device__ __forceinline__ void done(const Unit&) const {}
};
struct SchedDown {
    SchedStd b; const float* yb; const float* cw; const float* cb; bf16_t* a;
    __device__ bool next(int i, Unit& u) const { return b.next(i, u); }
    __device__ __forceinline__ const char* aptr(const Unit& u) const { return b.aptr(u); }
    __device__ __forceinline__ const char* bptr(const Unit& u) const { return b.bptr(u); }
    __device__ __forceinline__ void a_ready(const Unit& u) const {
        const int pm = u.pm;
        if (yb)
        for (int idx = threadIdx.x; idx < 2 * FF; idx += 512) {
            const int which = idx >= FF ? 1 : 0, j = idx - which * FF;
            float uv[2];
#pragma unroll
            for (int gs = 0; gs < 2; ++gs) {
                const int col = gs * FF + j; float y0, y1, y2;
                if (which == 0) { y0 = (pm & 7) ? yb[((size_t)(pm - 1) * 4 + 3) * FF2 + col] : 0.f; y1 = yb[((size_t)pm * 4 + 0) * FF2 + col]; y2 = yb[((size_t)pm * 4 + 1) * FF2 + col]; }
                else { y0 = yb[((size_t)pm * 4 + 2) * FF2 + col]; y1 = yb[((size_t)pm * 4 + 3) * FF2 + col]; y2 = ((pm & 7) != 7) ? yb[((size_t)(pm + 1) * 4 + 0) * FF2 + col] : 0.f; }
                uv[gs] = cb[col] + cw[col] * y0 + cw[FF2 + col] * y1 + cw[2 * FF2 + col] * y2;
            }
            const float sg = uv[1] * __builtin_amdgcn_rcpf(1.0f + __builtin_amdgcn_exp2f(-uv[1] * LOG2E));
            a[(size_t)(pm * BM + which * 255) * FF + j] = f2bf(sg * uv[0]);
        }
        asm volatile("s_waitcnt vmcnt(0)" ::: "memory");
        __builtin_amdgcn_s_barrier();
        asm volatile("" ::: "memory");
    }
    __device__ __forceinline__ void done(const Unit&) const {}
};

__device__ __forceinline__ void rtab_fill(PG8_LAS unsigned char* lds_, const float* __restrict__ ssx, int row0) {
    int t = threadIdx.x; asm volatile("" : "+v"(t));
    PG8_LAS float* rt = (PG8_LAS float*)(lds_ + RTAB_OFF);
    float v[4];
#pragma unroll
    for (int k = 0; k < 4; ++k) v[k] = ss16(ssx, row0 + t + 512 * k);
#pragma unroll
    for (int k = 0; k < 4; ++k) rt[t + 512 * k] = rsqrtf(v[k] * (1.0f / D) + EPS);
}
struct EpiIn {
    static constexpr bool PERM = true, AFTER_DRAIN = false;
    __device__ __forceinline__ void init(f32x4 (&acc)[2][2][4][2], const Unit&, int, int, int, int) const {
#pragma unroll
        for (int a = 0; a < 2; ++a)
#pragma unroll
            for (int b = 0; b < 2; ++b)
#pragma unroll
                for (int m = 0; m < 4; ++m)
#pragma unroll
                    for (int n = 0; n < 2; ++n) acc[a][b][m][n] = (f32x4){0.f, 0.f, 0.f, 0.f};
    }
    __device__ static constexpr bool zero_after(const Unit&) { return true; }
    bf16_t* zg; const float* ss; const float *qn_a, *kn_a, *qn_b, *kn_b, *bg; int dup, row0;
    __device__ __forceinline__ void prefill(PG8_LAS unsigned char* lds_) const { rtab_fill(lds_, ss, row0); }
    __device__ __forceinline__ void operator()(f32x4 (&acc)[2][2][4][2], const Unit& u, int wr, int wc, int fr, int fq, PG8_LAS unsigned char* lds_) const {
#pragma unroll
        for (int rep_ = 0; rep_ <= ((MK_EDUP & 2) ? 1 : 0); ++rep_) {
        if (rep_) {
#pragma unroll
            for (int ai = 0; ai < 2; ++ai)
#pragma unroll
                for (int bj = 0; bj < 2; ++bj)
#pragma unroll
                    for (int m = 0; m < 4; ++m)
#pragma unroll
                        for (int n = 0; n < 2; ++n) asm volatile("" : "+v"(acc[ai][bj][m][n]) :: "memory");
        }
        const int g = u.pn * 4 + wc, colb = u.pn * BM + wc * 64 + 8 * fq;
        const float* gain = nullptr; float sc = 1.f; int mode = 0;
        if (g < 8) { gain = qn_a; sc = C2; mode = 1; } else if (g < 10) { gain = kn_a; mode = 1; } else if (g < 12) { mode = 0; } else if (g < 20) { gain = qn_b; sc = C2; mode = 1; }
        else if (g < 28) { gain = kn_b; mode = 1; } else if (g < 36) { mode = 0; } else { mode = 2; }
        float rsv[2][4];
#pragma unroll
        for (int ai = 0; ai < 2; ++ai)
#pragma unroll
            for (int m = 0; m < 4; ++m) rsv[ai][m] = ((const PG8_LAS float*)(lds_ + RTAB_OFF))[(u.pm & 7) * BM + ai * HALF + wr * 64 + m * 16 + fr];
        f32x4 gv[2][2];
#pragma unroll
        for (int bj = 0; bj < 2; ++bj)
#pragma unroll
            for (int n = 0; n < 2; ++n) {
                if (mode == 1) gv[bj][n] = *(const f32x4*)(gain + 32 * bj + 8 * fq + 4 * n) * sc;
                else if (mode == 2) gv[bj][n] = *(const f32x4*)(bg + (colb - C_G) + 32 * bj + 4 * n);
                else gv[bj][n] = (f32x4){1.f, 1.f, 1.f, 1.f};
            }
#pragma unroll
        for (int ai = 0; ai < 2; ++ai)
#pragma unroll
            for (int m = 0; m < 4; ++m) {
                const int row = u.pm * BM + ai * HALF + wr * 64 + m * 16 + fr;
                const float rs = rsv[ai][m];
                f32x4 v[2][2];
#pragma unroll
                for (int bj = 0; bj < 2; ++bj)
#pragma unroll
                    for (int n = 0; n < 2; ++n) v[bj][n] = acc[ai][bj][m][n] * rs;
                if (mode == 1) {
                    float q = 0.f;
#pragma unroll
                    for (int bj = 0; bj < 2; ++bj)
#pragma unroll
                        for (int n = 0; n < 2; ++n) { const f32x4 x = v[bj][n]; q += (x[0] * x[0] + x[1] * x[1]) + (x[2] * x[2] + x[3] * x[3]); }
                    q += __shfl_xor(q, 16); q += __shfl_xor(q, 32);
                    const float r2 = rsqrtf(q * (1.0f / 64.0f) + EPS);
#pragma unroll
                    for (int bj = 0; bj < 2; ++bj)
#pragma unroll
                        for (int n = 0; n < 2; ++n) v[bj][n] = v[bj][n] * r2 * gv[bj][n];
                } else if (mode == 2) {
#pragma unroll
                    for (int bj = 0; bj < 2; ++bj)
#pragma unroll
                        for (int n = 0; n < 2; ++n) { f32x4 x = v[bj][n] + gv[bj][n];
#pragma unroll
                            for (int e = 0; e < 4; ++e) x[e] = __builtin_fmaxf(__builtin_amdgcn_rcpf(1.0f + __builtin_amdgcn_exp2f(-x[e] * LOG2E)), 9.5367431640625e-07f);
                            v[bj][n] = x; }
                }
                bf16_t* rowp = zg + (size_t)row * ZG + colb;
#pragma unroll
                for (int bj = 0; bj < 2; ++bj) { u32x4 w; w.x = cvt_pk_bf16(v[bj][0][0], v[bj][0][1]); w.y = cvt_pk_bf16(v[bj][0][2], v[bj][0][3]); w.z = cvt_pk_bf16(v[bj][1][0], v[bj][1][1]); w.w = cvt_pk_bf16(v[bj][1][2], v[bj][1][3]);
                    *(u32x4*)(rowp + 32 * bj) = w; }
            }
        }
    }
};
struct EpiMix {
    static constexpr bool PERM = true, AFTER_DRAIN = false;
    __device__ __forceinline__ void prefill(PG8_LAS unsigned char*) const {}
    __device__ __forceinline__ void init(f32x4 (&acc)[2][2][4][2], const Unit&, int, int, int, int) const {
#pragma unroll
        for (int a = 0; a < 2; ++a)
#pragma unroll
            for (int b = 0; b < 2; ++b)
#pragma unroll
                for (int m = 0; m < 4; ++m)
#pragma unroll
                    for (int n = 0; n < 2; ++n) acc[a][b][m][n] = (f32x4){0.f, 0.f, 0.f, 0.f};
    }
    __device__ static bool zero_after(const Unit& u) { return u.z != 0; }
    const bf16_t* zg; bf16_t* mix;
    __device__ __forceinline__ void operator()(f32x4 (&acc)[2][2][4][2], const Unit& u, int wr, int wc, int fr, int fq, PG8_LAS unsigned char*) const {
        const int col0 = u.pn * BM + wc * 32 + 8 * fq;
#pragma unroll
        for (int ai = 0; ai < 2; ++ai) {
            u32x4 gbv[4][2], gav[4][2];
#pragma unroll
            for (int m = 0; m < 4; ++m)
#pragma unroll
                for (int bj = 0; bj < 2; ++bj) { const size_t go = (size_t)(u.pm * BM + ai * HALF + wr * 64 + m * 16 + fr) * ZG + C_G + col0 + bj * HALF;
                    gbv[m][bj] = *(const u32x4*)(zg + go + D); if (u.z == 0) gav[m][bj] = *(const u32x4*)(zg + go); else gav[m][bj] = (u32x4){0u, 0u, 0u, 0u}; }
#pragma unroll
            for (int m = 0; m < 4; ++m) {
                const int row = u.pm * BM + ai * HALF + wr * 64 + m * 16 + fr;
#pragma unroll
                for (int bj = 0; bj < 2; ++bj) {
                    const int col = col0 + bj * HALF;
                    const u32x4 gb = gbv[m][bj];
                    if (u.z == 0) {
                        const u32x4 ga = gav[m][bj];
                        f32x4 r0, r1;
                        r0[0] = bflo(ga.x) * __builtin_amdgcn_rcpf(bflo(gb.x)); r0[1] = bfhi(ga.x) * __builtin_amdgcn_rcpf(bfhi(gb.x)); r0[2] = bflo(ga.y) * __builtin_amdgcn_rcpf(bflo(gb.y)); r0[3] = bfhi(ga.y) * __builtin_amdgcn_rcpf(bfhi(gb.y));
                        r1[0] = bflo(ga.z) * __builtin_amdgcn_rcpf(bflo(gb.z)); r1[1] = bfhi(ga.z) * __builtin_amdgcn_rcpf(bfhi(gb.z)); r1[2] = bflo(ga.w) * __builtin_amdgcn_rcpf(bflo(gb.w)); r1[3] = bfhi(ga.w) * __builtin_amdgcn_rcpf(bfhi(gb.w));
                        acc[ai][bj][m][0] *= r0; acc[ai][bj][m][1] *= r1;
                    } else {
                        const f32x4 v0 = acc[ai][bj][m][0] * (f32x4){bflo(gb.x), bfhi(gb.x), bflo(gb.y), bfhi(gb.y)}, v1 = acc[ai][bj][m][1] * (f32x4){bflo(gb.z), bfhi(gb.z), bflo(gb.w), bfhi(gb.w)};
                        u32x4 w; w.x = cvt_pk_bf16(v0[0], v0[1]); w.y = cvt_pk_bf16(v0[2], v0[3]); w.z = cvt_pk_bf16(v1[0], v1[1]); w.w = cvt_pk_bf16(v1[2], v1[3]);
                        *(u32x4*)(mix + (size_t)row * D + col) = w;
                    }
                }
            }
            asm volatile("" ::: "memory");
        }
    }
};
struct EpiRes {
    static constexpr bool PERM = false, AFTER_DRAIN = false;
    __device__ __forceinline__ void prefill(PG8_LAS unsigned char*) const {}
    __device__ static constexpr bool zero_after(const Unit&) { return true; }
    const float* base; float* xf; bf16_t* xb; float* ssn;
    __device__ __forceinline__ void init(f32x4 (&acc)[2][2][4][2], const Unit& u, int wr, int wc, int fr, int fq) const {
        const int col0 = u.pn * BM + wc * 32 + 4 * fq;
#pragma unroll
        for (int ai = 0; ai < 2; ++ai)
#pragma unroll
            for (int m = 0; m < 4; ++m) { const size_t off = (size_t)(u.pm * BM + ai * HALF + wr * 64 + m * 16 + fr) * D + col0;
#pragma unroll
                for (int bj = 0; bj < 2; ++bj)
#pragma unroll
                    for (int n = 0; n < 2; ++n) acc[ai][bj][m][n] = *(const f32x4*)(base + off + bj * HALF + n * 16); }
    }
    __device__ __forceinline__ void operator()(f32x4 (&acc)[2][2][4][2], const Unit& u, int wr, int wc, int fr, int fq, PG8_LAS unsigned char*) const {
        const int col0 = u.pn * BM + wc * 32 + 4 * fq;
#pragma unroll
        for (int ai = 0; ai < 2; ++ai)
#pragma unroll
            for (int m = 0; m < 4; ++m) {
                const int row = u.pm * BM + ai * HALF + wr * 64 + m * 16 + fr; const size_t off = (size_t)row * D + col0; float q = 0.f;
#pragma unroll
                for (int bj = 0; bj < 2; ++bj)
#pragma unroll
                    for (int n = 0; n < 2; ++n) { const f32x4 o = acc[ai][bj][m][n];
                        *(f32x4*)(xf + off + bj * HALF + n * 16) = o; q += (o[0] * o[0] + o[1] * o[1]) + (o[2] * o[2] + o[3] * o[3]);
                        if (xb) { u32x2 w; w.x = cvt_pk_bf16(o[0], o[1]); w.y = cvt_pk_bf16(o[2], o[3]); *(u32x2*)(xb + off + bj * HALF + n * 16) = w; } }
                if (ssn) { q += __shfl_xor(q, 16); q += __shfl_xor(q, 32); if (fq == 0) ssn[(size_t)row * 16 + u.pn * 4 + wc] = q; }
            }
    }
};
#define DPPF(oldv, src, ctrl, bc) __int_as_float(__builtin_amdgcn_update_dpp(__float_as_int(oldv), __float_as_int(src), (ctrl), 0xF, 0xF, (bc)))
struct EpiUp {
    static constexpr bool PERM = true, AFTER_DRAIN = false;
    __device__ __forceinline__ void init(f32x4 (&acc)[2][2][4][2], const Unit&, int, int, int, int) const {
#pragma unroll
        for (int a = 0; a < 2; ++a)
#pragma unroll
            for (int b = 0; b < 2; ++b)
#pragma unroll
                for (int m = 0; m < 4; ++m)
#pragma unroll
                    for (int n = 0; n < 2; ++n) acc[a][b][m][n] = (f32x4){0.f, 0.f, 0.f, 0.f};
    }
    __device__ static constexpr bool zero_after(const Unit&) { return true; }
    bf16_t* a; const float* ss; const float* cw; const float* cb; float* yb; int dup, row0;
    __device__ __forceinline__ void prefill(PG8_LAS unsigned char* lds_) const { rtab_fill(lds_, ss, row0); }
    __device__ __forceinline__ void operator()(f32x4 (&acc)[2][2][4][2], const Unit& u, int wr, int wc, int fr, int fq, PG8_LAS unsigned char* lds) const {
        PG8_LAS unsigned char* lds_ = lds; const int wid = wr * 4 + wc;
        PG8_LAS float* X = (PG8_LAS float*)(lds + XOFF);
        float rsv[2][4];
#pragma unroll
        for (int ai = 0; ai < 2; ++ai)
#pragma unroll
            for (int m = 0; m < 4; ++m) rsv[ai][m] = ((const PG8_LAS float*)(lds_ + RTAB_OFF))[(u.pm & 7) * BM + ai * HALF + wr * 64 + m * 16 + fr];
#pragma unroll
        for (int ai = 0; ai < 2; ++ai)
#pragma unroll
            for (int m = 0; m < 4; ++m) {
#pragma unroll
                for (int bj = 0; bj < 2; ++bj)
#pragma unroll
                    for (int n = 0; n < 2; ++n) acc[ai][bj][m][n] *= rsv[ai][m];
            }
#pragma unroll
        for (int ai = 0; ai < 2; ++ai) {
            if (fr == 0) {
#pragma unroll
                for (int bj = 0; bj < 2; ++bj)
#pragma unroll
                    for (int n = 0; n < 2; ++n) *(PG8_LAS f32x4*)(X + ((wid * 2 + ai) * 2 + 0) * 64 + 32 * bj + 8 * fq + 4 * n) = acc[ai][bj][0][n];
            }
            if (fr == 15) {
#pragma unroll
                for (int bj = 0; bj < 2; ++bj)
#pragma unroll
                    for (int n = 0; n < 2; ++n) *(PG8_LAS f32x4*)(X + ((wid * 2 + ai) * 2 + 1) * 64 + 32 * bj + 8 * fq + 4 * n) = acc[ai][bj][3][n];
            }
        }
        {
            const int ccol = u.pn * 128 + wc * 32 + 8 * fq;
            if (wr == 0 && fr < 2) {
#pragma unroll
                for (int bj = 0; bj < 2; ++bj)
#pragma unroll
                    for (int n = 0; n < 2; ++n) *(f32x4*)(yb + ((size_t)u.pm * 4 + fr) * FF2 + bj * FF + ccol + 4 * n) = acc[0][bj][0][n];
            }
            if (wr == 1 && fr >= 14) {
#pragma unroll
                for (int bj = 0; bj < 2; ++bj)
#pragma unroll
                    for (int n = 0; n < 2; ++n) *(f32x4*)(yb + ((size_t)u.pm * 4 + 2 + (fr - 14)) * FF2 + bj * FF + ccol + 4 * n) = acc[1][bj][3][n];
            }
        }
        asm volatile("s_waitcnt lgkmcnt(0)" ::: "memory"); __builtin_amdgcn_s_barrier(); asm volatile("" ::: "memory");
#pragma unroll
        for (int rep_ = 0; rep_ <= ((MK_EDUP & 1) ? 1 : 0); ++rep_) {
        if (rep_) {
#pragma unroll
            for (int ai = 0; ai < 2; ++ai)
#pragma unroll
                for (int bj = 0; bj < 2; ++bj)
#pragma unroll
                    for (int m = 0; m < 4; ++m)
#pragma unroll
                        for (int n = 0; n < 2; ++n) asm volatile("" : "+v"(acc[ai][bj][m][n]) :: "memory");
        }
#pragma unroll
        for (int n = 0; n < 2; ++n) {
            const int ccol = u.pn * 128 + wc * 32 + 8 * fq + 4 * n;
            f32x4 w0[2], w1[2], w2[2], bb[2];
#pragma unroll
            for (int bj = 0; bj < 2; ++bj) { w0[bj] = *(const f32x4*)(cw + bj * FF + ccol); w1[bj] = *(const f32x4*)(cw + FF2 + bj * FF + ccol); w2[bj] = *(const f32x4*)(cw + 2 * FF2 + bj * FF + ccol); bb[bj] = *(const f32x4*)(cb + bj * FF + ccol); }
#pragma unroll
            for (int ai = 0; ai < 2; ++ai) {
                const int pw = wr ? wid - 4 : wid + 4, pai = wr ? ai : 0;
                const int nw = wr ? wid - 4 : wid + 4, nai = wr ? 1 : ai;
                f32x4 xp[2], xn[2];
#pragma unroll
                for (int bj = 0; bj < 2; ++bj) { xp[bj] = *(PG8_LAS f32x4*)(X + ((pw * 2 + pai) * 2 + 1) * 64 + 32 * bj + 8 * fq + 4 * n); xn[bj] = *(PG8_LAS f32x4*)(X + ((nw * 2 + nai) * 2 + 0) * 64 + 32 * bj + 8 * fq + 4 * n); }
#pragma unroll
                for (int m = 0; m < 4; ++m) {
                    const int trow = ai * HALF + wr * 64 + m * 16 + fr;
                    float uv[2][4];
#pragma unroll
                    for (int bj = 0; bj < 2; ++bj)
#pragma unroll
                        for (int e = 0; e < 4; ++e) {
                            const float cur = acc[ai][bj][m][n][e];
                            float rp, rn;
                            if (m > 0) rp = DPPF(0.f, acc[ai][bj][m > 0 ? m - 1 : 0][n][e], 0x121, true); else rp = xp[bj][e];
                            if (m < 3) rn = DPPF(0.f, acc[ai][bj][m < 3 ? m + 1 : 3][n][e], 0x12F, true); else rn = xn[bj][e];
                            const float prev = DPPF(rp, cur, 0x111, false), next = DPPF(rn, cur, 0x101, false);
                            uv[bj][e] = bb[bj][e] + w0[bj][e] * prev + w1[bj][e] * cur + w2[bj][e] * next;
                        }
                    f32x4 o;
#pragma unroll
                    for (int e = 0; e < 4; ++e) o[e] = uv[0][e] * uv[1][e] * __builtin_amdgcn_rcpf(1.0f + __builtin_amdgcn_exp2f(-uv[1][e] * LOG2E));
                    u32x2 w; w.x = cvt_pk_bf16(o[0], o[1]); w.y = cvt_pk_bf16(o[2], o[3]);
                    if (trow != 0 && trow != 255) *(u32x2*)(a + (size_t)(u.pm * BM + trow) * FF + ccol) = w;
                    asm volatile("" ::: "memory");
                }
            }
        }
        }
    }
};

template <class Epi, class Sched, bool ALIGN_EPI = false, bool SP2 = false>
__device__ __forceinline__ void gemm_phase(PG8_LAS unsigned char* lds, const int K, const int lda, const Sched& S, const Epi& E) {
    int tid_ = threadIdx.x; asm volatile("" : "+v"(tid_));
    const int tid = tid_, wid = __builtin_amdgcn_readfirstlane(tid >> 6), lane = tid & 63, wr = wid >> 2, wc = wid & 3, fr = lane & 15, fq = lane >> 4;
    const int nt = K / BK;
    unsigned voffA[2], voffB[2];
#pragma unroll
    for (int i = 0; i < 2; ++i) { int R, C; stage_rc(tid * 16 + i * 8192, R, C); const int Rb = Epi::PERM ? ((R & ~31) + perm32(R & 31)) : R;
        voffA[i] = (unsigned)(R * lda + C) * 2u; voffB[i] = (unsigned)(Rb * K + C) * 2u; }
    const size_t kstep = (size_t)(BK * 2);
    const size_t hstepB = (size_t)HALF * K * 2;
    const size_t hstepA = (size_t)HALF * lda * 2;
    const unsigned ldsw = (unsigned)wid * 1024u;
    const int aoff = lds_byte(wr * 64 + fr, fq * 8), boff = lds_byte(wc * 32 + fr, fq * 8);
#define PG8_SA(b, h) (((b) * 2 + (h)) * HTB)
#define PG8_SB(b, h) ((4 + (b) * 2 + (h)) * HTB)
#define PG8_STAGE(bufoff, gbase, voff) do { _Pragma("unroll") for (int _i = 0; _i < 2; ++_i) \
        __builtin_amdgcn_global_load_lds((const unsigned*)((const char*)(gbase) + (voff)[_i]), (PG8_LAS unsigned*)(lds + (bufoff) + ldsw + _i * 8192), 16, 0, 0); } while (0)
#define PG8_LDA(dst, b, h) do { _Pragma("unroll") for (int m = 0; m < 4; ++m) _Pragma("unroll") for (int k = 0; k < 2; ++k) dst[m][k] = *(const PG8_LAS bf16x8*)(lds + PG8_SA(b, h) + aoff + m * 2048 + k * 1024); } while (0)
#define PG8_LDB(dst, b, h) do { _Pragma("unroll") for (int n = 0; n < 2; ++n) _Pragma("unroll") for (int k = 0; k < 2; ++k) dst[n][k] = *(const PG8_LAS bf16x8*)(lds + PG8_SB(b, h) + boff + n * 2048 + k * 1024); } while (0)
#define PG8_MMA(ai, bj, At, Bt) do { __builtin_amdgcn_s_setprio(1); _Pragma("unroll") for (int m = 0; m < 4; ++m) _Pragma("unroll") for (int n = 0; n < 2; ++n) _Pragma("unroll") for (int k = 0; k < 2; ++k) \
        acc[ai][bj][m][n] = __builtin_amdgcn_mfma_f32_16x16x32_bf16(Bt[n][k], At[m][k], acc[ai][bj][m][n], 0, 0, 0); __builtin_amdgcn_s_setprio(0); } while (0)
#define PG8_WAIT_V(n) asm volatile("s_waitcnt vmcnt(" #n ")" ::: "memory")
#define PG8_WAIT_L(n) asm volatile("s_waitcnt lgkmcnt(" #n ")" ::: "memory")
#define PG8_BAR __builtin_amdgcn_s_barrier()
#define PG8_SCHED __builtin_amdgcn_sched_barrier(0)
    Unit cur, nxt; int ui = 0;
    if (!S.next(0, cur)) return;
    f32x4 acc[2][2][4][2];
    E.init(acc, cur, wr, wc, fr, fq);
    bf16x8 At[4][2], B0[2][2], B1[2][2];
    const char* cA = S.aptr(cur); const char* cB = S.bptr(cur);
    S.a_ready(cur);
    if constexpr (SP2) {
        PG8_STAGE(PG8_SB(0, 0), cB, voffB); PG8_STAGE(PG8_SB(0, 1), cB + hstepB, voffB); PG8_STAGE(PG8_SA(0, 0), cA, voffA); PG8_STAGE(PG8_SA(0, 1), cA + hstepA, voffA);
        E.prefill(lds);
        if (wr == 1) PG8_BAR;
        PG8_WAIT_V(2); PG8_BAR;
        PG8_STAGE(PG8_SB(1, 0), cB + kstep, voffB); PG8_STAGE(PG8_SA(1, 0), cA + kstep, voffA); PG8_STAGE(PG8_SB(1, 1), cB + hstepB + kstep, voffB);
        PG8_WAIT_V(6); PG8_BAR;
    } else {
        PG8_STAGE(PG8_SB(0, 0), cB, voffB); PG8_STAGE(PG8_SA(0, 0), cA, voffA); PG8_STAGE(PG8_SB(0, 1), cB + hstepB, voffB); PG8_STAGE(PG8_SA(0, 1), cA + hstepA, voffA);
        E.prefill(lds);
        if (wr == 1) PG8_BAR;
        PG8_WAIT_V(4); PG8_BAR;
        PG8_STAGE(PG8_SB(1, 0), cB + kstep, voffB); PG8_STAGE(PG8_SA(1, 0), cA + kstep, voffA); PG8_STAGE(PG8_SB(1, 1), cB + hstepB + kstep, voffB);
        PG8_WAIT_V(6); PG8_BAR;
    }
    for (;;) {
        const bool has_next = S.next(ui + 1, nxt);
        const char* nA = has_next ? S.aptr(nxt) : cA; const char* nB = has_next ? S.bptr(nxt) : cB;
        for (int t = 0; t < nt; t += 2) {
            const bool last = (t == nt - 2);
            const char* a1 = cA + (size_t)(t + 1) * kstep;
            const char* a2 = last ? nA : cA + (size_t)(t + 2) * kstep; const char* b2 = last ? nB : cB + (size_t)(t + 2) * kstep;
            const char* a3 = a2 + kstep; const char* b3 = b2 + kstep;
            if (last && has_next) S.a_ready(nxt);
            if constexpr (SP2) {
            PG8_LDB(B0, 0, 0); PG8_LDB(B1, 0, 1); PG8_SCHED; PG8_LDA(At, 0, 0); PG8_STAGE(PG8_SA(1, 1), a1 + hstepA, voffA);
            PG8_WAIT_V(8); PG8_WAIT_L(0); PG8_BAR; PG8_MMA(0, 0, At, B0); PG8_MMA(0, 1, At, B1); PG8_BAR; PG8_SCHED;
            PG8_LDA(At, 0, 1); PG8_STAGE(PG8_SB(0, 0), b2, voffB); PG8_STAGE(PG8_SB(0, 1), b2 + hstepB, voffB); PG8_STAGE(PG8_SA(0, 0), a2, voffA);
            PG8_WAIT_V(8); PG8_WAIT_L(0); PG8_BAR; PG8_MMA(1, 0, At, B0); PG8_MMA(1, 1, At, B1); PG8_BAR; PG8_SCHED;
            PG8_LDB(B0, 1, 0); PG8_LDB(B1, 1, 1); PG8_SCHED; PG8_LDA(At, 1, 0); PG8_STAGE(PG8_SA(0, 1), a2 + hstepA, voffA);
            PG8_WAIT_V(8); PG8_WAIT_L(0); PG8_BAR; PG8_MMA(0, 0, At, B0); PG8_MMA(0, 1, At, B1); PG8_BAR; PG8_SCHED;
            PG8_LDA(At, 1, 1); PG8_STAGE(PG8_SB(1, 0), b3, voffB); PG8_STAGE(PG8_SB(1, 1), b3 + hstepB, voffB); PG8_STAGE(PG8_SA(1, 0), a3, voffA);
            PG8_WAIT_V(8); PG8_WAIT_L(0); PG8_BAR; PG8_MMA(1, 0, At, B0); PG8_MMA(1, 1, At, B1); PG8_BAR; PG8_SCHED;
            } else {
            PG8_LDB(B0, 0, 0); PG8_SCHED; PG8_LDA(At, 0, 0); PG8_STAGE(PG8_SA(1, 1), a1 + hstepA, voffA);
            PG8_WAIT_L(8); PG8_BAR; PG8_WAIT_L(0); PG8_MMA(0, 0, At, B0); PG8_BAR; PG8_SCHED;
            PG8_LDB(B1, 0, 1); PG8_STAGE(PG8_SB(0, 0), b2, voffB);
            PG8_BAR; PG8_WAIT_L(0); PG8_MMA(0, 1, At, B1); PG8_BAR;
            PG8_LDA(At, 0, 1); PG8_STAGE(PG8_SA(0, 0), a2, voffA);
            PG8_BAR; PG8_WAIT_L(0); PG8_MMA(1, 0, At, B0); PG8_BAR; PG8_SCHED;
            PG8_STAGE(PG8_SB(0, 1), b2 + hstepB, voffB);
            PG8_WAIT_V(6); PG8_BAR; PG8_MMA(1, 1, At, B1); PG8_BAR;
            PG8_LDB(B0, 1, 0); PG8_SCHED; PG8_LDA(At, 1, 0); PG8_STAGE(PG8_SA(0, 1), a2 + hstepA, voffA);
            PG8_WAIT_L(8); PG8_BAR; PG8_WAIT_L(0); PG8_MMA(0, 0, At, B0); PG8_BAR; PG8_SCHED;
            PG8_LDB(B1, 1, 1); PG8_STAGE(PG8_SB(1, 0), b3, voffB);
            PG8_BAR; PG8_WAIT_L(0); PG8_MMA(0, 1, At, B1); PG8_BAR;
            PG8_LDA(At, 1, 1); PG8_STAGE(PG8_SA(1, 0), a3, voffA);
            PG8_BAR; PG8_WAIT_L(0); PG8_MMA(1, 0, At, B0); PG8_BAR; PG8_SCHED;
            PG8_STAGE(PG8_SB(1, 1), b3 + hstepB, voffB);
            PG8_WAIT_V(6); PG8_BAR; PG8_MMA(1, 1, At, B1); PG8_BAR;
            }
        }
        if constexpr (ALIGN_EPI) { if (wr == 0) PG8_BAR; }
        if constexpr (!Epi::AFTER_DRAIN) { E(acc, cur, wr, wc, fr, fq, lds); S.done(cur); }
        if (!has_next) break;
        if (Epi::zero_after(cur)) E.init(acc, nxt, wr, wc, fr, fq);
        cur = nxt; cA = nA; cB = nB; ++ui;
        if constexpr (ALIGN_EPI) { if (wr == 1) PG8_BAR; }
    }
    PG8_WAIT_V(0);
    if constexpr (!ALIGN_EPI) { if (wr == 0) PG8_BAR; }
    PG8_BAR;
    if constexpr (Epi::AFTER_DRAIN) { E.fused(acc, cur, wr, wc, fr, fq, lds, wid, lane); S.done(cur); }
#undef PG8_SA
#undef PG8_SB
#undef PG8_STAGE
#undef PG8_LDA
#undef PG8_LDB
#undef PG8_MMA
#undef PG8_WAIT_V
#undef PG8_WAIT_L
#undef PG8_BAR
#undef PG8_SCHED
}
}

namespace att {
using namespace nv;
#define ALAS __attribute__((address_space(3)))
typedef short bf16x8 __attribute__((ext_vector_type(8)));
typedef short s16x4 __attribute__((ext_vector_type(4)));
typedef float f32x16 __attribute__((ext_vector_type(16)));
typedef float f32x4 __attribute__((ext_vector_type(4)));
typedef unsigned u32x4 __attribute__((ext_vector_type(4)));
typedef unsigned u32x2 __attribute__((ext_vector_type(2)));
typedef short v4i16_t __attribute__((ext_vector_type(4)));
typedef float f32x2_t __attribute__((ext_vector_type(2))); typedef __bf16 bf16x2_t __attribute__((ext_vector_type(2)));
constexpr int LUT_OFF = 98304, LUT_STRIDE = 520, GT_OFF = LUT_OFF + 12 * LUT_STRIDE * 4;
static_assert(GT_OFF + 512 <= 131072, "attention tables inside the ring region");
constexpr float NEG = -30000.f, THR = 6.f;
__device__ __forceinline__ unsigned cvtpk(float lo, float hi) { f32x2_t v = {lo, hi}; bf16x2_t b = __builtin_convertvector(v, bf16x2_t); return __builtin_bit_cast(unsigned, b); }
__device__ __forceinline__ s16x4 vtr(ALAS const unsigned char* p) { return __builtin_bit_cast(s16x4, __builtin_amdgcn_ds_read_tr16_b64_v4i16((ALAS v4i16_t*)p)); }
__device__ __forceinline__ void glds16(const void* gsrc, unsigned lds_dst) { unsigned keep;
    asm volatile("s_mov_b32 %0, m0\n\ts_mov_b32 m0, %2\n\ts_nop 0\n\tglobal_load_lds_dwordx4 %1, off\n\ts_mov_b32 m0, %0" : "=&s"(keep) : "v"(gsrc), "s"(lds_dst) : "memory"); }
__device__ __forceinline__ float swap_add(float v) { auto rr = __builtin_amdgcn_permlane32_swap(__float_as_uint(v), __float_as_uint(v), false, false); return __uint_as_float(rr[0]) + __uint_as_float(rr[1]); }
__device__ __forceinline__ float swap_max(float v) { auto rr = __builtin_amdgcn_permlane32_swap(__float_as_uint(v), __float_as_uint(v), false, false); return fmaxf(__uint_as_float(rr[0]), __uint_as_float(rr[1])); }
#define MX3(a, b, c) __builtin_fmaxf(__builtin_fmaxf((a), (b)), (c))

__device__ __forceinline__ void attn_tables(ALAS unsigned char* lds, const float* __restrict__ lutg, const float* __restrict__ subg, float osc) {
    int tid = threadIdx.x; asm volatile("" : "+v"(tid));
    ALAS float* lut = (ALAS float*)(lds + LUT_OFF); ALAS float* gt = (ALAS float*)(lds + GT_OFF);
    for (int i = tid; i < 12 * LUT_STRIDE; i += 512) lut[i] = lutg[i];
    if (tid < 128) gt[tid] = subg[tid] * osc;
    __syncthreads();
}
__device__ __forceinline__ float g4_max(float v) { v = fmaxf(v, __shfl_xor(v, 16)); return fmaxf(v, __shfl_xor(v, 32)); }
__device__ __forceinline__ float g4_sum(float v) { v += __shfl_xor(v, 16); return v + __shfl_xor(v, 32); }

template <bool ISB, int VAR = 0>
__device__ __forceinline__ void attn_unit(ALAS unsigned char* lds, bf16* zg, const float* __restrict__ lutg, int b, int hsel, int q0, const float* __restrict__ sinkp, float lam, float osc, const float* __restrict__ subg, bf16* odry) {
    int tid_ = threadIdx.x; asm volatile("" : "+v"(tid_));
    const int tid = tid_, lane = tid & 63, c16 = lane & 15, g = lane >> 4; const int wid = __builtin_amdgcn_readfirstlane(tid >> 6);
    constexpr int NDVB = ISB ? 8 : 4, BUF = ISB ? 32768 : 16384, VOFF = ISB ? 16384 : 8192, VROW = ISB ? 256 : 128;
    const int map = ISB ? (wid >> 2) : 0, qsub = ISB ? (wid & 3) : (wid & 1), gsel = ISB ? 0 : (wid >> 1);
    const int head = ISB ? hsel : hsel * 4 + gsel;
    const int qrow0 = q0 + 32 * qsub;
    const int qcol = ISB ? (C_QB + head * 128 + map * 64) : (C_QA + head * 64);
    const int kcol = ISB ? (C_KB + head * 128) : (C_KA + hsel * 64);
    const int vcol = ISB ? (C_VB + head * 128) : (C_VA + hsel * 64);
    const size_t rowbase = (size_t)b * S;
    int kt0 = 0, kt1 = S / 64;
    if (!ISB) { kt0 = q0 / 64 - 2; if (kt0 < 0) kt0 = 0; kt1 = q0 / 64 + 3; if (kt1 > S / 64) kt1 = S / 64; }
    const int nt = kt1 - kt0;
    ALAS float* lut = (ALAS float*)(lds + LUT_OFF) + (ISB ? 8 + head : hsel * 4 + gsel) * LUT_STRIDE;
    ALAS float* gt = (ALAS float*)(lds + GT_OFF);
    const float sink2 = ISB ? 0.f : sinkp[head] * LOG2E;
    bf16x8 qr[2][2];
#pragma unroll
    for (int qb = 0; qb < 2; ++qb) { const bf16* qp = zg + (rowbase + qrow0 + 16 * qb + c16) * ZG + qcol + 8 * g;
#pragma unroll
        for (int ks = 0; ks < 2; ++ks) qr[qb][ks] = *(const bf16x8*)(qp + 32 * ks); }
    const unsigned lds0 = (unsigned)(size_t)lds;
    const bf16* kp_[2]; const bf16* vp_[2];
#pragma unroll
    for (int i_ = 0; i_ < 2; ++i_) { const int p_ = ISB ? wid * 2 + i_ : wid;
        kp_[i_] = zg + (rowbase + (size_t)kt0 * 64 + (p_ & 7) * 8 + (lane >> 3)) * ZG + kcol + (ISB ? (p_ >> 3) * 64 : 0) + ((lane & 7) ^ (lane >> 3)) * 8;
        vp_[i_] = ISB ? zg + (rowbase + (size_t)kt0 * 64 + 4 * p_ + (lane >> 4)) * ZG + vcol + ((((lane & 15) >> 1) ^ (4 * (p_ & 1) + (lane >> 4))) * 16) + 8 * (lane & 1)
                      : zg + (rowbase + (size_t)kt0 * 64 + 8 * p_ + (lane >> 3)) * ZG + vcol + ((((lane & 7) >> 1) ^ ((lane >> 4) & 3)) * 16) + 8 * (lane & 1); }
#define ATT_ISSUE(bo) do { \
        _Pragma("unroll") for (int i_ = 0; i_ < (ISB ? 2 : 1); ++i_) { const int p_ = ISB ? wid * 2 + i_ : wid; \
            glds16(kp_[i_], (unsigned)__builtin_amdgcn_readfirstlane((int)(lds0 + (bo) + p_ * 1024))); \
            glds16(vp_[i_], (unsigned)__builtin_amdgcn_readfirstlane((int)(lds0 + (bo) + VOFF + p_ * 1024))); \
            kp_[i_] += 64 * ZG; vp_[i_] += 64 * ZG; } } while (0)
#define ATT_SB() __builtin_amdgcn_sched_barrier(0)
    float mhat[2] = {0.f, 0.f}, lsum[2] = {0.f, 0.f};
    f32x4 o[2][NDVB];
#pragma unroll
    for (int qb = 0; qb < 2; ++qb)
#pragma unroll
        for (int d = 0; d < NDVB; ++d) o[qb][d] = (f32x4){0.f, 0.f, 0.f, 0.f};
    const int kfo = (ISB ? map * 8192 : 0) + c16 * 128 + ((g ^ (c16 & 7)) * 16);
    const int vq = (lane & 15) >> 2, vsw = ISB ? (4 * (g & 1) + vq) : (2 * (g & 1) + (vq >> 1));
    const int vfo = VOFF + (4 * g + vq) * VROW + (lane & 3) * 8;
    u32x4 pw[2][2];
    const float cfar_r = ISB ? lut[256 + 128] : 0.f, cfar_l = ISB ? lut[256 - 128] : 0.f;
#define ATT_QK(P, t, so) do { const int kb_ = (t) * 64; float cf_ = 0.f; \
        if (ISB) { if (kb_ - qrow0 - 31 >= 91) cf_ = cfar_r; else if (kb_ + 63 - qrow0 <= -91) cf_ = cfar_l; } \
        const float c0_ = cf_ - mhat[0], c1_ = cf_ - mhat[1]; const f32x4 ci0_ = (f32x4){c0_, c0_, c0_, c0_}, ci1_ = (f32x4){c1_, c1_, c1_, c1_}; \
        ALAS const unsigned char* kp = lds + (so) + kfo; \
        _Pragma("unroll") for (int kb = 0; kb < 4; ++kb) { \
            const bf16x8 k0_ = *(ALAS const bf16x8*)(kp + kb * 2048), k1_ = *(ALAS const bf16x8*)((ALAS const unsigned char*)((unsigned)(size_t)kp ^ 64u) + kb * 2048); \
            P[0][kb] = __builtin_amdgcn_mfma_f32_16x16x32_bf16(k0_, qr[0][0], ci0_, 0, 0, 0); P[1][kb] = __builtin_amdgcn_mfma_f32_16x16x32_bf16(k0_, qr[1][0], ci1_, 0, 0, 0); \
            P[0][kb] = __builtin_amdgcn_mfma_f32_16x16x32_bf16(k1_, qr[0][1], P[0][kb], 0, 0, 0); P[1][kb] = __builtin_amdgcn_mfma_f32_16x16x32_bf16(k1_, qr[1][1], P[1][kb], 0, 0, 0); } } while (0)
#define ATT_DECIDE(P, t, first) do { const int kb_ = (t) * 64; \
        if (!ISB || !((kb_ - qrow0 - 31 >= 91) || (kb_ + 63 - qrow0 <= -91))) { \
            ALAS const float* lp = lut + (kb_ - (qrow0 + c16) + 256 + 4 * g); \
            _Pragma("unroll") for (int qb = 0; qb < 2; ++qb) { float lv_[16]; \
                _Pragma("unroll") for (int kb = 0; kb < 4; ++kb) _Pragma("unroll") for (int r = 0; r < 4; ++r) lv_[4 * kb + r] = lp[16 * kb - 16 * qb + r]; \
                _Pragma("unroll") for (int kb = 0; kb < 4; ++kb) _Pragma("unroll") for (int r = 0; r < 4; ++r) P[qb][kb][r] += lv_[4 * kb + r]; } } \
        float rm0_ = MX3(MX3(P[0][0][0], P[0][0][1], P[0][0][2]), P[0][0][3], P[0][1][0]), rm1_ = MX3(MX3(P[1][0][0], P[1][0][1], P[1][0][2]), P[1][0][3], P[1][1][0]); \
        rm0_ = MX3(MX3(rm0_, P[0][1][1], P[0][1][2]), P[0][1][3], P[0][2][0]); rm1_ = MX3(MX3(rm1_, P[1][1][1], P[1][1][2]), P[1][1][3], P[1][2][0]); \
        rm0_ = MX3(MX3(rm0_, P[0][2][1], P[0][2][2]), P[0][2][3], P[0][3][0]); rm1_ = MX3(MX3(rm1_, P[1][2][1], P[1][2][2]), P[1][2][3], P[1][3][0]); \
        rm0_ = MX3(MX3(rm0_, P[0][3][1], P[0][3][2]), P[0][3][3], rm0_); rm1_ = MX3(MX3(rm1_, P[1][3][1], P[1][3][2]), P[1][3][3], rm1_); \
        if ((first) || __any(__builtin_fmaxf(rm0_, rm1_) > THR)) { \
            const float f0_ = g4_max(rm0_), f1_ = g4_max(rm1_); \
            const float dl0 = (first) ? f0_ : __builtin_fmaxf(f0_, 0.f), dl1 = (first) ? f1_ : __builtin_fmaxf(f1_, 0.f); \
            mhat[0] += dl0; mhat[1] += dl1; \
            _Pragma("unroll") for (int kb = 0; kb < 4; ++kb) { P[0][kb] -= dl0; P[1][kb] -= dl1; } \
            if (!(first)) { const float s0_ = __builtin_amdgcn_exp2f(-dl0), s1_ = __builtin_amdgcn_exp2f(-dl1); lsum[0] *= s0_; lsum[1] *= s1_; \
                _Pragma("unroll") for (int d = 0; d < NDVB; ++d) { o[0][d] *= s0_; o[1][d] *= s1_; } } } } while (0)
#define ATT_FINISH(P) do { \
        _Pragma("unroll") for (int qb = 0; qb < 2; ++qb) { float sa_ = 0.f; \
            _Pragma("unroll") for (int kb = 0; kb < 4; ++kb) _Pragma("unroll") for (int r = 0; r < 4; ++r) { P[qb][kb][r] = __builtin_amdgcn_exp2f(P[qb][kb][r]); sa_ += P[qb][kb][r]; } \
            lsum[qb] += sa_; \
            _Pragma("unroll") for (int s_ = 0; s_ < 2; ++s_) pw[qb][s_] = (u32x4){cvtpk(P[qb][2 * s_][0], P[qb][2 * s_][1]), cvtpk(P[qb][2 * s_][2], P[qb][2 * s_][3]), cvtpk(P[qb][2 * s_ + 1][0], P[qb][2 * s_ + 1][1]), cvtpk(P[qb][2 * s_ + 1][2], P[qb][2 * s_ + 1][3])}; } } while (0)
#define ATT_LDV2(dst, s_, d0_) do { _Pragma("unroll") for (int dd = 0; dd < 2; ++dd) { ALAS const unsigned char* a_ = vp + (s_) * 32 * VROW + ((((d0_) + dd) ^ vsw) * 32); dst[2 * dd] = vtr(a_); dst[2 * dd + 1] = vtr(a_ + 16 * VROW); } } while (0)
#define ATT_PV2(src, s_, d0_) do { __builtin_amdgcn_s_setprio(1); _Pragma("unroll") for (int dd = 0; dd < 2; ++dd) { \
            const bf16x8 vf_ = (bf16x8){src[2 * dd][0], src[2 * dd][1], src[2 * dd][2], src[2 * dd][3], src[2 * dd + 1][0], src[2 * dd + 1][1], src[2 * dd + 1][2], src[2 * dd + 1][3]}; \
            o[0][(d0_) + dd] = __builtin_amdgcn_mfma_f32_16x16x32_bf16(vf_, __builtin_bit_cast(bf16x8, pw[0][s_]), o[0][(d0_) + dd], 0, 0, 0); \
            o[1][(d0_) + dd] = __builtin_amdgcn_mfma_f32_16x16x32_bf16(vf_, __builtin_bit_cast(bf16x8, pw[1][s_]), o[1][(d0_) + dd], 0, 0, 0); } __builtin_amdgcn_s_setprio(0); } while (0)
#define ATT_PV(so) do { ALAS const unsigned char* vp = lds + (so) + vfo; s16x4 va[4], vb[4]; constexpr int NG_ = NDVB / 2; \
        ATT_LDV2(va, 0, 0); ATT_SB(); \
        _Pragma("unroll") for (int k_ = 0; k_ < 2 * NG_; k_ += 2) { \
            ATT_LDV2(vb, (k_ + 1) / NG_, 2 * ((k_ + 1) % NG_)); ATT_SB(); \
            ATT_PV2(va, k_ / NG_, 2 * (k_ % NG_)); ATT_SB(); \
            if (k_ + 2 < 2 * NG_) { ATT_LDV2(va, (k_ + 2) / NG_, 2 * ((k_ + 2) % NG_)); ATT_SB(); } \
            ATT_PV2(vb, (k_ + 1) / NG_, 2 * ((k_ + 1) % NG_)); ATT_SB(); } } while (0)
#define ATT_SLOT(i) (ISB ? (((i) % 3) * BUF) : ((i) * BUF))
#define ATT_STEP(i, PC, PP) do { \
        if (ISB) { asm volatile("s_waitcnt vmcnt(0)" ::: "memory"); __syncthreads(); if ((i) + 1 < nt) ATT_ISSUE(ATT_SLOT((i) + 1)); } \
        ATT_QK(PC, kt0 + (i), ATT_SLOT(i)); ATT_SB(); \
        ATT_FINISH(PP); ATT_SB(); \
        ATT_PV(ATT_SLOT((i) - 1)); ATT_SB(); \
        ATT_DECIDE(PC, kt0 + (i), false); ATT_SB(); } while (0)
    f32x4 pA[2][4], pB[2][4];
    if (ISB) { ATT_ISSUE(0); asm volatile("s_waitcnt vmcnt(0)" ::: "memory"); __syncthreads(); if (nt > 1) ATT_ISSUE(BUF); }
    else {
#pragma unroll 1
        for (int i = 0; i < nt; ++i) ATT_ISSUE(i * BUF);
        asm volatile("s_waitcnt vmcnt(0)" ::: "memory"); __syncthreads();
    }
    ATT_QK(pA, kt0, 0); ATT_SB();
    ATT_DECIDE(pA, kt0, true); ATT_SB();
    int i = 1;
#pragma unroll 1
    for (; i + 1 < nt; i += 2) {
        ATT_STEP(i, pB, pA);
        ATT_STEP(i + 1, pA, pB);
    }
    if (i < nt) {
        ATT_STEP(i, pB, pA);
        ATT_FINISH(pB); ATT_SB(); ATT_PV(ATT_SLOT(nt - 1));
    } else {
        ATT_FINISH(pA); ATT_SB(); ATT_PV(ATT_SLOT(nt - 1));
    }
#undef ATT_ISSUE
#undef ATT_SB
#undef ATT_QK
#undef ATT_DECIDE
#undef ATT_FINISH
#undef ATT_LDV2
#undef ATT_PV2
#undef ATT_PV
#undef ATT_SLOT
#undef ATT_STEP
    float inv[2];
#pragma unroll
    for (int qb = 0; qb < 2; ++qb) { float l_ = g4_sum(lsum[qb]); if (!ISB) l_ += __builtin_amdgcn_exp2f(sink2 - mhat[qb]); inv[qb] = 1.0f / l_; }
    constexpr int DVE = ISB ? 128 : 64, SPITCH = DVE * 2 + 8;
    bf16* obase = odry ? odry + (rowbase + qrow0) * D + (ISB ? (512 + head * 128) : (head * 64)) : zg + (rowbase + qrow0) * ZG + (ISB ? (C_QB + head * 128) : (C_QA + head * 64));
    const size_t opitch = odry ? D : ZG;
    ALAS unsigned char* stg = lds + (ISB ? qsub * 16384 : wid * 4608);
#define ATT_OUT() do { asm volatile("s_waitcnt lgkmcnt(0)" ::: "memory"); \
        constexpr int LPR = DVE / 8, RPI = 64 / LPR; \
        _Pragma("unroll") for (int i_ = 0; i_ < 32 / RPI; ++i_) { const int row_ = i_ * RPI + lane / LPR, ch_ = lane % LPR; \
            const u32x2 a_ = *(ALAS const u32x2*)(stg + row_ * SPITCH + ch_ * 16), b_ = *(ALAS const u32x2*)(stg + row_ * SPITCH + ch_ * 16 + 8); \
            *(u32x4*)(obase + (size_t)row_ * opitch + ch_ * 8) = (u32x4){a_.x, a_.y, b_.x, b_.y}; } } while (0)
    if (ISB) {
        __syncthreads();
        ALAS float* cs = (ALAS float*)lds;
        if (map == 1) {
#pragma unroll
            for (int qb = 0; qb < 2; ++qb) { const float sc = -lam * inv[qb];
#pragma unroll
                for (int d = 0; d < NDVB; ++d)
#pragma unroll
                    for (int r = 0; r < 4; ++r) cs[(qsub * 64 + (qb * NDVB + d) * 4 + r) * 64 + lane] = o[qb][d][r] * sc; } }
        __syncthreads();
        if (map == 0) {
            float rstd[2];
#pragma unroll
            for (int qb = 0; qb < 2; ++qb) { float q = 0.f;
#pragma unroll
                for (int d = 0; d < NDVB; ++d)
#pragma unroll
                    for (int r = 0; r < 4; ++r) { const float v = o[qb][d][r] * inv[qb] + cs[(qsub * 64 + (qb * NDVB + d) * 4 + r) * 64 + lane]; o[qb][d][r] = v; q += v * v; }
                rstd[qb] = rsqrtf(g4_sum(q) * (1.0f / 128.0f) + EPS); }
            asm volatile("s_waitcnt lgkmcnt(0)" ::: "memory");
#pragma unroll
            for (int qb = 0; qb < 2; ++qb)
#pragma unroll
                for (int d = 0; d < NDVB; ++d) { const int dv0 = 16 * d + 4 * g; const f32x4 gv = *(ALAS const f32x4*)(gt + dv0);
                    u32x2 w; w.x = cvtpk(o[qb][d][0] * rstd[qb] * gv[0], o[qb][d][1] * rstd[qb] * gv[1]); w.y = cvtpk(o[qb][d][2] * rstd[qb] * gv[2], o[qb][d][3] * rstd[qb] * gv[3]);
                    *(ALAS u32x2*)(stg + (16 * qb + c16) * SPITCH + dv0 * 2) = w; }
            ATT_OUT();
        }
    } else {
        __syncthreads();
#pragma unroll
        for (int qb = 0; qb < 2; ++qb)
#pragma unroll
            for (int d = 0; d < NDVB; ++d) { const int dv0 = 16 * d + 4 * g;
                u32x2 w; w.x = cvtpk(o[qb][d][0] * inv[qb], o[qb][d][1] * inv[qb]); w.y = cvtpk(o[qb][d][2] * inv[qb], o[qb][d][3] * inv[qb]);
                *(ALAS u32x2*)(stg + (16 * qb + c16) * SPITCH + dv0 * 2) = w; }
        ATT_OUT();
    }
#undef ATT_OUT
    __syncthreads();
}
#undef MX3
}

#ifndef MK_VAR
#define MK_VAR 0
#endif
#define MK_DUP 0
#define MK_DSEL 0
namespace mk {
using namespace nv;
constexpr int NWAVES = 8;
constexpr size_t MiB = 1u << 20;
constexpr size_t WS_CTL = 0, CTL_ZERO_BYTES = 1 * MiB;
constexpr size_t WS_LUT = 512 * 1024;
constexpr size_t WS_SS = 1 * MiB;
constexpr size_t WS_XB = 6 * MiB;
constexpr size_t WS_ZG = 38 * MiB;
constexpr size_t WS_A = 38 * MiB;
constexpr size_t WS_YB = 126 * MiB;
constexpr size_t WS_MIX = 174 * MiB;
constexpr size_t WS_W = 206 * MiB;
constexpr size_t WL_IN = 0, WL_A = (size_t)ZG * D, WL_B = WL_A + (size_t)D * 512, WL_O = WL_B + (size_t)D * 512, WL_UP = WL_O + (size_t)D * D, WL_DN = WL_UP + (size_t)FF2 * D, WL_END = WL_DN + (size_t)D * FF;
constexpr size_t WS_END = 322 * MiB;
static_assert(WS_W + 4 * WL_END * 2 <= WS_END && WS_YB + (size_t)64 * 4 * FF2 * 4 <= WS_MIX && WS_A + (size_t)T * FF * 2 <= WS_YB, "d_ws map");
constexpr int CW_Q = 2048;
constexpr int CW_BAR = 4096;
constexpr int N_PHASES = 1 + 6 * L;
constexpr int RING_OFF = 0, RING_BYTES = 131072, LDSCTL_OFF = RING_BYTES, MISC_OFF = LDSCTL_OFF + 320;
constexpr int LDS_BYTES = 149504;
static_assert(pg8::RTAB_OFF + 8192 <= LDS_BYTES && MISC_OFF + 128 <= pg8::XOFF, "LDS map");

#define GAS __attribute__((address_space(1)))
#define LAS __attribute__((address_space(3)))
typedef unsigned v4u __attribute__((ext_vector_type(4)));
typedef float f32x4 __attribute__((ext_vector_type(4)));
typedef GAS unsigned gu32;
#define RLX_AGENT __ATOMIC_RELAXED, __HIP_MEMORY_SCOPE_AGENT
#define LDS_WAIT() asm volatile("s_waitcnt lgkmcnt(0)" ::: "memory")
#define VM_WAIT() asm volatile("s_waitcnt vmcnt(0)" ::: "memory")
__device__ __forceinline__ unsigned f2bfu(float f) { unsigned u = __builtin_bit_cast(unsigned, f); return (u + 0x7fffu + ((u >> 16) & 1u)) >> 16; }
__device__ __forceinline__ unsigned pk2(float lo, float hi) { return f2bfu(lo) | (f2bfu(hi) << 16); }

#define XB_TMO      128
#define XB_XCNT(j)  (256  + 64 * (j))
#define XB_XSUB(j)  (1280 + 64 * (j))
#define XB_XGEN(j)  (2304 + 64 * (j))
#define XB_TOP      3328
#define XB_TOPGEN   3392
#define XCD_BAR_WORDS 3456
#define XB_SPIN_CAP (1u << 18)

__device__ __forceinline__ unsigned xb_ld(unsigned* p)              { return __hip_atomic_load(p, __ATOMIC_RELAXED, __HIP_MEMORY_SCOPE_AGENT); }
__device__ __forceinline__ unsigned xb_add(unsigned* p, unsigned v) { return __hip_atomic_fetch_add(p, v, __ATOMIC_RELAXED, __HIP_MEMORY_SCOPE_AGENT); }
__device__ __forceinline__ unsigned xb_xcc_id() { return (unsigned)__builtin_amdgcn_s_getreg((3 << 11) | 20) & 0xFu; }
#define XB_SPIN(cond, bar) do { unsigned _sp = 0; while (cond) { __builtin_amdgcn_s_sleep(1); \
    if ((++_sp & 255u) == 0u) { if (xb_ld(&(bar)[XB_TMO])) break; if (_sp > XB_SPIN_CAP) { atomicAdd(&(bar)[XB_TMO], 1u); break; } } } } while (0)

struct XcdBarrier {
    unsigned* bar; unsigned x;
    volatile LAS unsigned* st;
};

__device__ __forceinline__ XcdBarrier xcd_barrier_post(unsigned* bar, volatile LAS unsigned* st) {
    XcdBarrier b; b.bar = bar; b.x = xb_xcc_id(); b.st = st;
    if (threadIdx.x == 0) (void)xb_add(&bar[XB_XCNT(b.x)], 1u);
    return b;
}
__device__ __forceinline__ void xcd_barrier_complete(unsigned* bar, unsigned x, unsigned& nloc, unsigned& nx) {
    const unsigned G = gridDim.x * gridDim.y * gridDim.z;
    unsigned sum, cnt, mine, sp = 0u;
    for (;;) {
        sum = 0u; cnt = 0u; mine = 0u;
#pragma unroll
        for (unsigned j = 0; j < 16; ++j) { const unsigned c = xb_ld(&bar[XB_XCNT(j)]); sum += c; cnt += (c > 0u) ? 1u : 0u; mine = (j == x) ? c : mine; }
        if (sum == G) break;
        __builtin_amdgcn_s_sleep(1);
        if ((++sp & 255u) == 0u) { if (xb_ld(&bar[XB_TMO])) break; if (sp > XB_SPIN_CAP) { atomicAdd(&bar[XB_TMO], 1u); break; } }
    }
    nloc = mine > 0u ? mine : 1u; nx = cnt > 0u ? cnt : 1u;
}

__device__ __forceinline__ void xcd_barrier(const XcdBarrier& b) {
    asm volatile("s_waitcnt vmcnt(0)" ::: "memory");
    __syncthreads();
    if (threadIdx.x == 0) {
        unsigned* bar = b.bar;
        __builtin_amdgcn_s_waitcnt(0);
        unsigned nloc = b.st[0], nx = b.st[1];
        if (nloc == 0u) { xcd_barrier_complete(bar, b.x, nloc, nx); b.st[0] = nloc; b.st[1] = nx; }
        const unsigned old = xb_add(&bar[XB_XSUB(b.x)], 1u);
        const unsigned gen = old / nloc;
        if (old + 1u == (gen + 1u) * nloc) {
            __builtin_amdgcn_fence(__ATOMIC_RELEASE, "agent");
            asm volatile("s_waitcnt vmcnt(0)" ::: "memory");
            const unsigned og = xb_add(&bar[XB_TOP], 1u);
            const unsigned tg = og / nx;
            if (og + 1u == (tg + 1u) * nx) xb_add(&bar[XB_TOPGEN], 1u);
            else XB_SPIN(xb_ld(&bar[XB_TOPGEN]) == tg, bar);
            __builtin_amdgcn_fence(__ATOMIC_ACQUIRE, "agent");
            xb_add(&bar[XB_XGEN(b.x)], 1u);
            asm volatile("s_waitcnt vmcnt(0)" ::: "memory");
        } else {
            XB_SPIN(xb_ld(&bar[XB_XGEN(b.x)]) == gen, bar);
            __builtin_amdgcn_fence(__ATOMIC_ACQUIRE, "agent");
            asm volatile("s_waitcnt vmcnt(0)" ::: "memory");
        }
    }
    __syncthreads();
}


struct Args { const float* in[24]; float* out; unsigned char* ws; int ph_lo, ph_hi, li, pad; };

__device__ __forceinline__ void p0_transpose_item(const float* __restrict__ W, int ldw, int K, int k0, int n0, bf16* __restrict__ WT, int vrow0, const float* __restrict__ gain, LAS float* scr, int lane) {
    f32x4 v[8];
    const float* wp = W + (size_t)(k0 + (lane >> 3)) * ldw + n0 + 4 * (lane & 7);
#pragma unroll
    for (int i = 0; i < 8; ++i) v[i] = __builtin_nontemporal_load((const f32x4*)(wp + (size_t)(8 * i) * ldw));
    if (gain) {
#pragma unroll
        for (int i = 0; i < 8; ++i) v[i] *= gain[k0 + 8 * i + (lane >> 3)];
    }
#pragma unroll
    for (int i = 0; i < 8; ++i) { LAS float* d = scr + (8 * i + (lane >> 3)) * 33 + 4 * (lane & 7); d[0] = v[i].x; d[1] = v[i].y; d[2] = v[i].z; d[3] = v[i].w; }
    LDS_WAIT(); asm volatile("" ::: "memory");
    const int c = lane & 7;
#pragma unroll
    for (int j = 0; j < 4; ++j) { const int n = (lane >> 3) + 8 * j; const LAS float* s = scr + (8 * c) * 33 + n;
        v4u o; o.x = pk2(s[0 * 33], s[1 * 33]); o.y = pk2(s[2 * 33], s[3 * 33]); o.z = pk2(s[4 * 33], s[5 * 33]); o.w = pk2(s[6 * 33], s[7 * 33]);
        *(GAS v4u*)(WT + (size_t)(vrow0 + n) * K + k0 + 8 * c) = o; }
    LDS_WAIT(); asm volatile("" ::: "memory");
}
__device__ __forceinline__ int vrow_in(int c) { const int pn = c >> 8, cr = c & 255, wc = cr >> 6, bj = (cr >> 5) & 1; return pn * 256 + bj * 128 + wc * 32; }
__device__ __forceinline__ int vrow_up(int c) { const int gs = c >= FF ? 1 : 0, cc = c - gs * FF, pn = cc >> 7, wc = (cc >> 5) & 3; return pn * 256 + gs * 128 + wc * 32; }

__global__ void __launch_bounds__(NWAVES * 64, 2) skel_fwd(Args args) {
    extern __shared__ __attribute__((aligned(16))) unsigned char lds_raw[];
    LAS unsigned char* lds = (LAS unsigned char*)lds_raw;
    volatile LAS unsigned* MISC = (volatile LAS unsigned*)(lds + MISC_OFF);
    const int G = gridDim.x; int vcu; { const int bx = blockIdx.x; vcu = (G % 8 == 0) ? (bx % 8) * (G / 8) + bx / 8 : bx; }
    unsigned char* ws = args.ws;
    gu32* ctl = (gu32*)(ws + WS_CTL);
    float* ss = (float*)(ws + WS_SS); bf16* xb = (bf16*)(ws + WS_XB); bf16* zg = (bf16*)(ws + WS_ZG); bf16* abuf = (bf16*)(ws + WS_A); float* yb = (float*)(ws + WS_YB);
    bf16* mix = (bf16*)(ws + WS_MIX); bf16* wbase = (bf16*)(ws + WS_W); float* xf = args.out;
    float* lutg = (float*)(ws + WS_LUT);
    for (int u = threadIdx.x; u < (LDS_BYTES - LDSCTL_OFF) / 4; u += NWAVES * 64) ((LAS unsigned*)(lds + LDSCTL_OFF))[u] = 0u;
    __syncthreads();
    XcdBarrier bar = xcd_barrier_post((unsigned*)(ctl + CW_BAR) + args.li * XCD_BAR_WORDS, MISC + 8);

#pragma unroll 1
    for (int ph = args.ph_lo; ph < args.ph_hi; ++ph) {
        const int l = ph > 0 ? (ph - 1) / 6 : 0, p = ph > 0 ? (ph - 1) % 6 + 1 : 0;
        bf16* wl = wbase + (size_t)l * WL_END;
        float* ss1 = ss + (size_t)((2 * l) & 3) * T * 16; float* ss2 = ss + (size_t)((2 * l + 1) & 3) * T * 16; float* ss3 = (l + 1 < L) ? ss + (size_t)((2 * l + 2) & 3) * T * 16 : nullptr;
#ifndef MK_ONLY
#define MK_ONLY 0x7f
#endif
        const int dupp = ((args.pad >> 8) & 0xff) - 1;
#pragma unroll 1
        for (int rep = (p == dupp) ? 0 : 1; rep < 2; ++rep) {
        if (p == 0 && (MK_ONLY & 1)) {
            int tid0 = threadIdx.x; asm volatile("" : "+v"(tid0));
            const int lane0 = tid0 & 63, wave = __builtin_amdgcn_readfirstlane(tid0 >> 6);
            LAS float* scr = (LAS float*)(lds + RING_OFF + wave * 16384);
            const int gw = vcu * NWAVES + wave, NGW = G * NWAVES;
            constexpr int I_IN = (D / 64) * (INW / 32), I_G = (D / 64) * (GW / 32), I_A = (512 / 64) * (D / 32), I_O = (D / 64) * (D / 32), I_UP = (D / 64) * (FF2 / 32), I_DN = (FF / 64) * (D / 32);
            constexpr int I_LAYER = I_IN + I_G + 2 * I_A + I_O + I_UP + I_DN;
            for (int i = gw * 64 + lane0; i < 12 * att::LUT_STRIDE; i += NGW * 64) { const int hh = i / att::LUT_STRIDE, j = i - hh * att::LUT_STRIDE, rel = j - 256, ar = rel < 0 ? -rel : rel;
                float v = 0.f; if (j <= 512) v = (hh < 8 && ar > 128) ? att::NEG : args.in[13][t5_bucket(rel) * 12 + hh] * LOG2E;
                lutg[i] = v; }
            for (int m = gw; m < T; m += 2 * NGW) {
                const int m2 = m + NGW;
                const GAS f32x4* xr = (const GAS f32x4*)(args.in[0] + (size_t)m * D) + lane0; const GAS f32x4* xr2 = (const GAS f32x4*)(args.in[0] + (size_t)m2 * D) + lane0;
                GAS unsigned long long* o8 = (GAS unsigned long long*)(xb + (size_t)m * D) + lane0; GAS unsigned long long* o82 = (GAS unsigned long long*)(xb + (size_t)m2 * D) + lane0;
                f32x4 va[4], vb[4];
#pragma unroll
                for (int j = 0; j < 4; ++j) { va[j] = xr[64 * j]; vb[j] = xr2[64 * j]; }
                float s = 0.f, s2 = 0.f;
#pragma unroll
                for (int j = 0; j < 4; ++j) { const f32x4 v = va[j], w = vb[j]; s += (v.x * v.x + v.y * v.y) + (v.z * v.z + v.w * v.w); s2 += (w.x * w.x + w.y * w.y) + (w.z * w.z + w.w * w.w);
                    o8[64 * j] = (unsigned long long)pk2(v.x, v.y) | ((unsigned long long)pk2(v.z, v.w) << 32); o82[64 * j] = (unsigned long long)pk2(w.x, w.y) | ((unsigned long long)pk2(w.z, w.w) << 32); }
                s = wave_sum(s); s2 = wave_sum(s2);
                ss16_store(ss, m, s, lane0); ss16_store(ss, m2, s2, lane0);
            }
        } else if (p == 1 && (MK_ONLY & 2)) {
            pg8::SchedStd S; S.init(xb, D, wl + WL_IN, D, T, ZG - 256, G, (int)blockIdx.x);
            S.fix = (rep == 0 && MK_VAR == 8) ? 1 : 0;
            pg8::EpiIn E{zg, ss1, args.in[3] + l * 64, args.in[4] + l * 64, args.in[6] + l * 64, args.in[7] + l * 64, args.in[15] + l * GW, (args.pad >> 25) & 1, 8 * ((int)blockIdx.x & 7) * 256};
            pg8::gemm_phase<pg8::EpiIn, pg8::SchedStd, true, true>(lds + RING_OFF, D, D, S, E);
        } else if (p == 2 && (MK_ONLY & 4)) {
            int lop = l; asm volatile("" : "+s"(lop));
            const float lam_init = 0.8f - 0.6f * __expf(-0.3f * (float)lop);
            int ln = threadIdx.x; asm volatile("" : "+v"(ln)); ln &= 63;
            const float d1 = wave_sum(args.in[8][l * 64 + ln] * args.in[9][l * 64 + ln]), d2 = wave_sum(args.in[10][l * 64 + ln] * args.in[11][l * 64 + ln]);
            const float lam = __expf(d1) - __expf(d2) + lam_init;
            if ((vcu & 3) == 0 && rep == 1) {
                pg8::SchedStd S1; S1.init(xb, D, wl + WL_IN, D, T, ZG, G, (int)blockIdx.x); S1.one = 1; S1.opm = 8 * (vcu >> 5) + ((vcu & 31) >> 2); S1.opn = 16;
                pg8::EpiIn E1{zg, ss1, args.in[3] + l * 64, args.in[4] + l * 64, args.in[6] + l * 64, args.in[7] + l * 64, args.in[15] + l * GW, 0, 8 * ((int)blockIdx.x & 7) * 256};
                pg8::gemm_phase<pg8::EpiIn, pg8::SchedStd, true, true>(lds + RING_OFF, D, D, S1, E1);
            }
            att::attn_tables(lds, lutg, args.in[12] + l * 128, 1.0f - lam_init);
            const int dsel = args.pad >> 16;
            if (rep == 1 || dsel != 2)
            for (int ui = vcu; ui < 512; ui += G) { const int bh = ui >> 4, qb = ui & 15; if (rep == 0 && MK_VAR == 7 && (vcu & 1)) {} else if (rep == 0) att::attn_unit<true, (MK_VAR == 7 ? 0 : MK_VAR)>(lds, zg, lutg, bh >> 2, bh & 3, qb * 128, nullptr, lam, 1.0f - lam_init, args.in[12] + l * 128, mix);
                else att::attn_unit<true, 0>(lds, zg, lutg, bh >> 2, bh & 3, qb * 128, nullptr, lam, 1.0f - lam_init, args.in[12] + l * 128, nullptr); }
            if (rep == 1 || dsel != 1) {
                unsigned* qctr = (unsigned*)(ctl + CW_Q + 64 * (2 * l + rep));
                for (;;) {
                    if (threadIdx.x == 0) MISC[4] = __hip_atomic_fetch_add(qctr, 1u, __ATOMIC_RELAXED, __HIP_MEMORY_SCOPE_AGENT);
                    __syncthreads();
                    const int ui = (int)MISC[4];
                    __syncthreads();
                    if (ui >= 512) break;
                    const int bk = ui >> 5, qb = ui & 31; att::attn_unit<false>(lds, zg, lutg, bk >> 1, bk & 1, qb * 64, args.in[5] + l * HA, 0.f, 0.f, nullptr, rep == 0 ? mix : nullptr);
                }
            }
        } else if (p == 3 && (MK_ONLY & 8)) {
            pg8::SchedMix S; S.b.init(zg + C_QA, ZG, wl + WL_A, 512, T, D, G, (int)blockIdx.x); S.A1 = (const char*)(zg + C_QB); S.Bt1 = (const char*)(wl + WL_B);
            pg8::EpiMix E{zg, mix};
            pg8::gemm_phase<pg8::EpiMix, pg8::SchedMix, true, true>(lds + RING_OFF, 512, ZG, S, E);
        } else if (p == 4 && (MK_ONLY & 16)) {
            pg8::SchedStd S; S.init(mix, D, wl + WL_O, D, T, D, G, (int)blockIdx.x);
            pg8::EpiRes E{l == 0 ? args.in[0] : xf, xf, xb, ss2};
            pg8::gemm_phase<pg8::EpiRes, pg8::SchedStd, true, true>(lds + RING_OFF, D, D, S, E);
        } else if (p == 5 && (MK_ONLY & 32)) {
            pg8::SchedStd S; S.init(xb, D, wl + WL_UP, D, T, FF2, G, (int)blockIdx.x);
            pg8::EpiUp E{abuf, ss2, args.in[21] + (size_t)l * 3 * FF2, args.in[22] + (size_t)l * FF2, yb, (args.pad >> 24) & 1, 8 * ((int)blockIdx.x & 7) * 256};
            pg8::gemm_phase<pg8::EpiUp, pg8::SchedStd, true, true>(lds + RING_OFF, D, D, S, E);
        } else if (MK_ONLY & 64) {
            pg8::SchedDown S; S.b.init(abuf, FF, wl + WL_DN, FF, T, D, G, (int)blockIdx.x); S.yb = (args.pad & 1) ? nullptr : yb; S.cw = args.in[21] + (size_t)l * 3 * FF2; S.cb = args.in[22] + (size_t)l * FF2; S.a = abuf;
            pg8::EpiRes E{xf, xf, ss3 ? xb : nullptr, ss3};
            pg8::gemm_phase<pg8::EpiRes, pg8::SchedDown, true, true>(lds + RING_OFF, FF, FF, S, E);
        }
        {
            int ph2 = ph; asm volatile("" : "+s"(ph2));
            const int l2 = ph2 > 0 ? (ph2 - 1) / 6 : 0, p2 = ph2 > 0 ? (ph2 - 1) % 6 + 1 : 0;
            const int G2 = gridDim.x, bx2 = blockIdx.x;
            int cl = -1, cw0 = 0, cnw = 1;
            if (p2 == 0) { cl = 0; cw0 = ((G2 % 8 == 0) ? (bx2 % 8) * (G2 / 8) + bx2 / 8 : bx2) * NWAVES; cnw = G2 * NWAVES; }
            else if (p2 == 5 && l2 + 1 < L && G2 == 256 && bx2 >= 128) { cl = l2 + 1; cw0 = (bx2 - 128) * NWAVES; cnw = 128 * NWAVES; }
            if (cl >= 0) {
                bf16* wbase2 = (bf16*)(args.ws + WS_W);
                int tid0 = threadIdx.x; asm volatile("" : "+v"(tid0));
                const int lane0 = tid0 & 63, wave = __builtin_amdgcn_readfirstlane(tid0 >> 6);
                LAS float* scr = (LAS float*)(lds + RING_OFF + wave * 16384);
                constexpr int I_IN = (D / 64) * (INW / 32), I_G = (D / 64) * (GW / 32), I_A = (512 / 64) * (D / 32), I_O = (D / 64) * (D / 32), I_UP = (D / 64) * (FF2 / 32), I_DN = (FF / 64) * (D / 32);
                constexpr int I_LAYER = I_IN + I_G + 2 * I_A + I_O + I_UP + I_DN;
                const int ll = cl; bf16* w = wbase2 + (size_t)ll * WL_END;
#pragma unroll 1
                for (int it = cw0 + wave; it < I_LAYER; it += cnw) {
                    int r = it;
                    if (r < I_IN) { const int nb = r % (INW / 32), kb = r / (INW / 32); p0_transpose_item(args.in[2] + (size_t)ll * D * INW, INW, D, 64 * kb, 32 * nb, w + WL_IN, vrow_in(32 * nb), args.in[1] + ll * D, scr, lane0); continue; } r -= I_IN;
                    if (r < I_G) { const int nb = r % (GW / 32), kb = r / (GW / 32); p0_transpose_item(args.in[14] + (size_t)ll * D * GW, GW, D, 64 * kb, 32 * nb, w + WL_IN, vrow_in(INW + 32 * nb), args.in[1] + ll * D, scr, lane0); continue; } r -= I_G;
                    if (r < I_A) { const int nb = r % (D / 32), kb = r / (D / 32); p0_transpose_item(args.in[16] + (size_t)ll * 512 * D, D, 512, 64 * kb, 32 * nb, w + WL_A, 32 * nb, nullptr, scr, lane0); continue; } r -= I_A;
                    if (r < I_A) { const int nb = r % (D / 32), kb = r / (D / 32); p0_transpose_item(args.in[17] + (size_t)ll * 512 * D, D, 512, 64 * kb, 32 * nb, w + WL_B, 32 * nb, nullptr, scr, lane0); continue; } r -= I_A;
                    if (r < I_O) { const int nb = r % (D / 32), kb = r / (D / 32); p0_transpose_item(args.in[18] + (size_t)ll * D * D, D, D, 64 * kb, 32 * nb, w + WL_O, 32 * nb, nullptr, scr, lane0); continue; } r -= I_O;
                    if (r < I_UP) { const int nb = r % (FF2 / 32), kb = r / (FF2 / 32); p0_transpose_item(args.in[20] + (size_t)ll * D * FF2, FF2, D, 64 * kb, 32 * nb, w + WL_UP, vrow_up(32 * nb), args.in[19] + ll * D, scr, lane0); continue; } r -= I_UP;
                    { const int nb = r % (D / 32), kb = r / (D / 32); p0_transpose_item(args.in[23] + (size_t)ll * FF * D, D, FF, 64 * kb, 32 * nb, w + WL_DN, 32 * nb, nullptr, scr, lane0); }
                }
            }
        }
        }
        if (ph + 1 < args.ph_hi) xcd_barrier(bar);
    }
}
}

extern "C" void kernel_launch(void* const* d_in, const int* in_sizes, int n_in, void* d_out, int out_size, void* d_ws, size_t ws_size, hipStream_t stream) {
    using namespace nv;
    static int grid = 0;
    if (grid == 0) {
        if (n_in != 24 || in_sizes[0] != T * D || out_size != T * D || ws_size < mk::WS_END) { fprintf(stderr, "kernel_launch: built for 24 inputs, x/out of %d floats, >= %zu bytes of workspace; got n_in %d, out %d, ws %zu; nothing launched\n", T * D, (size_t)mk::WS_END, n_in, out_size, ws_size); grid = -1; return; }
        int dev = 0, cus = 0, per_cu = 0;
        if (hipGetDevice(&dev) != hipSuccess || hipDeviceGetAttribute(&cus, hipDeviceAttributeMultiprocessorCount, dev) != hipSuccess) { fprintf(stderr, "kernel_launch: device query failed; nothing launched\n"); grid = -1; return; }
        if (hipFuncSetAttribute((const void*)mk::skel_fwd, hipFuncAttributeMaxDynamicSharedMemorySize, mk::LDS_BYTES) != hipSuccess) { fprintf(stderr, "kernel_launch: hipFuncSetAttribute failed (needs %d bytes of dynamic LDS)\n", mk::LDS_BYTES); grid = -1; return; }
        if (hipOccupancyMaxActiveBlocksPerMultiprocessor(&per_cu, (const void*)mk::skel_fwd, mk::NWAVES * 64, mk::LDS_BYTES) != hipSuccess || per_cu < 1) fprintf(stderr, "kernel_launch: note: occupancy query reports %d workgroups per CU\n", per_cu);
        (void)hipGetLastError();
        grid = cus;
        if (grid != 256) fprintf(stderr, "kernel_launch: the unit schedules are built for 256 CUs; this device reports %d\n", cus);
    }
    if (grid < 0) return;
    if (hipMemsetAsync((unsigned char*)d_ws + mk::WS_CTL, 0, mk::CTL_ZERO_BYTES, stream) != hipSuccess) { fprintf(stderr, "kernel_launch: memset of the control words failed; nothing launched\n"); return; }
    mk::Args a{};
    for (int i = 0; i < 24; ++i) a.in[i] = (const float*)d_in[i];
    a.out = (float*)d_out; a.ws = (unsigned char*)d_ws; a.ph_lo = 0; a.ph_hi = mk::N_PHASES; a.li = 0;
    a.pad = (MK_DUP << 8) | (MK_DSEL << 16);
    hipLaunchKernelGGL(mk::skel_fwd, dim3(grid), dim3(mk::NWAVES * 64), mk::LDS_BYTES, stream, a);
}
```

```cpp
#include <hip/hip_runtime.h>
#include <cstdio>
#include <cstdint>
#include <cmath>
#define MK_EDUP 0

namespace nv {
typedef unsigned short bf16;
constexpr int D = 1024, B = 8, S = 2048, T = B * S, L = 4;
constexpr int HA = 8, KVA = 2, HB = 4, HD = 64;
constexpr int INW = 2304, GW = 2048, ZG = INW + GW;
constexpr int FF = 2816, FF2 = 2 * FF;
constexpr int C_QA = 0, C_KA = 512, C_VA = 640, C_QB = 768, C_KB = 1280, C_VB = 1792, C_G = 2304;
constexpr float EPS = 1e-6f;
constexpr float LOG2E = 1.4426950408889634f;
constexpr float C2 = 0.125f * LOG2E;

__device__ __forceinline__ float bf2f(bf16 v) { return __uint_as_float(((unsigned)v) << 16); }
__device__ __forceinline__ bf16 f2bf(float f) { unsigned u = __float_as_uint(f); return (bf16)((u + 0x7fffu + ((u >> 16) & 1u)) >> 16); }
__device__ __forceinline__ float ldf(const float* p) { return *p; }
__device__ __forceinline__ float ldf(const bf16* p) { return bf2f(*p); }

__device__ __forceinline__ int t5_bucket(int rel) {
    const int n = rel < 0 ? -rel : rel; int v;
    if (n < 8) v = n; else if (n < 12) v = 8; else if (n < 16) v = 9; else if (n < 23) v = 10; else if (n < 32) v = 11;
    else if (n < 46) v = 12; else if (n < 64) v = 13; else if (n < 91) v = 14; else v = 15;
    return (rel > 0 ? 16 : 0) + v;
}
__device__ __forceinline__ float ss16(const float* ss, int t) { const float4* p = (const float4*)(ss + (size_t)t * 16); const float4 a = p[0], b = p[1], c = p[2], d = p[3];
    return ((a.x + a.y) + (a.z + a.w)) + ((b.x + b.y) + (b.z + b.w)) + ((c.x + c.y) + (c.z + c.w)) + ((d.x + d.y) + (d.z + d.w)); }
__device__ __forceinline__ float ss16_q(const float* ss, int t, int fq) { const float4 a = *(const float4*)(ss + (size_t)t * 16 + 4 * fq); float s = (a.x + a.y) + (a.z + a.w); s += __shfl_xor(s, 16); s += __shfl_xor(s, 32); return s; }
__device__ __forceinline__ void ss16_store(float* ss, int t, float s, int lane) { if (lane < 16) ss[(size_t)t * 16 + lane] = lane == 0 ? s : 0.f; }
__device__ __forceinline__ float wave_sum(float v) {
#pragma unroll
    for (int o = 1; o < 64; o <<= 1) v += __shfl_xor(v, o);
    return v;
}
__device__ __forceinline__ float wave_max(float v) {
#pragma unroll
    for (int o = 1; o < 64; o <<= 1) v = fmaxf(v, __shfl_xor(v, o));
    return v;
}

}


namespace pg8 {
using namespace nv;
#define PG8_LAS __attribute__((address_space(3)))
typedef unsigned short bf16_t;
typedef short bf16x8 __attribute__((ext_vector_type(8)));
typedef float f32x4 __attribute__((ext_vector_type(4)));
typedef unsigned u32x4 __attribute__((ext_vector_type(4)));
typedef unsigned u32x2 __attribute__((ext_vector_type(2)));
constexpr int BM = 256, BK = 64, HALF = 128, HTB = HALF * BK * 2  , STAGE_BYTES = 8 * HTB, NXCD = 8, WGM = 8;
constexpr int XOFF = 131072 + 1024;
constexpr int RTAB_OFF = XOFF + 8192;

__host__ __device__ __forceinline__ int lds_byte(int r, int c) { const int st = (r >> 4) * 2 + (c >> 5), rr = r & 15, cc = c & 31, ob = rr * 64 + cc * 2; return st * 1024 + (ob ^ (((ob >> 9) & 1) << 5)); }
__host__ __device__ __forceinline__ void stage_rc(int b, int& R, int& C) { const int st = b / 1024, sb = b % 1024, swz = sb ^ (((sb >> 9) & 1) << 5); R = (st >> 1) * 16 + swz / 64; C = (st & 1) * 32 + (swz % 64) / 2; }
__host__ __device__ __forceinline__ int perm32(int rho) { const int n = rho >> 4, i = rho & 15; return 8 * (i >> 2) + 4 * n + (i & 3); }

struct Unit { int pm, pn, z; };
typedef float f32x2 __attribute__((ext_vector_type(2))); typedef __bf16 bf16x2_t __attribute__((ext_vector_type(2)));
__device__ __forceinline__ unsigned cvt_pk_bf16(float lo, float hi) { f32x2 v = {lo, hi}; bf16x2_t b = __builtin_convertvector(v, bf16x2_t); return __builtin_bit_cast(unsigned, b); }
__device__ __forceinline__ float bflo(unsigned w) { return __uint_as_float(w << 16); }
__device__ __forceinline__ float bfhi(unsigned w) { return __uint_as_float(w & 0xffff0000u); }

struct SchedStd {
    int nM, nN, nwg, G, c, fix, one, opm, opn; const char* A; const char* Bt; size_t at, bt;
    __device__ void init(const void* A_, int lda, const void* Bt_, int K, int M, int N, int G_, int c_) { fix = 0; one = 0; opm = 0; opn = 0; nM = M / BM; nN = N / BM; nwg = nM * nN; G = G_; c = c_; A = (const char*)A_; Bt = (const char*)Bt_; at = (size_t)BM * lda * 2; bt = (size_t)BM * K * 2; }
    __device__ bool next(int i, Unit& u) const {
        if (one) { if (i > 0) return false; u.pm = opm; u.pn = opn; u.z = 0; return true; }
        const long L = (long)i * G + c; if (L >= nwg) return false;
        int wgid = (int)L; { const int q = nwg / NXCD, r = nwg % NXCD, xcd = wgid % NXCD, off = wgid / NXCD; wgid = (xcd < r ? xcd * (q + 1) : r * (q + 1) + (xcd - r) * q) + off; }
        const int nig = WGM * nN, gid = wgid / nig, fm = gid * WGM, gsz = (nM - fm) < WGM ? (nM - fm) : WGM;
        u.pm = fm + ((wgid % nig) % gsz); u.pn = (wgid % nig) / gsz; u.z = 0; if (fix) { u.pm = 0; u.pn = 0; } return true;
    }
    __device__ __forceinline__ const char* aptr(const Unit& u) const { return A + (size_t)u.pm * at; }
    __device__ __forceinline__ const char* bptr(const Unit& u) const { return Bt + (size_t)u.pn * bt; }
    __device__ __forceinline__ void a_ready(const Unit&) const {}
    __device__ __forceinline__ void done(const Unit&) const {}
};
struct SchedMix {
    SchedStd b; const char* A1; const char* Bt1;
    __device__ bool next(int i, Unit& u) const { if (!b.next(i >> 1, u)) return false; u.z = i & 1; return true; }
    __device__ __forceinline__ const char* aptr(const Unit& u) const { return (u.z ? A1 : b.A) + (size_t)u.pm * b.at; }
    __device__ __forceinline__ const char* bptr(const Unit& u) const { return (u.z ? Bt1 : b.Bt) + (size_t)u.pn * b.bt; }
    __device__ __forceinline__ void a_ready(const Unit&) const {}
    __device__ __forceinline__ void done(const Unit&) const {}
};
struct SchedDown {
    SchedStd b; const float* yb; const float* cw; const float* cb; bf16_t* a;
    __device__ bool next(int i, Unit& u) const { return b.next(i, u); }
    __device__ __forceinline__ const char* aptr(const Unit& u) const { return b.aptr(u); }
    __device__ __forceinline__ const char* bptr(const Unit& u) const { return b.bptr(u); }
    __device__ __forceinline__ void a_ready(const Unit& u) const {
        const int pm = u.pm;
        if (yb) {
            int t0 = threadIdx.x; asm volatile("" : "+v"(t0));
            const bool hasp = (pm & 7) != 0, hasn = (pm & 7) != 7;
#pragma unroll 1
            for (int g = 0; g < 3; ++g) {
                float yv[4][2][3], cv[4][2][4];
#pragma unroll
                for (int q = 0; q < 4; ++q) {
                    const int it = 4 * g + q;
                    if (it < 11) {
                        const int idx = t0 + 512 * it, which = idx >= FF ? 1 : 0, j = idx - which * FF;
#pragma unroll
                        for (int gs = 0; gs < 2; ++gs) {
                            const int col = gs * FF + j;
                            const float* r0 = yb + ((size_t)pm * 4 + (which ? 2 : -1)) * FF2 + col;
                            const bool v0 = which ? true : hasp, v2 = which ? hasn : true;
                            yv[q][gs][0] = v0 ? r0[0] : 0.f; yv[q][gs][1] = r0[FF2]; yv[q][gs][2] = v2 ? r0[2 * (size_t)FF2] : 0.f;
                            cv[q][gs][0] = cb[col]; cv[q][gs][1] = cw[col]; cv[q][gs][2] = cw[FF2 + col]; cv[q][gs][3] = cw[2 * FF2 + col];
                        }
                    }
                }
#pragma unroll
                for (int q = 0; q < 4; ++q) {
                    const int it = 4 * g + q;
                    if (it < 11) {
                        const int idx = t0 + 512 * it, which = idx >= FF ? 1 : 0, j = idx - which * FF;
                        float uv[2];
#pragma unroll
                        for (int gs = 0; gs < 2; ++gs) uv[gs] = cv[q][gs][0] + cv[q][gs][1] * yv[q][gs][0] + cv[q][gs][2] * yv[q][gs][1] + cv[q][gs][3] * yv[q][gs][2];
                        const float sg = uv[1] * __builtin_amdgcn_rcpf(1.0f + __builtin_amdgcn_exp2f(-uv[1] * LOG2E));
                        a[(size_t)(pm * BM + which * 255) * FF + j] = f2bf(sg * uv[0]);
                    }
                }
            }
        }
        asm volatile("s_waitcnt vmcnt(0)" ::: "memory");
        __builtin_amdgcn_s_barrier();
        asm volatile("" ::: "memory");
    }
    __device__ __forceinline__ void done(const Unit&) const {}
};

__device__ __forceinline__ void rtab_fill(PG8_LAS unsigned char* lds_, const float* __restrict__ ssx, int row0) {
    int t = threadIdx.x; asm volatile("" : "+v"(t));
    PG8_LAS float* rt = (PG8_LAS float*)(lds_ + RTAB_OFF);
    float v[4];
#pragma unroll
    for (int k = 0; k < 4; ++k) v[k] = ss16(ssx, row0 + t + 512 * k);
#pragma unroll
    for (int k = 0; k < 4; ++k) rt[t + 512 * k] = rsqrtf(v[k] * (1.0f / D) + EPS);
}
struct EpiIn {
    static constexpr bool PERM = true, AFTER_DRAIN = false;
    __device__ __forceinline__ void init(f32x4 (&acc)[2][2][4][2], const Unit&, int, int, int, int) const {
#pragma unroll
        for (int a = 0; a < 2; ++a)
#pragma unroll
            for (int b = 0; b < 2; ++b)
#pragma unroll
                for (int m = 0; m < 4; ++m)
#pragma unroll
                    for (int n = 0; n < 2; ++n) acc[a][b][m][n] = (f32x4){0.f, 0.f, 0.f, 0.f};
    }
    __device__ static constexpr bool zero_after(const Unit&) { return true; }
    bf16_t* zg; const float* ss; const float *qn_a, *kn_a, *qn_b, *kn_b, *bg; int dup, row0;
    __device__ __forceinline__ void prefill(PG8_LAS unsigned char* lds_) const { rtab_fill(lds_, ss, row0); }
    __device__ __forceinline__ void operator()(f32x4 (&acc)[2][2][4][2], const Unit& u, int wr, int wc, int fr, int fq, PG8_LAS unsigned char* lds_) const {
#pragma unroll
        for (int rep_ = 0; rep_ <= ((MK_EDUP & 2) ? 1 : 0); ++rep_) {
        if (rep_) {
#pragma unroll
            for (int ai = 0; ai < 2; ++ai)
#pragma unroll
                for (int bj = 0; bj < 2; ++bj)
#pragma unroll
                    for (int m = 0; m < 4; ++m)
#pragma unroll
                        for (int n = 0; n < 2; ++n) asm volatile("" : "+v"(acc[ai][bj][m][n]) :: "memory");
        }
        const int g = u.pn * 4 + wc, colb = u.pn * BM + wc * 64 + 8 * fq;
        const float* gain = nullptr; float sc = 1.f; int mode = 0;
        if (g < 8) { gain = qn_a; sc = C2; mode = 1; } else if (g < 10) { gain = kn_a; mode = 1; } else if (g < 12) { mode = 0; } else if (g < 20) { gain = qn_b; sc = C2; mode = 1; }
        else if (g < 28) { gain = kn_b; mode = 1; } else if (g < 36) { mode = 0; } else { mode = 2; }
        float rsv[2][4];
#pragma unroll
        for (int ai = 0; ai < 2; ++ai)
#pragma unroll
            for (int m = 0; m < 4; ++m) rsv[ai][m] = ((const PG8_LAS float*)(lds_ + RTAB_OFF))[(u.pm & 7) * BM + ai * HALF + wr * 64 + m * 16 + fr];
        f32x4 gv[2][2];
#pragma unroll
        for (int bj = 0; bj < 2; ++bj)
#pragma unroll
            for (int n = 0; n < 2; ++n) {
                if (mode == 1) gv[bj][n] = *(const f32x4*)(gain + 32 * bj + 8 * fq + 4 * n) * sc;
                else if (mode == 2) gv[bj][n] = *(const f32x4*)(bg + (colb - C_G) + 32 * bj + 4 * n);
                else gv[bj][n] = (f32x4){1.f, 1.f, 1.f, 1.f};
            }
#pragma unroll
        for (int ai = 0; ai < 2; ++ai)
#pragma unroll
            for (int m = 0; m < 4; ++m) {
                const int row = u.pm * BM + ai * HALF + wr * 64 + m * 16 + fr;
                const float rs = rsv[ai][m];
                f32x4 v[2][2];
#pragma unroll
                for (int bj = 0; bj < 2; ++bj)
#pragma unroll
                    for (int n = 0; n < 2; ++n) v[bj][n] = acc[ai][bj][m][n] * rs;
                if (mode == 1) {
                    float q = 0.f;
#pragma unroll
                    for (int bj = 0; bj < 2; ++bj)
#pragma unroll
                        for (int n = 0; n < 2; ++n) { const f32x4 x = v[bj][n]; q += (x[0] * x[0] + x[1] * x[1]) + (x[2] * x[2] + x[3] * x[3]); }
                    q += __shfl_xor(q, 16); q += __shfl_xor(q, 32);
                    const float r2 = rsqrtf(q * (1.0f / 64.0f) + EPS);
#pragma unroll
                    for (int bj = 0; bj < 2; ++bj)
#pragma unroll
                        for (int n = 0; n < 2; ++n) v[bj][n] = v[bj][n] * r2 * gv[bj][n];
                } else if (mode == 2) {
#pragma unroll
                    for (int bj = 0; bj < 2; ++bj)
#pragma unroll
                        for (int n = 0; n < 2; ++n) { f32x4 x = v[bj][n] + gv[bj][n];
#pragma unroll
                            for (int e = 0; e < 4; ++e) x[e] = __builtin_fmaxf(__builtin_amdgcn_rcpf(1.0f + __builtin_amdgcn_exp2f(-x[e] * LOG2E)), 9.5367431640625e-07f);
                            v[bj][n] = x; }
                }
                bf16_t* rowp = zg + (size_t)row * ZG + colb;
#pragma unroll
                for (int bj = 0; bj < 2; ++bj) { u32x4 w; w.x = cvt_pk_bf16(v[bj][0][0], v[bj][0][1]); w.y = cvt_pk_bf16(v[bj][0][2], v[bj][0][3]); w.z = cvt_pk_bf16(v[bj][1][0], v[bj][1][1]); w.w = cvt_pk_bf16(v[bj][1][2], v[bj][1][3]);
                    *(u32x4*)(rowp + 32 * bj) = w; }
            }
        }
    }
};
struct EpiMix {
    static constexpr bool PERM = true, AFTER_DRAIN = false;
    __device__ __forceinline__ void prefill(PG8_LAS unsigned char*) const {}
    __device__ __forceinline__ void init(f32x4 (&acc)[2][2][4][2], const Unit&, int, int, int, int) const {
#pragma unroll
        for (int a = 0; a < 2; ++a)
#pragma unroll
            for (int b = 0; b < 2; ++b)
#pragma unroll
                for (int m = 0; m < 4; ++m)
#pragma unroll
                    for (int n = 0; n < 2; ++n) acc[a][b][m][n] = (f32x4){0.f, 0.f, 0.f, 0.f};
    }
    __device__ static bool zero_after(const Unit& u) { return u.z != 0; }
    const bf16_t* zg; bf16_t* mix;
    __device__ __forceinline__ void operator()(f32x4 (&acc)[2][2][4][2], const Unit& u, int wr, int wc, int fr, int fq, PG8_LAS unsigned char*) const {
        const int col0 = u.pn * BM + wc * 32 + 8 * fq;
#pragma unroll
        for (int ai = 0; ai < 2; ++ai) {
            u32x4 gbv[4][2], gav[4][2];
#pragma unroll
            for (int m = 0; m < 4; ++m)
#pragma unroll
                for (int bj = 0; bj < 2; ++bj) { const size_t go = (size_t)(u.pm * BM + ai * HALF + wr * 64 + m * 16 + fr) * ZG + C_G + col0 + bj * HALF;
                    gbv[m][bj] = *(const u32x4*)(zg + go + D); if (u.z == 0) gav[m][bj] = *(const u32x4*)(zg + go); else gav[m][bj] = (u32x4){0u, 0u, 0u, 0u}; }
#pragma unroll
            for (int m = 0; m < 4; ++m) {
                const int row = u.pm * BM + ai * HALF + wr * 64 + m * 16 + fr;
#pragma unroll
                for (int bj = 0; bj < 2; ++bj) {
                    const int col = col0 + bj * HALF;
                    const u32x4 gb = gbv[m][bj];
                    if (u.z == 0) {
                        const u32x4 ga = gav[m][bj];
                        f32x4 r0, r1;
                        r0[0] = bflo(ga.x) * __builtin_amdgcn_rcpf(bflo(gb.x)); r0[1] = bfhi(ga.x) * __builtin_amdgcn_rcpf(bfhi(gb.x)); r0[2] = bflo(ga.y) * __builtin_amdgcn_rcpf(bflo(gb.y)); r0[3] = bfhi(ga.y) * __builtin_amdgcn_rcpf(bfhi(gb.y));
                        r1[0] = bflo(ga.z) * __builtin_amdgcn_rcpf(bflo(gb.z)); r1[1] = bfhi(ga.z) * __builtin_amdgcn_rcpf(bfhi(gb.z)); r1[2] = bflo(ga.w) * __builtin_amdgcn_rcpf(bflo(gb.w)); r1[3] = bfhi(ga.w) * __builtin_amdgcn_rcpf(bfhi(gb.w));
                        acc[ai][bj][m][0] *= r0; acc[ai][bj][m][1] *= r1;
                    } else {
                        const f32x4 v0 = acc[ai][bj][m][0] * (f32x4){bflo(gb.x), bfhi(gb.x), bflo(gb.y), bfhi(gb.y)}, v1 = acc[ai][bj][m][1] * (f32x4){bflo(gb.z), bfhi(gb.z), bflo(gb.w), bfhi(gb.w)};
                        u32x4 w; w.x = cvt_pk_bf16(v0[0], v0[1]); w.y = cvt_pk_bf16(v0[2], v0[3]); w.z = cvt_pk_bf16(v1[0], v1[1]); w.w = cvt_pk_bf16(v1[2], v1[3]);
                        *(u32x4*)(mix + (size_t)row * D + col) = w;
                    }
                }
            }
            asm volatile("" ::: "memory");
        }
    }
};
struct EpiRes {
    static constexpr bool PERM = false, AFTER_DRAIN = false;
    __device__ __forceinline__ void prefill(PG8_LAS unsigned char*) const {}
    __device__ static constexpr bool zero_after(const Unit&) { return true; }
    const float* base; float* xf; bf16_t* xb; float* ssn;
    __device__ __forceinline__ void init(f32x4 (&acc)[2][2][4][2], const Unit& u, int wr, int wc, int fr, int fq) const {
        const int col0 = u.pn * BM + wc * 32 + 4 * fq;
#pragma unroll
        for (int ai = 0; ai < 2; ++ai)
#pragma unroll
            for (int m = 0; m < 4; ++m) { const size_t off = (size_t)(u.pm * BM + ai * HALF + wr * 64 + m * 16 + fr) * D + col0;
#pragma unroll
                for (int bj = 0; bj < 2; ++bj)
#pragma unroll
                    for (int n = 0; n < 2; ++n) acc[ai][bj][m][n] = *(const f32x4*)(base + off + bj * HALF + n * 16); }
    }
    __device__ __forceinline__ void operator()(f32x4 (&acc)[2][2][4][2], const Unit& u, int wr, int wc, int fr, int fq, PG8_LAS unsigned char*) const {
        const int col0 = u.pn * BM + wc * 32 + 4 * fq;
#pragma unroll
        for (int ai = 0; ai < 2; ++ai)
#pragma unroll
            for (int m = 0; m < 4; ++m) {
                const int row = u.pm * BM + ai * HALF + wr * 64 + m * 16 + fr; const size_t off = (size_t)row * D + col0; float q = 0.f;
#pragma unroll
                for (int bj = 0; bj < 2; ++bj)
#pragma unroll
                    for (int n = 0; n < 2; ++n) { const f32x4 o = acc[ai][bj][m][n];
                        *(f32x4*)(xf + off + bj * HALF + n * 16) = o; q += (o[0] * o[0] + o[1] * o[1]) + (o[2] * o[2] + o[3] * o[3]);
                        if (xb) { u32x2 w; w.x = cvt_pk_bf16(o[0], o[1]); w.y = cvt_pk_bf16(o[2], o[3]); *(u32x2*)(xb + off + bj * HALF + n * 16) = w; } }
                if (ssn) { q += __shfl_xor(q, 16); q += __shfl_xor(q, 32); if (fq == 0) ssn[(size_t)row * 16 + u.pn * 4 + wc] = q; }
            }
    }
};
#define DPPF(oldv, src, ctrl, bc) __int_as_float(__builtin_amdgcn_update_dpp(__float_as_int(oldv), __float_as_int(src), (ctrl), 0xF, 0xF, (bc)))
struct EpiUp {
    static constexpr bool PERM = true, AFTER_DRAIN = false;
    __device__ __forceinline__ void init(f32x4 (&acc)[2][2][4][2], const Unit&, int, int, int, int) const {
#pragma unroll
        for (int a = 0; a < 2; ++a)
#pragma unroll
            for (int b = 0; b < 2; ++b)
#pragma unroll
                for (int m = 0; m < 4; ++m)
#pragma unroll
                    for (int n = 0; n < 2; ++n) acc[a][b][m][n] = (f32x4){0.f, 0.f, 0.f, 0.f};
    }
    __device__ static constexpr bool zero_after(const Unit&) { return true; }
    bf16_t* a; const float* ss; const float* cw; const float* cb; float* yb; int dup, row0;
    __device__ __forceinline__ void prefill(PG8_LAS unsigned char* lds_) const { rtab_fill(lds_, ss, row0); }
    __device__ __forceinline__ void operator()(f32x4 (&acc)[2][2][4][2], const Unit& u, int wr, int wc, int fr, int fq, PG8_LAS unsigned char* lds) const {
        PG8_LAS unsigned char* lds_ = lds; const int wid = wr * 4 + wc;
        PG8_LAS float* X = (PG8_LAS float*)(lds + XOFF);
        float rsv[2][4];
#pragma unroll
        for (int ai = 0; ai < 2; ++ai)
#pragma unroll
            for (int m = 0; m < 4; ++m) rsv[ai][m] = ((const PG8_LAS float*)(lds_ + RTAB_OFF))[(u.pm & 7) * BM + ai * HALF + wr * 64 + m * 16 + fr];
#pragma unroll
        for (int ai = 0; ai < 2; ++ai)
#pragma unroll
            for (int m = 0; m < 4; ++m) {
#pragma unroll
                for (int bj = 0; bj < 2; ++bj)
#pragma unroll
                    for (int n = 0; n < 2; ++n) acc[ai][bj][m][n] *= rsv[ai][m];
            }
#pragma unroll
        for (int ai = 0; ai < 2; ++ai) {
            if (fr == 0) {
#pragma unroll
                for (int bj = 0; bj < 2; ++bj)
#pragma unroll
                    for (int n = 0; n < 2; ++n) *(PG8_LAS f32x4*)(X + ((wid * 2 + ai) * 2 + 0) * 64 + 32 * bj + 8 * fq + 4 * n) = acc[ai][bj][0][n];
            }
            if (fr == 15) {
#pragma unroll
                for (int bj = 0; bj < 2; ++bj)
#pragma unroll
                    for (int n = 0; n < 2; ++n) *(PG8_LAS f32x4*)(X + ((wid * 2 + ai) * 2 + 1) * 64 + 32 * bj + 8 * fq + 4 * n) = acc[ai][bj][3][n];
            }
        }
        {
            const int ccol = u.pn * 128 + wc * 32 + 8 * fq;
            if (wr == 0 && fr < 2) {
#pragma unroll
                for (int bj = 0; bj < 2; ++bj)
#pragma unroll
                    for (int n = 0; n < 2; ++n) *(f32x4*)(yb + ((size_t)u.pm * 4 + fr) * FF2 + bj * FF + ccol + 4 * n) = acc[0][bj][0][n];
            }
            if (wr == 1 && fr >= 14) {
#pragma unroll
                for (int bj = 0; bj < 2; ++bj)
#pragma unroll
                    for (int n = 0; n < 2; ++n) *(f32x4*)(yb + ((size_t)u.pm * 4 + 2 + (fr - 14)) * FF2 + bj * FF + ccol + 4 * n) = acc[1][bj][3][n];
            }
        }
        asm volatile("s_waitcnt lgkmcnt(0)" ::: "memory"); __builtin_amdgcn_s_barrier(); asm volatile("" ::: "memory");
#pragma unroll
        for (int rep_ = 0; rep_ <= ((MK_EDUP & 1) ? 1 : 0); ++rep_) {
        if (rep_) {
#pragma unroll
            for (int ai = 0; ai < 2; ++ai)
#pragma unroll
                for (int bj = 0; bj < 2; ++bj)
#pragma unroll
                    for (int m = 0; m < 4; ++m)
#pragma unroll
                        for (int n = 0; n < 2; ++n) asm volatile("" : "+v"(acc[ai][bj][m][n]) :: "memory");
        }
#pragma unroll
        for (int n = 0; n < 2; ++n) {
            const int ccol = u.pn * 128 + wc * 32 + 8 * fq + 4 * n;
            f32x4 w0[2], w1[2], w2[2], bb[2];
#pragma unroll
            for (int bj = 0; bj < 2; ++bj) { w0[bj] = *(const f32x4*)(cw + bj * FF + ccol); w1[bj] = *(const f32x4*)(cw + FF2 + bj * FF + ccol); w2[bj] = *(const f32x4*)(cw + 2 * FF2 + bj * FF + ccol); bb[bj] = *(const f32x4*)(cb + bj * FF + ccol); }
#pragma unroll
            for (int ai = 0; ai < 2; ++ai) {
                const int pw = wr ? wid - 4 : wid + 4, pai = wr ? ai : 0;
                const int nw = wr ? wid - 4 : wid + 4, nai = wr ? 1 : ai;
                f32x4 xp[2], xn[2];
#pragma unroll
                for (int bj = 0; bj < 2; ++bj) { xp[bj] = *(PG8_LAS f32x4*)(X + ((pw * 2 + pai) * 2 + 1) * 64 + 32 * bj + 8 * fq + 4 * n); xn[bj] = *(PG8_LAS f32x4*)(X + ((nw * 2 + nai) * 2 + 0) * 64 + 32 * bj + 8 * fq + 4 * n); }
#pragma unroll
                for (int m = 0; m < 4; ++m) {
                    const int trow = ai * HALF + wr * 64 + m * 16 + fr;
                    float uv[2][4];
#pragma unroll
                    for (int bj = 0; bj < 2; ++bj)
#pragma unroll
                        for (int e = 0; e < 4; ++e) {
                            const float cur = acc[ai][bj][m][n][e];
                            float rp, rn;
                            if (m > 0) rp = DPPF(0.f, acc[ai][bj][m > 0 ? m - 1 : 0][n][e], 0x121, true); else rp = xp[bj][e];
                            if (m < 3) rn = DPPF(0.f, acc[ai][bj][m < 3 ? m + 1 : 3][n][e], 0x12F, true); else rn = xn[bj][e];
                            const float prev = DPPF(rp, cur, 0x111, false), next = DPPF(rn, cur, 0x101, false);
                            uv[bj][e] = bb[bj][e] + w0[bj][e] * prev + w1[bj][e] * cur + w2[bj][e] * next;
                        }
                    f32x4 o;
#pragma unroll
                    for (int e = 0; e < 4; ++e) o[e] = uv[0][e] * uv[1][e] * __builtin_amdgcn_rcpf(1.0f + __builtin_amdgcn_exp2f(-uv[1][e] * LOG2E));
                    u32x2 w; w.x = cvt_pk_bf16(o[0], o[1]); w.y = cvt_pk_bf16(o[2], o[3]);
                    if (trow != 0 && trow != 255) *(u32x2*)(a + (size_t)(u.pm * BM + trow) * FF + ccol) = w;
                    asm volatile("" ::: "memory");
                }
            }
        }
        }
    }
};

template <class Epi, class Sched, bool ALIGN_EPI = false, bool SP2 = false>
__device__ __forceinline__ void gemm_phase(PG8_LAS unsigned char* lds, const int K, const int lda, const Sched& S, const Epi& E) {
    int tid_ = threadIdx.x; asm volatile("" : "+v"(tid_));
    const int tid = tid_, wid = __builtin_amdgcn_readfirstlane(tid >> 6), lane = tid & 63, wr = wid >> 2, wc = wid & 3, fr = lane & 15, fq = lane >> 4;
    const int nt = K / BK;
    unsigned voffA[2], voffB[2];
#pragma unroll
    for (int i = 0; i < 2; ++i) { int R, C; stage_rc(tid * 16 + i * 8192, R, C); const int Rb = Epi::PERM ? ((R & ~31) + perm32(R & 31)) : R;
        voffA[i] = (unsigned)(R * lda + C) * 2u; voffB[i] = (unsigned)(Rb * K + C) * 2u; }
    const size_t kstep = (size_t)(BK * 2);
    const size_t hstepB = (size_t)HALF * K * 2;
    const size_t hstepA = (size_t)HALF * lda * 2;
    const unsigned ldsw = (unsigned)wid * 1024u;
    const int aoff = lds_byte(wr * 64 + fr, fq * 8), boff = lds_byte(wc * 32 + fr, fq * 8);
#define PG8_SA(b, h) (((b) * 2 + (h)) * HTB)
#define PG8_SB(b, h) ((4 + (b) * 2 + (h)) * HTB)
#define PG8_STAGE(bufoff, gbase, voff) do { _Pragma("unroll") for (int _i = 0; _i < 2; ++_i) \
        __builtin_amdgcn_global_load_lds((const unsigned*)((const char*)(gbase) + (voff)[_i]), (PG8_LAS unsigned*)(lds + (bufoff) + ldsw + _i * 8192), 16, 0, 0); } while (0)
#define PG8_LDA(dst, b, h) do { _Pragma("unroll") for (int m = 0; m < 4; ++m) _Pragma("unroll") for (int k = 0; k < 2; ++k) dst[m][k] = *(const PG8_LAS bf16x8*)(lds + PG8_SA(b, h) + aoff + m * 2048 + k * 1024); } while (0)
#define PG8_LDB(dst, b, h) do { _Pragma("unroll") for (int n = 0; n < 2; ++n) _Pragma("unroll") for (int k = 0; k < 2; ++k) dst[n][k] = *(const PG8_LAS bf16x8*)(lds + PG8_SB(b, h) + boff + n * 2048 + k * 1024); } while (0)
#define PG8_MMA(ai, bj, At, Bt) do { __builtin_amdgcn_s_setprio(1); _Pragma("unroll") for (int m = 0; m < 4; ++m) _Pragma("unroll") for (int n = 0; n < 2; ++n) _Pragma("unroll") for (int k = 0; k < 2; ++k) \
        acc[ai][bj][m][n] = __builtin_amdgcn_mfma_f32_16x16x32_bf16(Bt[n][k], At[m][k], acc[ai][bj][m][n], 0, 0, 0); __builtin_amdgcn_s_setprio(0); } while (0)
#define PG8_WAIT_V(n) asm volatile("s_waitcnt vmcnt(" #n ")" ::: "memory")
#define PG8_WAIT_L(n) asm volatile("s_waitcnt lgkmcnt(" #n ")" ::: "memory")
#define PG8_BAR __builtin_amdgcn_s_barrier()
#define PG8_SCHED __builtin_amdgcn_sched_barrier(0)
    Unit cur, nxt; int ui = 0;
    if (!S.next(0, cur)) return;
    f32x4 acc[2][2][4][2];
    E.init(acc, cur, wr, wc, fr, fq);
    bf16x8 At[4][2], B0[2][2], B1[2][2];
    const char* cA = S.aptr(cur); const char* cB = S.bptr(cur);
    S.a_ready(cur);
    if constexpr (SP2) {
        PG8_STAGE(PG8_SB(0, 0), cB, voffB); PG8_STAGE(PG8_SB(0, 1), cB + hstepB, voffB); PG8_STAGE(PG8_SA(0, 0), cA, voffA); PG8_STAGE(PG8_SA(0, 1), cA + hstepA, voffA);
        E.prefill(lds);
        if (wr == 1) PG8_BAR;
        PG8_WAIT_V(2); PG8_BAR;
        PG8_STAGE(PG8_SB(1, 0), cB + kstep, voffB); PG8_STAGE(PG8_SA(1, 0), cA + kstep, voffA); PG8_STAGE(PG8_SB(1, 1), cB + hstepB + kstep, voffB);
        PG8_WAIT_V(6); PG8_BAR;
    } else {
        PG8_STAGE(PG8_SB(0, 0), cB, voffB); PG8_STAGE(PG8_SA(0, 0), cA, voffA); PG8_STAGE(PG8_SB(0, 1), cB + hstepB, voffB); PG8_STAGE(PG8_SA(0, 1), cA + hstepA, voffA);
        E.prefill(lds);
        if (wr == 1) PG8_BAR;
        PG8_WAIT_V(4); PG8_BAR;
        PG8_STAGE(PG8_SB(1, 0), cB + kstep, voffB); PG8_STAGE(PG8_SA(1, 0), cA + kstep, voffA); PG8_STAGE(PG8_SB(1, 1), cB + hstepB + kstep, voffB);
        PG8_WAIT_V(6); PG8_BAR;
    }
    for (;;) {
        const bool has_next = S.next(ui + 1, nxt);
        const char* nA = has_next ? S.aptr(nxt) : cA; const char* nB = has_next ? S.bptr(nxt) : cB;
        for (int t = 0; t < nt; t += 2) {
            const bool last = (t == nt - 2);
            const char* a1 = cA + (size_t)(t + 1) * kstep;
            const char* a2 = last ? nA : cA + (size_t)(t + 2) * kstep; const char* b2 = last ? nB : cB + (size_t)(t + 2) * kstep;
            const char* a3 = a2 + kstep; const char* b3 = b2 + kstep;
            if (last && has_next) S.a_ready(nxt);
            if constexpr (SP2) {
            PG8_LDB(B0, 0, 0); PG8_LDB(B1, 0, 1); PG8_SCHED; PG8_LDA(At, 0, 0); PG8_STAGE(PG8_SA(1, 1), a1 + hstepA, voffA);
            PG8_WAIT_V(8); PG8_WAIT_L(0); PG8_BAR; PG8_MMA(0, 0, At, B0); PG8_MMA(0, 1, At, B1); PG8_BAR; PG8_SCHED;
            PG8_LDA(At, 0, 1); PG8_STAGE(PG8_SB(0, 0), b2, voffB); PG8_STAGE(PG8_SB(0, 1), b2 + hstepB, voffB); PG8_STAGE(PG8_SA(0, 0), a2, voffA);
            PG8_WAIT_V(8); PG8_WAIT_L(0); PG8_BAR; PG8_MMA(1, 0, At, B0); PG8_MMA(1, 1, At, B1); PG8_BAR; PG8_SCHED;
            PG8_LDB(B0, 1, 0); PG8_LDB(B1, 1, 1); PG8_SCHED; PG8_LDA(At, 1, 0); PG8_STAGE(PG8_SA(0, 1), a2 + hstepA, voffA);
            PG8_WAIT_V(8); PG8_WAIT_L(0); PG8_BAR; PG8_MMA(0, 0, At, B0); PG8_MMA(0, 1, At, B1); PG8_BAR; PG8_SCHED;
            PG8_LDA(At, 1, 1); PG8_STAGE(PG8_SB(1, 0), b3, voffB); PG8_STAGE(PG8_SB(1, 1), b3 + hstepB, voffB); PG8_STAGE(PG8_SA(1, 0), a3, voffA);
            PG8_WAIT_V(8); PG8_WAIT_L(0); PG8_BAR; PG8_MMA(1, 0, At, B0); PG8_MMA(1, 1, At, B1); PG8_BAR; PG8_SCHED;
            } else {
            PG8_LDB(B0, 0, 0); PG8_SCHED; PG8_LDA(At, 0, 0); PG8_STAGE(PG8_SA(1, 1), a1 + hstepA, voffA);
            PG8_WAIT_L(8); PG8_BAR; PG8_WAIT_L(0); PG8_MMA(0, 0, At, B0); PG8_BAR; PG8_SCHED;
            PG8_LDB(B1, 0, 1); PG8_STAGE(PG8_SB(0, 0), b2, voffB);
            PG8_BAR; PG8_WAIT_L(0); PG8_MMA(0, 1, At, B1); PG8_BAR;
            PG8_LDA(At, 0, 1); PG8_STAGE(PG8_SA(0, 0), a2, voffA);
            PG8_BAR; PG8_WAIT_L(0); PG8_MMA(1, 0, At, B0); PG8_BAR; PG8_SCHED;
            PG8_STAGE(PG8_SB(0, 1), b2 + hstepB, voffB);
            PG8_WAIT_V(6); PG8_BAR; PG8_MMA(1, 1, At, B1); PG8_BAR;
            PG8_LDB(B0, 1, 0); PG8_SCHED; PG8_LDA(At, 1, 0); PG8_STAGE(PG8_SA(0, 1), a2 + hstepA, voffA);
            PG8_WAIT_L(8); PG8_BAR; PG8_WAIT_L(0); PG8_MMA(0, 0, At, B0); PG8_BAR; PG8_SCHED;
            PG8_LDB(B1, 1, 1); PG8_STAGE(PG8_SB(1, 0), b3, voffB);
            PG8_BAR; PG8_WAIT_L(0); PG8_MMA(0, 1, At, B1); PG8_BAR;
            PG8_LDA(At, 1, 1); PG8_STAGE(PG8_SA(1, 0), a3, voffA);
            PG8_BAR; PG8_WAIT_L(0); PG8_MMA(1, 0, At, B0); PG8_BAR; PG8_SCHED;
            PG8_STAGE(PG8_SB(1, 1), b3 + hstepB, voffB);
            PG8_WAIT_V(6); PG8_BAR; PG8_MMA(1, 1, At, B1); PG8_BAR;
            }
        }
        if constexpr (ALIGN_EPI) { if (wr == 0) PG8_BAR; }
        if constexpr (!Epi::AFTER_DRAIN) { E(acc, cur, wr, wc, fr, fq, lds); S.done(cur); }
        if (!has_next) break;
        if (Epi::zero_after(cur)) E.init(acc, nxt, wr, wc, fr, fq);
        cur = nxt; cA = nA; cB = nB; ++ui;
        if constexpr (ALIGN_EPI) { if (wr == 1) PG8_BAR; }
    }
    PG8_WAIT_V(0);
    if constexpr (!ALIGN_EPI) { if (wr == 0) PG8_BAR; }
    PG8_BAR;
    if constexpr (Epi::AFTER_DRAIN) { E.fused(acc, cur, wr, wc, fr, fq, lds, wid, lane); S.done(cur); }
#undef PG8_SA
#undef PG8_SB
#undef PG8_STAGE
#undef PG8_LDA
#undef PG8_LDB
#undef PG8_MMA
#undef PG8_WAIT_V
#undef PG8_WAIT_L
#undef PG8_BAR
#undef PG8_SCHED
}
}

namespace att {
using namespace nv;
#define ALAS __attribute__((address_space(3)))
typedef short bf16x8 __attribute__((ext_vector_type(8)));
typedef short s16x4 __attribute__((ext_vector_type(4)));
typedef float f32x16 __attribute__((ext_vector_type(16)));
typedef float f32x4 __attribute__((ext_vector_type(4)));
typedef unsigned u32x4 __attribute__((ext_vector_type(4)));
typedef unsigned u32x2 __attribute__((ext_vector_type(2)));
typedef short v4i16_t __attribute__((ext_vector_type(4)));
typedef float f32x2_t __attribute__((ext_vector_type(2))); typedef __bf16 bf16x2_t __attribute__((ext_vector_type(2)));
constexpr int LUT_OFF = 98304, LUT_STRIDE = 520, GT_OFF = LUT_OFF + 12 * LUT_STRIDE * 4;
static_assert(GT_OFF + 512 <= 131072, "attention tables inside the ring region");
constexpr float NEG = -30000.f, THR = 6.f;
__device__ __forceinline__ unsigned cvtpk(float lo, float hi) { f32x2_t v = {lo, hi}; bf16x2_t b = __builtin_convertvector(v, bf16x2_t); return __builtin_bit_cast(unsigned, b); }
__device__ __forceinline__ s16x4 vtr(ALAS const unsigned char* p) { return __builtin_bit_cast(s16x4, __builtin_amdgcn_ds_read_tr16_b64_v4i16((ALAS v4i16_t*)p)); }
__device__ __forceinline__ void glds16(const void* gsrc, unsigned lds_dst) { unsigned keep;
    asm volatile("s_mov_b32 %0, m0\n\ts_mov_b32 m0, %2\n\ts_nop 0\n\tglobal_load_lds_dwordx4 %1, off\n\ts_mov_b32 m0, %0" : "=&s"(keep) : "v"(gsrc), "s"(lds_dst) : "memory"); }
__device__ __forceinline__ float swap_add(float v) { auto rr = __builtin_amdgcn_permlane32_swap(__float_as_uint(v), __float_as_uint(v), false, false); return __uint_as_float(rr[0]) + __uint_as_float(rr[1]); }
__device__ __forceinline__ float swap_max(float v) { auto rr = __builtin_amdgcn_permlane32_swap(__float_as_uint(v), __float_as_uint(v), false, false); return fmaxf(__uint_as_float(rr[0]), __uint_as_float(rr[1])); }
#define MX3(a, b, c) __builtin_fmaxf(__builtin_fmaxf((a), (b)), (c))

__device__ __forceinline__ void attn_tables(ALAS unsigned char* lds, const float* __restrict__ lutg, const float* __restrict__ subg, float osc) {
    int tid = threadIdx.x; asm volatile("" : "+v"(tid));
    ALAS float* lut = (ALAS float*)(lds + LUT_OFF); ALAS float* gt = (ALAS float*)(lds + GT_OFF);
    for (int i = tid; i < 12 * LUT_STRIDE; i += 512) lut[i] = lutg[i];
    if (tid < 128) gt[tid] = subg[tid] * osc;
    __syncthreads();
}
__device__ __forceinline__ float g4_max(float v) { v = fmaxf(v, __shfl_xor(v, 16)); return fmaxf(v, __shfl_xor(v, 32)); }
__device__ __forceinline__ float g4_sum(float v) { v += __shfl_xor(v, 16); return v + __shfl_xor(v, 32); }

template <bool ISB, int VAR = 0>
__device__ __forceinline__ void attn_unit(ALAS unsigned char* lds, bf16* zg, const float* __restrict__ lutg, int b, int hsel, int q0, const float* __restrict__ sinkp, float lam, float osc, const float* __restrict__ subg, bf16* odry) {
    int tid_ = threadIdx.x; asm volatile("" : "+v"(tid_));
    const int tid = tid_, lane = tid & 63, c16 = lane & 15, g = lane >> 4; const int wid = __builtin_amdgcn_readfirstlane(tid >> 6);
    constexpr int NDVB = ISB ? 8 : 4, BUF = ISB ? 32768 : 16384, VOFF = ISB ? 16384 : 8192, VROW = ISB ? 256 : 128;
    const int map = ISB ? (wid >> 2) : 0, qsub = ISB ? (wid & 3) : (wid & 1), gsel = ISB ? 0 : (wid >> 1);
    const int head = ISB ? hsel : hsel * 4 + gsel;
    const int qrow0 = q0 + 32 * qsub;
    const int qcol = ISB ? (C_QB + head * 128 + map * 64) : (C_QA + head * 64);
    const int kcol = ISB ? (C_KB + head * 128) : (C_KA + hsel * 64);
    const int vcol = ISB ? (C_VB + head * 128) : (C_VA + hsel * 64);
    const size_t rowbase = (size_t)b * S;
    int kt0 = 0, kt1 = S / 64;
    if (!ISB) { kt0 = q0 / 64 - 2; if (kt0 < 0) kt0 = 0; kt1 = q0 / 64 + 3; if (kt1 > S / 64) kt1 = S / 64; }
    const int nt = kt1 - kt0;
    ALAS float* lut = (ALAS float*)(lds + LUT_OFF) + (ISB ? 8 + head : hsel * 4 + gsel) * LUT_STRIDE;
    ALAS float* gt = (ALAS float*)(lds + GT_OFF);
    const float sink2 = ISB ? 0.f : sinkp[head] * LOG2E;
    bf16x8 qr[2][2];
#pragma unroll
    for (int qb = 0; qb < 2; ++qb) { const bf16* qp = zg + (rowbase + qrow0 + 16 * qb + c16) * ZG + qcol + 8 * g;
#pragma unroll
        for (int ks = 0; ks < 2; ++ks) qr[qb][ks] = *(const bf16x8*)(qp + 32 * ks); }
    const unsigned lds0 = (unsigned)(size_t)lds;
    const bf16* kp_[2]; const bf16* vp_[2];
#pragma unroll
    for (int i_ = 0; i_ < 2; ++i_) { const int p_ = ISB ? wid * 2 + i_ : wid;
        kp_[i_] = zg + (rowbase + (size_t)kt0 * 64 + (p_ & 7) * 8 + (lane >> 3)) * ZG + kcol + (ISB ? (p_ >> 3) * 64 : 0) + ((lane & 7) ^ (lane >> 3)) * 8;
        vp_[i_] = ISB ? zg + (rowbase + (size_t)kt0 * 64 + 4 * p_ + (lane >> 4)) * ZG + vcol + ((((lane & 15) >> 1) ^ (4 * (p_ & 1) + (lane >> 4))) * 16) + 8 * (lane & 1)
                      : zg + (rowbase + (size_t)kt0 * 64 + 8 * p_ + (lane >> 3)) * ZG + vcol + ((((lane & 7) >> 1) ^ ((lane >> 4) & 3)) * 16) + 8 * (lane & 1); }
#define ATT_ISSUE(bo) do { \
        _Pragma("unroll") for (int i_ = 0; i_ < (ISB ? 2 : 1); ++i_) { const int p_ = ISB ? wid * 2 + i_ : wid; \
            glds16(kp_[i_], (unsigned)__builtin_amdgcn_readfirstlane((int)(lds0 + (bo) + p_ * 1024))); \
            glds16(vp_[i_], (unsigned)__builtin_amdgcn_readfirstlane((int)(lds0 + (bo) + VOFF + p_ * 1024))); \
            kp_[i_] += 64 * ZG; vp_[i_] += 64 * ZG; } } while (0)
#define ATT_SB() __builtin_amdgcn_sched_barrier(0)
    float mhat[2] = {0.f, 0.f}, lsum[2] = {0.f, 0.f};
    f32x4 o[2][NDVB];
#pragma unroll
    for (int qb = 0; qb < 2; ++qb)
#pragma unroll
        for (int d = 0; d < NDVB; ++d) o[qb][d] = (f32x4){0.f, 0.f, 0.f, 0.f};
    const int kfo = (ISB ? map * 8192 : 0) + c16 * 128 + ((g ^ (c16 & 7)) * 16);
    const int vq = (lane & 15) >> 2, vsw = ISB ? (4 * (g & 1) + vq) : (2 * (g & 1) + (vq >> 1));
    const int vfo = VOFF + (4 * g + vq) * VROW + (lane & 3) * 8;
    u32x4 pw[2][2];
    const float cfar_r = ISB ? lut[256 + 128] : 0.f, cfar_l = ISB ? lut[256 - 128] : 0.f;
#define ATT_QK(P, t, so) do { const int kb_ = (t) * 64; float cf_ = 0.f; \
        if (ISB) { if (kb_ - qrow0 - 31 >= 91) cf_ = cfar_r; else if (kb_ + 63 - qrow0 <= -91) cf_ = cfar_l; } \
        const float c0_ = cf_ - mhat[0], c1_ = cf_ - mhat[1]; const f32x4 ci0_ = (f32x4){c0_, c0_, c0_, c0_}, ci1_ = (f32x4){c1_, c1_, c1_, c1_}; \
        ALAS const unsigned char* kp = lds + (so) + kfo; \
        _Pragma("unroll") for (int kb = 0; kb < 4; ++kb) { \
            const bf16x8 k0_ = *(ALAS const bf16x8*)(kp + kb * 2048), k1_ = *(ALAS const bf16x8*)((ALAS const unsigned char*)((unsigned)(size_t)kp ^ 64u) + kb * 2048); \
            P[0][kb] = __builtin_amdgcn_mfma_f32_16x16x32_bf16(k0_, qr[0][0], ci0_, 0, 0, 0); P[1][kb] = __builtin_amdgcn_mfma_f32_16x16x32_bf16(k0_, qr[1][0], ci1_, 0, 0, 0); \
            P[0][kb] = __builtin_amdgcn_mfma_f32_16x16x32_bf16(k1_, qr[0][1], P[0][kb], 0, 0, 0); P[1][kb] = __builtin_amdgcn_mfma_f32_16x16x32_bf16(k1_, qr[1][1], P[1][kb], 0, 0, 0); } } while (0)
#define ATT_DECIDE(P, t, first) do { const int kb_ = (t) * 64; \
        if (!ISB || !((kb_ - qrow0 - 31 >= 91) || (kb_ + 63 - qrow0 <= -91))) { \
            ALAS const float* lp = lut + (kb_ - (qrow0 + c16) + 256 + 4 * g); \
            _Pragma("unroll") for (int qb = 0; qb < 2; ++qb) { float lv_[16]; \
                _Pragma("unroll") for (int kb = 0; kb < 4; ++kb) _Pragma("unroll") for (int r = 0; r < 4; ++r) lv_[4 * kb + r] = lp[16 * kb - 16 * qb + r]; \
                _Pragma("unroll") for (int kb = 0; kb < 4; ++kb) _Pragma("unroll") for (int r = 0; r < 4; ++r) P[qb][kb][r] += lv_[4 * kb + r]; } } \
        float rm0_ = MX3(MX3(P[0][0][0], P[0][0][1], P[0][0][2]), P[0][0][3], P[0][1][0]), rm1_ = MX3(MX3(P[1][0][0], P[1][0][1], P[1][0][2]), P[1][0][3], P[1][1][0]); \
        rm0_ = MX3(MX3(rm0_, P[0][1][1], P[0][1][2]), P[0][1][3], P[0][2][0]); rm1_ = MX3(MX3(rm1_, P[1][1][1], P[1][1][2]), P[1][1][3], P[1][2][0]); \
        rm0_ = MX3(MX3(rm0_, P[0][2][1], P[0][2][2]), P[0][2][3], P[0][3][0]); rm1_ = MX3(MX3(rm1_, P[1][2][1], P[1][2][2]), P[1][2][3], P[1][3][0]); \
        rm0_ = MX3(MX3(rm0_, P[0][3][1], P[0][3][2]), P[0][3][3], rm0_); rm1_ = MX3(MX3(rm1_, P[1][3][1], P[1][3][2]), P[1][3][3], rm1_); \
        if ((first) || __any(__builtin_fmaxf(rm0_, rm1_) > THR)) { \
            const float f0_ = g4_max(rm0_), f1_ = g4_max(rm1_); \
            const float dl0 = (first) ? f0_ : __builtin_fmaxf(f0_, 0.f), dl1 = (first) ? f1_ : __builtin_fmaxf(f1_, 0.f); \
            mhat[0] += dl0; mhat[1] += dl1; \
            _Pragma("unroll") for (int kb = 0; kb < 4; ++kb) { P[0][kb] -= dl0; P[1][kb] -= dl1; } \
            if (!(first)) { const float s0_ = __builtin_amdgcn_exp2f(-dl0), s1_ = __builtin_amdgcn_exp2f(-dl1); lsum[0] *= s0_; lsum[1] *= s1_; \
                _Pragma("unroll") for (int d = 0; d < NDVB; ++d) { o[0][d] *= s0_; o[1][d] *= s1_; } } } } while (0)
#define ATT_FINISH(P) do { \
        _Pragma("unroll") for (int qb = 0; qb < 2; ++qb) { float sa_ = 0.f; \
            _Pragma("unroll") for (int kb = 0; kb < 4; ++kb) _Pragma("unroll") for (int r = 0; r < 4; ++r) { P[qb][kb][r] = __builtin_amdgcn_exp2f(P[qb][kb][r]); sa_ += P[qb][kb][r]; } \
            lsum[qb] += sa_; \
            _Pragma("unroll") for (int s_ = 0; s_ < 2; ++s_) pw[qb][s_] = (u32x4){cvtpk(P[qb][2 * s_][0], P[qb][2 * s_][1]), cvtpk(P[qb][2 * s_][2], P[qb][2 * s_][3]), cvtpk(P[qb][2 * s_ + 1][0], P[qb][2 * s_ + 1][1]), cvtpk(P[qb][2 * s_ + 1][2], P[qb][2 * s_ + 1][3])}; } } while (0)
#define ATT_LDV2(dst, s_, d0_) do { _Pragma("unroll") for (int dd = 0; dd < 2; ++dd) { ALAS const unsigned char* a_ = vp + (s_) * 32 * VROW + ((((d0_) + dd) ^ vsw) * 32); dst[2 * dd] = vtr(a_); dst[2 * dd + 1] = vtr(a_ + 16 * VROW); } } while (0)
#define ATT_PV2(src, s_, d0_) do { __builtin_amdgcn_s_setprio(1); _Pragma("unroll") for (int dd = 0; dd < 2; ++dd) { \
            const bf16x8 vf_ = (bf16x8){src[2 * dd][0], src[2 * dd][1], src[2 * dd][2], src[2 * dd][3], src[2 * dd + 1][0], src[2 * dd + 1][1], src[2 * dd + 1][2], src[2 * dd + 1][3]}; \
            o[0][(d0_) + dd] = __builtin_amdgcn_mfma_f32_16x16x32_bf16(vf_, __builtin_bit_cast(bf16x8, pw[0][s_]), o[0][(d0_) + dd], 0, 0, 0); \
            o[1][(d0_) + dd] = __builtin_amdgcn_mfma_f32_16x16x32_bf16(vf_, __builtin_bit_cast(bf16x8, pw[1][s_]), o[1][(d0_) + dd], 0, 0, 0); } __builtin_amdgcn_s_setprio(0); } while (0)
#define ATT_PV(so) do { ALAS const unsigned char* vp = lds + (so) + vfo; s16x4 va[4], vb[4]; constexpr int NG_ = NDVB / 2; \
        ATT_LDV2(va, 0, 0); ATT_SB(); \
        _Pragma("unroll") for (int k_ = 0; k_ < 2 * NG_; k_ += 2) { \
            ATT_LDV2(vb, (k_ + 1) / NG_, 2 * ((k_ + 1) % NG_)); ATT_SB(); \
            ATT_PV2(va, k_ / NG_, 2 * (k_ % NG_)); ATT_SB(); \
            if (k_ + 2 < 2 * NG_) { ATT_LDV2(va, (k_ + 2) / NG_, 2 * ((k_ + 2) % NG_)); ATT_SB(); } \
            ATT_PV2(vb, (k_ + 1) / NG_, 2 * ((k_ + 1) % NG_)); ATT_SB(); } } while (0)
#define ATT_SLOT(i) (ISB ? (((i) % 3) * BUF) : ((i) * BUF))
#define ATT_STEP(i, PC, PP) do { \
        if (ISB) { asm volatile("s_waitcnt vmcnt(0)" ::: "memory"); __syncthreads(); if ((i) + 1 < nt) ATT_ISSUE(ATT_SLOT((i) + 1)); } \
        ATT_QK(PC, kt0 + (i), ATT_SLOT(i)); ATT_SB(); \
        ATT_FINISH(PP); ATT_SB(); \
        ATT_PV(ATT_SLOT((i) - 1)); ATT_SB(); \
        ATT_DECIDE(PC, kt0 + (i), false); ATT_SB(); } while (0)
    f32x4 pA[2][4], pB[2][4];
    if (ISB) { ATT_ISSUE(0); asm volatile("s_waitcnt vmcnt(0)" ::: "memory"); __syncthreads(); if (nt > 1) ATT_ISSUE(BUF); }
    else {
#pragma unroll 1
        for (int i = 0; i < nt; ++i) ATT_ISSUE(i * BUF);
        asm volatile("s_waitcnt vmcnt(0)" ::: "memory"); __syncthreads();
    }
    ATT_QK(pA, kt0, 0); ATT_SB();
    ATT_DECIDE(pA, kt0, true); ATT_SB();
    int i = 1;
#pragma unroll 1
    for (; i + 1 < nt; i += 2) {
        ATT_STEP(i, pB, pA);
        ATT_STEP(i + 1, pA, pB);
    }
    if (i < nt) {
        ATT_STEP(i, pB, pA);
        ATT_FINISH(pB); ATT_SB(); ATT_PV(ATT_SLOT(nt - 1));
    } else {
        ATT_FINISH(pA); ATT_SB(); ATT_PV(ATT_SLOT(nt - 1));
    }
#undef ATT_ISSUE
#undef ATT_SB
#undef ATT_QK
#undef ATT_DECIDE
#undef ATT_FINISH
#undef ATT_LDV2
#undef ATT_PV2
#undef ATT_PV
#undef ATT_SLOT
#undef ATT_STEP
    float inv[2];
#pragma unroll
    for (int qb = 0; qb < 2; ++qb) { float l_ = g4_sum(lsum[qb]); if (!ISB) l_ += __builtin_amdgcn_exp2f(sink2 - mhat[qb]); inv[qb] = 1.0f / l_; }
    constexpr int DVE = ISB ? 128 : 64, SPITCH = DVE * 2 + 8;
    bf16* obase = odry ? odry + (rowbase + qrow0) * D + (ISB ? (512 + head * 128) : (head * 64)) : zg + (rowbase + qrow0) * ZG + (ISB ? (C_QB + head * 128) : (C_QA + head * 64));
    const size_t opitch = odry ? D : ZG;
    ALAS unsigned char* stg = lds + (ISB ? qsub * 16384 : wid * 4608);
#define ATT_OUT() do { asm volatile("s_waitcnt lgkmcnt(0)" ::: "memory"); \
        constexpr int LPR = DVE / 8, RPI = 64 / LPR; \
        _Pragma("unroll") for (int i_ = 0; i_ < 32 / RPI; ++i_) { const int row_ = i_ * RPI + lane / LPR, ch_ = lane % LPR; \
            const u32x2 a_ = *(ALAS const u32x2*)(stg + row_ * SPITCH + ch_ * 16), b_ = *(ALAS const u32x2*)(stg + row_ * SPITCH + ch_ * 16 + 8); \
            *(u32x4*)(obase + (size_t)row_ * opitch + ch_ * 8) = (u32x4){a_.x, a_.y, b_.x, b_.y}; } } while (0)
    if (ISB) {
        __syncthreads();
        ALAS float* cs = (ALAS float*)lds;
        if (map == 1) {
#pragma unroll
            for (int qb = 0; qb < 2; ++qb) { const float sc = -lam * inv[qb];
#pragma unroll
                for (int d = 0; d < NDVB; ++d)
#pragma unroll
                    for (int r = 0; r < 4; ++r) cs[(qsub * 64 + (qb * NDVB + d) * 4 + r) * 64 + lane] = o[qb][d][r] * sc; } }
        __syncthreads();
        if (map == 0) {
            float rstd[2];
#pragma unroll
            for (int qb = 0; qb < 2; ++qb) { float q = 0.f;
#pragma unroll
                for (int d = 0; d < NDVB; ++d)
#pragma unroll
                    for (int r = 0; r < 4; ++r) { const float v = o[qb][d][r] * inv[qb] + cs[(qsub * 64 + (qb * NDVB + d) * 4 + r) * 64 + lane]; o[qb][d][r] = v; q += v * v; }
                rstd[qb] = rsqrtf(g4_sum(q) * (1.0f / 128.0f) + EPS); }
            asm volatile("s_waitcnt lgkmcnt(0)" ::: "memory");
#pragma unroll
            for (int qb = 0; qb < 2; ++qb)
#pragma unroll
                for (int d = 0; d < NDVB; ++d) { const int dv0 = 16 * d + 4 * g; const f32x4 gv = *(ALAS const f32x4*)(gt + dv0);
                    u32x2 w; w.x = cvtpk(o[qb][d][0] * rstd[qb] * gv[0], o[qb][d][1] * rstd[qb] * gv[1]); w.y = cvtpk(o[qb][d][2] * rstd[qb] * gv[2], o[qb][d][3] * rstd[qb] * gv[3]);
                    *(ALAS u32x2*)(stg + (16 * qb + c16) * SPITCH + dv0 * 2) = w; }
            ATT_OUT();
        }
    } else {
        __syncthreads();
#pragma unroll
        for (int qb = 0; qb < 2; ++qb)
#pragma unroll
            for (int d = 0; d < NDVB; ++d) { const int dv0 = 16 * d + 4 * g;
                u32x2 w; w.x = cvtpk(o[qb][d][0] * inv[qb], o[qb][d][1] * inv[qb]); w.y = cvtpk(o[qb][d][2] * inv[qb], o[qb][d][3] * inv[qb]);
                *(ALAS u32x2*)(stg + (16 * qb + c16) * SPITCH + dv0 * 2) = w; }
        ATT_OUT();
    }
#undef ATT_OUT
    __syncthreads();
}
#undef MX3
}

#ifndef MK_VAR
#define MK_VAR 0
#endif
#define MK_DUP 0
#define MK_DSEL 0
namespace mk {
using namespace nv;
constexpr int NWAVES = 8;
constexpr size_t MiB = 1u << 20;
constexpr size_t WS_CTL = 0, CTL_ZERO_BYTES = 1 * MiB;
constexpr size_t WS_LUT = 512 * 1024;
constexpr size_t WS_SS = 1 * MiB;
constexpr size_t WS_XB = 6 * MiB;
constexpr size_t WS_ZG = 38 * MiB;
constexpr size_t WS_A = 38 * MiB;
constexpr size_t WS_YB = 126 * MiB;
constexpr size_t WS_MIX = 174 * MiB;
constexpr size_t WS_W = 206 * MiB;
constexpr size_t WL_IN = 0, WL_A = (size_t)ZG * D, WL_B = WL_A + (size_t)D * 512, WL_O = WL_B + (size_t)D * 512, WL_UP = WL_O + (size_t)D * D, WL_DN = WL_UP + (size_t)FF2 * D, WL_END = WL_DN + (size_t)D * FF;
constexpr size_t WS_END = 322 * MiB;
static_assert(WS_W + 4 * WL_END * 2 <= WS_END && WS_YB + (size_t)64 * 4 * FF2 * 4 <= WS_MIX && WS_A + (size_t)T * FF * 2 <= WS_YB, "d_ws map");
constexpr int CW_Q = 2048;
constexpr int CW_BAR = 4096;
constexpr int N_PHASES = 1 + 6 * L;
constexpr int RING_OFF = 0, RING_BYTES = 131072, LDSCTL_OFF = RING_BYTES, MISC_OFF = LDSCTL_OFF + 320;
constexpr int LDS_BYTES = 149504;
static_assert(pg8::RTAB_OFF + 8192 <= LDS_BYTES && MISC_OFF + 128 <= pg8::XOFF, "LDS map");

#define GAS __attribute__((address_space(1)))
#define LAS __attribute__((address_space(3)))
typedef unsigned v4u __attribute__((ext_vector_type(4)));
typedef float f32x4 __attribute__((ext_vector_type(4)));
typedef GAS unsigned gu32;
#define RLX_AGENT __ATOMIC_RELAXED, __HIP_MEMORY_SCOPE_AGENT
#define LDS_WAIT() asm volatile("s_waitcnt lgkmcnt(0)" ::: "memory")
#define VM_WAIT() asm volatile("s_waitcnt vmcnt(0)" ::: "memory")
__device__ __forceinline__ unsigned f2bfu(float f) { unsigned u = __builtin_bit_cast(unsigned, f); return (u + 0x7fffu + ((u >> 16) & 1u)) >> 16; }
__device__ __forceinline__ unsigned pk2(float lo, float hi) { return f2bfu(lo) | (f2bfu(hi) << 16); }

#define XB_TMO      128
#define XB_XCNT(j)  (256  + 64 * (j))
#define XB_XSUB(j)  (1280 + 64 * (j))
#define XB_XGEN(j)  (2304 + 64 * (j))
#define XB_TOP      3328
#define XB_TOPGEN   3392
#define XCD_BAR_WORDS 3456
#define XB_SPIN_CAP (1u << 18)

__device__ __forceinline__ unsigned xb_ld(unsigned* p)              { return __hip_atomic_load(p, __ATOMIC_RELAXED, __HIP_MEMORY_SCOPE_AGENT); }
__device__ __forceinline__ unsigned xb_add(unsigned* p, unsigned v) { return __hip_atomic_fetch_add(p, v, __ATOMIC_RELAXED, __HIP_MEMORY_SCOPE_AGENT); }
__device__ __forceinline__ unsigned xb_xcc_id() { return (unsigned)__builtin_amdgcn_s_getreg((3 << 11) | 20) & 0xFu; }
#define XB_SPIN(cond, bar) do { unsigned _sp = 0; while (cond) { __builtin_amdgcn_s_sleep(1); \
    if ((++_sp & 255u) == 0u) { if (xb_ld(&(bar)[XB_TMO])) break; if (_sp > XB_SPIN_CAP) { atomicAdd(&(bar)[XB_TMO], 1u); break; } } } } while (0)

struct XcdBarrier {
    unsigned* bar; unsigned x;
    volatile LAS unsigned* st;
};

__device__ __forceinline__ XcdBarrier xcd_barrier_post(unsigned* bar, volatile LAS unsigned* st) {
    XcdBarrier b; b.bar = bar; b.x = xb_xcc_id(); b.st = st;
    if (threadIdx.x == 0) (void)xb_add(&bar[XB_XCNT(b.x)], 1u);
    return b;
}
__device__ __forceinline__ void xcd_barrier_complete(unsigned* bar, unsigned x, unsigned& nloc, unsigned& nx) {
    const unsigned G = gridDim.x * gridDim.y * gridDim.z;
    unsigned sum, cnt, mine, sp = 0u;
    for (;;) {
        sum = 0u; cnt = 0u; mine = 0u;
#pragma unroll
        for (unsigned j = 0; j < 16; ++j) { const unsigned c = xb_ld(&bar[XB_XCNT(j)]); sum += c; cnt += (c > 0u) ? 1u : 0u; mine = (j == x) ? c : mine; }
        if (sum == G) break;
        __builtin_amdgcn_s_sleep(1);
        if ((++sp & 255u) == 0u) { if (xb_ld(&bar[XB_TMO])) break; if (sp > XB_SPIN_CAP) { atomicAdd(&bar[XB_TMO], 1u); break; } }
    }
    nloc = mine > 0u ? mine : 1u; nx = cnt > 0u ? cnt : 1u;
}

__device__ __forceinline__ void xcd_barrier(const XcdBarrier& b) {
    asm volatile("s_waitcnt vmcnt(0)" ::: "memory");
    __syncthreads();
    if (threadIdx.x == 0) {
        unsigned* bar = b.bar;
        __builtin_amdgcn_s_waitcnt(0);
        unsigned nloc = b.st[0], nx = b.st[1];
        if (nloc == 0u) { xcd_barrier_complete(bar, b.x, nloc, nx); b.st[0] = nloc; b.st[1] = nx; }
        const unsigned old = xb_add(&bar[XB_XSUB(b.x)], 1u);
        const unsigned gen = old / nloc;
        if (old + 1u == (gen + 1u) * nloc) {
            __builtin_amdgcn_fence(__ATOMIC_RELEASE, "agent");
            asm volatile("s_waitcnt vmcnt(0)" ::: "memory");
            const unsigned og = xb_add(&bar[XB_TOP], 1u);
            const unsigned tg = og / nx;
            if (og + 1u == (tg + 1u) * nx) xb_add(&bar[XB_TOPGEN], 1u);
            else XB_SPIN(xb_ld(&bar[XB_TOPGEN]) == tg, bar);
            __builtin_amdgcn_fence(__ATOMIC_ACQUIRE, "agent");
            xb_add(&bar[XB_XGEN(b.x)], 1u);
            asm volatile("s_waitcnt vmcnt(0)" ::: "memory");
        } else {
            XB_SPIN(xb_ld(&bar[XB_XGEN(b.x)]) == gen, bar);
            __builtin_amdgcn_fence(__ATOMIC_ACQUIRE, "agent");
            asm volatile("s_waitcnt vmcnt(0)" ::: "memory");
        }
    }
    __syncthreads();
}


struct Args { const float* in[24]; float* out; unsigned char* ws; int ph_lo, ph_hi, li, pad; };

__device__ __forceinline__ void p0_transpose_item(const float* __restrict__ W, int ldw, int K, int k0, int n0, bf16* __restrict__ WT, int vrow0, const float* __restrict__ gain, LAS float* scr, int lane) {
    f32x4 v[8];
    const float* wp = W + (size_t)(k0 + (lane >> 3)) * ldw + n0 + 4 * (lane & 7);
#pragma unroll
    for (int i = 0; i < 8; ++i) v[i] = __builtin_nontemporal_load((const f32x4*)(wp + (size_t)(8 * i) * ldw));
    if (gain) {
#pragma unroll
        for (int i = 0; i < 8; ++i) v[i] *= gain[k0 + 8 * i + (lane >> 3)];
    }
#pragma unroll
    for (int i = 0; i < 8; ++i) { LAS float* d = scr + (8 * i + (lane >> 3)) * 33 + 4 * (lane & 7); d[0] = v[i].x; d[1] = v[i].y; d[2] = v[i].z; d[3] = v[i].w; }
    LDS_WAIT(); asm volatile("" ::: "memory");
    const int c = lane & 7;
#pragma unroll
    for (int j = 0; j < 4; ++j) { const int n = (lane >> 3) + 8 * j; const LAS float* s = scr + (8 * c) * 33 + n;
        v4u o; o.x = pk2(s[0 * 33], s[1 * 33]); o.y = pk2(s[2 * 33], s[3 * 33]); o.z = pk2(s[4 * 33], s[5 * 33]); o.w = pk2(s[6 * 33], s[7 * 33]);
        *(GAS v4u*)(WT + (size_t)(vrow0 + n) * K + k0 + 8 * c) = o; }
    LDS_WAIT(); asm volatile("" ::: "memory");
}
__device__ __forceinline__ int vrow_in(int c) { const int pn = c >> 8, cr = c & 255, wc = cr >> 6, bj = (cr >> 5) & 1; return pn * 256 + bj * 128 + wc * 32; }
__device__ __forceinline__ int vrow_up(int c) { const int gs = c >= FF ? 1 : 0, cc = c - gs * FF, pn = cc >> 7, wc = (cc >> 5) & 3; return pn * 256 + gs * 128 + wc * 32; }

__global__ void __launch_bounds__(NWAVES * 64, 2) skel_fwd(Args args) {
    extern __shared__ __attribute__((aligned(16))) unsigned char lds_raw[];
    LAS unsigned char* lds = (LAS unsigned char*)lds_raw;
    volatile LAS unsigned* MISC = (volatile LAS unsigned*)(lds + MISC_OFF);
    const int G = gridDim.x; int vcu; { const int bx = blockIdx.x; vcu = (G % 8 == 0) ? (bx % 8) * (G / 8) + bx / 8 : bx; }
    unsigned char* ws = args.ws;
    gu32* ctl = (gu32*)(ws + WS_CTL);
    float* ss = (float*)(ws + WS_SS); bf16* xb = (bf16*)(ws + WS_XB); bf16* zg = (bf16*)(ws + WS_ZG); bf16* abuf = (bf16*)(ws + WS_A); float* yb = (float*)(ws + WS_YB);
    bf16* mix = (bf16*)(ws + WS_MIX); bf16* wbase = (bf16*)(ws + WS_W); float* xf = args.out;
    float* lutg = (float*)(ws + WS_LUT);
    for (int u = threadIdx.x; u < (LDS_BYTES - LDSCTL_OFF) / 4; u += NWAVES * 64) ((LAS unsigned*)(lds + LDSCTL_OFF))[u] = 0u;
    __syncthreads();
    XcdBarrier bar = xcd_barrier_post((unsigned*)(ctl + CW_BAR) + args.li * XCD_BAR_WORDS, MISC + 8);

#pragma unroll 1
    for (int ph = args.ph_lo; ph < args.ph_hi; ++ph) {
        const int l = ph > 0 ? (ph - 1) / 6 : 0, p = ph > 0 ? (ph - 1) % 6 + 1 : 0;
        bf16* wl = wbase + (size_t)l * WL_END;
        float* ss1 = ss + (size_t)((2 * l) & 3) * T * 16; float* ss2 = ss + (size_t)((2 * l + 1) & 3) * T * 16; float* ss3 = (l + 1 < L) ? ss + (size_t)((2 * l + 2) & 3) * T * 16 : nullptr;
#ifndef MK_ONLY
#define MK_ONLY 0x7f
#endif
        const int dupp = ((args.pad >> 8) & 0xff) - 1;
#pragma unroll 1
        for (int rep = (p == dupp) ? 0 : 1; rep < 2; ++rep) {
        if (p == 0 && (MK_ONLY & 1)) {
            int tid0 = threadIdx.x; asm volatile("" : "+v"(tid0));
            const int lane0 = tid0 & 63, wave = __builtin_amdgcn_readfirstlane(tid0 >> 6);
            LAS float* scr = (LAS float*)(lds + RING_OFF + wave * 16384);
            const int gw = vcu * NWAVES + wave, NGW = G * NWAVES;
            constexpr int I_IN = (D / 64) * (INW / 32), I_G = (D / 64) * (GW / 32), I_A = (512 / 64) * (D / 32), I_O = (D / 64) * (D / 32), I_UP = (D / 64) * (FF2 / 32), I_DN = (FF / 64) * (D / 32);
            constexpr int I_LAYER = I_IN + I_G + 2 * I_A + I_O + I_UP + I_DN;
            for (int i = gw * 64 + lane0; i < 12 * att::LUT_STRIDE; i += NGW * 64) { const int hh = i / att::LUT_STRIDE, j = i - hh * att::LUT_STRIDE, rel = j - 256, ar = rel < 0 ? -rel : rel;
                float v = 0.f; if (j <= 512) v = (hh < 8 && ar > 128) ? att::NEG : args.in[13][t5_bucket(rel) * 12 + hh] * LOG2E;
                lutg[i] = v; }
            for (int m = gw; m < T; m += 2 * NGW) {
                const int m2 = m + NGW;
                const GAS f32x4* xr = (const GAS f32x4*)(args.in[0] + (size_t)m * D) + lane0; const GAS f32x4* xr2 = (const GAS f32x4*)(args.in[0] + (size_t)m2 * D) + lane0;
                GAS unsigned long long* o8 = (GAS unsigned long long*)(xb + (size_t)m * D) + lane0; GAS unsigned long long* o82 = (GAS unsigned long long*)(xb + (size_t)m2 * D) + lane0;
                f32x4 va[4], vb[4];
#pragma unroll
                for (int j = 0; j < 4; ++j) { va[j] = xr[64 * j]; vb[j] = xr2[64 * j]; }
                float s = 0.f, s2 = 0.f;
#pragma unroll
                for (int j = 0; j < 4; ++j) { const f32x4 v = va[j], w = vb[j]; s += (v.x * v.x + v.y * v.y) + (v.z * v.z + v.w * v.w); s2 += (w.x * w.x + w.y * w.y) + (w.z * w.z + w.w * w.w);
                    o8[64 * j] = (unsigned long long)pk2(v.x, v.y) | ((unsigned long long)pk2(v.z, v.w) << 32); o82[64 * j] = (unsigned long long)pk2(w.x, w.y) | ((unsigned long long)pk2(w.z, w.w) << 32); }
                s = wave_sum(s); s2 = wave_sum(s2);
                ss16_store(ss, m, s, lane0); ss16_store(ss, m2, s2, lane0);
            }
        } else if (p == 1 && (MK_ONLY & 2)) {
            pg8::SchedStd S; S.init(xb, D, wl + WL_IN, D, T, ZG - 256, G, (int)blockIdx.x);
            S.fix = (rep == 0 && MK_VAR == 8) ? 1 : 0;
            pg8::EpiIn E{zg, ss1, args.in[3] + l * 64, args.in[4] + l * 64, args.in[6] + l * 64, args.in[7] + l * 64, args.in[15] + l * GW, (args.pad >> 25) & 1, 8 * ((int)blockIdx.x & 7) * 256};
            pg8::gemm_phase<pg8::EpiIn, pg8::SchedStd, true, true>(lds + RING_OFF, D, D, S, E);
        } else if (p == 2 && (MK_ONLY & 4)) {
            int lop = l; asm volatile("" : "+s"(lop));
            const float lam_init = 0.8f - 0.6f * __expf(-0.3f * (float)lop);
            int ln = threadIdx.x; asm volatile("" : "+v"(ln)); ln &= 63;
            const float d1 = wave_sum(args.in[8][l * 64 + ln] * args.in[9][l * 64 + ln]), d2 = wave_sum(args.in[10][l * 64 + ln] * args.in[11][l * 64 + ln]);
            const float lam = __expf(d1) - __expf(d2) + lam_init;
            if ((vcu & 3) == 0 && rep == 1) {
                pg8::SchedStd S1; S1.init(xb, D, wl + WL_IN, D, T, ZG, G, (int)blockIdx.x); S1.one = 1; S1.opm = 8 * (vcu >> 5) + ((vcu & 31) >> 2); S1.opn = 16;
                pg8::EpiIn E1{zg, ss1, args.in[3] + l * 64, args.in[4] + l * 64, args.in[6] + l * 64, args.in[7] + l * 64, args.in[15] + l * GW, 0, 8 * ((int)blockIdx.x & 7) * 256};
                pg8::gemm_phase<pg8::EpiIn, pg8::SchedStd, true, true>(lds + RING_OFF, D, D, S1, E1);
            }
            att::attn_tables(lds, lutg, args.in[12] + l * 128, 1.0f - lam_init);
            const int dsel = args.pad >> 16;
            if (rep == 1 || dsel != 2)
            for (int ui = vcu; ui < 512; ui += G) { const int bh = ui >> 4, qb = ui & 15; if (rep == 0 && MK_VAR == 7 && (vcu & 1)) {} else if (rep == 0) att::attn_unit<true, (MK_VAR == 7 ? 0 : MK_VAR)>(lds, zg, lutg, bh >> 2, bh & 3, qb * 128, nullptr, lam, 1.0f - lam_init, args.in[12] + l * 128, mix);
                else att::attn_unit<true, 0>(lds, zg, lutg, bh >> 2, bh & 3, qb * 128, nullptr, lam, 1.0f - lam_init, args.in[12] + l * 128, nullptr); }
            if (rep == 1 || dsel != 1) {
                unsigned* qctr = (unsigned*)(ctl + CW_Q + 64 * (2 * l + rep));
                for (;;) {
                    if (threadIdx.x == 0) MISC[4] = __hip_atomic_fetch_add(qctr, 1u, __ATOMIC_RELAXED, __HIP_MEMORY_SCOPE_AGENT);
                    __syncthreads();
                    const int ui = (int)MISC[4];
                    __syncthreads();
                    if (ui >= 512) break;
                    const int bk = ui >> 5, qb = ui & 31; att::attn_unit<false>(lds, zg, lutg, bk >> 1, bk & 1, qb * 64, args.in[5] + l * HA, 0.f, 0.f, nullptr, rep == 0 ? mix : nullptr);
                }
            }
        } else if (p == 3 && (MK_ONLY & 8)) {
            pg8::SchedMix S; S.b.init(zg + C_QA, ZG, wl + WL_A, 512, T, D, G, (int)blockIdx.x); S.A1 = (const char*)(zg + C_QB); S.Bt1 = (const char*)(wl + WL_B);
            pg8::EpiMix E{zg, mix};
            pg8::gemm_phase<pg8::EpiMix, pg8::SchedMix, true, true>(lds + RING_OFF, 512, ZG, S, E);
        } else if (p == 4 && (MK_ONLY & 16)) {
            pg8::SchedStd S; S.init(mix, D, wl + WL_O, D, T, D, G, (int)blockIdx.x);
            pg8::EpiRes E{l == 0 ? args.in[0] : xf, xf, xb, ss2};
            pg8::gemm_phase<pg8::EpiRes, pg8::SchedStd, true, true>(lds + RING_OFF, D, D, S, E);
        } else if (p == 5 && (MK_ONLY & 32)) {
            pg8::SchedStd S; S.init(xb, D, wl + WL_UP, D, T, FF2, G, (int)blockIdx.x);
            pg8::EpiUp E{abuf, ss2, args.in[21] + (size_t)l * 3 * FF2, args.in[22] + (size_t)l * FF2, yb, (args.pad >> 24) & 1, 8 * ((int)blockIdx.x & 7) * 256};
            pg8::gemm_phase<pg8::EpiUp, pg8::SchedStd, true, true>(lds + RING_OFF, D, D, S, E);
        } else if (MK_ONLY & 64) {
            pg8::SchedDown S; S.b.init(abuf, FF, wl + WL_DN, FF, T, D, G, (int)blockIdx.x); S.yb = (args.pad & 1) ? nullptr : yb; S.cw = args.in[21] + (size_t)l * 3 * FF2; S.cb = args.in[22] + (size_t)l * FF2; S.a = abuf;
            pg8::EpiRes E{xf, xf, ss3 ? xb : nullptr, ss3};
            pg8::gemm_phase<pg8::EpiRes, pg8::SchedDown, true, true>(lds + RING_OFF, FF, FF, S, E);
        }
        {
            int ph2 = ph; asm volatile("" : "+s"(ph2));
            const int l2 = ph2 > 0 ? (ph2 - 1) / 6 : 0, p2 = ph2 > 0 ? (ph2 - 1) % 6 + 1 : 0;
            const int G2 = gridDim.x, bx2 = blockIdx.x;
            int cl = -1, cw0 = 0, cnw = 1;
            if (p2 == 0) { cl = 0; cw0 = ((G2 % 8 == 0) ? (bx2 % 8) * (G2 / 8) + bx2 / 8 : bx2) * NWAVES; cnw = G2 * NWAVES; }
            else if (p2 == 5 && l2 + 1 < L && G2 == 256 && bx2 >= 128) { cl = l2 + 1; cw0 = (bx2 - 128) * NWAVES; cnw = 128 * NWAVES; }
            if (cl >= 0) {
                bf16* wbase2 = (bf16*)(args.ws + WS_W);
                int tid0 = threadIdx.x; asm volatile("" : "+v"(tid0));
                const int lane0 = tid0 & 63, wave = __builtin_amdgcn_readfirstlane(tid0 >> 6);
                LAS float* scr = (LAS float*)(lds + RING_OFF + wave * 16384);
                constexpr int I_IN = (D / 64) * (INW / 32), I_G = (D / 64) * (GW / 32), I_A = (512 / 64) * (D / 32), I_O = (D / 64) * (D / 32), I_UP = (D / 64) * (FF2 / 32), I_DN = (FF / 64) * (D / 32);
                constexpr int I_LAYER = I_IN + I_G + 2 * I_A + I_O + I_UP + I_DN;
                const int ll = cl; bf16* w = wbase2 + (size_t)ll * WL_END;
#pragma unroll 1
                for (int it = cw0 + wave; it < I_LAYER; it += cnw) {
                    int r = it;
                    if (r < I_IN) { const int nb = r % (INW / 32), kb = r / (INW / 32); p0_transpose_item(args.in[2] + (size_t)ll * D * INW, INW, D, 64 * kb, 32 * nb, w + WL_IN, vrow_in(32 * nb), args.in[1] + ll * D, scr, lane0); continue; } r -= I_IN;
                    if (r < I_G) { const int nb = r % (GW / 32), kb = r / (GW / 32); p0_transpose_item(args.in[14] + (size_t)ll * D * GW, GW, D, 64 * kb, 32 * nb, w + WL_IN, vrow_in(INW + 32 * nb), args.in[1] + ll * D, scr, lane0); continue; } r -= I_G;
                    if (r < I_A) { const int nb = r % (D / 32), kb = r / (D / 32); p0_transpose_item(args.in[16] + (size_t)ll * 512 * D, D, 512, 64 * kb, 32 * nb, w + WL_A, 32 * nb, nullptr, scr, lane0); continue; } r -= I_A;
                    if (r < I_A) { const int nb = r % (D / 32), kb = r / (D / 32); p0_transpose_item(args.in[17] + (size_t)ll * 512 * D, D, 512, 64 * kb, 32 * nb, w + WL_B, 32 * nb, nullptr, scr, lane0); continue; } r -= I_A;
                    if (r < I_O) { const int nb = r % (D / 32), kb = r / (D / 32); p0_transpose_item(args.in[18] + (size_t)ll * D * D, D, D, 64 * kb, 32 * nb, w + WL_O, 32 * nb, nullptr, scr, lane0); continue; } r -= I_O;
                    if (r < I_UP) { const int nb = r % (FF2 / 32), kb = r / (FF2 / 32); p0_transpose_item(args.in[20] + (size_t)ll * D * FF2, FF2, D, 64 * kb, 32 * nb, w + WL_UP, vrow_up(32 * nb), args.in[19] + ll * D, scr, lane0); continue; } r -= I_UP;
                    { const int nb = r % (D / 32), kb = r / (D / 32); p0_transpose_item(args.in[23] + (size_t)ll * FF * D, D, FF, 64 * kb, 32 * nb, w + WL_DN, 32 * nb, nullptr, scr, lane0); }
                }
            }
        }
        }
        if (ph + 1 < args.ph_hi) xcd_barrier(bar);
    }
}
}

extern "C" void kernel_launch(void* const* d_in, const int* in_sizes, int n_in, void* d_out, int out_size, void* d_ws, size_t ws_size, hipStream_t stream) {
    using namespace nv;
    static int grid = 0;
    if (grid == 0) {
        if (n_in != 24 || in_sizes[0] != T * D || out_size != T * D || ws_size < mk::WS_END) { fprintf(stderr, "kernel_launch: built for 24 inputs, x/out of %d floats, >= %zu bytes of workspace; got n_in %d, out %d, ws %zu; nothing launched\n", T * D, (size_t)mk::WS_END, n_in, out_size, ws_size); grid = -1; return; }
        int dev = 0, cus = 0, per_cu = 0;
        if (hipGetDevice(&dev) != hipSuccess || hipDeviceGetAttribute(&cus, hipDeviceAttributeMultiprocessorCount, dev) != hipSuccess) { fprintf(stderr, "kernel_launch: device query failed; nothing launched\n"); grid = -1; return; }
        if (hipFuncSetAttribute((const void*)mk::skel_fwd, hipFuncAttributeMaxDynamicSharedMemorySize, mk::LDS_BYTES) != hipSuccess) { fprintf(stderr, "kernel_launch: hipFuncSetAttribute failed (needs %d bytes of dynamic LDS)\n", mk::LDS_BYTES); grid = -1; return; }
        if (hipOccupancyMaxActiveBlocksPerMultiprocessor(&per_cu, (const void*)mk::skel_fwd, mk::NWAVES * 64, mk::LDS_BYTES) != hipSuccess || per_cu < 1) fprintf(stderr, "kernel_launch: note: occupancy query reports %d workgroups per CU\n", per_cu);
        (void)hipGetLastError();
        grid = cus;
        if (grid != 256) fprintf(stderr, "kernel_launch: the unit schedules are built for 256 CUs; this device reports %d\n", cus);
    }
    if (grid < 0) return;
    if (hipMemsetAsync((unsigned char*)d_ws + mk::WS_CTL, 0, mk::CTL_ZERO_BYTES, stream) != hipSuccess) { fprintf(stderr, "kernel_launch: memset of the control words failed; nothing launched\n"); return; }
    mk::Args a{};
    for (int i = 0; i < 24; ++i) a.in[i] = (const float*)d_in[i];
    a.out = (float*)d_out; a.ws = (unsigned char*)d_ws; a.ph_lo = 0; a.ph_hi = mk::N_PHASES; a.li = 0;
    a.pad = (MK_DUP << 8) | (MK_DSEL << 16);
    hipLaunchKernelGGL(mk::skel_fwd, dim3(grid), dim3(mk::NWAVES * 64), mk::LDS_BYTES, stream, a);
}
```

```cpp
#include <hip/hip_runtime.h>
#include <cstdio>
#include <cstdint>
#include <cmath>
#define MK_EDUP 0

namespace nv {
typedef unsigned short bf16;
constexpr int D = 1024, B = 8, S = 2048, T = B * S, L = 4;
constexpr int HA = 8, KVA = 2, HB = 4, HD = 64;
constexpr int INW = 2304, GW = 2048, ZG = INW + GW;
constexpr int FF = 2816, FF2 = 2 * FF;
constexpr int C_QA = 0, C_KA = 512, C_VA = 640, C_QB = 768, C_KB = 1280, C_VB = 1792, C_G = 2304;
constexpr float EPS = 1e-6f;
constexpr float LOG2E = 1.4426950408889634f;
constexpr float C2 = 0.125f * LOG2E;

__device__ __forceinline__ float bf2f(bf16 v) { return __uint_as_float(((unsigned)v) << 16); }
__device__ __forceinline__ bf16 f2bf(float f) { unsigned u = __float_as_uint(f); return (bf16)((u + 0x7fffu + ((u >> 16) & 1u)) >> 16); }
__device__ __forceinline__ float ldf(const float* p) { return *p; }
__device__ __forceinline__ float ldf(const bf16* p) { return bf2f(*p); }

__device__ __forceinline__ int t5_bucket(int rel) {
    const int n = rel < 0 ? -rel : rel; int v;
    if (n < 8) v = n; else if (n < 12) v = 8; else if (n < 16) v = 9; else if (n < 23) v = 10; else if (n < 32) v = 11;
    else if (n < 46) v = 12; else if (n < 64) v = 13; else if (n < 91) v = 14; else v = 15;
    return (rel > 0 ? 16 : 0) + v;
}
__device__ __forceinline__ float ss16(const float* ss, int t) { const float4* p = (const float4*)(ss + (size_t)t * 16); const float4 a = p[0], b = p[1], c = p[2], d = p[3];
    return ((a.x + a.y) + (a.z + a.w)) + ((b.x + b.y) + (b.z + b.w)) + ((c.x + c.y) + (c.z + c.w)) + ((d.x + d.y) + (d.z + d.w)); }
__device__ __forceinline__ float ss16_q(const float* ss, int t, int fq) { const float4 a = *(const float4*)(ss + (size_t)t * 16 + 4 * fq); float s = (a.x + a.y) + (a.z + a.w); s += __shfl_xor(s, 16); s += __shfl_xor(s, 32); return s; }
__device__ __forceinline__ void ss16_store(float* ss, int t, float s, int lane) { if (lane < 16) ss[(size_t)t * 16 + lane] = lane == 0 ? s : 0.f; }
__device__ __forceinline__ float wave_sum(float v) {
#pragma unroll
    for (int o = 1; o < 64; o <<= 1) v += __shfl_xor(v, o);
    return v;
}
__device__ __forceinline__ float wave_max(float v) {
#pragma unroll
    for (int o = 1; o < 64; o <<= 1) v = fmaxf(v, __shfl_xor(v, o));
    return v;
}

}


namespace pg8 {
using namespace nv;
#define PG8_LAS __attribute__((address_space(3)))
typedef unsigned short bf16_t;
typedef short bf16x8 __attribute__((ext_vector_type(8)));
typedef float f32x4 __attribute__((ext_vector_type(4)));
typedef unsigned u32x4 __attribute__((ext_vector_type(4)));
typedef unsigned u32x2 __attribute__((ext_vector_type(2)));
constexpr int BM = 256, BK = 64, HALF = 128, HTB = HALF * BK * 2  , STAGE_BYTES = 8 * HTB, NXCD = 8, WGM = 8;
constexpr int XOFF = 131072 + 1024;
constexpr int RTAB_OFF = XOFF + 8192;

__host__ __device__ __forceinline__ int lds_byte(int r, int c) { const int st = (r >> 4) * 2 + (c >> 5), rr = r & 15, cc = c & 31, ob = rr * 64 + cc * 2; return st * 1024 + (ob ^ (((ob >> 9) & 1) << 5)); }
__host__ __device__ __forceinline__ void stage_rc(int b, int& R, int& C) { const int st = b / 1024, sb = b % 1024, swz = sb ^ (((sb >> 9) & 1) << 5); R = (st >> 1) * 16 + swz / 64; C = (st & 1) * 32 + (swz % 64) / 2; }
__host__ __device__ __forceinline__ int perm32(int rho) { const int n = rho >> 4, i = rho & 15; return 8 * (i >> 2) + 4 * n + (i & 3); }

struct Unit { int pm, pn, z; };
typedef float f32x2 __attribute__((ext_vector_type(2))); typedef __bf16 bf16x2_t __attribute__((ext_vector_type(2)));
__device__ __forceinline__ unsigned cvt_pk_bf16(float lo, float hi) { f32x2 v = {lo, hi}; bf16x2_t b = __builtin_convertvector(v, bf16x2_t); return __builtin_bit_cast(unsigned, b); }
__device__ __forceinline__ float bflo(unsigned w) { return __uint_as_float(w << 16); }
__device__ __forceinline__ float bfhi(unsigned w) { return __uint_as_float(w & 0xffff0000u); }

struct SchedStd {
    int nM, nN, nwg, G, c, fix, one, opm, opn; const char* A; const char* Bt; size_t at, bt;
    __device__ void init(const void* A_, int lda, const void* Bt_, int K, int M, int N, int G_, int c_) { fix = 0; one = 0; opm = 0; opn = 0; nM = M / BM; nN = N / BM; nwg = nM * nN; G = G_; c = c_; A = (const char*)A_; Bt = (const char*)Bt_; at = (size_t)BM * lda * 2; bt = (size_t)BM * K * 2; }
    __device__ bool next(int i, Unit& u) const {
        if (one) { if (i > 0) return false; u.pm = opm; u.pn = opn; u.z = 0; return true; }
        const long L = (long)i * G + c; if (L >= nwg) return false;
        int wgid = (int)L; { const int q = nwg / NXCD, r = nwg % NXCD, xcd = wgid % NXCD, off = wgid / NXCD; wgid = (xcd < r ? xcd * (q + 1) : r * (q + 1) + (xcd - r) * q) + off; }
        const int nig = WGM * nN, gid = wgid / nig, fm = gid * WGM, gsz = (nM - fm) < WGM ? (nM - fm) : WGM;
        u.pm = fm + ((wgid % nig) % gsz); u.pn = (wgid % nig) / gsz; u.z = 0; if (fix) { u.pm = 0; u.pn = 0; } return true;
    }
    __device__ __forceinline__ const char* aptr(const Unit& u) const { return A + (size_t)u.pm * at; }
    __device__ __forceinline__ const char* bptr(const Unit& u) const { return Bt + (size_t)u.pn * bt; }
    __device__ __forceinline__ void a_ready(const Unit&) const {}
    __device__ __forceinline__ void done(const Unit&) const {}
};
struct SchedMix {
    SchedStd b; const char* A1; const char* Bt1;
    __device__ bool next(int i, Unit& u) const { if (!b.next(i >> 1, u)) return false; u.z = i & 1; return true; }
    __device__ __forceinline__ const char* aptr(const Unit& u) const { return (u.z ? A1 : b.A) + (size_t)u.pm * b.at; }
    __device__ __forceinline__ const char* bptr(const Unit& u) const { return (u.z ? Bt1 : b.Bt) + (size_t)u.pn * b.bt; }
    __device__ __forceinline__ void a_ready(const Unit&) const {}
    __device__ __forceinline__ void done(const Unit&) const {}
};
struct SchedDown {
    SchedStd b; const float* yb; const float* cw; const float* cb; bf16_t* a;
    __device__ bool next(int i, Unit& u) const { return b.next(i, u); }
    __device__ __forceinline__ const char* aptr(const Unit& u) const { return b.aptr(u); }
    __device__ __forceinline__ const char* bptr(const Unit& u) const { return b.bptr(u); }
    __device__ __forceinline__ void a_ready(const Unit& u) const {
        const int pm = u.pm;
        if (yb) {
            int t0 = threadIdx.x; asm volatile("" : "+v"(t0));
            const bool hasp = (pm & 7) != 0, hasn = (pm & 7) != 7;
#pragma unroll 1
            for (int g = 0; g < 3; ++g) {
                float yv[4][2][3], cv[4][2][4];
#pragma unroll
                for (int q = 0; q < 4; ++q) {
                    const int it = 4 * g + q;
                    if (it < 11) {
                        const int idx = t0 + 512 * it, which = idx >= FF ? 1 : 0, j = idx - which * FF;
#pragma unroll
                        for (int gs = 0; gs < 2; ++gs) {
                            const int col = gs * FF + j;
                            const float* r0 = yb + ((size_t)pm * 4 + (which ? 2 : -1)) * FF2 + col;
                            const bool v0 = which ? true : hasp, v2 = which ? hasn : true;
                            yv[q][gs][0] = v0 ? r0[0] : 0.f; yv[q][gs][1] = r0[FF2]; yv[q][gs][2] = v2 ? r0[2 * (size_t)FF2] : 0.f;
                            cv[q][gs][0] = cb[col]; cv[q][gs][1] = cw[col]; cv[q][gs][2] = cw[FF2 + col]; cv[q][gs][3] = cw[2 * FF2 + col];
                        }
                    }
                }
#pragma unroll
                for (int q = 0; q < 4; ++q) {
                    const int it = 4 * g + q;
                    if (it < 11) {
                        const int idx = t0 + 512 * it, which = idx >= FF ? 1 : 0, j = idx - which * FF;
                        float uv[2];
#pragma unroll
                        for (int gs = 0; gs < 2; ++gs) uv[gs] = cv[q][gs][0] + cv[q][gs][1] * yv[q][gs][0] + cv[q][gs][2] * yv[q][gs][1] + cv[q][gs][3] * yv[q][gs][2];
                        const float sg = uv[1] * __builtin_amdgcn_rcpf(1.0f + __builtin_amdgcn_exp2f(-uv[1] * LOG2E));
                        a[(size_t)(pm * BM + which * 255) * FF + j] = f2bf(sg * uv[0]);
                    }
                }
            }
        }
        asm volatile("s_waitcnt vmcnt(0)" ::: "memory");
        __builtin_amdgcn_s_barrier();
        asm volatile("" ::: "memory");
    }
    __device__ __forceinline__ void done(const Unit&) const {}
};

__device__ __forceinline__ void rtab_fill(PG8_LAS unsigned char* lds_, const float* __restrict__ ssx, int row0) {
    int t = threadIdx.x; asm volatile("" : "+v"(t));
    PG8_LAS float* rt = (PG8_LAS float*)(lds_ + RTAB_OFF);
    float v[4];
#pragma unroll
    for (int k = 0; k < 4; ++k) v[k] = ss16(ssx, row0 + t + 512 * k);
#pragma unroll
    for (int k = 0; k < 4; ++k) rt[t + 512 * k] = rsqrtf(v[k] * (1.0f / D) + EPS);
}
struct EpiIn {
    static constexpr bool PERM = true, AFTER_DRAIN = false;
    __device__ __forceinline__ void init(f32x4 (&acc)[2][2][4][2], const Unit&, int, int, int, int) const {
#pragma unroll
        for (int a = 0; a < 2; ++a)
#pragma unroll
            for (int b = 0; b < 2; ++b)
#pragma unroll
                for (int m = 0; m < 4; ++m)
#pragma unroll
                    for (int n = 0; n < 2; ++n) acc[a][b][m][n] = (f32x4){0.f, 0.f, 0.f, 0.f};
    }
    __device__ static constexpr bool zero_after(const Unit&) { return true; }
    bf16_t* zg; const float* ss; const float *qn_a, *kn_a, *qn_b, *kn_b, *bg; int dup, row0;
    __device__ __forceinline__ void prefill(PG8_LAS unsigned char* lds_) const { rtab_fill(lds_, ss, row0); }
    __device__ __forceinline__ void operator()(f32x4 (&acc)[2][2][4][2], const Unit& u, int wr, int wc, int fr, int fq, PG8_LAS unsigned char* lds_) const {
#pragma unroll
        for (int rep_ = 0; rep_ <= ((MK_EDUP & 2) ? 1 : 0); ++rep_) {
        if (rep_) {
#pragma unroll
            for (int ai = 0; ai < 2; ++ai)
#pragma unroll
                for (int bj = 0; bj < 2; ++bj)
#pragma unroll
                    for (int m = 0; m < 4; ++m)
#pragma unroll
                        for (int n = 0; n < 2; ++n) asm volatile("" : "+v"(acc[ai][bj][m][n]) :: "memory");
        }
        const int g = u.pn * 4 + wc, colb = u.pn * BM + wc * 64 + 8 * fq;
        const float* gain = nullptr; float sc = 1.f; int mode = 0;
        if (g < 8) { gain = qn_a; sc = C2; mode = 1; } else if (g < 10) { gain = kn_a; mode = 1; } else if (g < 12) { mode = 0; } else if (g < 20) { gain = qn_b; sc = C2; mode = 1; }
        else if (g < 28) { gain = kn_b; mode = 1; } else if (g < 36) { mode = 0; } else { mode = 2; }
        float rsv[2][4];
#pragma unroll
        for (int ai = 0; ai < 2; ++ai)
#pragma unroll
            for (int m = 0; m < 4; ++m) rsv[ai][m] = ((const PG8_LAS float*)(lds_ + RTAB_OFF))[(u.pm & 7) * BM + ai * HALF + wr * 64 + m * 16 + fr];
        f32x4 gv[2][2];
#pragma unroll
        for (int bj = 0; bj < 2; ++bj)
#pragma unroll
            for (int n = 0; n < 2; ++n) {
                if (mode == 1) gv[bj][n] = *(const f32x4*)(gain + 32 * bj + 8 * fq + 4 * n) * sc;
                else if (mode == 2) gv[bj][n] = *(const f32x4*)(bg + (colb - C_G) + 32 * bj + 4 * n);
                else gv[bj][n] = (f32x4){1.f, 1.f, 1.f, 1.f};
            }
#pragma unroll
        for (int ai = 0; ai < 2; ++ai)
#pragma unroll
            for (int m = 0; m < 4; ++m) {
                const int row = u.pm * BM + ai * HALF + wr * 64 + m * 16 + fr;
                const float rs = rsv[ai][m];
                f32x4 v[2][2];
#pragma unroll
                for (int bj = 0; bj < 2; ++bj)
#pragma unroll
                    for (int n = 0; n < 2; ++n) v[bj][n] = acc[ai][bj][m][n] * rs;
                if (mode == 1) {
                    float q = 0.f;
#pragma unroll
                    for (int bj = 0; bj < 2; ++bj)
#pragma unroll
                        for (int n = 0; n < 2; ++n) { const f32x4 x = v[bj][n]; q += (x[0] * x[0] + x[1] * x[1]) + (x[2] * x[2] + x[3] * x[3]); }
                    q += __shfl_xor(q, 16); q += __shfl_xor(q, 32);
                    const float r2 = rsqrtf(q * (1.0f / 64.0f) + EPS);
#pragma unroll
                    for (int bj = 0; bj < 2; ++bj)
#pragma unroll
                        for (int n = 0; n < 2; ++n) v[bj][n] = v[bj][n] * r2 * gv[bj][n];
                } else if (mode == 2) {
#pragma unroll
                    for (int bj = 0; bj < 2; ++bj)
#pragma unroll
                        for (int n = 0; n < 2; ++n) { f32x4 x = v[bj][n] + gv[bj][n];
#pragma unroll
                            for (int e = 0; e < 4; ++e) x[e] = __builtin_fmaxf(__builtin_amdgcn_rcpf(1.0f + __builtin_amdgcn_exp2f(-x[e] * LOG2E)), 9.5367431640625e-07f);
                            v[bj][n] = x; }
                }
                bf16_t* rowp = zg + (size_t)row * ZG + colb;
#pragma unroll
                for (int bj = 0; bj < 2; ++bj) { u32x4 w; w.x = cvt_pk_bf16(v[bj][0][0], v[bj][0][1]); w.y = cvt_pk_bf16(v[bj][0][2], v[bj][0][3]); w.z = cvt_pk_bf16(v[bj][1][0], v[bj][1][1]); w.w = cvt_pk_bf16(v[bj][1][2], v[bj][1][3]);
                    *(u32x4*)(rowp + 32 * bj) = w; }
            }
        }
    }
};
struct EpiMix {
    static constexpr bool PERM = true, AFTER_DRAIN = false;
    __device__ __forceinline__ void prefill(PG8_LAS unsigned char*) const {}
    __device__ __forceinline__ void init(f32x4 (&acc)[2][2][4][2], const Unit&, int, int, int, int) const {
#pragma unroll
        for (int a = 0; a < 2; ++a)
#pragma unroll
            for (int b = 0; b < 2; ++b)
#pragma unroll
                for (int m = 0; m < 4; ++m)
#pragma unroll
                    for (int n = 0; n < 2; ++n) acc[a][b][m][n] = (f32x4){0.f, 0.f, 0.f, 0.f};
    }
    __device__ static bool zero_after(const Unit& u) { return u.z != 0; }
    const bf16_t* zg; bf16_t* mix;
    __device__ __forceinline__ void operator()(f32x4 (&acc)[2][2][4][2], const Unit& u, int wr, int wc, int fr, int fq, PG8_LAS unsigned char*) const {
        const int col0 = u.pn * BM + wc * 32 + 8 * fq;
#pragma unroll
        for (int ai = 0; ai < 2; ++ai) {
            u32x4 gbv[4][2], gav[4][2];
#pragma unroll
            for (int m = 0; m < 4; ++m)
#pragma unroll
                for (int bj = 0; bj < 2; ++bj) { const size_t go = (size_t)(u.pm * BM + ai * HALF + wr * 64 + m * 16 + fr) * ZG + C_G + col0 + bj * HALF;
                    gbv[m][bj] = *(const u32x4*)(zg + go + D); if (u.z == 0) gav[m][bj] = *(const u32x4*)(zg + go); else gav[m][bj] = (u32x4){0u, 0u, 0u, 0u}; }
#pragma unroll
            for (int m = 0; m < 4; ++m) {
                const int row = u.pm * BM + ai * HALF + wr * 64 + m * 16 + fr;
#pragma unroll
                for (int bj = 0; bj < 2; ++bj) {
                    const int col = col0 + bj * HALF;
                    const u32x4 gb = gbv[m][bj];
                    if (u.z == 0) {
                        const u32x4 ga = gav[m][bj];
                        f32x4 r0, r1;
                        r0[0] = bflo(ga.x) * __builtin_amdgcn_rcpf(bflo(gb.x)); r0[1] = bfhi(ga.x) * __builtin_amdgcn_rcpf(bfhi(gb.x)); r0[2] = bflo(ga.y) * __builtin_amdgcn_rcpf(bflo(gb.y)); r0[3] = bfhi(ga.y) * __builtin_amdgcn_rcpf(bfhi(gb.y));
                        r1[0] = bflo(ga.z) * __builtin_amdgcn_rcpf(bflo(gb.z)); r1[1] = bfhi(ga.z) * __builtin_amdgcn_rcpf(bfhi(gb.z)); r1[2] = bflo(ga.w) * __builtin_amdgcn_rcpf(bflo(gb.w)); r1[3] = bfhi(ga.w) * __builtin_amdgcn_rcpf(bfhi(gb.w));
                        acc[ai][bj][m][0] *= r0; acc[ai][bj][m][1] *= r1;
                    } else {
                        const f32x4 v0 = acc[ai][bj][m][0] * (f32x4){bflo(gb.x), bfhi(gb.x), bflo(gb.y), bfhi(gb.y)}, v1 = acc[ai][bj][m][1] * (f32x4){bflo(gb.z), bfhi(gb.z), bflo(gb.w), bfhi(gb.w)};
                        u32x4 w; w.x = cvt_pk_bf16(v0[0], v0[1]); w.y = cvt_pk_bf16(v0[2], v0[3]); w.z = cvt_pk_bf16(v1[0], v1[1]); w.w = cvt_pk_bf16(v1[2], v1[3]);
                        *(u32x4*)(mix + (size_t)row * D + col) = w;
                    }
                }
            }
            asm volatile("" ::: "memory");
        }
    }
};
struct EpiRes {
    static constexpr bool PERM = false, AFTER_DRAIN = false;
    __device__ __forceinline__ void prefill(PG8_LAS unsigned char*) const {}
    __device__ static constexpr bool zero_after(const Unit&) { return true; }
    const float* base; float* xf; bf16_t* xb; float* ssn;
    __device__ __forceinline__ void init(f32x4 (&acc)[2][2][4][2], const Unit& u, int wr, int wc, int fr, int fq) const {
        const int col0 = u.pn * BM + wc * 32 + 4 * fq;
#pragma unroll
        for (int ai = 0; ai < 2; ++ai)
#pragma unroll
            for (int m = 0; m < 4; ++m) { const size_t off = (size_t)(u.pm * BM + ai * HALF + wr * 64 + m * 16 + fr) * D + col0;
#pragma unroll
                for (int bj = 0; bj < 2; ++bj)
#pragma unroll
                    for (int n = 0; n < 2; ++n) acc[ai][bj][m][n] = *(const f32x4*)(base + off + bj * HALF + n * 16); }
    }
    __device__ __forceinline__ void operator()(f32x4 (&acc)[2][2][4][2], const Unit& u, int wr, int wc, int fr, int fq, PG8_LAS unsigned char*) const {
        const int col0 = u.pn * BM + wc * 32 + 4 * fq;
#pragma unroll
        for (int ai = 0; ai < 2; ++ai)
#pragma unroll
            for (int m = 0; m < 4; ++m) {
                const int row = u.pm * BM + ai * HALF + wr * 64 + m * 16 + fr; const size_t off = (size_t)row * D + col0; float q = 0.f;
#pragma unroll
                for (int bj = 0; bj < 2; ++bj)
#pragma unroll
                    for (int n = 0; n < 2; ++n) { const f32x4 o = acc[ai][bj][m][n];
                        *(f32x4*)(xf + off + bj * HALF + n * 16) = o; q += (o[0] * o[0] + o[1] * o[1]) + (o[2] * o[2] + o[3] * o[3]);
                        if (xb) { u32x2 w; w.x = cvt_pk_bf16(o[0], o[1]); w.y = cvt_pk_bf16(o[2], o[3]); *(u32x2*)(xb + off + bj * HALF + n * 16) = w; } }
                if (ssn) { q += __shfl_xor(q, 16); q += __shfl_xor(q, 32); if (fq == 0) ssn[(size_t)row * 16 + u.pn * 4 + wc] = q; }
            }
    }
};
#define DPPF(oldv, src, ctrl, bc) __int_as_float(__builtin_amdgcn_update_dpp(__float_as_int(oldv), __float_as_int(src), (ctrl), 0xF, 0xF, (bc)))
struct EpiUp {
    static constexpr bool PERM = true, AFTER_DRAIN = false;
    __device__ __forceinline__ void init(f32x4 (&acc)[2][2][4][2], const Unit&, int, int, int, int) const {
#pragma unroll
        for (int a = 0; a < 2; ++a)
#pragma unroll
            for (int b = 0; b < 2; ++b)
#pragma unroll
                for (int m = 0; m < 4; ++m)
#pragma unroll
                    for (int n = 0; n < 2; ++n) acc[a][b][m][n] = (f32x4){0.f, 0.f, 0.f, 0.f};
    }
    __device__ static constexpr bool zero_after(const Unit&) { return true; }
    bf16_t* a; const float* ss; const float* cw; const float* cb; float* yb; int dup, row0;
    __device__ __forceinline__ void prefill(PG8_LAS unsigned char* lds_) const { rtab_fill(lds_, ss, row0); }
    __device__ __forceinline__ void operator()(f32x4 (&acc)[2][2][4][2], const Unit& u, int wr, int wc, int fr, int fq, PG8_LAS unsigned char* lds) const {
        PG8_LAS unsigned char* lds_ = lds; const int wid = wr * 4 + wc;
        PG8_LAS float* X = (PG8_LAS float*)(lds + XOFF);
        float rsv[2][4];
#pragma unroll
        for (int ai = 0; ai < 2; ++ai)
#pragma unroll
            for (int m = 0; m < 4; ++m) rsv[ai][m] = ((const PG8_LAS float*)(lds_ + RTAB_OFF))[(u.pm & 7) * BM + ai * HALF + wr * 64 + m * 16 + fr];
#pragma unroll
        for (int ai = 0; ai < 2; ++ai)
#pragma unroll
            for (int m = 0; m < 4; ++m) {
#pragma unroll
                for (int bj = 0; bj < 2; ++bj)
#pragma unroll
                    for (int n = 0; n < 2; ++n) acc[ai][bj][m][n] *= rsv[ai][m];
            }
#pragma unroll
        for (int ai = 0; ai < 2; ++ai) {
            if (fr == 0) {
#pragma unroll
                for (int bj = 0; bj < 2; ++bj)
#pragma unroll
                    for (int n = 0; n < 2; ++n) *(PG8_LAS f32x4*)(X + ((wid * 2 + ai) * 2 + 0) * 64 + 32 * bj + 8 * fq + 4 * n) = acc[ai][bj][0][n];
            }
            if (fr == 15) {
#pragma unroll
                for (int bj = 0; bj < 2; ++bj)
#pragma unroll
                    for (int n = 0; n < 2; ++n) *(PG8_LAS f32x4*)(X + ((wid * 2 + ai) * 2 + 1) * 64 + 32 * bj + 8 * fq + 4 * n) = acc[ai][bj][3][n];
            }
        }
        {
            const int ccol = u.pn * 128 + wc * 32 + 8 * fq;
            if (wr == 0 && fr < 2) {
#pragma unroll
                for (int bj = 0; bj < 2; ++bj)
#pragma unroll
                    for (int n = 0; n < 2; ++n) *(f32x4*)(yb + ((size_t)u.pm * 4 + fr) * FF2 + bj * FF + ccol + 4 * n) = acc[0][bj][0][n];
            }
            if (wr == 1 && fr >= 14) {
#pragma unroll
                for (int bj = 0; bj < 2; ++bj)
#pragma unroll
                    for (int n = 0; n < 2; ++n) *(f32x4*)(yb + ((size_t)u.pm * 4 + 2 + (fr - 14)) * FF2 + bj * FF + ccol + 4 * n) = acc[1][bj][3][n];
            }
        }
        asm volatile("s_waitcnt lgkmcnt(0)" ::: "memory"); __builtin_amdgcn_s_barrier(); asm volatile("" ::: "memory");
#pragma unroll
        for (int rep_ = 0; rep_ <= ((MK_EDUP & 1) ? 1 : 0); ++rep_) {
        if (rep_) {
#pragma unroll
            for (int ai = 0; ai < 2; ++ai)
#pragma unroll
                for (int bj = 0; bj < 2; ++bj)
#pragma unroll
                    for (int m = 0; m < 4; ++m)
#pragma unroll
                        for (int n = 0; n < 2; ++n) asm volatile("" : "+v"(acc[ai][bj][m][n]) :: "memory");
        }
#pragma unroll
        for (int n = 0; n < 2; ++n) {
            const int ccol = u.pn * 128 + wc * 32 + 8 * fq + 4 * n;
            f32x4 w0[2], w1[2], w2[2], bb[2];
#pragma unroll
            for (int bj = 0; bj < 2; ++bj) { w0[bj] = *(const f32x4*)(cw + bj * FF + ccol); w1[bj] = *(const f32x4*)(cw + FF2 + bj * FF + ccol); w2[bj] = *(const f32x4*)(cw + 2 * FF2 + bj * FF + ccol); bb[bj] = *(const f32x4*)(cb + bj * FF + ccol); }
#pragma unroll
            for (int ai = 0; ai < 2; ++ai) {
                const int pw = wr ? wid - 4 : wid + 4, pai = wr ? ai : 0;
                const int nw = wr ? wid - 4 : wid + 4, nai = wr ? 1 : ai;
                f32x4 xp[2], xn[2];
#pragma unroll
                for (int bj = 0; bj < 2; ++bj) { xp[bj] = *(PG8_LAS f32x4*)(X + ((pw * 2 + pai) * 2 + 1) * 64 + 32 * bj + 8 * fq + 4 * n); xn[bj] = *(PG8_LAS f32x4*)(X + ((nw * 2 + nai) * 2 + 0) * 64 + 32 * bj + 8 * fq + 4 * n); }
#pragma unroll
                for (int m = 0; m < 4; ++m) {
                    const int trow = ai * HALF + wr * 64 + m * 16 + fr;
                    float uv[2][4];
#pragma unroll
                    for (int bj = 0; bj < 2; ++bj)
#pragma unroll
                        for (int e = 0; e < 4; ++e) {
                            const float cur = acc[ai][bj][m][n][e];
                            float rp, rn;
                            if (m > 0) rp = DPPF(0.f, acc[ai][bj][m > 0 ? m - 1 : 0][n][e], 0x121, true); else rp = xp[bj][e];
                            if (m < 3) rn = DPPF(0.f, acc[ai][bj][m < 3 ? m + 1 : 3][n][e], 0x12F, true); else rn = xn[bj][e];
                            const float prev = DPPF(rp, cur, 0x111, false), next = DPPF(rn, cur, 0x101, false);
                            uv[bj][e] = bb[bj][e] + w0[bj][e] * prev + w1[bj][e] * cur + w2[bj][e] * next;
                        }
                    f32x4 o;
#pragma unroll
                    for (int e = 0; e < 4; ++e) o[e] = uv[0][e] * uv[1][e] * __builtin_amdgcn_rcpf(1.0f + __builtin_amdgcn_exp2f(-uv[1][e] * LOG2E));
                    u32x2 w; w.x = cvt_pk_bf16(o[0], o[1]); w.y = cvt_pk_bf16(o[2], o[3]);
                    if (trow != 0 && trow != 255) *(u32x2*)(a + (size_t)(u.pm * BM + trow) * FF + ccol) = w;
                    asm volatile("" ::: "memory");
                }
            }
        }
        }
    }
};

template <class Epi, class Sched, bool ALIGN_EPI = false, bool SP2 = false>
__device__ __forceinline__ void gemm_phase(PG8_LAS unsigned char* lds, const int K, const int lda, const Sched& S, const Epi& E) {
    int tid_ = threadIdx.x; asm volatile("" : "+v"(tid_));
    const int tid = tid_, wid = __builtin_amdgcn_readfirstlane(tid >> 6), lane = tid & 63, wr = wid >> 2, wc = wid & 3, fr = lane & 15, fq = lane >> 4;
    const int nt = K / BK;
    unsigned voffA[2], voffB[2];
#pragma unroll
    for (int i = 0; i < 2; ++i) { int R, C; stage_rc(tid * 16 + i * 8192, R, C); const int Rb = Epi::PERM ? ((R & ~31) + perm32(R & 31)) : R;
        voffA[i] = (unsigned)(R * lda + C) * 2u; voffB[i] = (unsigned)(Rb * K + C) * 2u; }
    const size_t kstep = (size_t)(BK * 2);
    const size_t hstepB = (size_t)HALF * K * 2;
    const size_t hstepA = (size_t)HALF * lda * 2;
    const unsigned ldsw = (unsigned)wid * 1024u;
    const int aoff = lds_byte(wr * 64 + fr, fq * 8), boff = lds_byte(wc * 32 + fr, fq * 8);
#define PG8_SA(b, h) (((b) * 2 + (h)) * HTB)
#define PG8_SB(b, h) ((4 + (b) * 2 + (h)) * HTB)
#define PG8_STAGE(bufoff, gbase, voff) do { _Pragma("unroll") for (int _i = 0; _i < 2; ++_i) \
        __builtin_amdgcn_global_load_lds((const unsigned*)((const char*)(gbase) + (voff)[_i]), (PG8_LAS unsigned*)(lds + (bufoff) + ldsw + _i * 8192), 16, 0, 0); } while (0)
#define PG8_LDA(dst, b, h) do { _Pragma("unroll") for (int m = 0; m < 4; ++m) _Pragma("unroll") for (int k = 0; k < 2; ++k) dst[m][k] = *(const PG8_LAS bf16x8*)(lds + PG8_SA(b, h) + aoff + m * 2048 + k * 1024); } while (0)
#define PG8_LDB(dst, b, h) do { _Pragma("unroll") for (int n = 0; n < 2; ++n) _Pragma("unroll") for (int k = 0; k < 2; ++k) dst[n][k] = *(const PG8_LAS bf16x8*)(lds + PG8_SB(b, h) + boff + n * 2048 + k * 1024); } while (0)
#define PG8_MMA(ai, bj, At, Bt) do { __builtin_amdgcn_s_setprio(1); _Pragma("unroll") for (int m = 0; m < 4; ++m) _Pragma("unroll") for (int n = 0; n < 2; ++n) _Pragma("unroll") for (int k = 0; k < 2; ++k) \
        acc[ai][bj][m][n] = __builtin_amdgcn_mfma_f32_16x16x32_bf16(Bt[n][k], At[m][k], acc[ai][bj][m][n], 0, 0, 0); __builtin_amdgcn_s_setprio(0); } while (0)
#define PG8_WAIT_V(n) asm volatile("s_waitcnt vmcnt(" #n ")" ::: "memory")
#define PG8_WAIT_L(n) asm volatile("s_waitcnt lgkmcnt(" #n ")" ::: "memory")
#define PG8_BAR __builtin_amdgcn_s_barrier()
#define PG8_SCHED __builtin_amdgcn_sched_barrier(0)
    Unit cur, nxt; int ui = 0;
    if (!S.next(0, cur)) return;
    f32x4 acc[2][2][4][2];
    E.init(acc, cur, wr, wc, fr, fq);
    bf16x8 At[4][2], B0[2][2], B1[2][2];
    const char* cA = S.aptr(cur); const char* cB = S.bptr(cur);
    S.a_ready(cur);
    if constexpr (SP2) {
        PG8_STAGE(PG8_SB(0, 0), cB, voffB); PG8_STAGE(PG8_SB(0, 1), cB + hstepB, voffB); PG8_STAGE(PG8_SA(0, 0), cA, voffA); PG8_STAGE(PG8_SA(0, 1), cA + hstepA, voffA);
        E.prefill(lds);
        if (wr == 1) PG8_BAR;
        PG8_WAIT_V(2); PG8_BAR;
        PG8_STAGE(PG8_SB(1, 0), cB + kstep, voffB); PG8_STAGE(PG8_SA(1, 0), cA + kstep, voffA); PG8_STAGE(PG8_SB(1, 1), cB + hstepB + kstep, voffB);
        PG8_WAIT_V(6); PG8_BAR;
    } else {
        PG8_STAGE(PG8_SB(0, 0), cB, voffB); PG8_STAGE(PG8_SA(0, 0), cA, voffA); PG8_STAGE(PG8_SB(0, 1), cB + hstepB, voffB); PG8_STAGE(PG8_SA(0, 1), cA + hstepA, voffA);
        E.prefill(lds);
        if (wr == 1) PG8_BAR;
        PG8_WAIT_V(4); PG8_BAR;
        PG8_STAGE(PG8_SB(1, 0), cB + kstep, voffB); PG8_STAGE(PG8_SA(1, 0), cA + kstep, voffA); PG8_STAGE(PG8_SB(1, 1), cB + hstepB + kstep, voffB);
        PG8_WAIT_V(6); PG8_BAR;
    }
    for (;;) {
        const bool has_next = S.next(ui + 1, nxt);
        const char* nA = has_next ? S.aptr(nxt) : cA; const char* nB = has_next ? S.bptr(nxt) : cB;
        for (int t = 0; t < nt; t += 2) {
            const bool last = (t == nt - 2);
            const char* a1 = cA + (size_t)(t + 1) * kstep;
            const char* a2 = last ? nA : cA + (size_t)(t + 2) * kstep; const char* b2 = last ? nB : cB + (size_t)(t + 2) * kstep;
            const char* a3 = a2 + kstep; const char* b3 = b2 + kstep;
            if (last && has_next) S.a_ready(nxt);
            if constexpr (SP2) {
            PG8_LDB(B0, 0, 0); PG8_LDB(B1, 0, 1); PG8_SCHED; PG8_LDA(At, 0, 0); PG8_STAGE(PG8_SA(1, 1), a1 + hstepA, voffA);
            PG8_WAIT_V(8); PG8_WAIT_L(0); PG8_BAR; PG8_MMA(0, 0, At, B0); PG8_MMA(0, 1, At, B1); PG8_BAR; PG8_SCHED;
            PG8_LDA(At, 0, 1); PG8_STAGE(PG8_SB(0, 0), b2, voffB); PG8_STAGE(PG8_SB(0, 1), b2 + hstepB, voffB); PG8_STAGE(PG8_SA(0, 0), a2, voffA);
            PG8_WAIT_V(8); PG8_WAIT_L(0); PG8_BAR; PG8_MMA(1, 0, At, B0); PG8_MMA(1, 1, At, B1); PG8_BAR; PG8_SCHED;
            PG8_LDB(B0, 1, 0); PG8_LDB(B1, 1, 1); PG8_SCHED; PG8_LDA(At, 1, 0); PG8_STAGE(PG8_SA(0, 1), a2 + hstepA, voffA);
            PG8_WAIT_V(8); PG8_WAIT_L(0); PG8_BAR; PG8_MMA(0, 0, At, B0); PG8_MMA(0, 1, At, B1); PG8_BAR; PG8_SCHED;
            PG8_LDA(At, 1, 1); PG8_STAGE(PG8_SB(1, 0), b3, voffB); PG8_STAGE(PG8_SB(1, 1), b3 + hstepB, voffB); PG8_STAGE(PG8_SA(1, 0), a3, voffA);
            PG8_WAIT_V(8); PG8_WAIT_L(0); PG8_BAR; PG8_MMA(1, 0, At, B0); PG8_MMA(1, 1, At, B1); PG8_BAR; PG8_SCHED;
            } else {
            PG8_LDB(B0, 0, 0); PG8_SCHED; PG8_LDA(At, 0, 0); PG8_STAGE(PG8_SA(1, 1), a1 + hstepA, voffA);
            PG8_WAIT_L(8); PG8_BAR; PG8_WAIT_L(0); PG8_MMA(0, 0, At, B0); PG8_BAR; PG8_SCHED;
            PG8_LDB(B1, 0, 1); PG8_STAGE(PG8_SB(0, 0), b2, voffB);
            PG8_BAR; PG8_WAIT_L(0); PG8_MMA(0, 1, At, B1); PG8_BAR;
            PG8_LDA(At, 0, 1); PG8_STAGE(PG8_SA(0, 0), a2, voffA);
            PG8_BAR; PG8_WAIT_L(0); PG8_MMA(1, 0, At, B0); PG8_BAR; PG8_SCHED;
            PG8_STAGE(PG8_SB(0, 1), b2 + hstepB, voffB);
            PG8_WAIT_V(6); PG8_BAR; PG8_MMA(1, 1, At, B1); PG8_BAR;
            PG8_LDB(B0, 1, 0); PG8_SCHED; PG8_LDA(At, 1, 0); PG8_STAGE(PG8_SA(0, 1), a2 + hstepA, voffA);
            PG8_WAIT_L(8); PG8_BAR; PG8_WAIT_L(0); PG8_MMA(0, 0, At, B0); PG8_BAR; PG8_SCHED;
            PG8_LDB(B1, 1, 1); PG8_STAGE(PG8_SB(1, 0), b3, voffB);
            PG8_BAR; PG8_WAIT_L(0); PG8_MMA(0, 1, At, B1); PG8_BAR;
            PG8_LDA(At, 1, 1); PG8_STAGE(PG8_SA(1, 0), a3, voffA);
            PG8_BAR; PG8_WAIT_L(0); PG8_MMA(1, 0, At, B0); PG8_BAR; PG8_SCHED;
            PG8_STAGE(PG8_SB(1, 1), b3 + hstepB, voffB);
            PG8_WAIT_V(6); PG8_BAR; PG8_MMA(1, 1, At, B1); PG8_BAR;
            }
        }
        if constexpr (ALIGN_EPI) { if (wr == 0) PG8_BAR; }
        if constexpr (!Epi::AFTER_DRAIN) { E(acc, cur, wr, wc, fr, fq, lds); S.done(cur); }
        if (!has_next) break;
        if (Epi::zero_after(cur)) E.init(acc, nxt, wr, wc, fr, fq);
        cur = nxt; cA = nA; cB = nB; ++ui;
        if constexpr (ALIGN_EPI) { if (wr == 1) PG8_BAR; }
    }
    PG8_WAIT_V(0);
    if constexpr (!ALIGN_EPI) { if (wr == 0) PG8_BAR; }
    PG8_BAR;
    if constexpr (Epi::AFTER_DRAIN) { E.fused(acc, cur, wr, wc, fr, fq, lds, wid, lane); S.done(cur); }
#undef PG8_SA
#undef PG8_SB
#undef PG8_STAGE
#undef PG8_LDA
#undef PG8_LDB
#undef PG8_MMA
#undef PG8_WAIT_V
#undef PG8_WAIT_L
#undef PG8_BAR
#undef PG8_SCHED
}
}

namespace att {
using namespace nv;
#define ALAS __attribute__((address_space(3)))
typedef short bf16x8 __attribute__((ext_vector_type(8)));
typedef short s16x4 __attribute__((ext_vector_type(4)));
typedef float f32x16 __attribute__((ext_vector_type(16)));
typedef float f32x4 __attribute__((ext_vector_type(4)));
typedef unsigned u32x4 __attribute__((ext_vector_type(4)));
typedef unsigned u32x2 __attribute__((ext_vector_type(2)));
typedef short v4i16_t __attribute__((ext_vector_type(4)));
typedef float f32x2_t __attribute__((ext_vector_type(2))); typedef __bf16 bf16x2_t __attribute__((ext_vector_type(2)));
constexpr int LUT_OFF = 98304, LUT_STRIDE = 520, GT_OFF = LUT_OFF + 12 * LUT_STRIDE * 4;
static_assert(GT_OFF + 512 <= 131072, "attention tables inside the ring region");
constexpr float NEG = -30000.f, THR = 6.f;
__device__ __forceinline__ unsigned cvtpk(float lo, float hi) { f32x2_t v = {lo, hi}; bf16x2_t b = __builtin_convertvector(v, bf16x2_t); return __builtin_bit_cast(unsigned, b); }
__device__ __forceinline__ s16x4 vtr(ALAS const unsigned char* p) { return __builtin_bit_cast(s16x4, __builtin_amdgcn_ds_read_tr16_b64_v4i16((ALAS v4i16_t*)p)); }
__device__ __forceinline__ void glds16(const void* gsrc, unsigned lds_dst) { unsigned keep;
    asm volatile("s_mov_b32 %0, m0\n\ts_mov_b32 m0, %2\n\ts_nop 0\n\tglobal_load_lds_dwordx4 %1, off\n\ts_mov_b32 m0, %0" : "=&s"(keep) : "v"(gsrc), "s"(lds_dst) : "memory"); }
__device__ __forceinline__ float swap_add(float v) { auto rr = __builtin_amdgcn_permlane32_swap(__float_as_uint(v), __float_as_uint(v), false, false); return __uint_as_float(rr[0]) + __uint_as_float(rr[1]); }
__device__ __forceinline__ float swap_max(float v) { auto rr = __builtin_amdgcn_permlane32_swap(__float_as_uint(v), __float_as_uint(v), false, false); return fmaxf(__uint_as_float(rr[0]), __uint_as_float(rr[1])); }
#define MX3(a, b, c) __builtin_fmaxf(__builtin_fmaxf((a), (b)), (c))

__device__ __forceinline__ void attn_tables(ALAS unsigned char* lds, const float* __restrict__ lutg, const float* __restrict__ subg, float osc) {
    int tid = threadIdx.x; asm volatile("" : "+v"(tid));
    ALAS float* lut = (ALAS float*)(lds + LUT_OFF); ALAS float* gt = (ALAS float*)(lds + GT_OFF);
    {
        typedef float lf4 __attribute__((ext_vector_type(4)));
        static_assert((12 * LUT_STRIDE) % 4 == 0 && 12 * LUT_STRIDE / 4 <= 4 * 512, "lut copy");
        const lf4* src = (const lf4*)lutg; lf4 v[4];
#pragma unroll
        for (int k = 0; k < 4; ++k) { const int i = tid + 512 * k; if (i < 12 * LUT_STRIDE / 4) v[k] = src[i]; }
#pragma unroll
        for (int k = 0; k < 4; ++k) { const int i = tid + 512 * k; if (i < 12 * LUT_STRIDE / 4) ((ALAS lf4*)lut)[i] = v[k]; }
    }
    if (tid < 128) gt[tid] = subg[tid] * osc;
    __syncthreads();
}
__device__ __forceinline__ float g4_max(float v) { v = fmaxf(v, __shfl_xor(v, 16)); return fmaxf(v, __shfl_xor(v, 32)); }
__device__ __forceinline__ float g4_sum(float v) { v += __shfl_xor(v, 16); return v + __shfl_xor(v, 32); }

template <bool ISB, int VAR = 0>
__device__ __forceinline__ void attn_unit(ALAS unsigned char* lds, bf16* zg, const float* __restrict__ lutg, int b, int hsel, int q0, const float* __restrict__ sinkp, float lam, float osc, const float* __restrict__ subg, bf16* odry) {
    int tid_ = threadIdx.x; asm volatile("" : "+v"(tid_));
    const int tid = tid_, lane = tid & 63, c16 = lane & 15, g = lane >> 4; const int wid = __builtin_amdgcn_readfirstlane(tid >> 6);
    constexpr int NDVB = ISB ? 8 : 4, BUF = ISB ? 32768 : 16384, VOFF = ISB ? 16384 : 8192, VROW = ISB ? 256 : 128;
    const int map = ISB ? (wid >> 2) : 0, qsub = ISB ? (wid & 3) : (wid & 1), gsel = ISB ? 0 : (wid >> 1);
    const int head = ISB ? hsel : hsel * 4 + gsel;
    const int qrow0 = q0 + 32 * qsub;
    const int qcol = ISB ? (C_QB + head * 128 + map * 64) : (C_QA + head * 64);
    const int kcol = ISB ? (C_KB + head * 128) : (C_KA + hsel * 64);
    const int vcol = ISB ? (C_VB + head * 128) : (C_VA + hsel * 64);
    const size_t rowbase = (size_t)b * S;
    int kt0 = 0, kt1 = S / 64;
    if (!ISB) { kt0 = q0 / 64 - 2; if (kt0 < 0) kt0 = 0; kt1 = q0 / 64 + 3; if (kt1 > S / 64) kt1 = S / 64; }
    const int nt = kt1 - kt0;
    ALAS float* lut = (ALAS float*)(lds + LUT_OFF) + (ISB ? 8 + head : hsel * 4 + gsel) * LUT_STRIDE;
    ALAS float* gt = (ALAS float*)(lds + GT_OFF);
    const float sink2 = ISB ? 0.f : sinkp[head] * LOG2E;
    bf16x8 qr[2][2];
#pragma unroll
    for (int qb = 0; qb < 2; ++qb) { const bf16* qp = zg + (rowbase + qrow0 + 16 * qb + c16) * ZG + qcol + 8 * g;
#pragma unroll
        for (int ks = 0; ks < 2; ++ks) qr[qb][ks] = *(const bf16x8*)(qp + 32 * ks); }
    const unsigned lds0 = (unsigned)(size_t)lds;
    const bf16* kp_[2]; const bf16* vp_[2];
#pragma unroll
    for (int i_ = 0; i_ < 2; ++i_) { const int p_ = ISB ? wid * 2 + i_ : wid;
        kp_[i_] = zg + (rowbase + (size_t)kt0 * 64 + (p_ & 7) * 8 + (lane >> 3)) * ZG + kcol + (ISB ? (p_ >> 3) * 64 : 0) + ((lane & 7) ^ (lane >> 3)) * 8;
        vp_[i_] = ISB ? zg + (rowbase + (size_t)kt0 * 64 + 4 * p_ + (lane >> 4)) * ZG + vcol + ((((lane & 15) >> 1) ^ (4 * (p_ & 1) + (lane >> 4))) * 16) + 8 * (lane & 1)
                      : zg + (rowbase + (size_t)kt0 * 64 + 8 * p_ + (lane >> 3)) * ZG + vcol + ((((lane & 7) >> 1) ^ ((lane >> 4) & 3)) * 16) + 8 * (lane & 1); }
#define ATT_ISSUE(bo) do { \
        _Pragma("unroll") for (int i_ = 0; i_ < (ISB ? 2 : 1); ++i_) { const int p_ = ISB ? wid * 2 + i_ : wid; \
            glds16(kp_[i_], (unsigned)__builtin_amdgcn_readfirstlane((int)(lds0 + (bo) + p_ * 1024))); \
            glds16(vp_[i_], (unsigned)__builtin_amdgcn_readfirstlane((int)(lds0 + (bo) + VOFF + p_ * 1024))); \
            kp_[i_] += 64 * ZG; vp_[i_] += 64 * ZG; } } while (0)
#define ATT_SB() __builtin_amdgcn_sched_barrier(0)
    float mhat[2] = {0.f, 0.f}, lsum[2] = {0.f, 0.f};
    f32x4 o[2][NDVB];
#pragma unroll
    for (int qb = 0; qb < 2; ++qb)
#pragma unroll
        for (int d = 0; d < NDVB; ++d) o[qb][d] = (f32x4){0.f, 0.f, 0.f, 0.f};
    const int kfo = (ISB ? map * 8192 : 0) + c16 * 128 + ((g ^ (c16 & 7)) * 16);
    const int vq = (lane & 15) >> 2, vsw = ISB ? (4 * (g & 1) + vq) : (2 * (g & 1) + (vq >> 1));
    const int vfo = VOFF + (4 * g + vq) * VROW + (lane & 3) * 8;
    u32x4 pw[2][2];
    const float cfar_r = ISB ? lut[256 + 128] : 0.f, cfar_l = ISB ? lut[256 - 128] : 0.f;
#define ATT_QK(P, t, so) do { const int kb_ = (t) * 64; float cf_ = 0.f; \
        if (ISB) { if (kb_ - qrow0 - 31 >= 91) cf_ = cfar_r; else if (kb_ + 63 - qrow0 <= -91) cf_ = cfar_l; } \
        const float c0_ = cf_ - mhat[0], c1_ = cf_ - mhat[1]; const f32x4 ci0_ = (f32x4){c0_, c0_, c0_, c0_}, ci1_ = (f32x4){c1_, c1_, c1_, c1_}; \
        ALAS const unsigned char* kp = lds + (so) + kfo; \
        _Pragma("unroll") for (int kb = 0; kb < 4; ++kb) { \
            const bf16x8 k0_ = *(ALAS const bf16x8*)(kp + kb * 2048), k1_ = *(ALAS const bf16x8*)((ALAS const unsigned char*)((unsigned)(size_t)kp ^ 64u) + kb * 2048); \
            P[0][kb] = __builtin_amdgcn_mfma_f32_16x16x32_bf16(k0_, qr[0][0], ci0_, 0, 0, 0); P[1][kb] = __builtin_amdgcn_mfma_f32_16x16x32_bf16(k0_, qr[1][0], ci1_, 0, 0, 0); \
            P[0][kb] = __builtin_amdgcn_mfma_f32_16x16x32_bf16(k1_, qr[0][1], P[0][kb], 0, 0, 0); P[1][kb] = __builtin_amdgcn_mfma_f32_16x16x32_bf16(k1_, qr[1][1], P[1][kb], 0, 0, 0); } } while (0)
#define ATT_DECIDE(P, t, first) do { const int kb_ = (t) * 64; \
        if (!ISB || !((kb_ - qrow0 - 31 >= 91) || (kb_ + 63 - qrow0 <= -91))) { \
            ALAS const float* lp = lut + (kb_ - (qrow0 + c16) + 256 + 4 * g); \
            _Pragma("unroll") for (int qb = 0; qb < 2; ++qb) { float lv_[16]; \
                _Pragma("unroll") for (int kb = 0; kb < 4; ++kb) _Pragma("unroll") for (int r = 0; r < 4; ++r) lv_[4 * kb + r] = lp[16 * kb - 16 * qb + r]; \
                _Pragma("unroll") for (int kb = 0; kb < 4; ++kb) _Pragma("unroll") for (int r = 0; r < 4; ++r) P[qb][kb][r] += lv_[4 * kb + r]; } } \
        float rm0_ = MX3(MX3(P[0][0][0], P[0][0][1], P[0][0][2]), P[0][0][3], P[0][1][0]), rm1_ = MX3(MX3(P[1][0][0], P[1][0][1], P[1][0][2]), P[1][0][3], P[1][1][0]); \
        rm0_ = MX3(MX3(rm0_, P[0][1][1], P[0][1][2]), P[0][1][3], P[0][2][0]); rm1_ = MX3(MX3(rm1_, P[1][1][1], P[1][1][2]), P[1][1][3], P[1][2][0]); \
        rm0_ = MX3(MX3(rm0_, P[0][2][1], P[0][2][2]), P[0][2][3], P[0][3][0]); rm1_ = MX3(MX3(rm1_, P[1][2][1], P[1][2][2]), P[1][2][3], P[1][3][0]); \
        rm0_ = MX3(MX3(rm0_, P[0][3][1], P[0][3][2]), P[0][3][3], rm0_); rm1_ = MX3(MX3(rm1_, P[1][3][1], P[1][3][2]), P[1][3][3], rm1_); \
        if ((first) || __any(__builtin_fmaxf(rm0_, rm1_) > THR)) { \
            const float f0_ = g4_max(rm0_), f1_ = g4_max(rm1_); \
            const float dl0 = (first) ? f0_ : __builtin_fmaxf(f0_, 0.f), dl1 = (first) ? f1_ : __builtin_fmaxf(f1_, 0.f); \
            mhat[0] += dl0; mhat[1] += dl1; \
            _Pragma("unroll") for (int kb = 0; kb < 4; ++kb) { P[0][kb] -= dl0; P[1][kb] -= dl1; } \
            if (!(first)) { const float s0_ = __builtin_amdgcn_exp2f(-dl0), s1_ = __builtin_amdgcn_exp2f(-dl1); lsum[0] *= s0_; lsum[1] *= s1_; \
                _Pragma("unroll") for (int d = 0; d < NDVB; ++d) { o[0][d] *= s0_; o[1][d] *= s1_; } } } } while (0)
#define ATT_FINISH(P) do { \
        _Pragma("unroll") for (int qb = 0; qb < 2; ++qb) { float sa_ = 0.f; \
            _Pragma("unroll") for (int kb = 0; kb < 4; ++kb) _Pragma("unroll") for (int r = 0; r < 4; ++r) { P[qb][kb][r] = __builtin_amdgcn_exp2f(P[qb][kb][r]); sa_ += P[qb][kb][r]; } \
            lsum[qb] += sa_; \
            _Pragma("unroll") for (int s_ = 0; s_ < 2; ++s_) pw[qb][s_] = (u32x4){cvtpk(P[qb][2 * s_][0], P[qb][2 * s_][1]), cvtpk(P[qb][2 * s_][2], P[qb][2 * s_][3]), cvtpk(P[qb][2 * s_ + 1][0], P[qb][2 * s_ + 1][1]), cvtpk(P[qb][2 * s_ + 1][2], P[qb][2 * s_ + 1][3])}; } } while (0)
#define ATT_LDV2(dst, s_, d0_) do { _Pragma("unroll") for (int dd = 0; dd < 2; ++dd) { ALAS const unsigned char* a_ = vp + (s_) * 32 * VROW + ((((d0_) + dd) ^ vsw) * 32); dst[2 * dd] = vtr(a_); dst[2 * dd + 1] = vtr(a_ + 16 * VROW); } } while (0)
#define ATT_PV2(src, s_, d0_) do { __builtin_amdgcn_s_setprio(1); _Pragma("unroll") for (int dd = 0; dd < 2; ++dd) { \
            const bf16x8 vf_ = (bf16x8){src[2 * dd][0], src[2 * dd][1], src[2 * dd][2], src[2 * dd][3], src[2 * dd + 1][0], src[2 * dd + 1][1], src[2 * dd + 1][2], src[2 * dd + 1][3]}; \
            o[0][(d0_) + dd] = __builtin_amdgcn_mfma_f32_16x16x32_bf16(vf_, __builtin_bit_cast(bf16x8, pw[0][s_]), o[0][(d0_) + dd], 0, 0, 0); \
            o[1][(d0_) + dd] = __builtin_amdgcn_mfma_f32_16x16x32_bf16(vf_, __builtin_bit_cast(bf16x8, pw[1][s_]), o[1][(d0_) + dd], 0, 0, 0); } __builtin_amdgcn_s_setprio(0); } while (0)
#define ATT_PV(so) do { ALAS const unsigned char* vp = lds + (so) + vfo; s16x4 va[4], vb[4]; constexpr int NG_ = NDVB / 2; \
        ATT_LDV2(va, 0, 0); ATT_SB(); \
        _Pragma("unroll") for (int k_ = 0; k_ < 2 * NG_; k_ += 2) { \
            ATT_LDV2(vb, (k_ + 1) / NG_, 2 * ((k_ + 1) % NG_)); ATT_SB(); \
            ATT_PV2(va, k_ / NG_, 2 * (k_ % NG_)); ATT_SB(); \
            if (k_ + 2 < 2 * NG_) { ATT_LDV2(va, (k_ + 2) / NG_, 2 * ((k_ + 2) % NG_)); ATT_SB(); } \
            ATT_PV2(vb, (k_ + 1) / NG_, 2 * ((k_ + 1) % NG_)); ATT_SB(); } } while (0)
#define ATT_SLOT(i) (ISB ? (((i) % 3) * BUF) : ((i) * BUF))
#define ATT_STEP(i, PC, PP) do { \
        if (ISB) { asm volatile("s_waitcnt vmcnt(0)" ::: "memory"); __syncthreads(); if ((i) + 1 < nt) ATT_ISSUE(ATT_SLOT((i) + 1)); } \
        ATT_QK(PC, kt0 + (i), ATT_SLOT(i)); ATT_SB(); \
        ATT_FINISH(PP); ATT_SB(); \
        ATT_PV(ATT_SLOT((i) - 1)); ATT_SB(); \
        ATT_DECIDE(PC, kt0 + (i), false); ATT_SB(); } while (0)
    f32x4 pA[2][4], pB[2][4];
    if (ISB) { ATT_ISSUE(0); asm volatile("s_waitcnt vmcnt(0)" ::: "memory"); __syncthreads(); if (nt > 1) ATT_ISSUE(BUF); }
    else {
#pragma unroll 1
        for (int i = 0; i < nt; ++i) ATT_ISSUE(i * BUF);
        asm volatile("s_waitcnt vmcnt(0)" ::: "memory"); __syncthreads();
    }
    ATT_QK(pA, kt0, 0); ATT_SB();
    ATT_DECIDE(pA, kt0, true); ATT_SB();
    int i = 1;
#pragma unroll 1
    for (; i + 1 < nt; i += 2) {
        ATT_STEP(i, pB, pA);
        ATT_STEP(i + 1, pA, pB);
    }
    if (i < nt) {
        ATT_STEP(i, pB, pA);
        ATT_FINISH(pB); ATT_SB(); ATT_PV(ATT_SLOT(nt - 1));
    } else {
        ATT_FINISH(pA); ATT_SB(); ATT_PV(ATT_SLOT(nt - 1));
    }
#undef ATT_ISSUE
#undef ATT_SB
#undef ATT_QK
#undef ATT_DECIDE
#undef ATT_FINISH
#undef ATT_LDV2
#undef ATT_PV2
#undef ATT_PV
#undef ATT_SLOT
#undef ATT_STEP
    float inv[2];
#pragma unroll
    for (int qb = 0; qb < 2; ++qb) { float l_ = g4_sum(lsum[qb]); if (!ISB) l_ += __builtin_amdgcn_exp2f(sink2 - mhat[qb]); inv[qb] = 1.0f / l_; }
    constexpr int DVE = ISB ? 128 : 64, SPITCH = DVE * 2 + 8;
    bf16* obase = odry ? odry + (rowbase + qrow0) * D + (ISB ? (512 + head * 128) : (head * 64)) : zg + (rowbase + qrow0) * ZG + (ISB ? (C_QB + head * 128) : (C_QA + head * 64));
    const size_t opitch = odry ? D : ZG;
    ALAS unsigned char* stg = lds + (ISB ? qsub * 16384 : wid * 4608);
#define ATT_OUT() do { asm volatile("s_waitcnt lgkmcnt(0)" ::: "memory"); \
        constexpr int LPR = DVE / 8, RPI = 64 / LPR; \
        _Pragma("unroll") for (int i_ = 0; i_ < 32 / RPI; ++i_) { const int row_ = i_ * RPI + lane / LPR, ch_ = lane % LPR; \
            const u32x2 a_ = *(ALAS const u32x2*)(stg + row_ * SPITCH + ch_ * 16), b_ = *(ALAS const u32x2*)(stg + row_ * SPITCH + ch_ * 16 + 8); \
            *(u32x4*)(obase + (size_t)row_ * opitch + ch_ * 8) = (u32x4){a_.x, a_.y, b_.x, b_.y}; } } while (0)
    if (ISB) {
        __syncthreads();
        ALAS float* cs = (ALAS float*)lds;
        if (map == 1) {
#pragma unroll
            for (int qb = 0; qb < 2; ++qb) { const float sc = -lam * inv[qb];
#pragma unroll
                for (int d = 0; d < NDVB; ++d)
#pragma unroll
                    for (int r = 0; r < 4; ++r) cs[(qsub * 64 + (qb * NDVB + d) * 4 + r) * 64 + lane] = o[qb][d][r] * sc; } }
        __syncthreads();
        if (map == 0) {
            float rstd[2];
#pragma unroll
            for (int qb = 0; qb < 2; ++qb) { float q = 0.f;
#pragma unroll
                for (int d = 0; d < NDVB; ++d)
#pragma unroll
                    for (int r = 0; r < 4; ++r) { const float v = o[qb][d][r] * inv[qb] + cs[(qsub * 64 + (qb * NDVB + d) * 4 + r) * 64 + lane]; o[qb][d][r] = v; q += v * v; }
                rstd[qb] = rsqrtf(g4_sum(q) * (1.0f / 128.0f) + EPS); }
            asm volatile("s_waitcnt lgkmcnt(0)" ::: "memory");
#pragma unroll
            for (int qb = 0; qb < 2; ++qb)
#pragma unroll
                for (int d = 0; d < NDVB; ++d) { const int dv0 = 16 * d + 4 * g; const f32x4 gv = *(ALAS const f32x4*)(gt + dv0);
                    u32x2 w; w.x = cvtpk(o[qb][d][0] * rstd[qb] * gv[0], o[qb][d][1] * rstd[qb] * gv[1]); w.y = cvtpk(o[qb][d][2] * rstd[qb] * gv[2], o[qb][d][3] * rstd[qb] * gv[3]);
                    *(ALAS u32x2*)(stg + (16 * qb + c16) * SPITCH + dv0 * 2) = w; }
            ATT_OUT();
        }
    } else {
        __syncthreads();
#pragma unroll
        for (int qb = 0; qb < 2; ++qb)
#pragma unroll
            for (int d = 0; d < NDVB; ++d) { const int dv0 = 16 * d + 4 * g;
                u32x2 w; w.x = cvtpk(o[qb][d][0] * inv[qb], o[qb][d][1] * inv[qb]); w.y = cvtpk(o[qb][d][2] * inv[qb], o[qb][d][3] * inv[qb]);
                *(ALAS u32x2*)(stg + (16 * qb + c16) * SPITCH + dv0 * 2) = w; }
        ATT_OUT();
    }
#undef ATT_OUT
    __syncthreads();
}
#undef MX3
}

#ifndef MK_VAR
#define MK_VAR 0
#endif
#define MK_DUP 0
#define MK_DSEL 0
namespace mk {
using namespace nv;
constexpr int NWAVES = 8;
constexpr size_t MiB = 1u << 20;
constexpr size_t WS_CTL = 0, CTL_ZERO_BYTES = 1 * MiB;
constexpr size_t WS_LUT = 512 * 1024;
constexpr size_t WS_SS = 1 * MiB;
constexpr size_t WS_XB = 6 * MiB;
constexpr size_t WS_ZG = 38 * MiB;
constexpr size_t WS_A = 38 * MiB;
constexpr size_t WS_YB = 126 * MiB;
constexpr size_t WS_MIX = 174 * MiB;
constexpr size_t WS_W = 206 * MiB;
constexpr size_t WL_IN = 0, WL_A = (size_t)ZG * D, WL_B = WL_A + (size_t)D * 512, WL_O = WL_B + (size_t)D * 512, WL_UP = WL_O + (size_t)D * D, WL_DN = WL_UP + (size_t)FF2 * D, WL_END = WL_DN + (size_t)D * FF;
constexpr size_t WS_END = 322 * MiB;
static_assert(WS_W + 4 * WL_END * 2 <= WS_END && WS_YB + (size_t)64 * 4 * FF2 * 4 <= WS_MIX && WS_A + (size_t)T * FF * 2 <= WS_YB, "d_ws map");
constexpr int CW_Q = 2048;
constexpr int CW_BAR = 4096;
constexpr int N_PHASES = 1 + 6 * L;
constexpr int RING_OFF = 0, RING_BYTES = 131072, LDSCTL_OFF = RING_BYTES, MISC_OFF = LDSCTL_OFF + 320;
constexpr int LDS_BYTES = 149504;
static_assert(pg8::RTAB_OFF + 8192 <= LDS_BYTES && MISC_OFF + 128 <= pg8::XOFF, "LDS map");

#define GAS __attribute__((address_space(1)))
#define LAS __attribute__((address_space(3)))
typedef unsigned v4u __attribute__((ext_vector_type(4)));
typedef float f32x4 __attribute__((ext_vector_type(4)));
typedef GAS unsigned gu32;
#define RLX_AGENT __ATOMIC_RELAXED, __HIP_MEMORY_SCOPE_AGENT
#define LDS_WAIT() asm volatile("s_waitcnt lgkmcnt(0)" ::: "memory")
#define VM_WAIT() asm volatile("s_waitcnt vmcnt(0)" ::: "memory")
__device__ __forceinline__ unsigned f2bfu(float f) { unsigned u = __builtin_bit_cast(unsigned, f); return (u + 0x7fffu + ((u >> 16) & 1u)) >> 16; }
__device__ __forceinline__ unsigned pk2(float lo, float hi) { return f2bfu(lo) | (f2bfu(hi) << 16); }

#define XB_TMO      128
#define XB_XCNT(j)  (256  + 64 * (j))
#define XB_XSUB(j)  (1280 + 64 * (j))
#define XB_XGEN(j)  (2304 + 64 * (j))
#define XB_TOP      3328
#define XB_TOPGEN   3392
#define XCD_BAR_WORDS 3456
#define XB_SPIN_CAP (1u << 18)

__device__ __forceinline__ unsigned xb_ld(unsigned* p)              { return __hip_atomic_load(p, __ATOMIC_RELAXED, __HIP_MEMORY_SCOPE_AGENT); }
__device__ __forceinline__ unsigned xb_add(unsigned* p, unsigned v) { return __hip_atomic_fetch_add(p, v, __ATOMIC_RELAXED, __HIP_MEMORY_SCOPE_AGENT); }
__device__ __forceinline__ unsigned xb_xcc_id() { return (unsigned)__builtin_amdgcn_s_getreg((3 << 11) | 20) & 0xFu; }
#define XB_SPIN(cond, bar) do { unsigned _sp = 0; while (cond) { __builtin_amdgcn_s_sleep(1); \
    if ((++_sp & 255u) == 0u) { if (xb_ld(&(bar)[XB_TMO])) break; if (_sp > XB_SPIN_CAP) { atomicAdd(&(bar)[XB_TMO], 1u); break; } } } } while (0)

struct XcdBarrier {
    unsigned* bar; unsigned x;
    volatile LAS unsigned* st;
};

__device__ __forceinline__ XcdBarrier xcd_barrier_post(unsigned* bar, volatile LAS unsigned* st) {
    XcdBarrier b; b.bar = bar; b.x = xb_xcc_id(); b.st = st;
    if (threadIdx.x == 0) (void)xb_add(&bar[XB_XCNT(b.x)], 1u);
    return b;
}
__device__ __forceinline__ void xcd_barrier_complete(unsigned* bar, unsigned x, unsigned& nloc, unsigned& nx) {
    const unsigned G = gridDim.x * gridDim.y * gridDim.z;
    unsigned sum, cnt, mine, sp = 0u;
    for (;;) {
        sum = 0u; cnt = 0u; mine = 0u;
#pragma unroll
        for (unsigned j = 0; j < 16; ++j) { const unsigned c = xb_ld(&bar[XB_XCNT(j)]); sum += c; cnt += (c > 0u) ? 1u : 0u; mine = (j == x) ? c : mine; }
        if (sum == G) break;
        __builtin_amdgcn_s_sleep(1);
        if ((++sp & 255u) == 0u) { if (xb_ld(&bar[XB_TMO])) break; if (sp > XB_SPIN_CAP) { atomicAdd(&bar[XB_TMO], 1u); break; } }
    }
    nloc = mine > 0u ? mine : 1u; nx = cnt > 0u ? cnt : 1u;
}

__device__ __forceinline__ void xcd_barrier(const XcdBarrier& b) {
    asm volatile("s_waitcnt vmcnt(0)" ::: "memory");
    __syncthreads();
    if (threadIdx.x == 0) {
        unsigned* bar = b.bar;
        __builtin_amdgcn_s_waitcnt(0);
        unsigned nloc = b.st[0], nx = b.st[1];
        if (nloc == 0u) { xcd_barrier_complete(bar, b.x, nloc, nx); b.st[0] = nloc; b.st[1] = nx; }
        const unsigned old = xb_add(&bar[XB_XSUB(b.x)], 1u);
        const unsigned gen = old / nloc;
        if (old + 1u == (gen + 1u) * nloc) {
            __builtin_amdgcn_fence(__ATOMIC_RELEASE, "agent");
            asm volatile("s_waitcnt vmcnt(0)" ::: "memory");
            const unsigned og = xb_add(&bar[XB_TOP], 1u);
            const unsigned tg = og / nx;
            if (og + 1u == (tg + 1u) * nx) xb_add(&bar[XB_TOPGEN], 1u);
            else XB_SPIN(xb_ld(&bar[XB_TOPGEN]) == tg, bar);
            __builtin_amdgcn_fence(__ATOMIC_ACQUIRE, "agent");
            xb_add(&bar[XB_XGEN(b.x)], 1u);
            asm volatile("s_waitcnt vmcnt(0)" ::: "memory");
        } else {
            XB_SPIN(xb_ld(&bar[XB_XGEN(b.x)]) == gen, bar);
            __builtin_amdgcn_fence(__ATOMIC_ACQUIRE, "agent");
            asm volatile("s_waitcnt vmcnt(0)" ::: "memory");
        }
    }
    __syncthreads();
}


struct Args { const float* in[24]; float* out; unsigned char* ws; int ph_lo, ph_hi, li, pad; };

__device__ __forceinline__ void p0_transpose_item(const float* __restrict__ W, int ldw, int K, int k0, int n0, bf16* __restrict__ WT, int vrow0, const float* __restrict__ gain, LAS float* scr, int lane) {
    f32x4 v[8];
    const float* wp = W + (size_t)(k0 + (lane >> 3)) * ldw + n0 + 4 * (lane & 7);
#pragma unroll
    for (int i = 0; i < 8; ++i) v[i] = __builtin_nontemporal_load((const f32x4*)(wp + (size_t)(8 * i) * ldw));
    if (gain) {
#pragma unroll
        for (int i = 0; i < 8; ++i) v[i] *= gain[k0 + 8 * i + (lane >> 3)];
    }
#pragma unroll
    for (int i = 0; i < 8; ++i) { LAS float* d = scr + (8 * i + (lane >> 3)) * 33 + 4 * (lane & 7); d[0] = v[i].x; d[1] = v[i].y; d[2] = v[i].z; d[3] = v[i].w; }
    LDS_WAIT(); asm volatile("" ::: "memory");
    const int c = lane & 7;
#pragma unroll
    for (int j = 0; j < 4; ++j) { const int n = (lane >> 3) + 8 * j; const LAS float* s = scr + (8 * c) * 33 + n;
        v4u o; o.x = pk2(s[0 * 33], s[1 * 33]); o.y = pk2(s[2 * 33], s[3 * 33]); o.z = pk2(s[4 * 33], s[5 * 33]); o.w = pk2(s[6 * 33], s[7 * 33]);
        *(GAS v4u*)(WT + (size_t)(vrow0 + n) * K + k0 + 8 * c) = o; }
    LDS_WAIT(); asm volatile("" ::: "memory");
}
__device__ __forceinline__ int vrow_in(int c) { const int pn = c >> 8, cr = c & 255, wc = cr >> 6, bj = (cr >> 5) & 1; return pn * 256 + bj * 128 + wc * 32; }
__device__ __forceinline__ int vrow_up(int c) { const int gs = c >= FF ? 1 : 0, cc = c - gs * FF, pn = cc >> 7, wc = (cc >> 5) & 3; return pn * 256 + gs * 128 + wc * 32; }

__global__ void __launch_bounds__(NWAVES * 64, 2) skel_fwd(Args args) {
    extern __shared__ __attribute__((aligned(16))) unsigned char lds_raw[];
    LAS unsigned char* lds = (LAS unsigned char*)lds_raw;
    volatile LAS unsigned* MISC = (volatile LAS unsigned*)(lds + MISC_OFF);
    const int G = gridDim.x; int vcu; { const int bx = blockIdx.x; vcu = (G % 8 == 0) ? (bx % 8) * (G / 8) + bx / 8 : bx; }
    unsigned char* ws = args.ws;
    gu32* ctl = (gu32*)(ws + WS_CTL);
    float* ss = (float*)(ws + WS_SS); bf16* xb = (bf16*)(ws + WS_XB); bf16* zg = (bf16*)(ws + WS_ZG); bf16* abuf = (bf16*)(ws + WS_A); float* yb = (float*)(ws + WS_YB);
    bf16* mix = (bf16*)(ws + WS_MIX); bf16* wbase = (bf16*)(ws + WS_W); float* xf = args.out;
    float* lutg = (float*)(ws + WS_LUT);
    for (int u = threadIdx.x; u < (LDS_BYTES - LDSCTL_OFF) / 4; u += NWAVES * 64) ((LAS unsigned*)(lds + LDSCTL_OFF))[u] = 0u;
    __syncthreads();
    XcdBarrier bar = xcd_barrier_post((unsigned*)(ctl + CW_BAR) + args.li * XCD_BAR_WORDS, MISC + 8);

#pragma unroll 1
    for (int ph = args.ph_lo; ph < args.ph_hi; ++ph) {
        const int l = ph > 0 ? (ph - 1) / 6 : 0, p = ph > 0 ? (ph - 1) % 6 + 1 : 0;
        bf16* wl = wbase + (size_t)l * WL_END;
        float* ss1 = ss + (size_t)((2 * l) & 3) * T * 16; float* ss2 = ss + (size_t)((2 * l + 1) & 3) * T * 16; float* ss3 = (l + 1 < L) ? ss + (size_t)((2 * l + 2) & 3) * T * 16 : nullptr;
#ifndef MK_ONLY
#define MK_ONLY 0x7f
#endif
        const int dupp = ((args.pad >> 8) & 0xff) - 1;
#pragma unroll 1
        for (int rep = (p == dupp) ? 0 : 1; rep < 2; ++rep) {
        if (p == 0 && (MK_ONLY & 1)) {
            int tid0 = threadIdx.x; asm volatile("" : "+v"(tid0));
            const int lane0 = tid0 & 63, wave = __builtin_amdgcn_readfirstlane(tid0 >> 6);
            LAS float* scr = (LAS float*)(lds + RING_OFF + wave * 16384);
            const int gw = vcu * NWAVES + wave, NGW = G * NWAVES;
            constexpr int I_IN = (D / 64) * (INW / 32), I_G = (D / 64) * (GW / 32), I_A = (512 / 64) * (D / 32), I_O = (D / 64) * (D / 32), I_UP = (D / 64) * (FF2 / 32), I_DN = (FF / 64) * (D / 32);
            constexpr int I_LAYER = I_IN + I_G + 2 * I_A + I_O + I_UP + I_DN;
            for (int i = gw * 64 + lane0; i < 12 * att::LUT_STRIDE; i += NGW * 64) { const int hh = i / att::LUT_STRIDE, j = i - hh * att::LUT_STRIDE, rel = j - 256, ar = rel < 0 ? -rel : rel;
                float v = 0.f; if (j <= 512) v = (hh < 8 && ar > 128) ? att::NEG : args.in[13][t5_bucket(rel) * 12 + hh] * LOG2E;
                lutg[i] = v; }
            for (int m = gw; m < T; m += 2 * NGW) {
                const int m2 = m + NGW;
                const GAS f32x4* xr = (const GAS f32x4*)(args.in[0] + (size_t)m * D) + lane0; const GAS f32x4* xr2 = (const GAS f32x4*)(args.in[0] + (size_t)m2 * D) + lane0;
                GAS unsigned long long* o8 = (GAS unsigned long long*)(xb + (size_t)m * D) + lane0; GAS unsigned long long* o82 = (GAS unsigned long long*)(xb + (size_t)m2 * D) + lane0;
                f32x4 va[4], vb[4];
#pragma unroll
                for (int j = 0; j < 4; ++j) { va[j] = xr[64 * j]; vb[j] = xr2[64 * j]; }
                float s = 0.f, s2 = 0.f;
#pragma unroll
                for (int j = 0; j < 4; ++j) { const f32x4 v = va[j], w = vb[j]; s += (v.x * v.x + v.y * v.y) + (v.z * v.z + v.w * v.w); s2 += (w.x * w.x + w.y * w.y) + (w.z * w.z + w.w * w.w);
                    o8[64 * j] = (unsigned long long)pk2(v.x, v.y) | ((unsigned long long)pk2(v.z, v.w) << 32); o82[64 * j] = (unsigned long long)pk2(w.x, w.y) | ((unsigned long long)pk2(w.z, w.w) << 32); }
                s = wave_sum(s); s2 = wave_sum(s2);
                ss16_store(ss, m, s, lane0); ss16_store(ss, m2, s2, lane0);
            }
        } else if (p == 1 && (MK_ONLY & 2)) {
            pg8::SchedStd S; S.init(xb, D, wl + WL_IN, D, T, ZG - 256, G, (int)blockIdx.x);
            S.fix = (rep == 0 && MK_VAR == 8) ? 1 : 0;
            pg8::EpiIn E{zg, ss1, args.in[3] + l * 64, args.in[4] + l * 64, args.in[6] + l * 64, args.in[7] + l * 64, args.in[15] + l * GW, (args.pad >> 25) & 1, 8 * ((int)blockIdx.x & 7) * 256};
            pg8::gemm_phase<pg8::EpiIn, pg8::SchedStd, true, true>(lds + RING_OFF, D, D, S, E);
        } else if (p == 2 && (MK_ONLY & 4)) {
            int lop = l; asm volatile("" : "+s"(lop));
            const float lam_init = 0.8f - 0.6f * __expf(-0.3f * (float)lop);
            int ln = threadIdx.x; asm volatile("" : "+v"(ln)); ln &= 63;
            const float d1 = wave_sum(args.in[8][l * 64 + ln] * args.in[9][l * 64 + ln]), d2 = wave_sum(args.in[10][l * 64 + ln] * args.in[11][l * 64 + ln]);
            const float lam = __expf(d1) - __expf(d2) + lam_init;
            if ((vcu & 3) == 0 && rep == 1) {
                pg8::SchedStd S1; S1.init(xb, D, wl + WL_IN, D, T, ZG, G, (int)blockIdx.x); S1.one = 1; S1.opm = 8 * (vcu >> 5) + ((vcu & 31) >> 2); S1.opn = 16;
                pg8::EpiIn E1{zg, ss1, args.in[3] + l * 64, args.in[4] + l * 64, args.in[6] + l * 64, args.in[7] + l * 64, args.in[15] + l * GW, 0, 8 * ((int)blockIdx.x & 7) * 256};
                pg8::gemm_phase<pg8::EpiIn, pg8::SchedStd, true, true>(lds + RING_OFF, D, D, S1, E1);
            }
            att::attn_tables(lds, lutg, args.in[12] + l * 128, 1.0f - lam_init);
            const int dsel = args.pad >> 16;
            if (rep == 1 || dsel != 2)
            for (int ui = vcu; ui < 512; ui += G) { const int bh = ui >> 4, qb = ui & 15; if (rep == 0 && MK_VAR == 7 && (vcu & 1)) {} else if (rep == 0) att::attn_unit<true, (MK_VAR == 7 ? 0 : MK_VAR)>(lds, zg, lutg, bh >> 2, bh & 3, qb * 128, nullptr, lam, 1.0f - lam_init, args.in[12] + l * 128, mix);
                else att::attn_unit<true, 0>(lds, zg, lutg, bh >> 2, bh & 3, qb * 128, nullptr, lam, 1.0f - lam_init, args.in[12] + l * 128, nullptr); }
            if (rep == 1 || dsel != 1) {
                unsigned* qctr = (unsigned*)(ctl + CW_Q + 64 * (2 * l + rep));
                for (;;) {
                    if (threadIdx.x == 0) MISC[4] = __hip_atomic_fetch_add(qctr, 1u, __ATOMIC_RELAXED, __HIP_MEMORY_SCOPE_AGENT);
                    __syncthreads();
                    const int ui = (int)MISC[4];
                    __syncthreads();
                    if (ui >= 512) break;
                    const int bk = ui >> 5, qb = ui & 31; att::attn_unit<false>(lds, zg, lutg, bk >> 1, bk & 1, qb * 64, args.in[5] + l * HA, 0.f, 0.f, nullptr, rep == 0 ? mix : nullptr);
                }
            }
        } else if (p == 3 && (MK_ONLY & 8)) {
            pg8::SchedMix S; S.b.init(zg + C_QA, ZG, wl + WL_A, 512, T, D, G, (int)blockIdx.x); S.A1 = (const char*)(zg + C_QB); S.Bt1 = (const char*)(wl + WL_B);
            pg8::EpiMix E{zg, mix};
            pg8::gemm_phase<pg8::EpiMix, pg8::SchedMix, true, true>(lds + RING_OFF, 512, ZG, S, E);
        } else if (p == 4 && (MK_ONLY & 16)) {
            pg8::SchedStd S; S.init(mix, D, wl + WL_O, D, T, D, G, (int)blockIdx.x);
            pg8::EpiRes E{l == 0 ? args.in[0] : xf, xf, xb, ss2};
            pg8::gemm_phase<pg8::EpiRes, pg8::SchedStd, true, true>(lds + RING_OFF, D, D, S, E);
        } else if (p == 5 && (MK_ONLY & 32)) {
            pg8::SchedStd S; S.init(xb, D, wl + WL_UP, D, T, FF2, G, (int)blockIdx.x);
            pg8::EpiUp E{abuf, ss2, args.in[21] + (size_t)l * 3 * FF2, args.in[22] + (size_t)l * FF2, yb, (args.pad >> 24) & 1, 8 * ((int)blockIdx.x & 7) * 256};
            pg8::gemm_phase<pg8::EpiUp, pg8::SchedStd, true, true>(lds + RING_OFF, D, D, S, E);
        } else if (MK_ONLY & 64) {
            pg8::SchedDown S; S.b.init(abuf, FF, wl + WL_DN, FF, T, D, G, (int)blockIdx.x); S.yb = (args.pad & 1) ? nullptr : yb; S.cw = args.in[21] + (size_t)l * 3 * FF2; S.cb = args.in[22] + (size_t)l * FF2; S.a = abuf;
            pg8::EpiRes E{xf, xf, ss3 ? xb : nullptr, ss3};
            pg8::gemm_phase<pg8::EpiRes, pg8::SchedDown, true, true>(lds + RING_OFF, FF, FF, S, E);
        }
        {
            int ph2 = ph; asm volatile("" : "+s"(ph2));
            const int l2 = ph2 > 0 ? (ph2 - 1) / 6 : 0, p2 = ph2 > 0 ? (ph2 - 1) % 6 + 1 : 0;
            const int G2 = gridDim.x, bx2 = blockIdx.x;
            int cl = -1, cw0 = 0, cnw = 1;
            if (p2 == 0) { cl = 0; cw0 = ((G2 % 8 == 0) ? (bx2 % 8) * (G2 / 8) + bx2 / 8 : bx2) * NWAVES; cnw = G2 * NWAVES; }
            else if (p2 == 5 && l2 + 1 < L && G2 == 256 && bx2 >= 128) { cl = l2 + 1; cw0 = (bx2 - 128) * NWAVES; cnw = 128 * NWAVES; }
            if (cl >= 0) {
                bf16* wbase2 = (bf16*)(args.ws + WS_W);
                int tid0 = threadIdx.x; asm volatile("" : "+v"(tid0));
                const int lane0 = tid0 & 63, wave = __builtin_amdgcn_readfirstlane(tid0 >> 6);
                LAS float* scr = (LAS float*)(lds + RING_OFF + wave * 16384);
                constexpr int I_IN = (D / 64) * (INW / 32), I_G = (D / 64) * (GW / 32), I_A = (512 / 64) * (D / 32), I_O = (D / 64) * (D / 32), I_UP = (D / 64) * (FF2 / 32), I_DN = (FF / 64) * (D / 32);
                constexpr int I_LAYER = I_IN + I_G + 2 * I_A + I_O + I_UP + I_DN;
                const int ll = cl; bf16* w = wbase2 + (size_t)ll * WL_END;
#pragma unroll 1
                for (int it = cw0 + wave; it < I_LAYER; it += cnw) {
                    int r = it;
                    if (r < I_IN) { const int nb = r % (INW / 32), kb = r / (INW / 32); p0_transpose_item(args.in[2] + (size_t)ll * D * INW, INW, D, 64 * kb, 32 * nb, w + WL_IN, vrow_in(32 * nb), args.in[1] + ll * D, scr, lane0); continue; } r -= I_IN;
                    if (r < I_G) { const int nb = r % (GW / 32), kb = r / (GW / 32); p0_transpose_item(args.in[14] + (size_t)ll * D * GW, GW, D, 64 * kb, 32 * nb, w + WL_IN, vrow_in(INW + 32 * nb), args.in[1] + ll * D, scr, lane0); continue; } r -= I_G;
                    if (r < I_A) { const int nb = r % (D / 32), kb = r / (D / 32); p0_transpose_item(args.in[16] + (size_t)ll * 512 * D, D, 512, 64 * kb, 32 * nb, w + WL_A, 32 * nb, nullptr, scr, lane0); continue; } r -= I_A;
                    if (r < I_A) { const int nb = r % (D / 32), kb = r / (D / 32); p0_transpose_item(args.in[17] + (size_t)ll * 512 * D, D, 512, 64 * kb, 32 * nb, w + WL_B, 32 * nb, nullptr, scr, lane0); continue; } r -= I_A;
                    if (r < I_O) { const int nb = r % (D / 32), kb = r / (D / 32); p0_transpose_item(args.in[18] + (size_t)ll * D * D, D, D, 64 * kb, 32 * nb, w + WL_O, 32 * nb, nullptr, scr, lane0); continue; } r -= I_O;
                    if (r < I_UP) { const int nb = r % (FF2 / 32), kb = r / (FF2 / 32); p0_transpose_item(args.in[20] + (size_t)ll * D * FF2, FF2, D, 64 * kb, 32 * nb, w + WL_UP, vrow_up(32 * nb), args.in[19] + ll * D, scr, lane0); continue; } r -= I_UP;
                    { const int nb = r % (D / 32), kb = r / (D / 32); p0_transpose_item(args.in[23] + (size_t)ll * FF * D, D, FF, 64 * kb, 32 * nb, w + WL_DN, 32 * nb, nullptr, scr, lane0); }
                }
            }
        }
        }
        if (ph + 1 < args.ph_hi) xcd_barrier(bar);
    }
}
}

extern "C" void kernel_launch(void* const* d_in, const int* in_sizes, int n_in, void* d_out, int out_size, void* d_ws, size_t ws_size, hipStream_t stream) {
    using namespace nv;
    static int grid = 0;
    if (grid == 0) {
        if (n_in != 24 || in_sizes[0] != T * D || out_size != T * D || ws_size < mk::WS_END) { fprintf(stderr, "kernel_launch: built for 24 inputs, x/out of %d floats, >= %zu bytes of workspace; got n_in %d, out %d, ws %zu; nothing launched\n", T * D, (size_t)mk::WS_END, n_in, out_size, ws_size); grid = -1; return; }
        int dev = 0, cus = 0, per_cu = 0;
        if (hipGetDevice(&dev) != hipSuccess || hipDeviceGetAttribute(&cus, hipDeviceAttributeMultiprocessorCount, dev) != hipSuccess) { fprintf(stderr, "kernel_launch: device query failed; nothing launched\n"); grid = -1; return; }
        if (hipFuncSetAttribute((const void*)mk::skel_fwd, hipFuncAttributeMaxDynamicSharedMemorySize, mk::LDS_BYTES) != hipSuccess) { fprintf(stderr, "kernel_launch: hipFuncSetAttribute failed (needs %d bytes of dynamic LDS)\n", mk::LDS_BYTES); grid = -1; return; }
        if (hipOccupancyMaxActiveBlocksPerMultiprocessor(&per_cu, (const void*)mk::skel_fwd, mk::NWAVES * 64, mk::LDS_BYTES) != hipSuccess || per_cu < 1) fprintf(stderr, "kernel_launch: note: occupancy query reports %d workgroups per CU\n", per_cu);
        (void)hipGetLastError();
        grid = cus;
        if (grid != 256) fprintf(stderr, "kernel_launch: the unit schedules are built for 256 CUs; this device reports %d\n", cus);
    }
    if (grid < 0) return;
    if (hipMemsetAsync((unsigned char*)d_ws + mk::WS_CTL, 0, mk::CTL_ZERO_BYTES, stream) != hipSuccess) { fprintf(stderr, "kernel_launch: memset of the control words failed; nothing launched\n"); return; }
    mk::Args a{};
    for (int i = 0; i < 24; ++i) a.in[i] = (const float*)d_in[i];
    a.out = (float*)d_out; a.ws = (unsigned char*)d_ws; a.ph_lo = 0; a.ph_hi = mk::N_PHASES; a.li = 0;
    a.pad = (MK_DUP << 8) | (MK_DSEL << 16);
    hipLaunchKernelGGL(mk::skel_fwd, dim3(grid), dim3(mk::NWAVES * 64), mk::LDS_BYTES, stream, a);
}
```

```cpp
#include <hip/hip_runtime.h>
#include <cstdio>
#include <cstdint>
#include <cmath>
#define MK_EDUP 0

namespace nv {
typedef unsigned short bf16;
constexpr int D = 1024, B = 8, S = 2048, T = B * S, L = 4;
constexpr int HA = 8, KVA = 2, HB = 4, HD = 64;
constexpr int INW = 2304, GW = 2048, ZG = INW + GW;
constexpr int FF = 2816, FF2 = 2 * FF;
constexpr int C_QA = 0, C_KA = 512, C_VA = 640, C_QB = 768, C_KB = 1280, C_VB = 1792, C_G = 2304;
constexpr float EPS = 1e-6f;
constexpr float LOG2E = 1.4426950408889634f;
constexpr float C2 = 0.125f * LOG2E;

__device__ __forceinline__ float bf2f(bf16 v) { return __uint_as_float(((unsigned)v) << 16); }
__device__ __forceinline__ bf16 f2bf(float f) { unsigned u = __float_as_uint(f); return (bf16)((u + 0x7fffu + ((u >> 16) & 1u)) >> 16); }
__device__ __forceinline__ float ldf(const float* p) { return *p; }
__device__ __forceinline__ float ldf(const bf16* p) { return bf2f(*p); }

__device__ __forceinline__ int t5_bucket(int rel) {
    const int n = rel < 0 ? -rel : rel; int v;
    if (n < 8) v = n; else if (n < 12) v = 8; else if (n < 16) v = 9; else if (n < 23) v = 10; else if (n < 32) v = 11;
    else if (n < 46) v = 12; else if (n < 64) v = 13; else if (n < 91) v = 14; else v = 15;
    return (rel > 0 ? 16 : 0) + v;
}
__device__ __forceinline__ float ss16(const float* ss, int t) { const float4* p = (const float4*)(ss + (size_t)t * 16); const float4 a = p[0], b = p[1], c = p[2], d = p[3];
    return ((a.x + a.y) + (a.z + a.w)) + ((b.x + b.y) + (b.z + b.w)) + ((c.x + c.y) + (c.z + c.w)) + ((d.x + d.y) + (d.z + d.w)); }
__device__ __forceinline__ float ss16_q(const float* ss, int t, int fq) { const float4 a = *(const float4*)(ss + (size_t)t * 16 + 4 * fq); float s = (a.x + a.y) + (a.z + a.w); s += __shfl_xor(s, 16); s += __shfl_xor(s, 32); return s; }
__device__ __forceinline__ void ss16_store(float* ss, int t, float s, int lane) { if (lane < 16) ss[(size_t)t * 16 + lane] = lane == 0 ? s : 0.f; }
__device__ __forceinline__ float wave_sum(float v) {
#pragma unroll
    for (int o = 1; o < 64; o <<= 1) v += __shfl_xor(v, o);
    return v;
}
__device__ __forceinline__ float wave_max(float v) {
#pragma unroll
    for (int o = 1; o < 64; o <<= 1) v = fmaxf(v, __shfl_xor(v, o));
    return v;
}

}


namespace pg8 {
using namespace nv;
#define PG8_LAS __attribute__((address_space(3)))
typedef unsigned short bf16_t;
typedef short bf16x8 __attribute__((ext_vector_type(8)));
typedef float f32x4 __attribute__((ext_vector_type(4)));
typedef unsigned u32x4 __attribute__((ext_vector_type(4)));
typedef unsigned u32x2 __attribute__((ext_vector_type(2)));
constexpr int BM = 256, BK = 64, HALF = 128, HTB = HALF * BK * 2  , STAGE_BYTES = 8 * HTB, NXCD = 8, WGM = 8;
constexpr int XOFF = 131072 + 1024;
constexpr int RTAB_OFF = XOFF + 8192;

__host__ __device__ __forceinline__ int lds_byte(int r, int c) { const int st = (r >> 4) * 2 + (c >> 5), rr = r & 15, cc = c & 31, ob = rr * 64 + cc * 2; return st * 1024 + (ob ^ (((ob >> 9) & 1) << 5)); }
__host__ __device__ __forceinline__ void stage_rc(int b, int& R, int& C) { const int st = b / 1024, sb = b % 1024, swz = sb ^ (((sb >> 9) & 1) << 5); R = (st >> 1) * 16 + swz / 64; C = (st & 1) * 32 + (swz % 64) / 2; }
__host__ __device__ __forceinline__ int perm32(int rho) { const int n = rho >> 4, i = rho & 15; return 8 * (i >> 2) + 4 * n + (i & 3); }

struct Unit { int pm, pn, z; };
typedef float f32x2 __attribute__((ext_vector_type(2))); typedef __bf16 bf16x2_t __attribute__((ext_vector_type(2)));
__device__ __forceinline__ unsigned cvt_pk_bf16(float lo, float hi) { f32x2 v = {lo, hi}; bf16x2_t b = __builtin_convertvector(v, bf16x2_t); return __builtin_bit_cast(unsigned, b); }
__device__ __forceinline__ float bflo(unsigned w) { return __uint_as_float(w << 16); }
__device__ __forceinline__ float bfhi(unsigned w) { return __uint_as_float(w & 0xffff0000u); }

struct SchedStd {
    int nM, nN, nwg, G, c, fix, one, opm, opn; const char* A; const char* Bt; size_t at, bt;
    __device__ void init(const void* A_, int lda, const void* Bt_, int K, int M, int N, int G_, int c_) { fix = 0; one = 0; opm = 0; opn = 0; nM = M / BM; nN = N / BM; nwg = nM * nN; G = G_; c = c_; A = (const char*)A_; Bt = (const char*)Bt_; at = (size_t)BM * lda * 2; bt = (size_t)BM * K * 2; }
    __device__ bool next(int i, Unit& u) const {
        if (one) { if (i > 0) return false; u.pm = opm; u.pn = opn; u.z = 0; return true; }
        const long L = (long)i * G + c; if (L >= nwg) return false;
        int wgid = (int)L; { const int q = nwg / NXCD, r = nwg % NXCD, xcd = wgid % NXCD, off = wgid / NXCD; wgid = (xcd < r ? xcd * (q + 1) : r * (q + 1) + (xcd - r) * q) + off; }
        const int nig = WGM * nN, gid = wgid / nig, fm = gid * WGM, gsz = (nM - fm) < WGM ? (nM - fm) : WGM;
        u.pm = fm + ((wgid % nig) % gsz); u.pn = (wgid % nig) / gsz; u.z = 0; if (fix) { u.pm = 0; u.pn = 0; } return true;
    }
    __device__ __forceinline__ const char* aptr(const Unit& u) const { return A + (size_t)u.pm * at; }
    __device__ __forceinline__ const char* bptr(const Unit& u) const { return Bt + (size_t)u.pn * bt; }
    __device__ __forceinline__ void a_ready(const Unit&) const {}
    __device__ __forceinline__ void done(const Unit&) const {}
};
struct SchedMix {
    SchedStd b; const char* A1; const char* Bt1;
    __device__ bool next(int i, Unit& u) const { if (!b.next(i >> 1, u)) return false; u.z = i & 1; return true; }
    __device__ __forceinline__ const char* aptr(const Unit& u) const { return (u.z ? A1 : b.A) + (size_t)u.pm * b.at; }
    __device__ __forceinline__ const char* bptr(const Unit& u) const { return (u.z ? Bt1 : b.Bt) + (size_t)u.pn * b.bt; }
    __device__ __forceinline__ void a_ready(const Unit&) const {}
    __device__ __forceinline__ void done(const Unit&) const {}
};
struct SchedDown {
    SchedStd b; const float* yb; const float* cw; const float* cb; bf16_t* a;
    __device__ bool next(int i, Unit& u) const { return b.next(i, u); }
    __device__ __forceinline__ const char* aptr(const Unit& u) const { return b.aptr(u); }
    __device__ __forceinline__ const char* bptr(const Unit& u) const { return b.bptr(u); }
    __device__ __forceinline__ void a_ready(const Unit& u) const {
        const int pm = u.pm;
        if (yb) {
            int t0 = threadIdx.x; asm volatile("" : "+v"(t0));
            const bool hasp = (pm & 7) != 0, hasn = (pm & 7) != 7;
#pragma unroll 1
            for (int g = 0; g < 3; ++g) {
                float yv[4][2][3], cv[4][2][4];
#pragma unroll
                for (int q = 0; q < 4; ++q) {
                    const int it = 4 * g + q;
                    if (it < 11) {
                        const int idx = t0 + 512 * it, which = idx >= FF ? 1 : 0, j = idx - which * FF;
#pragma unroll
                        for (int gs = 0; gs < 2; ++gs) {
                            const int col = gs * FF + j;
                            const float* r0 = yb + ((size_t)pm * 4 + (which ? 2 : -1)) * FF2 + col;
                            const bool v0 = which ? true : hasp, v2 = which ? hasn : true;
                            yv[q][gs][0] = v0 ? r0[0] : 0.f; yv[q][gs][1] = r0[FF2]; yv[q][gs][2] = v2 ? r0[2 * (size_t)FF2] : 0.f;
                            cv[q][gs][0] = cb[col]; cv[q][gs][1] = cw[col]; cv[q][gs][2] = cw[FF2 + col]; cv[q][gs][3] = cw[2 * FF2 + col];
                        }
                    }
                }
#pragma unroll
                for (int q = 0; q < 4; ++q) {
                    const int it = 4 * g + q;
                    if (it < 11) {
                        const int idx = t0 + 512 * it, which = idx >= FF ? 1 : 0, j = idx - which * FF;
                        float uv[2];
#pragma unroll
                        for (int gs = 0; gs < 2; ++gs) uv[gs] = cv[q][gs][0] + cv[q][gs][1] * yv[q][gs][0] + cv[q][gs][2] * yv[q][gs][1] + cv[q][gs][3] * yv[q][gs][2];
                        const float sg = uv[1] * __builtin_amdgcn_rcpf(1.0f + __builtin_amdgcn_exp2f(-uv[1] * LOG2E));
                        a[(size_t)(pm * BM + which * 255) * FF + j] = f2bf(sg * uv[0]);
                    }
                }
            }
        }
        asm volatile("s_waitcnt vmcnt(0)" ::: "memory");
        __builtin_amdgcn_s_barrier();
        asm volatile("" ::: "memory");
    }
    __device__ __forceinline__ void done(const Unit&) const {}
};

__device__ __forceinline__ void rtab_fill(PG8_LAS unsigned char* lds_, const float* __restrict__ ssx, int row0) {
    int t = threadIdx.x; asm volatile("" : "+v"(t));
    PG8_LAS float* rt = (PG8_LAS float*)(lds_ + RTAB_OFF);
    float v[4];
#pragma unroll
    for (int k = 0; k < 4; ++k) v[k] = ss16(ssx, row0 + t + 512 * k);
#pragma unroll
    for (int k = 0; k < 4; ++k) rt[t + 512 * k] = rsqrtf(v[k] * (1.0f / D) + EPS);
}
struct EpiIn {
    static constexpr bool PERM = true, AFTER_DRAIN = false;
    __device__ __forceinline__ void init(f32x4 (&acc)[2][2][4][2], const Unit&, int, int, int, int) const {
#pragma unroll
        for (int a = 0; a < 2; ++a)
#pragma unroll
            for (int b = 0; b < 2; ++b)
#pragma unroll
                for (int m = 0; m < 4; ++m)
#pragma unroll
                    for (int n = 0; n < 2; ++n) acc[a][b][m][n] = (f32x4){0.f, 0.f, 0.f, 0.f};
    }
    __device__ static constexpr bool zero_after(const Unit&) { return true; }
    bf16_t* zg; const float* ss; const float *qn_a, *kn_a, *qn_b, *kn_b, *bg; int dup, row0;
    __device__ __forceinline__ void prefill(PG8_LAS unsigned char* lds_) const { rtab_fill(lds_, ss, row0); }
    __device__ __forceinline__ void operator()(f32x4 (&acc)[2][2][4][2], const Unit& u, int wr, int wc, int fr, int fq, PG8_LAS unsigned char* lds_) const {
#pragma unroll
        for (int rep_ = 0; rep_ <= ((MK_EDUP & 2) ? 1 : 0); ++rep_) {
        if (rep_) {
#pragma unroll
            for (int ai = 0; ai < 2; ++ai)
#pragma unroll
                for (int bj = 0; bj < 2; ++bj)
#pragma unroll
                    for (int m = 0; m < 4; ++m)
#pragma unroll
                        for (int n = 0; n < 2; ++n) asm volatile("" : "+v"(acc[ai][bj][m][n]) :: "memory");
        }
        const int g = u.pn * 4 + wc, colb = u.pn * BM + wc * 64 + 8 * fq;
        const float* gain = nullptr; float sc = 1.f; int mode = 0;
        if (g < 8) { gain = qn_a; sc = C2; mode = 1; } else if (g < 10) { gain = kn_a; mode = 1; } else if (g < 12) { mode = 0; } else if (g < 20) { gain = qn_b; sc = C2; mode = 1; }
        else if (g < 28) { gain = kn_b; mode = 1; } else if (g < 36) { mode = 0; } else { mode = 2; }
        float rsv[2][4];
#pragma unroll
        for (int ai = 0; ai < 2; ++ai)
#pragma unroll
            for (int m = 0; m < 4; ++m) rsv[ai][m] = ((const PG8_LAS float*)(lds_ + RTAB_OFF))[(u.pm & 7) * BM + ai * HALF + wr * 64 + m * 16 + fr];
        f32x4 gv[2][2];
#pragma unroll
        for (int bj = 0; bj < 2; ++bj)
#pragma unroll
            for (int n = 0; n < 2; ++n) {
                if (mode == 1) gv[bj][n] = *(const f32x4*)(gain + 32 * bj + 8 * fq + 4 * n) * sc;
                else if (mode == 2) gv[bj][n] = *(const f32x4*)(bg + (colb - C_G) + 32 * bj + 4 * n);
                else gv[bj][n] = (f32x4){1.f, 1.f, 1.f, 1.f};
            }
#pragma unroll
        for (int ai = 0; ai < 2; ++ai)
#pragma unroll
            for (int m = 0; m < 4; ++m) {
                const int row = u.pm * BM + ai * HALF + wr * 64 + m * 16 + fr;
                const float rs = rsv[ai][m];
                f32x4 v[2][2];
#pragma unroll
                for (int bj = 0; bj < 2; ++bj)
#pragma unroll
                    for (int n = 0; n < 2; ++n) v[bj][n] = acc[ai][bj][m][n] * rs;
                if (mode == 1) {
                    float q = 0.f;
#pragma unroll
                    for (int bj = 0; bj < 2; ++bj)
#pragma unroll
                        for (int n = 0; n < 2; ++n) { const f32x4 x = v[bj][n]; q += (x[0] * x[0] + x[1] * x[1]) + (x[2] * x[2] + x[3] * x[3]); }
                    q += __shfl_xor(q, 16); q += __shfl_xor(q, 32);
                    const float r2 = rsqrtf(q * (1.0f / 64.0f) + EPS);
#pragma unroll
                    for (int bj = 0; bj < 2; ++bj)
#pragma unroll
                        for (int n = 0; n < 2; ++n) v[bj][n] = v[bj][n] * r2 * gv[bj][n];
                } else if (mode == 2) {
#pragma unroll
                    for (int bj = 0; bj < 2; ++bj)
#pragma unroll
                        for (int n = 0; n < 2; ++n) { f32x4 x = v[bj][n] + gv[bj][n];
#pragma unroll
                            for (int e = 0; e < 4; ++e) x[e] = __builtin_fmaxf(__builtin_amdgcn_rcpf(1.0f + __builtin_amdgcn_exp2f(-x[e] * LOG2E)), 9.5367431640625e-07f);
                            v[bj][n] = x; }
                }
                bf16_t* rowp = zg + (size_t)row * ZG + colb;
#pragma unroll
                for (int bj = 0; bj < 2; ++bj) { u32x4 w; w.x = cvt_pk_bf16(v[bj][0][0], v[bj][0][1]); w.y = cvt_pk_bf16(v[bj][0][2], v[bj][0][3]); w.z = cvt_pk_bf16(v[bj][1][0], v[bj][1][1]); w.w = cvt_pk_bf16(v[bj][1][2], v[bj][1][3]);
                    *(u32x4*)(rowp + 32 * bj) = w; }
            }
        }
    }
};
struct EpiMix {
    static constexpr bool PERM = true, AFTER_DRAIN = false;
    __device__ __forceinline__ void prefill(PG8_LAS unsigned char*) const {}
    __device__ __forceinline__ void init(f32x4 (&acc)[2][2][4][2], const Unit&, int, int, int, int) const {
#pragma unroll
        for (int a = 0; a < 2; ++a)
#pragma unroll
            for (int b = 0; b < 2; ++b)
#pragma unroll
                for (int m = 0; m < 4; ++m)
#pragma unroll
                    for (int n = 0; n < 2; ++n) acc[a][b][m][n] = (f32x4){0.f, 0.f, 0.f, 0.f};
    }
    __device__ static bool zero_after(const Unit& u) { return u.z != 0; }
    const bf16_t* zg; bf16_t* mix;
    __device__ __forceinline__ void operator()(f32x4 (&acc)[2][2][4][2], const Unit& u, int wr, int wc, int fr, int fq, PG8_LAS unsigned char*) const {
        const int col0 = u.pn * BM + wc * 32 + 8 * fq;
#pragma unroll
        for (int ai = 0; ai < 2; ++ai) {
            u32x4 gbv[4][2], gav[4][2];
#pragma unroll
            for (int m = 0; m < 4; ++m)
#pragma unroll
                for (int bj = 0; bj < 2; ++bj) { const size_t go = (size_t)(u.pm * BM + ai * HALF + wr * 64 + m * 16 + fr) * ZG + C_G + col0 + bj * HALF;
                    gbv[m][bj] = *(const u32x4*)(zg + go + D); if (u.z == 0) gav[m][bj] = *(const u32x4*)(zg + go); else gav[m][bj] = (u32x4){0u, 0u, 0u, 0u}; }
#pragma unroll
            for (int m = 0; m < 4; ++m) {
                const int row = u.pm * BM + ai * HALF + wr * 64 + m * 16 + fr;
#pragma unroll
                for (int bj = 0; bj < 2; ++bj) {
                    const int col = col0 + bj * HALF;
                    const u32x4 gb = gbv[m][bj];
                    if (u.z == 0) {
                        const u32x4 ga = gav[m][bj];
                        f32x4 r0, r1;
                        r0[0] = bflo(ga.x) * __builtin_amdgcn_rcpf(bflo(gb.x)); r0[1] = bfhi(ga.x) * __builtin_amdgcn_rcpf(bfhi(gb.x)); r0[2] = bflo(ga.y) * __builtin_amdgcn_rcpf(bflo(gb.y)); r0[3] = bfhi(ga.y) * __builtin_amdgcn_rcpf(bfhi(gb.y));
                        r1[0] = bflo(ga.z) * __builtin_amdgcn_rcpf(bflo(gb.z)); r1[1] = bfhi(ga.z) * __builtin_amdgcn_rcpf(bfhi(gb.z)); r1[2] = bflo(ga.w) * __builtin_amdgcn_rcpf(bflo(gb.w)); r1[3] = bfhi(ga.w) * __builtin_amdgcn_rcpf(bfhi(gb.w));
                        acc[ai][bj][m][0] *= r0; acc[ai][bj][m][1] *= r1;
                    } else {
                        const f32x4 v0 = acc[ai][bj][m][0] * (f32x4){bflo(gb.x), bfhi(gb.x), bflo(gb.y), bfhi(gb.y)}, v1 = acc[ai][bj][m][1] * (f32x4){bflo(gb.z), bfhi(gb.z), bflo(gb.w), bfhi(gb.w)};
                        u32x4 w; w.x = cvt_pk_bf16(v0[0], v0[1]); w.y = cvt_pk_bf16(v0[2], v0[3]); w.z = cvt_pk_bf16(v1[0], v1[1]); w.w = cvt_pk_bf16(v1[2], v1[3]);
                        *(u32x4*)(mix + (size_t)row * D + col) = w;
                    }
                }
            }
            asm volatile("" ::: "memory");
        }
    }
};
struct EpiRes {
    static constexpr bool PERM = false, AFTER_DRAIN = false;
    __device__ __forceinline__ void prefill(PG8_LAS unsigned char*) const {}
    __device__ static constexpr bool zero_after(const Unit&) { return true; }
    const float* base; float* xf; bf16_t* xb; float* ssn;
    __device__ __forceinline__ void init(f32x4 (&acc)[2][2][4][2], const Unit& u, int wr, int wc, int fr, int fq) const {
        const int col0 = u.pn * BM + wc * 32 + 4 * fq;
#pragma unroll
        for (int ai = 0; ai < 2; ++ai)
#pragma unroll
            for (int m = 0; m < 4; ++m) { const size_t off = (size_t)(u.pm * BM + ai * HALF + wr * 64 + m * 16 + fr) * D + col0;
#pragma unroll
                for (int bj = 0; bj < 2; ++bj)
#pragma unroll
                    for (int n = 0; n < 2; ++n) acc[ai][bj][m][n] = *(const f32x4*)(base + off + bj * HALF + n * 16); }
    }
    __device__ __forceinline__ void operator()(f32x4 (&acc)[2][2][4][2], const Unit& u, int wr, int wc, int fr, int fq, PG8_LAS unsigned char*) const {
        const int col0 = u.pn * BM + wc * 32 + 4 * fq;
#pragma unroll
        for (int ai = 0; ai < 2; ++ai)
#pragma unroll
            for (int m = 0; m < 4; ++m) {
                const int row = u.pm * BM + ai * HALF + wr * 64 + m * 16 + fr; const size_t off = (size_t)row * D + col0; float q = 0.f;
#pragma unroll
                for (int bj = 0; bj < 2; ++bj)
#pragma unroll
                    for (int n = 0; n < 2; ++n) { const f32x4 o = acc[ai][bj][m][n];
                        *(f32x4*)(xf + off + bj * HALF + n * 16) = o; q += (o[0] * o[0] + o[1] * o[1]) + (o[2] * o[2] + o[3] * o[3]);
                        if (xb) { u32x2 w; w.x = cvt_pk_bf16(o[0], o[1]); w.y = cvt_pk_bf16(o[2], o[3]); *(u32x2*)(xb + off + bj * HALF + n * 16) = w; } }
                if (ssn) { q += __shfl_xor(q, 16); q += __shfl_xor(q, 32); if (fq == 0) ssn[(size_t)row * 16 + u.pn * 4 + wc] = q; }
            }
    }
};
#define DPPF(oldv, src, ctrl, bc) __int_as_float(__builtin_amdgcn_update_dpp(__float_as_int(oldv), __float_as_int(src), (ctrl), 0xF, 0xF, (bc)))
struct EpiUp {
    static constexpr bool PERM = true, AFTER_DRAIN = false;
    __device__ __forceinline__ void init(f32x4 (&acc)[2][2][4][2], const Unit&, int, int, int, int) const {
#pragma unroll
        for (int a = 0; a < 2; ++a)
#pragma unroll
            for (int b = 0; b < 2; ++b)
#pragma unroll
                for (int m = 0; m < 4; ++m)
#pragma unroll
                    for (int n = 0; n < 2; ++n) acc[a][b][m][n] = (f32x4){0.f, 0.f, 0.f, 0.f};
    }
    __device__ static constexpr bool zero_after(const Unit&) { return true; }
    bf16_t* a; const float* ss; const float* cw; const float* cb; float* yb; int dup, row0;
    __device__ __forceinline__ void prefill(PG8_LAS unsigned char* lds_) const { rtab_fill(lds_, ss, row0); }
    __device__ __forceinline__ void operator()(f32x4 (&acc)[2][2][4][2], const Unit& u, int wr, int wc, int fr, int fq, PG8_LAS unsigned char* lds) const {
        PG8_LAS unsigned char* lds_ = lds; const int wid = wr * 4 + wc;
        PG8_LAS float* X = (PG8_LAS float*)(lds + XOFF);
        float rsv[2][4];
#pragma unroll
        for (int ai = 0; ai < 2; ++ai)
#pragma unroll
            for (int m = 0; m < 4; ++m) rsv[ai][m] = ((const PG8_LAS float*)(lds_ + RTAB_OFF))[(u.pm & 7) * BM + ai * HALF + wr * 64 + m * 16 + fr];
#pragma unroll
        for (int ai = 0; ai < 2; ++ai)
#pragma unroll
            for (int m = 0; m < 4; ++m) {
#pragma unroll
                for (int bj = 0; bj < 2; ++bj)
#pragma unroll
                    for (int n = 0; n < 2; ++n) acc[ai][bj][m][n] *= rsv[ai][m];
            }
#pragma unroll
        for (int ai = 0; ai < 2; ++ai) {
            if (fr == 0) {
#pragma unroll
                for (int bj = 0; bj < 2; ++bj)
#pragma unroll
                    for (int n = 0; n < 2; ++n) *(PG8_LAS f32x4*)(X + ((wid * 2 + ai) * 2 + 0) * 64 + 32 * bj + 8 * fq + 4 * n) = acc[ai][bj][0][n];
            }
            if (fr == 15) {
#pragma unroll
                for (int bj = 0; bj < 2; ++bj)
#pragma unroll
                    for (int n = 0; n < 2; ++n) *(PG8_LAS f32x4*)(X + ((wid * 2 + ai) * 2 + 1) * 64 + 32 * bj + 8 * fq + 4 * n) = acc[ai][bj][3][n];
            }
        }
        {
            const int ccol = u.pn * 128 + wc * 32 + 8 * fq;
            if (wr == 0 && fr < 2) {
#pragma unroll
                for (int bj = 0; bj < 2; ++bj)
#pragma unroll
                    for (int n = 0; n < 2; ++n) *(f32x4*)(yb + ((size_t)u.pm * 4 + fr) * FF2 + bj * FF + ccol + 4 * n) = acc[0][bj][0][n];
            }
            if (wr == 1 && fr >= 14) {
#pragma unroll
                for (int bj = 0; bj < 2; ++bj)
#pragma unroll
                    for (int n = 0; n < 2; ++n) *(f32x4*)(yb + ((size_t)u.pm * 4 + 2 + (fr - 14)) * FF2 + bj * FF + ccol + 4 * n) = acc[1][bj][3][n];
            }
        }
        asm volatile("s_waitcnt lgkmcnt(0)" ::: "memory"); __builtin_amdgcn_s_barrier(); asm volatile("" ::: "memory");
#pragma unroll
        for (int rep_ = 0; rep_ <= ((MK_EDUP & 1) ? 1 : 0); ++rep_) {
        if (rep_) {
#pragma unroll
            for (int ai = 0; ai < 2; ++ai)
#pragma unroll
                for (int bj = 0; bj < 2; ++bj)
#pragma unroll
                    for (int m = 0; m < 4; ++m)
#pragma unroll
                        for (int n = 0; n < 2; ++n) asm volatile("" : "+v"(acc[ai][bj][m][n]) :: "memory");
        }
#pragma unroll
        for (int n = 0; n < 2; ++n) {
            const int ccol = u.pn * 128 + wc * 32 + 8 * fq + 4 * n;
            f32x4 w0[2], w1[2], w2[2], bb[2];
#pragma unroll
            for (int bj = 0; bj < 2; ++bj) { w0[bj] = *(const f32x4*)(cw + bj * FF + ccol); w1[bj] = *(const f32x4*)(cw + FF2 + bj * FF + ccol); w2[bj] = *(const f32x4*)(cw + 2 * FF2 + bj * FF + ccol); bb[bj] = *(const f32x4*)(cb + bj * FF + ccol); }
#pragma unroll
            for (int ai = 0; ai < 2; ++ai) {
                const int pw = wr ? wid - 4 : wid + 4, pai = wr ? ai : 0;
                const int nw = wr ? wid - 4 : wid + 4, nai = wr ? 1 : ai;
                f32x4 xp[2], xn[2];
#pragma unroll
                for (int bj = 0; bj < 2; ++bj) { xp[bj] = *(PG8_LAS f32x4*)(X + ((pw * 2 + pai) * 2 + 1) * 64 + 32 * bj + 8 * fq + 4 * n); xn[bj] = *(PG8_LAS f32x4*)(X + ((nw * 2 + nai) * 2 + 0) * 64 + 32 * bj + 8 * fq + 4 * n); }
#pragma unroll
                for (int m = 0; m < 4; ++m) {
                    const int trow = ai * HALF + wr * 64 + m * 16 + fr;
                    float uv[2][4];
#pragma unroll
                    for (int bj = 0; bj < 2; ++bj)
#pragma unroll
                        for (int e = 0; e < 4; ++e) {
                            const float cur = acc[ai][bj][m][n][e];
                            float rp, rn;
                            if (m > 0) rp = DPPF(0.f, acc[ai][bj][m > 0 ? m - 1 : 0][n][e], 0x121, true); else rp = xp[bj][e];
                            if (m < 3) rn = DPPF(0.f, acc[ai][bj][m < 3 ? m + 1 : 3][n][e], 0x12F, true); else rn = xn[bj][e];
                            const float prev = DPPF(rp, cur, 0x111, false), next = DPPF(rn, cur, 0x101, false);
                            uv[bj][e] = bb[bj][e] + w0[bj][e] * prev + w1[bj][e] * cur + w2[bj][e] * next;
                        }
                    f32x4 o;
#pragma unroll
                    for (int e = 0; e < 4; ++e) o[e] = uv[0][e] * uv[1][e] * __builtin_amdgcn_rcpf(1.0f + __builtin_amdgcn_exp2f(-uv[1][e] * LOG2E));
                    u32x2 w; w.x = cvt_pk_bf16(o[0], o[1]); w.y = cvt_pk_bf16(o[2], o[3]);
                    if (trow != 0 && trow != 255) *(u32x2*)(a + (size_t)(u.pm * BM + trow) * FF + ccol) = w;
                    asm volatile("" ::: "memory");
                }
            }
        }
        }
    }
};

template <class Epi, class Sched, bool ALIGN_EPI = false, bool SP2 = false>
__device__ __forceinline__ void gemm_phase(PG8_LAS unsigned char* lds, const int K, const int lda, const Sched& S, const Epi& E) {
    int tid_ = threadIdx.x; asm volatile("" : "+v"(tid_));
    const int tid = tid_, wid = __builtin_amdgcn_readfirstlane(tid >> 6), lane = tid & 63, wr = wid >> 2, wc = wid & 3, fr = lane & 15, fq = lane >> 4;
    const int nt = K / BK;
    unsigned voffA[2], voffB[2];
#pragma unroll
    for (int i = 0; i < 2; ++i) { int R, C; stage_rc(tid * 16 + i * 8192, R, C); const int Rb = Epi::PERM ? ((R & ~31) + perm32(R & 31)) : R;
        voffA[i] = (unsigned)(R * lda + C) * 2u; voffB[i] = (unsigned)(Rb * K + C) * 2u; }
    const size_t kstep = (size_t)(BK * 2);
    const size_t hstepB = (size_t)HALF * K * 2;
    const size_t hstepA = (size_t)HALF * lda * 2;
    const unsigned ldsw = (unsigned)wid * 1024u;
    const int aoff = lds_byte(wr * 64 + fr, fq * 8), boff = lds_byte(wc * 32 + fr, fq * 8);
#define PG8_SA(b, h) (((b) * 2 + (h)) * HTB)
#define PG8_SB(b, h) ((4 + (b) * 2 + (h)) * HTB)
#define PG8_STAGE(bufoff, gbase, voff) do { _Pragma("unroll") for (int _i = 0; _i < 2; ++_i) \
        __builtin_amdgcn_global_load_lds((const unsigned*)((const char*)(gbase) + (voff)[_i]), (PG8_LAS unsigned*)(lds + (bufoff) + ldsw + _i * 8192), 16, 0, 0); } while (0)
#define PG8_LDA(dst, b, h) do { _Pragma("unroll") for (int m = 0; m < 4; ++m) _Pragma("unroll") for (int k = 0; k < 2; ++k) dst[m][k] = *(const PG8_LAS bf16x8*)(lds + PG8_SA(b, h) + aoff + m * 2048 + k * 1024); } while (0)
#define PG8_LDB(dst, b, h) do { _Pragma("unroll") for (int n = 0; n < 2; ++n) _Pragma("unroll") for (int k = 0; k < 2; ++k) dst[n][k] = *(const PG8_LAS bf16x8*)(lds + PG8_SB(b, h) + boff + n * 2048 + k * 1024); } while (0)
#define PG8_MMA(ai, bj, At, Bt) do { __builtin_amdgcn_s_setprio(1); _Pragma("unroll") for (int m = 0; m < 4; ++m) _Pragma("unroll") for (int n = 0; n < 2; ++n) _Pragma("unroll") for (int k = 0; k < 2; ++k) \
        acc[ai][bj][m][n] = __builtin_amdgcn_mfma_f32_16x16x32_bf16(Bt[n][k], At[m][k], acc[ai][bj][m][n], 0, 0, 0); __builtin_amdgcn_s_setprio(0); } while (0)
#define PG8_WAIT_V(n) asm volatile("s_waitcnt vmcnt(" #n ")" ::: "memory")
#define PG8_WAIT_L(n) asm volatile("s_waitcnt lgkmcnt(" #n ")" ::: "memory")
#define PG8_BAR __builtin_amdgcn_s_barrier()
#define PG8_SCHED __builtin_amdgcn_sched_barrier(0)
    Unit cur, nxt; int ui = 0;
    if (!S.next(0, cur)) return;
    f32x4 acc[2][2][4][2];
    E.init(acc, cur, wr, wc, fr, fq);
    bf16x8 At[4][2], B0[2][2], B1[2][2];
    const char* cA = S.aptr(cur); const char* cB = S.bptr(cur);
    S.a_ready(cur);
    if constexpr (SP2) {
        PG8_STAGE(PG8_SB(0, 0), cB, voffB); PG8_STAGE(PG8_SB(0, 1), cB + hstepB, voffB); PG8_STAGE(PG8_SA(0, 0), cA, voffA); PG8_STAGE(PG8_SA(0, 1), cA + hstepA, voffA);
        E.prefill(lds);
        if (wr == 1) PG8_BAR;
        PG8_WAIT_V(2); PG8_BAR;
        PG8_STAGE(PG8_SB(1, 0), cB + kstep, voffB); PG8_STAGE(PG8_SA(1, 0), cA + kstep, voffA); PG8_STAGE(PG8_SB(1, 1), cB + hstepB + kstep, voffB);
        PG8_WAIT_V(6); PG8_BAR;
    } else {
        PG8_STAGE(PG8_SB(0, 0), cB, voffB); PG8_STAGE(PG8_SA(0, 0), cA, voffA); PG8_STAGE(PG8_SB(0, 1), cB + hstepB, voffB); PG8_STAGE(PG8_SA(0, 1), cA + hstepA, voffA);
        E.prefill(lds);
        if (wr == 1) PG8_BAR;
        PG8_WAIT_V(4); PG8_BAR;
        PG8_STAGE(PG8_SB(1, 0), cB + kstep, voffB); PG8_STAGE(PG8_SA(1, 0), cA + kstep, voffA); PG8_STAGE(PG8_SB(1, 1), cB + hstepB + kstep, voffB);
        PG8_WAIT_V(6); PG8_BAR;
    }
    for (;;) {
        const bool has_next = S.next(ui + 1, nxt);
        const char* nA = has_next ? S.aptr(nxt) : cA; const char* nB = has_next ? S.bptr(nxt) : cB;
        for (int t = 0; t < nt; t += 2) {
            const bool last = (t == nt - 2);
            const char* a1 = cA + (size_t)(t + 1) * kstep;
            const char* a2 = last ? nA : cA + (size_t)(t + 2) * kstep; const char* b2 = last ? nB : cB + (size_t)(t + 2) * kstep;
            const char* a3 = a2 + kstep; const char* b3 = b2 + kstep;
            if (last && has_next) S.a_ready(nxt);
            if constexpr (SP2) {
            PG8_LDB(B0, 0, 0); PG8_LDB(B1, 0, 1); PG8_SCHED; PG8_LDA(At, 0, 0); PG8_STAGE(PG8_SA(1, 1), a1 + hstepA, voffA);
            PG8_WAIT_V(8); PG8_WAIT_L(0); PG8_BAR; PG8_MMA(0, 0, At, B0); PG8_MMA(0, 1, At, B1); PG8_BAR; PG8_SCHED;
            PG8_LDA(At, 0, 1); PG8_STAGE(PG8_SB(0, 0), b2, voffB); PG8_STAGE(PG8_SB(0, 1), b2 + hstepB, voffB); PG8_STAGE(PG8_SA(0, 0), a2, voffA);
            PG8_WAIT_V(8); PG8_WAIT_L(0); PG8_BAR; PG8_MMA(1, 0, At, B0); PG8_MMA(1, 1, At, B1); PG8_BAR; PG8_SCHED;
            PG8_LDB(B0, 1, 0); PG8_LDB(B1, 1, 1); PG8_SCHED; PG8_LDA(At, 1, 0); PG8_STAGE(PG8_SA(0, 1), a2 + hstepA, voffA);
            PG8_WAIT_V(8); PG8_WAIT_L(0); PG8_BAR; PG8_MMA(0, 0, At, B0); PG8_MMA(0, 1, At, B1); PG8_BAR; PG8_SCHED;
            PG8_LDA(At, 1, 1); PG8_STAGE(PG8_SB(1, 0), b3, voffB); PG8_STAGE(PG8_SB(1, 1), b3 + hstepB, voffB); PG8_STAGE(PG8_SA(1, 0), a3, voffA);
            PG8_WAIT_V(8); PG8_WAIT_L(0); PG8_BAR; PG8_MMA(1, 0, At, B0); PG8_MMA(1, 1, At, B1); PG8_BAR; PG8_SCHED;
            } else {
            PG8_LDB(B0, 0, 0); PG8_SCHED; PG8_LDA(At, 0, 0); PG8_STAGE(PG8_SA(1, 1), a1 + hstepA, voffA);
            PG8_WAIT_L(8); PG8_BAR; PG8_WAIT_L(0); PG8_MMA(0, 0, At, B0); PG8_BAR; PG8_SCHED;
            PG8_LDB(B1, 0, 1); PG8_STAGE(PG8_SB(0, 0), b2, voffB);
            PG8_BAR; PG8_WAIT_L(0); PG8_MMA(0, 1, At, B1); PG8_BAR;
            PG8_LDA(At, 0, 1); PG8_STAGE(PG8_SA(0, 0), a2, voffA);
            PG8_BAR; PG8_WAIT_L(0); PG8_MMA(1, 0, At, B0); PG8_BAR; PG8_SCHED;
            PG8_STAGE(PG8_SB(0, 1), b2 + hstepB, voffB);
            PG8_WAIT_V(6); PG8_BAR; PG8_MMA(1, 1, At, B1); PG8_BAR;
            PG8_LDB(B0, 1, 0); PG8_SCHED; PG8_LDA(At, 1, 0); PG8_STAGE(PG8_SA(0, 1), a2 + hstepA, voffA);
            PG8_WAIT_L(8); PG8_BAR; PG8_WAIT_L(0); PG8_MMA(0, 0, At, B0); PG8_BAR; PG8_SCHED;
            PG8_LDB(B1, 1, 1); PG8_STAGE(PG8_SB(1, 0), b3, voffB);
            PG8_BAR; PG8_WAIT_L(0); PG8_MMA(0, 1, At, B1); PG8_BAR;
            PG8_LDA(At, 1, 1); PG8_STAGE(PG8_SA(1, 0), a3, voffA);
            PG8_BAR; PG8_WAIT_L(0); PG8_MMA(1, 0, At, B0); PG8_BAR; PG8_SCHED;
            PG8_STAGE(PG8_SB(1, 1), b3 + hstepB, voffB);
            PG8_WAIT_V(6); PG8_BAR; PG8_MMA(1, 1, At, B1); PG8_BAR;
            }
        }
        if constexpr (ALIGN_EPI) { if (wr == 0) PG8_BAR; }
        if constexpr (!Epi::AFTER_DRAIN) { E(acc, cur, wr, wc, fr, fq, lds); S.done(cur); }
        if (!has_next) break;
        if (Epi::zero_after(cur)) E.init(acc, nxt, wr, wc, fr, fq);
        cur = nxt; cA = nA; cB = nB; ++ui;
        if constexpr (ALIGN_EPI) { if (wr == 1) PG8_BAR; }
    }
    PG8_WAIT_V(0);
    if constexpr (!ALIGN_EPI) { if (wr == 0) PG8_BAR; }
    PG8_BAR;
    if constexpr (Epi::AFTER_DRAIN) { E.fused(acc, cur, wr, wc, fr, fq, lds, wid, lane); S.done(cur); }
#undef PG8_SA
#undef PG8_SB
#undef PG8_STAGE
#undef PG8_LDA
#undef PG8_LDB
#undef PG8_MMA
#undef PG8_WAIT_V
#undef PG8_WAIT_L
#undef PG8_BAR
#undef PG8_SCHED
}
}

namespace att {
using namespace nv;
#define ALAS __attribute__((address_space(3)))
typedef short bf16x8 __attribute__((ext_vector_type(8)));
typedef short s16x4 __attribute__((ext_vector_type(4)));
typedef float f32x16 __attribute__((ext_vector_type(16)));
typedef float f32x4 __attribute__((ext_vector_type(4)));
typedef unsigned u32x4 __attribute__((ext_vector_type(4)));
typedef unsigned u32x2 __attribute__((ext_vector_type(2)));
typedef short v4i16_t __attribute__((ext_vector_type(4)));
typedef float f32x2_t __attribute__((ext_vector_type(2))); typedef __bf16 bf16x2_t __attribute__((ext_vector_type(2)));
constexpr int LUT_OFF = 98304, LUT_STRIDE = 520, GT_OFF = LUT_OFF + 12 * LUT_STRIDE * 4;
static_assert(GT_OFF + 512 <= 131072, "attention tables inside the ring region");
constexpr float NEG = -30000.f, THR = 6.f;
__device__ __forceinline__ unsigned cvtpk(float lo, float hi) { f32x2_t v = {lo, hi}; bf16x2_t b = __builtin_convertvector(v, bf16x2_t); return __builtin_bit_cast(unsigned, b); }
__device__ __forceinline__ s16x4 vtr(ALAS const unsigned char* p) { return __builtin_bit_cast(s16x4, __builtin_amdgcn_ds_read_tr16_b64_v4i16((ALAS v4i16_t*)p)); }
__device__ __forceinline__ void glds16(const void* gsrc, unsigned lds_dst) { unsigned keep;
    asm volatile("s_mov_b32 %0, m0\n\ts_mov_b32 m0, %2\n\ts_nop 0\n\tglobal_load_lds_dwordx4 %1, off\n\ts_mov_b32 m0, %0" : "=&s"(keep) : "v"(gsrc), "s"(lds_dst) : "memory"); }
__device__ __forceinline__ float swap_add(float v) { auto rr = __builtin_amdgcn_permlane32_swap(__float_as_uint(v), __float_as_uint(v), false, false); return __uint_as_float(rr[0]) + __uint_as_float(rr[1]); }
__device__ __forceinline__ float swap_max(float v) { auto rr = __builtin_amdgcn_permlane32_swap(__float_as_uint(v), __float_as_uint(v), false, false); return fmaxf(__uint_as_float(rr[0]), __uint_as_float(rr[1])); }
#define MX3(a, b, c) __builtin_fmaxf(__builtin_fmaxf((a), (b)), (c))

__device__ __forceinline__ void attn_tables(ALAS unsigned char* lds, const float* __restrict__ lutg, const float* __restrict__ subg, float osc) {
    int tid = threadIdx.x; asm volatile("" : "+v"(tid));
    ALAS float* lut = (ALAS float*)(lds + LUT_OFF); ALAS float* gt = (ALAS float*)(lds + GT_OFF);
    {
        typedef float lf4 __attribute__((ext_vector_type(4)));
        static_assert((12 * LUT_STRIDE) % 4 == 0 && 12 * LUT_STRIDE / 4 <= 4 * 512, "lut copy");
        const lf4* src = (const lf4*)lutg; lf4 v[4];
#pragma unroll
        for (int k = 0; k < 4; ++k) { const int i = tid + 512 * k; if (i < 12 * LUT_STRIDE / 4) v[k] = src[i]; }
#pragma unroll
        for (int k = 0; k < 4; ++k) { const int i = tid + 512 * k; if (i < 12 * LUT_STRIDE / 4) ((ALAS lf4*)lut)[i] = v[k]; }
    }
    if (tid < 128) gt[tid] = subg[tid] * osc;
    __syncthreads();
}
__device__ __forceinline__ float g4_max(float v) { v = fmaxf(v, __shfl_xor(v, 16)); return fmaxf(v, __shfl_xor(v, 32)); }
__device__ __forceinline__ float g4_sum(float v) { v += __shfl_xor(v, 16); return v + __shfl_xor(v, 32); }

template <bool ISB, int VAR = 0>
__device__ __forceinline__ void attn_unit(ALAS unsigned char* lds, bf16* zg, const float* __restrict__ lutg, int b, int hsel, int q0, const float* __restrict__ sinkp, float lam, float osc, const float* __restrict__ subg, bf16* odry) {
    int tid_ = threadIdx.x; asm volatile("" : "+v"(tid_));
    const int tid = tid_, lane = tid & 63, c16 = lane & 15, g = lane >> 4; const int wid = __builtin_amdgcn_readfirstlane(tid >> 6);
    constexpr int NDVB = ISB ? 8 : 4, BUF = ISB ? 32768 : 16384, VOFF = ISB ? 16384 : 8192, VROW = ISB ? 256 : 128;
    const int map = ISB ? (wid >> 2) : 0, qsub = ISB ? (wid & 3) : (wid & 1), gsel = ISB ? 0 : (wid >> 1);
    const int head = ISB ? hsel : hsel * 4 + gsel;
    const int qrow0 = q0 + 32 * qsub;
    const int qcol = ISB ? (C_QB + head * 128 + map * 64) : (C_QA + head * 64);
    const int kcol = ISB ? (C_KB + head * 128) : (C_KA + hsel * 64);
    const int vcol = ISB ? (C_VB + head * 128) : (C_VA + hsel * 64);
    const size_t rowbase = (size_t)b * S;
    int kt0 = 0, kt1 = S / 64;
    if (!ISB) { kt0 = q0 / 64 - 2; if (kt0 < 0) kt0 = 0; kt1 = q0 / 64 + 3; if (kt1 > S / 64) kt1 = S / 64; }
    const int nt = kt1 - kt0;
    ALAS float* lut = (ALAS float*)(lds + LUT_OFF) + (ISB ? 8 + head : hsel * 4 + gsel) * LUT_STRIDE;
    ALAS float* gt = (ALAS float*)(lds + GT_OFF);
    const float sink2 = ISB ? 0.f : sinkp[head] * LOG2E;
    bf16x8 qr[2][2];
#pragma unroll
    for (int qb = 0; qb < 2; ++qb) { const bf16* qp = zg + (rowbase + qrow0 + 16 * qb + c16) * ZG + qcol + 8 * g;
#pragma unroll
        for (int ks = 0; ks < 2; ++ks) qr[qb][ks] = *(const bf16x8*)(qp + 32 * ks); }
    const unsigned lds0 = (unsigned)(size_t)lds;
    const bf16* kp_[2]; const bf16* vp_[2];
#pragma unroll
    for (int i_ = 0; i_ < 2; ++i_) { const int p_ = ISB ? wid * 2 + i_ : wid;
        kp_[i_] = zg + (rowbase + (size_t)kt0 * 64 + (p_ & 7) * 8 + (lane >> 3)) * ZG + kcol + (ISB ? (p_ >> 3) * 64 : 0) + ((lane & 7) ^ (lane >> 3)) * 8;
        vp_[i_] = ISB ? zg + (rowbase + (size_t)kt0 * 64 + 4 * p_ + (lane >> 4)) * ZG + vcol + ((((lane & 15) >> 1) ^ (4 * (p_ & 1) + (lane >> 4))) * 16) + 8 * (lane & 1)
                      : zg + (rowbase + (size_t)kt0 * 64 + 8 * p_ + (lane >> 3)) * ZG + vcol + ((((lane & 7) >> 1) ^ ((lane >> 4) & 3)) * 16) + 8 * (lane & 1); }
#define ATT_ISSUE(bo) do { \
        _Pragma("unroll") for (int i_ = 0; i_ < (ISB ? 2 : 1); ++i_) { const int p_ = ISB ? wid * 2 + i_ : wid; \
            glds16(kp_[i_], (unsigned)__builtin_amdgcn_readfirstlane((int)(lds0 + (bo) + p_ * 1024))); \
            glds16(vp_[i_], (unsigned)__builtin_amdgcn_readfirstlane((int)(lds0 + (bo) + VOFF + p_ * 1024))); \
            kp_[i_] += 64 * ZG; vp_[i_] += 64 * ZG; } } while (0)
#define ATT_SB() __builtin_amdgcn_sched_barrier(0)
    float mhat[2] = {0.f, 0.f}, lsum[2] = {0.f, 0.f};
    f32x4 o[2][NDVB];
#pragma unroll
    for (int qb = 0; qb < 2; ++qb)
#pragma unroll
        for (int d = 0; d < NDVB; ++d) o[qb][d] = (f32x4){0.f, 0.f, 0.f, 0.f};
    const int kfo = (ISB ? map * 8192 : 0) + c16 * 128 + ((g ^ (c16 & 7)) * 16);
    const int vq = (lane & 15) >> 2, vsw = ISB ? (4 * (g & 1) + vq) : (2 * (g & 1) + (vq >> 1));
    const int vfo = VOFF + (4 * g + vq) * VROW + (lane & 3) * 8;
    u32x4 pw[2][2];
    const float cfar_r = ISB ? lut[256 + 128] : 0.f, cfar_l = ISB ? lut[256 - 128] : 0.f;
#define ATT_QK(P, t, so) do { const int kb_ = (t) * 64; float cf_ = 0.f; \
        if (ISB) { if (kb_ - qrow0 - 31 >= 91) cf_ = cfar_r; else if (kb_ + 63 - qrow0 <= -91) cf_ = cfar_l; } \
        const float c0_ = cf_ - mhat[0], c1_ = cf_ - mhat[1]; const f32x4 ci0_ = (f32x4){c0_, c0_, c0_, c0_}, ci1_ = (f32x4){c1_, c1_, c1_, c1_}; \
        ALAS const unsigned char* kp = lds + (so) + kfo; \
        _Pragma("unroll") for (int kb = 0; kb < 4; ++kb) { \
            const bf16x8 k0_ = *(ALAS const bf16x8*)(kp + kb * 2048), k1_ = *(ALAS const bf16x8*)((ALAS const unsigned char*)((unsigned)(size_t)kp ^ 64u) + kb * 2048); \
            P[0][kb] = __builtin_amdgcn_mfma_f32_16x16x32_bf16(k0_, qr[0][0], ci0_, 0, 0, 0); P[1][kb] = __builtin_amdgcn_mfma_f32_16x16x32_bf16(k0_, qr[1][0], ci1_, 0, 0, 0); \
            P[0][kb] = __builtin_amdgcn_mfma_f32_16x16x32_bf16(k1_, qr[0][1], P[0][kb], 0, 0, 0); P[1][kb] = __builtin_amdgcn_mfma_f32_16x16x32_bf16(k1_, qr[1][1], P[1][kb], 0, 0, 0); } } while (0)
#define ATT_DECIDE(P, t, first) do { const int kb_ = (t) * 64; \
        if (!ISB || !((kb_ - qrow0 - 31 >= 91) || (kb_ + 63 - qrow0 <= -91))) { \
            ALAS const float* lp = lut + (kb_ - (qrow0 + c16) + 256 + 4 * g); \
            _Pragma("unroll") for (int qb = 0; qb < 2; ++qb) { float lv_[16]; \
                _Pragma("unroll") for (int kb = 0; kb < 4; ++kb) _Pragma("unroll") for (int r = 0; r < 4; ++r) lv_[4 * kb + r] = lp[16 * kb - 16 * qb + r]; \
                _Pragma("unroll") for (int kb = 0; kb < 4; ++kb) _Pragma("unroll") for (int r = 0; r < 4; ++r) P[qb][kb][r] += lv_[4 * kb + r]; } } \
        float rm0_ = MX3(MX3(P[0][0][0], P[0][0][1], P[0][0][2]), P[0][0][3], P[0][1][0]), rm1_ = MX3(MX3(P[1][0][0], P[1][0][1], P[1][0][2]), P[1][0][3], P[1][1][0]); \
        rm0_ = MX3(MX3(rm0_, P[0][1][1], P[0][1][2]), P[0][1][3], P[0][2][0]); rm1_ = MX3(MX3(rm1_, P[1][1][1], P[1][1][2]), P[1][1][3], P[1][2][0]); \
        rm0_ = MX3(MX3(rm0_, P[0][2][1], P[0][2][2]), P[0][2][3], P[0][3][0]); rm1_ = MX3(MX3(rm1_, P[1][2][1], P[1][2][2]), P[1][2][3], P[1][3][0]); \
        rm0_ = MX3(MX3(rm0_, P[0][3][1], P[0][3][2]), P[0][3][3], rm0_); rm1_ = MX3(MX3(rm1_, P[1][3][1], P[1][3][2]), P[1][3][3], rm1_); \
        if ((first) || __any(__builtin_fmaxf(rm0_, rm1_) > THR)) { \
            const float f0_ = g4_max(rm0_), f1_ = g4_max(rm1_); \
            const float dl0 = (first) ? f0_ : __builtin_fmaxf(f0_, 0.f), dl1 = (first) ? f1_ : __builtin_fmaxf(f1_, 0.f); \
            mhat[0] += dl0; mhat[1] += dl1; \
            _Pragma("unroll") for (int kb = 0; kb < 4; ++kb) { P[0][kb] -= dl0; P[1][kb] -= dl1; } \
            if (!(first)) { const float s0_ = __builtin_amdgcn_exp2f(-dl0), s1_ = __builtin_amdgcn_exp2f(-dl1); lsum[0] *= s0_; lsum[1] *= s1_; \
                _Pragma("unroll") for (int d = 0; d < NDVB; ++d) { o[0][d] *= s0_; o[1][d] *= s1_; } } } } while (0)
#define ATT_FINISH(P) do { \
        _Pragma("unroll") for (int qb = 0; qb < 2; ++qb) { float sa_ = 0.f; \
            _Pragma("unroll") for (int kb = 0; kb < 4; ++kb) _Pragma("unroll") for (int r = 0; r < 4; ++r) { P[qb][kb][r] = __builtin_amdgcn_exp2f(P[qb][kb][r]); sa_ += P[qb][kb][r]; } \
            lsum[qb] += sa_; \
            _Pragma("unroll") for (int s_ = 0; s_ < 2; ++s_) pw[qb][s_] = (u32x4){cvtpk(P[qb][2 * s_][0], P[qb][2 * s_][1]), cvtpk(P[qb][2 * s_][2], P[qb][2 * s_][3]), cvtpk(P[qb][2 * s_ + 1][0], P[qb][2 * s_ + 1][1]), cvtpk(P[qb][2 * s_ + 1][2], P[qb][2 * s_ + 1][3])}; } } while (0)
#define ATT_LDV2(dst, s_, d0_) do { _Pragma("unroll") for (int dd = 0; dd < 2; ++dd) { ALAS const unsigned char* a_ = vp + (s_) * 32 * VROW + ((((d0_) + dd) ^ vsw) * 32); dst[2 * dd] = vtr(a_); dst[2 * dd + 1] = vtr(a_ + 16 * VROW); } } while (0)
#define ATT_PV2(src, s_, d0_) do { __builtin_amdgcn_s_setprio(1); _Pragma("unroll") for (int dd = 0; dd < 2; ++dd) { \
            const bf16x8 vf_ = (bf16x8){src[2 * dd][0], src[2 * dd][1], src[2 * dd][2], src[2 * dd][3], src[2 * dd + 1][0], src[2 * dd + 1][1], src[2 * dd + 1][2], src[2 * dd + 1][3]}; \
            o[0][(d0_) + dd] = __builtin_amdgcn_mfma_f32_16x16x32_bf16(vf_, __builtin_bit_cast(bf16x8, pw[0][s_]), o[0][(d0_) + dd], 0, 0, 0); \
            o[1][(d0_) + dd] = __builtin_amdgcn_mfma_f32_16x16x32_bf16(vf_, __builtin_bit_cast(bf16x8, pw[1][s_]), o[1][(d0_) + dd], 0, 0, 0); } __builtin_amdgcn_s_setprio(0); } while (0)
#define ATT_PV(so) do { ALAS const unsigned char* vp = lds + (so) + vfo; s16x4 va[4], vb[4]; constexpr int NG_ = NDVB / 2; \
        ATT_LDV2(va, 0, 0); ATT_SB(); \
        _Pragma("unroll") for (int k_ = 0; k_ < 2 * NG_; k_ += 2) { \
            ATT_LDV2(vb, (k_ + 1) / NG_, 2 * ((k_ + 1) % NG_)); ATT_SB(); \
            ATT_PV2(va, k_ / NG_, 2 * (k_ % NG_)); ATT_SB(); \
            if (k_ + 2 < 2 * NG_) { ATT_LDV2(va, (k_ + 2) / NG_, 2 * ((k_ + 2) % NG_)); ATT_SB(); } \
            ATT_PV2(vb, (k_ + 1) / NG_, 2 * ((k_ + 1) % NG_)); ATT_SB(); } } while (0)
#define ATT_SLOT(i) (ISB ? (((i) % 3) * BUF) : ((i) * BUF))
#define ATT_STEP(i, PC, PP) do { \
        if (ISB) { asm volatile("s_waitcnt vmcnt(0)" ::: "memory"); __syncthreads(); if ((i) + 1 < nt) ATT_ISSUE(ATT_SLOT((i) + 1)); } \
        ATT_QK(PC, kt0 + (i), ATT_SLOT(i)); ATT_SB(); \
        ATT_FINISH(PP); ATT_SB(); \
        ATT_PV(ATT_SLOT((i) - 1)); ATT_SB(); \
        ATT_DECIDE(PC, kt0 + (i), false); ATT_SB(); } while (0)
    f32x4 pA[2][4], pB[2][4];
    if (ISB) { ATT_ISSUE(0); asm volatile("s_waitcnt vmcnt(0)" ::: "memory"); __syncthreads(); if (nt > 1) ATT_ISSUE(BUF); }
    else {
#pragma unroll 1
        for (int i = 0; i < nt; ++i) ATT_ISSUE(i * BUF);
        asm volatile("s_waitcnt vmcnt(0)" ::: "memory"); __syncthreads();
    }
    ATT_QK(pA, kt0, 0); ATT_SB();
    ATT_DECIDE(pA, kt0, true); ATT_SB();
    int i = 1;
#pragma unroll 1
    for (; i + 1 < nt; i += 2) {
        ATT_STEP(i, pB, pA);
        ATT_STEP(i + 1, pA, pB);
    }
    if (i < nt) {
        ATT_STEP(i, pB, pA);
        ATT_FINISH(pB); ATT_SB(); ATT_PV(ATT_SLOT(nt - 1));
    } else {
        ATT_FINISH(pA); ATT_SB(); ATT_PV(ATT_SLOT(nt - 1));
    }
#undef ATT_ISSUE
#undef ATT_SB
#undef ATT_QK
#undef ATT_DECIDE
#undef ATT_FINISH
#undef ATT_LDV2
#undef ATT_PV2
#undef ATT_PV
#undef ATT_SLOT
#undef ATT_STEP
    float inv[2];
#pragma unroll
    for (int qb = 0; qb < 2; ++qb) { float l_ = g4_sum(lsum[qb]); if (!ISB) l_ += __builtin_amdgcn_exp2f(sink2 - mhat[qb]); inv[qb] = 1.0f / l_; }
    constexpr int DVE = ISB ? 128 : 64, SPITCH = DVE * 2 + 8;
    bf16* obase = odry ? odry + (rowbase + qrow0) * D + (ISB ? (512 + head * 128) : (head * 64)) : zg + (rowbase + qrow0) * ZG + (ISB ? (C_QB + head * 128) : (C_QA + head * 64));
    const size_t opitch = odry ? D : ZG;
    ALAS unsigned char* stg = lds + (ISB ? qsub * 16384 : wid * 4608);
#define ATT_OUT() do { asm volatile("s_waitcnt lgkmcnt(0)" ::: "memory"); \
        constexpr int LPR = DVE / 8, RPI = 64 / LPR; \
        _Pragma("unroll") for (int i_ = 0; i_ < 32 / RPI; ++i_) { const int row_ = i_ * RPI + lane / LPR, ch_ = lane % LPR; \
            const u32x2 a_ = *(ALAS const u32x2*)(stg + row_ * SPITCH + ch_ * 16), b_ = *(ALAS const u32x2*)(stg + row_ * SPITCH + ch_ * 16 + 8); \
            *(u32x4*)(obase + (size_t)row_ * opitch + ch_ * 8) = (u32x4){a_.x, a_.y, b_.x, b_.y}; } } while (0)
    if (ISB) {
        __syncthreads();
        ALAS float* cs = (ALAS float*)lds;
        if (map == 1) {
#pragma unroll
            for (int qb = 0; qb < 2; ++qb) { const float sc = -lam * inv[qb];
#pragma unroll
                for (int d = 0; d < NDVB; ++d)
#pragma unroll
                    for (int r = 0; r < 4; ++r) cs[(qsub * 64 + (qb * NDVB + d) * 4 + r) * 64 + lane] = o[qb][d][r] * sc; } }
        __syncthreads();
        if (map == 0) {
            float rstd[2];
#pragma unroll
            for (int qb = 0; qb < 2; ++qb) { float q = 0.f;
#pragma unroll
                for (int d = 0; d < NDVB; ++d)
#pragma unroll
                    for (int r = 0; r < 4; ++r) { const float v = o[qb][d][r] * inv[qb] + cs[(qsub * 64 + (qb * NDVB + d) * 4 + r) * 64 + lane]; o[qb][d][r] = v; q += v * v; }
                rstd[qb] = rsqrtf(g4_sum(q) * (1.0f / 128.0f) + EPS); }
            asm volatile("s_waitcnt lgkmcnt(0)" ::: "memory");
#pragma unroll
            for (int qb = 0; qb < 2; ++qb)
#pragma unroll
                for (int d = 0; d < NDVB; ++d) { const int dv0 = 16 * d + 4 * g; const f32x4 gv = *(ALAS const f32x4*)(gt + dv0);
                    u32x2 w; w.x = cvtpk(o[qb][d][0] * rstd[qb] * gv[0], o[qb][d][1] * rstd[qb] * gv[1]); w.y = cvtpk(o[qb][d][2] * rstd[qb] * gv[2], o[qb][d][3] * rstd[qb] * gv[3]);
                    *(ALAS u32x2*)(stg + (16 * qb + c16) * SPITCH + dv0 * 2) = w; }
            ATT_OUT();
        }
    } else {
        __syncthreads();
#pragma unroll
        for (int qb = 0; qb < 2; ++qb)
#pragma unroll
            for (int d = 0; d < NDVB; ++d) { const int dv0 = 16 * d + 4 * g;
                u32x2 w; w.x = cvtpk(o[qb][d][0] * inv[qb], o[qb][d][1] * inv[qb]); w.y = cvtpk(o[qb][d][2] * inv[qb], o[qb][d][3] * inv[qb]);
                *(ALAS u32x2*)(stg + (16 * qb + c16) * SPITCH + dv0 * 2) = w; }
        ATT_OUT();
    }
#undef ATT_OUT
    __syncthreads();
}
#undef MX3
}

#ifndef MK_VAR
#define MK_VAR 0
#endif
#define MK_DUP 0
#define MK_DSEL 0
namespace mk {
using namespace nv;
constexpr int NWAVES = 8;
constexpr size_t MiB = 1u << 20;
constexpr size_t WS_CTL = 0, CTL_ZERO_BYTES = 1 * MiB;
constexpr size_t WS_LUT = 512 * 1024;
constexpr size_t WS_SS = 1 * MiB;
constexpr size_t WS_XB = 6 * MiB;
constexpr size_t WS_ZG = 38 * MiB;
constexpr size_t WS_A = 38 * MiB;
constexpr size_t WS_YB = 126 * MiB;
constexpr size_t WS_MIX = 174 * MiB;
constexpr size_t WS_W = 206 * MiB;
constexpr size_t WL_IN = 0, WL_A = (size_t)ZG * D, WL_B = WL_A + (size_t)D * 512, WL_O = WL_B + (size_t)D * 512, WL_UP = WL_O + (size_t)D * D, WL_DN = WL_UP + (size_t)FF2 * D, WL_END = WL_DN + (size_t)D * FF;
constexpr size_t WS_END = 322 * MiB;
static_assert(WS_W + 4 * WL_END * 2 <= WS_END && WS_YB + (size_t)64 * 4 * FF2 * 4 <= WS_MIX && WS_A + (size_t)T * FF * 2 <= WS_YB, "d_ws map");
constexpr int CW_Q = 2048;
constexpr int CW_BAR = 8192;
constexpr int N_PHASES = 1 + 6 * L;
constexpr int RING_OFF = 0, RING_BYTES = 131072, LDSCTL_OFF = RING_BYTES, MISC_OFF = LDSCTL_OFF + 320;
constexpr int LDS_BYTES = 149504;
static_assert(pg8::RTAB_OFF + 8192 <= LDS_BYTES && MISC_OFF + 128 <= pg8::XOFF, "LDS map");

#define GAS __attribute__((address_space(1)))
#define LAS __attribute__((address_space(3)))
typedef unsigned v4u __attribute__((ext_vector_type(4)));
typedef float f32x4 __attribute__((ext_vector_type(4)));
typedef GAS unsigned gu32;
#define RLX_AGENT __ATOMIC_RELAXED, __HIP_MEMORY_SCOPE_AGENT
#define LDS_WAIT() asm volatile("s_waitcnt lgkmcnt(0)" ::: "memory")
#define VM_WAIT() asm volatile("s_waitcnt vmcnt(0)" ::: "memory")
__device__ __forceinline__ unsigned f2bfu(float f) { unsigned u = __builtin_bit_cast(unsigned, f); return (u + 0x7fffu + ((u >> 16) & 1u)) >> 16; }
__device__ __forceinline__ unsigned pk2(float lo, float hi) { return f2bfu(lo) | (f2bfu(hi) << 16); }

#define XB_TMO      128
#define XB_XCNT(j)  (256  + 64 * (j))
#define XB_XSUB(j)  (1280 + 64 * (j))
#define XB_XGEN(j)  (2304 + 64 * (j))
#define XB_TOP      3328
#define XB_TOPGEN   3392
#define XB_LSUB(j)  (3456 + 64 * (j))
#define XB_LGEN(j)  (4480 + 64 * (j))
#define XCD_BAR_WORDS 5504
#define XB_SPIN_CAP (1u << 18)

__device__ __forceinline__ unsigned xb_ld(unsigned* p)              { return __hip_atomic_load(p, __ATOMIC_RELAXED, __HIP_MEMORY_SCOPE_AGENT); }
__device__ __forceinline__ unsigned xb_add(unsigned* p, unsigned v) { return __hip_atomic_fetch_add(p, v, __ATOMIC_RELAXED, __HIP_MEMORY_SCOPE_AGENT); }
__device__ __forceinline__ unsigned xb_xcc_id() { return (unsigned)__builtin_amdgcn_s_getreg((3 << 11) | 20) & 0xFu; }
#define XB_SPIN(cond, bar) do { unsigned _sp = 0; while (cond) { __builtin_amdgcn_s_sleep(1); \
    if ((++_sp & 255u) == 0u) { if (xb_ld(&(bar)[XB_TMO])) break; if (_sp > XB_SPIN_CAP) { atomicAdd(&(bar)[XB_TMO], 1u); break; } } } } while (0)

struct XcdBarrier {
    unsigned* bar; unsigned x;
    volatile LAS unsigned* st;
};

__device__ __forceinline__ XcdBarrier xcd_barrier_post(unsigned* bar, volatile LAS unsigned* st) {
    XcdBarrier b; b.bar = bar; b.x = xb_xcc_id(); b.st = st;
    if (threadIdx.x == 0) { st[2] = b.x; st[3] = xb_add(&bar[XB_XCNT(b.x)], 1u); }
    return b;
}
__device__ __forceinline__ void xcd_barrier_complete(unsigned* bar, unsigned x, unsigned& nloc, unsigned& nx, unsigned& even) {
    const unsigned G = gridDim.x * gridDim.y * gridDim.z;
    unsigned sum, cnt, mine, odd, sp = 0u;
    for (;;) {
        sum = 0u; cnt = 0u; mine = 0u; odd = 0u;
#pragma unroll
        for (unsigned j = 0; j < 16; ++j) { const unsigned c = xb_ld(&bar[XB_XCNT(j)]); sum += c; cnt += (c > 0u) ? 1u : 0u; mine = (j == x) ? c : mine; odd += (c != 0u && c != 32u) ? 1u : 0u; }
        if (sum == G) break;
        __builtin_amdgcn_s_sleep(1);
        if ((++sp & 255u) == 0u) { if (xb_ld(&bar[XB_TMO])) break; if (sp > XB_SPIN_CAP) { atomicAdd(&bar[XB_TMO], 1u); break; } }
    }
    nloc = mine > 0u ? mine : 1u; nx = cnt > 0u ? cnt : 1u;
    even = (sum == G && G == 256u && cnt == 8u && odd == 0u) ? 1u : 0u;
}

__device__ __forceinline__ void xcd_barrier(const XcdBarrier& b) {
    asm volatile("s_waitcnt vmcnt(0)" ::: "memory");
    __syncthreads();
    if (threadIdx.x == 0) {
        unsigned* bar = b.bar;
        __builtin_amdgcn_s_waitcnt(0);
        unsigned nloc = b.st[0], nx = b.st[1];
        if (nloc == 0u) { unsigned even; xcd_barrier_complete(bar, b.x, nloc, nx, even); b.st[0] = nloc; b.st[1] = nx; b.st[4] = even; }
        const unsigned old = xb_add(&bar[XB_XSUB(b.x)], 1u);
        const unsigned gen = old / nloc;
        if (old + 1u == (gen + 1u) * nloc) {
            __builtin_amdgcn_fence(__ATOMIC_RELEASE, "agent");
            asm volatile("s_waitcnt vmcnt(0)" ::: "memory");
            const unsigned og = xb_add(&bar[XB_TOP], 1u);
            const unsigned tg = og / nx;
            if (og + 1u == (tg + 1u) * nx) xb_add(&bar[XB_TOPGEN], 1u);
            else XB_SPIN(xb_ld(&bar[XB_TOPGEN]) == tg, bar);
            __builtin_amdgcn_fence(__ATOMIC_ACQUIRE, "agent");
            xb_add(&bar[XB_XGEN(b.x)], 1u);
            asm volatile("s_waitcnt vmcnt(0)" ::: "memory");
        } else {
            XB_SPIN(xb_ld(&bar[XB_XGEN(b.x)]) == gen, bar);
            __builtin_amdgcn_fence(__ATOMIC_ACQUIRE, "agent");
            asm volatile("s_waitcnt vmcnt(0)" ::: "memory");
        }
    }
    __syncthreads();
}

__device__ __forceinline__ void xcd_local_barrier(const XcdBarrier& b) {
    asm volatile("s_waitcnt vmcnt(0)" ::: "memory");
    __syncthreads();
    if (threadIdx.x == 0) {
        unsigned* bar = b.bar;
        __builtin_amdgcn_s_waitcnt(0);
        const unsigned nloc = b.st[0];
        const unsigned old = xb_add(&bar[XB_LSUB(b.x)], 1u);
        const unsigned gen = old / nloc;
        if (old + 1u == (gen + 1u) * nloc) xb_add(&bar[XB_LGEN(b.x)], 1u);
        else XB_SPIN(xb_ld(&bar[XB_LGEN(b.x)]) == gen, bar);
        __builtin_amdgcn_fence(__ATOMIC_ACQUIRE, "agent");
        asm volatile("s_waitcnt vmcnt(0)" ::: "memory");
    }
    __syncthreads();
}

struct Args { const float* in[24]; float* out; unsigned char* ws; int ph_lo, ph_hi, li, pad; };

__device__ __forceinline__ void p0_transpose_item(const float* __restrict__ W, int ldw, int K, int k0, int n0, bf16* __restrict__ WT, int vrow0, const float* __restrict__ gain, LAS float* scr, int lane) {
    f32x4 v[8];
    const float* wp = W + (size_t)(k0 + (lane >> 3)) * ldw + n0 + 4 * (lane & 7);
#pragma unroll
    for (int i = 0; i < 8; ++i) v[i] = __builtin_nontemporal_load((const f32x4*)(wp + (size_t)(8 * i) * ldw));
    if (gain) {
#pragma unroll
        for (int i = 0; i < 8; ++i) v[i] *= gain[k0 + 8 * i + (lane >> 3)];
    }
#pragma unroll
    for (int i = 0; i < 8; ++i) { LAS float* d = scr + (8 * i + (lane >> 3)) * 33 + 4 * (lane & 7); d[0] = v[i].x; d[1] = v[i].y; d[2] = v[i].z; d[3] = v[i].w; }
    LDS_WAIT(); asm volatile("" ::: "memory");
    const int c = lane & 7;
#pragma unroll
    for (int j = 0; j < 4; ++j) { const int n = (lane >> 3) + 8 * j; const LAS float* s = scr + (8 * c) * 33 + n;
        v4u o; o.x = pk2(s[0 * 33], s[1 * 33]); o.y = pk2(s[2 * 33], s[3 * 33]); o.z = pk2(s[4 * 33], s[5 * 33]); o.w = pk2(s[6 * 33], s[7 * 33]);
        *(GAS v4u*)(WT + (size_t)(vrow0 + n) * K + k0 + 8 * c) = o; }
    LDS_WAIT(); asm volatile("" ::: "memory");
}
__device__ __forceinline__ int vrow_in(int c) { const int pn = c >> 8, cr = c & 255, wc = cr >> 6, bj = (cr >> 5) & 1; return pn * 256 + bj * 128 + wc * 32; }
__device__ __forceinline__ int vrow_up(int c) { const int gs = c >= FF ? 1 : 0, cc = c - gs * FF, pn = cc >> 7, wc = (cc >> 5) & 3; return pn * 256 + gs * 128 + wc * 32; }

__device__ __forceinline__ int cur_bxv(volatile LAS unsigned* MISC) { int b = blockIdx.x; const unsigned ev = MISC[12]; if (ev) b = (int)(MISC[11] * 8u + MISC[10]); return __builtin_amdgcn_readfirstlane(b); }
__device__ __forceinline__ int cur_vcu(volatile LAS unsigned* MISC) { const int b = cur_bxv(MISC), G = gridDim.x; return (G % 8 == 0) ? (b % 8) * (G / 8) + b / 8 : b; }
__global__ void __launch_bounds__(NWAVES * 64, 2) skel_fwd(Args args) {
    extern __shared__ __attribute__((aligned(16))) unsigned char lds_raw[];
    LAS unsigned char* lds = (LAS unsigned char*)lds_raw;
    volatile LAS unsigned* MISC = (volatile LAS unsigned*)(lds + MISC_OFF);
    const int G = gridDim.x;
    unsigned char* ws = args.ws;
    gu32* ctl = (gu32*)(ws + WS_CTL);
    float* ss = (float*)(ws + WS_SS); bf16* xb = (bf16*)(ws + WS_XB); bf16* zg = (bf16*)(ws + WS_ZG); bf16* abuf = (bf16*)(ws + WS_A); float* yb = (float*)(ws + WS_YB);
    bf16* mix = (bf16*)(ws + WS_MIX); bf16* wbase = (bf16*)(ws + WS_W); float* xf = args.out;
    float* lutg = (float*)(ws + WS_LUT);
    for (int u = threadIdx.x; u < (LDS_BYTES - LDSCTL_OFF) / 4; u += NWAVES * 64) ((LAS unsigned*)(lds + LDSCTL_OFF))[u] = 0u;
    __syncthreads();
    XcdBarrier bar = xcd_barrier_post((unsigned*)(ctl + CW_BAR) + args.li * XCD_BAR_WORDS, MISC + 8);

#pragma unroll 1
    for (int ph = args.ph_lo; ph < args.ph_hi; ++ph) {
        const int l = ph > 0 ? (ph - 1) / 6 : 0, p = ph > 0 ? (ph - 1) % 6 + 1 : 0;
#define BXV() cur_bxv(MISC)
#define VCU() cur_vcu(MISC)
        bf16* wl = wbase + (size_t)l * WL_END;
        float* ss1 = ss + (size_t)((2 * l) & 3) * T * 16; float* ss2 = ss + (size_t)((2 * l + 1) & 3) * T * 16; float* ss3 = (l + 1 < L) ? ss + (size_t)((2 * l + 2) & 3) * T * 16 : nullptr;
#ifndef MK_ONLY
#define MK_ONLY 0x7f
#endif
        const int dupp = ((args.pad >> 8) & 0xff) - 1;
#pragma unroll 1
        for (int rep = (p == dupp) ? 0 : 1; rep < 2; ++rep) {
        if (p == 0 && (MK_ONLY & 1)) {
            int tid0 = threadIdx.x; asm volatile("" : "+v"(tid0));
            const int lane0 = tid0 & 63, wave = __builtin_amdgcn_readfirstlane(tid0 >> 6);
            LAS float* scr = (LAS float*)(lds + RING_OFF + wave * 16384);
            const int gw = VCU() * NWAVES + wave, NGW = G * NWAVES;
            constexpr int I_IN = (D / 64) * (INW / 32), I_G = (D / 64) * (GW / 32), I_A = (512 / 64) * (D / 32), I_O = (D / 64) * (D / 32), I_UP = (D / 64) * (FF2 / 32), I_DN = (FF / 64) * (D / 32);
            constexpr int I_LAYER = I_IN + I_G + 2 * I_A + I_O + I_UP + I_DN;
            for (int i = gw * 64 + lane0; i < 12 * att::LUT_STRIDE; i += NGW * 64) { const int hh = i / att::LUT_STRIDE, j = i - hh * att::LUT_STRIDE, rel = j - 256, ar = rel < 0 ? -rel : rel;
                float v = 0.f; if (j <= 512) v = (hh < 8 && ar > 128) ? att::NEG : args.in[13][t5_bucket(rel) * 12 + hh] * LOG2E;
                lutg[i] = v; }
            for (int m = gw; m < T; m += 2 * NGW) {
                const int m2 = m + NGW;
                const GAS f32x4* xr = (const GAS f32x4*)(args.in[0] + (size_t)m * D) + lane0; const GAS f32x4* xr2 = (const GAS f32x4*)(args.in[0] + (size_t)m2 * D) + lane0;
                GAS unsigned long long* o8 = (GAS unsigned long long*)(xb + (size_t)m * D) + lane0; GAS unsigned long long* o82 = (GAS unsigned long long*)(xb + (size_t)m2 * D) + lane0;
                f32x4 va[4], vb[4];
#pragma unroll
                for (int j = 0; j < 4; ++j) { va[j] = xr[64 * j]; vb[j] = xr2[64 * j]; }
                float s = 0.f, s2 = 0.f;
#pragma unroll
                for (int j = 0; j < 4; ++j) { const f32x4 v = va[j], w = vb[j]; s += (v.x * v.x + v.y * v.y) + (v.z * v.z + v.w * v.w); s2 += (w.x * w.x + w.y * w.y) + (w.z * w.z + w.w * w.w);
                    o8[64 * j] = (unsigned long long)pk2(v.x, v.y) | ((unsigned long long)pk2(v.z, v.w) << 32); o82[64 * j] = (unsigned long long)pk2(w.x, w.y) | ((unsigned long long)pk2(w.z, w.w) << 32); }
                s = wave_sum(s); s2 = wave_sum(s2);
                ss16_store(ss, m, s, lane0); ss16_store(ss, m2, s2, lane0);
            }
        } else if (p == 1 && (MK_ONLY & 2)) {
            pg8::SchedStd S; S.init(xb, D, wl + WL_IN, D, T, ZG - 256, G, BXV());
            S.fix = (rep == 0 && MK_VAR == 8) ? 1 : 0;
            pg8::EpiIn E{zg, ss1, args.in[3] + l * 64, args.in[4] + l * 64, args.in[6] + l * 64, args.in[7] + l * 64, args.in[15] + l * GW, (args.pad >> 25) & 1, 8 * (BXV() & 7) * 256};
            pg8::gemm_phase<pg8::EpiIn, pg8::SchedStd, true, true>(lds + RING_OFF, D, D, S, E);
        } else if (p == 2 && (MK_ONLY & 4)) {
            int lop = l; asm volatile("" : "+s"(lop));
            const float lam_init = 0.8f - 0.6f * __expf(-0.3f * (float)lop);
            int ln = threadIdx.x; asm volatile("" : "+v"(ln)); ln &= 63;
            const float d1 = wave_sum(args.in[8][l * 64 + ln] * args.in[9][l * 64 + ln]), d2 = wave_sum(args.in[10][l * 64 + ln] * args.in[11][l * 64 + ln]);
            const float lam = __expf(d1) - __expf(d2) + lam_init;
            if ((VCU() & 3) == 0 && rep == 1) {
                pg8::SchedStd S1; S1.init(xb, D, wl + WL_IN, D, T, ZG, G, BXV()); S1.one = 1; { const int vc = VCU(); S1.opm = 8 * (vc >> 5) + ((vc & 31) >> 2); } S1.opn = 16;
                pg8::EpiIn E1{zg, ss1, args.in[3] + l * 64, args.in[4] + l * 64, args.in[6] + l * 64, args.in[7] + l * 64, args.in[15] + l * GW, 0, 8 * (BXV() & 7) * 256};
                pg8::gemm_phase<pg8::EpiIn, pg8::SchedStd, true, true>(lds + RING_OFF, D, D, S1, E1);
            }
            att::attn_tables(lds, lutg, args.in[12] + l * 128, 1.0f - lam_init);
            const int dsel = args.pad >> 16;
            if (rep == 1 || dsel != 2)
            for (int k_ = 0; k_ < 2; ++k_) { const int vcu = VCU(); const int ui = vcu + k_ * G; if (ui >= 512) break; const int bh = ui >> 4, qb = ui & 15; if (rep == 0 && MK_VAR == 7 && (vcu & 1)) {} else if (rep == 0) att::attn_unit<true, (MK_VAR == 7 ? 0 : MK_VAR)>(lds, zg, lutg, bh >> 2, bh & 3, qb * 128, nullptr, lam, 1.0f - lam_init, args.in[12] + l * 128, mix);
                else att::attn_unit<true, 0>(lds, zg, lutg, bh >> 2, bh & 3, qb * 128, nullptr, lam, 1.0f - lam_init, args.in[12] + l * 128, nullptr); }
            if (rep == 1 || dsel != 1) {
                unsigned* qctr = (unsigned*)(ctl + CW_Q + 64 * (2 * l + rep));
                for (;;) {
                    if (threadIdx.x == 0) MISC[4] = __hip_atomic_fetch_add(qctr, 1u, __ATOMIC_RELAXED, __HIP_MEMORY_SCOPE_AGENT);
                    __syncthreads();
                    const int ui = (int)MISC[4];
                    __syncthreads();
                    if (ui >= 512) break;
                    const int bk = ui >> 5, qb = ui & 31; att::attn_unit<false>(lds, zg, lutg, bk >> 1, bk & 1, qb * 64, args.in[5] + l * HA, 0.f, 0.f, nullptr, rep == 0 ? mix : nullptr);
                }
            }
        } else if (p == 3 && (MK_ONLY & 8)) {
            pg8::SchedMix S; S.b.init(zg + C_QA, ZG, wl + WL_A, 512, T, D, G, BXV()); S.A1 = (const char*)(zg + C_QB); S.Bt1 = (const char*)(wl + WL_B);
            pg8::EpiMix E{zg, mix};
            pg8::gemm_phase<pg8::EpiMix, pg8::SchedMix, true, true>(lds + RING_OFF, 512, ZG, S, E);
        } else if (p == 4 && (MK_ONLY & 16)) {
            pg8::SchedStd S; S.init(mix, D, wl + WL_O, D, T, D, G, BXV());
            pg8::EpiRes E{l == 0 ? args.in[0] : xf, xf, xb, ss2};
            pg8::gemm_phase<pg8::EpiRes, pg8::SchedStd, true, true>(lds + RING_OFF, D, D, S, E);
        } else if (p == 5 && (MK_ONLY & 32)) {
            pg8::SchedStd S; S.init(xb, D, wl + WL_UP, D, T, FF2, G, BXV());
            pg8::EpiUp E{abuf, ss2, args.in[21] + (size_t)l * 3 * FF2, args.in[22] + (size_t)l * FF2, yb, (args.pad >> 24) & 1, 8 * (BXV() & 7) * 256};
            pg8::gemm_phase<pg8::EpiUp, pg8::SchedStd, true, true>(lds + RING_OFF, D, D, S, E);
        } else if (MK_ONLY & 64) {
            pg8::SchedDown S; S.b.init(abuf, FF, wl + WL_DN, FF, T, D, G, BXV()); S.yb = (args.pad & 1) ? nullptr : yb; S.cw = args.in[21] + (size_t)l * 3 * FF2; S.cb = args.in[22] + (size_t)l * FF2; S.a = abuf;
            pg8::EpiRes E{xf, xf, ss3 ? xb : nullptr, ss3};
            pg8::gemm_phase<pg8::EpiRes, pg8::SchedDown, true, true>(lds + RING_OFF, FF, FF, S, E);
        }
        {
            int ph2 = ph; asm volatile("" : "+s"(ph2));
            const int l2 = ph2 > 0 ? (ph2 - 1) / 6 : 0, p2 = ph2 > 0 ? (ph2 - 1) % 6 + 1 : 0;
            const int G2 = gridDim.x; int bx2 = blockIdx.x; { const unsigned ev2 = MISC[12]; if (ev2) bx2 = (int)(MISC[11] * 8u + MISC[10]); } bx2 = __builtin_amdgcn_readfirstlane(bx2);
            int cl = -1, cw0 = 0, cnw = 1;
            if (p2 == 0) { cl = 0; cw0 = ((G2 % 8 == 0) ? (bx2 % 8) * (G2 / 8) + bx2 / 8 : bx2) * NWAVES; cnw = G2 * NWAVES; }
            else if (p2 == 5 && l2 + 1 < L && G2 == 256 && bx2 >= 128) { cl = l2 + 1; cw0 = (bx2 - 128) * NWAVES; cnw = 128 * NWAVES; }
            if (cl >= 0) {
                bf16* wbase2 = (bf16*)(args.ws + WS_W);
                int tid0 = threadIdx.x; asm volatile("" : "+v"(tid0));
                const int lane0 = tid0 & 63, wave = __builtin_amdgcn_readfirstlane(tid0 >> 6);
                LAS float* scr = (LAS float*)(lds + RING_OFF + wave * 16384);
                constexpr int I_IN = (D / 64) * (INW / 32), I_G = (D / 64) * (GW / 32), I_A = (512 / 64) * (D / 32), I_O = (D / 64) * (D / 32), I_UP = (D / 64) * (FF2 / 32), I_DN = (FF / 64) * (D / 32);
                constexpr int I_LAYER = I_IN + I_G + 2 * I_A + I_O + I_UP + I_DN;
                const int ll = cl; bf16* w = wbase2 + (size_t)ll * WL_END;
#pragma unroll 1
                for (int it = cw0 + wave; it < I_LAYER; it += cnw) {
                    int r = it;
                    if (r < I_IN) { const int nb = r % (INW / 32), kb = r / (INW / 32); p0_transpose_item(args.in[2] + (size_t)ll * D * INW, INW, D, 64 * kb, 32 * nb, w + WL_IN, vrow_in(32 * nb), args.in[1] + ll * D, scr, lane0); continue; } r -= I_IN;
                    if (r < I_G) { const int nb = r % (GW / 32), kb = r / (GW / 32); p0_transpose_item(args.in[14] + (size_t)ll * D * GW, GW, D, 64 * kb, 32 * nb, w + WL_IN, vrow_in(INW + 32 * nb), args.in[1] + ll * D, scr, lane0); continue; } r -= I_G;
                    if (r < I_A) { const int nb = r % (D / 32), kb = r / (D / 32); p0_transpose_item(args.in[16] + (size_t)ll * 512 * D, D, 512, 64 * kb, 32 * nb, w + WL_A, 32 * nb, nullptr, scr, lane0); continue; } r -= I_A;
                    if (r < I_A) { const int nb = r % (D / 32), kb = r / (D / 32); p0_transpose_item(args.in[17] + (size_t)ll * 512 * D, D, 512, 64 * kb, 32 * nb, w + WL_B, 32 * nb, nullptr, scr, lane0); continue; } r -= I_A;
                    if (r < I_O) { const int nb = r % (D / 32), kb = r / (D / 32); p0_transpose_item(args.in[18] + (size_t)ll * D * D, D, D, 64 * kb, 32 * nb, w + WL_O, 32 * nb, nullptr, scr, lane0); continue; } r -= I_O;
                    if (r < I_UP) { const int nb = r % (FF2 / 32), kb = r / (FF2 / 32); p0_transpose_item(args.in[20] + (size_t)ll * D * FF2, FF2, D, 64 * kb, 32 * nb, w + WL_UP, vrow_up(32 * nb), args.in[19] + ll * D, scr, lane0); continue; } r -= I_UP;
                    { const int nb = r % (D / 32), kb = r / (D / 32); p0_transpose_item(args.in[23] + (size_t)ll * FF * D, D, FF, 64 * kb, 32 * nb, w + WL_DN, 32 * nb, nullptr, scr, lane0); }
                }
            }
        }
        }
        if (ph + 1 < args.ph_hi) { int pq = ph; asm volatile("" : "+s"(pq)); const unsigned ev3 = MISC[12]; const bool loc = ev3 != 0u && pq > 0 && (pq - 1) % 6 >= 2 && (pq - 1) % 6 != 5; if (__builtin_amdgcn_readfirstlane((int)loc)) xcd_local_barrier(bar); else xcd_barrier(bar); }
    }
}
}

extern "C" void kernel_launch(void* const* d_in, const int* in_sizes, int n_in, void* d_out, int out_size, void* d_ws, size_t ws_size, hipStream_t stream) {
    using namespace nv;
    static int grid = 0;
    if (grid == 0) {
        if (n_in != 24 || in_sizes[0] != T * D || out_size != T * D || ws_size < mk::WS_END) { fprintf(stderr, "kernel_launch: built for 24 inputs, x/out of %d floats, >= %zu bytes of workspace; got n_in %d, out %d, ws %zu; nothing launched\n", T * D, (size_t)mk::WS_END, n_in, out_size, ws_size); grid = -1; return; }
        int dev = 0, cus = 0, per_cu = 0;
        if (hipGetDevice(&dev) != hipSuccess || hipDeviceGetAttribute(&cus, hipDeviceAttributeMultiprocessorCount, dev) != hipSuccess) { fprintf(stderr, "kernel_launch: device query failed; nothing launched\n"); grid = -1; return; }
        if (hipFuncSetAttribute((const void*)mk::skel_fwd, hipFuncAttributeMaxDynamicSharedMemorySize, mk::LDS_BYTES) != hipSuccess) { fprintf(stderr, "kernel_launch: hipFuncSetAttribute failed (needs %d bytes of dynamic LDS)\n", mk::LDS_BYTES); grid = -1; return; }
        if (hipOccupancyMaxActiveBlocksPerMultiprocessor(&per_cu, (const void*)mk::skel_fwd, mk::NWAVES * 64, mk::LDS_BYTES) != hipSuccess || per_cu < 1) fprintf(stderr, "kernel_launch: note: occupancy query reports %d workgroups per CU\n", per_cu);
        (void)hipGetLastError();
        grid = cus;
        if (grid != 256) fprintf(stderr, "kernel_launch: the unit schedules are built for 256 CUs; this device reports %d\n", cus);
    }
    if (grid < 0) return;
    if (hipMemsetAsync((unsigned char*)d_ws + mk::WS_CTL, 0, mk::CTL_ZERO_BYTES, stream) != hipSuccess) { fprintf(stderr, "kernel_launch: memset of the control words failed; nothing launched\n"); return; }
    mk::Args a{};
    for (int i = 0; i < 24; ++i) a.in[i] = (const float*)d_in[i];
    a.out = (float*)d_out; a.ws = (unsigned char*)d_ws; a.ph_lo = 0; a.ph_hi = mk::N_PHASES; a.li = 0;
    a.pad = (MK_DUP << 8) | (MK_DSEL << 16);
    hipLaunchKernelGGL(mk::skel_fwd, dim3(grid), dim3(mk::NWAVES * 64), mk::LDS_BYTES, stream, a);
}
```

```cpp
#include <hip/hip_runtime.h>
#include <cstdio>
#include <cstdint>
#include <cmath>
#define MK_EDUP 0

namespace nv {
typedef unsigned short bf16;
constexpr int D = 1024, B = 8, S = 2048, T = B * S, L = 4;
constexpr int HA = 8, KVA = 2, HB = 4, HD = 64;
constexpr int INW = 2304, GW = 2048, ZG = INW + GW;
constexpr int FF = 2816, FF2 = 2 * FF;
constexpr int C_QA = 0, C_KA = 512, C_VA = 640, C_QB = 768, C_KB = 1280, C_VB = 1792, C_G = 2304;
constexpr float EPS = 1e-6f;
constexpr float LOG2E = 1.4426950408889634f;
constexpr float C2 = 0.125f * LOG2E;

__device__ __forceinline__ float bf2f(bf16 v) { return __uint_as_float(((unsigned)v) << 16); }
__device__ __forceinline__ bf16 f2bf(float f) { unsigned u = __float_as_uint(f); return (bf16)((u + 0x7fffu + ((u >> 16) & 1u)) >> 16); }
__device__ __forceinline__ float ldf(const float* p) { return *p; }
__device__ __forceinline__ float ldf(const bf16* p) { return bf2f(*p); }

__device__ __forceinline__ int t5_bucket(int rel) {
    const int n = rel < 0 ? -rel : rel; int v;
    if (n < 8) v = n; else if (n < 12) v = 8; else if (n < 16) v = 9; else if (n < 23) v = 10; else if (n < 32) v = 11;
    else if (n < 46) v = 12; else if (n < 64) v = 13; else if (n < 91) v = 14; else v = 15;
    return (rel > 0 ? 16 : 0) + v;
}
__device__ __forceinline__ float ss16(const float* ss, int t) { const float4* p = (const float4*)(ss + (size_t)t * 16); const float4 a = p[0], b = p[1], c = p[2], d = p[3];
    return ((a.x + a.y) + (a.z + a.w)) + ((b.x + b.y) + (b.z + b.w)) + ((c.x + c.y) + (c.z + c.w)) + ((d.x + d.y) + (d.z + d.w)); }
__device__ __forceinline__ float ss16_q(const float* ss, int t, int fq) { const float4 a = *(const float4*)(ss + (size_t)t * 16 + 4 * fq); float s = (a.x + a.y) + (a.z + a.w); s += __shfl_xor(s, 16); s += __shfl_xor(s, 32); return s; }
__device__ __forceinline__ void ss16_store(float* ss, int t, float s, int lane) { if (lane < 16) ss[(size_t)t * 16 + lane] = lane == 0 ? s : 0.f; }
__device__ __forceinline__ float wave_sum(float v) {
#pragma unroll
    for (int o = 1; o < 64; o <<= 1) v += __shfl_xor(v, o);
    return v;
}
__device__ __forceinline__ float wave_max(float v) {
#pragma unroll
    for (int o = 1; o < 64; o <<= 1) v = fmaxf(v, __shfl_xor(v, o));
    return v;
}

}


namespace pg8 {
using namespace nv;
#define PG8_LAS __attribute__((address_space(3)))
typedef unsigned short bf16_t;
typedef short bf16x8 __attribute__((ext_vector_type(8)));
typedef float f32x4 __attribute__((ext_vector_type(4)));
typedef unsigned u32x4 __attribute__((ext_vector_type(4)));
typedef unsigned u32x2 __attribute__((ext_vector_type(2)));
constexpr int BM = 256, BK = 64, HALF = 128, HTB = HALF * BK * 2  , STAGE_BYTES = 8 * HTB, NXCD = 8, WGM = 8;
constexpr int XOFF = 131072 + 1024;
constexpr int RTAB_OFF = XOFF + 8192;

__host__ __device__ __forceinline__ int lds_byte(int r, int c) { const int st = (r >> 4) * 2 + (c >> 5), rr = r & 15, cc = c & 31, ob = rr * 64 + cc * 2; return st * 1024 + (ob ^ (((ob >> 9) & 1) << 5)); }
__host__ __device__ __forceinline__ void stage_rc(int b, int& R, int& C) { const int st = b / 1024, sb = b % 1024, swz = sb ^ (((sb >> 9) & 1) << 5); R = (st >> 1) * 16 + swz / 64; C = (st & 1) * 32 + (swz % 64) / 2; }
__host__ __device__ __forceinline__ int perm32(int rho) { const int n = rho >> 4, i = rho & 15; return 8 * (i >> 2) + 4 * n + (i & 3); }

struct Unit { int pm, pn, z; };
typedef float f32x2 __attribute__((ext_vector_type(2))); typedef __bf16 bf16x2_t __attribute__((ext_vector_type(2)));
__device__ __forceinline__ unsigned cvt_pk_bf16(float lo, float hi) { f32x2 v = {lo, hi}; bf16x2_t b = __builtin_convertvector(v, bf16x2_t); return __builtin_bit_cast(unsigned, b); }
__device__ __forceinline__ float bflo(unsigned w) { return __uint_as_float(w << 16); }
__device__ __forceinline__ float bfhi(unsigned w) { return __uint_as_float(w & 0xffff0000u); }

struct SchedStd {
    int nM, nN, nwg, G, c, fix, one, opm, opn; const char* A; const char* Bt; size_t at, bt;
    __device__ void init(const void* A_, int lda, const void* Bt_, int K, int M, int N, int G_, int c_) { fix = 0; one = 0; opm = 0; opn = 0; nM = M / BM; nN = N / BM; nwg = nM * nN; G = G_; c = c_; A = (const char*)A_; Bt = (const char*)Bt_; at = (size_t)BM * lda * 2; bt = (size_t)BM * K * 2; }
    __device__ bool next(int i, Unit& u) const {
        if (one) { if (i > 0) return false; u.pm = opm; u.pn = opn; u.z = 0; return true; }
        const long L = (long)i * G + c; if (L >= nwg) return false;
        int wgid = (int)L; { const int q = nwg / NXCD, r = nwg % NXCD, xcd = wgid % NXCD, off = wgid / NXCD; wgid = (xcd < r ? xcd * (q + 1) : r * (q + 1) + (xcd - r) * q) + off; }
        const int nig = WGM * nN, gid = wgid / nig, fm = gid * WGM, gsz = (nM - fm) < WGM ? (nM - fm) : WGM;
        u.pm = fm + ((wgid % nig) % gsz); u.pn = (wgid % nig) / gsz; u.z = 0; if (fix) { u.pm = 0; u.pn = 0; } return true;
    }
    __device__ __forceinline__ const char* aptr(const Unit& u) const { return A + (size_t)u.pm * at; }
    __device__ __forceinline__ const char* bptr(const Unit& u) const { return Bt + (size_t)u.pn * bt; }
    __device__ __forceinline__ void a_ready(const Unit&) const {}
    __device__ __forceinline__ void done(const Unit&) const {}
};
struct SchedMix {
    SchedStd b; const char* A1; const char* Bt1;
    __device__ bool next(int i, Unit& u) const { if (!b.next(i >> 1, u)) return false; u.z = i & 1; return true; }
    __device__ __forceinline__ const char* aptr(const Unit& u) const { return (u.z ? A1 : b.A) + (size_t)u.pm * b.at; }
    __device__ __forceinline__ const char* bptr(const Unit& u) const { return (u.z ? Bt1 : b.Bt) + (size_t)u.pn * b.bt; }
    __device__ __forceinline__ void a_ready(const Unit&) const {}
    __device__ __forceinline__ void done(const Unit&) const {}
};
struct SchedDown {
    SchedStd b; const float* yb; const float* cw; const float* cb; bf16_t* a;
    __device__ bool next(int i, Unit& u) const { return b.next(i, u); }
    __device__ __forceinline__ const char* aptr(const Unit& u) const { return b.aptr(u); }
    __device__ __forceinline__ const char* bptr(const Unit& u) const { return b.bptr(u); }
    __device__ __forceinline__ void a_ready(const Unit& u) const {
        const int pm = u.pm;
        if (yb) {
            int t0 = threadIdx.x; asm volatile("" : "+v"(t0));
            const bool hasp = (pm & 7) != 0, hasn = (pm & 7) != 7;
#pragma unroll 1
            for (int g = 0; g < 3; ++g) {
                float yv[4][2][3], cv[4][2][4];
#pragma unroll
                for (int q = 0; q < 4; ++q) {
                    const int it = 4 * g + q;
                    if (it < 11) {
                        const int idx = t0 + 512 * it, which = idx >= FF ? 1 : 0, j = idx - which * FF;
#pragma unroll
                        for (int gs = 0; gs < 2; ++gs) {
                            const int col = gs * FF + j;
                            const float* r0 = yb + ((size_t)pm * 4 + (which ? 2 : -1)) * FF2 + col;
                            const bool v0 = which ? true : hasp, v2 = which ? hasn : true;
                            yv[q][gs][0] = v0 ? r0[0] : 0.f; yv[q][gs][1] = r0[FF2]; yv[q][gs][2] = v2 ? r0[2 * (size_t)FF2] : 0.f;
                            cv[q][gs][0] = cb[col]; cv[q][gs][1] = cw[col]; cv[q][gs][2] = cw[FF2 + col]; cv[q][gs][3] = cw[2 * FF2 + col];
                        }
                    }
                }
#pragma unroll
                for (int q = 0; q < 4; ++q) {
                    const int it = 4 * g + q;
                    if (it < 11) {
                        const int idx = t0 + 512 * it, which = idx >= FF ? 1 : 0, j = idx - which * FF;
                        float uv[2];
#pragma unroll
                        for (int gs = 0; gs < 2; ++gs) uv[gs] = cv[q][gs][0] + cv[q][gs][1] * yv[q][gs][0] + cv[q][gs][2] * yv[q][gs][1] + cv[q][gs][3] * yv[q][gs][2];
                        const float sg = uv[1] * __builtin_amdgcn_rcpf(1.0f + __builtin_amdgcn_exp2f(-uv[1] * LOG2E));
                        a[(size_t)(pm * BM + which * 255) * FF + j] = f2bf(sg * uv[0]);
                    }
                }
            }
        }
        asm volatile("s_waitcnt vmcnt(0)" ::: "memory");
        __builtin_amdgcn_s_barrier();
        asm volatile("" ::: "memory");
    }
    __device__ __forceinline__ void done(const Unit&) const {}
};

__device__ __forceinline__ void rtab_fill(PG8_LAS unsigned char* lds_, const float* __restrict__ ssx, int row0) {
    int t = threadIdx.x; asm volatile("" : "+v"(t));
    PG8_LAS float* rt = (PG8_LAS float*)(lds_ + RTAB_OFF);
    float v[4];
#pragma unroll
    for (int k = 0; k < 4; ++k) v[k] = ss16(ssx, row0 + t + 512 * k);
#pragma unroll
    for (int k = 0; k < 4; ++k) rt[t + 512 * k] = rsqrtf(v[k] * (1.0f / D) + EPS);
}
struct EpiIn {
    static constexpr bool PERM = true, AFTER_DRAIN = false;
    __device__ __forceinline__ void init(f32x4 (&acc)[2][2][4][2], const Unit&, int, int, int, int) const {
#pragma unroll
        for (int a = 0; a < 2; ++a)
#pragma unroll
            for (int b = 0; b < 2; ++b)
#pragma unroll
                for (int m = 0; m < 4; ++m)
#pragma unroll
                    for (int n = 0; n < 2; ++n) acc[a][b][m][n] = (f32x4){0.f, 0.f, 0.f, 0.f};
    }
    __device__ static constexpr bool zero_after(const Unit&) { return true; }
    bf16_t* zg; const float* ss; const float *qn_a, *kn_a, *qn_b, *kn_b, *bg; int dup, row0;
    __device__ __forceinline__ void prefill(PG8_LAS unsigned char* lds_) const { rtab_fill(lds_, ss, row0); }
    __device__ __forceinline__ void operator()(f32x4 (&acc)[2][2][4][2], const Unit& u, int wr, int wc, int fr, int fq, PG8_LAS unsigned char* lds_) const {
#pragma unroll
        for (int rep_ = 0; rep_ <= ((MK_EDUP & 2) ? 1 : 0); ++rep_) {
        if (rep_) {
#pragma unroll
            for (int ai = 0; ai < 2; ++ai)
#pragma unroll
                for (int bj = 0; bj < 2; ++bj)
#pragma unroll
                    for (int m = 0; m < 4; ++m)
#pragma unroll
                        for (int n = 0; n < 2; ++n) asm volatile("" : "+v"(acc[ai][bj][m][n]) :: "memory");
        }
        const int g = u.pn * 4 + wc, colb = u.pn * BM + wc * 64 + 8 * fq;
        const float* gain = nullptr; float sc = 1.f; int mode = 0;
        if (g < 8) { gain = qn_a; sc = C2; mode = 1; } else if (g < 10) { gain = kn_a; mode = 1; } else if (g < 12) { mode = 0; } else if (g < 20) { gain = qn_b; sc = C2; mode = 1; }
        else if (g < 28) { gain = kn_b; mode = 1; } else if (g < 36) { mode = 0; } else { mode = 2; }
        float rsv[2][4];
#pragma unroll
        for (int ai = 0; ai < 2; ++ai)
#pragma unroll
            for (int m = 0; m < 4; ++m) rsv[ai][m] = ((const PG8_LAS float*)(lds_ + RTAB_OFF))[(u.pm & 7) * BM + ai * HALF + wr * 64 + m * 16 + fr];
        f32x4 gv[2][2];
#pragma unroll
        for (int bj = 0; bj < 2; ++bj)
#pragma unroll
            for (int n = 0; n < 2; ++n) {
                if (mode == 1) gv[bj][n] = *(const f32x4*)(gain + 32 * bj + 8 * fq + 4 * n) * sc;
                else if (mode == 2) gv[bj][n] = *(const f32x4*)(bg + bj * D + (u.pn - 9) * 128 + wc * 32 + 8 * fq + 4 * n);
                else gv[bj][n] = (f32x4){1.f, 1.f, 1.f, 1.f};
            }
#pragma unroll
        for (int ai = 0; ai < 2; ++ai)
#pragma unroll
            for (int m = 0; m < 4; ++m) {
                const int row = u.pm * BM + ai * HALF + wr * 64 + m * 16 + fr;
                const float rs = rsv[ai][m];
                f32x4 v[2][2];
#pragma unroll
                for (int bj = 0; bj < 2; ++bj)
#pragma unroll
                    for (int n = 0; n < 2; ++n) v[bj][n] = acc[ai][bj][m][n] * rs;
                if (mode == 1) {
                    float q = 0.f;
#pragma unroll
                    for (int bj = 0; bj < 2; ++bj)
#pragma unroll
                        for (int n = 0; n < 2; ++n) { const f32x4 x = v[bj][n]; q += (x[0] * x[0] + x[1] * x[1]) + (x[2] * x[2] + x[3] * x[3]); }
                    q += __shfl_xor(q, 16); q += __shfl_xor(q, 32);
                    const float r2 = rsqrtf(q * (1.0f / 64.0f) + EPS);
#pragma unroll
                    for (int bj = 0; bj < 2; ++bj)
#pragma unroll
                        for (int n = 0; n < 2; ++n) v[bj][n] = v[bj][n] * r2 * gv[bj][n];
                } else if (mode == 2) {
#pragma unroll
                    for (int n = 0; n < 2; ++n) { const f32x4 xa = v[0][n] + gv[0][n], xb_ = v[1][n] + gv[1][n]; f32x4 rr, gb;
#pragma unroll
                        for (int e = 0; e < 4; ++e) { const float sa = 1.0f + __builtin_amdgcn_exp2f(-xa[e] * LOG2E), sb = 1.0f + __builtin_amdgcn_exp2f(-xb_[e] * LOG2E);
                            const float ga = __builtin_fmaxf(__builtin_amdgcn_rcpf(sa), 9.5367431640625e-07f);
                            gb[e] = __builtin_fmaxf(__builtin_amdgcn_rcpf(sb), 9.5367431640625e-07f); rr[e] = ga * __builtin_fminf(sb, 1048576.0f); }
                        v[0][n] = rr; v[1][n] = gb; }
                }
                bf16_t* rowp = zg + (size_t)row * ZG + colb;
                if (mode == 2) {
                    bf16_t* gp = zg + (size_t)row * ZG + C_G + (u.pn - 9) * 128 + wc * 32 + 8 * fq;
#pragma unroll
                    for (int bj = 0; bj < 2; ++bj) { u32x4 w; w.x = cvt_pk_bf16(v[bj][0][0], v[bj][0][1]); w.y = cvt_pk_bf16(v[bj][0][2], v[bj][0][3]); w.z = cvt_pk_bf16(v[bj][1][0], v[bj][1][1]); w.w = cvt_pk_bf16(v[bj][1][2], v[bj][1][3]);
                        *(u32x4*)(gp + bj * D) = w; }
                } else
#pragma unroll
                for (int bj = 0; bj < 2; ++bj) { u32x4 w; w.x = cvt_pk_bf16(v[bj][0][0], v[bj][0][1]); w.y = cvt_pk_bf16(v[bj][0][2], v[bj][0][3]); w.z = cvt_pk_bf16(v[bj][1][0], v[bj][1][1]); w.w = cvt_pk_bf16(v[bj][1][2], v[bj][1][3]);
                    *(u32x4*)(rowp + 32 * bj) = w; }
            }
        }
    }
};
struct EpiMix {
    static constexpr bool PERM = true, AFTER_DRAIN = false;
    __device__ __forceinline__ void prefill(PG8_LAS unsigned char*) const {}
    __device__ __forceinline__ void init(f32x4 (&acc)[2][2][4][2], const Unit&, int, int, int, int) const {
#pragma unroll
        for (int a = 0; a < 2; ++a)
#pragma unroll
            for (int b = 0; b < 2; ++b)
#pragma unroll
                for (int m = 0; m < 4; ++m)
#pragma unroll
                    for (int n = 0; n < 2; ++n) acc[a][b][m][n] = (f32x4){0.f, 0.f, 0.f, 0.f};
    }
    __device__ static bool zero_after(const Unit& u) { return u.z != 0; }
    const bf16_t* zg; bf16_t* mix;
    __device__ __forceinline__ void operator()(f32x4 (&acc)[2][2][4][2], const Unit& u, int wr, int wc, int fr, int fq, PG8_LAS unsigned char*) const {
        const int col0 = u.pn * BM + wc * 32 + 8 * fq;
#pragma unroll
        for (int ai = 0; ai < 2; ++ai) {
            u32x4 gbv[4][2];
#pragma unroll
            for (int m = 0; m < 4; ++m)
#pragma unroll
                for (int bj = 0; bj < 2; ++bj) { const size_t go = (size_t)(u.pm * BM + ai * HALF + wr * 64 + m * 16 + fr) * ZG + C_G + col0 + bj * HALF;
                    gbv[m][bj] = *(const u32x4*)(zg + go + (u.z ? D : 0)); }
#pragma unroll
            for (int m = 0; m < 4; ++m) {
                const int row = u.pm * BM + ai * HALF + wr * 64 + m * 16 + fr;
#pragma unroll
                for (int bj = 0; bj < 2; ++bj) {
                    const int col = col0 + bj * HALF;
                    const u32x4 gb = gbv[m][bj];
                    if (u.z == 0) {
                        acc[ai][bj][m][0] *= (f32x4){bflo(gb.x), bfhi(gb.x), bflo(gb.y), bfhi(gb.y)}; acc[ai][bj][m][1] *= (f32x4){bflo(gb.z), bfhi(gb.z), bflo(gb.w), bfhi(gb.w)};
                    } else {
                        const f32x4 v0 = acc[ai][bj][m][0] * (f32x4){bflo(gb.x), bfhi(gb.x), bflo(gb.y), bfhi(gb.y)}, v1 = acc[ai][bj][m][1] * (f32x4){bflo(gb.z), bfhi(gb.z), bflo(gb.w), bfhi(gb.w)};
                        u32x4 w; w.x = cvt_pk_bf16(v0[0], v0[1]); w.y = cvt_pk_bf16(v0[2], v0[3]); w.z = cvt_pk_bf16(v1[0], v1[1]); w.w = cvt_pk_bf16(v1[2], v1[3]);
                        *(u32x4*)(mix + (size_t)row * D + col) = w;
                    }
                }
            }
            asm volatile("" ::: "memory");
        }
    }
};
struct EpiRes {
    static constexpr bool PERM = false, AFTER_DRAIN = false;
    __device__ __forceinline__ void prefill(PG8_LAS unsigned char*) const {}
    __device__ static constexpr bool zero_after(const Unit&) { return true; }
    const float* base; float* xf; bf16_t* xb; float* ssn;
    __device__ __forceinline__ void init(f32x4 (&acc)[2][2][4][2], const Unit& u, int wr, int wc, int fr, int fq) const {
        const int col0 = u.pn * BM + wc * 32 + 4 * fq;
#pragma unroll
        for (int ai = 0; ai < 2; ++ai)
#pragma unroll
            for (int m = 0; m < 4; ++m) { const size_t off = (size_t)(u.pm * BM + ai * HALF + wr * 64 + m * 16 + fr) * D + col0;
#pragma unroll
                for (int bj = 0; bj < 2; ++bj)
#pragma unroll
                    for (int n = 0; n < 2; ++n) acc[ai][bj][m][n] = *(const f32x4*)(base + off + bj * HALF + n * 16); }
    }
    __device__ __forceinline__ void operator()(f32x4 (&acc)[2][2][4][2], const Unit& u, int wr, int wc, int fr, int fq, PG8_LAS unsigned char*) const {
        const int col0 = u.pn * BM + wc * 32 + 4 * fq;
#pragma unroll
        for (int ai = 0; ai < 2; ++ai)
#pragma unroll
            for (int m = 0; m < 4; ++m) {
                const int row = u.pm * BM + ai * HALF + wr * 64 + m * 16 + fr; const size_t off = (size_t)row * D + col0; float q = 0.f;
#pragma unroll
                for (int bj = 0; bj < 2; ++bj)
#pragma unroll
                    for (int n = 0; n < 2; ++n) { const f32x4 o = acc[ai][bj][m][n];
                        *(f32x4*)(xf + off + bj * HALF + n * 16) = o; q += (o[0] * o[0] + o[1] * o[1]) + (o[2] * o[2] + o[3] * o[3]);
                        if (xb) { u32x2 w; w.x = cvt_pk_bf16(o[0], o[1]); w.y = cvt_pk_bf16(o[2], o[3]); *(u32x2*)(xb + off + bj * HALF + n * 16) = w; } }
                if (ssn) { q += __shfl_xor(q, 16); q += __shfl_xor(q, 32); if (fq == 0) ssn[(size_t)row * 16 + u.pn * 4 + wc] = q; }
            }
    }
};
#define DPPF(oldv, src, ctrl, bc) __int_as_float(__builtin_amdgcn_update_dpp(__float_as_int(oldv), __float_as_int(src), (ctrl), 0xF, 0xF, (bc)))
struct EpiUp {
    static constexpr bool PERM = true, AFTER_DRAIN = false;
    __device__ __forceinline__ void init(f32x4 (&acc)[2][2][4][2], const Unit&, int, int, int, int) const {
#pragma unroll
        for (int a = 0; a < 2; ++a)
#pragma unroll
            for (int b = 0; b < 2; ++b)
#pragma unroll
                for (int m = 0; m < 4; ++m)
#pragma unroll
                    for (int n = 0; n < 2; ++n) acc[a][b][m][n] = (f32x4){0.f, 0.f, 0.f, 0.f};
    }
    __device__ static constexpr bool zero_after(const Unit&) { return true; }
    bf16_t* a; const float* ss; const float* cw; const float* cb; float* yb; int dup, row0;
    __device__ __forceinline__ void prefill(PG8_LAS unsigned char* lds_) const { rtab_fill(lds_, ss, row0); }
    __device__ __forceinline__ void operator()(f32x4 (&acc)[2][2][4][2], const Unit& u, int wr, int wc, int fr, int fq, PG8_LAS unsigned char* lds) const {
        PG8_LAS unsigned char* lds_ = lds; const int wid = wr * 4 + wc;
        PG8_LAS float* X = (PG8_LAS float*)(lds + XOFF);
        float rsv[2][4];
#pragma unroll
        for (int ai = 0; ai < 2; ++ai)
#pragma unroll
            for (int m = 0; m < 4; ++m) rsv[ai][m] = ((const PG8_LAS float*)(lds_ + RTAB_OFF))[(u.pm & 7) * BM + ai * HALF + wr * 64 + m * 16 + fr];
#pragma unroll
        for (int ai = 0; ai < 2; ++ai)
#pragma unroll
            for (int m = 0; m < 4; ++m) {
#pragma unroll
                for (int bj = 0; bj < 2; ++bj)
#pragma unroll
                    for (int n = 0; n < 2; ++n) acc[ai][bj][m][n] *= rsv[ai][m];
            }
#pragma unroll
        for (int ai = 0; ai < 2; ++ai) {
            if (fr == 0) {
#pragma unroll
                for (int bj = 0; bj < 2; ++bj)
#pragma unroll
                    for (int n = 0; n < 2; ++n) *(PG8_LAS f32x4*)(X + ((wid * 2 + ai) * 2 + 0) * 64 + 32 * bj + 8 * fq + 4 * n) = acc[ai][bj][0][n];
            }
            if (fr == 15) {
#pragma unroll
                for (int bj = 0; bj < 2; ++bj)
#pragma unroll
                    for (int n = 0; n < 2; ++n) *(PG8_LAS f32x4*)(X + ((wid * 2 + ai) * 2 + 1) * 64 + 32 * bj + 8 * fq + 4 * n) = acc[ai][bj][3][n];
            }
        }
        {
            const int ccol = u.pn * 128 + wc * 32 + 8 * fq;
            if (wr == 0 && fr < 2) {
#pragma unroll
                for (int bj = 0; bj < 2; ++bj)
#pragma unroll
                    for (int n = 0; n < 2; ++n) *(f32x4*)(yb + ((size_t)u.pm * 4 + fr) * FF2 + bj * FF + ccol + 4 * n) = acc[0][bj][0][n];
            }
            if (wr == 1 && fr >= 14) {
#pragma unroll
                for (int bj = 0; bj < 2; ++bj)
#pragma unroll
                    for (int n = 0; n < 2; ++n) *(f32x4*)(yb + ((size_t)u.pm * 4 + 2 + (fr - 14)) * FF2 + bj * FF + ccol + 4 * n) = acc[1][bj][3][n];
            }
        }
        asm volatile("s_waitcnt lgkmcnt(0)" ::: "memory"); __builtin_amdgcn_s_barrier(); asm volatile("" ::: "memory");
#pragma unroll
        for (int rep_ = 0; rep_ <= ((MK_EDUP & 1) ? 1 : 0); ++rep_) {
        if (rep_) {
#pragma unroll
            for (int ai = 0; ai < 2; ++ai)
#pragma unroll
                for (int bj = 0; bj < 2; ++bj)
#pragma unroll
                    for (int m = 0; m < 4; ++m)
#pragma unroll
                        for (int n = 0; n < 2; ++n) asm volatile("" : "+v"(acc[ai][bj][m][n]) :: "memory");
        }
#pragma unroll
        for (int n = 0; n < 2; ++n) {
            const int ccol = u.pn * 128 + wc * 32 + 8 * fq + 4 * n;
            f32x4 w0[2], w1[2], w2[2], bb[2];
#pragma unroll
            for (int bj = 0; bj < 2; ++bj) { w0[bj] = *(const f32x4*)(cw + bj * FF + ccol); w1[bj] = *(const f32x4*)(cw + FF2 + bj * FF + ccol); w2[bj] = *(const f32x4*)(cw + 2 * FF2 + bj * FF + ccol); bb[bj] = *(const f32x4*)(cb + bj * FF + ccol); }
#pragma unroll
            for (int ai = 0; ai < 2; ++ai) {
                const int pw = wr ? wid - 4 : wid + 4, pai = wr ? ai : 0;
                const int nw = wr ? wid - 4 : wid + 4, nai = wr ? 1 : ai;
                f32x4 xp[2], xn[2];
#pragma unroll
                for (int bj = 0; bj < 2; ++bj) { xp[bj] = *(PG8_LAS f32x4*)(X + ((pw * 2 + pai) * 2 + 1) * 64 + 32 * bj + 8 * fq + 4 * n); xn[bj] = *(PG8_LAS f32x4*)(X + ((nw * 2 + nai) * 2 + 0) * 64 + 32 * bj + 8 * fq + 4 * n); }
#pragma unroll
                for (int m = 0; m < 4; ++m) {
                    const int trow = ai * HALF + wr * 64 + m * 16 + fr;
                    float uv[2][4];
#pragma unroll
                    for (int bj = 0; bj < 2; ++bj)
#pragma unroll
                        for (int e = 0; e < 4; ++e) {
                            const float cur = acc[ai][bj][m][n][e];
                            float rp, rn;
                            if (m > 0) rp = DPPF(0.f, acc[ai][bj][m > 0 ? m - 1 : 0][n][e], 0x121, true); else rp = xp[bj][e];
                            if (m < 3) rn = DPPF(0.f, acc[ai][bj][m < 3 ? m + 1 : 3][n][e], 0x12F, true); else rn = xn[bj][e];
                            const float prev = DPPF(rp, cur, 0x111, false), next = DPPF(rn, cur, 0x101, false);
                            uv[bj][e] = bb[bj][e] + w0[bj][e] * prev + w1[bj][e] * cur + w2[bj][e] * next;
                        }
                    f32x4 o;
#pragma unroll
                    for (int e = 0; e < 4; ++e) o[e] = uv[0][e] * uv[1][e] * __builtin_amdgcn_rcpf(1.0f + __builtin_amdgcn_exp2f(-uv[1][e] * LOG2E));
                    u32x2 w; w.x = cvt_pk_bf16(o[0], o[1]); w.y = cvt_pk_bf16(o[2], o[3]);
                    if (trow != 0 && trow != 255) *(u32x2*)(a + (size_t)(u.pm * BM + trow) * FF + ccol) = w;
                    asm volatile("" ::: "memory");
                }
            }
        }
        }
    }
};

template <class Epi, class Sched, bool ALIGN_EPI = false, bool SP2 = false>
__device__ __forceinline__ void gemm_phase(PG8_LAS unsigned char* lds, const int K, const int lda, const Sched& S, const Epi& E) {
    int tid_ = threadIdx.x; asm volatile("" : "+v"(tid_));
    const int tid = tid_, wid = __builtin_amdgcn_readfirstlane(tid >> 6), lane = tid & 63, wr = wid >> 2, wc = wid & 3, fr = lane & 15, fq = lane >> 4;
    const int nt = K / BK;
    unsigned voffA[2], voffB[2];
#pragma unroll
    for (int i = 0; i < 2; ++i) { int R, C; stage_rc(tid * 16 + i * 8192, R, C); const int Rb = Epi::PERM ? ((R & ~31) + perm32(R & 31)) : R;
        voffA[i] = (unsigned)(R * lda + C) * 2u; voffB[i] = (unsigned)(Rb * K + C) * 2u; }
    const size_t kstep = (size_t)(BK * 2);
    const size_t hstepB = (size_t)HALF * K * 2;
    const size_t hstepA = (size_t)HALF * lda * 2;
    const unsigned ldsw = (unsigned)wid * 1024u;
    const int aoff = lds_byte(wr * 64 + fr, fq * 8), boff = lds_byte(wc * 32 + fr, fq * 8);
#define PG8_SA(b, h) (((b) * 2 + (h)) * HTB)
#define PG8_SB(b, h) ((4 + (b) * 2 + (h)) * HTB)
#define PG8_STAGE(bufoff, gbase, voff) do { _Pragma("unroll") for (int _i = 0; _i < 2; ++_i) \
        __builtin_amdgcn_global_load_lds((const unsigned*)((const char*)(gbase) + (voff)[_i]), (PG8_LAS unsigned*)(lds + (bufoff) + ldsw + _i * 8192), 16, 0, 0); } while (0)
#define PG8_LDA(dst, b, h) do { _Pragma("unroll") for (int m = 0; m < 4; ++m) _Pragma("unroll") for (int k = 0; k < 2; ++k) dst[m][k] = *(const PG8_LAS bf16x8*)(lds + PG8_SA(b, h) + aoff + m * 2048 + k * 1024); } while (0)
#define PG8_LDB(dst, b, h) do { _Pragma("unroll") for (int n = 0; n < 2; ++n) _Pragma("unroll") for (int k = 0; k < 2; ++k) dst[n][k] = *(const PG8_LAS bf16x8*)(lds + PG8_SB(b, h) + boff + n * 2048 + k * 1024); } while (0)
#define PG8_MMA(ai, bj, At, Bt) do { __builtin_amdgcn_s_setprio(1); _Pragma("unroll") for (int m = 0; m < 4; ++m) _Pragma("unroll") for (int n = 0; n < 2; ++n) _Pragma("unroll") for (int k = 0; k < 2; ++k) \
        acc[ai][bj][m][n] = __builtin_amdgcn_mfma_f32_16x16x32_bf16(Bt[n][k], At[m][k], acc[ai][bj][m][n], 0, 0, 0); __builtin_amdgcn_s_setprio(0); } while (0)
#define PG8_WAIT_V(n) asm volatile("s_waitcnt vmcnt(" #n ")" ::: "memory")
#define PG8_WAIT_L(n) asm volatile("s_waitcnt lgkmcnt(" #n ")" ::: "memory")
#define PG8_BAR __builtin_amdgcn_s_barrier()
#define PG8_SCHED __builtin_amdgcn_sched_barrier(0)
    Unit cur, nxt; int ui = 0;
    if (!S.next(0, cur)) return;
    f32x4 acc[2][2][4][2];
    E.init(acc, cur, wr, wc, fr, fq);
    bf16x8 At[4][2], B0[2][2], B1[2][2];
    const char* cA = S.aptr(cur); const char* cB = S.bptr(cur);
    S.a_ready(cur);
    if constexpr (SP2) {
        PG8_STAGE(PG8_SB(0, 0), cB, voffB); PG8_STAGE(PG8_SB(0, 1), cB + hstepB, voffB); PG8_STAGE(PG8_SA(0, 0), cA, voffA); PG8_STAGE(PG8_SA(0, 1), cA + hstepA, voffA);
        E.prefill(lds);
        if (wr == 1) PG8_BAR;
        PG8_WAIT_V(2); PG8_BAR;
        PG8_STAGE(PG8_SB(1, 0), cB + kstep, voffB); PG8_STAGE(PG8_SA(1, 0), cA + kstep, voffA); PG8_STAGE(PG8_SB(1, 1), cB + hstepB + kstep, voffB);
        PG8_WAIT_V(6); PG8_BAR;
    } else {
        PG8_STAGE(PG8_SB(0, 0), cB, voffB); PG8_STAGE(PG8_SA(0, 0), cA, voffA); PG8_STAGE(PG8_SB(0, 1), cB + hstepB, voffB); PG8_STAGE(PG8_SA(0, 1), cA + hstepA, voffA);
        E.prefill(lds);
        if (wr == 1) PG8_BAR;
        PG8_WAIT_V(4); PG8_BAR;
        PG8_STAGE(PG8_SB(1, 0), cB + kstep, voffB); PG8_STAGE(PG8_SA(1, 0), cA + kstep, voffA); PG8_STAGE(PG8_SB(1, 1), cB + hstepB + kstep, voffB);
        PG8_WAIT_V(6); PG8_BAR;
    }
    for (;;) {
        const bool has_next = S.next(ui + 1, nxt);
        const char* nA = has_next ? S.aptr(nxt) : cA; const char* nB = has_next ? S.bptr(nxt) : cB;
        for (int t = 0; t < nt; t += 2) {
            const bool last = (t == nt - 2);
            const char* a1 = cA + (size_t)(t + 1) * kstep;
            const char* a2 = last ? nA : cA + (size_t)(t + 2) * kstep; const char* b2 = last ? nB : cB + (size_t)(t + 2) * kstep;
            const char* a3 = a2 + kstep; const char* b3 = b2 + kstep;
            if (last && has_next) S.a_ready(nxt);
            if constexpr (SP2) {
            PG8_LDB(B0, 0, 0); PG8_LDB(B1, 0, 1); PG8_SCHED; PG8_LDA(At, 0, 0); PG8_STAGE(PG8_SA(1, 1), a1 + hstepA, voffA);
            PG8_WAIT_V(8); PG8_WAIT_L(0); PG8_BAR; PG8_MMA(0, 0, At, B0); PG8_MMA(0, 1, At, B1); PG8_BAR; PG8_SCHED;
            PG8_LDA(At, 0, 1); PG8_STAGE(PG8_SB(0, 0), b2, voffB); PG8_STAGE(PG8_SB(0, 1), b2 + hstepB, voffB); PG8_STAGE(PG8_SA(0, 0), a2, voffA);
            PG8_WAIT_V(8); PG8_WAIT_L(0); PG8_BAR; PG8_MMA(1, 0, At, B0); PG8_MMA(1, 1, At, B1); PG8_BAR; PG8_SCHED;
            PG8_LDB(B0, 1, 0); PG8_LDB(B1, 1, 1); PG8_SCHED; PG8_LDA(At, 1, 0); PG8_STAGE(PG8_SA(0, 1), a2 + hstepA, voffA);
            PG8_WAIT_V(8); PG8_WAIT_L(0); PG8_BAR; PG8_MMA(0, 0, At, B0); PG8_MMA(0, 1, At, B1); PG8_BAR; PG8_SCHED;
            PG8_LDA(At, 1, 1); PG8_STAGE(PG8_SB(1, 0), b3, voffB); PG8_STAGE(PG8_SB(1, 1), b3 + hstepB, voffB); PG8_STAGE(PG8_SA(1, 0), a3, voffA);
            PG8_WAIT_V(8); PG8_WAIT_L(0); PG8_BAR; PG8_MMA(1, 0, At, B0); PG8_MMA(1, 1, At, B1); PG8_BAR; PG8_SCHED;
            } else {
            PG8_LDB(B0, 0, 0); PG8_SCHED; PG8_LDA(At, 0, 0); PG8_STAGE(PG8_SA(1, 1), a1 + hstepA, voffA);
            PG8_WAIT_L(8); PG8_BAR; PG8_WAIT_L(0); PG8_MMA(0, 0, At, B0); PG8_BAR; PG8_SCHED;
            PG8_LDB(B1, 0, 1); PG8_STAGE(PG8_SB(0, 0), b2, voffB);
            PG8_BAR; PG8_WAIT_L(0); PG8_MMA(0, 1, At, B1); PG8_BAR;
            PG8_LDA(At, 0, 1); PG8_STAGE(PG8_SA(0, 0), a2, voffA);
            PG8_BAR; PG8_WAIT_L(0); PG8_MMA(1, 0, At, B0); PG8_BAR; PG8_SCHED;
            PG8_STAGE(PG8_SB(0, 1), b2 + hstepB, voffB);
            PG8_WAIT_V(6); PG8_BAR; PG8_MMA(1, 1, At, B1); PG8_BAR;
            PG8_LDB(B0, 1, 0); PG8_SCHED; PG8_LDA(At, 1, 0); PG8_STAGE(PG8_SA(0, 1), a2 + hstepA, voffA);
            PG8_WAIT_L(8); PG8_BAR; PG8_WAIT_L(0); PG8_MMA(0, 0, At, B0); PG8_BAR; PG8_SCHED;
            PG8_LDB(B1, 1, 1); PG8_STAGE(PG8_SB(1, 0), b3, voffB);
            PG8_BAR; PG8_WAIT_L(0); PG8_MMA(0, 1, At, B1); PG8_BAR;
            PG8_LDA(At, 1, 1); PG8_STAGE(PG8_SA(1, 0), a3, voffA);
            PG8_BAR; PG8_WAIT_L(0); PG8_MMA(1, 0, At, B0); PG8_BAR; PG8_SCHED;
            PG8_STAGE(PG8_SB(1, 1), b3 + hstepB, voffB);
            PG8_WAIT_V(6); PG8_BAR; PG8_MMA(1, 1, At, B1); PG8_BAR;
            }
        }
        if constexpr (ALIGN_EPI) { if (wr == 0) PG8_BAR; }
        if constexpr (!Epi::AFTER_DRAIN) { E(acc, cur, wr, wc, fr, fq, lds); S.done(cur); }
        if (!has_next) break;
        if (Epi::zero_after(cur)) E.init(acc, nxt, wr, wc, fr, fq);
        cur = nxt; cA = nA; cB = nB; ++ui;
        if constexpr (ALIGN_EPI) { if (wr == 1) PG8_BAR; }
    }
    PG8_WAIT_V(0);
    if constexpr (!ALIGN_EPI) { if (wr == 0) PG8_BAR; }
    PG8_BAR;
    if constexpr (Epi::AFTER_DRAIN) { E.fused(acc, cur, wr, wc, fr, fq, lds, wid, lane); S.done(cur); }
#undef PG8_SA
#undef PG8_SB
#undef PG8_STAGE
#undef PG8_LDA
#undef PG8_LDB
#undef PG8_MMA
#undef PG8_WAIT_V
#undef PG8_WAIT_L
#undef PG8_BAR
#undef PG8_SCHED
}
}

namespace att {
using namespace nv;
#define ALAS __attribute__((address_space(3)))
typedef short bf16x8 __attribute__((ext_vector_type(8)));
typedef short s16x4 __attribute__((ext_vector_type(4)));
typedef float f32x16 __attribute__((ext_vector_type(16)));
typedef float f32x4 __attribute__((ext_vector_type(4)));
typedef unsigned u32x4 __attribute__((ext_vector_type(4)));
typedef unsigned u32x2 __attribute__((ext_vector_type(2)));
typedef short v4i16_t __attribute__((ext_vector_type(4)));
typedef float f32x2_t __attribute__((ext_vector_type(2))); typedef __bf16 bf16x2_t __attribute__((ext_vector_type(2)));
constexpr int LUT_OFF = 98304, LUT_STRIDE = 520, GT_OFF = LUT_OFF + 12 * LUT_STRIDE * 4;
static_assert(GT_OFF + 512 <= 131072, "attention tables inside the ring region");
constexpr float NEG = -30000.f, THR = 6.f;
__device__ __forceinline__ unsigned cvtpk(float lo, float hi) { f32x2_t v = {lo, hi}; bf16x2_t b = __builtin_convertvector(v, bf16x2_t); return __builtin_bit_cast(unsigned, b); }
__device__ __forceinline__ s16x4 vtr(ALAS const unsigned char* p) { return __builtin_bit_cast(s16x4, __builtin_amdgcn_ds_read_tr16_b64_v4i16((ALAS v4i16_t*)p)); }
__device__ __forceinline__ void glds16(const void* gsrc, unsigned lds_dst) { unsigned keep;
    asm volatile("s_mov_b32 %0, m0\n\ts_mov_b32 m0, %2\n\ts_nop 0\n\tglobal_load_lds_dwordx4 %1, off\n\ts_mov_b32 m0, %0" : "=&s"(keep) : "v"(gsrc), "s"(lds_dst) : "memory"); }
__device__ __forceinline__ float swap_add(float v) { auto rr = __builtin_amdgcn_permlane32_swap(__float_as_uint(v), __float_as_uint(v), false, false); return __uint_as_float(rr[0]) + __uint_as_float(rr[1]); }
__device__ __forceinline__ float swap_max(float v) { auto rr = __builtin_amdgcn_permlane32_swap(__float_as_uint(v), __float_as_uint(v), false, false); return fmaxf(__uint_as_float(rr[0]), __uint_as_float(rr[1])); }
#define MX3(a, b, c) __builtin_fmaxf(__builtin_fmaxf((a), (b)), (c))

__device__ __forceinline__ void attn_tables(ALAS unsigned char* lds, const float* __restrict__ lutg, const float* __restrict__ subg, float osc) {
    int tid = threadIdx.x; asm volatile("" : "+v"(tid));
    ALAS float* lut = (ALAS float*)(lds + LUT_OFF); ALAS float* gt = (ALAS float*)(lds + GT_OFF);
    {
        typedef float lf4 __attribute__((ext_vector_type(4)));
        static_assert((12 * LUT_STRIDE) % 4 == 0 && 12 * LUT_STRIDE / 4 <= 4 * 512, "lut copy");
        const lf4* src = (const lf4*)lutg; lf4 v[4];
#pragma unroll
        for (int k = 0; k < 4; ++k) { const int i = tid + 512 * k; if (i < 12 * LUT_STRIDE / 4) v[k] = src[i]; }
#pragma unroll
        for (int k = 0; k < 4; ++k) { const int i = tid + 512 * k; if (i < 12 * LUT_STRIDE / 4) ((ALAS lf4*)lut)[i] = v[k]; }
    }
    if (tid < 128) gt[tid] = subg[tid] * osc;
    __syncthreads();
}
__device__ __forceinline__ float g4_max(float v) { v = fmaxf(v, __shfl_xor(v, 16)); return fmaxf(v, __shfl_xor(v, 32)); }
__device__ __forceinline__ float g4_sum(float v) { v += __shfl_xor(v, 16); return v + __shfl_xor(v, 32); }

template <bool ISB, int VAR = 0>
__device__ __forceinline__ void attn_unit(ALAS unsigned char* lds, bf16* zg, const float* __restrict__ lutg, int b, int hsel, int q0, const float* __restrict__ sinkp, float lam, float osc, const float* __restrict__ subg, bf16* odry) {
    int tid_ = threadIdx.x; asm volatile("" : "+v"(tid_));
    const int tid = tid_, lane = tid & 63, c16 = lane & 15, g = lane >> 4; const int wid = __builtin_amdgcn_readfirstlane(tid >> 6);
    constexpr int NDVB = ISB ? 8 : 4, BUF = ISB ? 32768 : 16384, VOFF = ISB ? 16384 : 8192, VROW = ISB ? 256 : 128;
    const int map = ISB ? (wid >> 2) : 0, qsub = ISB ? (wid & 3) : (wid & 1), gsel = ISB ? 0 : (wid >> 1);
    const int head = ISB ? hsel : hsel * 4 + gsel;
    const int qrow0 = q0 + 32 * qsub;
    const int qcol = ISB ? (C_QB + head * 128 + map * 64) : (C_QA + head * 64);
    const int kcol = ISB ? (C_KB + head * 128) : (C_KA + hsel * 64);
    const int vcol = ISB ? (C_VB + head * 128) : (C_VA + hsel * 64);
    const size_t rowbase = (size_t)b * S;
    int kt0 = 0, kt1 = S / 64;
    if (!ISB) { kt0 = q0 / 64 - 2; if (kt0 < 0) kt0 = 0; kt1 = q0 / 64 + 3; if (kt1 > S / 64) kt1 = S / 64; }
    const int nt = kt1 - kt0;
    ALAS float* lut = (ALAS float*)(lds + LUT_OFF) + (ISB ? 8 + head : hsel * 4 + gsel) * LUT_STRIDE;
    ALAS float* gt = (ALAS float*)(lds + GT_OFF);
    const float sink2 = ISB ? 0.f : sinkp[head] * LOG2E;
    bf16x8 qr[2][2];
#pragma unroll
    for (int qb = 0; qb < 2; ++qb) { const bf16* qp = zg + (rowbase + qrow0 + 16 * qb + c16) * ZG + qcol + 8 * g;
#pragma unroll
        for (int ks = 0; ks < 2; ++ks) qr[qb][ks] = *(const bf16x8*)(qp + 32 * ks); }
    const unsigned lds0 = (unsigned)(size_t)lds;
    const bf16* kp_[2]; const bf16* vp_[2];
#pragma unroll
    for (int i_ = 0; i_ < 2; ++i_) { const int p_ = ISB ? wid * 2 + i_ : wid;
        kp_[i_] = zg + (rowbase + (size_t)kt0 * 64 + (p_ & 7) * 8 + (lane >> 3)) * ZG + kcol + (ISB ? (p_ >> 3) * 64 : 0) + ((lane & 7) ^ (lane >> 3)) * 8;
        vp_[i_] = ISB ? zg + (rowbase + (size_t)kt0 * 64 + 4 * p_ + (lane >> 4)) * ZG + vcol + ((((lane & 15) >> 1) ^ (4 * (p_ & 1) + (lane >> 4))) * 16) + 8 * (lane & 1)
                      : zg + (rowbase + (size_t)kt0 * 64 + 8 * p_ + (lane >> 3)) * ZG + vcol + ((((lane & 7) >> 1) ^ ((lane >> 4) & 3)) * 16) + 8 * (lane & 1); }
#define ATT_ISSUE(bo) do { \
        _Pragma("unroll") for (int i_ = 0; i_ < (ISB ? 2 : 1); ++i_) { const int p_ = ISB ? wid * 2 + i_ : wid; \
            glds16(kp_[i_], (unsigned)__builtin_amdgcn_readfirstlane((int)(lds0 + (bo) + p_ * 1024))); \
            glds16(vp_[i_], (unsigned)__builtin_amdgcn_readfirstlane((int)(lds0 + (bo) + VOFF + p_ * 1024))); \
            kp_[i_] += 64 * ZG; vp_[i_] += 64 * ZG; } } while (0)
#define ATT_SB() __builtin_amdgcn_sched_barrier(0)
    float mhat[2] = {0.f, 0.f}, lsum[2] = {0.f, 0.f};
    f32x4 o[2][NDVB];
#pragma unroll
    for (int qb = 0; qb < 2; ++qb)
#pragma unroll
        for (int d = 0; d < NDVB; ++d) o[qb][d] = (f32x4){0.f, 0.f, 0.f, 0.f};
    const int kfo = (ISB ? map * 8192 : 0) + c16 * 128 + ((g ^ (c16 & 7)) * 16);
    const int vq = (lane & 15) >> 2, vsw = ISB ? (4 * (g & 1) + vq) : (2 * (g & 1) + (vq >> 1));
    const int vfo = VOFF + (4 * g + vq) * VROW + (lane & 3) * 8;
    u32x4 pw[2][2];
    const float cfar_r = ISB ? lut[256 + 128] : 0.f, cfar_l = ISB ? lut[256 - 128] : 0.f;
#define ATT_QK(P, t, so) do { const int kb_ = (t) * 64; float cf_ = 0.f; \
        if (ISB) { if (kb_ - qrow0 - 31 >= 91) cf_ = cfar_r; else if (kb_ + 63 - qrow0 <= -91) cf_ = cfar_l; } \
        const float c0_ = cf_ - mhat[0], c1_ = cf_ - mhat[1]; const f32x4 ci0_ = (f32x4){c0_, c0_, c0_, c0_}, ci1_ = (f32x4){c1_, c1_, c1_, c1_}; \
        ALAS const unsigned char* kp = lds + (so) + kfo; \
        _Pragma("unroll") for (int kb = 0; kb < 4; ++kb) { \
            const bf16x8 k0_ = *(ALAS const bf16x8*)(kp + kb * 2048), k1_ = *(ALAS const bf16x8*)((ALAS const unsigned char*)((unsigned)(size_t)kp ^ 64u) + kb * 2048); \
            P[0][kb] = __builtin_amdgcn_mfma_f32_16x16x32_bf16(k0_, qr[0][0], ci0_, 0, 0, 0); P[1][kb] = __builtin_amdgcn_mfma_f32_16x16x32_bf16(k0_, qr[1][0], ci1_, 0, 0, 0); \
            P[0][kb] = __builtin_amdgcn_mfma_f32_16x16x32_bf16(k1_, qr[0][1], P[0][kb], 0, 0, 0); P[1][kb] = __builtin_amdgcn_mfma_f32_16x16x32_bf16(k1_, qr[1][1], P[1][kb], 0, 0, 0); } } while (0)
#define ATT_DECIDE(P, t, first) do { const int kb_ = (t) * 64; \
        if (!ISB || !((kb_ - qrow0 - 31 >= 91) || (kb_ + 63 - qrow0 <= -91))) { \
            ALAS const float* lp = lut + (kb_ - (qrow0 + c16) + 256 + 4 * g); \
            _Pragma("unroll") for (int qb = 0; qb < 2; ++qb) { float lv_[16]; \
                _Pragma("unroll") for (int kb = 0; kb < 4; ++kb) _Pragma("unroll") for (int r = 0; r < 4; ++r) lv_[4 * kb + r] = lp[16 * kb - 16 * qb + r]; \
                _Pragma("unroll") for (int kb = 0; kb < 4; ++kb) _Pragma("unroll") for (int r = 0; r < 4; ++r) P[qb][kb][r] += lv_[4 * kb + r]; } } \
        float rm0_ = MX3(MX3(P[0][0][0], P[0][0][1], P[0][0][2]), P[0][0][3], P[0][1][0]), rm1_ = MX3(MX3(P[1][0][0], P[1][0][1], P[1][0][2]), P[1][0][3], P[1][1][0]); \
        rm0_ = MX3(MX3(rm0_, P[0][1][1], P[0][1][2]), P[0][1][3], P[0][2][0]); rm1_ = MX3(MX3(rm1_, P[1][1][1], P[1][1][2]), P[1][1][3], P[1][2][0]); \
        rm0_ = MX3(MX3(rm0_, P[0][2][1], P[0][2][2]), P[0][2][3], P[0][3][0]); rm1_ = MX3(MX3(rm1_, P[1][2][1], P[1][2][2]), P[1][2][3], P[1][3][0]); \
        rm0_ = MX3(MX3(rm0_, P[0][3][1], P[0][3][2]), P[0][3][3], rm0_); rm1_ = MX3(MX3(rm1_, P[1][3][1], P[1][3][2]), P[1][3][3], rm1_); \
        if ((first) || __any(__builtin_fmaxf(rm0_, rm1_) > THR)) { \
            const float f0_ = g4_max(rm0_), f1_ = g4_max(rm1_); \
            const float dl0 = (first) ? f0_ : __builtin_fmaxf(f0_, 0.f), dl1 = (first) ? f1_ : __builtin_fmaxf(f1_, 0.f); \
            mhat[0] += dl0; mhat[1] += dl1; \
            _Pragma("unroll") for (int kb = 0; kb < 4; ++kb) { P[0][kb] -= dl0; P[1][kb] -= dl1; } \
            if (!(first)) { const float s0_ = __builtin_amdgcn_exp2f(-dl0), s1_ = __builtin_amdgcn_exp2f(-dl1); lsum[0] *= s0_; lsum[1] *= s1_; \
                _Pragma("unroll") for (int d = 0; d < NDVB; ++d) { o[0][d] *= s0_; o[1][d] *= s1_; } } } } while (0)
#define ATT_FINISH(P) do { \
        _Pragma("unroll") for (int qb = 0; qb < 2; ++qb) { float sa_ = 0.f; \
            _Pragma("unroll") for (int kb = 0; kb < 4; ++kb) _Pragma("unroll") for (int r = 0; r < 4; ++r) { P[qb][kb][r] = __builtin_amdgcn_exp2f(P[qb][kb][r]); sa_ += P[qb][kb][r]; } \
            lsum[qb] += sa_; \
            _Pragma("unroll") for (int s_ = 0; s_ < 2; ++s_) pw[qb][s_] = (u32x4){cvtpk(P[qb][2 * s_][0], P[qb][2 * s_][1]), cvtpk(P[qb][2 * s_][2], P[qb][2 * s_][3]), cvtpk(P[qb][2 * s_ + 1][0], P[qb][2 * s_ + 1][1]), cvtpk(P[qb][2 * s_ + 1][2], P[qb][2 * s_ + 1][3])}; } } while (0)
#define ATT_LDV2(dst, s_, d0_) do { _Pragma("unroll") for (int dd = 0; dd < 2; ++dd) { ALAS const unsigned char* a_ = vp + (s_) * 32 * VROW + ((((d0_) + dd) ^ vsw) * 32); dst[2 * dd] = vtr(a_); dst[2 * dd + 1] = vtr(a_ + 16 * VROW); } } while (0)
#define ATT_PV2(src, s_, d0_) do { __builtin_amdgcn_s_setprio(1); _Pragma("unroll") for (int dd = 0; dd < 2; ++dd) { \
            const bf16x8 vf_ = (bf16x8){src[2 * dd][0], src[2 * dd][1], src[2 * dd][2], src[2 * dd][3], src[2 * dd + 1][0], src[2 * dd + 1][1], src[2 * dd + 1][2], src[2 * dd + 1][3]}; \
            o[0][(d0_) + dd] = __builtin_amdgcn_mfma_f32_16x16x32_bf16(vf_, __builtin_bit_cast(bf16x8, pw[0][s_]), o[0][(d0_) + dd], 0, 0, 0); \
            o[1][(d0_) + dd] = __builtin_amdgcn_mfma_f32_16x16x32_bf16(vf_, __builtin_bit_cast(bf16x8, pw[1][s_]), o[1][(d0_) + dd], 0, 0, 0); } __builtin_amdgcn_s_setprio(0); } while (0)
#define ATT_PV(so) do { ALAS const unsigned char* vp = lds + (so) + vfo; s16x4 va[4], vb[4]; constexpr int NG_ = NDVB / 2; \
        ATT_LDV2(va, 0, 0); ATT_SB(); \
        _Pragma("unroll") for (int k_ = 0; k_ < 2 * NG_; k_ += 2) { \
            ATT_LDV2(vb, (k_ + 1) / NG_, 2 * ((k_ + 1) % NG_)); ATT_SB(); \
            ATT_PV2(va, k_ / NG_, 2 * (k_ % NG_)); ATT_SB(); \
            if (k_ + 2 < 2 * NG_) { ATT_LDV2(va, (k_ + 2) / NG_, 2 * ((k_ + 2) % NG_)); ATT_SB(); } \
            ATT_PV2(vb, (k_ + 1) / NG_, 2 * ((k_ + 1) % NG_)); ATT_SB(); } } while (0)
#define ATT_SLOT(i) (ISB ? (((i) % 3) * BUF) : ((i) * BUF))
#define ATT_STEP(i, PC, PP) do { \
        if (ISB) { asm volatile("s_waitcnt vmcnt(0)" ::: "memory"); __syncthreads(); if ((i) + 1 < nt) ATT_ISSUE(ATT_SLOT((i) + 1)); } \
        ATT_QK(PC, kt0 + (i), ATT_SLOT(i)); ATT_SB(); \
        ATT_FINISH(PP); ATT_SB(); \
        ATT_PV(ATT_SLOT((i) - 1)); ATT_SB(); \
        ATT_DECIDE(PC, kt0 + (i), false); ATT_SB(); } while (0)
    f32x4 pA[2][4], pB[2][4];
    if (ISB) { ATT_ISSUE(0); asm volatile("s_waitcnt vmcnt(0)" ::: "memory"); __syncthreads(); if (nt > 1) ATT_ISSUE(BUF); }
    else {
#pragma unroll 1
        for (int i = 0; i < nt; ++i) ATT_ISSUE(i * BUF);
        asm volatile("s_waitcnt vmcnt(0)" ::: "memory"); __syncthreads();
    }
    ATT_QK(pA, kt0, 0); ATT_SB();
    ATT_DECIDE(pA, kt0, true); ATT_SB();
    int i = 1;
#pragma unroll 1
    for (; i + 1 < nt; i += 2) {
        ATT_STEP(i, pB, pA);
        ATT_STEP(i + 1, pA, pB);
    }
    if (i < nt) {
        ATT_STEP(i, pB, pA);
        ATT_FINISH(pB); ATT_SB(); ATT_PV(ATT_SLOT(nt - 1));
    } else {
        ATT_FINISH(pA); ATT_SB(); ATT_PV(ATT_SLOT(nt - 1));
    }
#undef ATT_ISSUE
#undef ATT_SB
#undef ATT_QK
#undef ATT_DECIDE
#undef ATT_FINISH
#undef ATT_LDV2
#undef ATT_PV2
#undef ATT_PV
#undef ATT_SLOT
#undef ATT_STEP
    float inv[2];
#pragma unroll
    for (int qb = 0; qb < 2; ++qb) { float l_ = g4_sum(lsum[qb]); if (!ISB) l_ += __builtin_amdgcn_exp2f(sink2 - mhat[qb]); inv[qb] = 1.0f / l_; }
    constexpr int DVE = ISB ? 128 : 64, SPITCH = DVE * 2 + 8;
    bf16* obase = odry ? odry + (rowbase + qrow0) * D + (ISB ? (512 + head * 128) : (head * 64)) : zg + (rowbase + qrow0) * ZG + (ISB ? (C_QB + head * 128) : (C_QA + head * 64));
    const size_t opitch = odry ? D : ZG;
    ALAS unsigned char* stg = lds + (ISB ? qsub * 16384 : wid * 4608);
#define ATT_OUT() do { asm volatile("s_waitcnt lgkmcnt(0)" ::: "memory"); \
        constexpr int LPR = DVE / 8, RPI = 64 / LPR; \
        _Pragma("unroll") for (int i_ = 0; i_ < 32 / RPI; ++i_) { const int row_ = i_ * RPI + lane / LPR, ch_ = lane % LPR; \
            const u32x2 a_ = *(ALAS const u32x2*)(stg + row_ * SPITCH + ch_ * 16), b_ = *(ALAS const u32x2*)(stg + row_ * SPITCH + ch_ * 16 + 8); \
            *(u32x4*)(obase + (size_t)row_ * opitch + ch_ * 8) = (u32x4){a_.x, a_.y, b_.x, b_.y}; } } while (0)
    if (ISB) {
        __syncthreads();
        ALAS float* cs = (ALAS float*)lds;
        if (map == 1) {
#pragma unroll
            for (int qb = 0; qb < 2; ++qb) { const float sc = -lam * inv[qb];
#pragma unroll
                for (int d = 0; d < NDVB; ++d)
#pragma unroll
                    for (int r = 0; r < 4; ++r) cs[(qsub * 64 + (qb * NDVB + d) * 4 + r) * 64 + lane] = o[qb][d][r] * sc; } }
        __syncthreads();
        if (map == 0) {
            float rstd[2];
#pragma unroll
            for (int qb = 0; qb < 2; ++qb) { float q = 0.f;
#pragma unroll
                for (int d = 0; d < NDVB; ++d)
#pragma unroll
                    for (int r = 0; r < 4; ++r) { const float v = o[qb][d][r] * inv[qb] + cs[(qsub * 64 + (qb * NDVB + d) * 4 + r) * 64 + lane]; o[qb][d][r] = v; q += v * v; }
                rstd[qb] = rsqrtf(g4_sum(q) * (1.0f / 128.0f) + EPS); }
            asm volatile("s_waitcnt lgkmcnt(0)" ::: "memory");
#pragma unroll
            for (int qb = 0; qb < 2; ++qb)
#pragma unroll
                for (int d = 0; d < NDVB; ++d) { const int dv0 = 16 * d + 4 * g; const f32x4 gv = *(ALAS const f32x4*)(gt + dv0);
                    u32x2 w; w.x = cvtpk(o[qb][d][0] * rstd[qb] * gv[0], o[qb][d][1] * rstd[qb] * gv[1]); w.y = cvtpk(o[qb][d][2] * rstd[qb] * gv[2], o[qb][d][3] * rstd[qb] * gv[3]);
                    *(ALAS u32x2*)(stg + (16 * qb + c16) * SPITCH + dv0 * 2) = w; }
            ATT_OUT();
        }
    } else {
        __syncthreads();
#pragma unroll
        for (int qb = 0; qb < 2; ++qb)
#pragma unroll
            for (int d = 0; d < NDVB; ++d) { const int dv0 = 16 * d + 4 * g;
                u32x2 w; w.x = cvtpk(o[qb][d][0] * inv[qb], o[qb][d][1] * inv[qb]); w.y = cvtpk(o[qb][d][2] * inv[qb], o[qb][d][3] * inv[qb]);
                *(ALAS u32x2*)(stg + (16 * qb + c16) * SPITCH + dv0 * 2) = w; }
        ATT_OUT();
    }
#undef ATT_OUT
    __syncthreads();
}
#undef MX3
}

#ifndef MK_VAR
#define MK_VAR 0
#endif
#define MK_DUP 0
#define MK_DSEL 0
namespace mk {
using namespace nv;
constexpr int NWAVES = 8;
constexpr size_t MiB = 1u << 20;
constexpr size_t WS_CTL = 0, CTL_ZERO_BYTES = 1 * MiB;
constexpr size_t WS_LUT = 512 * 1024;
constexpr size_t WS_SS = 1 * MiB;
constexpr size_t WS_XB = 6 * MiB;
constexpr size_t WS_ZG = 38 * MiB;
constexpr size_t WS_A = 38 * MiB;
constexpr size_t WS_YB = 126 * MiB;
constexpr size_t WS_MIX = 174 * MiB;
constexpr size_t WS_W = 206 * MiB;
constexpr size_t WL_IN = 0, WL_A = (size_t)ZG * D, WL_B = WL_A + (size_t)D * 512, WL_O = WL_B + (size_t)D * 512, WL_UP = WL_O + (size_t)D * D, WL_DN = WL_UP + (size_t)FF2 * D, WL_END = WL_DN + (size_t)D * FF;
constexpr size_t WS_END = 322 * MiB;
static_assert(WS_W + 4 * WL_END * 2 <= WS_END && WS_YB + (size_t)64 * 4 * FF2 * 4 <= WS_MIX && WS_A + (size_t)T * FF * 2 <= WS_YB, "d_ws map");
constexpr int CW_Q = 2048;
constexpr int CW_BAR = 8192;
constexpr int N_PHASES = 1 + 6 * L;
constexpr int RING_OFF = 0, RING_BYTES = 131072, LDSCTL_OFF = RING_BYTES, MISC_OFF = LDSCTL_OFF + 320;
constexpr int LDS_BYTES = 149504;
static_assert(pg8::RTAB_OFF + 8192 <= LDS_BYTES && MISC_OFF + 128 <= pg8::XOFF, "LDS map");

#define GAS __attribute__((address_space(1)))
#define LAS __attribute__((address_space(3)))
typedef unsigned v4u __attribute__((ext_vector_type(4)));
typedef float f32x4 __attribute__((ext_vector_type(4)));
typedef GAS unsigned gu32;
#define RLX_AGENT __ATOMIC_RELAXED, __HIP_MEMORY_SCOPE_AGENT
#define LDS_WAIT() asm volatile("s_waitcnt lgkmcnt(0)" ::: "memory")
#define VM_WAIT() asm volatile("s_waitcnt vmcnt(0)" ::: "memory")
__device__ __forceinline__ unsigned f2bfu(float f) { unsigned u = __builtin_bit_cast(unsigned, f); return (u + 0x7fffu + ((u >> 16) & 1u)) >> 16; }
__device__ __forceinline__ unsigned pk2(float lo, float hi) { return f2bfu(lo) | (f2bfu(hi) << 16); }

#define XB_TMO      128
#define XB_XCNT(j)  (256  + 64 * (j))
#define XB_XSUB(j)  (1280 + 64 * (j))
#define XB_XGEN(j)  (2304 + 64 * (j))
#define XB_TOP      3328
#define XB_TOPGEN   3392
#define XB_LSUB(j)  (3456 + 64 * (j))
#define XB_LGEN(j)  (4480 + 64 * (j))
#define XCD_BAR_WORDS 5504
#define XB_SPIN_CAP (1u << 18)

__device__ __forceinline__ unsigned xb_ld(unsigned* p)              { return __hip_atomic_load(p, __ATOMIC_RELAXED, __HIP_MEMORY_SCOPE_AGENT); }
__device__ __forceinline__ unsigned xb_add(unsigned* p, unsigned v) { return __hip_atomic_fetch_add(p, v, __ATOMIC_RELAXED, __HIP_MEMORY_SCOPE_AGENT); }
__device__ __forceinline__ unsigned xb_xcc_id() { return (unsigned)__builtin_amdgcn_s_getreg((3 << 11) | 20) & 0xFu; }
#define XB_SPIN(cond, bar) do { unsigned _sp = 0; while (cond) { __builtin_amdgcn_s_sleep(1); \
    if ((++_sp & 255u) == 0u) { if (xb_ld(&(bar)[XB_TMO])) break; if (_sp > XB_SPIN_CAP) { atomicAdd(&(bar)[XB_TMO], 1u); break; } } } } while (0)

struct XcdBarrier {
    unsigned* bar; unsigned x;
    volatile LAS unsigned* st;
};

__device__ __forceinline__ XcdBarrier xcd_barrier_post(unsigned* bar, volatile LAS unsigned* st) {
    XcdBarrier b; b.bar = bar; b.x = xb_xcc_id(); b.st = st;
    if (threadIdx.x == 0) { st[2] = b.x; st[3] = xb_add(&bar[XB_XCNT(b.x)], 1u); }
    return b;
}
__device__ __forceinline__ void xcd_barrier_complete(unsigned* bar, unsigned x, unsigned& nloc, unsigned& nx, unsigned& even) {
    const unsigned G = gridDim.x * gridDim.y * gridDim.z;
    unsigned sum, cnt, mine, odd, sp = 0u;
    for (;;) {
        sum = 0u; cnt = 0u; mine = 0u; odd = 0u;
#pragma unroll
        for (unsigned j = 0; j < 16; ++j) { const unsigned c = xb_ld(&bar[XB_XCNT(j)]); sum += c; cnt += (c > 0u) ? 1u : 0u; mine = (j == x) ? c : mine; odd += (c != 0u && c != 32u) ? 1u : 0u; }
        if (sum == G) break;
        __builtin_amdgcn_s_sleep(1);
        if ((++sp & 255u) == 0u) { if (xb_ld(&bar[XB_TMO])) break; if (sp > XB_SPIN_CAP) { atomicAdd(&bar[XB_TMO], 1u); break; } }
    }
    nloc = mine > 0u ? mine : 1u; nx = cnt > 0u ? cnt : 1u;
    even = (sum == G && G == 256u && cnt == 8u && odd == 0u) ? 1u : 0u;
}

__device__ __forceinline__ void xcd_barrier(const XcdBarrier& b) {
    asm volatile("s_waitcnt vmcnt(0)" ::: "memory");
    __syncthreads();
    if (threadIdx.x == 0) {
        unsigned* bar = b.bar;
        __builtin_amdgcn_s_waitcnt(0);
        unsigned nloc = b.st[0], nx = b.st[1];
        if (nloc == 0u) { unsigned even; xcd_barrier_complete(bar, b.x, nloc, nx, even); b.st[0] = nloc; b.st[1] = nx; b.st[4] = even; }
        const unsigned old = xb_add(&bar[XB_XSUB(b.x)], 1u);
        const unsigned gen = old / nloc;
        if (old + 1u == (gen + 1u) * nloc) {
            __builtin_amdgcn_fence(__ATOMIC_RELEASE, "agent");
            asm volatile("s_waitcnt vmcnt(0)" ::: "memory");
            const unsigned og = xb_add(&bar[XB_TOP], 1u);
            const unsigned tg = og / nx;
            if (og + 1u == (tg + 1u) * nx) xb_add(&bar[XB_TOPGEN], 1u);
            else XB_SPIN(xb_ld(&bar[XB_TOPGEN]) == tg, bar);
            __builtin_amdgcn_fence(__ATOMIC_ACQUIRE, "agent");
            xb_add(&bar[XB_XGEN(b.x)], 1u);
            asm volatile("s_waitcnt vmcnt(0)" ::: "memory");
        } else {
            XB_SPIN(xb_ld(&bar[XB_XGEN(b.x)]) == gen, bar);
            __builtin_amdgcn_fence(__ATOMIC_ACQUIRE, "agent");
            asm volatile("s_waitcnt vmcnt(0)" ::: "memory");
        }
    }
    __syncthreads();
}

__device__ __forceinline__ void xcd_local_barrier(const XcdBarrier& b) {
    asm volatile("s_waitcnt vmcnt(0)" ::: "memory");
    __syncthreads();
    if (threadIdx.x == 0) {
        unsigned* bar = b.bar;
        __builtin_amdgcn_s_waitcnt(0);
        const unsigned nloc = b.st[0];
        const unsigned old = xb_add(&bar[XB_LSUB(b.x)], 1u);
        const unsigned gen = old / nloc;
        if (old + 1u == (gen + 1u) * nloc) xb_add(&bar[XB_LGEN(b.x)], 1u);
        else XB_SPIN(xb_ld(&bar[XB_LGEN(b.x)]) == gen, bar);
        __builtin_amdgcn_fence(__ATOMIC_ACQUIRE, "agent");
        asm volatile("s_waitcnt vmcnt(0)" ::: "memory");
    }
    __syncthreads();
}

struct Args { const float* in[24]; float* out; unsigned char* ws; int ph_lo, ph_hi, li, pad; };

__device__ __forceinline__ void p0_transpose_item(const float* __restrict__ W, int ldw, int K, int k0, int n0, bf16* __restrict__ WT, int vrow0, const float* __restrict__ gain, LAS float* scr, int lane) {
    f32x4 v[8];
    const float* wp = W + (size_t)(k0 + (lane >> 3)) * ldw + n0 + 4 * (lane & 7);
#pragma unroll
    for (int i = 0; i < 8; ++i) v[i] = __builtin_nontemporal_load((const f32x4*)(wp + (size_t)(8 * i) * ldw));
    if (gain) {
#pragma unroll
        for (int i = 0; i < 8; ++i) v[i] *= gain[k0 + 8 * i + (lane >> 3)];
    }
#pragma unroll
    for (int i = 0; i < 8; ++i) { LAS float* d = scr + (8 * i + (lane >> 3)) * 33 + 4 * (lane & 7); d[0] = v[i].x; d[1] = v[i].y; d[2] = v[i].z; d[3] = v[i].w; }
    LDS_WAIT(); asm volatile("" ::: "memory");
    const int c = lane & 7;
#pragma unroll
    for (int j = 0; j < 4; ++j) { const int n = (lane >> 3) + 8 * j; const LAS float* s = scr + (8 * c) * 33 + n;
        v4u o; o.x = pk2(s[0 * 33], s[1 * 33]); o.y = pk2(s[2 * 33], s[3 * 33]); o.z = pk2(s[4 * 33], s[5 * 33]); o.w = pk2(s[6 * 33], s[7 * 33]);
        *(GAS v4u*)(WT + (size_t)(vrow0 + n) * K + k0 + 8 * c) = o; }
    LDS_WAIT(); asm volatile("" ::: "memory");
}
__device__ __forceinline__ int vrow_in(int c) { const int pn = c >> 8, cr = c & 255, wc = cr >> 6, bj = (cr >> 5) & 1; return pn * 256 + bj * 128 + wc * 32; }
__device__ __forceinline__ int vrow_gate(int cg) { const int s_ = cg >= D ? 1 : 0, cc = cg - s_ * D; return (9 + (cc >> 7)) * 256 + s_ * 128 + (cc & 127); }
__device__ __forceinline__ int vrow_up(int c) { const int gs = c >= FF ? 1 : 0, cc = c - gs * FF, pn = cc >> 7, wc = (cc >> 5) & 3; return pn * 256 + gs * 128 + wc * 32; }

__device__ __forceinline__ int cur_bxv(volatile LAS unsigned* MISC) { int b = blockIdx.x; const unsigned ev = MISC[12]; if (ev) b = (int)(MISC[11] * 8u + MISC[10]); return __builtin_amdgcn_readfirstlane(b); }
__device__ __forceinline__ int cur_vcu(volatile LAS unsigned* MISC) { const int b = cur_bxv(MISC), G = gridDim.x; return (G % 8 == 0) ? (b % 8) * (G / 8) + b / 8 : b; }
__global__ void __launch_bounds__(NWAVES * 64, 2) skel_fwd(Args args) {
    extern __shared__ __attribute__((aligned(16))) unsigned char lds_raw[];
    LAS unsigned char* lds = (LAS unsigned char*)lds_raw;
    volatile LAS unsigned* MISC = (volatile LAS unsigned*)(lds + MISC_OFF);
    const int G = gridDim.x;
    unsigned char* ws = args.ws;
    gu32* ctl = (gu32*)(ws + WS_CTL);
    float* ss = (float*)(ws + WS_SS); bf16* xb = (bf16*)(ws + WS_XB); bf16* zg = (bf16*)(ws + WS_ZG); bf16* abuf = (bf16*)(ws + WS_A); float* yb = (float*)(ws + WS_YB);
    bf16* mix = (bf16*)(ws + WS_MIX); bf16* wbase = (bf16*)(ws + WS_W); float* xf = args.out;
    float* lutg = (float*)(ws + WS_LUT);
    for (int u = threadIdx.x; u < (LDS_BYTES - LDSCTL_OFF) / 4; u += NWAVES * 64) ((LAS unsigned*)(lds + LDSCTL_OFF))[u] = 0u;
    __syncthreads();
    XcdBarrier bar = xcd_barrier_post((unsigned*)(ctl + CW_BAR) + args.li * XCD_BAR_WORDS, MISC + 8);

#pragma unroll 1
    for (int ph = args.ph_lo; ph < args.ph_hi; ++ph) {
        const int l = ph > 0 ? (ph - 1) / 6 : 0, p = ph > 0 ? (ph - 1) % 6 + 1 : 0;
#define BXV() cur_bxv(MISC)
#define VCU() cur_vcu(MISC)
        bf16* wl = wbase + (size_t)l * WL_END;
        float* ss1 = ss + (size_t)((2 * l) & 3) * T * 16; float* ss2 = ss + (size_t)((2 * l + 1) & 3) * T * 16; float* ss3 = (l + 1 < L) ? ss + (size_t)((2 * l + 2) & 3) * T * 16 : nullptr;
#ifndef MK_ONLY
#define MK_ONLY 0x7f
#endif
        const int dupp = ((args.pad >> 8) & 0xff) - 1;
#pragma unroll 1
        for (int rep = (p == dupp) ? 0 : 1; rep < 2; ++rep) {
        if (p == 0 && (MK_ONLY & 1)) {
            int tid0 = threadIdx.x; asm volatile("" : "+v"(tid0));
            const int lane0 = tid0 & 63, wave = __builtin_amdgcn_readfirstlane(tid0 >> 6);
            LAS float* scr = (LAS float*)(lds + RING_OFF + wave * 16384);
            const int gw = VCU() * NWAVES + wave, NGW = G * NWAVES;
            constexpr int I_IN = (D / 64) * (INW / 32), I_G = (D / 64) * (GW / 32), I_A = (512 / 64) * (D / 32), I_O = (D / 64) * (D / 32), I_UP = (D / 64) * (FF2 / 32), I_DN = (FF / 64) * (D / 32);
            constexpr int I_LAYER = I_IN + I_G + 2 * I_A + I_O + I_UP + I_DN;
            for (int i = gw * 64 + lane0; i < 12 * att::LUT_STRIDE; i += NGW * 64) { const int hh = i / att::LUT_STRIDE, j = i - hh * att::LUT_STRIDE, rel = j - 256, ar = rel < 0 ? -rel : rel;
                float v = 0.f; if (j <= 512) v = (hh < 8 && ar > 128) ? att::NEG : args.in[13][t5_bucket(rel) * 12 + hh] * LOG2E;
                lutg[i] = v; }
            for (int m = gw; m < T; m += 2 * NGW) {
                const int m2 = m + NGW;
                const GAS f32x4* xr = (const GAS f32x4*)(args.in[0] + (size_t)m * D) + lane0; const GAS f32x4* xr2 = (const GAS f32x4*)(args.in[0] + (size_t)m2 * D) + lane0;
                GAS unsigned long long* o8 = (GAS unsigned long long*)(xb + (size_t)m * D) + lane0; GAS unsigned long long* o82 = (GAS unsigned long long*)(xb + (size_t)m2 * D) + lane0;
                f32x4 va[4], vb[4];
#pragma unroll
                for (int j = 0; j < 4; ++j) { va[j] = xr[64 * j]; vb[j] = xr2[64 * j]; }
                float s = 0.f, s2 = 0.f;
#pragma unroll
                for (int j = 0; j < 4; ++j) { const f32x4 v = va[j], w = vb[j]; s += (v.x * v.x + v.y * v.y) + (v.z * v.z + v.w * v.w); s2 += (w.x * w.x + w.y * w.y) + (w.z * w.z + w.w * w.w);
                    o8[64 * j] = (unsigned long long)pk2(v.x, v.y) | ((unsigned long long)pk2(v.z, v.w) << 32); o82[64 * j] = (unsigned long long)pk2(w.x, w.y) | ((unsigned long long)pk2(w.z, w.w) << 32); }
                s = wave_sum(s); s2 = wave_sum(s2);
                ss16_store(ss, m, s, lane0); ss16_store(ss, m2, s2, lane0);
            }
        } else if (p == 1 && (MK_ONLY & 2)) {
            pg8::SchedStd S; S.init(xb, D, wl + WL_IN, D, T, ZG - 256, G, BXV());
            S.fix = (rep == 0 && MK_VAR == 8) ? 1 : 0;
            pg8::EpiIn E{zg, ss1, args.in[3] + l * 64, args.in[4] + l * 64, args.in[6] + l * 64, args.in[7] + l * 64, args.in[15] + l * GW, (args.pad >> 25) & 1, 8 * (BXV() & 7) * 256};
            pg8::gemm_phase<pg8::EpiIn, pg8::SchedStd, true, true>(lds + RING_OFF, D, D, S, E);
        } else if (p == 2 && (MK_ONLY & 4)) {
            int lop = l; asm volatile("" : "+s"(lop));
            const float lam_init = 0.8f - 0.6f * __expf(-0.3f * (float)lop);
            int ln = threadIdx.x; asm volatile("" : "+v"(ln)); ln &= 63;
            const float d1 = wave_sum(args.in[8][l * 64 + ln] * args.in[9][l * 64 + ln]), d2 = wave_sum(args.in[10][l * 64 + ln] * args.in[11][l * 64 + ln]);
            const float lam = __expf(d1) - __expf(d2) + lam_init;
            if ((VCU() & 3) == 0 && rep == 1) {
                pg8::SchedStd S1; S1.init(xb, D, wl + WL_IN, D, T, ZG, G, BXV()); S1.one = 1; { const int vc = VCU(); S1.opm = 8 * (vc >> 5) + ((vc & 31) >> 2); } S1.opn = 16;
                pg8::EpiIn E1{zg, ss1, args.in[3] + l * 64, args.in[4] + l * 64, args.in[6] + l * 64, args.in[7] + l * 64, args.in[15] + l * GW, 0, 8 * (BXV() & 7) * 256};
                pg8::gemm_phase<pg8::EpiIn, pg8::SchedStd, true, true>(lds + RING_OFF, D, D, S1, E1);
            }
            att::attn_tables(lds, lutg, args.in[12] + l * 128, 1.0f - lam_init);
            const int dsel = args.pad >> 16;
            if (rep == 1 || dsel != 2)
            for (int k_ = 0; k_ < 2; ++k_) { const int vcu = VCU(); const int ui = vcu + k_ * G; if (ui >= 512) break; const int bh = ui >> 4, qb = ui & 15; if (rep == 0 && MK_VAR == 7 && (vcu & 1)) {} else if (rep == 0) att::attn_unit<true, (MK_VAR == 7 ? 0 : MK_VAR)>(lds, zg, lutg, bh >> 2, bh & 3, qb * 128, nullptr, lam, 1.0f - lam_init, args.in[12] + l * 128, mix);
                else att::attn_unit<true, 0>(lds, zg, lutg, bh >> 2, bh & 3, qb * 128, nullptr, lam, 1.0f - lam_init, args.in[12] + l * 128, nullptr); }
            if (rep == 1 || dsel != 1) {
                unsigned* qctr = (unsigned*)(ctl + CW_Q + 64 * (2 * l + rep));
                for (;;) {
                    if (threadIdx.x == 0) MISC[4] = __hip_atomic_fetch_add(qctr, 1u, __ATOMIC_RELAXED, __HIP_MEMORY_SCOPE_AGENT);
                    __syncthreads();
                    const int ui = (int)MISC[4];
                    __syncthreads();
                    if (ui >= 512) break;
                    const int bk = ui >> 5, qb = ui & 31; att::attn_unit<false>(lds, zg, lutg, bk >> 1, bk & 1, qb * 64, args.in[5] + l * HA, 0.f, 0.f, nullptr, rep == 0 ? mix : nullptr);
                }
            }
        } else if (p == 3 && (MK_ONLY & 8)) {
            pg8::SchedMix S; S.b.init(zg + C_QA, ZG, wl + WL_A, 512, T, D, G, BXV()); S.A1 = (const char*)(zg + C_QB); S.Bt1 = (const char*)(wl + WL_B);
            pg8::EpiMix E{zg, mix};
            pg8::gemm_phase<pg8::EpiMix, pg8::SchedMix, true, true>(lds + RING_OFF, 512, ZG, S, E);
        } else if (p == 4 && (MK_ONLY & 16)) {
            pg8::SchedStd S; S.init(mix, D, wl + WL_O, D, T, D, G, BXV());
            pg8::EpiRes E{l == 0 ? args.in[0] : xf, xf, xb, ss2};
            pg8::gemm_phase<pg8::EpiRes, pg8::SchedStd, true, true>(lds + RING_OFF, D, D, S, E);
        } else if (p == 5 && (MK_ONLY & 32)) {
            pg8::SchedStd S; S.init(xb, D, wl + WL_UP, D, T, FF2, G, BXV());
            pg8::EpiUp E{abuf, ss2, args.in[21] + (size_t)l * 3 * FF2, args.in[22] + (size_t)l * FF2, yb, (args.pad >> 24) & 1, 8 * (BXV() & 7) * 256};
            pg8::gemm_phase<pg8::EpiUp, pg8::SchedStd, true, true>(lds + RING_OFF, D, D, S, E);
        } else if (MK_ONLY & 64) {
            pg8::SchedDown S; S.b.init(abuf, FF, wl + WL_DN, FF, T, D, G, BXV()); S.yb = (args.pad & 1) ? nullptr : yb; S.cw = args.in[21] + (size_t)l * 3 * FF2; S.cb = args.in[22] + (size_t)l * FF2; S.a = abuf;
            pg8::EpiRes E{xf, xf, ss3 ? xb : nullptr, ss3};
            pg8::gemm_phase<pg8::EpiRes, pg8::SchedDown, true, true>(lds + RING_OFF, FF, FF, S, E);
        }
        {
            int ph2 = ph; asm volatile("" : "+s"(ph2));
            const int l2 = ph2 > 0 ? (ph2 - 1) / 6 : 0, p2 = ph2 > 0 ? (ph2 - 1) % 6 + 1 : 0;
            const int G2 = gridDim.x; int bx2 = blockIdx.x; { const unsigned ev2 = MISC[12]; if (ev2) bx2 = (int)(MISC[11] * 8u + MISC[10]); } bx2 = __builtin_amdgcn_readfirstlane(bx2);
            int cl = -1, cw0 = 0, cnw = 1;
            if (p2 == 0) { cl = 0; cw0 = ((G2 % 8 == 0) ? (bx2 % 8) * (G2 / 8) + bx2 / 8 : bx2) * NWAVES; cnw = G2 * NWAVES; }
            else if (p2 == 5 && l2 + 1 < L && G2 == 256 && bx2 >= 128) { cl = l2 + 1; cw0 = (bx2 - 128) * NWAVES; cnw = 128 * NWAVES; }
            if (cl >= 0) {
                bf16* wbase2 = (bf16*)(args.ws + WS_W);
                int tid0 = threadIdx.x; asm volatile("" : "+v"(tid0));
                const int lane0 = tid0 & 63, wave = __builtin_amdgcn_readfirstlane(tid0 >> 6);
                LAS float* scr = (LAS float*)(lds + RING_OFF + wave * 16384);
                constexpr int I_IN = (D / 64) * (INW / 32), I_G = (D / 64) * (GW / 32), I_A = (512 / 64) * (D / 32), I_O = (D / 64) * (D / 32), I_UP = (D / 64) * (FF2 / 32), I_DN = (FF / 64) * (D / 32);
                constexpr int I_LAYER = I_IN + I_G + 2 * I_A + I_O + I_UP + I_DN;
                const int ll = cl; bf16* w = wbase2 + (size_t)ll * WL_END;
#pragma unroll 1
                for (int it = cw0 + wave; it < I_LAYER; it += cnw) {
                    int r = it;
                    if (r < I_IN) { const int nb = r % (INW / 32), kb = r / (INW / 32); p0_transpose_item(args.in[2] + (size_t)ll * D * INW, INW, D, 64 * kb, 32 * nb, w + WL_IN, vrow_in(32 * nb), args.in[1] + ll * D, scr, lane0); continue; } r -= I_IN;
                    if (r < I_G) { const int nb = r % (GW / 32), kb = r / (GW / 32); p0_transpose_item(args.in[14] + (size_t)ll * D * GW, GW, D, 64 * kb, 32 * nb, w + WL_IN, vrow_gate(32 * nb), args.in[1] + ll * D, scr, lane0); continue; } r -= I_G;
                    if (r < I_A) { const int nb = r % (D / 32), kb = r / (D / 32); p0_transpose_item(args.in[16] + (size_t)ll * 512 * D, D, 512, 64 * kb, 32 * nb, w + WL_A, 32 * nb, nullptr, scr, lane0); continue; } r -= I_A;
                    if (r < I_A) { const int nb = r % (D / 32), kb = r / (D / 32); p0_transpose_item(args.in[17] + (size_t)ll * 512 * D, D, 512, 64 * kb, 32 * nb, w + WL_B, 32 * nb, nullptr, scr, lane0); continue; } r -= I_A;
                    if (r < I_O) { const int nb = r % (D / 32), kb = r / (D / 32); p0_transpose_item(args.in[18] + (size_t)ll * D * D, D, D, 64 * kb, 32 * nb, w + WL_O, 32 * nb, nullptr, scr, lane0); continue; } r -= I_O;
                    if (r < I_UP) { const int nb = r % (FF2 / 32), kb = r / (FF2 / 32); p0_transpose_item(args.in[20] + (size_t)ll * D * FF2, FF2, D, 64 * kb, 32 * nb, w + WL_UP, vrow_up(32 * nb), args.in[19] + ll * D, scr, lane0); continue; } r -= I_UP;
                    { const int nb = r % (D / 32), kb = r / (D / 32); p0_transpose_item(args.in[23] + (size_t)ll * FF * D, D, FF, 64 * kb, 32 * nb, w + WL_DN, 32 * nb, nullptr, scr, lane0); }
                }
            }
        }
        }
        if (ph + 1 < args.ph_hi) { int pq = ph; asm volatile("" : "+s"(pq)); const unsigned ev3 = MISC[12]; const bool loc = ev3 != 0u && pq > 0 && (pq - 1) % 6 >= 2 && (pq - 1) % 6 != 5; if (__builtin_amdgcn_readfirstlane((int)loc)) xcd_local_barrier(bar); else xcd_barrier(bar); }
    }
}
}

extern "C" void kernel_launch(void* const* d_in, const int* in_sizes, int n_in, void* d_out, int out_size, void* d_ws, size_t ws_size, hipStream_t stream) {
    using namespace nv;
    static int grid = 0;
    if (grid == 0) {
        if (n_in != 24 || in_sizes[0] != T * D || out_size != T * D || ws_size < mk::WS_END) { fprintf(stderr, "kernel_launch: built for 24 inputs, x/out of %d floats, >= %zu bytes of workspace; got n_in %d, out %d, ws %zu; nothing launched\n", T * D, (size_t)mk::WS_END, n_in, out_size, ws_size); grid = -1; return; }
        int dev = 0, cus = 0, per_cu = 0;
        if (hipGetDevice(&dev) != hipSuccess || hipDeviceGetAttribute(&cus, hipDeviceAttributeMultiprocessorCount, dev) != hipSuccess) { fprintf(stderr, "kernel_launch: device query failed; nothing launched\n"); grid = -1; return; }
        if (hipFuncSetAttribute((const void*)mk::skel_fwd, hipFuncAttributeMaxDynamicSharedMemorySize, mk::LDS_BYTES) != hipSuccess) { fprintf(stderr, "kernel_launch: hipFuncSetAttribute failed (needs %d bytes of dynamic LDS)\n", mk::LDS_BYTES); grid = -1; return; }
        if (hipOccupancyMaxActiveBlocksPerMultiprocessor(&per_cu, (const void*)mk::skel_fwd, mk::NWAVES * 64, mk::LDS_BYTES) != hipSuccess || per_cu < 1) fprintf(stderr, "kernel_launch: note: occupancy query reports %d workgroups per CU\n", per_cu);
        (void)hipGetLastError();
        grid = cus;
        if (grid != 256) fprintf(stderr, "kernel_launch: the unit schedules are built for 256 CUs; this device reports %d\n", cus);
    }
    if (grid < 0) return;
    if (hipMemsetAsync((unsigned char*)d_ws + mk::WS_CTL, 0, mk::CTL_ZERO_BYTES, stream) != hipSuccess) { fprintf(stderr, "kernel_launch: memset of the control words failed; nothing launched\n"); return; }
    mk::Args a{};
    for (int i = 0; i < 24; ++i) a.in[i] = (const float*)d_in[i];
    a.out = (float*)d_out; a.ws = (unsigned char*)d_ws; a.ph_lo = 0; a.ph_hi = mk::N_PHASES; a.li = 0;
    a.pad = (MK_DUP << 8) | (MK_DSEL << 16);
    hipLaunchKernelGGL(mk::skel_fwd, dim3(grid), dim3(mk::NWAVES * 64), mk::LDS_BYTES, stream, a);
}
```

```cpp
#include <hip/hip_runtime.h>
#include <cstdio>
#include <cstdint>
#include <cmath>
#define MK_EDUP 0

namespace nv {
typedef unsigned short bf16;
constexpr int D = 1024, B = 8, S = 2048, T = B * S, L = 4;
constexpr int HA = 8, KVA = 2, HB = 4, HD = 64;
constexpr int INW = 2304, GW = 2048, ZG = INW + GW;
constexpr int FF = 2816, FF2 = 2 * FF;
constexpr int C_QA = 0, C_KA = 512, C_VA = 640, C_QB = 768, C_KB = 1280, C_VB = 1792, C_G = 2304;
constexpr float EPS = 1e-6f;
constexpr float LOG2E = 1.4426950408889634f;
constexpr float C2 = 0.125f * LOG2E;

__device__ __forceinline__ float bf2f(bf16 v) { return __uint_as_float(((unsigned)v) << 16); }
__device__ __forceinline__ bf16 f2bf(float f) { unsigned u = __float_as_uint(f); return (bf16)((u + 0x7fffu + ((u >> 16) & 1u)) >> 16); }
__device__ __forceinline__ float ldf(const float* p) { return *p; }
__device__ __forceinline__ float ldf(const bf16* p) { return bf2f(*p); }

__device__ __forceinline__ int t5_bucket(int rel) {
    const int n = rel < 0 ? -rel : rel; int v;
    if (n < 8) v = n; else if (n < 12) v = 8; else if (n < 16) v = 9; else if (n < 23) v = 10; else if (n < 32) v = 11;
    else if (n < 46) v = 12; else if (n < 64) v = 13; else if (n < 91) v = 14; else v = 15;
    return (rel > 0 ? 16 : 0) + v;
}
__device__ __forceinline__ float ss16(const float* ss, int t) { const float4* p = (const float4*)(ss + (size_t)t * 16); const float4 a = p[0], b = p[1], c = p[2], d = p[3];
    return ((a.x + a.y) + (a.z + a.w)) + ((b.x + b.y) + (b.z + b.w)) + ((c.x + c.y) + (c.z + c.w)) + ((d.x + d.y) + (d.z + d.w)); }
__device__ __forceinline__ float ss16_q(const float* ss, int t, int fq) { const float4 a = *(const float4*)(ss + (size_t)t * 16 + 4 * fq); float s = (a.x + a.y) + (a.z + a.w); s += __shfl_xor(s, 16); s += __shfl_xor(s, 32); return s; }
__device__ __forceinline__ void ss16_store(float* ss, int t, float s, int lane) { if (lane < 16) ss[(size_t)t * 16 + lane] = lane == 0 ? s : 0.f; }
__device__ __forceinline__ float wave_sum(float v) {
#pragma unroll
    for (int o = 1; o < 64; o <<= 1) v += __shfl_xor(v, o);
    return v;
}
__device__ __forceinline__ float wave_max(float v) {
#pragma unroll
    for (int o = 1; o < 64; o <<= 1) v = fmaxf(v, __shfl_xor(v, o));
    return v;
}

}


namespace pg8 {
using namespace nv;
#define PG8_LAS __attribute__((address_space(3)))
typedef unsigned short bf16_t;
typedef short bf16x8 __attribute__((ext_vector_type(8)));
typedef float f32x4 __attribute__((ext_vector_type(4)));
typedef unsigned u32x4 __attribute__((ext_vector_type(4)));
typedef unsigned u32x2 __attribute__((ext_vector_type(2)));
constexpr int BM = 256, BK = 64, HALF = 128, HTB = HALF * BK * 2  , STAGE_BYTES = 8 * HTB, NXCD = 8, WGM = 8;
constexpr int XOFF = 131072 + 1024;
constexpr int RTAB_OFF = XOFF + 8192;

__host__ __device__ __forceinline__ int lds_byte(int r, int c) { const int st = (r >> 4) * 2 + (c >> 5), rr = r & 15, cc = c & 31, ob = rr * 64 + cc * 2; return st * 1024 + (ob ^ (((ob >> 9) & 1) << 5)); }
__host__ __device__ __forceinline__ void stage_rc(int b, int& R, int& C) { const int st = b / 1024, sb = b % 1024, swz = sb ^ (((sb >> 9) & 1) << 5); R = (st >> 1) * 16 + swz / 64; C = (st & 1) * 32 + (swz % 64) / 2; }
__host__ __device__ __forceinline__ int perm32(int rho) { const int n = rho >> 4, i = rho & 15; return 8 * (i >> 2) + 4 * n + (i & 3); }

struct Unit { int pm, pn, z; };
typedef float f32x2 __attribute__((ext_vector_type(2))); typedef __bf16 bf16x2_t __attribute__((ext_vector_type(2)));
__device__ __forceinline__ unsigned cvt_pk_bf16(float lo, float hi) { f32x2 v = {lo, hi}; bf16x2_t b = __builtin_convertvector(v, bf16x2_t); return __builtin_bit_cast(unsigned, b); }
__device__ __forceinline__ float bflo(unsigned w) { return __uint_as_float(w << 16); }
__device__ __forceinline__ float bfhi(unsigned w) { return __uint_as_float(w & 0xffff0000u); }

struct SchedStd {
    int nM, nN, nwg, G, c, fix, one, opm, opn; const char* A; const char* Bt; size_t at, bt;
    __device__ void init(const void* A_, int lda, const void* Bt_, int K, int M, int N, int G_, int c_) { fix = 0; one = 0; opm = 0; opn = 0; nM = M / BM; nN = N / BM; nwg = nM * nN; G = G_; c = c_; A = (const char*)A_; Bt = (const char*)Bt_; at = (size_t)BM * lda * 2; bt = (size_t)BM * K * 2; }
    __device__ bool next(int i, Unit& u) const {
        if (one) { if (i > 0) return false; u.pm = opm; u.pn = opn; u.z = 0; return true; }
        const long L = (long)i * G + c; if (L >= nwg) return false;
        int wgid = (int)L; { const int q = nwg / NXCD, r = nwg % NXCD, xcd = wgid % NXCD, off = wgid / NXCD; wgid = (xcd < r ? xcd * (q + 1) : r * (q + 1) + (xcd - r) * q) + off; }
        const int nig = WGM * nN, gid = wgid / nig, fm = gid * WGM, gsz = (nM - fm) < WGM ? (nM - fm) : WGM;
        u.pm = fm + ((wgid % nig) % gsz); u.pn = (wgid % nig) / gsz; u.z = 0; if (fix) { u.pm = 0; u.pn = 0; } return true;
    }
    __device__ __forceinline__ const char* aptr(const Unit& u) const { return A + (size_t)u.pm * at; }
    __device__ __forceinline__ const char* bptr(const Unit& u) const { return Bt + (size_t)u.pn * bt; }
    __device__ __forceinline__ void a_ready(const Unit&) const {}
    __device__ __forceinline__ void done(const Unit&) const {}
};
struct SchedMix {
    SchedStd b; const char* A1; const char* Bt1;
    __device__ bool next(int i, Unit& u) const { if (!b.next(i >> 1, u)) return false; u.z = i & 1; return true; }
    __device__ __forceinline__ const char* aptr(const Unit& u) const { return (u.z ? A1 : b.A) + (size_t)u.pm * b.at; }
    __device__ __forceinline__ const char* bptr(const Unit& u) const { return (u.z ? Bt1 : b.Bt) + (size_t)u.pn * b.bt; }
    __device__ __forceinline__ void a_ready(const Unit&) const {}
    __device__ __forceinline__ void done(const Unit&) const {}
};
struct SchedDown {
    SchedStd b; const float* yb; const float* cw; const float* cb; bf16_t* a;
    __device__ bool next(int i, Unit& u) const { return b.next(i, u); }
    __device__ __forceinline__ const char* aptr(const Unit& u) const { return b.aptr(u); }
    __device__ __forceinline__ const char* bptr(const Unit& u) const { return b.bptr(u); }
    __device__ __forceinline__ void a_ready(const Unit& u) const {
        const int pm = u.pm;
        if (yb) {
            int t0 = threadIdx.x; asm volatile("" : "+v"(t0));
            const bool hasp = (pm & 7) != 0, hasn = (pm & 7) != 7;
#pragma unroll 1
            for (int g = 0; g < 3; ++g) {
                float yv[4][2][3], cv[4][2][4];
#pragma unroll
                for (int q = 0; q < 4; ++q) {
                    const int it = 4 * g + q;
                    if (it < 11) {
                        const int idx = t0 + 512 * it, which = idx >= FF ? 1 : 0, j = idx - which * FF;
#pragma unroll
                        for (int gs = 0; gs < 2; ++gs) {
                            const int col = gs * FF + j;
                            const float* r0 = yb + ((size_t)pm * 4 + (which ? 2 : -1)) * FF2 + col;
                            const bool v0 = which ? true : hasp, v2 = which ? hasn : true;
                            yv[q][gs][0] = v0 ? r0[0] : 0.f; yv[q][gs][1] = r0[FF2]; yv[q][gs][2] = v2 ? r0[2 * (size_t)FF2] : 0.f;
                            cv[q][gs][0] = cb[col]; cv[q][gs][1] = cw[col]; cv[q][gs][2] = cw[FF2 + col]; cv[q][gs][3] = cw[2 * FF2 + col];
                        }
                    }
                }
#pragma unroll
                for (int q = 0; q < 4; ++q) {
                    const int it = 4 * g + q;
                    if (it < 11) {
                        const int idx = t0 + 512 * it, which = idx >= FF ? 1 : 0, j = idx - which * FF;
                        float uv[2];
#pragma unroll
                        for (int gs = 0; gs < 2; ++gs) uv[gs] = cv[q][gs][0] + cv[q][gs][1] * yv[q][gs][0] + cv[q][gs][2] * yv[q][gs][1] + cv[q][gs][3] * yv[q][gs][2];
                        const float sg = uv[1] * __builtin_amdgcn_rcpf(1.0f + __builtin_amdgcn_exp2f(-uv[1] * LOG2E));
                        a[(size_t)(pm * BM + which * 255) * FF + j] = f2bf(sg * uv[0]);
                    }
                }
            }
        }
        asm volatile("s_waitcnt vmcnt(0)" ::: "memory");
        __builtin_amdgcn_s_barrier();
        asm volatile("" ::: "memory");
    }
    __device__ __forceinline__ void done(const Unit&) const {}
};

__device__ __forceinline__ void rtab_fill(PG8_LAS unsigned char* lds_, const float* __restrict__ ssx, int row0) {
    int t = threadIdx.x; asm volatile("" : "+v"(t));
    PG8_LAS float* rt = (PG8_LAS float*)(lds_ + RTAB_OFF);
    float v[4];
#pragma unroll
    for (int k = 0; k < 4; ++k) v[k] = ss16(ssx, row0 + t + 512 * k);
#pragma unroll
    for (int k = 0; k < 4; ++k) rt[t + 512 * k] = rsqrtf(v[k] * (1.0f / D) + EPS);
}
struct EpiIn {
    static constexpr bool PERM = true, AFTER_DRAIN = false;
    __device__ __forceinline__ void init(f32x4 (&acc)[2][2][4][2], const Unit&, int, int, int, int) const {
#pragma unroll
        for (int a = 0; a < 2; ++a)
#pragma unroll
            for (int b = 0; b < 2; ++b)
#pragma unroll
                for (int m = 0; m < 4; ++m)
#pragma unroll
                    for (int n = 0; n < 2; ++n) acc[a][b][m][n] = (f32x4){0.f, 0.f, 0.f, 0.f};
    }
    __device__ static constexpr bool zero_after(const Unit&) { return true; }
    bf16_t* zg; const float* ss; const float *qn_a, *kn_a, *qn_b, *kn_b, *bg; int dup, row0;
    __device__ __forceinline__ void prefill(PG8_LAS unsigned char* lds_) const { rtab_fill(lds_, ss, row0); }
    __device__ __forceinline__ void operator()(f32x4 (&acc)[2][2][4][2], const Unit& u, int wr, int wc, int fr, int fq, PG8_LAS unsigned char* lds_) const {
#pragma unroll
        for (int rep_ = 0; rep_ <= ((MK_EDUP & 2) ? 1 : 0); ++rep_) {
        if (rep_) {
#pragma unroll
            for (int ai = 0; ai < 2; ++ai)
#pragma unroll
                for (int bj = 0; bj < 2; ++bj)
#pragma unroll
                    for (int m = 0; m < 4; ++m)
#pragma unroll
                        for (int n = 0; n < 2; ++n) asm volatile("" : "+v"(acc[ai][bj][m][n]) :: "memory");
        }
        const int g = u.pn * 4 + wc, colb = u.pn * BM + wc * 64 + 8 * fq;
        const float* gain = nullptr; float sc = 1.f; int mode = 0;
        if (g < 8) { gain = qn_a; sc = C2; mode = 1; } else if (g < 10) { gain = kn_a; mode = 1; } else if (g < 12) { mode = 0; } else if (g < 20) { gain = qn_b; sc = C2; mode = 1; }
        else if (g < 28) { gain = kn_b; mode = 1; } else if (g < 36) { mode = 0; } else { mode = 2; }
        float rsv[2][4];
#pragma unroll
        for (int ai = 0; ai < 2; ++ai)
#pragma unroll
            for (int m = 0; m < 4; ++m) rsv[ai][m] = ((const PG8_LAS float*)(lds_ + RTAB_OFF))[(u.pm & 7) * BM + ai * HALF + wr * 64 + m * 16 + fr];
        f32x4 gv[2][2];
#pragma unroll
        for (int bj = 0; bj < 2; ++bj)
#pragma unroll
            for (int n = 0; n < 2; ++n) {
                if (mode == 1) gv[bj][n] = *(const f32x4*)(gain + 32 * bj + 8 * fq + 4 * n) * sc;
                else if (mode == 2) gv[bj][n] = *(const f32x4*)(bg + bj * D + (u.pn - 9) * 128 + wc * 32 + 8 * fq + 4 * n);
                else gv[bj][n] = (f32x4){1.f, 1.f, 1.f, 1.f};
            }
#pragma unroll
        for (int ai = 0; ai < 2; ++ai)
#pragma unroll
            for (int m = 0; m < 4; ++m) {
                const int row = u.pm * BM + ai * HALF + wr * 64 + m * 16 + fr;
                const float rs = rsv[ai][m];
                f32x4 v[2][2];
#pragma unroll
                for (int bj = 0; bj < 2; ++bj)
#pragma unroll
                    for (int n = 0; n < 2; ++n) v[bj][n] = acc[ai][bj][m][n] * rs;
                if (mode == 1) {
                    float q = 0.f;
#pragma unroll
                    for (int bj = 0; bj < 2; ++bj)
#pragma unroll
                        for (int n = 0; n < 2; ++n) { const f32x4 x = v[bj][n]; q += (x[0] * x[0] + x[1] * x[1]) + (x[2] * x[2] + x[3] * x[3]); }
                    q += __shfl_xor(q, 16); q += __shfl_xor(q, 32);
                    const float r2 = rsqrtf(q * (1.0f / 64.0f) + EPS);
#pragma unroll
                    for (int bj = 0; bj < 2; ++bj)
#pragma unroll
                        for (int n = 0; n < 2; ++n) v[bj][n] = v[bj][n] * r2 * gv[bj][n];
                } else if (mode == 2) {
#pragma unroll
                    for (int n = 0; n < 2; ++n) { const f32x4 xa = v[0][n] + gv[0][n], xb_ = v[1][n] + gv[1][n]; f32x4 rr, gb;
#pragma unroll
                        for (int e = 0; e < 4; ++e) { const float sa = 1.0f + __builtin_amdgcn_exp2f(-xa[e] * LOG2E), sb = 1.0f + __builtin_amdgcn_exp2f(-xb_[e] * LOG2E);
                            const float ga = __builtin_fmaxf(__builtin_amdgcn_rcpf(sa), 9.5367431640625e-07f);
                            gb[e] = __builtin_fmaxf(__builtin_amdgcn_rcpf(sb), 9.5367431640625e-07f); rr[e] = ga * __builtin_fminf(sb, 1048576.0f); }
                        v[0][n] = rr; v[1][n] = gb; }
                }
                bf16_t* rowp = zg + (size_t)row * ZG + colb;
                if (mode == 2) {
                    bf16_t* gp = zg + (size_t)row * ZG + C_G + (u.pn - 9) * 128 + wc * 32 + 8 * fq;
#pragma unroll
                    for (int bj = 0; bj < 2; ++bj) { u32x4 w; w.x = cvt_pk_bf16(v[bj][0][0], v[bj][0][1]); w.y = cvt_pk_bf16(v[bj][0][2], v[bj][0][3]); w.z = cvt_pk_bf16(v[bj][1][0], v[bj][1][1]); w.w = cvt_pk_bf16(v[bj][1][2], v[bj][1][3]);
                        *(u32x4*)(gp + bj * D) = w; }
                } else
#pragma unroll
                for (int bj = 0; bj < 2; ++bj) { u32x4 w; w.x = cvt_pk_bf16(v[bj][0][0], v[bj][0][1]); w.y = cvt_pk_bf16(v[bj][0][2], v[bj][0][3]); w.z = cvt_pk_bf16(v[bj][1][0], v[bj][1][1]); w.w = cvt_pk_bf16(v[bj][1][2], v[bj][1][3]);
                    *(u32x4*)(rowp + 32 * bj) = w; }
            }
        }
    }
};
struct EpiMix {
    static constexpr bool PERM = true, AFTER_DRAIN = false;
    __device__ __forceinline__ void prefill(PG8_LAS unsigned char*) const {}
    __device__ __forceinline__ void init(f32x4 (&acc)[2][2][4][2], const Unit&, int, int, int, int) const {
#pragma unroll
        for (int a = 0; a < 2; ++a)
#pragma unroll
            for (int b = 0; b < 2; ++b)
#pragma unroll
                for (int m = 0; m < 4; ++m)
#pragma unroll
                    for (int n = 0; n < 2; ++n) acc[a][b][m][n] = (f32x4){0.f, 0.f, 0.f, 0.f};
    }
    __device__ static bool zero_after(const Unit& u) { return u.z != 0; }
    const bf16_t* zg; bf16_t* mix;
    __device__ __forceinline__ void operator()(f32x4 (&acc)[2][2][4][2], const Unit& u, int wr, int wc, int fr, int fq, PG8_LAS unsigned char*) const {
        const int col0 = u.pn * BM + wc * 32 + 8 * fq;
        u32x4 gbv[2][4][2];
#pragma unroll
        for (int ai = 0; ai < 2; ++ai)
#pragma unroll
            for (int m = 0; m < 4; ++m)
#pragma unroll
                for (int bj = 0; bj < 2; ++bj) { const size_t go = (size_t)(u.pm * BM + ai * HALF + wr * 64 + m * 16 + fr) * ZG + C_G + col0 + bj * HALF;
                    gbv[ai][m][bj] = *(const u32x4*)(zg + go + (u.z ? D : 0)); }
#pragma unroll
        for (int ai = 0; ai < 2; ++ai) {
#pragma unroll
            for (int m = 0; m < 4; ++m) {
                const int row = u.pm * BM + ai * HALF + wr * 64 + m * 16 + fr;
#pragma unroll
                for (int bj = 0; bj < 2; ++bj) {
                    const int col = col0 + bj * HALF;
                    const u32x4 gb = gbv[ai][m][bj];
                    if (u.z == 0) {
                        acc[ai][bj][m][0] *= (f32x4){bflo(gb.x), bfhi(gb.x), bflo(gb.y), bfhi(gb.y)}; acc[ai][bj][m][1] *= (f32x4){bflo(gb.z), bfhi(gb.z), bflo(gb.w), bfhi(gb.w)};
                    } else {
                        const f32x4 v0 = acc[ai][bj][m][0] * (f32x4){bflo(gb.x), bfhi(gb.x), bflo(gb.y), bfhi(gb.y)}, v1 = acc[ai][bj][m][1] * (f32x4){bflo(gb.z), bfhi(gb.z), bflo(gb.w), bfhi(gb.w)};
                        u32x4 w; w.x = cvt_pk_bf16(v0[0], v0[1]); w.y = cvt_pk_bf16(v0[2], v0[3]); w.z = cvt_pk_bf16(v1[0], v1[1]); w.w = cvt_pk_bf16(v1[2], v1[3]);
                        *(u32x4*)(mix + (size_t)row * D + col) = w;
                    }
                }
            }
        }
    }
};
struct EpiRes {
    static constexpr bool PERM = false, AFTER_DRAIN = false;
    __device__ __forceinline__ void prefill(PG8_LAS unsigned char*) const {}
    __device__ static constexpr bool zero_after(const Unit&) { return true; }
    const float* base; float* xf; bf16_t* xb; float* ssn;
    __device__ __forceinline__ void init(f32x4 (&acc)[2][2][4][2], const Unit& u, int wr, int wc, int fr, int fq) const {
        const int col0 = u.pn * BM + wc * 32 + 4 * fq;
#pragma unroll
        for (int ai = 0; ai < 2; ++ai)
#pragma unroll
            for (int m = 0; m < 4; ++m) { const size_t off = (size_t)(u.pm * BM + ai * HALF + wr * 64 + m * 16 + fr) * D + col0;
#pragma unroll
                for (int bj = 0; bj < 2; ++bj)
#pragma unroll
                    for (int n = 0; n < 2; ++n) acc[ai][bj][m][n] = *(const f32x4*)(base + off + bj * HALF + n * 16); }
    }
    __device__ __forceinline__ void operator()(f32x4 (&acc)[2][2][4][2], const Unit& u, int wr, int wc, int fr, int fq, PG8_LAS unsigned char*) const {
        const int col0 = u.pn * BM + wc * 32 + 4 * fq;
#pragma unroll
        for (int ai = 0; ai < 2; ++ai)
#pragma unroll
            for (int m = 0; m < 4; ++m) {
                const int row = u.pm * BM + ai * HALF + wr * 64 + m * 16 + fr; const size_t off = (size_t)row * D + col0; float q = 0.f;
#pragma unroll
                for (int bj = 0; bj < 2; ++bj)
#pragma unroll
                    for (int n = 0; n < 2; ++n) { const f32x4 o = acc[ai][bj][m][n];
                        *(f32x4*)(xf + off + bj * HALF + n * 16) = o; q += (o[0] * o[0] + o[1] * o[1]) + (o[2] * o[2] + o[3] * o[3]);
                        if (xb) { u32x2 w; w.x = cvt_pk_bf16(o[0], o[1]); w.y = cvt_pk_bf16(o[2], o[3]); *(u32x2*)(xb + off + bj * HALF + n * 16) = w; } }
                if (ssn) { q += __shfl_xor(q, 16); q += __shfl_xor(q, 32); if (fq == 0) ssn[(size_t)row * 16 + u.pn * 4 + wc] = q; }
            }
    }
};
#define DPPF(oldv, src, ctrl, bc) __int_as_float(__builtin_amdgcn_update_dpp(__float_as_int(oldv), __float_as_int(src), (ctrl), 0xF, 0xF, (bc)))
struct EpiUp {
    static constexpr bool PERM = true, AFTER_DRAIN = false;
    __device__ __forceinline__ void init(f32x4 (&acc)[2][2][4][2], const Unit&, int, int, int, int) const {
#pragma unroll
        for (int a = 0; a < 2; ++a)
#pragma unroll
            for (int b = 0; b < 2; ++b)
#pragma unroll
                for (int m = 0; m < 4; ++m)
#pragma unroll
                    for (int n = 0; n < 2; ++n) acc[a][b][m][n] = (f32x4){0.f, 0.f, 0.f, 0.f};
    }
    __device__ static constexpr bool zero_after(const Unit&) { return true; }
    bf16_t* a; const float* ss; const float* cw; const float* cb; float* yb; int dup, row0;
    __device__ __forceinline__ void prefill(PG8_LAS unsigned char* lds_) const { rtab_fill(lds_, ss, row0); }
    __device__ __forceinline__ void operator()(f32x4 (&acc)[2][2][4][2], const Unit& u, int wr, int wc, int fr, int fq, PG8_LAS unsigned char* lds) const {
        PG8_LAS unsigned char* lds_ = lds; const int wid = wr * 4 + wc;
        PG8_LAS float* X = (PG8_LAS float*)(lds + XOFF);
        float rsv[2][4];
#pragma unroll
        for (int ai = 0; ai < 2; ++ai)
#pragma unroll
            for (int m = 0; m < 4; ++m) rsv[ai][m] = ((const PG8_LAS float*)(lds_ + RTAB_OFF))[(u.pm & 7) * BM + ai * HALF + wr * 64 + m * 16 + fr];
#pragma unroll
        for (int ai = 0; ai < 2; ++ai)
#pragma unroll
            for (int m = 0; m < 4; ++m) {
#pragma unroll
                for (int bj = 0; bj < 2; ++bj)
#pragma unroll
                    for (int n = 0; n < 2; ++n) acc[ai][bj][m][n] *= rsv[ai][m];
            }
#pragma unroll
        for (int ai = 0; ai < 2; ++ai) {
            if (fr == 0) {
#pragma unroll
                for (int bj = 0; bj < 2; ++bj)
#pragma unroll
                    for (int n = 0; n < 2; ++n) *(PG8_LAS f32x4*)(X + ((wid * 2 + ai) * 2 + 0) * 64 + 32 * bj + 8 * fq + 4 * n) = acc[ai][bj][0][n];
            }
            if (fr == 15) {
#pragma unroll
                for (int bj = 0; bj < 2; ++bj)
#pragma unroll
                    for (int n = 0; n < 2; ++n) *(PG8_LAS f32x4*)(X + ((wid * 2 + ai) * 2 + 1) * 64 + 32 * bj + 8 * fq + 4 * n) = acc[ai][bj][3][n];
            }
        }
        {
            const int ccol = u.pn * 128 + wc * 32 + 8 * fq;
            if (wr == 0 && fr < 2) {
#pragma unroll
                for (int bj = 0; bj < 2; ++bj)
#pragma unroll
                    for (int n = 0; n < 2; ++n) *(f32x4*)(yb + ((size_t)u.pm * 4 + fr) * FF2 + bj * FF + ccol + 4 * n) = acc[0][bj][0][n];
            }
            if (wr == 1 && fr >= 14) {
#pragma unroll
                for (int bj = 0; bj < 2; ++bj)
#pragma unroll
                    for (int n = 0; n < 2; ++n) *(f32x4*)(yb + ((size_t)u.pm * 4 + 2 + (fr - 14)) * FF2 + bj * FF + ccol + 4 * n) = acc[1][bj][3][n];
            }
        }
        asm volatile("s_waitcnt lgkmcnt(0)" ::: "memory"); __builtin_amdgcn_s_barrier(); asm volatile("" ::: "memory");
#pragma unroll
        for (int rep_ = 0; rep_ <= ((MK_EDUP & 1) ? 1 : 0); ++rep_) {
        if (rep_) {
#pragma unroll
            for (int ai = 0; ai < 2; ++ai)
#pragma unroll
                for (int bj = 0; bj < 2; ++bj)
#pragma unroll
                    for (int m = 0; m < 4; ++m)
#pragma unroll
                        for (int n = 0; n < 2; ++n) asm volatile("" : "+v"(acc[ai][bj][m][n]) :: "memory");
        }
#pragma unroll
        for (int n = 0; n < 2; ++n) {
            const int ccol = u.pn * 128 + wc * 32 + 8 * fq + 4 * n;
            f32x4 w0[2], w1[2], w2[2], bb[2];
#pragma unroll
            for (int bj = 0; bj < 2; ++bj) { w0[bj] = *(const f32x4*)(cw + bj * FF + ccol); w1[bj] = *(const f32x4*)(cw + FF2 + bj * FF + ccol); w2[bj] = *(const f32x4*)(cw + 2 * FF2 + bj * FF + ccol); bb[bj] = *(const f32x4*)(cb + bj * FF + ccol); }
#pragma unroll
            for (int ai = 0; ai < 2; ++ai) {
                const int pw = wr ? wid - 4 : wid + 4, pai = wr ? ai : 0;
                const int nw = wr ? wid - 4 : wid + 4, nai = wr ? 1 : ai;
                f32x4 xp[2], xn[2];
#pragma unroll
                for (int bj = 0; bj < 2; ++bj) { xp[bj] = *(PG8_LAS f32x4*)(X + ((pw * 2 + pai) * 2 + 1) * 64 + 32 * bj + 8 * fq + 4 * n); xn[bj] = *(PG8_LAS f32x4*)(X + ((nw * 2 + nai) * 2 + 0) * 64 + 32 * bj + 8 * fq + 4 * n); }
#pragma unroll
                for (int m = 0; m < 4; ++m) {
                    const int trow = ai * HALF + wr * 64 + m * 16 + fr;
                    float uv[2][4];
#pragma unroll
                    for (int bj = 0; bj < 2; ++bj)
#pragma unroll
                        for (int e = 0; e < 4; ++e) {
                            const float cur = acc[ai][bj][m][n][e];
                            float rp, rn;
                            if (m > 0) rp = DPPF(0.f, acc[ai][bj][m > 0 ? m - 1 : 0][n][e], 0x121, true); else rp = xp[bj][e];
                            if (m < 3) rn = DPPF(0.f, acc[ai][bj][m < 3 ? m + 1 : 3][n][e], 0x12F, true); else rn = xn[bj][e];
                            const float prev = DPPF(rp, cur, 0x111, false), next = DPPF(rn, cur, 0x101, false);
                            uv[bj][e] = bb[bj][e] + w0[bj][e] * prev + w1[bj][e] * cur + w2[bj][e] * next;
                        }
                    f32x4 o;
#pragma unroll
                    for (int e = 0; e < 4; ++e) o[e] = uv[0][e] * uv[1][e] * __builtin_amdgcn_rcpf(1.0f + __builtin_amdgcn_exp2f(-uv[1][e] * LOG2E));
                    u32x2 w; w.x = cvt_pk_bf16(o[0], o[1]); w.y = cvt_pk_bf16(o[2], o[3]);
                    if (trow != 0 && trow != 255) *(u32x2*)(a + (size_t)(u.pm * BM + trow) * FF + ccol) = w;
                    asm volatile("" ::: "memory");
                }
            }
        }
        }
    }
};

template <class Epi, class Sched, bool ALIGN_EPI = false, bool SP2 = false>
__device__ __forceinline__ void gemm_phase(PG8_LAS unsigned char* lds, const int K, const int lda, const Sched& S, const Epi& E) {
    int tid_ = threadIdx.x; asm volatile("" : "+v"(tid_));
    const int tid = tid_, wid = __builtin_amdgcn_readfirstlane(tid >> 6), lane = tid & 63, wr = wid >> 2, wc = wid & 3, fr = lane & 15, fq = lane >> 4;
    const int nt = K / BK;
    unsigned voffA[2], voffB[2];
#pragma unroll
    for (int i = 0; i < 2; ++i) { int R, C; stage_rc(tid * 16 + i * 8192, R, C); const int Rb = Epi::PERM ? ((R & ~31) + perm32(R & 31)) : R;
        voffA[i] = (unsigned)(R * lda + C) * 2u; voffB[i] = (unsigned)(Rb * K + C) * 2u; }
    const size_t kstep = (size_t)(BK * 2);
    const size_t hstepB = (size_t)HALF * K * 2;
    const size_t hstepA = (size_t)HALF * lda * 2;
    const unsigned ldsw = (unsigned)wid * 1024u;
    const int aoff = lds_byte(wr * 64 + fr, fq * 8), boff = lds_byte(wc * 32 + fr, fq * 8);
#define PG8_SA(b, h) (((b) * 2 + (h)) * HTB)
#define PG8_SB(b, h) ((4 + (b) * 2 + (h)) * HTB)
#define PG8_STAGE(bufoff, gbase, voff) do { _Pragma("unroll") for (int _i = 0; _i < 2; ++_i) \
        __builtin_amdgcn_global_load_lds((const unsigned*)((const char*)(gbase) + (voff)[_i]), (PG8_LAS unsigned*)(lds + (bufoff) + ldsw + _i * 8192), 16, 0, 0); } while (0)
#define PG8_LDA(dst, b, h) do { _Pragma("unroll") for (int m = 0; m < 4; ++m) _Pragma("unroll") for (int k = 0; k < 2; ++k) dst[m][k] = *(const PG8_LAS bf16x8*)(lds + PG8_SA(b, h) + aoff + m * 2048 + k * 1024); } while (0)
#define PG8_LDB(dst, b, h) do { _Pragma("unroll") for (int n = 0; n < 2; ++n) _Pragma("unroll") for (int k = 0; k < 2; ++k) dst[n][k] = *(const PG8_LAS bf16x8*)(lds + PG8_SB(b, h) + boff + n * 2048 + k * 1024); } while (0)
#define PG8_MMA(ai, bj, At, Bt) do { __builtin_amdgcn_s_setprio(1); _Pragma("unroll") for (int m = 0; m < 4; ++m) _Pragma("unroll") for (int n = 0; n < 2; ++n) _Pragma("unroll") for (int k = 0; k < 2; ++k) \
        acc[ai][bj][m][n] = __builtin_amdgcn_mfma_f32_16x16x32_bf16(Bt[n][k], At[m][k], acc[ai][bj][m][n], 0, 0, 0); __builtin_amdgcn_s_setprio(0); } while (0)
#define PG8_WAIT_V(n) asm volatile("s_waitcnt vmcnt(" #n ")" ::: "memory")
#define PG8_WAIT_L(n) asm volatile("s_waitcnt lgkmcnt(" #n ")" ::: "memory")
#define PG8_BAR __builtin_amdgcn_s_barrier()
#define PG8_SCHED __builtin_amdgcn_sched_barrier(0)
    Unit cur, nxt; int ui = 0;
    if (!S.next(0, cur)) return;
    f32x4 acc[2][2][4][2];
    E.init(acc, cur, wr, wc, fr, fq);
    bf16x8 At[4][2], B0[2][2], B1[2][2];
    const char* cA = S.aptr(cur); const char* cB = S.bptr(cur);
    S.a_ready(cur);
    if constexpr (SP2) {
        PG8_STAGE(PG8_SB(0, 0), cB, voffB); PG8_STAGE(PG8_SB(0, 1), cB + hstepB, voffB); PG8_STAGE(PG8_SA(0, 0), cA, voffA); PG8_STAGE(PG8_SA(0, 1), cA + hstepA, voffA);
        E.prefill(lds);
        if (wr == 1) PG8_BAR;
        PG8_WAIT_V(2); PG8_BAR;
        PG8_STAGE(PG8_SB(1, 0), cB + kstep, voffB); PG8_STAGE(PG8_SA(1, 0), cA + kstep, voffA); PG8_STAGE(PG8_SB(1, 1), cB + hstepB + kstep, voffB);
        PG8_WAIT_V(6); PG8_BAR;
    } else {
        PG8_STAGE(PG8_SB(0, 0), cB, voffB); PG8_STAGE(PG8_SA(0, 0), cA, voffA); PG8_STAGE(PG8_SB(0, 1), cB + hstepB, voffB); PG8_STAGE(PG8_SA(0, 1), cA + hstepA, voffA);
        E.prefill(lds);
        if (wr == 1) PG8_BAR;
        PG8_WAIT_V(4); PG8_BAR;
        PG8_STAGE(PG8_SB(1, 0), cB + kstep, voffB); PG8_STAGE(PG8_SA(1, 0), cA + kstep, voffA); PG8_STAGE(PG8_SB(1, 1), cB + hstepB + kstep, voffB);
        PG8_WAIT_V(6); PG8_BAR;
    }
    for (;;) {
        const bool has_next = S.next(ui + 1, nxt);
        const char* nA = has_next ? S.aptr(nxt) : cA; const char* nB = has_next ? S.bptr(nxt) : cB;
        for (int t = 0; t < nt; t += 2) {
            const bool last = (t == nt - 2);
            const char* a1 = cA + (size_t)(t + 1) * kstep;
            const char* a2 = last ? nA : cA + (size_t)(t + 2) * kstep; const char* b2 = last ? nB : cB + (size_t)(t + 2) * kstep;
            const char* a3 = a2 + kstep; const char* b3 = b2 + kstep;
            if (last && has_next) S.a_ready(nxt);
            if constexpr (SP2) {
            PG8_LDB(B0, 0, 0); PG8_LDB(B1, 0, 1); PG8_SCHED; PG8_LDA(At, 0, 0); PG8_STAGE(PG8_SA(1, 1), a1 + hstepA, voffA);
            PG8_WAIT_V(8); PG8_WAIT_L(0); PG8_BAR; PG8_MMA(0, 0, At, B0); PG8_MMA(0, 1, At, B1); PG8_BAR; PG8_SCHED;
            PG8_LDA(At, 0, 1); PG8_STAGE(PG8_SB(0, 0), b2, voffB); PG8_STAGE(PG8_SB(0, 1), b2 + hstepB, voffB); PG8_STAGE(PG8_SA(0, 0), a2, voffA);
            PG8_WAIT_V(8); PG8_WAIT_L(0); PG8_BAR; PG8_MMA(1, 0, At, B0); PG8_MMA(1, 1, At, B1); PG8_BAR; PG8_SCHED;
            PG8_LDB(B0, 1, 0); PG8_LDB(B1, 1, 1); PG8_SCHED; PG8_LDA(At, 1, 0); PG8_STAGE(PG8_SA(0, 1), a2 + hstepA, voffA);
            PG8_WAIT_V(8); PG8_WAIT_L(0); PG8_BAR; PG8_MMA(0, 0, At, B0); PG8_MMA(0, 1, At, B1); PG8_BAR; PG8_SCHED;
            PG8_LDA(At, 1, 1); PG8_STAGE(PG8_SB(1, 0), b3, voffB); PG8_STAGE(PG8_SB(1, 1), b3 + hstepB, voffB); PG8_STAGE(PG8_SA(1, 0), a3, voffA);
            PG8_WAIT_V(8); PG8_WAIT_L(0); PG8_BAR; PG8_MMA(1, 0, At, B0); PG8_MMA(1, 1, At, B1); PG8_BAR; PG8_SCHED;
            } else {
            PG8_LDB(B0, 0, 0); PG8_SCHED; PG8_LDA(At, 0, 0); PG8_STAGE(PG8_SA(1, 1), a1 + hstepA, voffA);
            PG8_WAIT_L(8); PG8_BAR; PG8_WAIT_L(0); PG8_MMA(0, 0, At, B0); PG8_BAR; PG8_SCHED;
            PG8_LDB(B1, 0, 1); PG8_STAGE(PG8_SB(0, 0), b2, voffB);
            PG8_BAR; PG8_WAIT_L(0); PG8_MMA(0, 1, At, B1); PG8_BAR;
            PG8_LDA(At, 0, 1); PG8_STAGE(PG8_SA(0, 0), a2, voffA);
            PG8_BAR; PG8_WAIT_L(0); PG8_MMA(1, 0, At, B0); PG8_BAR; PG8_SCHED;
            PG8_STAGE(PG8_SB(0, 1), b2 + hstepB, voffB);
            PG8_WAIT_V(6); PG8_BAR; PG8_MMA(1, 1, At, B1); PG8_BAR;
            PG8_LDB(B0, 1, 0); PG8_SCHED; PG8_LDA(At, 1, 0); PG8_STAGE(PG8_SA(0, 1), a2 + hstepA, voffA);
            PG8_WAIT_L(8); PG8_BAR; PG8_WAIT_L(0); PG8_MMA(0, 0, At, B0); PG8_BAR; PG8_SCHED;
            PG8_LDB(B1, 1, 1); PG8_STAGE(PG8_SB(1, 0), b3, voffB);
            PG8_BAR; PG8_WAIT_L(0); PG8_MMA(0, 1, At, B1); PG8_BAR;
            PG8_LDA(At, 1, 1); PG8_STAGE(PG8_SA(1, 0), a3, voffA);
            PG8_BAR; PG8_WAIT_L(0); PG8_MMA(1, 0, At, B0); PG8_BAR; PG8_SCHED;
            PG8_STAGE(PG8_SB(1, 1), b3 + hstepB, voffB);
            PG8_WAIT_V(6); PG8_BAR; PG8_MMA(1, 1, At, B1); PG8_BAR;
            }
        }
        if constexpr (ALIGN_EPI) { if (wr == 0) PG8_BAR; }
        if constexpr (!Epi::AFTER_DRAIN) { E(acc, cur, wr, wc, fr, fq, lds); S.done(cur); }
        if (!has_next) break;
        if (Epi::zero_after(cur)) E.init(acc, nxt, wr, wc, fr, fq);
        cur = nxt; cA = nA; cB = nB; ++ui;
        if constexpr (ALIGN_EPI) { if (wr == 1) PG8_BAR; }
    }
    PG8_WAIT_V(0);
    if constexpr (!ALIGN_EPI) { if (wr == 0) PG8_BAR; }
    PG8_BAR;
    if constexpr (Epi::AFTER_DRAIN) { E.fused(acc, cur, wr, wc, fr, fq, lds, wid, lane); S.done(cur); }
#undef PG8_SA
#undef PG8_SB
#undef PG8_STAGE
#undef PG8_LDA
#undef PG8_LDB
#undef PG8_MMA
#undef PG8_WAIT_V
#undef PG8_WAIT_L
#undef PG8_BAR
#undef PG8_SCHED
}
}

namespace att {
using namespace nv;
#define ALAS __attribute__((address_space(3)))
typedef short bf16x8 __attribute__((ext_vector_type(8)));
typedef short s16x4 __attribute__((ext_vector_type(4)));
typedef float f32x16 __attribute__((ext_vector_type(16)));
typedef float f32x4 __attribute__((ext_vector_type(4)));
typedef unsigned u32x4 __attribute__((ext_vector_type(4)));
typedef unsigned u32x2 __attribute__((ext_vector_type(2)));
typedef short v4i16_t __attribute__((ext_vector_type(4)));
typedef float f32x2_t __attribute__((ext_vector_type(2))); typedef __bf16 bf16x2_t __attribute__((ext_vector_type(2)));
constexpr int LUT_OFF = 98304, LUT_STRIDE = 520, GT_OFF = LUT_OFF + 12 * LUT_STRIDE * 4;
static_assert(GT_OFF + 512 <= 131072, "attention tables inside the ring region");
constexpr float NEG = -30000.f, THR = 6.f;
__device__ __forceinline__ unsigned cvtpk(float lo, float hi) { f32x2_t v = {lo, hi}; bf16x2_t b = __builtin_convertvector(v, bf16x2_t); return __builtin_bit_cast(unsigned, b); }
__device__ __forceinline__ s16x4 vtr(ALAS const unsigned char* p) { return __builtin_bit_cast(s16x4, __builtin_amdgcn_ds_read_tr16_b64_v4i16((ALAS v4i16_t*)p)); }
__device__ __forceinline__ void glds16(const void* gsrc, unsigned lds_dst) { unsigned keep;
    asm volatile("s_mov_b32 %0, m0\n\ts_mov_b32 m0, %2\n\ts_nop 0\n\tglobal_load_lds_dwordx4 %1, off\n\ts_mov_b32 m0, %0" : "=&s"(keep) : "v"(gsrc), "s"(lds_dst) : "memory"); }
__device__ __forceinline__ float swap_add(float v) { auto rr = __builtin_amdgcn_permlane32_swap(__float_as_uint(v), __float_as_uint(v), false, false); return __uint_as_float(rr[0]) + __uint_as_float(rr[1]); }
__device__ __forceinline__ float swap_max(float v) { auto rr = __builtin_amdgcn_permlane32_swap(__float_as_uint(v), __float_as_uint(v), false, false); return fmaxf(__uint_as_float(rr[0]), __uint_as_float(rr[1])); }
#define MX3(a, b, c) __builtin_fmaxf(__builtin_fmaxf((a), (b)), (c))

__device__ __forceinline__ void attn_tables(ALAS unsigned char* lds, const float* __restrict__ lutg, const float* __restrict__ subg, float osc) {
    int tid = threadIdx.x; asm volatile("" : "+v"(tid));
    ALAS float* lut = (ALAS float*)(lds + LUT_OFF); ALAS float* gt = (ALAS float*)(lds + GT_OFF);
    {
        typedef float lf4 __attribute__((ext_vector_type(4)));
        static_assert((12 * LUT_STRIDE) % 4 == 0 && 12 * LUT_STRIDE / 4 <= 4 * 512, "lut copy");
        const lf4* src = (const lf4*)lutg; lf4 v[4];
#pragma unroll
        for (int k = 0; k < 4; ++k) { const int i = tid + 512 * k; if (i < 12 * LUT_STRIDE / 4) v[k] = src[i]; }
#pragma unroll
        for (int k = 0; k < 4; ++k) { const int i = tid + 512 * k; if (i < 12 * LUT_STRIDE / 4) ((ALAS lf4*)lut)[i] = v[k]; }
    }
    if (tid < 128) gt[tid] = subg[tid] * osc;
    __syncthreads();
}
__device__ __forceinline__ float g4_max(float v) { v = fmaxf(v, __shfl_xor(v, 16)); return fmaxf(v, __shfl_xor(v, 32)); }
__device__ __forceinline__ float g4_sum(float v) { v += __shfl_xor(v, 16); return v + __shfl_xor(v, 32); }

template <bool ISB, int VAR = 0>
__device__ __forceinline__ void attn_unit(ALAS unsigned char* lds, bf16* zg, const float* __restrict__ lutg, int b, int hsel, int q0, const float* __restrict__ sinkp, float lam, float osc, const float* __restrict__ subg, bf16* odry) {
    int tid_ = threadIdx.x; asm volatile("" : "+v"(tid_));
    const int tid = tid_, lane = tid & 63, c16 = lane & 15, g = lane >> 4; const int wid = __builtin_amdgcn_readfirstlane(tid >> 6);
    constexpr int NDVB = ISB ? 8 : 4, BUF = ISB ? 32768 : 16384, VOFF = ISB ? 16384 : 8192, VROW = ISB ? 256 : 128;
    const int map = ISB ? (wid >> 2) : 0, qsub = ISB ? (wid & 3) : (wid & 1), gsel = ISB ? 0 : (wid >> 1);
    const int head = ISB ? hsel : hsel * 4 + gsel;
    const int qrow0 = q0 + 32 * qsub;
    const int qcol = ISB ? (C_QB + head * 128 + map * 64) : (C_QA + head * 64);
    const int kcol = ISB ? (C_KB + head * 128) : (C_KA + hsel * 64);
    const int vcol = ISB ? (C_VB + head * 128) : (C_VA + hsel * 64);
    const size_t rowbase = (size_t)b * S;
    int kt0 = 0, kt1 = S / 64;
    if (!ISB) { kt0 = q0 / 64 - 2; if (kt0 < 0) kt0 = 0; kt1 = q0 / 64 + 3; if (kt1 > S / 64) kt1 = S / 64; }
    const int nt = kt1 - kt0;
    ALAS float* lut = (ALAS float*)(lds + LUT_OFF) + (ISB ? 8 + head : hsel * 4 + gsel) * LUT_STRIDE;
    ALAS float* gt = (ALAS float*)(lds + GT_OFF);
    const float sink2 = ISB ? 0.f : sinkp[head] * LOG2E;
    bf16x8 qr[2][2];
#pragma unroll
    for (int qb = 0; qb < 2; ++qb) { const bf16* qp = zg + (rowbase + qrow0 + 16 * qb + c16) * ZG + qcol + 8 * g;
#pragma unroll
        for (int ks = 0; ks < 2; ++ks) qr[qb][ks] = *(const bf16x8*)(qp + 32 * ks); }
    const unsigned lds0 = (unsigned)(size_t)lds;
    const bf16* kp_[2]; const bf16* vp_[2];
#pragma unroll
    for (int i_ = 0; i_ < 2; ++i_) { const int p_ = ISB ? wid * 2 + i_ : wid;
        kp_[i_] = zg + (rowbase + (size_t)kt0 * 64 + (p_ & 7) * 8 + (lane >> 3)) * ZG + kcol + (ISB ? (p_ >> 3) * 64 : 0) + ((lane & 7) ^ (lane >> 3)) * 8;
        vp_[i_] = ISB ? zg + (rowbase + (size_t)kt0 * 64 + 4 * p_ + (lane >> 4)) * ZG + vcol + ((((lane & 15) >> 1) ^ (4 * (p_ & 1) + (lane >> 4))) * 16) + 8 * (lane & 1)
                      : zg + (rowbase + (size_t)kt0 * 64 + 8 * p_ + (lane >> 3)) * ZG + vcol + ((((lane & 7) >> 1) ^ ((lane >> 4) & 3)) * 16) + 8 * (lane & 1); }
#define ATT_ISSUE(bo) do { \
        _Pragma("unroll") for (int i_ = 0; i_ < (ISB ? 2 : 1); ++i_) { const int p_ = ISB ? wid * 2 + i_ : wid; \
            glds16(kp_[i_], (unsigned)__builtin_amdgcn_readfirstlane((int)(lds0 + (bo) + p_ * 1024))); \
            glds16(vp_[i_], (unsigned)__builtin_amdgcn_readfirstlane((int)(lds0 + (bo) + VOFF + p_ * 1024))); \
            kp_[i_] += 64 * ZG; vp_[i_] += 64 * ZG; } } while (0)
#define ATT_SB() __builtin_amdgcn_sched_barrier(0)
    float mhat[2] = {0.f, 0.f}, lsum[2] = {0.f, 0.f};
    f32x4 o[2][NDVB];
#pragma unroll
    for (int qb = 0; qb < 2; ++qb)
#pragma unroll
        for (int d = 0; d < NDVB; ++d) o[qb][d] = (f32x4){0.f, 0.f, 0.f, 0.f};
    const int kfo = (ISB ? map * 8192 : 0) + c16 * 128 + ((g ^ (c16 & 7)) * 16);
    const int vq = (lane & 15) >> 2, vsw = ISB ? (4 * (g & 1) + vq) : (2 * (g & 1) + (vq >> 1));
    const int vfo = VOFF + (4 * g + vq) * VROW + (lane & 3) * 8;
    u32x4 pw[2][2];
    const float cfar_r = ISB ? lut[256 + 128] : 0.f, cfar_l = ISB ? lut[256 - 128] : 0.f;
#define ATT_QK(P, t, so) do { const int kb_ = (t) * 64; float cf_ = 0.f; \
        if (ISB) { if (kb_ - qrow0 - 31 >= 91) cf_ = cfar_r; else if (kb_ + 63 - qrow0 <= -91) cf_ = cfar_l; } \
        const float c0_ = cf_ - mhat[0], c1_ = cf_ - mhat[1]; const f32x4 ci0_ = (f32x4){c0_, c0_, c0_, c0_}, ci1_ = (f32x4){c1_, c1_, c1_, c1_}; \
        ALAS const unsigned char* kp = lds + (so) + kfo; \
        _Pragma("unroll") for (int kb = 0; kb < 4; ++kb) { \
            const bf16x8 k0_ = *(ALAS const bf16x8*)(kp + kb * 2048), k1_ = *(ALAS const bf16x8*)((ALAS const unsigned char*)((unsigned)(size_t)kp ^ 64u) + kb * 2048); \
            P[0][kb] = __builtin_amdgcn_mfma_f32_16x16x32_bf16(k0_, qr[0][0], ci0_, 0, 0, 0); P[1][kb] = __builtin_amdgcn_mfma_f32_16x16x32_bf16(k0_, qr[1][0], ci1_, 0, 0, 0); \
            P[0][kb] = __builtin_amdgcn_mfma_f32_16x16x32_bf16(k1_, qr[0][1], P[0][kb], 0, 0, 0); P[1][kb] = __builtin_amdgcn_mfma_f32_16x16x32_bf16(k1_, qr[1][1], P[1][kb], 0, 0, 0); } } while (0)
#define ATT_DECIDE(P, t, first) do { const int kb_ = (t) * 64; \
        if (!ISB || !((kb_ - qrow0 - 31 >= 91) || (kb_ + 63 - qrow0 <= -91))) { \
            ALAS const float* lp = lut + (kb_ - (qrow0 + c16) + 256 + 4 * g); \
            _Pragma("unroll") for (int qb = 0; qb < 2; ++qb) { float lv_[16]; \
                _Pragma("unroll") for (int kb = 0; kb < 4; ++kb) _Pragma("unroll") for (int r = 0; r < 4; ++r) lv_[4 * kb + r] = lp[16 * kb - 16 * qb + r]; \
                _Pragma("unroll") for (int kb = 0; kb < 4; ++kb) _Pragma("unroll") for (int r = 0; r < 4; ++r) P[qb][kb][r] += lv_[4 * kb + r]; } } \
        float rm0_ = MX3(MX3(P[0][0][0], P[0][0][1], P[0][0][2]), P[0][0][3], P[0][1][0]), rm1_ = MX3(MX3(P[1][0][0], P[1][0][1], P[1][0][2]), P[1][0][3], P[1][1][0]); \
        rm0_ = MX3(MX3(rm0_, P[0][1][1], P[0][1][2]), P[0][1][3], P[0][2][0]); rm1_ = MX3(MX3(rm1_, P[1][1][1], P[1][1][2]), P[1][1][3], P[1][2][0]); \
        rm0_ = MX3(MX3(rm0_, P[0][2][1], P[0][2][2]), P[0][2][3], P[0][3][0]); rm1_ = MX3(MX3(rm1_, P[1][2][1], P[1][2][2]), P[1][2][3], P[1][3][0]); \
        rm0_ = MX3(MX3(rm0_, P[0][3][1], P[0][3][2]), P[0][3][3], rm0_); rm1_ = MX3(MX3(rm1_, P[1][3][1], P[1][3][2]), P[1][3][3], rm1_); \
        if ((first) || __any(__builtin_fmaxf(rm0_, rm1_) > THR)) { \
            const float f0_ = g4_max(rm0_), f1_ = g4_max(rm1_); \
            const float dl0 = (first) ? f0_ : __builtin_fmaxf(f0_, 0.f), dl1 = (first) ? f1_ : __builtin_fmaxf(f1_, 0.f); \
            mhat[0] += dl0; mhat[1] += dl1; \
            _Pragma("unroll") for (int kb = 0; kb < 4; ++kb) { P[0][kb] -= dl0; P[1][kb] -= dl1; } \
            if (!(first)) { const float s0_ = __builtin_amdgcn_exp2f(-dl0), s1_ = __builtin_amdgcn_exp2f(-dl1); lsum[0] *= s0_; lsum[1] *= s1_; \
                _Pragma("unroll") for (int d = 0; d < NDVB; ++d) { o[0][d] *= s0_; o[1][d] *= s1_; } } } } while (0)
#define ATT_FINISH(P) do { \
        _Pragma("unroll") for (int qb = 0; qb < 2; ++qb) { float sa_ = 0.f; \
            _Pragma("unroll") for (int kb = 0; kb < 4; ++kb) _Pragma("unroll") for (int r = 0; r < 4; ++r) { P[qb][kb][r] = __builtin_amdgcn_exp2f(P[qb][kb][r]); sa_ += P[qb][kb][r]; } \
            lsum[qb] += sa_; \
            _Pragma("unroll") for (int s_ = 0; s_ < 2; ++s_) pw[qb][s_] = (u32x4){cvtpk(P[qb][2 * s_][0], P[qb][2 * s_][1]), cvtpk(P[qb][2 * s_][2], P[qb][2 * s_][3]), cvtpk(P[qb][2 * s_ + 1][0], P[qb][2 * s_ + 1][1]), cvtpk(P[qb][2 * s_ + 1][2], P[qb][2 * s_ + 1][3])}; } } while (0)
#define ATT_LDV2(dst, s_, d0_) do { _Pragma("unroll") for (int dd = 0; dd < 2; ++dd) { ALAS const unsigned char* a_ = vp + (s_) * 32 * VROW + ((((d0_) + dd) ^ vsw) * 32); dst[2 * dd] = vtr(a_); dst[2 * dd + 1] = vtr(a_ + 16 * VROW); } } while (0)
#define ATT_PV2(src, s_, d0_) do { __builtin_amdgcn_s_setprio(1); _Pragma("unroll") for (int dd = 0; dd < 2; ++dd) { \
            const bf16x8 vf_ = (bf16x8){src[2 * dd][0], src[2 * dd][1], src[2 * dd][2], src[2 * dd][3], src[2 * dd + 1][0], src[2 * dd + 1][1], src[2 * dd + 1][2], src[2 * dd + 1][3]}; \
            o[0][(d0_) + dd] = __builtin_amdgcn_mfma_f32_16x16x32_bf16(vf_, __builtin_bit_cast(bf16x8, pw[0][s_]), o[0][(d0_) + dd], 0, 0, 0); \
            o[1][(d0_) + dd] = __builtin_amdgcn_mfma_f32_16x16x32_bf16(vf_, __builtin_bit_cast(bf16x8, pw[1][s_]), o[1][(d0_) + dd], 0, 0, 0); } __builtin_amdgcn_s_setprio(0); } while (0)
#define ATT_PV(so) do { ALAS const unsigned char* vp = lds + (so) + vfo; s16x4 va[4], vb[4]; constexpr int NG_ = NDVB / 2; \
        ATT_LDV2(va, 0, 0); ATT_SB(); \
        _Pragma("unroll") for (int k_ = 0; k_ < 2 * NG_; k_ += 2) { \
            ATT_LDV2(vb, (k_ + 1) / NG_, 2 * ((k_ + 1) % NG_)); ATT_SB(); \
            ATT_PV2(va, k_ / NG_, 2 * (k_ % NG_)); ATT_SB(); \
            if (k_ + 2 < 2 * NG_) { ATT_LDV2(va, (k_ + 2) / NG_, 2 * ((k_ + 2) % NG_)); ATT_SB(); } \
            ATT_PV2(vb, (k_ + 1) / NG_, 2 * ((k_ + 1) % NG_)); ATT_SB(); } } while (0)
#define ATT_SLOT(i) (ISB ? (((i) % 3) * BUF) : ((i) * BUF))
#define ATT_STEP(i, PC, PP) do { \
        if (ISB) { asm volatile("s_waitcnt vmcnt(0)" ::: "memory"); __syncthreads(); if ((i) + 1 < nt) ATT_ISSUE(ATT_SLOT((i) + 1)); } \
        ATT_QK(PC, kt0 + (i), ATT_SLOT(i)); ATT_SB(); \
        ATT_FINISH(PP); ATT_SB(); \
        ATT_PV(ATT_SLOT((i) - 1)); ATT_SB(); \
        ATT_DECIDE(PC, kt0 + (i), false); ATT_SB(); } while (0)
    f32x4 pA[2][4], pB[2][4];
    if (ISB) { ATT_ISSUE(0); asm volatile("s_waitcnt vmcnt(0)" ::: "memory"); __syncthreads(); if (nt > 1) ATT_ISSUE(BUF); }
    else {
#pragma unroll 1
        for (int i = 0; i < nt; ++i) ATT_ISSUE(i * BUF);
        asm volatile("s_waitcnt vmcnt(0)" ::: "memory"); __syncthreads();
    }
    ATT_QK(pA, kt0, 0); ATT_SB();
    ATT_DECIDE(pA, kt0, true); ATT_SB();
    int i = 1;
#pragma unroll 1
    for (; i + 1 < nt; i += 2) {
        ATT_STEP(i, pB, pA);
        ATT_STEP(i + 1, pA, pB);
    }
    if (i < nt) {
        ATT_STEP(i, pB, pA);
        ATT_FINISH(pB); ATT_SB(); ATT_PV(ATT_SLOT(nt - 1));
    } else {
        ATT_FINISH(pA); ATT_SB(); ATT_PV(ATT_SLOT(nt - 1));
    }
#undef ATT_ISSUE
#undef ATT_SB
#undef ATT_QK
#undef ATT_DECIDE
#undef ATT_FINISH
#undef ATT_LDV2
#undef ATT_PV2
#undef ATT_PV
#undef ATT_SLOT
#undef ATT_STEP
    float inv[2];
#pragma unroll
    for (int qb = 0; qb < 2; ++qb) { float l_ = g4_sum(lsum[qb]); if (!ISB) l_ += __builtin_amdgcn_exp2f(sink2 - mhat[qb]); inv[qb] = 1.0f / l_; }
    constexpr int DVE = ISB ? 128 : 64, SPITCH = DVE * 2 + 8;
    bf16* obase = odry ? odry + (rowbase + qrow0) * D + (ISB ? (512 + head * 128) : (head * 64)) : zg + (rowbase + qrow0) * ZG + (ISB ? (C_QB + head * 128) : (C_QA + head * 64));
    const size_t opitch = odry ? D : ZG;
    ALAS unsigned char* stg = lds + (ISB ? qsub * 16384 : wid * 4608);
#define ATT_OUT() do { asm volatile("s_waitcnt lgkmcnt(0)" ::: "memory"); \
        constexpr int LPR = DVE / 8, RPI = 64 / LPR; \
        _Pragma("unroll") for (int i_ = 0; i_ < 32 / RPI; ++i_) { const int row_ = i_ * RPI + lane / LPR, ch_ = lane % LPR; \
            const u32x2 a_ = *(ALAS const u32x2*)(stg + row_ * SPITCH + ch_ * 16), b_ = *(ALAS const u32x2*)(stg + row_ * SPITCH + ch_ * 16 + 8); \
            *(u32x4*)(obase + (size_t)row_ * opitch + ch_ * 8) = (u32x4){a_.x, a_.y, b_.x, b_.y}; } } while (0)
    if (ISB) {
        __syncthreads();
        ALAS float* cs = (ALAS float*)lds;
        if (map == 1) {
#pragma unroll
            for (int qb = 0; qb < 2; ++qb) { const float sc = -lam * inv[qb];
#pragma unroll
                for (int d = 0; d < NDVB; ++d)
#pragma unroll
                    for (int r = 0; r < 4; ++r) cs[(qsub * 64 + (qb * NDVB + d) * 4 + r) * 64 + lane] = o[qb][d][r] * sc; } }
        __syncthreads();
        if (map == 0) {
            float rstd[2];
#pragma unroll
            for (int qb = 0; qb < 2; ++qb) { float q = 0.f;
#pragma unroll
                for (int d = 0; d < NDVB; ++d)
#pragma unroll
                    for (int r = 0; r < 4; ++r) { const float v = o[qb][d][r] * inv[qb] + cs[(qsub * 64 + (qb * NDVB + d) * 4 + r) * 64 + lane]; o[qb][d][r] = v; q += v * v; }
                rstd[qb] = rsqrtf(g4_sum(q) * (1.0f / 128.0f) + EPS); }
            asm volatile("s_waitcnt lgkmcnt(0)" ::: "memory");
#pragma unroll
            for (int qb = 0; qb < 2; ++qb)
#pragma unroll
                for (int d = 0; d < NDVB; ++d) { const int dv0 = 16 * d + 4 * g; const f32x4 gv = *(ALAS const f32x4*)(gt + dv0);
                    u32x2 w; w.x = cvtpk(o[qb][d][0] * rstd[qb] * gv[0], o[qb][d][1] * rstd[qb] * gv[1]); w.y = cvtpk(o[qb][d][2] * rstd[qb] * gv[2], o[qb][d][3] * rstd[qb] * gv[3]);
                    *(ALAS u32x2*)(stg + (16 * qb + c16) * SPITCH + dv0 * 2) = w; }
            ATT_OUT();
        }
    } else {
        __syncthreads();
#pragma unroll
        for (int qb = 0; qb < 2; ++qb)
#pragma unroll
            for (int d = 0; d < NDVB; ++d) { const int dv0 = 16 * d + 4 * g;
                u32x2 w; w.x = cvtpk(o[qb][d][0] * inv[qb], o[qb][d][1] * inv[qb]); w.y = cvtpk(o[qb][d][2] * inv[qb], o[qb][d][3] * inv[qb]);
                *(ALAS u32x2*)(stg + (16 * qb + c16) * SPITCH + dv0 * 2) = w; }
        ATT_OUT();
    }
#undef ATT_OUT
    __syncthreads();
}
#undef MX3
}

#ifndef MK_VAR
#define MK_VAR 0
#endif
#define MK_DUP 0
#define MK_DSEL 0
namespace mk {
using namespace nv;
constexpr int NWAVES = 8;
constexpr size_t MiB = 1u << 20;
constexpr size_t WS_CTL = 0, CTL_ZERO_BYTES = 1 * MiB;
constexpr size_t WS_LUT = 512 * 1024;
constexpr size_t WS_SS = 1 * MiB;
constexpr size_t WS_XB = 6 * MiB;
constexpr size_t WS_ZG = 38 * MiB;
constexpr size_t WS_A = 38 * MiB;
constexpr size_t WS_YB = 126 * MiB;
constexpr size_t WS_MIX = 174 * MiB;
constexpr size_t WS_W = 206 * MiB;
constexpr size_t WL_IN = 0, WL_A = (size_t)ZG * D, WL_B = WL_A + (size_t)D * 512, WL_O = WL_B + (size_t)D * 512, WL_UP = WL_O + (size_t)D * D, WL_DN = WL_UP + (size_t)FF2 * D, WL_END = WL_DN + (size_t)D * FF;
constexpr size_t WS_END = 322 * MiB;
static_assert(WS_W + 4 * WL_END * 2 <= WS_END && WS_YB + (size_t)64 * 4 * FF2 * 4 <= WS_MIX && WS_A + (size_t)T * FF * 2 <= WS_YB, "d_ws map");
constexpr int CW_Q = 2048;
constexpr int CW_BAR = 8192;
constexpr int N_PHASES = 1 + 6 * L;
constexpr int RING_OFF = 0, RING_BYTES = 131072, LDSCTL_OFF = RING_BYTES, MISC_OFF = LDSCTL_OFF + 320;
constexpr int LDS_BYTES = 149504;
static_assert(pg8::RTAB_OFF + 8192 <= LDS_BYTES && MISC_OFF + 128 <= pg8::XOFF, "LDS map");

#define GAS __attribute__((address_space(1)))
#define LAS __attribute__((address_space(3)))
typedef unsigned v4u __attribute__((ext_vector_type(4)));
typedef float f32x4 __attribute__((ext_vector_type(4)));
typedef GAS unsigned gu32;
#define RLX_AGENT __ATOMIC_RELAXED, __HIP_MEMORY_SCOPE_AGENT
#define LDS_WAIT() asm volatile("s_waitcnt lgkmcnt(0)" ::: "memory")
#define VM_WAIT() asm volatile("s_waitcnt vmcnt(0)" ::: "memory")
__device__ __forceinline__ unsigned f2bfu(float f) { unsigned u = __builtin_bit_cast(unsigned, f); return (u + 0x7fffu + ((u >> 16) & 1u)) >> 16; }
__device__ __forceinline__ unsigned pk2(float lo, float hi) { return f2bfu(lo) | (f2bfu(hi) << 16); }

#define XB_TMO      128
#define XB_XCNT(j)  (256  + 64 * (j))
#define XB_XSUB(j)  (1280 + 64 * (j))
#define XB_XGEN(j)  (2304 + 64 * (j))
#define XB_TOP      3328
#define XB_TOPGEN   3392
#define XB_LSUB(j)  (3456 + 64 * (j))
#define XB_LGEN(j)  (4480 + 64 * (j))
#define XCD_BAR_WORDS 5504
#define XB_SPIN_CAP (1u << 18)

__device__ __forceinline__ unsigned xb_ld(unsigned* p)              { return __hip_atomic_load(p, __ATOMIC_RELAXED, __HIP_MEMORY_SCOPE_AGENT); }
__device__ __forceinline__ unsigned xb_add(unsigned* p, unsigned v) { return __hip_atomic_fetch_add(p, v, __ATOMIC_RELAXED, __HIP_MEMORY_SCOPE_AGENT); }
__device__ __forceinline__ unsigned xb_xcc_id() { return (unsigned)__builtin_amdgcn_s_getreg((3 << 11) | 20) & 0xFu; }
#define XB_SPIN(cond, bar) do { unsigned _sp = 0; while (cond) { __builtin_amdgcn_s_sleep(1); \
    if ((++_sp & 255u) == 0u) { if (xb_ld(&(bar)[XB_TMO])) break; if (_sp > XB_SPIN_CAP) { atomicAdd(&(bar)[XB_TMO], 1u); break; } } } } while (0)

struct XcdBarrier {
    unsigned* bar; unsigned x;
    volatile LAS unsigned* st;
};

__device__ __forceinline__ XcdBarrier xcd_barrier_post(unsigned* bar, volatile LAS unsigned* st) {
    XcdBarrier b; b.bar = bar; b.x = xb_xcc_id(); b.st = st;
    if (threadIdx.x == 0) { st[2] = b.x; st[3] = xb_add(&bar[XB_XCNT(b.x)], 1u); }
    return b;
}
__device__ __forceinline__ void xcd_barrier_complete(unsigned* bar, unsigned x, unsigned& nloc, unsigned& nx, unsigned& even) {
    const unsigned G = gridDim.x * gridDim.y * gridDim.z;
    unsigned sum, cnt, mine, odd, sp = 0u;
    for (;;) {
        sum = 0u; cnt = 0u; mine = 0u; odd = 0u;
#pragma unroll
        for (unsigned j = 0; j < 16; ++j) { const unsigned c = xb_ld(&bar[XB_XCNT(j)]); sum += c; cnt += (c > 0u) ? 1u : 0u; mine = (j == x) ? c : mine; odd += (c != 0u && c != 32u) ? 1u : 0u; }
        if (sum == G) break;
        __builtin_amdgcn_s_sleep(1);
        if ((++sp & 255u) == 0u) { if (xb_ld(&bar[XB_TMO])) break; if (sp > XB_SPIN_CAP) { atomicAdd(&bar[XB_TMO], 1u); break; } }
    }
    nloc = mine > 0u ? mine : 1u; nx = cnt > 0u ? cnt : 1u;
    even = (sum == G && G == 256u && cnt == 8u && odd == 0u) ? 1u : 0u;
}

__device__ __forceinline__ void xcd_barrier(const XcdBarrier& b) {
    asm volatile("s_waitcnt vmcnt(0)" ::: "memory");
    __syncthreads();
    if (threadIdx.x == 0) {
        unsigned* bar = b.bar;
        __builtin_amdgcn_s_waitcnt(0);
        unsigned nloc = b.st[0], nx = b.st[1];
        if (nloc == 0u) { unsigned even; xcd_barrier_complete(bar, b.x, nloc, nx, even); b.st[0] = nloc; b.st[1] = nx; b.st[4] = even; }
        const unsigned old = xb_add(&bar[XB_XSUB(b.x)], 1u);
        const unsigned gen = old / nloc;
        if (old + 1u == (gen + 1u) * nloc) {
            __builtin_amdgcn_fence(__ATOMIC_RELEASE, "agent");
            asm volatile("s_waitcnt vmcnt(0)" ::: "memory");
            const unsigned og = xb_add(&bar[XB_TOP], 1u);
            const unsigned tg = og / nx;
            if (og + 1u == (tg + 1u) * nx) xb_add(&bar[XB_TOPGEN], 1u);
            else XB_SPIN(xb_ld(&bar[XB_TOPGEN]) == tg, bar);
            __builtin_amdgcn_fence(__ATOMIC_ACQUIRE, "agent");
            xb_add(&bar[XB_XGEN(b.x)], 1u);
            asm volatile("s_waitcnt vmcnt(0)" ::: "memory");
        } else {
            XB_SPIN(xb_ld(&bar[XB_XGEN(b.x)]) == gen, bar);
            __builtin_amdgcn_fence(__ATOMIC_ACQUIRE, "agent");
            asm volatile("s_waitcnt vmcnt(0)" ::: "memory");
        }
    }
    __syncthreads();
}

__device__ __forceinline__ void xcd_local_barrier(const XcdBarrier& b) {
    asm volatile("s_waitcnt vmcnt(0)" ::: "memory");
    __syncthreads();
    if (threadIdx.x == 0) {
        unsigned* bar = b.bar;
        __builtin_amdgcn_s_waitcnt(0);
        const unsigned nloc = b.st[0];
        const unsigned old = xb_add(&bar[XB_LSUB(b.x)], 1u);
        const unsigned gen = old / nloc;
        if (old + 1u == (gen + 1u) * nloc) xb_add(&bar[XB_LGEN(b.x)], 1u);
        else XB_SPIN(xb_ld(&bar[XB_LGEN(b.x)]) == gen, bar);
        __builtin_amdgcn_fence(__ATOMIC_ACQUIRE, "agent");
        asm volatile("s_waitcnt vmcnt(0)" ::: "memory");
    }
    __syncthreads();
}

struct Args { const float* in[24]; float* out; unsigned char* ws; int ph_lo, ph_hi, li, pad; };

__device__ __forceinline__ void p0_transpose_item(const float* __restrict__ W, int ldw, int K, int k0, int n0, bf16* __restrict__ WT, int vrow0, const float* __restrict__ gain, LAS float* scr, int lane) {
    f32x4 v[8];
    const float* wp = W + (size_t)(k0 + (lane >> 3)) * ldw + n0 + 4 * (lane & 7);
#pragma unroll
    for (int i = 0; i < 8; ++i) v[i] = __builtin_nontemporal_load((const f32x4*)(wp + (size_t)(8 * i) * ldw));
    if (gain) {
#pragma unroll
        for (int i = 0; i < 8; ++i) v[i] *= gain[k0 + 8 * i + (lane >> 3)];
    }
#pragma unroll
    for (int i = 0; i < 8; ++i) { LAS float* d = scr + (8 * i + (lane >> 3)) * 33 + 4 * (lane & 7); d[0] = v[i].x; d[1] = v[i].y; d[2] = v[i].z; d[3] = v[i].w; }
    LDS_WAIT(); asm volatile("" ::: "memory");
    const int c = lane & 7;
#pragma unroll
    for (int j = 0; j < 4; ++j) { const int n = (lane >> 3) + 8 * j; const LAS float* s = scr + (8 * c) * 33 + n;
        v4u o; o.x = pk2(s[0 * 33], s[1 * 33]); o.y = pk2(s[2 * 33], s[3 * 33]); o.z = pk2(s[4 * 33], s[5 * 33]); o.w = pk2(s[6 * 33], s[7 * 33]);
        *(GAS v4u*)(WT + (size_t)(vrow0 + n) * K + k0 + 8 * c) = o; }
    LDS_WAIT(); asm volatile("" ::: "memory");
}
__device__ __forceinline__ int vrow_in(int c) { const int pn = c >> 8, cr = c & 255, wc = cr >> 6, bj = (cr >> 5) & 1; return pn * 256 + bj * 128 + wc * 32; }
__device__ __forceinline__ int vrow_gate(int cg) { const int s_ = cg >= D ? 1 : 0, cc = cg - s_ * D; return (9 + (cc >> 7)) * 256 + s_ * 128 + (cc & 127); }
__device__ __forceinline__ int vrow_up(int c) { const int gs = c >= FF ? 1 : 0, cc = c - gs * FF, pn = cc >> 7, wc = (cc >> 5) & 3; return pn * 256 + gs * 128 + wc * 32; }

__device__ __forceinline__ int cur_bxv(volatile LAS unsigned* MISC) { int b = blockIdx.x; const unsigned ev = MISC[12]; if (ev) b = (int)(MISC[11] * 8u + MISC[10]); return __builtin_amdgcn_readfirstlane(b); }
__device__ __forceinline__ int cur_vcu(volatile LAS unsigned* MISC) { const int b = cur_bxv(MISC), G = gridDim.x; return (G % 8 == 0) ? (b % 8) * (G / 8) + b / 8 : b; }
__global__ void __launch_bounds__(NWAVES * 64, 2) skel_fwd(Args args) {
    extern __shared__ __attribute__((aligned(16))) unsigned char lds_raw[];
    LAS unsigned char* lds = (LAS unsigned char*)lds_raw;
    volatile LAS unsigned* MISC = (volatile LAS unsigned*)(lds + MISC_OFF);
    const int G = gridDim.x;
    unsigned char* ws = args.ws;
    gu32* ctl = (gu32*)(ws + WS_CTL);
    float* ss = (float*)(ws + WS_SS); bf16* xb = (bf16*)(ws + WS_XB); bf16* zg = (bf16*)(ws + WS_ZG); bf16* abuf = (bf16*)(ws + WS_A); float* yb = (float*)(ws + WS_YB);
    bf16* mix = (bf16*)(ws + WS_MIX); bf16* wbase = (bf16*)(ws + WS_W); float* xf = args.out;
    float* lutg = (float*)(ws + WS_LUT);
    for (int u = threadIdx.x; u < (LDS_BYTES - LDSCTL_OFF) / 4; u += NWAVES * 64) ((LAS unsigned*)(lds + LDSCTL_OFF))[u] = 0u;
    __syncthreads();
    XcdBarrier bar = xcd_barrier_post((unsigned*)(ctl + CW_BAR) + args.li * XCD_BAR_WORDS, MISC + 8);

#pragma unroll 1
    for (int ph = args.ph_lo; ph < args.ph_hi; ++ph) {
        const int l = ph > 0 ? (ph - 1) / 6 : 0, p = ph > 0 ? (ph - 1) % 6 + 1 : 0;
#define BXV() cur_bxv(MISC)
#define VCU() cur_vcu(MISC)
        bf16* wl = wbase + (size_t)l * WL_END;
        float* ss1 = ss + (size_t)((2 * l) & 3) * T * 16; float* ss2 = ss + (size_t)((2 * l + 1) & 3) * T * 16; float* ss3 = (l + 1 < L) ? ss + (size_t)((2 * l + 2) & 3) * T * 16 : nullptr;
#ifndef MK_ONLY
#define MK_ONLY 0x7f
#endif
        const int dupp = ((args.pad >> 8) & 0xff) - 1;
#pragma unroll 1
        for (int rep = (p == dupp) ? 0 : 1; rep < 2; ++rep) {
        if (p == 0 && (MK_ONLY & 1)) {
            int tid0 = threadIdx.x; asm volatile("" : "+v"(tid0));
            const int lane0 = tid0 & 63, wave = __builtin_amdgcn_readfirstlane(tid0 >> 6);
            LAS float* scr = (LAS float*)(lds + RING_OFF + wave * 16384);
            const int gw = VCU() * NWAVES + wave, NGW = G * NWAVES;
            constexpr int I_IN = (D / 64) * (INW / 32), I_G = (D / 64) * (GW / 32), I_A = (512 / 64) * (D / 32), I_O = (D / 64) * (D / 32), I_UP = (D / 64) * (FF2 / 32), I_DN = (FF / 64) * (D / 32);
            constexpr int I_LAYER = I_IN + I_G + 2 * I_A + I_O + I_UP + I_DN;
            for (int i = gw * 64 + lane0; i < 12 * att::LUT_STRIDE; i += NGW * 64) { const int hh = i / att::LUT_STRIDE, j = i - hh * att::LUT_STRIDE, rel = j - 256, ar = rel < 0 ? -rel : rel;
                float v = 0.f; if (j <= 512) v = (hh < 8 && ar > 128) ? att::NEG : args.in[13][t5_bucket(rel) * 12 + hh] * LOG2E;
                lutg[i] = v; }
            for (int m = gw; m < T; m += 2 * NGW) {
                const int m2 = m + NGW;
                const GAS f32x4* xr = (const GAS f32x4*)(args.in[0] + (size_t)m * D) + lane0; const GAS f32x4* xr2 = (const GAS f32x4*)(args.in[0] + (size_t)m2 * D) + lane0;
                GAS unsigned long long* o8 = (GAS unsigned long long*)(xb + (size_t)m * D) + lane0; GAS unsigned long long* o82 = (GAS unsigned long long*)(xb + (size_t)m2 * D) + lane0;
                f32x4 va[4], vb[4];
#pragma unroll
                for (int j = 0; j < 4; ++j) { va[j] = xr[64 * j]; vb[j] = xr2[64 * j]; }
                float s = 0.f, s2 = 0.f;
#pragma unroll
                for (int j = 0; j < 4; ++j) { const f32x4 v = va[j], w = vb[j]; s += (v.x * v.x + v.y * v.y) + (v.z * v.z + v.w * v.w); s2 += (w.x * w.x + w.y * w.y) + (w.z * w.z + w.w * w.w);
                    o8[64 * j] = (unsigned long long)pk2(v.x, v.y) | ((unsigned long long)pk2(v.z, v.w) << 32); o82[64 * j] = (unsigned long long)pk2(w.x, w.y) | ((unsigned long long)pk2(w.z, w.w) << 32); }
                s = wave_sum(s); s2 = wave_sum(s2);
                ss16_store(ss, m, s, lane0); ss16_store(ss, m2, s2, lane0);
            }
        } else if (p == 1 && (MK_ONLY & 2)) {
            pg8::SchedStd S; S.init(xb, D, wl + WL_IN, D, T, ZG - 256, G, BXV());
            S.fix = (rep == 0 && MK_VAR == 8) ? 1 : 0;
            pg8::EpiIn E{zg, ss1, args.in[3] + l * 64, args.in[4] + l * 64, args.in[6] + l * 64, args.in[7] + l * 64, args.in[15] + l * GW, (args.pad >> 25) & 1, 8 * (BXV() & 7) * 256};
            pg8::gemm_phase<pg8::EpiIn, pg8::SchedStd, true, true>(lds + RING_OFF, D, D, S, E);
        } else if (p == 2 && (MK_ONLY & 4)) {
            int lop = l; asm volatile("" : "+s"(lop));
            const float lam_init = 0.8f - 0.6f * __expf(-0.3f * (float)lop);
            int ln = threadIdx.x; asm volatile("" : "+v"(ln)); ln &= 63;
            const float d1 = wave_sum(args.in[8][l * 64 + ln] * args.in[9][l * 64 + ln]), d2 = wave_sum(args.in[10][l * 64 + ln] * args.in[11][l * 64 + ln]);
            const float lam = __expf(d1) - __expf(d2) + lam_init;
            if ((VCU() & 3) == 0 && rep == 1) {
                pg8::SchedStd S1; S1.init(xb, D, wl + WL_IN, D, T, ZG, G, BXV()); S1.one = 1; { const int vc = VCU(); S1.opm = 8 * (vc >> 5) + ((vc & 31) >> 2); } S1.opn = 16;
                pg8::EpiIn E1{zg, ss1, args.in[3] + l * 64, args.in[4] + l * 64, args.in[6] + l * 64, args.in[7] + l * 64, args.in[15] + l * GW, 0, 8 * (BXV() & 7) * 256};
                pg8::gemm_phase<pg8::EpiIn, pg8::SchedStd, true, true>(lds + RING_OFF, D, D, S1, E1);
            }
            att::attn_tables(lds, lutg, args.in[12] + l * 128, 1.0f - lam_init);
            const int dsel = args.pad >> 16;
            if (rep == 1 || dsel != 2)
            for (int k_ = 0; k_ < 2; ++k_) { const int vcu = VCU(); const int ui = vcu + k_ * G; if (ui >= 512) break; const int bh = ui >> 4, qb = ui & 15; if (rep == 0 && MK_VAR == 7 && (vcu & 1)) {} else if (rep == 0) att::attn_unit<true, (MK_VAR == 7 ? 0 : MK_VAR)>(lds, zg, lutg, bh >> 2, bh & 3, qb * 128, nullptr, lam, 1.0f - lam_init, args.in[12] + l * 128, mix);
                else att::attn_unit<true, 0>(lds, zg, lutg, bh >> 2, bh & 3, qb * 128, nullptr, lam, 1.0f - lam_init, args.in[12] + l * 128, nullptr); }
            if (rep == 1 || dsel != 1) {
                unsigned* qctr = (unsigned*)(ctl + CW_Q + 64 * (2 * l + rep));
                for (;;) {
                    if (threadIdx.x == 0) MISC[4] = __hip_atomic_fetch_add(qctr, 1u, __ATOMIC_RELAXED, __HIP_MEMORY_SCOPE_AGENT);
                    __syncthreads();
                    const int ui = (int)MISC[4];
                    __syncthreads();
                    if (ui >= 512) break;
                    const int bk = ui >> 5, qb = ui & 31; att::attn_unit<false>(lds, zg, lutg, bk >> 1, bk & 1, qb * 64, args.in[5] + l * HA, 0.f, 0.f, nullptr, rep == 0 ? mix : nullptr);
                }
            }
        } else if (p == 3 && (MK_ONLY & 8)) {
            pg8::SchedMix S; S.b.init(zg + C_QA, ZG, wl + WL_A, 512, T, D, G, BXV()); S.A1 = (const char*)(zg + C_QB); S.Bt1 = (const char*)(wl + WL_B);
            pg8::EpiMix E{zg, mix};
            pg8::gemm_phase<pg8::EpiMix, pg8::SchedMix, true, true>(lds + RING_OFF, 512, ZG, S, E);
        } else if (p == 4 && (MK_ONLY & 16)) {
            pg8::SchedStd S; S.init(mix, D, wl + WL_O, D, T, D, G, BXV());
            pg8::EpiRes E{l == 0 ? args.in[0] : xf, xf, xb, ss2};
            pg8::gemm_phase<pg8::EpiRes, pg8::SchedStd, true, true>(lds + RING_OFF, D, D, S, E);
        } else if (p == 5 && (MK_ONLY & 32)) {
            pg8::SchedStd S; S.init(xb, D, wl + WL_UP, D, T, FF2, G, BXV());
            pg8::EpiUp E{abuf, ss2, args.in[21] + (size_t)l * 3 * FF2, args.in[22] + (size_t)l * FF2, yb, (args.pad >> 24) & 1, 8 * (BXV() & 7) * 256};
            pg8::gemm_phase<pg8::EpiUp, pg8::SchedStd, true, true>(lds + RING_OFF, D, D, S, E);
        } else if (MK_ONLY & 64) {
            pg8::SchedDown S; S.b.init(abuf, FF, wl + WL_DN, FF, T, D, G, BXV()); S.yb = (args.pad & 1) ? nullptr : yb; S.cw = args.in[21] + (size_t)l * 3 * FF2; S.cb = args.in[22] + (size_t)l * FF2; S.a = abuf;
            pg8::EpiRes E{xf, xf, ss3 ? xb : nullptr, ss3};
            pg8::gemm_phase<pg8::EpiRes, pg8::SchedDown, true, true>(lds + RING_OFF, FF, FF, S, E);
        }
        {
            int ph2 = ph; asm volatile("" : "+s"(ph2));
            const int l2 = ph2 > 0 ? (ph2 - 1) / 6 : 0, p2 = ph2 > 0 ? (ph2 - 1) % 6 + 1 : 0;
            const int G2 = gridDim.x; int bx2 = blockIdx.x; { const unsigned ev2 = MISC[12]; if (ev2) bx2 = (int)(MISC[11] * 8u + MISC[10]); } bx2 = __builtin_amdgcn_readfirstlane(bx2);
            int cl = -1, cw0 = 0, cnw = 1;
            if (p2 == 0) { cl = 0; cw0 = ((G2 % 8 == 0) ? (bx2 % 8) * (G2 / 8) + bx2 / 8 : bx2) * NWAVES; cnw = G2 * NWAVES; }
            else if (p2 == 5 && l2 + 1 < L && G2 == 256 && bx2 >= 128) { cl = l2 + 1; cw0 = (bx2 - 128) * NWAVES; cnw = 128 * NWAVES; }
            if (cl >= 0) {
                bf16* wbase2 = (bf16*)(args.ws + WS_W);
                int tid0 = threadIdx.x; asm volatile("" : "+v"(tid0));
                const int lane0 = tid0 & 63, wave = __builtin_amdgcn_readfirstlane(tid0 >> 6);
                LAS float* scr = (LAS float*)(lds + RING_OFF + wave * 16384);
                constexpr int I_IN = (D / 64) * (INW / 32), I_G = (D / 64) * (GW / 32), I_A = (512 / 64) * (D / 32), I_O = (D / 64) * (D / 32), I_UP = (D / 64) * (FF2 / 32), I_DN = (FF / 64) * (D / 32);
                constexpr int I_LAYER = I_IN + I_G + 2 * I_A + I_O + I_UP + I_DN;
                const int ll = cl; bf16* w = wbase2 + (size_t)ll * WL_END;
#pragma unroll 1
                for (int it = cw0 + wave; it < I_LAYER; it += cnw) {
                    int r = it;
                    if (r < I_IN) { const int nb = r % (INW / 32), kb = r / (INW / 32); p0_transpose_item(args.in[2] + (size_t)ll * D * INW, INW, D, 64 * kb, 32 * nb, w + WL_IN, vrow_in(32 * nb), args.in[1] + ll * D, scr, lane0); continue; } r -= I_IN;
                    if (r < I_G) { const int nb = r % (GW / 32), kb = r / (GW / 32); p0_transpose_item(args.in[14] + (size_t)ll * D * GW, GW, D, 64 * kb, 32 * nb, w + WL_IN, vrow_gate(32 * nb), args.in[1] + ll * D, scr, lane0); continue; } r -= I_G;
                    if (r < I_A) { const int nb = r % (D / 32), kb = r / (D / 32); p0_transpose_item(args.in[16] + (size_t)ll * 512 * D, D, 512, 64 * kb, 32 * nb, w + WL_A, 32 * nb, nullptr, scr, lane0); continue; } r -= I_A;
                    if (r < I_A) { const int nb = r % (D / 32), kb = r / (D / 32); p0_transpose_item(args.in[17] + (size_t)ll * 512 * D, D, 512, 64 * kb, 32 * nb, w + WL_B, 32 * nb, nullptr, scr, lane0); continue; } r -= I_A;
                    if (r < I_O) { const int nb = r % (D / 32), kb = r / (D / 32); p0_transpose_item(args.in[18] + (size_t)ll * D * D, D, D, 64 * kb, 32 * nb, w + WL_O, 32 * nb, nullptr, scr, lane0); continue; } r -= I_O;
                    if (r < I_UP) { const int nb = r % (FF2 / 32), kb = r / (FF2 / 32); p0_transpose_item(args.in[20] + (size_t)ll * D * FF2, FF2, D, 64 * kb, 32 * nb, w + WL_UP, vrow_up(32 * nb), args.in[19] + ll * D, scr, lane0); continue; } r -= I_UP;
                    { const int nb = r % (D / 32), kb = r / (D / 32); p0_transpose_item(args.in[23] + (size_t)ll * FF * D, D, FF, 64 * kb, 32 * nb, w + WL_DN, 32 * nb, nullptr, scr, lane0); }
                }
            }
        }
        }
        if (ph + 1 < args.ph_hi) { int pq = ph; asm volatile("" : "+s"(pq)); const unsigned ev3 = MISC[12]; const bool loc = ev3 != 0u && pq > 0 && (pq - 1) % 6 >= 2 && (pq - 1) % 6 != 5; if (__builtin_amdgcn_readfirstlane((int)loc)) xcd_local_barrier(bar); else xcd_barrier(bar); }
    }
}
}

extern "C" void kernel_launch(void* const* d_in, const int* in_sizes, int n_in, void* d_out, int out_size, void* d_ws, size_t ws_size, hipStream_t stream) {
    using namespace nv;
    static int grid = 0;
    if (grid == 0) {
        if (n_in != 24 || in_sizes[0] != T * D || out_size != T * D || ws_size < mk::WS_END) { fprintf(stderr, "kernel_launch: built for 24 inputs, x/out of %d floats, >= %zu bytes of workspace; got n_in %d, out %d, ws %zu; nothing launched\n", T * D, (size_t)mk::WS_END, n_in, out_size, ws_size); grid = -1; return; }
        int dev = 0, cus = 0, per_cu = 0;
        if (hipGetDevice(&dev) != hipSuccess || hipDeviceGetAttribute(&cus, hipDeviceAttributeMultiprocessorCount, dev) != hipSuccess) { fprintf(stderr, "kernel_launch: device query failed; nothing launched\n"); grid = -1; return; }
        if (hipFuncSetAttribute((const void*)mk::skel_fwd, hipFuncAttributeMaxDynamicSharedMemorySize, mk::LDS_BYTES) != hipSuccess) { fprintf(stderr, "kernel_launch: hipFuncSetAttribute failed (needs %d bytes of dynamic LDS)\n", mk::LDS_BYTES); grid = -1; return; }
        if (hipOccupancyMaxActiveBlocksPerMultiprocessor(&per_cu, (const void*)mk::skel_fwd, mk::NWAVES * 64, mk::LDS_BYTES) != hipSuccess || per_cu < 1) fprintf(stderr, "kernel_launch: note: occupancy query reports %d workgroups per CU\n", per_cu);
        (void)hipGetLastError();
        grid = cus;
        if (grid != 256) fprintf(stderr, "kernel_launch: the unit schedules are built for 256 CUs; this device reports %d\n", cus);
    }
    if (grid < 0) return;
    if (hipMemsetAsync((unsigned char*)d_ws + mk::WS_CTL, 0, mk::CTL_ZERO_BYTES, stream) != hipSuccess) { fprintf(stderr, "kernel_launch: memset of the control words failed; nothing launched\n"); return; }
    mk::Args a{};
    for (int i = 0; i < 24; ++i) a.in[i] = (const float*)d_in[i];
    a.out = (float*)d_out; a.ws = (unsigned char*)d_ws; a.ph_lo = 0; a.ph_hi = mk::N_PHASES; a.li = 0;
    a.pad = (MK_DUP << 8) | (MK_DSEL << 16);
    hipLaunchKernelGGL(mk::skel_fwd, dim3(grid), dim3(mk::NWAVES * 64), mk::LDS_BYTES, stream, a);
}
```
